# Optimizing an MI355X kernel written in HIP

```python
import math
import jax, jax.numpy as jnp
from jax import lax
import numpy as np

D_MODEL = 1024
BATCH = 8
SEQ = 4096
DEPTH = 2
DEC_BATCH = 8
DEC_SEQ = 64
PAST_LEN = 2048

CHUNK = 64
N_META = 16
EPS = 1e-6
F32 = jnp.float32

SSD_HEADS = 8
SSD_HEAD_DIM = 64
SSD_INNER = SSD_HEADS * SSD_HEAD_DIM
SSD_GROUPS = 2
SSD_STATE = 128
SSD_CONV = 4
SSD_CONV_DIM = SSD_INNER + 2 * SSD_GROUPS * SSD_STATE
SSD_IN = SSD_INNER + SSD_CONV_DIM + SSD_HEADS

RW_HEADS = 8
RW_HEAD_DIM = 64
RW_DIM = RW_HEADS * RW_HEAD_DIM
RW_DECAY_LORA = 64
RW_A_LORA = 64
RW_GATE_LORA = 128
RW_IN = 3 * RW_DIM + RW_DECAY_LORA + RW_A_LORA + RW_GATE_LORA
RW_GN_EPS = 64e-5

HG_HEADS = 4
HG_KEY = 128
HG_VAL = 128
HG_KDIM = HG_HEADS * HG_KEY
HG_VDIM = HG_HEADS * HG_VAL
HG_IN = 2 * HG_KDIM + 2 * HG_VDIM

D_MIX = SSD_INNER + RW_DIM + HG_VDIM
N_IN = SSD_IN + RW_IN + HG_IN
D_FF = -(-8 * D_MODEL // (3 * 256)) * 256
EXP_CLAMP = 60.0

kernel_name = 'hymba_ssd_rwkv7_hgrn2_stream_step'


def _split(a, sizes):
    return jnp.split(a, np.cumsum(sizes)[:-1].tolist(), axis=-1)


def _rmsnorm(x, w):
    xf = x.astype(F32)
    y = xf * lax.rsqrt(jnp.mean(jnp.square(xf), -1, keepdims=True) + EPS)
    return (y * w.astype(F32)).astype(x.dtype)


def _group_rmsnorm(x, w, n_groups):
    shp = x.shape
    xf = x.astype(F32).reshape(shp[:-1] + (n_groups, shp[-1] // n_groups))
    y = xf * lax.rsqrt(jnp.mean(jnp.square(xf), -1, keepdims=True) + EPS)
    return y.reshape(shp) * w.astype(F32)


def _group_layernorm(x, w, b, n_groups, eps):
    shp = x.shape
    xf = x.astype(F32).reshape(shp[:-1] + (n_groups, shp[-1] // n_groups))
    mu = jnp.mean(xf, -1, keepdims=True)
    var = jnp.mean(jnp.square(xf - mu), -1, keepdims=True)
    y = (xf - mu) * lax.rsqrt(var + eps)
    return y.reshape(shp) * w.astype(F32) + b.astype(F32)


def _masked_exp(diff, mask):
    return jnp.where(mask, jnp.exp(jnp.where(mask, diff, 0.0)), 0.0)


def _causal_conv(u, buf, w, b):
    up = jnp.concatenate([buf.astype(u.dtype), u], axis=1)
    T = u.shape[1]
    y = sum(up[:, j:j + T] * w[j] for j in range(SSD_CONV)) + b
    return jax.nn.silu(y), up[:, -(SSD_CONV - 1):]


def _token_shift(u, prev, mu):
    shifted = jnp.concatenate([prev[:, None].astype(u.dtype), u[:, :-1]], axis=1)
    return u + (shifted - u) * mu, u[:, -1]


def _ssd_chunk_scan(x, loga, Bm, Cm, h0, chunk):
    b, T = x.shape[:2]
    n = T // chunk
    R = SSD_HEADS // SSD_GROUPS
    mask = jnp.tril(jnp.ones((chunk, chunk), bool))[None, :, :, None, None]

    def blocks(a):
        return jnp.moveaxis(a.astype(F32).reshape((b, n, chunk) + a.shape[2:]), 1, 0)

    def step(h, inp):
        xc, ac, bc, cc = inp
        xg = xc.reshape(b, chunk, SSD_GROUPS, R, SSD_HEAD_DIM)
        cum = jnp.cumsum(ac, axis=1).reshape(b, chunk, SSD_GROUPS, R)
        L = _masked_exp(cum[:, :, None] - cum[:, None], mask)
        cb = jnp.einsum('bign,bjgn->bijg', cc, bc)
        y = jnp.einsum('bijgr,bjgrp->bigrp', L * cb[..., None], xg)
        y = y + jnp.einsum('bign,bgrpn->bigrp', cc, h) * jnp.exp(cum)[..., None]
        h = h * jnp.exp(cum[:, -1])[..., None, None] + jnp.einsum(
            'bjgrp,bjgn->bgrpn', xg * jnp.exp(cum[:, -1:] - cum)[..., None], bc)
        return h, y

    hg0 = h0.astype(F32).reshape(b, SSD_GROUPS, R, SSD_HEAD_DIM, SSD_STATE)
    hT, ys = lax.scan(step, hg0, (blocks(x), blocks(loga), blocks(Bm), blocks(Cm)))
    y = jnp.moveaxis(ys, 0, 1).reshape(b, T, SSD_HEADS, SSD_HEAD_DIM)
    return y, hT.reshape(b, SSD_HEADS, SSD_HEAD_DIM, SSD_STATE)


def _gla_chunk_scan(q, k, v, logf, S0, chunk):
    b, T, H, K = q.shape
    n = T // chunk
    mask = jnp.tril(jnp.ones((chunk, chunk), bool))[None, :, :, None, None]

    def blocks(a):
        return jnp.moveaxis(a.astype(F32).reshape((b, n, chunk) + a.shape[2:]), 1, 0)

    def step(S, inp):
        qc, kc, vc, fc = inp
        cum = jnp.cumsum(fc, axis=1)
        dec = _masked_exp(cum[:, :, None] - cum[:, None], mask)
        A = jnp.einsum('bijhk,bjhk->bijh', dec * qc[:, :, None], kc)
        o = jnp.einsum('bijh,bjhv->bihv', A, vc) + jnp.einsum('bihk,bhkv->bihv', qc * jnp.exp(cum), S)
        S = S * jnp.exp(cum[:, -1])[..., None] + jnp.einsum(
            'bjhk,bjhv->bhkv', kc * jnp.exp(cum[:, -1:] - cum), vc)
        return S, o

    ST, os_ = lax.scan(step, S0.astype(F32), tuple(blocks(a) for a in (q, k, v, logf)))
    return jnp.moveaxis(os_, 0, 1).reshape(b, T, H, v.shape[-1]), ST


def _rwkv7_scan(r, w, k, v, a, bb, S0):
    def step(S, inp):
        rt, wt, kt, vt, at, bt = inp
        sa = jnp.einsum('bhvk,bhk->bhv', S, at)
        S = S * wt[:, :, None, :] + sa[..., None] * bt[:, :, None, :] + vt[..., None] * kt[:, :, None, :]
        return S, jnp.einsum('bhvk,bhk->bhv', S, rt)

    xs = tuple(jnp.moveaxis(t.astype(F32), 1, 0) for t in (r, w, k, v, a, bb))
    ST, outs = lax.scan(step, S0.astype(F32), xs)
    return jnp.moveaxis(outs, 0, 1), ST


def _run_segments(scan_fn, arrays, state, segs):
    outs, start = [], 0
    for length, chunk in segs:
        y, state = scan_fn(*[a[:, start:start + length] for a in arrays], state, chunk)
        outs.append(y)
        start += length
    return jnp.concatenate(outs, axis=1), state


def _lower_bounds(logits):
    s = jax.nn.softmax(logits.astype(F32), axis=0)
    return jnp.cumsum(s, axis=0) - s[0]


def _mixer(h, l, ssm0, conv0, rw0, shift0, hg0, segs, p):
    b, T, _ = h.shape
    proj = jnp.einsum('btd,dn->btn', h, p['w_in'][l])
    z, xbc, dt_raw, rw_in, hg_in = _split(proj, [SSD_INNER, SSD_CONV_DIM, SSD_HEADS, RW_IN, HG_IN])

    xbc, conv_new = _causal_conv(xbc, conv0, p['conv_w'][l], p['conv_b'][l])
    xs, Bm, Cm = _split(xbc.astype(F32), [SSD_INNER, SSD_GROUPS * SSD_STATE, SSD_GROUPS * SSD_STATE])
    dt = jax.nn.softplus(dt_raw.astype(F32) + p['dt_bias'][l])
    loga = -jnp.exp(p['a_log'][l].astype(F32)) * dt
    xh = xs.reshape(b, T, SSD_HEADS, SSD_HEAD_DIM)
    y_ssd, ssm_new = _run_segments(
        _ssd_chunk_scan,
        (xh * dt[..., None], loga, Bm.reshape(b, T, SSD_GROUPS, SSD_STATE), Cm.reshape(b, T, SSD_GROUPS, SSD_STATE)),
        ssm0, segs)
    y_ssd = (y_ssd + p['d_skip'][l][:, None] * xh).reshape(b, T, SSD_INNER)
    y_ssd = _group_rmsnorm(y_ssd * jax.nn.silu(z.astype(F32)), p['ssd_norm_w'][l], SSD_GROUPS)

    rw_in, shift_new = _token_shift(rw_in, shift0, p['rw_mu'][l])
    r, k, v, xw, xa, xg = _split(rw_in.astype(F32), [RW_DIM] * 3 + [RW_DECAY_LORA, RW_A_LORA, RW_GATE_LORA])
    logw = -jax.nn.softplus(-(p['rw_w0'][l] + jnp.tanh(xw) @ p['rw_w2'][l])) - 0.5
    decay = jnp.exp(-jnp.exp(logw))
    a = jax.nn.sigmoid(p['rw_a0'][l] + xa @ p['rw_a2'][l])
    g = jax.nn.sigmoid(xg) @ p['rw_g2'][l]
    heads = lambda t: t.reshape(b, T, RW_HEADS, RW_HEAD_DIM)
    kk = heads(k * p['rw_kk'][l])
    kk = kk * lax.rsqrt(jnp.sum(kk * kk, -1, keepdims=True) + 1e-12)
    k = k * (1.0 + (a - 1.0) * p['rw_ka'][l])
    rh, kh, vh, ah = heads(r), heads(k), heads(v), heads(a)
    o_rw, rw_new = _rwkv7_scan(rh, heads(decay), kh, vh, -kk, kk * ah, rw0)
    o_rw = _group_layernorm(o_rw.reshape(b, T, RW_DIM), p['rw_lnx_w'][l], p['rw_lnx_b'][l], RW_HEADS, RW_GN_EPS)
    bonus = jnp.sum(rh * kh * p['rw_rk'][l].reshape(RW_HEADS, RW_HEAD_DIM), -1, keepdims=True) * vh
    y_rw = (o_rw + bonus.reshape(b, T, RW_DIM)) * g

    q, fz, inp, gg = _split(hg_in.astype(F32), [HG_KDIM, HG_KDIM, HG_VDIM, HG_VDIM])
    lb = _lower_bounds(p['hg_lb_logits'])[l]
    logf = jax.nn.log_sigmoid(fz) + jnp.log1p(lb * jnp.exp(jnp.minimum(-fz, EXP_CLAMP)))
    kg = (1.0 - lb) * jax.nn.sigmoid(-fz)
    hk = lambda t: t.reshape(b, T, HG_HEADS, HG_KEY)
    o_hg, hg_new = _run_segments(
        _gla_chunk_scan, (hk(q), hk(kg), inp.reshape(b, T, HG_HEADS, HG_VAL), hk(logf)), hg0, segs)
    y_hg = _group_rmsnorm(o_hg.reshape(b, T, HG_VDIM), p['hg_norm_w'][l], HG_HEADS) * jax.nn.silu(gg)

    y = jnp.concatenate([y_ssd, y_rw, y_hg], axis=-1).astype(h.dtype)
    out = jnp.einsum('btm,md->btd', y, p['w_out'][l])
    dt_ = h.dtype
    return out, (ssm_new.astype(dt_), conv_new.astype(dt_), rw_new.astype(dt_),
                 shift_new.astype(dt_), hg_new.astype(dt_))


def _swiglu(h, wg, wu, wd):
    return (jax.nn.silu(h @ wg) * (h @ wu)) @ wd


def _trunk(x, states, segs, p):
    new = [[] for _ in range(5)]
    for l in range(DEPTH):
        st = [s[l] for s in states]
        m, ns = _mixer(_rmsnorm(x, p['norm1_w'][l]), l, *st, segs, p)
        x = x + m
        x = x + _swiglu(_rmsnorm(x, p['norm2_w'][l]), p['w_gate'][l], p['w_up'][l], p['w_down'][l])
        for lst, s in zip(new, ns):
            lst.append(s)
    return _rmsnorm(x, p['final_norm_w']), [jnp.stack(lst) for lst in new]


def setup_inputs(seed: int = 0) -> dict:
    k = jax.random.split(jax.random.key(seed), 40)

    def nrm(i, shape, scale):
        return jax.random.normal(k[i], shape, jnp.float32) * scale

    L = DEPTH
    dt0 = jnp.exp(jax.random.uniform(k[12], (L, SSD_HEADS), jnp.float32, math.log(1e-3), math.log(1e-1)))
    return {
        'x_prompt': nrm(0, (BATCH, SEQ, D_MODEL), 1.0),
        'x_sample': nrm(1, (DEC_BATCH, DEC_SEQ, D_MODEL), 1.0),
        'state_ssm': nrm(2, (L, DEC_BATCH, SSD_HEADS, SSD_HEAD_DIM, SSD_STATE), 0.1),
        'state_conv': nrm(3, (L, DEC_BATCH, SSD_CONV - 1, SSD_CONV_DIM), 1.0),
        'state_rwkv': nrm(4, (L, DEC_BATCH, RW_HEADS, RW_HEAD_DIM, RW_HEAD_DIM), 0.1),
        'state_shift': nrm(5, (L, DEC_BATCH, RW_IN), 1.0),
        'state_hgrn': nrm(6, (L, DEC_BATCH, HG_HEADS, HG_KEY, HG_VAL), 0.1),
        'meta_tokens': nrm(7, (N_META, D_MODEL), 1.0),
        'norm1_w': 1.0 + nrm(8, (L, D_MODEL), 0.05),
        'w_in': nrm(9, (L, D_MODEL, N_IN), D_MODEL ** -0.5),
        'conv_w': nrm(10, (L, SSD_CONV, SSD_CONV_DIM), 0.5),
        'conv_b': nrm(11, (L, SSD_CONV_DIM), 0.05),
        'dt_bias': dt0 + jnp.log(-jnp.expm1(-dt0)),
        'a_log': jnp.log(jax.random.uniform(k[13], (L, SSD_HEADS), jnp.float32, 1.0, 16.0)),
        'd_skip': 1.0 + nrm(14, (L, SSD_HEADS), 0.1),
        'ssd_norm_w': 1.0 + nrm(15, (L, SSD_INNER), 0.05),
        'rw_mu': jax.random.uniform(k[16], (L, RW_IN), jnp.float32),
        'rw_w0': jax.random.uniform(k[17], (L, RW_DIM), jnp.float32, -6.0, 1.0),
        'rw_w2': nrm(18, (L, RW_DECAY_LORA, RW_DIM), 0.1),
        'rw_a0': nrm(19, (L, RW_DIM), 0.1),
        'rw_a2': nrm(20, (L, RW_A_LORA, RW_DIM), 0.1),
        'rw_g2': nrm(21, (L, RW_GATE_LORA, RW_DIM), RW_GATE_LORA ** -0.5),
        'rw_kk': 1.0 + nrm(22, (L, RW_DIM), 0.1),
        'rw_ka': 1.0 + nrm(23, (L, RW_DIM), 0.1),
        'rw_rk': nrm(24, (L, RW_DIM), 0.1),
        'rw_lnx_w': 1.0 + nrm(25, (L, RW_DIM), 0.05),
        'rw_lnx_b': nrm(26, (L, RW_DIM), 0.02),
        'hg_lb_logits': nrm(27, (L, HG_KDIM), 0.5),
        'hg_norm_w': 1.0 + nrm(28, (L, HG_VDIM), 0.05),
        'w_out': nrm(29, (L, D_MIX, D_MODEL), D_MIX ** -0.5),
        'norm2_w': 1.0 + nrm(30, (L, D_MODEL), 0.05),
        'w_gate': nrm(31, (L, D_MODEL, D_FF), D_MODEL ** -0.5),
        'w_up': nrm(32, (L, D_MODEL, D_FF), D_MODEL ** -0.5),
        'w_down': nrm(33, (L, D_FF, D_MODEL), D_FF ** -0.5),
        'final_norm_w': 1.0 + nrm(34, (D_MODEL,), 0.05),
    }


def reference(x_prompt, x_sample, state_ssm, state_conv, state_rwkv, state_shift, state_hgrn,
              meta_tokens, norm1_w, w_in, conv_w, conv_b, dt_bias, a_log, d_skip, ssd_norm_w,
              rw_mu, rw_w0, rw_w2, rw_a0, rw_a2, rw_g2, rw_kk, rw_ka, rw_rk, rw_lnx_w, rw_lnx_b,
              hg_lb_logits, hg_norm_w, w_out, norm2_w, w_gate, w_up, w_down, final_norm_w):
    p = {'norm1_w': norm1_w, 'w_in': w_in, 'conv_w': conv_w, 'conv_b': conv_b, 'dt_bias': dt_bias,
         'a_log': a_log, 'd_skip': d_skip, 'ssd_norm_w': ssd_norm_w, 'rw_mu': rw_mu, 'rw_w0': rw_w0,
         'rw_w2': rw_w2, 'rw_a0': rw_a0, 'rw_a2': rw_a2, 'rw_g2': rw_g2, 'rw_kk': rw_kk, 'rw_ka': rw_ka,
         'rw_rk': rw_rk, 'rw_lnx_w': rw_lnx_w, 'rw_lnx_b': rw_lnx_b, 'hg_lb_logits': hg_lb_logits,
         'hg_norm_w': hg_norm_w, 'w_out': w_out, 'norm2_w': norm2_w, 'w_gate': w_gate, 'w_up': w_up,
         'w_down': w_down, 'final_norm_w': final_norm_w}

    b, T = x_prompt.shape[:2]
    dt_ = x_prompt.dtype
    meta = jnp.broadcast_to(meta_tokens[None].astype(dt_), (b, N_META, D_MODEL))
    xp = jnp.concatenate([meta, x_prompt], axis=1)
    zero_states = [jnp.zeros((DEPTH, b) + s.shape[2:], dt_)
                   for s in (state_ssm, state_conv, state_rwkv, state_shift, state_hgrn)]
    yp, ps = _trunk(xp, zero_states, ((N_META, N_META), (T, CHUNK)), p)
    y_prompt = yp[:, N_META:]
    p_ssm, p_conv, p_rwkv, p_shift, p_hgrn = ps

    ds = x_sample.shape[1]
    y_sample, ss = _trunk(x_sample, (state_ssm, state_conv, state_rwkv, state_shift, state_hgrn),
                          ((ds, ds),), p)
    s_ssm, s_conv, s_rwkv, s_shift, s_hgrn = ss
    return (y_prompt, y_sample, p_ssm, p_conv, p_rwkv, p_shift, p_hgrn,
            s_ssm, s_conv, s_rwkv, s_shift, s_hgrn)
```

```cpp
#include <hip/hip_runtime.h>
#include <hip/hip_bf16.h>
#include <hip/hip_cooperative_groups.h>
#include <cstdio>
namespace cg = cooperative_groups;

#ifndef MEGA
#define MEGA 1
#endif

typedef unsigned short u16;
using bf16x8 = __attribute__((ext_vector_type(8))) short;
using f32x16 = __attribute__((ext_vector_type(16))) float;

constexpr int DM = 1024;
constexpr int M_TOT = 33408;
constexpr int M_PROMPT = 32896;
constexpr int T_P = 4112;
constexpr int LDP = 5376;
constexpr int N_IN = 5384;
constexpr int D_FF = 2816;
constexpr int NBLK16 = M_TOT / 16;
constexpr int C_Z = 0, C_R = 512, C_GG = 1024, C_XBC = 1536, C_K = 2560, C_V = 3072, C_XW = 3584, C_XA = 3648,
              C_XG = 3712, C_Q = 3840, C_F = 4352, C_I = 4864;
constexpr long O_YP = 0, O_YS = 33554432, O_PSSM = 34078720, O_PCONV = 35127296, O_PRWKV = 35176448,
               O_PSHIFT = 35700736, O_PHGRN = 35729408, O_SSSM = 36777984, O_SCONV = 37826560,
               O_SRWKV = 37875712, O_SSHIFT = 38400000, O_SHGRN = 38428672;

struct Params {
  const float *x_prompt, *x_sample, *state_ssm, *state_conv, *state_rwkv, *state_shift, *state_hgrn, *meta,
      *norm1_w, *w_in, *conv_w, *conv_b, *dt_bias, *a_log, *d_skip, *ssd_norm_w, *rw_mu, *rw_w0, *rw_w2, *rw_a0,
      *rw_a2, *rw_g2, *rw_kk, *rw_ka, *rw_rk, *rw_lnx_w, *rw_lnx_b, *hg_lb, *hg_norm_w, *w_out, *norm2_w, *w_gate,
      *w_up, *w_down, *final_w;
  float* out;
  u16 *XB, *PROJ, *W1T, *WOT, *WGU, *WDT, *BND, *ORW, *RWX;
  float *RS, *DTRAW, *RKS;
};

__device__ __forceinline__ u16 f2bf(float f) {
  unsigned u = __float_as_uint(f);
  u += 0x7fffu + ((u >> 16) & 1u);
  return (u16)(u >> 16);
}
__device__ __forceinline__ float bf2f(u16 h) { return __uint_as_float(((unsigned)h) << 16); }
__device__ __forceinline__ float sigmoidf_(float x) { return 1.f / (1.f + __expf(-x)); }
__device__ __forceinline__ float siluf_(float x) { return x / (1.f + __expf(-x)); }
__device__ __forceinline__ float softplusf_(float x) { return x > 20.f ? x : log1pf(__expf(x)); }

template <int CTRL>
__device__ __forceinline__ float dppf(float v) {
  return __int_as_float(__builtin_amdgcn_update_dpp(0, __float_as_int(v), CTRL, 0xF, 0xF, true));
}
__device__ __forceinline__ float sum16(float v) {
  v += dppf<0xB1>(v);
  v += dppf<0x4E>(v);
  v += dppf<0x141>(v);
  v += dppf<0x140>(v);
  return v;
}
__device__ __forceinline__ float sum64(float v) {
  v = sum16(v);
  v += __shfl_xor(v, 16);
  v += __shfl_xor(v, 32);
  return v;
}

__device__ __forceinline__ int opaque_tid() {
  int t = threadIdx.x;
  asm volatile("" : "+v"(t));
  return t;
}
__device__ __forceinline__ int seq_base(int s) { return s < 8 ? s * T_P : M_PROMPT + (s - 8) * 64; }
__device__ __forceinline__ int seq_len(int s) { return s < 8 ? T_P : 64; }

__device__ __forceinline__ void phase_embed(const Params& p) {
  const long n4 = (long)M_TOT * 256;
  for (long idx = (long)blockIdx.x * 256 + threadIdx.x; idx < n4; idx += (long)gridDim.x * 256) {
    int m = (int)(idx >> 8), c4 = ((int)idx & 255) * 4;
    const float* src;
    if (m < M_PROMPT) {
      int b = m / T_P, t = m - b * T_P;
      src = (t < 16) ? p.meta + (long)t * DM : p.x_prompt + ((long)b * 4096 + (t - 16)) * DM;
    } else {
      src = p.x_sample + (long)(m - M_PROMPT) * DM;
    }
    float4 v = *(const float4*)(src + c4);
    ushort4 o;
    o.x = f2bf(v.x); o.y = f2bf(v.y); o.z = f2bf(v.z); o.w = f2bf(v.w);
    *(ushort4*)(p.XB + (long)m * DM + c4) = o;
  }
}

__device__ __forceinline__ void conv_tile(const float* __restrict__ src, int ldsrc, int srccol0, const float* __restrict__ scale,
                          u16* __restrict__ dst, int K, int k0, int n0, float* tile  ) {
  const int tid = opaque_tid();
  __syncthreads();
  {
    int nn = tid & 63, kb = tid >> 6;
#pragma unroll
    for (int i = 0; i < 16; ++i) {
      int kk = kb + 4 * i;
      float v = src[(long)(k0 + kk) * ldsrc + srccol0 + nn];
      if (scale) v *= scale[k0 + kk];
      tile[kk * 65 + nn] = v;
    }
  }
  __syncthreads();
  {
    int nn = tid >> 2, kq = (tid & 3) * 16;
    u16* d = dst + (long)(n0 + nn) * K + k0 + kq;
#pragma unroll
    for (int j = 0; j < 16; j += 2) {
      unsigned w = f2bf(tile[(kq + j) * 65 + nn]) | ((unsigned)f2bf(tile[(kq + j + 1) * 65 + nn]) << 16);
      *(unsigned*)(d + j) = w;
    }
  }
}

__device__ __forceinline__ int w1_srccol(int n0) {
  if (n0 < 512) return n0;
  if (n0 < 1024) return n0 - 512 + 1544;
  if (n0 < 1536) return n0 - 1024 + 4872;
  if (n0 < 2560) return n0 - 1536 + 512;
  if (n0 < 3840) return n0 - 2560 + 2056;
  return n0 - 3840 + 3336;
}

constexpr int CV_W1 = 16 * 84, CV_WO = 24 * 16, CV_WGU = 16 * 88, CV_WD = 44 * 16;
constexpr int CV_TOTAL = CV_W1 + CV_WO + CV_WGU + CV_WD;

__device__ __forceinline__ void phase_convert(const Params& p, int l, float* smem) {
  for (int u = blockIdx.x; u < CV_TOTAL; u += gridDim.x) {
    if (u < CV_W1) {
      int kt = u % 16, nt = u / 16;
      conv_tile(p.w_in + (long)l * DM * N_IN, N_IN, w1_srccol(nt * 64), p.norm1_w + l * DM, p.W1T, 1024, kt * 64,
                nt * 64, smem);
    } else if (u < CV_W1 + CV_WO) {
      int v = u - CV_W1;
      int kt = v % 24, nt = v / 24;
      conv_tile(p.w_out + (long)l * 1536 * DM, DM, nt * 64, nullptr, p.WOT, 1536, kt * 64, nt * 64, smem);
    } else if (u < CV_W1 + CV_WO + CV_WGU) {
      int v = u - CV_W1 - CV_WO;
      int kt = v % 16, nt = v / 16;
      const float* wg = p.w_gate + (long)l * DM * D_FF;
      const float* wu = p.w_up + (long)l * DM * D_FF;
      const float* sc = p.norm2_w + l * DM;
      const int tid = opaque_tid();
      __syncthreads();
      {
        int nn = tid & 63, kb = tid >> 6;
        const float* src = (nn < 32) ? wg : wu;
        int col = nt * 32 + (nn & 31);
#pragma unroll
        for (int i = 0; i < 16; ++i) {
          int kk = kb + 4 * i;
          smem[kk * 65 + nn] = src[(long)(kt * 64 + kk) * D_FF + col] * sc[kt * 64 + kk];
        }
      }
      __syncthreads();
      {
        int nn = tid >> 2, kq = (tid & 3) * 16;
        u16* d = p.WGU + (long)(nt * 64 + nn) * 1024 + kt * 64 + kq;
#pragma unroll
        for (int j = 0; j < 16; j += 2) {
          unsigned w = f2bf(smem[(kq + j) * 65 + nn]) | ((unsigned)f2bf(smem[(kq + j + 1) * 65 + nn]) << 16);
          *(unsigned*)(d + j) = w;
        }
      }
    } else {
      int v = u - CV_W1 - CV_WO - CV_WGU;
      int kt = v % 44, nt = v / 44;
      conv_tile(p.w_down + (long)l * D_FF * DM, DM, nt * 64, nullptr, p.WDT, D_FF, kt * 64, nt * 64, smem);
    }
  }
}

template <bool WITH_DT>
__device__ __forceinline__ void phase_rowstat(const Params& p, int l, float* smem) {
  const int tid = opaque_tid(), lane = tid & 63, wid = tid >> 6;
  float* dtw = smem;
  if (WITH_DT) {
    __syncthreads();
    const float* w = p.w_in + (long)l * DM * N_IN + 1536;
    const float* nw = p.norm1_w + l * DM;
    for (int i = tid; i < 8192; i += 256) {
      int k = i >> 3, h = i & 7;
      dtw[i] = w[(long)k * N_IN + h] * nw[k];
    }
    __syncthreads();
  }
  for (int blk = blockIdx.x; blk < NBLK16; blk += gridDim.x) {
    for (int rr = wid; rr < 16; rr += 4) {
      int m = blk * 16 + rr;
      float ss = 0.f;
      float d[8];
#pragma unroll
      for (int h = 0; h < 8; ++h) d[h] = 0.f;
#pragma unroll 1
      for (int j = 0; j < 4; ++j) {
        int k0 = lane * 4 + 256 * j;
        uint2 raw = *(const uint2*)(p.XB + (long)m * DM + k0);
        float xs[4] = {bf2f((u16)(raw.x & 0xffff)), bf2f((u16)(raw.x >> 16)), bf2f((u16)(raw.y & 0xffff)),
                       bf2f((u16)(raw.y >> 16))};
#pragma unroll
        for (int e = 0; e < 4; ++e) {
          float x = xs[e];
          ss += x * x;
          if (WITH_DT) {
            float4 w0 = *(const float4*)(dtw + (k0 + e) * 8);
            float4 w1 = *(const float4*)(dtw + (k0 + e) * 8 + 4);
            d[0] += x * w0.x; d[1] += x * w0.y; d[2] += x * w0.z; d[3] += x * w0.w;
            d[4] += x * w1.x; d[5] += x * w1.y; d[6] += x * w1.z; d[7] += x * w1.w;
          }
        }
      }
      ss = sum64(ss);
      float rs = rsqrtf(ss * (1.f / 1024.f) + 1e-6f);
      if (WITH_DT) {
#pragma unroll
        for (int h = 0; h < 8; ++h) d[h] = sum64(d[h]);
        if (lane == 0) {
#pragma unroll
          for (int h = 0; h < 8; ++h) p.DTRAW[(long)m * 8 + h] = d[h] * rs;
        }
      }
      if (lane == 0) p.RS[m] = rs;
    }
  }
}

constexpr int G_BK = 32, G_LDS_ROW = 80;
constexpr int G_OPER_BYTES = 128 * G_LDS_ROW;
template <int MODE>
__device__ __forceinline__ void phase_gemm(const Params& p, const u16* __restrict__ A, int lda, const u16* __restrict__ Bt, int K,
                           int nN, char* smem) {
  const int tid = opaque_tid(), lane = tid & 63, wid = tid >> 6, wm = wid >> 1, wn = wid & 1;
  const int nM = M_TOT / 128;
  const int ntiles = nM * nN;
  const int nk = K / G_BK;
  const int lrow = tid >> 2, lkc = tid & 3;
  for (int tile = blockIdx.x; tile < ntiles; tile += gridDim.x) {
    int grp = tile / (8 * nN);
    int first_m = grp * 8;
    int gsz = min(8, nM - first_m);
    int rem = tile - grp * 8 * nN;
    int pm = first_m + rem % gsz, pn = rem / gsz;
    const u16* gA = A + (long)(pm * 128 + lrow) * lda + lkc * 8;
    const u16* gB = Bt + (long)(pn * 128 + lrow) * K + lkc * 8;
    f32x16 acc[2][2];
#pragma unroll
    for (int i = 0; i < 2; ++i)
#pragma unroll
      for (int j = 0; j < 2; ++j)
#pragma unroll
        for (int r = 0; r < 16; ++r) acc[i][j][r] = 0.f;
    uint4 ra0, ra1, rb0, rb1;
    ra0 = *(const uint4*)(gA);
    ra1 = *(const uint4*)(gA + (long)64 * lda);
    rb0 = *(const uint4*)(gB);
    rb1 = *(const uint4*)(gB + (long)64 * K);
    __syncthreads();
    {
      char* sA = smem;
      char* sB = smem + G_OPER_BYTES;
      *(uint4*)(sA + lrow * G_LDS_ROW + lkc * 16) = ra0;
      *(uint4*)(sA + (lrow + 64) * G_LDS_ROW + lkc * 16) = ra1;
      *(uint4*)(sB + lrow * G_LDS_ROW + lkc * 16) = rb0;
      *(uint4*)(sB + (lrow + 64) * G_LDS_ROW + lkc * 16) = rb1;
    }
    __syncthreads();
    for (int kt = 0; kt < nk; ++kt) {
      const int cur = kt & 1;
      if (kt + 1 < nk) {
        ra0 = *(const uint4*)(gA + (kt + 1) * G_BK);
        ra1 = *(const uint4*)(gA + (long)64 * lda + (kt + 1) * G_BK);
        rb0 = *(const uint4*)(gB + (kt + 1) * G_BK);
        rb1 = *(const uint4*)(gB + (long)64 * K + (kt + 1) * G_BK);
      }
      const char* sA = smem + cur * 2 * G_OPER_BYTES;
      const char* sB = sA + G_OPER_BYTES;
#pragma unroll
      for (int ks = 0; ks < 2; ++ks) {
        bf16x8 af[2], bfr[2];
        const int koff = (ks * 16 + (lane >> 5) * 8) * 2;
#pragma unroll
        for (int i = 0; i < 2; ++i)
          af[i] = *(const bf16x8*)(sA + (wm * 64 + i * 32 + (lane & 31)) * G_LDS_ROW + koff);
#pragma unroll
        for (int j = 0; j < 2; ++j)
          bfr[j] = *(const bf16x8*)(sB + (wn * 64 + j * 32 + (lane & 31)) * G_LDS_ROW + koff);
#pragma unroll
        for (int i = 0; i < 2; ++i)
#pragma unroll
          for (int j = 0; j < 2; ++j)
            acc[i][j] = __builtin_amdgcn_mfma_f32_32x32x16_bf16(af[i], bfr[j], acc[i][j], 0, 0, 0);
      }
      if (kt + 1 < nk) {
        char* dA = smem + (cur ^ 1) * 2 * G_OPER_BYTES;
        char* dB = dA + G_OPER_BYTES;
        *(uint4*)(dA + lrow * G_LDS_ROW + lkc * 16) = ra0;
        *(uint4*)(dA + (lrow + 64) * G_LDS_ROW + lkc * 16) = ra1;
        *(uint4*)(dB + lrow * G_LDS_ROW + lkc * 16) = rb0;
        *(uint4*)(dB + (lrow + 64) * G_LDS_ROW + lkc * 16) = rb1;
      }
      __syncthreads();
    }
    const int colb = pn * 128 + wn * 64 + (lane & 31);
    const int rowb = pm * 128 + wm * 64 + 4 * (lane >> 5);
    if (MODE == 1) {
#pragma unroll
      for (int i = 0; i < 2; ++i)
#pragma unroll
        for (int r = 0; r < 16; ++r) {
          int row = rowb + i * 32 + (r & 3) + 8 * (r >> 2);
          float rs = p.RS[row];
#pragma unroll
          for (int j = 0; j < 2; ++j) {
            int col = colb + j * 32;
            u16 v = f2bf(acc[i][j][r] * rs);
            p.PROJ[(long)row * LDP + col] = v;
            if ((row & 15) == 15) {
              int jj = -1;
              if (col >= C_R && col < C_GG) jj = col - C_R;
              else if (col >= C_K && col < C_Q) jj = col - C_K + 512;
              if (jj >= 0) p.BND[(long)(row >> 4) * 1792 + jj] = v;
            }
          }
        }
    } else if (MODE == 2) {
#pragma unroll
      for (int i = 0; i < 2; ++i)
#pragma unroll
        for (int r = 0; r < 16; ++r) {
          int row = rowb + i * 32 + (r & 3) + 8 * (r >> 2);
#pragma unroll
          for (int j = 0; j < 2; ++j) {
            int col = colb + j * 32;
            u16* px = p.XB + (long)row * DM + col;
            *px = f2bf(bf2f(*px) + acc[i][j][r]);
          }
        }
    } else {
      const int cact = pn * 64 + wn * 32 + (lane & 31);
      u16* ACT = p.PROJ;
#pragma unroll
      for (int i = 0; i < 2; ++i)
#pragma unroll
        for (int r = 0; r < 16; ++r) {
          int row = rowb + i * 32 + (r & 3) + 8 * (r >> 2);
          float rs = p.RS[row];
          float g = acc[i][0][r] * rs, u = acc[i][1][r] * rs;
          ACT[(long)row * D_FF + cact] = f2bf(siluf_(g) * u);
        }
    }
  }
}

__device__ __forceinline__ void phase_pre(const Params& p, int l, float* smem) {
  const int tid = opaque_tid(), lane = tid & 63, wid = tid >> 6;
  float* XW = smem;
  float* XA = smem + 1024;
  const float* mu = p.rw_mu + l * 1792;
  for (int blk = blockIdx.x; blk < NBLK16; blk += gridDim.x) {
    const int m0 = blk * 16;
    int s, t0;
    if (m0 < M_PROMPT) { s = m0 / T_P; t0 = m0 - s * T_P; } else { s = 8 + (m0 - M_PROMPT) / 64; t0 = (m0 - M_PROMPT) & 63; }
    const bool first = (t0 == 0);
    auto prev_of = [&](int j) -> float {
      if (!first) return bf2f(p.BND[(long)(blk - 1) * 1792 + j]);
      if (s < 8) return 0.f;
      return p.state_shift[((long)l * 8 + (s - 8)) * 1792 + j];
    };
    __syncthreads();
    {
      int j = 1536 + tid;
      float mj = mu[j];
      float pv = prev_of(j);
      u16* col = p.PROJ + (long)m0 * LDP + C_XW + tid;
#pragma unroll
      for (int t = 0; t < 16; ++t) {
        float x = bf2f(col[(long)t * LDP]);
        float sh = x + (pv - x) * mj;
        pv = x;
        if (tid < 64) XW[tid * 16 + t] = tanhf(sh);
        else if (tid < 128) XA[(tid - 64) * 16 + t] = sh;
        else col[(long)t * LDP] = f2bf(sigmoidf_(sh));
      }
    }
    __syncthreads();
#pragma unroll 1
    for (int c = 0; c < 2; ++c) {
      const int ch = tid + 256 * c;
      const int head = wid + 4 * c;
      float aw[16], aa[16];
#pragma unroll
      for (int t = 0; t < 16; ++t) { aw[t] = 0.f; aa[t] = 0.f; }
      {
        const float* w2 = p.rw_w2 + (long)l * 64 * 512 + ch;
        const float* a2 = p.rw_a2 + (long)l * 64 * 512 + ch;
#pragma unroll 2
        for (int i = 0; i < 64; ++i) {
          float w2v = w2[i * 512];
          float a2v = a2[i * 512];
#pragma unroll
          for (int q = 0; q < 4; ++q) {
            float4 xw = *(const float4*)(XW + i * 16 + q * 4);
            float4 xa = *(const float4*)(XA + i * 16 + q * 4);
            aw[q * 4 + 0] += xw.x * w2v; aw[q * 4 + 1] += xw.y * w2v;
            aw[q * 4 + 2] += xw.z * w2v; aw[q * 4 + 3] += xw.w * w2v;
            aa[q * 4 + 0] += xa.x * a2v; aa[q * 4 + 1] += xa.y * a2v;
            aa[q * 4 + 2] += xa.z * a2v; aa[q * 4 + 3] += xa.w * a2v;
          }
        }
      }
      {
        float w0 = p.rw_w0[l * 512 + ch], a0 = p.rw_a0[l * 512 + ch];
#pragma unroll
        for (int t = 0; t < 16; ++t) {
          float lw = -softplusf_(-(w0 + aw[t])) - 0.5f;
          float u = -__expf(lw);
          p.RWX[(long)(m0 + t) * 1536 + ch] = f2bf(u);
          aa[t] = sigmoidf_(a0 + aa[t]);
        }
      }
      float rt[16];
      {
        float mj = mu[ch];
        float pv = prev_of(ch);
        u16* col = p.PROJ + (long)m0 * LDP + C_R + ch;
#pragma unroll
        for (int t = 0; t < 16; ++t) {
          float x = bf2f(col[(long)t * LDP]);
          rt[t] = x + (pv - x) * mj;
          pv = x;
        }
#pragma unroll
        for (int t = 0; t < 16; ++t) col[(long)t * LDP] = f2bf(rt[t]);
      }
      {
        float mj = mu[512 + ch];
        float pv = prev_of(512 + ch);
        float kkw = p.rw_kk[l * 512 + ch], kaw = p.rw_ka[l * 512 + ch], rkw = p.rw_rk[l * 512 + ch];
        u16* col = p.PROJ + (long)m0 * LDP + C_K + ch;
        float kt[16];
#pragma unroll
        for (int t = 0; t < 16; ++t) {
          float x = bf2f(col[(long)t * LDP]);
          kt[t] = x + (pv - x) * mj;
          pv = x;
        }
#pragma unroll
        for (int t = 0; t < 16; ++t) {
          float kkv = kt[t] * kkw;
          float ssq = sum64(kkv * kkv);
          float kk = kkv * rsqrtf(ssq + 1e-12f);
          float a = aa[t];
          float kp = kt[t] * (1.f + (a - 1.f) * kaw);
          float rks = sum64(rt[t] * kp * rkw);
          col[(long)t * LDP] = f2bf(kp);
          p.RWX[(long)(m0 + t) * 1536 + 512 + ch] = f2bf(kk);
          p.RWX[(long)(m0 + t) * 1536 + 1024 + ch] = f2bf(kk * a);
          if (lane == 0) p.RKS[(long)(m0 + t) * 8 + head] = rks;
        }
      }
      {
        float mj = mu[1024 + ch];
        float pv = prev_of(1024 + ch);
        u16* col = p.PROJ + (long)m0 * LDP + C_V + ch;
        float vt[16];
#pragma unroll
        for (int t = 0; t < 16; ++t) {
          float x = bf2f(col[(long)t * LDP]);
          vt[t] = x + (pv - x) * mj;
          pv = x;
        }
#pragma unroll
        for (int t = 0; t < 16; ++t) col[(long)t * LDP] = f2bf(vt[t]);
      }
    }
    if (t0 + 16 == seq_len(s)) {
      float* o = p.out + (s < 8 ? O_PSHIFT + ((long)l * 8 + s) * 1792 : O_SSHIFT + ((long)l * 8 + (s - 8)) * 1792);
      for (int j = tid; j < 1792; j += 256) o[j] = bf2f(p.BND[(long)blk * 1792 + j]);
    }
  }
}

__device__ __forceinline__ void scan_rwkv(const Params& p, int l, int s, int h, int q, float* smem) {
  const int tid = opaque_tid(), lane = tid & 63, wid = tid >> 6;
  float* R_ = smem;
  float* W_ = smem + 1024;
  float* K_ = smem + 2048;
  float* A_ = smem + 3072;
  float* B_ = smem + 4096;
  float* V_ = smem + 5120;
  float* O_ = smem + 5376;
  const int rl = wid * 4 + (lane >> 4);
  const int row = q * 16 + rl;
  const int ksl = (lane & 15) * 4;
  const int base = seq_base(s), T = seq_len(s);
  float s0 = 0.f, s1 = 0.f, s2 = 0.f, s3 = 0.f;
  if (s >= 8) {
    const float* st = p.state_rwkv + (((long)l * 8 + (s - 8)) * 8 + h) * 4096 + row * 64 + ksl;
    float4 v = *(const float4*)st;
    s0 = v.x; s1 = v.y; s2 = v.z; s3 = v.w;
  }
  const int stt = tid >> 4, skq = (tid & 15) * 4;
  for (int blk = 0; blk < T / 16; ++blk) {
    const long m = base + blk * 16 + stt;
    __syncthreads();
    {
      const u16* pr = p.PROJ + m * LDP;
      const u16* px = p.RWX + m * 1536;
      ushort4 r4 = *(const ushort4*)(pr + C_R + h * 64 + skq);
      ushort4 k4 = *(const ushort4*)(pr + C_K + h * 64 + skq);
      ushort4 u4 = *(const ushort4*)(px + h * 64 + skq);
      ushort4 a4 = *(const ushort4*)(px + 512 + h * 64 + skq);
      ushort4 b4 = *(const ushort4*)(px + 1024 + h * 64 + skq);
      u16 vv = pr[C_V + h * 64 + q * 16 + (tid & 15)];
      *(float4*)(R_ + stt * 64 + skq) = make_float4(bf2f(r4.x), bf2f(r4.y), bf2f(r4.z), bf2f(r4.w));
      *(float4*)(K_ + stt * 64 + skq) = make_float4(bf2f(k4.x), bf2f(k4.y), bf2f(k4.z), bf2f(k4.w));
      *(float4*)(W_ + stt * 64 + skq) =
          make_float4(__expf(bf2f(u4.x)), __expf(bf2f(u4.y)), __expf(bf2f(u4.z)), __expf(bf2f(u4.w)));
      *(float4*)(A_ + stt * 64 + skq) = make_float4(-bf2f(a4.x), -bf2f(a4.y), -bf2f(a4.z), -bf2f(a4.w));
      *(float4*)(B_ + stt * 64 + skq) = make_float4(bf2f(b4.x), bf2f(b4.y), bf2f(b4.z), bf2f(b4.w));
      V_[stt * 16 + (tid & 15)] = bf2f(vv);
    }
    __syncthreads();
#pragma unroll 4
    for (int tt = 0; tt < 16; ++tt) {
      float4 a = *(const float4*)(A_ + tt * 64 + ksl);
      float4 w = *(const float4*)(W_ + tt * 64 + ksl);
      float4 b = *(const float4*)(B_ + tt * 64 + ksl);
      float4 k = *(const float4*)(K_ + tt * 64 + ksl);
      float4 r = *(const float4*)(R_ + tt * 64 + ksl);
      float v = V_[tt * 16 + rl];
      float sa = sum16(s0 * a.x + s1 * a.y + s2 * a.z + s3 * a.w);
      s0 = s0 * w.x + sa * b.x + v * k.x;
      s1 = s1 * w.y + sa * b.y + v * k.y;
      s2 = s2 * w.z + sa * b.z + v * k.z;
      s3 = s3 * w.w + sa * b.w + v * k.w;
      float o = sum16(s0 * r.x + s1 * r.y + s2 * r.z + s3 * r.w);
      if ((lane & 15) == 0) O_[tt * 16 + rl] = o;
    }
    __syncthreads();
    p.ORW[m * 512 + h * 64 + q * 16 + (tid & 15)] = f2bf(O_[stt * 16 + (tid & 15)]);
  }
  {
    float* o = p.out + (s < 8 ? O_PRWKV + (((long)l * 8 + s) * 8 + h) * 4096
                              : O_SRWKV + (((long)l * 8 + (s - 8)) * 8 + h) * 4096);
    *(float4*)(o + row * 64 + ksl) = make_float4(s0, s1, s2, s3);
  }
}

__device__ __forceinline__ void scan_hgrn(const Params& p, int l, int s, int h, int q, float* smem) {
  const int tid = opaque_tid(), lane = tid & 63, wid = tid >> 6;
  float* Q_ = smem;
  float* F_ = smem + 2048;
  float* G_ = smem + 4096;
  float* I_ = smem + 6144;
  float* O_ = smem + 6400;
  const int rl = wid * 4 + (lane >> 4);
  const int row = q * 16 + rl;
  const int ksl = (lane & 15) * 8;
  const int base = seq_base(s), T = seq_len(s);
  float st[8];
#pragma unroll
  for (int i = 0; i < 8; ++i) st[i] = 0.f;
  if (s >= 8) {
    const float* sp = p.state_hgrn + (((long)l * 8 + (s - 8)) * 4 + h) * 16384;
#pragma unroll
    for (int i = 0; i < 8; ++i) st[i] = sp[(ksl + i) * 128 + row];
  }
  const int stt = tid >> 4, skq = (tid & 15) * 8;
  float lb[8];
#pragma unroll
  for (int i = 0; i < 8; ++i) {
    if (l == 0) lb[i] = 0.f;
    else {
      float x0 = p.hg_lb[h * 128 + skq + i], x1 = p.hg_lb[512 + h * 128 + skq + i];
      lb[i] = 1.f / (1.f + __expf(x0 - x1));
    }
  }
  for (int blk = 0; blk < T / 16; ++blk) {
    const long m = base + blk * 16 + stt;
    __syncthreads();
    {
      const u16* pr = p.PROJ + m * LDP;
      uint4 q8 = *(const uint4*)(pr + C_Q + h * 128 + skq);
      uint4 f8 = *(const uint4*)(pr + C_F + h * 128 + skq);
      u16 iv = pr[C_I + h * 128 + q * 16 + (tid & 15)];
      unsigned qw[4] = {q8.x, q8.y, q8.z, q8.w}, fw[4] = {f8.x, f8.y, f8.z, f8.w};
#pragma unroll
      for (int e = 0; e < 8; ++e) {
        float qv = bf2f((u16)((qw[e >> 1] >> ((e & 1) * 16)) & 0xffff));
        float fz = bf2f((u16)((fw[e >> 1] >> ((e & 1) * 16)) & 0xffff));
        float ex = __expf(-fz);
        float sg = 1.f / (1.f + ex);
        float sgn = ex * sg;
        Q_[stt * 128 + skq + e] = qv;
        F_[stt * 128 + skq + e] = lb[e] + (1.f - lb[e]) * sg;
        G_[stt * 128 + skq + e] = (1.f - lb[e]) * sgn;
      }
      I_[stt * 16 + (tid & 15)] = bf2f(iv);
    }
    __syncthreads();
#pragma unroll 2
    for (int tt = 0; tt < 16; ++tt) {
      float iv = I_[tt * 16 + rl];
      float acc = 0.f;
#pragma unroll
      for (int hlf = 0; hlf < 2; ++hlf) {
        float4 f = *(const float4*)(F_ + tt * 128 + ksl + hlf * 4);
        float4 g = *(const float4*)(G_ + tt * 128 + ksl + hlf * 4);
        float4 qq = *(const float4*)(Q_ + tt * 128 + ksl + hlf * 4);
        st[hlf * 4 + 0] = st[hlf * 4 + 0] * f.x + g.x * iv;
        st[hlf * 4 + 1] = st[hlf * 4 + 1] * f.y + g.y * iv;
        st[hlf * 4 + 2] = st[hlf * 4 + 2] * f.z + g.z * iv;
        st[hlf * 4 + 3] = st[hlf * 4 + 3] * f.w + g.w * iv;
        acc += st[hlf * 4 + 0] * qq.x + st[hlf * 4 + 1] * qq.y + st[hlf * 4 + 2] * qq.z + st[hlf * 4 + 3] * qq.w;
      }
      float o = sum16(acc);
      if ((lane & 15) == 0) O_[tt * 16 + rl] = o;
    }
    __syncthreads();
    p.PROJ[m * LDP + C_I + h * 128 + q * 16 + (tid & 15)] = f2bf(O_[stt * 16 + (tid & 15)]);
  }
  {
    float* o = p.out + (s < 8 ? O_PHGRN + (((long)l * 8 + s) * 4 + h) * 16384
                              : O_SHGRN + (((long)l * 8 + (s - 8)) * 4 + h) * 16384);
#pragma unroll
    for (int i = 0; i < 8; ++i) o[(ksl + i) * 128 + row] = st[i];
  }
}

__device__ __forceinline__ void scan_ssd(const Params& p, int l, int s, int h, int q, float* smem) {
  const int tid = opaque_tid(), lane = tid & 63, wid = tid >> 6;
  float* B_ = smem;
  float* C_ = smem + 2048;
  float* X_ = smem + 4096;
  float* O_ = smem + 4352;
  float* DT_ = smem + 4608;
  float* DE_ = smem + 4624;
  const int rl = wid * 4 + (lane >> 4);
  const int row = q * 16 + rl;
  const int ksl = (lane & 15) * 8;
  const int g = h >> 2;
  const int base = seq_base(s), T = seq_len(s);
  float st[8];
#pragma unroll
  for (int i = 0; i < 8; ++i) st[i] = 0.f;
  if (s >= 8) {
    const float* sp = p.state_ssm + (((long)l * 8 + (s - 8)) * 8 + h) * 8192 + row * 128 + ksl;
    float4 a = *(const float4*)sp, b = *(const float4*)(sp + 4);
    st[0] = a.x; st[1] = a.y; st[2] = a.z; st[3] = a.w; st[4] = b.x; st[5] = b.y; st[6] = b.z; st[7] = b.w;
  }
  const int xc_bc = (tid < 128) ? (512 + g * 128 + tid) : (768 + g * 128 + (tid - 128));
  const float* cw = p.conv_w + (long)l * 4 * 1024;
  const float cb0 = cw[xc_bc], cb1 = cw[1024 + xc_bc], cb2 = cw[2048 + xc_bc], cb3 = cw[3072 + xc_bc];
  const float cbb = p.conv_b[l * 1024 + xc_bc];
  float u3 = 0.f, u2 = 0.f, u1 = 0.f;
  const int xc_x = h * 64 + q * 16 + (tid & 15);
  const float cx0 = cw[xc_x], cx1 = cw[1024 + xc_x], cx2 = cw[2048 + xc_x], cx3 = cw[3072 + xc_x];
  const float cxb = p.conv_b[l * 1024 + xc_x];
  float x3 = 0.f, x2 = 0.f, x1 = 0.f;
  if (s >= 8) {
    const float* sc = p.state_conv + ((long)l * 8 + (s - 8)) * 3 * 1024;
    u3 = sc[xc_bc]; u2 = sc[1024 + xc_bc]; u1 = sc[2048 + xc_bc];
    x3 = sc[xc_x]; x2 = sc[1024 + xc_x]; x1 = sc[2048 + xc_x];
  }
  const float dtb = p.dt_bias[l * 8 + h];
  const float aexp = __expf(p.a_log[l * 8 + h]);
  const float dsk = p.d_skip[l * 8 + h];
  const int stt = tid >> 4;
  for (int blk = 0; blk < T / 16; ++blk) {
    const long m0 = base + blk * 16;
    __syncthreads();
    {
      const u16* col = p.PROJ + m0 * LDP + C_XBC + xc_bc;
      float* dst = (tid < 128) ? (B_ + tid) : (C_ + (tid - 128));
#pragma unroll
      for (int t = 0; t < 16; ++t) {
        float u0 = bf2f(col[(long)t * LDP]);
        float y = cb0 * u3 + cb1 * u2 + cb2 * u1 + cb3 * u0 + cbb;
        dst[t * 128] = siluf_(y);
        u3 = u2; u2 = u1; u1 = u0;
      }
      if (tid < 16) {
        const u16* colx = p.PROJ + m0 * LDP + C_XBC + xc_x;
#pragma unroll
        for (int t = 0; t < 16; ++t) {
          float u0 = bf2f(colx[(long)t * LDP]);
          float y = cx0 * x3 + cx1 * x2 + cx2 * x1 + cx3 * u0 + cxb;
          X_[t * 16 + tid] = siluf_(y);
          x3 = x2; x2 = x1; x1 = u0;
        }
      } else if (tid < 32) {
        int t = tid - 16;
        float dtv = softplusf_(p.DTRAW[(m0 + t) * 8 + h] + dtb);
        DT_[t] = dtv;
        DE_[t] = __expf(-aexp * dtv);
      }
    }
    __syncthreads();
#pragma unroll 2
    for (int tt = 0; tt < 16; ++tt) {
      float xv = X_[tt * 16 + rl];
      float xd = xv * DT_[tt];
      float de = DE_[tt];
      float acc = 0.f;
#pragma unroll
      for (int hlf = 0; hlf < 2; ++hlf) {
        float4 b = *(const float4*)(B_ + tt * 128 + ksl + hlf * 4);
        float4 c = *(const float4*)(C_ + tt * 128 + ksl + hlf * 4);
        st[hlf * 4 + 0] = st[hlf * 4 + 0] * de + xd * b.x;
        st[hlf * 4 + 1] = st[hlf * 4 + 1] * de + xd * b.y;
        st[hlf * 4 + 2] = st[hlf * 4 + 2] * de + xd * b.z;
        st[hlf * 4 + 3] = st[hlf * 4 + 3] * de + xd * b.w;
        acc += st[hlf * 4 + 0] * c.x + st[hlf * 4 + 1] * c.y + st[hlf * 4 + 2] * c.z + st[hlf * 4 + 3] * c.w;
      }
      float y = sum16(acc);
      if ((lane & 15) == 0) O_[tt * 16 + rl] = y + dsk * xv;
    }
    __syncthreads();
    {
      u16* pz = p.PROJ + (m0 + stt) * LDP + C_Z + h * 64 + q * 16 + (tid & 15);
      float z = bf2f(*pz);
      *pz = f2bf(O_[stt * 16 + (tid & 15)] * siluf_(z));
    }
  }
  {
    float* o = p.out + (s < 8 ? O_PSSM + (((long)l * 8 + s) * 8 + h) * 8192
                              : O_SSSM + (((long)l * 8 + (s - 8)) * 8 + h) * 8192);
    *(float4*)(o + row * 128 + ksl) = make_float4(st[0], st[1], st[2], st[3]);
    *(float4*)(o + row * 128 + ksl + 4) = make_float4(st[4], st[5], st[6], st[7]);
  }
  if (h == 0 && q == 0) {
    float* o = p.out + (s < 8 ? O_PCONV + ((long)l * 8 + s) * 3072 : O_SCONV + ((long)l * 8 + (s - 8)) * 3072);
    for (int i = tid; i < 3072; i += 256) {
      int r = i >> 10, c = i & 1023;
      o[i] = bf2f(p.PROJ[(long)(base + T - 3 + r) * LDP + C_XBC + c]);
    }
  }
}

__device__ __forceinline__ void phase_scan(const Params& p, int l, float* smem) {
  for (int u = blockIdx.x; u < 1536; u += gridDim.x) {
    int sample = u >= 768;
    int v = sample ? u - 768 : u;
    int type = v % 3, w = v / 3;
    if (type == 0) {
      int q = w & 3, h = (w >> 2) & 7, b = w >> 5;
      scan_rwkv(p, l, b + 8 * sample, h, q, smem);
    } else if (type == 1) {
      int q = w & 7, h = (w >> 3) & 3, b = w >> 5;
      scan_hgrn(p, l, b + 8 * sample, h, q, smem);
    } else {
      int q = w & 3, h = (w >> 2) & 7, b = w >> 5;
      scan_ssd(p, l, b + 8 * sample, h, q, smem);
    }
  }
}

__device__ __forceinline__ void phase_post(const Params& p, int l, float* smem) {
  const int tid = opaque_tid(), lane = tid & 63, wid = tid >> 6;
  float* SG = smem;
  float* RED = smem + 2048;
  for (int blk = blockIdx.x; blk < NBLK16; blk += gridDim.x) {
    const long m0 = (long)blk * 16;
    __syncthreads();
    if (tid < 128) {
      const u16* col = p.PROJ + m0 * LDP + C_XG + tid;
#pragma unroll
      for (int t = 0; t < 16; ++t) SG[tid * 16 + t] = bf2f(col[(long)t * LDP]);
    }
    float ys[2][16], oh[2][16];
#pragma unroll
    for (int c = 0; c < 2; ++c) {
      int ch = tid + 256 * c;
#pragma unroll
      for (int t = 0; t < 16; ++t) {
        ys[c][t] = bf2f(p.PROJ[(m0 + t) * LDP + C_Z + ch]);
        oh[c][t] = bf2f(p.PROJ[(m0 + t) * LDP + C_I + ch]);
      }
    }
#pragma unroll
    for (int t = 0; t < 16; ++t) {
      float a0 = sum64(ys[0][t] * ys[0][t]), a1 = sum64(ys[1][t] * ys[1][t]);
      float b0 = sum64(oh[0][t] * oh[0][t]), b1 = sum64(oh[1][t] * oh[1][t]);
      if (lane == 0) *(float4*)(RED + (wid * 16 + t) * 4) = make_float4(a0, a1, b0, b1);
    }
    __syncthreads();
    {
      const float nw0 = p.ssd_norm_w[l * 512 + tid], nw1 = p.ssd_norm_w[l * 512 + tid + 256];
      const float hw0 = p.hg_norm_w[l * 512 + tid], hw1 = p.hg_norm_w[l * 512 + tid + 256];
      const int pw = (wid >> 1) * 2;
#pragma unroll
      for (int t = 0; t < 16; ++t) {
        float4 r0 = *(const float4*)(RED + (0 * 16 + t) * 4), r1 = *(const float4*)(RED + (1 * 16 + t) * 4);
        float4 r2 = *(const float4*)(RED + (2 * 16 + t) * 4), r3 = *(const float4*)(RED + (3 * 16 + t) * 4);
        float g0 = r0.x + r1.x + r2.x + r3.x, g1 = r0.y + r1.y + r2.y + r3.y;
        float4 pa = *(const float4*)(RED + (pw * 16 + t) * 4), pb = *(const float4*)(RED + ((pw + 1) * 16 + t) * 4);
        float h0 = pa.z + pb.z, h1 = pa.w + pb.w;
        u16* rowp = p.PROJ + (m0 + t) * LDP;
        rowp[C_Z + tid] = f2bf(ys[0][t] * rsqrtf(g0 * (1.f / 256.f) + 1e-6f) * nw0);
        rowp[C_Z + tid + 256] = f2bf(ys[1][t] * rsqrtf(g1 * (1.f / 256.f) + 1e-6f) * nw1);
        float gg0 = bf2f(rowp[C_GG + tid]), gg1 = bf2f(rowp[C_GG + tid + 256]);
        rowp[C_GG + tid] = f2bf(oh[0][t] * rsqrtf(h0 * (1.f / 128.f) + 1e-6f) * hw0 * siluf_(gg0));
        rowp[C_GG + tid + 256] = f2bf(oh[1][t] * rsqrtf(h1 * (1.f / 128.f) + 1e-6f) * hw1 * siluf_(gg1));
      }
    }
    float ga[2][16];
#pragma unroll
    for (int c = 0; c < 2; ++c)
#pragma unroll
      for (int t = 0; t < 16; ++t) ga[c][t] = 0.f;
    {
      const float* g2 = p.rw_g2 + (long)l * 128 * 512;
      for (int i = 0; i < 128; ++i) {
        float gv[2] = {g2[i * 512 + tid], g2[i * 512 + tid + 256]};
#pragma unroll
        for (int q = 0; q < 4; ++q) {
          float4 x = *(const float4*)(SG + i * 16 + q * 4);
#pragma unroll
          for (int c = 0; c < 2; ++c) {
            ga[c][q * 4 + 0] += x.x * gv[c]; ga[c][q * 4 + 1] += x.y * gv[c];
            ga[c][q * 4 + 2] += x.z * gv[c]; ga[c][q * 4 + 3] += x.w * gv[c];
          }
        }
      }
    }
#pragma unroll
    for (int c = 0; c < 2; ++c) {
      int ch = tid + 256 * c, head = wid + 4 * c;
      float lw = p.rw_lnx_w[l * 512 + ch], lbv = p.rw_lnx_b[l * 512 + ch];
#pragma unroll
      for (int t = 0; t < 16; ++t) {
        float o = bf2f(p.ORW[(m0 + t) * 512 + ch]);
        float mean = sum64(o) * (1.f / 64.f);
        float d = o - mean;
        float var = sum64(d * d) * (1.f / 64.f);
        float ln = d * rsqrtf(var + 64e-5f) * lw + lbv;
        float v = bf2f(p.PROJ[(m0 + t) * LDP + C_V + ch]);
        float bonus = p.RKS[(m0 + t) * 8 + head] * v;
        p.PROJ[(m0 + t) * LDP + C_R + ch] = f2bf((ln + bonus) * ga[c][t]);
      }
    }
  }
}

__device__ __forceinline__ void phase_final(const Params& p) {
  const int tid = opaque_tid(), lane = tid & 63, wid = tid >> 6;
  for (int m = blockIdx.x * 4 + wid; m < M_TOT; m += gridDim.x * 4) {
    float* dst;
    if (m < M_PROMPT) {
      int b = m / T_P, t = m - b * T_P;
      if (t < 16) continue;
      dst = p.out + O_YP + ((long)b * 4096 + (t - 16)) * DM;
    } else {
      dst = p.out + O_YS + (long)(m - M_PROMPT) * DM;
    }
    float x[16];
    float ss = 0.f;
#pragma unroll
    for (int j = 0; j < 2; ++j) {
      uint4 raw = *(const uint4*)(p.XB + (long)m * DM + lane * 8 + 512 * j);
      unsigned wv[4] = {raw.x, raw.y, raw.z, raw.w};
#pragma unroll
      for (int e = 0; e < 8; ++e) {
        x[j * 8 + e] = bf2f((u16)((wv[e >> 1] >> ((e & 1) * 16)) & 0xffff));
        ss += x[j * 8 + e] * x[j * 8 + e];
      }
    }
    ss = sum64(ss);
    float rs = rsqrtf(ss * (1.f / 1024.f) + 1e-6f);
#pragma unroll
    for (int j = 0; j < 2; ++j) {
      int k0 = lane * 8 + 512 * j;
      float4 w0 = *(const float4*)(p.final_w + k0), w1 = *(const float4*)(p.final_w + k0 + 4);
      *(float4*)(dst + k0) = make_float4(x[j * 8 + 0] * rs * w0.x, x[j * 8 + 1] * rs * w0.y, x[j * 8 + 2] * rs * w0.z,
                                         x[j * 8 + 3] * rs * w0.w);
      *(float4*)(dst + k0 + 4) = make_float4(x[j * 8 + 4] * rs * w1.x, x[j * 8 + 5] * rs * w1.y,
                                             x[j * 8 + 6] * rs * w1.z, x[j * 8 + 7] * rs * w1.w);
    }
  }
}

constexpr int SMEM_BYTES = 40960;
__device__ __forceinline__ void run_phase(const Params& p, int ph, char* smem) {
  if (ph == 0) { phase_embed(p); return; }
  if (ph == 19) { phase_final(p); return; }
  int l = (ph - 1) / 9, s = (ph - 1) % 9;
  float* fs = (float*)smem;
  switch (s) {
    case 0: phase_convert(p, l, fs); phase_rowstat<true>(p, l, fs); break;
    case 1: phase_gemm<1>(p, p.XB, DM, p.W1T, 1024, LDP / 128, smem); break;
    case 2: phase_pre(p, l, fs); break;
    case 3: phase_scan(p, l, fs); break;
    case 4: phase_post(p, l, fs); break;
    case 5: phase_gemm<2>(p, p.PROJ, LDP, p.WOT, 1536, 8, smem); break;
    case 6: phase_rowstat<false>(p, l, fs); break;
    case 7: phase_gemm<3>(p, p.XB, DM, p.WGU, 1024, 44, smem); break;
    case 8: phase_gemm<2>(p, p.PROJ, D_FF, p.WDT, D_FF, 8, smem); break;
  }
}
constexpr int N_PHASES = 20;

#if MEGA
__global__ void __launch_bounds__(256, 3) k_mega(Params pin) {
  __shared__ __attribute__((aligned(16))) char smem[SMEM_BYTES];
  __shared__ Params sp;
  if (threadIdx.x == 0) sp = pin;
  __syncthreads();
  const Params& p = sp;
  cg::grid_group grid = cg::this_grid();
  float* fs = (float*)smem;
  phase_embed(p);
  grid.sync();
#pragma unroll 1
  for (int l = 0; l < 2; ++l) {
    phase_convert(p, l, fs);
    phase_rowstat<true>(p, l, fs);
    grid.sync();
    phase_gemm<1>(p, p.XB, DM, p.W1T, 1024, LDP / 128, smem);
    grid.sync();
    phase_pre(p, l, fs);
    grid.sync();
    phase_scan(p, l, fs);
    grid.sync();
    phase_post(p, l, fs);
    grid.sync();
    phase_gemm<2>(p, p.PROJ, LDP, p.WOT, 1536, 8, smem);
    grid.sync();
    phase_rowstat<false>(p, l, fs);
    grid.sync();
    phase_gemm<3>(p, p.XB, DM, p.WGU, 1024, 44, smem);
    grid.sync();
    phase_gemm<2>(p, p.PROJ, D_FF, p.WDT, D_FF, 8, smem);
    grid.sync();
  }
  phase_final(p);
}
#else
template <int PH>
__global__ void __launch_bounds__(256, 3) k_phase(Params p) {
  __shared__ __attribute__((aligned(16))) char smem[SMEM_BYTES];
  run_phase(p, PH, smem);
}
template <int PH>
static void launch_all(const Params& p, int grid, hipStream_t stream) {
  hipLaunchKernelGGL(k_phase<PH>, dim3(grid), dim3(256), 0, stream, p);
  if constexpr (PH + 1 < N_PHASES) launch_all<PH + 1>(p, grid, stream);
}
#endif

extern "C" void kernel_launch(void* const* d_in, const int* in_sizes, int n_in, void* d_out, int out_size, void* d_ws,
                              size_t ws_size, hipStream_t stream) {
  Params p{};
  const float** pf = (const float**)&p;
  for (int i = 0; i < 35; ++i) pf[i] = (const float*)d_in[i];
  p.out = (float*)d_out;
  char* ws = (char*)d_ws;
  size_t off = 0;
  auto take = [&](size_t bytes) { char* r = ws + off; off += (bytes + 255) & ~(size_t)255; return r; };
  p.XB = (u16*)take((size_t)M_TOT * DM * 2);
  p.PROJ = (u16*)take((size_t)M_TOT * LDP * 2);
  p.W1T = (u16*)take((size_t)LDP * 1024 * 2);
  p.WOT = (u16*)take((size_t)1024 * 1536 * 2);
  p.WGU = (u16*)take((size_t)5632 * 1024 * 2);
  p.WDT = (u16*)take((size_t)1024 * D_FF * 2);
  p.BND = (u16*)take((size_t)NBLK16 * 1792 * 2);
  p.ORW = (u16*)take((size_t)M_TOT * 512 * 2);
  p.RS = (float*)take((size_t)M_TOT * 4);
  p.DTRAW = (float*)take((size_t)M_TOT * 8 * 4);
  p.RKS = (float*)take((size_t)M_TOT * 8 * 4);
  p.RWX = (u16*)d_out;
  if (off > ws_size) fprintf(stderr, "workspace too small: need %zu have %zu\n", off, ws_size);
#if MEGA
  static int grid_blocks = 0;
  if (!grid_blocks) {
    int dev = 0, cus = 0, per_cu = 0;
    hipGetDevice(&dev);
    hipDeviceGetAttribute(&cus, hipDeviceAttributeMultiprocessorCount, dev);
    hipOccupancyMaxActiveBlocksPerMultiprocessor(&per_cu, k_mega, 256, 0);
    if (per_cu > 3) per_cu = 3;
    grid_blocks = cus * per_cu;
  }
  void* args[] = {&p};
  hipError_t e = hipLaunchCooperativeKernel((void*)k_mega, dim3(grid_blocks), dim3(256), args, 0, stream);
  if (e != hipSuccess) fprintf(stderr, "cooperative launch failed: %s (grid %d)\n", hipGetErrorString(e), grid_blocks);
#else
  launch_all<0>(p, 768, stream);
#endif
}
```

```cpp
#include <hip/hip_runtime.h>
#include <hip/hip_bf16.h>
#include <hip/hip_cooperative_groups.h>
#include <cstdio>
namespace cg = cooperative_groups;

#ifndef MEGA
#define MEGA 1
#endif

typedef unsigned short u16;
using bf16x8 = __attribute__((ext_vector_type(8))) short;
using f32x16 = __attribute__((ext_vector_type(16))) float;

constexpr int DM = 1024;
constexpr int M_TOT = 33408;
constexpr int M_PROMPT = 32896;
constexpr int T_P = 4112;
constexpr int LDP = 5376;
constexpr int N_IN = 5384;
constexpr int D_FF = 2816;
constexpr int NBLK16 = M_TOT / 16;
constexpr int C_Z = 0, C_R = 512, C_GG = 1024, C_XBC = 1536, C_K = 2560, C_V = 3072, C_XW = 3584, C_XA = 3648,
              C_XG = 3712, C_Q = 3840, C_F = 4352, C_I = 4864;
constexpr long O_YP = 0, O_YS = 33554432, O_PSSM = 34078720, O_PCONV = 35127296, O_PRWKV = 35176448,
               O_PSHIFT = 35700736, O_PHGRN = 35729408, O_SSSM = 36777984, O_SCONV = 37826560,
               O_SRWKV = 37875712, O_SSHIFT = 38400000, O_SHGRN = 38428672;

struct Params {
  const float *x_prompt, *x_sample, *state_ssm, *state_conv, *state_rwkv, *state_shift, *state_hgrn, *meta,
      *norm1_w, *w_in, *conv_w, *conv_b, *dt_bias, *a_log, *d_skip, *ssd_norm_w, *rw_mu, *rw_w0, *rw_w2, *rw_a0,
      *rw_a2, *rw_g2, *rw_kk, *rw_ka, *rw_rk, *rw_lnx_w, *rw_lnx_b, *hg_lb, *hg_norm_w, *w_out, *norm2_w, *w_gate,
      *w_up, *w_down, *final_w;
  float* out;
  u16 *XB, *PROJ, *W1T, *WOT, *WGU, *WDT, *BND, *ORW, *RWX;
  float *RS, *DTRAW, *RKS;
  unsigned* bar;
};

__device__ __forceinline__ u16 f2bf(float f) {
  unsigned u = __float_as_uint(f);
  u += 0x7fffu + ((u >> 16) & 1u);
  return (u16)(u >> 16);
}
__device__ __forceinline__ float bf2f(u16 h) { return __uint_as_float(((unsigned)h) << 16); }
__device__ __forceinline__ float sigmoidf_(float x) { return 1.f / (1.f + __expf(-x)); }
__device__ __forceinline__ float siluf_(float x) { return x / (1.f + __expf(-x)); }
__device__ __forceinline__ float softplusf_(float x) { return x > 20.f ? x : log1pf(__expf(x)); }

template <int CTRL>
__device__ __forceinline__ float dppf(float v) {
  return __int_as_float(__builtin_amdgcn_update_dpp(0, __float_as_int(v), CTRL, 0xF, 0xF, true));
}
__device__ __forceinline__ float sum16(float v) {
  v += dppf<0xB1>(v);
  v += dppf<0x4E>(v);
  v += dppf<0x141>(v);
  v += dppf<0x140>(v);
  return v;
}
__device__ __forceinline__ float sum64(float v) {
  v = sum16(v);
  v += __shfl_xor(v, 16);
  v += __shfl_xor(v, 32);
  return v;
}

__device__ __forceinline__ int opaque_tid() {
  int t = threadIdx.x;
  asm volatile("" : "+v"(t));
  return t;
}
__device__ __forceinline__ int opaque_s(int v) {
  asm volatile("" : "+s"(v));
  return v;
}
#define BID opaque_s((int)blockIdx.x)
#define NBLK opaque_s((int)gridDim.x)
__device__ __forceinline__ int seq_base(int s) { return s < 8 ? s * T_P : M_PROMPT + (s - 8) * 64; }
__device__ __forceinline__ int seq_len(int s) { return s < 8 ? T_P : 64; }

__device__ __forceinline__ void phase_embed(const Params& p) {
  const long n4 = (long)M_TOT * 256;
  for (long idx = (long)BID * 256 + threadIdx.x, st_ = (long)NBLK * 256; idx < n4; idx += st_) {
    int m = (int)(idx >> 8), c4 = ((int)idx & 255) * 4;
    const float* src;
    if (m < M_PROMPT) {
      int b = m / T_P, t = m - b * T_P;
      src = (t < 16) ? p.meta + (long)t * DM : p.x_prompt + ((long)b * 4096 + (t - 16)) * DM;
    } else {
      src = p.x_sample + (long)(m - M_PROMPT) * DM;
    }
    float4 v = *(const float4*)(src + c4);
    ushort4 o;
    o.x = f2bf(v.x); o.y = f2bf(v.y); o.z = f2bf(v.z); o.w = f2bf(v.w);
    *(ushort4*)(p.XB + (long)m * DM + c4) = o;
  }
}

__device__ __forceinline__ void conv_tile(const float* __restrict__ src, int ldsrc, int srccol0, const float* __restrict__ scale,
                          u16* __restrict__ dst, int K, int k0, int n0, float* tile  ) {
  const int tid = opaque_tid();
  __syncthreads();
  {
    int nn = tid & 63, kb = tid >> 6;
#pragma unroll
    for (int i = 0; i < 16; ++i) {
      int kk = kb + 4 * i;
      float v = src[(long)(k0 + kk) * ldsrc + srccol0 + nn];
      if (scale) v *= scale[k0 + kk];
      tile[kk * 65 + nn] = v;
    }
  }
  __syncthreads();
  {
    int nn = tid >> 2, kq = (tid & 3) * 16;
    u16* d = dst + (long)(n0 + nn) * K + k0 + kq;
#pragma unroll
    for (int j = 0; j < 16; j += 2) {
      unsigned w = f2bf(tile[(kq + j) * 65 + nn]) | ((unsigned)f2bf(tile[(kq + j + 1) * 65 + nn]) << 16);
      *(unsigned*)(d + j) = w;
    }
  }
}

__device__ __forceinline__ int w1_srccol(int n0) {
  if (n0 < 512) return n0;
  if (n0 < 1024) return n0 - 512 + 1544;
  if (n0 < 1536) return n0 - 1024 + 4872;
  if (n0 < 2560) return n0 - 1536 + 512;
  if (n0 < 3840) return n0 - 2560 + 2056;
  return n0 - 3840 + 3336;
}

constexpr int CV_W1 = 16 * 84, CV_WO = 24 * 16, CV_WGU = 16 * 88, CV_WD = 44 * 16;
constexpr int CV_TOTAL = CV_W1 + CV_WO + CV_WGU + CV_WD;

__device__ __forceinline__ void phase_convert(const Params& p, int l, float* smem) {
  for (int u = BID, nb_ = NBLK; u < CV_TOTAL; u += nb_) {
    if (u < CV_W1) {
      int kt = u % 16, nt = u / 16;
      conv_tile(p.w_in + (long)l * DM * N_IN, N_IN, w1_srccol(nt * 64), p.norm1_w + l * DM, p.W1T, 1024, kt * 64,
                nt * 64, smem);
    } else if (u < CV_W1 + CV_WO) {
      int v = u - CV_W1;
      int kt = v % 24, nt = v / 24;
      conv_tile(p.w_out + (long)l * 1536 * DM, DM, nt * 64, nullptr, p.WOT, 1536, kt * 64, nt * 64, smem);
    } else if (u < CV_W1 + CV_WO + CV_WGU) {
      int v = u - CV_W1 - CV_WO;
      int kt = v % 16, nt = v / 16;
      const float* wg = p.w_gate + (long)l * DM * D_FF;
      const float* wu = p.w_up + (long)l * DM * D_FF;
      const float* sc = p.norm2_w + l * DM;
      const int tid = opaque_tid();
      __syncthreads();
      {
        int nn = tid & 63, kb = tid >> 6;
        const float* src = (nn < 32) ? wg : wu;
        int col = nt * 32 + (nn & 31);
#pragma unroll
        for (int i = 0; i < 16; ++i) {
          int kk = kb + 4 * i;
          smem[kk * 65 + nn] = src[(long)(kt * 64 + kk) * D_FF + col] * sc[kt * 64 + kk];
        }
      }
      __syncthreads();
      {
        int nn = tid >> 2, kq = (tid & 3) * 16;
        u16* d = p.WGU + (long)(nt * 64 + nn) * 1024 + kt * 64 + kq;
#pragma unroll
        for (int j = 0; j < 16; j += 2) {
          unsigned w = f2bf(smem[(kq + j) * 65 + nn]) | ((unsigned)f2bf(smem[(kq + j + 1) * 65 + nn]) << 16);
          *(unsigned*)(d + j) = w;
        }
      }
    } else {
      int v = u - CV_W1 - CV_WO - CV_WGU;
      int kt = v % 44, nt = v / 44;
      conv_tile(p.w_down + (long)l * D_FF * DM, DM, nt * 64, nullptr, p.WDT, D_FF, kt * 64, nt * 64, smem);
    }
  }
}

template <bool WITH_DT>
__device__ __forceinline__ void phase_rowstat(const Params& p, int l, float* smem) {
  const int tid = opaque_tid(), lane = tid & 63, wid = tid >> 6;
  float* dtw = smem;
  if (WITH_DT) {
    __syncthreads();
    const float* w = p.w_in + (long)l * DM * N_IN + 1536;
    const float* nw = p.norm1_w + l * DM;
    for (int i = tid; i < 8192; i += 256) {
      int k = i >> 3, h = i & 7;
      dtw[i] = w[(long)k * N_IN + h] * nw[k];
    }
    __syncthreads();
  }
  for (int blk = BID, nb_ = NBLK; blk < NBLK16; blk += nb_) {
    for (int rr = wid; rr < 16; rr += 4) {
      int m = blk * 16 + rr;
      float ss = 0.f;
      float d[8];
#pragma unroll
      for (int h = 0; h < 8; ++h) d[h] = 0.f;
#pragma unroll 1
      for (int j = 0; j < 4; ++j) {
        int k0 = lane * 4 + 256 * j;
        uint2 raw = *(const uint2*)(p.XB + (long)m * DM + k0);
        float xs[4] = {bf2f((u16)(raw.x & 0xffff)), bf2f((u16)(raw.x >> 16)), bf2f((u16)(raw.y & 0xffff)),
                       bf2f((u16)(raw.y >> 16))};
#pragma unroll
        for (int e = 0; e < 4; ++e) {
          float x = xs[e];
          ss += x * x;
          if (WITH_DT) {
            float4 w0 = *(const float4*)(dtw + (k0 + e) * 8);
            float4 w1 = *(const float4*)(dtw + (k0 + e) * 8 + 4);
            d[0] += x * w0.x; d[1] += x * w0.y; d[2] += x * w0.z; d[3] += x * w0.w;
            d[4] += x * w1.x; d[5] += x * w1.y; d[6] += x * w1.z; d[7] += x * w1.w;
          }
        }
      }
      ss = sum64(ss);
      float rs = rsqrtf(ss * (1.f / 1024.f) + 1e-6f);
      if (WITH_DT) {
#pragma unroll
        for (int h = 0; h < 8; ++h) d[h] = sum64(d[h]);
        if (lane == 0) {
#pragma unroll
          for (int h = 0; h < 8; ++h) p.DTRAW[(long)m * 8 + h] = d[h] * rs;
        }
      }
      if (lane == 0) p.RS[m] = rs;
    }
  }
}

constexpr int G_BK = 32, G_LDS_ROW = 80;
constexpr int G_OPER_BYTES = 128 * G_LDS_ROW;
template <int MODE>
__device__ __forceinline__ void phase_gemm(const Params& p, const u16* __restrict__ A, int lda, const u16* __restrict__ Bt, int K,
                           int nN, char* smem) {
  const int tid = opaque_tid(), lane = tid & 63, wid = tid >> 6, wm = wid >> 1, wn = wid & 1;
  const int nM = M_TOT / 128;
  const int ntiles = nM * nN;
  const int nk = K / G_BK;
  const int lrow = tid >> 2, lkc = tid & 3;
  for (int tile = BID, nb_ = NBLK; tile < ntiles; tile += nb_) {
    int grp = tile / (8 * nN);
    int first_m = grp * 8;
    int gsz = min(8, nM - first_m);
    int rem = tile - grp * 8 * nN;
    int pm = first_m + rem % gsz, pn = rem / gsz;
    const u16* gA = A + (long)(pm * 128 + lrow) * lda + lkc * 8;
    const u16* gB = Bt + (long)(pn * 128 + lrow) * K + lkc * 8;
    f32x16 acc[2][2];
#pragma unroll
    for (int i = 0; i < 2; ++i)
#pragma unroll
      for (int j = 0; j < 2; ++j)
#pragma unroll
        for (int r = 0; r < 16; ++r) acc[i][j][r] = 0.f;
    uint4 ra0, ra1, rb0, rb1;
    ra0 = *(const uint4*)(gA);
    ra1 = *(const uint4*)(gA + (long)64 * lda);
    rb0 = *(const uint4*)(gB);
    rb1 = *(const uint4*)(gB + (long)64 * K);
    __syncthreads();
    {
      char* sA = smem;
      char* sB = smem + G_OPER_BYTES;
      *(uint4*)(sA + lrow * G_LDS_ROW + lkc * 16) = ra0;
      *(uint4*)(sA + (lrow + 64) * G_LDS_ROW + lkc * 16) = ra1;
      *(uint4*)(sB + lrow * G_LDS_ROW + lkc * 16) = rb0;
      *(uint4*)(sB + (lrow + 64) * G_LDS_ROW + lkc * 16) = rb1;
    }
    __syncthreads();
    for (int kt = 0; kt < nk; ++kt) {
      const int cur = kt & 1;
      if (kt + 1 < nk) {
        ra0 = *(const uint4*)(gA + (kt + 1) * G_BK);
        ra1 = *(const uint4*)(gA + (long)64 * lda + (kt + 1) * G_BK);
        rb0 = *(const uint4*)(gB + (kt + 1) * G_BK);
        rb1 = *(const uint4*)(gB + (long)64 * K + (kt + 1) * G_BK);
      }
      __builtin_amdgcn_sched_barrier(0);
      const char* sA = smem + cur * 2 * G_OPER_BYTES;
      const char* sB = sA + G_OPER_BYTES;
#pragma unroll
      for (int ks = 0; ks < 2; ++ks) {
        bf16x8 af[2], bfr[2];
        const int koff = (ks * 16 + (lane >> 5) * 8) * 2;
#pragma unroll
        for (int i = 0; i < 2; ++i)
          af[i] = *(const bf16x8*)(sA + (wm * 64 + i * 32 + (lane & 31)) * G_LDS_ROW + koff);
#pragma unroll
        for (int j = 0; j < 2; ++j)
          bfr[j] = *(const bf16x8*)(sB + (wn * 64 + j * 32 + (lane & 31)) * G_LDS_ROW + koff);
#pragma unroll
        for (int i = 0; i < 2; ++i)
#pragma unroll
          for (int j = 0; j < 2; ++j)
            acc[i][j] = __builtin_amdgcn_mfma_f32_32x32x16_bf16(af[i], bfr[j], acc[i][j], 0, 0, 0);
      }
      if (kt + 1 < nk) {
        char* dA = smem + (cur ^ 1) * 2 * G_OPER_BYTES;
        char* dB = dA + G_OPER_BYTES;
        *(uint4*)(dA + lrow * G_LDS_ROW + lkc * 16) = ra0;
        *(uint4*)(dA + (lrow + 64) * G_LDS_ROW + lkc * 16) = ra1;
        *(uint4*)(dB + lrow * G_LDS_ROW + lkc * 16) = rb0;
        *(uint4*)(dB + (lrow + 64) * G_LDS_ROW + lkc * 16) = rb1;
      }
      __syncthreads();
    }
    const int colb = pn * 128 + wn * 64 + (lane & 31);
    const int rowb = pm * 128 + wm * 64 + 4 * (lane >> 5);
    if (MODE == 1) {
#pragma unroll
      for (int i = 0; i < 2; ++i)
#pragma unroll
        for (int r = 0; r < 16; ++r) {
          int row = rowb + i * 32 + (r & 3) + 8 * (r >> 2);
          float rs = p.RS[row];
#pragma unroll
          for (int j = 0; j < 2; ++j) {
            int col = colb + j * 32;
            u16 v = f2bf(acc[i][j][r] * rs);
            p.PROJ[(long)row * LDP + col] = v;
            if ((row & 15) == 15) {
              int jj = -1;
              if (col >= C_R && col < C_GG) jj = col - C_R;
              else if (col >= C_K && col < C_Q) jj = col - C_K + 512;
              if (jj >= 0) p.BND[(long)(row >> 4) * 1792 + jj] = v;
            }
          }
        }
    } else if (MODE == 2) {
#pragma unroll
      for (int i = 0; i < 2; ++i)
#pragma unroll
        for (int r = 0; r < 16; ++r) {
          int row = rowb + i * 32 + (r & 3) + 8 * (r >> 2);
#pragma unroll
          for (int j = 0; j < 2; ++j) {
            int col = colb + j * 32;
            u16* px = p.XB + (long)row * DM + col;
            *px = f2bf(bf2f(*px) + acc[i][j][r]);
          }
        }
    } else {
      const int cact = pn * 64 + wn * 32 + (lane & 31);
      u16* ACT = p.PROJ;
#pragma unroll
      for (int i = 0; i < 2; ++i)
#pragma unroll
        for (int r = 0; r < 16; ++r) {
          int row = rowb + i * 32 + (r & 3) + 8 * (r >> 2);
          float rs = p.RS[row];
          float g = acc[i][0][r] * rs, u = acc[i][1][r] * rs;
          ACT[(long)row * D_FF + cact] = f2bf(siluf_(g) * u);
        }
    }
  }
}

__device__ __forceinline__ void phase_pre(const Params& p, int l, float* smem) {
  const int tid = opaque_tid(), lane = tid & 63, wid = tid >> 6;
  float* XW = smem;
  float* XA = smem + 1024;
  const float* mu = p.rw_mu + l * 1792;
  for (int blk = BID, nb_ = NBLK; blk < NBLK16; blk += nb_) {
    const int m0 = blk * 16;
    int s, t0;
    if (m0 < M_PROMPT) { s = m0 / T_P; t0 = m0 - s * T_P; } else { s = 8 + (m0 - M_PROMPT) / 64; t0 = (m0 - M_PROMPT) & 63; }
    const bool first = (t0 == 0);
    auto prev_of = [&](int j) -> float {
      if (!first) return bf2f(p.BND[(long)(blk - 1) * 1792 + j]);
      if (s < 8) return 0.f;
      return p.state_shift[((long)l * 8 + (s - 8)) * 1792 + j];
    };
    __syncthreads();
    {
      int j = 1536 + tid;
      float mj = mu[j];
      float pv = prev_of(j);
      u16* col = p.PROJ + (long)m0 * LDP + C_XW + tid;
#pragma unroll
      for (int t = 0; t < 16; ++t) {
        float x = bf2f(col[(long)t * LDP]);
        float sh = x + (pv - x) * mj;
        pv = x;
        if (tid < 64) XW[tid * 16 + t] = tanhf(sh);
        else if (tid < 128) XA[(tid - 64) * 16 + t] = sh;
        else col[(long)t * LDP] = f2bf(sigmoidf_(sh));
      }
    }
    __syncthreads();
#pragma unroll 1
    for (int c = 0; c < 2; ++c) {
      const int ch = tid + 256 * c;
      const int head = wid + 4 * c;
      float aw[16], aa[16];
#pragma unroll
      for (int t = 0; t < 16; ++t) { aw[t] = 0.f; aa[t] = 0.f; }
      {
        const float* w2 = p.rw_w2 + (long)l * 64 * 512 + ch;
        const float* a2 = p.rw_a2 + (long)l * 64 * 512 + ch;
#pragma unroll 2
        for (int i = 0; i < 64; ++i) {
          float w2v = w2[i * 512];
          float a2v = a2[i * 512];
#pragma unroll
          for (int q = 0; q < 4; ++q) {
            float4 xw = *(const float4*)(XW + i * 16 + q * 4);
            float4 xa = *(const float4*)(XA + i * 16 + q * 4);
            aw[q * 4 + 0] += xw.x * w2v; aw[q * 4 + 1] += xw.y * w2v;
            aw[q * 4 + 2] += xw.z * w2v; aw[q * 4 + 3] += xw.w * w2v;
            aa[q * 4 + 0] += xa.x * a2v; aa[q * 4 + 1] += xa.y * a2v;
            aa[q * 4 + 2] += xa.z * a2v; aa[q * 4 + 3] += xa.w * a2v;
          }
        }
      }
      {
        float w0 = p.rw_w0[l * 512 + ch], a0 = p.rw_a0[l * 512 + ch];
#pragma unroll
        for (int t = 0; t < 16; ++t) {
          float lw = -softplusf_(-(w0 + aw[t])) - 0.5f;
          float u = -__expf(lw);
          p.RWX[(long)(m0 + t) * 1536 + ch] = f2bf(u);
          aa[t] = sigmoidf_(a0 + aa[t]);
        }
      }
      float rt[16];
      {
        float mj = mu[ch];
        float pv = prev_of(ch);
        u16* col = p.PROJ + (long)m0 * LDP + C_R + ch;
#pragma unroll
        for (int t = 0; t < 16; ++t) {
          float x = bf2f(col[(long)t * LDP]);
          rt[t] = x + (pv - x) * mj;
          pv = x;
        }
#pragma unroll
        for (int t = 0; t < 16; ++t) col[(long)t * LDP] = f2bf(rt[t]);
      }
      {
        float mj = mu[512 + ch];
        float pv = prev_of(512 + ch);
        float kkw = p.rw_kk[l * 512 + ch], kaw = p.rw_ka[l * 512 + ch], rkw = p.rw_rk[l * 512 + ch];
        u16* col = p.PROJ + (long)m0 * LDP + C_K + ch;
        float kt[16];
#pragma unroll
        for (int t = 0; t < 16; ++t) {
          float x = bf2f(col[(long)t * LDP]);
          kt[t] = x + (pv - x) * mj;
          pv = x;
        }
#pragma unroll
        for (int t = 0; t < 16; ++t) {
          float kkv = kt[t] * kkw;
          float ssq = sum64(kkv * kkv);
          float kk = kkv * rsqrtf(ssq + 1e-12f);
          float a = aa[t];
          float kp = kt[t] * (1.f + (a - 1.f) * kaw);
          float rks = sum64(rt[t] * kp * rkw);
          col[(long)t * LDP] = f2bf(kp);
          p.RWX[(long)(m0 + t) * 1536 + 512 + ch] = f2bf(kk);
          p.RWX[(long)(m0 + t) * 1536 + 1024 + ch] = f2bf(kk * a);
          if (lane == 0) p.RKS[(long)(m0 + t) * 8 + head] = rks;
        }
      }
      {
        float mj = mu[1024 + ch];
        float pv = prev_of(1024 + ch);
        u16* col = p.PROJ + (long)m0 * LDP + C_V + ch;
        float vt[16];
#pragma unroll
        for (int t = 0; t < 16; ++t) {
          float x = bf2f(col[(long)t * LDP]);
          vt[t] = x + (pv - x) * mj;
          pv = x;
        }
#pragma unroll
        for (int t = 0; t < 16; ++t) col[(long)t * LDP] = f2bf(vt[t]);
      }
    }
    if (t0 + 16 == seq_len(s)) {
      float* o = p.out + (s < 8 ? O_PSHIFT + ((long)l * 8 + s) * 1792 : O_SSHIFT + ((long)l * 8 + (s - 8)) * 1792);
      for (int j = tid; j < 1792; j += 256) o[j] = bf2f(p.BND[(long)blk * 1792 + j]);
    }
  }
}

__device__ __forceinline__ void scan_rwkv(const Params& p, int l, int s, int h, int q, float* smem) {
  const int tid = opaque_tid(), lane = tid & 63, wid = tid >> 6;
  float* R_ = smem;
  float* W_ = smem + 1024;
  float* K_ = smem + 2048;
  float* A_ = smem + 3072;
  float* B_ = smem + 4096;
  float* V_ = smem + 5120;
  float* O_ = smem + 5376;
  const int rl = wid * 4 + (lane >> 4);
  const int row = q * 16 + rl;
  const int ksl = (lane & 15) * 4;
  const int base = seq_base(s), T = seq_len(s);
  float s0 = 0.f, s1 = 0.f, s2 = 0.f, s3 = 0.f;
  if (s >= 8) {
    const float* st = p.state_rwkv + (((long)l * 8 + (s - 8)) * 8 + h) * 4096 + row * 64 + ksl;
    float4 v = *(const float4*)st;
    s0 = v.x; s1 = v.y; s2 = v.z; s3 = v.w;
  }
  const int stt = tid >> 4, skq = (tid & 15) * 4;
  const int nblk = T / 16;
  ushort4 r4, k4, u4, a4, b4;
  u16 vv;
  {
    const long m = base + stt;
    const u16* pr = p.PROJ + m * LDP;
    const u16* px = p.RWX + m * 1536;
    r4 = *(const ushort4*)(pr + C_R + h * 64 + skq);
    k4 = *(const ushort4*)(pr + C_K + h * 64 + skq);
    u4 = *(const ushort4*)(px + h * 64 + skq);
    a4 = *(const ushort4*)(px + 512 + h * 64 + skq);
    b4 = *(const ushort4*)(px + 1024 + h * 64 + skq);
    vv = pr[C_V + h * 64 + q * 16 + (tid & 15)];
  }
  __syncthreads();
  for (int blk = 0; blk < nblk; ++blk) {
    const long m = base + blk * 16 + stt;
    {
      *(float4*)(R_ + stt * 64 + skq) = make_float4(bf2f(r4.x), bf2f(r4.y), bf2f(r4.z), bf2f(r4.w));
      *(float4*)(K_ + stt * 64 + skq) = make_float4(bf2f(k4.x), bf2f(k4.y), bf2f(k4.z), bf2f(k4.w));
      *(float4*)(W_ + stt * 64 + skq) =
          make_float4(__expf(bf2f(u4.x)), __expf(bf2f(u4.y)), __expf(bf2f(u4.z)), __expf(bf2f(u4.w)));
      *(float4*)(A_ + stt * 64 + skq) = make_float4(-bf2f(a4.x), -bf2f(a4.y), -bf2f(a4.z), -bf2f(a4.w));
      *(float4*)(B_ + stt * 64 + skq) = make_float4(bf2f(b4.x), bf2f(b4.y), bf2f(b4.z), bf2f(b4.w));
      V_[stt * 16 + (tid & 15)] = bf2f(vv);
    }
    __syncthreads();
    if (blk + 1 < nblk) {
      const u16* pr = p.PROJ + (m + 16) * LDP;
      const u16* px = p.RWX + (m + 16) * 1536;
      r4 = *(const ushort4*)(pr + C_R + h * 64 + skq);
      k4 = *(const ushort4*)(pr + C_K + h * 64 + skq);
      u4 = *(const ushort4*)(px + h * 64 + skq);
      a4 = *(const ushort4*)(px + 512 + h * 64 + skq);
      b4 = *(const ushort4*)(px + 1024 + h * 64 + skq);
      vv = pr[C_V + h * 64 + q * 16 + (tid & 15)];
    }
    __builtin_amdgcn_sched_barrier(0);
#pragma unroll 4
    for (int tt = 0; tt < 16; ++tt) {
      float4 a = *(const float4*)(A_ + tt * 64 + ksl);
      float4 w = *(const float4*)(W_ + tt * 64 + ksl);
      float4 b = *(const float4*)(B_ + tt * 64 + ksl);
      float4 k = *(const float4*)(K_ + tt * 64 + ksl);
      float4 r = *(const float4*)(R_ + tt * 64 + ksl);
      float v = V_[tt * 16 + rl];
      float sa = sum16(s0 * a.x + s1 * a.y + s2 * a.z + s3 * a.w);
      s0 = s0 * w.x + sa * b.x + v * k.x;
      s1 = s1 * w.y + sa * b.y + v * k.y;
      s2 = s2 * w.z + sa * b.z + v * k.z;
      s3 = s3 * w.w + sa * b.w + v * k.w;
      float o = sum16(s0 * r.x + s1 * r.y + s2 * r.z + s3 * r.w);
      if ((lane & 15) == 0) O_[tt * 16 + rl] = o;
    }
    __builtin_amdgcn_sched_barrier(0);
    __syncthreads();
    p.ORW[m * 512 + h * 64 + q * 16 + (tid & 15)] = f2bf(O_[stt * 16 + (tid & 15)]);
  }
  __syncthreads();
  {
    float* o = p.out + (s < 8 ? O_PRWKV + (((long)l * 8 + s) * 8 + h) * 4096
                              : O_SRWKV + (((long)l * 8 + (s - 8)) * 8 + h) * 4096);
    *(float4*)(o + row * 64 + ksl) = make_float4(s0, s1, s2, s3);
  }
}

__device__ __forceinline__ void scan_hgrn(const Params& p, int l, int s, int h, int q, float* smem) {
  const int tid = opaque_tid(), lane = tid & 63, wid = tid >> 6;
  float* Q_ = smem;
  float* F_ = smem + 2048;
  float* G_ = smem + 4096;
  float* I_ = smem + 6144;
  float* O_ = smem + 6400;
  const int rl = wid * 4 + (lane >> 4);
  const int row = q * 16 + rl;
  const int ksl = (lane & 15) * 8;
  const int base = seq_base(s), T = seq_len(s);
  float st[8];
#pragma unroll
  for (int i = 0; i < 8; ++i) st[i] = 0.f;
  if (s >= 8) {
    const float* sp = p.state_hgrn + (((long)l * 8 + (s - 8)) * 4 + h) * 16384;
#pragma unroll
    for (int i = 0; i < 8; ++i) st[i] = sp[(ksl + i) * 128 + row];
  }
  const int stt = tid >> 4, skq = (tid & 15) * 8;
  float lb[8];
#pragma unroll
  for (int i = 0; i < 8; ++i) {
    if (l == 0) lb[i] = 0.f;
    else {
      float x0 = p.hg_lb[h * 128 + skq + i], x1 = p.hg_lb[512 + h * 128 + skq + i];
      lb[i] = 1.f / (1.f + __expf(x0 - x1));
    }
  }
  const int nblk = T / 16;
  uint4 q8, f8;
  u16 iv16;
  {
    const u16* pr = p.PROJ + (long)(base + stt) * LDP;
    q8 = *(const uint4*)(pr + C_Q + h * 128 + skq);
    f8 = *(const uint4*)(pr + C_F + h * 128 + skq);
    iv16 = pr[C_I + h * 128 + q * 16 + (tid & 15)];
  }
  __syncthreads();
  for (int blk = 0; blk < nblk; ++blk) {
    const long m = base + blk * 16 + stt;
    {
      unsigned qw[4] = {q8.x, q8.y, q8.z, q8.w}, fw[4] = {f8.x, f8.y, f8.z, f8.w};
#pragma unroll
      for (int e = 0; e < 8; ++e) {
        float qv = bf2f((u16)((qw[e >> 1] >> ((e & 1) * 16)) & 0xffff));
        float fz = bf2f((u16)((fw[e >> 1] >> ((e & 1) * 16)) & 0xffff));
        float ex = __expf(-fz);
        float sg = 1.f / (1.f + ex);
        float sgn = ex * sg;
        Q_[stt * 128 + skq + e] = qv;
        F_[stt * 128 + skq + e] = lb[e] + (1.f - lb[e]) * sg;
        G_[stt * 128 + skq + e] = (1.f - lb[e]) * sgn;
      }
      I_[stt * 16 + (tid & 15)] = bf2f(iv16);
    }
    __syncthreads();
    if (blk + 1 < nblk) {
      const u16* pr = p.PROJ + (m + 16) * LDP;
      q8 = *(const uint4*)(pr + C_Q + h * 128 + skq);
      f8 = *(const uint4*)(pr + C_F + h * 128 + skq);
      iv16 = pr[C_I + h * 128 + q * 16 + (tid & 15)];
    }
    __builtin_amdgcn_sched_barrier(0);
#pragma unroll 2
    for (int tt = 0; tt < 16; ++tt) {
      float iv = I_[tt * 16 + rl];
      float acc = 0.f;
#pragma unroll
      for (int hlf = 0; hlf < 2; ++hlf) {
        float4 f = *(const float4*)(F_ + tt * 128 + ksl + hlf * 4);
        float4 g = *(const float4*)(G_ + tt * 128 + ksl + hlf * 4);
        float4 qq = *(const float4*)(Q_ + tt * 128 + ksl + hlf * 4);
        st[hlf * 4 + 0] = st[hlf * 4 + 0] * f.x + g.x * iv;
        st[hlf * 4 + 1] = st[hlf * 4 + 1] * f.y + g.y * iv;
        st[hlf * 4 + 2] = st[hlf * 4 + 2] * f.z + g.z * iv;
        st[hlf * 4 + 3] = st[hlf * 4 + 3] * f.w + g.w * iv;
        acc += st[hlf * 4 + 0] * qq.x + st[hlf * 4 + 1] * qq.y + st[hlf * 4 + 2] * qq.z + st[hlf * 4 + 3] * qq.w;
      }
      float o = sum16(acc);
      if ((lane & 15) == 0) O_[tt * 16 + rl] = o;
    }
    __builtin_amdgcn_sched_barrier(0);
    __syncthreads();
    p.PROJ[m * LDP + C_I + h * 128 + q * 16 + (tid & 15)] = f2bf(O_[stt * 16 + (tid & 15)]);
  }
  __syncthreads();
  {
    float* o = p.out + (s < 8 ? O_PHGRN + (((long)l * 8 + s) * 4 + h) * 16384
                              : O_SHGRN + (((long)l * 8 + (s - 8)) * 4 + h) * 16384);
#pragma unroll
    for (int i = 0; i < 8; ++i) o[(ksl + i) * 128 + row] = st[i];
  }
}

__device__ __forceinline__ void scan_ssd(const Params& p, int l, int s, int h, int q, float* smem) {
  const int tid = opaque_tid(), lane = tid & 63, wid = tid >> 6;
  float* B_ = smem;
  float* C_ = smem + 2048;
  float* X_ = smem + 4096;
  float* O_ = smem + 4352;
  float* DT_ = smem + 4608;
  float* DE_ = smem + 4624;
  const int rl = wid * 4 + (lane >> 4);
  const int row = q * 16 + rl;
  const int ksl = (lane & 15) * 8;
  const int g = h >> 2;
  const int base = seq_base(s), T = seq_len(s);
  float st[8];
#pragma unroll
  for (int i = 0; i < 8; ++i) st[i] = 0.f;
  if (s >= 8) {
    const float* sp = p.state_ssm + (((long)l * 8 + (s - 8)) * 8 + h) * 8192 + row * 128 + ksl;
    float4 a = *(const float4*)sp, b = *(const float4*)(sp + 4);
    st[0] = a.x; st[1] = a.y; st[2] = a.z; st[3] = a.w; st[4] = b.x; st[5] = b.y; st[6] = b.z; st[7] = b.w;
  }
  const int xc_bc = (tid < 128) ? (512 + g * 128 + tid) : (768 + g * 128 + (tid - 128));
  const float* cw = p.conv_w + (long)l * 4 * 1024;
  const float cb0 = cw[xc_bc], cb1 = cw[1024 + xc_bc], cb2 = cw[2048 + xc_bc], cb3 = cw[3072 + xc_bc];
  const float cbb = p.conv_b[l * 1024 + xc_bc];
  float u3 = 0.f, u2 = 0.f, u1 = 0.f;
  const int xc_x = h * 64 + q * 16 + (tid & 15);
  const float cx0 = cw[xc_x], cx1 = cw[1024 + xc_x], cx2 = cw[2048 + xc_x], cx3 = cw[3072 + xc_x];
  const float cxb = p.conv_b[l * 1024 + xc_x];
  float x3 = 0.f, x2 = 0.f, x1 = 0.f;
  if (s >= 8) {
    const float* sc = p.state_conv + ((long)l * 8 + (s - 8)) * 3 * 1024;
    u3 = sc[xc_bc]; u2 = sc[1024 + xc_bc]; u1 = sc[2048 + xc_bc];
    x3 = sc[xc_x]; x2 = sc[1024 + xc_x]; x1 = sc[2048 + xc_x];
  }
  const float dtb = p.dt_bias[l * 8 + h];
  const float aexp = __expf(p.a_log[l * 8 + h]);
  const float dsk = p.d_skip[l * 8 + h];
  const int stt = tid >> 4;
  const int nblk = T / 16;
  u16 raw[16], rawx[16];
  float dtr = 0.f;
  u16 zc, zn = 0;
#define SSD_LOAD(M0)                                                              \
  {                                                                               \
    const u16* col = p.PROJ + (long)(M0) * LDP + C_XBC + xc_bc;                   \
    _Pragma("unroll") for (int t = 0; t < 16; ++t) raw[t] = col[(long)t * LDP];   \
    if (tid < 16) {                                                               \
      const u16* colx = p.PROJ + (long)(M0) * LDP + C_XBC + xc_x;                 \
      _Pragma("unroll") for (int t = 0; t < 16; ++t) rawx[t] = colx[(long)t * LDP]; \
    } else if (tid < 32) {                                                        \
      dtr = p.DTRAW[((long)(M0) + (tid - 16)) * 8 + h];                           \
    }                                                                             \
    zn = p.PROJ[((long)(M0) + stt) * LDP + C_Z + h * 64 + q * 16 + (tid & 15)];   \
  }
#pragma unroll
  for (int t = 0; t < 16; ++t) { raw[t] = 0; rawx[t] = 0; }
  SSD_LOAD(base);
  __syncthreads();
  for (int blk = 0; blk < nblk; ++blk) {
    const long m0 = base + blk * 16;
    zc = zn;
    {
      float* dst = (tid < 128) ? (B_ + tid) : (C_ + (tid - 128));
#pragma unroll
      for (int t = 0; t < 16; ++t) {
        float u0 = bf2f(raw[t]);
        float y = cb0 * u3 + cb1 * u2 + cb2 * u1 + cb3 * u0 + cbb;
        dst[t * 128] = siluf_(y);
        u3 = u2; u2 = u1; u1 = u0;
      }
      if (tid < 16) {
#pragma unroll
        for (int t = 0; t < 16; ++t) {
          float u0 = bf2f(rawx[t]);
          float y = cx0 * x3 + cx1 * x2 + cx2 * x1 + cx3 * u0 + cxb;
          X_[t * 16 + tid] = siluf_(y);
          x3 = x2; x2 = x1; x1 = u0;
        }
      } else if (tid < 32) {
        int t = tid - 16;
        float dtv = softplusf_(dtr + dtb);
        DT_[t] = dtv;
        DE_[t] = __expf(-aexp * dtv);
      }
    }
    __syncthreads();
    if (blk + 1 < nblk) SSD_LOAD(m0 + 16);
    __builtin_amdgcn_sched_barrier(0);
#pragma unroll 2
    for (int tt = 0; tt < 16; ++tt) {
      float xv = X_[tt * 16 + rl];
      float xd = xv * DT_[tt];
      float de = DE_[tt];
      float acc = 0.f;
#pragma unroll
      for (int hlf = 0; hlf < 2; ++hlf) {
        float4 b = *(const float4*)(B_ + tt * 128 + ksl + hlf * 4);
        float4 c = *(const float4*)(C_ + tt * 128 + ksl + hlf * 4);
        st[hlf * 4 + 0] = st[hlf * 4 + 0] * de + xd * b.x;
        st[hlf * 4 + 1] = st[hlf * 4 + 1] * de + xd * b.y;
        st[hlf * 4 + 2] = st[hlf * 4 + 2] * de + xd * b.z;
        st[hlf * 4 + 3] = st[hlf * 4 + 3] * de + xd * b.w;
        acc += st[hlf * 4 + 0] * c.x + st[hlf * 4 + 1] * c.y + st[hlf * 4 + 2] * c.z + st[hlf * 4 + 3] * c.w;
      }
      float y = sum16(acc);
      if ((lane & 15) == 0) O_[tt * 16 + rl] = y + dsk * xv;
    }
    __builtin_amdgcn_sched_barrier(0);
    __syncthreads();
    {
      u16* pz = p.PROJ + (m0 + stt) * LDP + C_Z + h * 64 + q * 16 + (tid & 15);
      *pz = f2bf(O_[stt * 16 + (tid & 15)] * siluf_(bf2f(zc)));
    }
  }
  __syncthreads();
#undef SSD_LOAD
  {
    float* o = p.out + (s < 8 ? O_PSSM + (((long)l * 8 + s) * 8 + h) * 8192
                              : O_SSSM + (((long)l * 8 + (s - 8)) * 8 + h) * 8192);
    *(float4*)(o + row * 128 + ksl) = make_float4(st[0], st[1], st[2], st[3]);
    *(float4*)(o + row * 128 + ksl + 4) = make_float4(st[4], st[5], st[6], st[7]);
  }
  if (h == 0 && q == 0) {
    float* o = p.out + (s < 8 ? O_PCONV + ((long)l * 8 + s) * 3072 : O_SCONV + ((long)l * 8 + (s - 8)) * 3072);
    for (int i = tid; i < 3072; i += 256) {
      int r = i >> 10, c = i & 1023;
      o[i] = bf2f(p.PROJ[(long)(base + T - 3 + r) * LDP + C_XBC + c]);
    }
  }
}

__device__ __forceinline__ void phase_scan(const Params& p, int l, float* smem) {
  for (int u = BID, nb_ = NBLK; u < 1536; u += nb_) {
    int sample = u >= 768;
    int v = sample ? u - 768 : u;
    int type = v % 3, w = v / 3;
    if (type == 0) {
      int q = w & 3, h = (w >> 2) & 7, b = w >> 5;
      scan_rwkv(p, l, b + 8 * sample, h, q, smem);
    } else if (type == 1) {
      int q = w & 7, h = (w >> 3) & 3, b = w >> 5;
      scan_hgrn(p, l, b + 8 * sample, h, q, smem);
    } else {
      int q = w & 3, h = (w >> 2) & 7, b = w >> 5;
      scan_ssd(p, l, b + 8 * sample, h, q, smem);
    }
  }
}

__device__ __forceinline__ void phase_post(const Params& p, int l, float* smem) {
  const int tid = opaque_tid(), lane = tid & 63, wid = tid >> 6;
  float* SG = smem;
  float* RED = smem + 2048;
  for (int blk = BID, nb_ = NBLK; blk < NBLK16; blk += nb_) {
    const long m0 = (long)blk * 16;
    __syncthreads();
    if (tid < 128) {
      const u16* col = p.PROJ + m0 * LDP + C_XG + tid;
#pragma unroll
      for (int t = 0; t < 16; ++t) SG[tid * 16 + t] = bf2f(col[(long)t * LDP]);
    }
    float ys[2][16], oh[2][16];
#pragma unroll
    for (int c = 0; c < 2; ++c) {
      int ch = tid + 256 * c;
#pragma unroll
      for (int t = 0; t < 16; ++t) {
        ys[c][t] = bf2f(p.PROJ[(m0 + t) * LDP + C_Z + ch]);
        oh[c][t] = bf2f(p.PROJ[(m0 + t) * LDP + C_I + ch]);
      }
    }
#pragma unroll
    for (int t = 0; t < 16; ++t) {
      float a0 = sum64(ys[0][t] * ys[0][t]), a1 = sum64(ys[1][t] * ys[1][t]);
      float b0 = sum64(oh[0][t] * oh[0][t]), b1 = sum64(oh[1][t] * oh[1][t]);
      if (lane == 0) *(float4*)(RED + (wid * 16 + t) * 4) = make_float4(a0, a1, b0, b1);
    }
    __syncthreads();
    {
      const float nw0 = p.ssd_norm_w[l * 512 + tid], nw1 = p.ssd_norm_w[l * 512 + tid + 256];
      const float hw0 = p.hg_norm_w[l * 512 + tid], hw1 = p.hg_norm_w[l * 512 + tid + 256];
      const int pw = (wid >> 1) * 2;
#pragma unroll
      for (int t = 0; t < 16; ++t) {
        float4 r0 = *(const float4*)(RED + (0 * 16 + t) * 4), r1 = *(const float4*)(RED + (1 * 16 + t) * 4);
        float4 r2 = *(const float4*)(RED + (2 * 16 + t) * 4), r3 = *(const float4*)(RED + (3 * 16 + t) * 4);
        float g0 = r0.x + r1.x + r2.x + r3.x, g1 = r0.y + r1.y + r2.y + r3.y;
        float4 pa = *(const float4*)(RED + (pw * 16 + t) * 4), pb = *(const float4*)(RED + ((pw + 1) * 16 + t) * 4);
        float h0 = pa.z + pb.z, h1 = pa.w + pb.w;
        u16* rowp = p.PROJ + (m0 + t) * LDP;
        rowp[C_Z + tid] = f2bf(ys[0][t] * rsqrtf(g0 * (1.f / 256.f) + 1e-6f) * nw0);
        rowp[C_Z + tid + 256] = f2bf(ys[1][t] * rsqrtf(g1 * (1.f / 256.f) + 1e-6f) * nw1);
        float gg0 = bf2f(rowp[C_GG + tid]), gg1 = bf2f(rowp[C_GG + tid + 256]);
        rowp[C_GG + tid] = f2bf(oh[0][t] * rsqrtf(h0 * (1.f / 128.f) + 1e-6f) * hw0 * siluf_(gg0));
        rowp[C_GG + tid + 256] = f2bf(oh[1][t] * rsqrtf(h1 * (1.f / 128.f) + 1e-6f) * hw1 * siluf_(gg1));
      }
    }
    float ga[2][16];
#pragma unroll
    for (int c = 0; c < 2; ++c)
#pragma unroll
      for (int t = 0; t < 16; ++t) ga[c][t] = 0.f;
    {
      const float* g2 = p.rw_g2 + (long)l * 128 * 512;
      for (int i = 0; i < 128; ++i) {
        float gv[2] = {g2[i * 512 + tid], g2[i * 512 + tid + 256]};
#pragma unroll
        for (int q = 0; q < 4; ++q) {
          float4 x = *(const float4*)(SG + i * 16 + q * 4);
#pragma unroll
          for (int c = 0; c < 2; ++c) {
            ga[c][q * 4 + 0] += x.x * gv[c]; ga[c][q * 4 + 1] += x.y * gv[c];
            ga[c][q * 4 + 2] += x.z * gv[c]; ga[c][q * 4 + 3] += x.w * gv[c];
          }
        }
      }
    }
#pragma unroll
    for (int c = 0; c < 2; ++c) {
      int ch = tid + 256 * c, head = wid + 4 * c;
      float lw = p.rw_lnx_w[l * 512 + ch], lbv = p.rw_lnx_b[l * 512 + ch];
#pragma unroll
      for (int t = 0; t < 16; ++t) {
        float o = bf2f(p.ORW[(m0 + t) * 512 + ch]);
        float mean = sum64(o) * (1.f / 64.f);
        float d = o - mean;
        float var = sum64(d * d) * (1.f / 64.f);
        float ln = d * rsqrtf(var + 64e-5f) * lw + lbv;
        float v = bf2f(p.PROJ[(m0 + t) * LDP + C_V + ch]);
        float bonus = p.RKS[(m0 + t) * 8 + head] * v;
        p.PROJ[(m0 + t) * LDP + C_R + ch] = f2bf((ln + bonus) * ga[c][t]);
      }
    }
  }
}

__device__ __forceinline__ void phase_final(const Params& p) {
  const int tid = opaque_tid(), lane = tid & 63, wid = tid >> 6;
  for (int m = BID * 4 + wid, nb_ = NBLK; m < M_TOT; m += nb_ * 4) {
    float* dst;
    if (m < M_PROMPT) {
      int b = m / T_P, t = m - b * T_P;
      if (t < 16) continue;
      dst = p.out + O_YP + ((long)b * 4096 + (t - 16)) * DM;
    } else {
      dst = p.out + O_YS + (long)(m - M_PROMPT) * DM;
    }
    float x[16];
    float ss = 0.f;
#pragma unroll
    for (int j = 0; j < 2; ++j) {
      uint4 raw = *(const uint4*)(p.XB + (long)m * DM + lane * 8 + 512 * j);
      unsigned wv[4] = {raw.x, raw.y, raw.z, raw.w};
#pragma unroll
      for (int e = 0; e < 8; ++e) {
        x[j * 8 + e] = bf2f((u16)((wv[e >> 1] >> ((e & 1) * 16)) & 0xffff));
        ss += x[j * 8 + e] * x[j * 8 + e];
      }
    }
    ss = sum64(ss);
    float rs = rsqrtf(ss * (1.f / 1024.f) + 1e-6f);
#pragma unroll
    for (int j = 0; j < 2; ++j) {
      int k0 = lane * 8 + 512 * j;
      float4 w0 = *(const float4*)(p.final_w + k0), w1 = *(const float4*)(p.final_w + k0 + 4);
      *(float4*)(dst + k0) = make_float4(x[j * 8 + 0] * rs * w0.x, x[j * 8 + 1] * rs * w0.y, x[j * 8 + 2] * rs * w0.z,
                                         x[j * 8 + 3] * rs * w0.w);
      *(float4*)(dst + k0 + 4) = make_float4(x[j * 8 + 4] * rs * w1.x, x[j * 8 + 5] * rs * w1.y,
                                             x[j * 8 + 6] * rs * w1.z, x[j * 8 + 7] * rs * w1.w);
    }
  }
}


#define XB_TMO      128
#define XB_XCNT(j)  (256  + 64 * (j))
#define XB_XSUB(j)  (1280 + 64 * (j))
#define XB_XGEN(j)  (2304 + 64 * (j))
#define XB_TOP      3328
#define XB_TOPGEN   3392
#define XCD_BAR_WORDS 3456
#define XB_SPIN_CAP (1u << 22)
__device__ __forceinline__ unsigned xb_ld(unsigned* p) { return __hip_atomic_load(p, __ATOMIC_RELAXED, __HIP_MEMORY_SCOPE_AGENT); }
__device__ __forceinline__ unsigned xb_add(unsigned* p, unsigned v) { return __hip_atomic_fetch_add(p, v, __ATOMIC_RELAXED, __HIP_MEMORY_SCOPE_AGENT); }
__device__ __forceinline__ unsigned xb_xcc_id() { return (unsigned)__builtin_amdgcn_s_getreg((3 << 11) | 20) & 0xFu; }
#define XB_SPIN(cond, bar) do { unsigned _sp = 0; while (cond) { __builtin_amdgcn_s_sleep(1); \
    if ((++_sp & 255u) == 0u) { if (xb_ld(&(bar)[XB_TMO])) break; if (_sp > XB_SPIN_CAP) { atomicAdd(&(bar)[XB_TMO], 1u); break; } } } } while (0)

__device__ __forceinline__ void xcd_barrier_post(unsigned* bar) {
  if (threadIdx.x == 0) (void)xb_add(&bar[XB_XCNT(xb_xcc_id())], 1u);
}
__device__ __forceinline__ void xcd_barrier_complete(unsigned* bar, unsigned x, unsigned& nloc, unsigned& nx) {
  const unsigned G = gridDim.x;
  unsigned sum, cnt, mine, sp = 0u;
  for (;;) {
    sum = 0u; cnt = 0u; mine = 0u;
#pragma unroll
    for (unsigned j = 0; j < 16; ++j) { const unsigned c = xb_ld(&bar[XB_XCNT(j)]); sum += c; cnt += (c > 0u) ? 1u : 0u; mine = (j == x) ? c : mine; }
    if (sum == G) break;
    __builtin_amdgcn_s_sleep(1);
    if ((++sp & 255u) == 0u) { if (xb_ld(&bar[XB_TMO])) break; if (sp > XB_SPIN_CAP) { atomicAdd(&bar[XB_TMO], 1u); break; } }
  }
  nloc = mine > 0u ? mine : 1u; nx = cnt > 0u ? cnt : 1u;
}
__device__ __forceinline__ void xcd_barrier(unsigned* bar, volatile unsigned* st) {
  asm volatile("s_waitcnt vmcnt(0)" ::: "memory");
  __syncthreads();
  if (threadIdx.x == 0) {
    __builtin_amdgcn_s_waitcnt(0);
    const unsigned x = xb_xcc_id();
    unsigned nloc = st[0], nx = st[1];
    if (nloc == 0u) { xcd_barrier_complete(bar, x, nloc, nx); st[0] = nloc; st[1] = nx; }
    const unsigned old = xb_add(&bar[XB_XSUB(x)], 1u);
    const unsigned gen = old / nloc;
    if (old + 1u == (gen + 1u) * nloc) {
      __builtin_amdgcn_fence(__ATOMIC_RELEASE, "agent");
      asm volatile("s_waitcnt vmcnt(0)" ::: "memory");
      const unsigned og = xb_add(&bar[XB_TOP], 1u);
      const unsigned tg = og / nx;
      if (og + 1u == (tg + 1u) * nx) xb_add(&bar[XB_TOPGEN], 1u);
      else XB_SPIN(xb_ld(&bar[XB_TOPGEN]) == tg, bar);
      __builtin_amdgcn_fence(__ATOMIC_ACQUIRE, "agent");
      xb_add(&bar[XB_XGEN(x)], 1u);
      asm volatile("s_waitcnt vmcnt(0)" ::: "memory");
    } else {
      XB_SPIN(xb_ld(&bar[XB_XGEN(x)]) == gen, bar);
      __builtin_amdgcn_fence(__ATOMIC_ACQUIRE, "agent");
      asm volatile("s_waitcnt vmcnt(0)" ::: "memory");
    }
  }
  __syncthreads();
}

constexpr int SMEM_BYTES = 40960;
__device__ __forceinline__ void run_phase(const Params& p, int ph, char* smem) {
  if (ph == 0) { phase_embed(p); return; }
  if (ph == 19) { phase_final(p); return; }
  int l = (ph - 1) / 9, s = (ph - 1) % 9;
  float* fs = (float*)smem;
  switch (s) {
    case 0: phase_convert(p, l, fs); phase_rowstat<true>(p, l, fs); break;
    case 1: phase_gemm<1>(p, p.XB, DM, p.W1T, 1024, LDP / 128, smem); break;
    case 2: phase_pre(p, l, fs); break;
    case 3: phase_scan(p, l, fs); break;
    case 4: phase_post(p, l, fs); break;
    case 5: phase_gemm<2>(p, p.PROJ, LDP, p.WOT, 1536, 8, smem); break;
    case 6: phase_rowstat<false>(p, l, fs); break;
    case 7: phase_gemm<3>(p, p.XB, DM, p.WGU, 1024, 44, smem); break;
    case 8: phase_gemm<2>(p, p.PROJ, D_FF, p.WDT, D_FF, 8, smem); break;
  }
}
constexpr int N_PHASES = 20;

#if MEGA
__global__ void __launch_bounds__(256, 3) k_mega(Params p) {
  __shared__ __attribute__((aligned(16))) char smem[SMEM_BYTES];
  __shared__ uint4 xb_words;
  if (threadIdx.x == 0) { xb_words = make_uint4(0u, 0u, 0u, 0u); }
  __syncthreads();
  cg::grid_group grid = cg::this_grid();
  float* fs = (float*)smem;
  volatile unsigned* xst = (volatile unsigned*)&xb_words;
  xcd_barrier_post(p.bar);
  phase_embed(p);
  grid.sync();
#define GSYNC() do { unsigned* b_ = p.bar; asm volatile("" : "+s"(b_)); xcd_barrier(b_, xst); } while (0)
#pragma unroll 1
  for (int l0 = 0; l0 < 2; ++l0) {
    int l = opaque_s(l0);
    phase_convert(p, l, fs);
    phase_rowstat<true>(p, l, fs);
    GSYNC();
    l = opaque_s(l);
    phase_gemm<1>(p, p.XB, DM, p.W1T, 1024, LDP / 128, smem);
    GSYNC();
    l = opaque_s(l);
    phase_pre(p, l, fs);
    GSYNC();
    l = opaque_s(l);
    phase_scan(p, l, fs);
    GSYNC();
    l = opaque_s(l);
    phase_post(p, l, fs);
    GSYNC();
    l = opaque_s(l);
    phase_gemm<2>(p, p.PROJ, LDP, p.WOT, 1536, 8, smem);
    GSYNC();
    l = opaque_s(l);
    phase_rowstat<false>(p, l, fs);
    GSYNC();
    l = opaque_s(l);
    phase_gemm<3>(p, p.XB, DM, p.WGU, 1024, 44, smem);
    GSYNC();
    l = opaque_s(l);
    phase_gemm<2>(p, p.PROJ, D_FF, p.WDT, D_FF, 8, smem);
    GSYNC();
  }
  phase_final(p);
}
#else
template <int PH>
__global__ void __launch_bounds__(256, 3) k_phase(Params p) {
  __shared__ __attribute__((aligned(16))) char smem[SMEM_BYTES];
  run_phase(p, PH, smem);
}
template <int PH>
static void launch_all(const Params& p, int grid, hipStream_t stream) {
  hipLaunchKernelGGL(k_phase<PH>, dim3(grid), dim3(256), 0, stream, p);
  if constexpr (PH + 1 < N_PHASES) launch_all<PH + 1>(p, grid, stream);
}
#endif

extern "C" void kernel_launch(void* const* d_in, const int* in_sizes, int n_in, void* d_out, int out_size, void* d_ws,
                              size_t ws_size, hipStream_t stream) {
  Params p{};
  const float** pf = (const float**)&p;
  for (int i = 0; i < 35; ++i) pf[i] = (const float*)d_in[i];
  p.out = (float*)d_out;
  char* ws = (char*)d_ws;
  size_t off = 0;
  auto take = [&](size_t bytes) { char* r = ws + off; off += (bytes + 255) & ~(size_t)255; return r; };
  p.XB = (u16*)take((size_t)M_TOT * DM * 2);
  p.PROJ = (u16*)take((size_t)M_TOT * LDP * 2);
  p.W1T = (u16*)take((size_t)LDP * 1024 * 2);
  p.WOT = (u16*)take((size_t)1024 * 1536 * 2);
  p.WGU = (u16*)take((size_t)5632 * 1024 * 2);
  p.WDT = (u16*)take((size_t)1024 * D_FF * 2);
  p.BND = (u16*)take((size_t)NBLK16 * 1792 * 2);
  p.ORW = (u16*)take((size_t)M_TOT * 512 * 2);
  p.RS = (float*)take((size_t)M_TOT * 4);
  p.DTRAW = (float*)take((size_t)M_TOT * 8 * 4);
  p.RKS = (float*)take((size_t)M_TOT * 8 * 4);
  p.bar = (unsigned*)take((size_t)XCD_BAR_WORDS * 4);
  p.RWX = (u16*)d_out;
  if (off > ws_size) fprintf(stderr, "workspace too small: need %zu have %zu\n", off, ws_size);
#if MEGA
  static int grid_blocks = 0;
  if (!grid_blocks) {
    int dev = 0, cus = 0, per_cu = 0;
    hipGetDevice(&dev);
    hipDeviceGetAttribute(&cus, hipDeviceAttributeMultiprocessorCount, dev);
    hipOccupancyMaxActiveBlocksPerMultiprocessor(&per_cu, k_mega, 256, 0);
    if (per_cu > 3) per_cu = 3;
    grid_blocks = cus * per_cu;
  }
  hipMemsetAsync(p.bar, 0, (size_t)XCD_BAR_WORDS * 4, stream);
  void* args[] = {&p};
  hipError_t e = hipLaunchCooperativeKernel((void*)k_mega, dim3(grid_blocks), dim3(256), args, 0, stream);
  if (e != hipSuccess) fprintf(stderr, "cooperative launch failed: %s (grid %d)\n", hipGetErrorString(e), grid_blocks);
#else
  launch_all<0>(p, 768, stream);
#endif
}
```

```cpp
#include <hip/hip_runtime.h>
#include <hip/hip_bf16.h>
#include <hip/hip_cooperative_groups.h>
#include <cstdio>
namespace cg = cooperative_groups;

#ifndef MEGA
#define MEGA 1
#endif

typedef unsigned short u16;
using bf16x8 = __attribute__((ext_vector_type(8))) short;
using f32x16 = __attribute__((ext_vector_type(16))) float;

constexpr int DM = 1024;
constexpr int M_TOT = 33408;
constexpr int M_PROMPT = 32896;
constexpr int T_P = 4112;
constexpr int LDP = 5376;
constexpr int N_IN = 5384;
constexpr int D_FF = 2816;
constexpr int NBLK16 = M_TOT / 16;
constexpr int C_Z = 0, C_R = 512, C_GG = 1024, C_XBC = 1536, C_K = 2560, C_V = 3072, C_XW = 3584, C_XA = 3648,
              C_XG = 3712, C_Q = 3840, C_F = 4352, C_I = 4864;
constexpr long O_YP = 0, O_YS = 33554432, O_PSSM = 34078720, O_PCONV = 35127296, O_PRWKV = 35176448,
               O_PSHIFT = 35700736, O_PHGRN = 35729408, O_SSSM = 36777984, O_SCONV = 37826560,
               O_SRWKV = 37875712, O_SSHIFT = 38400000, O_SHGRN = 38428672;

struct Params {
  const float *x_prompt, *x_sample, *state_ssm, *state_conv, *state_rwkv, *state_shift, *state_hgrn, *meta,
      *norm1_w, *w_in, *conv_w, *conv_b, *dt_bias, *a_log, *d_skip, *ssd_norm_w, *rw_mu, *rw_w0, *rw_w2, *rw_a0,
      *rw_a2, *rw_g2, *rw_kk, *rw_ka, *rw_rk, *rw_lnx_w, *rw_lnx_b, *hg_lb, *hg_norm_w, *w_out, *norm2_w, *w_gate,
      *w_up, *w_down, *final_w;
  float* out;
  u16 *XB, *PROJ, *W1T, *WOT, *WGU, *WDT, *BND, *ORW, *RWX;
  float *RS, *DTRAW, *RKS;
  unsigned* bar;
};

__device__ __forceinline__ u16 f2bf(float f) {
  unsigned u = __float_as_uint(f);
  u += 0x7fffu + ((u >> 16) & 1u);
  return (u16)(u >> 16);
}
__device__ __forceinline__ float bf2f(u16 h) { return __uint_as_float(((unsigned)h) << 16); }
__device__ __forceinline__ float frcp_(float x) { return __builtin_amdgcn_rcpf(x); }
__device__ __forceinline__ float sigmoidf_(float x) { return frcp_(1.f + __expf(-x)); }
__device__ __forceinline__ float siluf_(float x) { return x * frcp_(1.f + __expf(-x)); }
__device__ __forceinline__ float softplusf_(float x) { return x > 20.f ? x : log1pf(__expf(x)); }

template <int CTRL>
__device__ __forceinline__ float dppf(float v) {
  return __int_as_float(__builtin_amdgcn_update_dpp(0, __float_as_int(v), CTRL, 0xF, 0xF, true));
}
__device__ __forceinline__ float sum16(float v) {
  v += dppf<0xB1>(v);
  v += dppf<0x4E>(v);
  v += dppf<0x141>(v);
  v += dppf<0x140>(v);
  return v;
}
__device__ __forceinline__ float sum64(float v) {
  v = sum16(v);
  v += __shfl_xor(v, 16);
  v += __shfl_xor(v, 32);
  return v;
}

#define NOPK(x) asm("" : "+v"(x))
__device__ __forceinline__ int opaque_tid() {
  int t = threadIdx.x;
  asm volatile("" : "+v"(t));
  return t;
}
__device__ __forceinline__ int opaque_s(int v) {
  asm volatile("" : "+s"(v));
  return v;
}
#define BID opaque_s((int)blockIdx.x)
#define NBLK opaque_s((int)gridDim.x)
__device__ __forceinline__ int seq_base(int s) { return s < 8 ? s * T_P : M_PROMPT + (s - 8) * 64; }
__device__ __forceinline__ int seq_len(int s) { return s < 8 ? T_P : 64; }

__device__ __forceinline__ void phase_embed(const Params& p) {
  const long n4 = (long)M_TOT * 256;
  for (long idx = (long)BID * 256 + threadIdx.x, st_ = (long)NBLK * 256; idx < n4; idx += st_) {
    int m = (int)(idx >> 8), c4 = ((int)idx & 255) * 4;
    const float* src;
    if (m < M_PROMPT) {
      int b = m / T_P, t = m - b * T_P;
      src = (t < 16) ? p.meta + (long)t * DM : p.x_prompt + ((long)b * 4096 + (t - 16)) * DM;
    } else {
      src = p.x_sample + (long)(m - M_PROMPT) * DM;
    }
    float4 v = *(const float4*)(src + c4);
    ushort4 o;
    o.x = f2bf(v.x); o.y = f2bf(v.y); o.z = f2bf(v.z); o.w = f2bf(v.w);
    *(ushort4*)(p.XB + (long)m * DM + c4) = o;
  }
}

template <bool HAS_SCALE>
__device__ __forceinline__ void conv_tile(const float* __restrict__ src, int ldsrc, int srccol0, const float* __restrict__ scale,
                          u16* __restrict__ dst, int K, int k0, int n0, float* tile  ) {
  const int tid = opaque_tid();
  __syncthreads();
  {
    int nn = tid & 63, kb = tid >> 6;
#pragma unroll
    for (int i = 0; i < 16; ++i) {
      int kk = kb + 4 * i;
      float v = src[(long)(k0 + kk) * ldsrc + srccol0 + nn];
      if (HAS_SCALE) v *= scale[k0 + kk];
      tile[kk * 65 + nn] = v;
    }
  }
  __syncthreads();
  {
    int nn = tid >> 2, kq = (tid & 3) * 16;
    u16* d = dst + (long)(n0 + nn) * K + k0 + kq;
#pragma unroll
    for (int j = 0; j < 16; j += 2) {
      unsigned w = f2bf(tile[(kq + j) * 65 + nn]) | ((unsigned)f2bf(tile[(kq + j + 1) * 65 + nn]) << 16);
      *(unsigned*)(d + j) = w;
    }
  }
}

__device__ __forceinline__ int w1_srccol(int n0) {
  if (n0 < 512) return n0;
  if (n0 < 1024) return n0 - 512 + 1544;
  if (n0 < 1536) return n0 - 1024 + 4872;
  if (n0 < 2560) return n0 - 1536 + 512;
  if (n0 < 3840) return n0 - 2560 + 2056;
  return n0 - 3840 + 3336;
}

constexpr int CV_W1 = 16 * 84, CV_WO = 24 * 16, CV_WGU = 16 * 88, CV_WD = 44 * 16;
constexpr int CV_TOTAL = CV_W1 + CV_WO + CV_WGU + CV_WD;

__device__ __forceinline__ void phase_convert(const Params& p, int l, float* smem) {
  for (int u = BID, nb_ = NBLK; u < CV_TOTAL; u += nb_) {
    if (u < CV_W1) {
      int kt = u % 16, nt = u / 16;
      conv_tile<true>(p.w_in + (long)l * DM * N_IN, N_IN, w1_srccol(nt * 64), p.norm1_w + l * DM, p.W1T, 1024, kt * 64,
                nt * 64, smem);
    } else if (u < CV_W1 + CV_WO) {
      int v = u - CV_W1;
      int kt = v % 24, nt = v / 24;
      conv_tile<false>(p.w_out + (long)l * 1536 * DM, DM, nt * 64, nullptr, p.WOT, 1536, kt * 64, nt * 64, smem);
    } else if (u < CV_W1 + CV_WO + CV_WGU) {
      int v = u - CV_W1 - CV_WO;
      int kt = v % 16, nt = v / 16;
      const float* wg = p.w_gate + (long)l * DM * D_FF;
      const float* wu = p.w_up + (long)l * DM * D_FF;
      const float* sc = p.norm2_w + l * DM;
      const int tid = opaque_tid();
      __syncthreads();
      {
        int nn = tid & 63, kb = tid >> 6;
        const float* src = (nn < 32) ? wg : wu;
        int col = nt * 32 + (nn & 31);
#pragma unroll
        for (int i = 0; i < 16; ++i) {
          int kk = kb + 4 * i;
          smem[kk * 65 + nn] = src[(long)(kt * 64 + kk) * D_FF + col] * sc[kt * 64 + kk];
        }
      }
      __syncthreads();
      {
        int nn = tid >> 2, kq = (tid & 3) * 16;
        u16* d = p.WGU + (long)(nt * 64 + nn) * 1024 + kt * 64 + kq;
#pragma unroll
        for (int j = 0; j < 16; j += 2) {
          unsigned w = f2bf(smem[(kq + j) * 65 + nn]) | ((unsigned)f2bf(smem[(kq + j + 1) * 65 + nn]) << 16);
          *(unsigned*)(d + j) = w;
        }
      }
    } else {
      int v = u - CV_W1 - CV_WO - CV_WGU;
      int kt = v % 44, nt = v / 44;
      conv_tile<false>(p.w_down + (long)l * D_FF * DM, DM, nt * 64, nullptr, p.WDT, D_FF, kt * 64, nt * 64, smem);
    }
  }
}

template <bool WITH_DT>
__device__ __forceinline__ void phase_rowstat(const Params& p, int l, float* smem) {
  const int tid = opaque_tid(), lane = tid & 63, wid = tid >> 6;
  float* dtw = smem;
  if (WITH_DT) {
    __syncthreads();
    const float* w = p.w_in + (long)l * DM * N_IN + 1536;
    const float* nw = p.norm1_w + l * DM;
    for (int i = tid; i < 8192; i += 256) {
      int k = i >> 3, h = i & 7;
      dtw[i] = w[(long)k * N_IN + h] * nw[k];
    }
    __syncthreads();
  }
  for (int blk = BID, nb_ = NBLK; blk < NBLK16; blk += nb_) {
    for (int rr = wid; rr < 16; rr += 4) {
      int m = blk * 16 + rr;
      float ss = 0.f;
      float d[8];
#pragma unroll
      for (int h = 0; h < 8; ++h) d[h] = 0.f;
#pragma unroll 1
      for (int j = 0; j < 4; ++j) {
        int k0 = lane * 4 + 256 * j;
        uint2 raw = *(const uint2*)(p.XB + (long)m * DM + k0);
        float xs[4] = {bf2f((u16)(raw.x & 0xffff)), bf2f((u16)(raw.x >> 16)), bf2f((u16)(raw.y & 0xffff)),
                       bf2f((u16)(raw.y >> 16))};
#pragma unroll
        for (int e = 0; e < 4; ++e) {
          float x = xs[e];
          ss += x * x;
          if (WITH_DT) {
            float4 w0 = *(const float4*)(dtw + (k0 + e) * 8);
            float4 w1 = *(const float4*)(dtw + (k0 + e) * 8 + 4);
            d[0] += x * w0.x; d[1] += x * w0.y; d[2] += x * w0.z; d[3] += x * w0.w;
            d[4] += x * w1.x; d[5] += x * w1.y; d[6] += x * w1.z; d[7] += x * w1.w;
          }
        }
      }
      ss = sum64(ss);
      float rs = rsqrtf(ss * (1.f / 1024.f) + 1e-6f);
      if (WITH_DT) {
#pragma unroll
        for (int h = 0; h < 8; ++h) d[h] = sum64(d[h]);
        if (lane == 0) {
#pragma unroll
          for (int h = 0; h < 8; ++h) p.DTRAW[(long)m * 8 + h] = d[h] * rs;
        }
      }
      if (lane == 0) p.RS[m] = rs;
    }
  }
}

constexpr int G_BK = 32, G_LDS_ROW = 80;
constexpr int G_OPER_BYTES = 128 * G_LDS_ROW;
template <int MODE>
__device__ __forceinline__ void phase_gemm(const Params& p, const u16* __restrict__ A, int lda, const u16* __restrict__ Bt, int K,
                           int nN, char* smem) {
  const int tid = opaque_tid(), lane = tid & 63, wid = tid >> 6, wm = wid >> 1, wn = wid & 1;
  const int nM = M_TOT / 128;
  const int ntiles = nM * nN;
  const int nk = K / G_BK;
  const int lrow = tid >> 2, lkc = tid & 3;
  for (int tile = BID, nb_ = NBLK; tile < ntiles; tile += nb_) {
    int grp = tile / (8 * nN);
    int first_m = grp * 8;
    int gsz = min(8, nM - first_m);
    int rem = tile - grp * 8 * nN;
    int pm = first_m + rem % gsz, pn = rem / gsz;
    const u16* gA = A + (long)(pm * 128 + lrow) * lda + lkc * 8;
    const u16* gB = Bt + (long)(pn * 128 + lrow) * K + lkc * 8;
    f32x16 acc[2][2];
#pragma unroll
    for (int i = 0; i < 2; ++i)
#pragma unroll
      for (int j = 0; j < 2; ++j)
#pragma unroll
        for (int r = 0; r < 16; ++r) acc[i][j][r] = 0.f;
    uint4 xa0, xa1, xb0, xb1, ya0, ya1, yb0, yb1;
#define G_LOAD(S, KT)                                                  \
  {                                                                    \
    S##a0 = *(const uint4*)(gA + (KT) * G_BK);                         \
    S##a1 = *(const uint4*)(gA + (long)64 * lda + (KT) * G_BK);        \
    S##b0 = *(const uint4*)(gB + (KT) * G_BK);                         \
    S##b1 = *(const uint4*)(gB + (long)64 * K + (KT) * G_BK);          \
  }
#define G_STORE(S, BUF)                                                \
  {                                                                    \
    char* dA = smem + (BUF) * 2 * G_OPER_BYTES;                        \
    char* dB = dA + G_OPER_BYTES;                                      \
    *(uint4*)(dA + lrow * G_LDS_ROW + lkc * 16) = S##a0;               \
    *(uint4*)(dA + (lrow + 64) * G_LDS_ROW + lkc * 16) = S##a1;        \
    *(uint4*)(dB + lrow * G_LDS_ROW + lkc * 16) = S##b0;               \
    *(uint4*)(dB + (lrow + 64) * G_LDS_ROW + lkc * 16) = S##b1;        \
  }
#define G_COMPUTE(BUF)                                                                           \
  {                                                                                              \
    const char* sA = smem + (BUF) * 2 * G_OPER_BYTES;                                            \
    const char* sB = sA + G_OPER_BYTES;                                                          \
    _Pragma("unroll") for (int ks = 0; ks < 2; ++ks) {                                           \
      bf16x8 af[2], bfr[2];                                                                      \
      const int koff = (ks * 16 + (lane >> 5) * 8) * 2;                                          \
      _Pragma("unroll") for (int i = 0; i < 2; ++i)                                              \
        af[i] = *(const bf16x8*)(sA + (wm * 64 + i * 32 + (lane & 31)) * G_LDS_ROW + koff);      \
      _Pragma("unroll") for (int j = 0; j < 2; ++j)                                              \
        bfr[j] = *(const bf16x8*)(sB + (wn * 64 + j * 32 + (lane & 31)) * G_LDS_ROW + koff);     \
      _Pragma("unroll") for (int i = 0; i < 2; ++i)                                              \
        _Pragma("unroll") for (int j = 0; j < 2; ++j)                                            \
          acc[i][j] = __builtin_amdgcn_mfma_f32_32x32x16_bf16(af[i], bfr[j], acc[i][j], 0, 0, 0); \
    }                                                                                            \
  }
    G_LOAD(x, 0);
    G_LOAD(y, 1);
    __builtin_amdgcn_sched_barrier(0);
    __syncthreads();
    G_STORE(x, 0);
    __syncthreads();
    for (int kt = 0; kt < nk; kt += 2) {
      if (kt + 2 < nk) G_LOAD(x, kt + 2);
      __builtin_amdgcn_sched_barrier(0);
      G_COMPUTE(0);
      __builtin_amdgcn_sched_barrier(0);
      G_STORE(y, 1);
      __syncthreads();
      if (kt + 3 < nk) G_LOAD(y, kt + 3);
      __builtin_amdgcn_sched_barrier(0);
      G_COMPUTE(1);
      __builtin_amdgcn_sched_barrier(0);
      if (kt + 2 < nk) G_STORE(x, 0);
      __syncthreads();
    }
#undef G_LOAD
#undef G_STORE
#undef G_COMPUTE
    const int colb = pn * 128 + wn * 64 + (lane & 31);
    const int rowb = pm * 128 + wm * 64 + 4 * (lane >> 5);
    if (MODE == 1) {
#pragma unroll
      for (int i = 0; i < 2; ++i)
#pragma unroll
        for (int r = 0; r < 16; ++r) {
          int row = rowb + i * 32 + (r & 3) + 8 * (r >> 2);
          float rs = p.RS[row];
#pragma unroll
          for (int j = 0; j < 2; ++j) {
            int col = colb + j * 32;
            u16 v = f2bf(acc[i][j][r] * rs);
            p.PROJ[(long)row * LDP + col] = v;
            if ((row & 15) == 15) {
              int jj = -1;
              if (col >= C_R && col < C_GG) jj = col - C_R;
              else if (col >= C_K && col < C_Q) jj = col - C_K + 512;
              if (jj >= 0) p.BND[(long)(row >> 4) * 1792 + jj] = v;
            }
          }
        }
    } else if (MODE == 2) {
#pragma unroll
      for (int i = 0; i < 2; ++i)
#pragma unroll
        for (int r = 0; r < 16; ++r) {
          int row = rowb + i * 32 + (r & 3) + 8 * (r >> 2);
#pragma unroll
          for (int j = 0; j < 2; ++j) {
            int col = colb + j * 32;
            u16* px = p.XB + (long)row * DM + col;
            *px = f2bf(bf2f(*px) + acc[i][j][r]);
          }
        }
    } else {
      const int cact = pn * 64 + wn * 32 + (lane & 31);
      u16* ACT = p.PROJ;
#pragma unroll
      for (int i = 0; i < 2; ++i)
#pragma unroll
        for (int r = 0; r < 16; ++r) {
          int row = rowb + i * 32 + (r & 3) + 8 * (r >> 2);
          float rs = p.RS[row];
          float g = acc[i][0][r] * rs, u = acc[i][1][r] * rs;
          ACT[(long)row * D_FF + cact] = f2bf(siluf_(g) * u);
        }
    }
  }
}

__device__ __forceinline__ void phase_pre(const Params& p, int l, float* smem) {
  const int tid = opaque_tid(), lane = tid & 63, wid = tid >> 6;
  float* XW = smem;
  float* XA = smem + 1024;
  const float* mu = p.rw_mu + l * 1792;
  for (int blk = BID, nb_ = NBLK; blk < NBLK16; blk += nb_) {
    const int m0 = blk * 16;
    int s, t0;
    if (m0 < M_PROMPT) { s = m0 / T_P; t0 = m0 - s * T_P; } else { s = 8 + (m0 - M_PROMPT) / 64; t0 = (m0 - M_PROMPT) & 63; }
    const bool first = (t0 == 0);
    auto prev_of = [&](int j) -> float {
      if (!first) return bf2f(p.BND[(long)(blk - 1) * 1792 + j]);
      if (s < 8) return 0.f;
      return p.state_shift[((long)l * 8 + (s - 8)) * 1792 + j];
    };
    __syncthreads();
    {
      int j = 1536 + tid;
      float mj = mu[j];
      float pv = prev_of(j);
      u16* col = p.PROJ + (long)m0 * LDP + C_XW + tid;
#pragma unroll
      for (int t = 0; t < 16; ++t) {
        float x = bf2f(col[(long)t * LDP]);
        float sh = x + (pv - x) * mj;
        pv = x;
        if (tid < 64) XW[tid * 16 + t] = tanhf(sh);
        else if (tid < 128) XA[(tid - 64) * 16 + t] = sh;
        else col[(long)t * LDP] = f2bf(sigmoidf_(sh));
      }
    }
    __syncthreads();
#pragma unroll 1
    for (int c = 0; c < 2; ++c) {
      const int ch = tid + 256 * c;
      const int head = wid + 4 * c;
      float aw[16], aa[16];
#pragma unroll
      for (int t = 0; t < 16; ++t) { aw[t] = 0.f; aa[t] = 0.f; }
      {
        const float* w2 = p.rw_w2 + (long)l * 64 * 512 + ch;
        const float* a2 = p.rw_a2 + (long)l * 64 * 512 + ch;
#pragma unroll 2
        for (int i = 0; i < 64; ++i) {
          float w2v = w2[i * 512];
          float a2v = a2[i * 512];
#pragma unroll
          for (int q = 0; q < 4; ++q) {
            float4 xw = *(const float4*)(XW + i * 16 + q * 4);
            float4 xa = *(const float4*)(XA + i * 16 + q * 4);
            aw[q * 4 + 0] += xw.x * w2v; aw[q * 4 + 1] += xw.y * w2v;
            aw[q * 4 + 2] += xw.z * w2v; aw[q * 4 + 3] += xw.w * w2v;
            aa[q * 4 + 0] += xa.x * a2v; aa[q * 4 + 1] += xa.y * a2v;
            aa[q * 4 + 2] += xa.z * a2v; aa[q * 4 + 3] += xa.w * a2v;
          }
        }
      }
      {
        float w0 = p.rw_w0[l * 512 + ch], a0 = p.rw_a0[l * 512 + ch];
#pragma unroll
        for (int t = 0; t < 16; ++t) {
          float lw = -softplusf_(-(w0 + aw[t])) - 0.5f;
          float u = -__expf(lw);
          p.RWX[(long)(m0 + t) * 1536 + ch] = f2bf(u);
          aa[t] = sigmoidf_(a0 + aa[t]);
        }
      }
      float rt[16];
      {
        float mj = mu[ch];
        float pv = prev_of(ch);
        u16* col = p.PROJ + (long)m0 * LDP + C_R + ch;
#pragma unroll
        for (int t = 0; t < 16; ++t) {
          float x = bf2f(col[(long)t * LDP]);
          rt[t] = x + (pv - x) * mj;
          pv = x;
        }
#pragma unroll
        for (int t = 0; t < 16; ++t) col[(long)t * LDP] = f2bf(rt[t]);
      }
      {
        float mj = mu[512 + ch];
        float pv = prev_of(512 + ch);
        float kkw = p.rw_kk[l * 512 + ch], kaw = p.rw_ka[l * 512 + ch], rkw = p.rw_rk[l * 512 + ch];
        u16* col = p.PROJ + (long)m0 * LDP + C_K + ch;
        float kt[16];
#pragma unroll
        for (int t = 0; t < 16; ++t) {
          float x = bf2f(col[(long)t * LDP]);
          kt[t] = x + (pv - x) * mj;
          pv = x;
        }
#pragma unroll
        for (int t = 0; t < 16; ++t) {
          float kkv = kt[t] * kkw;
          float ssq = sum64(kkv * kkv);
          float kk = kkv * rsqrtf(ssq + 1e-12f);
          float a = aa[t];
          float kp = kt[t] * (1.f + (a - 1.f) * kaw);
          float rks = sum64(rt[t] * kp * rkw);
          col[(long)t * LDP] = f2bf(kp);
          p.RWX[(long)(m0 + t) * 1536 + 512 + ch] = f2bf(kk);
          p.RWX[(long)(m0 + t) * 1536 + 1024 + ch] = f2bf(kk * a);
          if (lane == 0) p.RKS[(long)(m0 + t) * 8 + head] = rks;
        }
      }
      {
        float mj = mu[1024 + ch];
        float pv = prev_of(1024 + ch);
        u16* col = p.PROJ + (long)m0 * LDP + C_V + ch;
        float vt[16];
#pragma unroll
        for (int t = 0; t < 16; ++t) {
          float x = bf2f(col[(long)t * LDP]);
          vt[t] = x + (pv - x) * mj;
          pv = x;
        }
#pragma unroll
        for (int t = 0; t < 16; ++t) col[(long)t * LDP] = f2bf(vt[t]);
      }
    }
    if (t0 + 16 == seq_len(s)) {
      float* o = p.out + (s < 8 ? O_PSHIFT + ((long)l * 8 + s) * 1792 : O_SSHIFT + ((long)l * 8 + (s - 8)) * 1792);
      for (int j = tid; j < 1792; j += 256) o[j] = bf2f(p.BND[(long)blk * 1792 + j]);
    }
  }
}

__device__ __forceinline__ void scan_rwkv(const Params& p, int l, int s, int h, int q, float* smem) {
  const int tid = opaque_tid(), lane = tid & 63, wid = tid >> 6;
  float* R_ = smem;
  float* W_ = smem + 1024;
  float* K_ = smem + 2048;
  float* A_ = smem + 3072;
  float* B_ = smem + 4096;
  float* V_ = smem + 5120;
  float* O_ = smem + 5376;
  const int rl = wid * 4 + (lane >> 4);
  const int row = q * 16 + rl;
  const int ksl = (lane & 15) * 4;
  const int base = seq_base(s), T = seq_len(s);
  float s0 = 0.f, s1 = 0.f, s2 = 0.f, s3 = 0.f;
  if (s >= 8) {
    const float* st = p.state_rwkv + (((long)l * 8 + (s - 8)) * 8 + h) * 4096 + row * 64 + ksl;
    float4 v = *(const float4*)st;
    s0 = v.x; s1 = v.y; s2 = v.z; s3 = v.w;
  }
  const int stt = tid >> 4, skq = (tid & 15) * 4;
  const int nblk = T / 16;
  ushort4 r4, k4, u4, a4, b4;
  u16 vv;
  {
    const long m = base + stt;
    const u16* pr = p.PROJ + m * LDP;
    const u16* px = p.RWX + m * 1536;
    r4 = *(const ushort4*)(pr + C_R + h * 64 + skq);
    k4 = *(const ushort4*)(pr + C_K + h * 64 + skq);
    u4 = *(const ushort4*)(px + h * 64 + skq);
    a4 = *(const ushort4*)(px + 512 + h * 64 + skq);
    b4 = *(const ushort4*)(px + 1024 + h * 64 + skq);
    vv = pr[C_V + h * 64 + q * 16 + (tid & 15)];
  }
  __syncthreads();
  float* TR_ = smem + 5376 + 512;
  const bool wr = (lane & 15) == 0;
  const int ooff = wr ? rl : (512 + lane);
  const int ostr = wr ? 16 : 0;
  for (int blk = 0; blk < nblk; ++blk) {
    const long m = base + blk * 16 + stt;
    float* Oc = O_ + (blk & 1) * 256;
    {
      *(float4*)(R_ + stt * 64 + skq) = make_float4(bf2f(r4.x), bf2f(r4.y), bf2f(r4.z), bf2f(r4.w));
      *(float4*)(K_ + stt * 64 + skq) = make_float4(bf2f(k4.x), bf2f(k4.y), bf2f(k4.z), bf2f(k4.w));
      *(float4*)(W_ + stt * 64 + skq) =
          make_float4(__expf(bf2f(u4.x)), __expf(bf2f(u4.y)), __expf(bf2f(u4.z)), __expf(bf2f(u4.w)));
      *(float4*)(A_ + stt * 64 + skq) = make_float4(-bf2f(a4.x), -bf2f(a4.y), -bf2f(a4.z), -bf2f(a4.w));
      *(float4*)(B_ + stt * 64 + skq) = make_float4(bf2f(b4.x), bf2f(b4.y), bf2f(b4.z), bf2f(b4.w));
      V_[stt * 16 + (tid & 15)] = bf2f(vv);
    }
    __syncthreads();
    if (blk > 0)
      p.ORW[(m - 16) * 512 + h * 64 + q * 16 + (tid & 15)] = f2bf(O_[((blk - 1) & 1) * 256 + stt * 16 + (tid & 15)]);
    if (blk + 1 < nblk) {
      const u16* pr = p.PROJ + (m + 16) * LDP;
      const u16* px = p.RWX + (m + 16) * 1536;
      r4 = *(const ushort4*)(pr + C_R + h * 64 + skq);
      k4 = *(const ushort4*)(pr + C_K + h * 64 + skq);
      u4 = *(const ushort4*)(px + h * 64 + skq);
      a4 = *(const ushort4*)(px + 512 + h * 64 + skq);
      b4 = *(const ushort4*)(px + 1024 + h * 64 + skq);
      vv = pr[C_V + h * 64 + q * 16 + (tid & 15)];
    }
    __builtin_amdgcn_sched_barrier(0);
#pragma unroll 8
    for (int tt = 0; tt < 16; ++tt) {
      float4 a = *(const float4*)(A_ + tt * 64 + ksl);
      float4 w = *(const float4*)(W_ + tt * 64 + ksl);
      float4 b = *(const float4*)(B_ + tt * 64 + ksl);
      float4 k = *(const float4*)(K_ + tt * 64 + ksl);
      float4 r = *(const float4*)(R_ + tt * 64 + ksl);
      float v = V_[tt * 16 + rl];
      float sa = sum16(fmaf(s0, a.x, fmaf(s1, a.y, fmaf(s2, a.z, s3 * a.w))));
      s0 = fmaf(s0, w.x, fmaf(sa, b.x, v * k.x)); NOPK(s0);
      s1 = fmaf(s1, w.y, fmaf(sa, b.y, v * k.y)); NOPK(s1);
      s2 = fmaf(s2, w.z, fmaf(sa, b.z, v * k.z)); NOPK(s2);
      s3 = fmaf(s3, w.w, fmaf(sa, b.w, v * k.w)); NOPK(s3);
      float o = sum16(fmaf(s0, r.x, fmaf(s1, r.y, fmaf(s2, r.z, s3 * r.w))));
      Oc[ooff + tt * ostr] = o;
    }
    __builtin_amdgcn_sched_barrier(0);
    __syncthreads();
  }
  {
    const long m = base + (nblk - 1) * 16 + stt;
    p.ORW[m * 512 + h * 64 + q * 16 + (tid & 15)] = f2bf(O_[((nblk - 1) & 1) * 256 + stt * 16 + (tid & 15)]);
  }
  __syncthreads();
  {
    float* o = p.out + (s < 8 ? O_PRWKV + (((long)l * 8 + s) * 8 + h) * 4096
                              : O_SRWKV + (((long)l * 8 + (s - 8)) * 8 + h) * 4096);
    *(float4*)(o + row * 64 + ksl) = make_float4(s0, s1, s2, s3);
  }
}

__device__ __forceinline__ void scan_hgrn(const Params& p, int l, int s, int h, int q, float* smem) {
  const int tid = opaque_tid(), lane = tid & 63, wid = tid >> 6;
  float* Q_ = smem;
  float* F_ = smem + 2048;
  float* G_ = smem + 4096;
  float* I_ = smem + 6144;
  float* O_ = smem + 6400;
  const int rl = wid * 4 + (lane >> 4);
  const int row = q * 16 + rl;
  const int ksl4 = (lane & 15) * 4;
  const int base = seq_base(s), T = seq_len(s);
  float st[8];
#pragma unroll
  for (int i = 0; i < 8; ++i) st[i] = 0.f;
  if (s >= 8) {
    const float* sp = p.state_hgrn + (((long)l * 8 + (s - 8)) * 4 + h) * 16384;
#pragma unroll
    for (int i = 0; i < 8; ++i) st[i] = sp[((i >> 2) * 64 + ksl4 + (i & 3)) * 128 + row];
  }
  const int stt = tid >> 4, skq = (tid & 15) * 8;
  float lb[8];
#pragma unroll
  for (int i = 0; i < 8; ++i) {
    if (l == 0) lb[i] = 0.f;
    else {
      float x0 = p.hg_lb[h * 128 + skq + i], x1 = p.hg_lb[512 + h * 128 + skq + i];
      lb[i] = frcp_(1.f + __expf(x0 - x1));
    }
  }
  const int nblk = T / 16;
  uint4 q8, f8;
  u16 iv16;
  {
    const u16* pr = p.PROJ + (long)(base + stt) * LDP;
    q8 = *(const uint4*)(pr + C_Q + h * 128 + skq);
    f8 = *(const uint4*)(pr + C_F + h * 128 + skq);
    iv16 = pr[C_I + h * 128 + q * 16 + (tid & 15)];
  }
  __syncthreads();
  float* TR_ = smem + 6400 + 512;
  const bool wr = (lane & 15) == 0;
  const int ooff = wr ? rl : (512 + lane);
  const int ostr = wr ? 16 : 0;
  for (int blk = 0; blk < nblk; ++blk) {
    const long m = base + blk * 16 + stt;
    float* Oc = O_ + (blk & 1) * 256;
    {
      unsigned qw[4] = {q8.x, q8.y, q8.z, q8.w}, fw[4] = {f8.x, f8.y, f8.z, f8.w};
      float qv[8], fv[8], gv[8];
#pragma unroll
      for (int e = 0; e < 8; ++e) {
        qv[e] = bf2f((u16)((qw[e >> 1] >> ((e & 1) * 16)) & 0xffff));
        float fz = bf2f((u16)((fw[e >> 1] >> ((e & 1) * 16)) & 0xffff));
        float ex = __expf(-fz);
        float sg = frcp_(1.f + ex);
        float sgn = ex * sg;
        fv[e] = lb[e] + (1.f - lb[e]) * sg;
        gv[e] = (1.f - lb[e]) * sgn;
      }
      *(float4*)(Q_ + stt * 128 + skq) = make_float4(qv[0], qv[1], qv[2], qv[3]);
      *(float4*)(Q_ + stt * 128 + skq + 4) = make_float4(qv[4], qv[5], qv[6], qv[7]);
      *(float4*)(F_ + stt * 128 + skq) = make_float4(fv[0], fv[1], fv[2], fv[3]);
      *(float4*)(F_ + stt * 128 + skq + 4) = make_float4(fv[4], fv[5], fv[6], fv[7]);
      *(float4*)(G_ + stt * 128 + skq) = make_float4(gv[0], gv[1], gv[2], gv[3]);
      *(float4*)(G_ + stt * 128 + skq + 4) = make_float4(gv[4], gv[5], gv[6], gv[7]);
      I_[stt * 16 + (tid & 15)] = bf2f(iv16);
    }
    __syncthreads();
    if (blk > 0) {
      u16* dp = p.PROJ + (m - 16) * LDP + C_I + h * 128 + q * 16 + (tid & 15);
      *dp = f2bf(O_[((blk - 1) & 1) * 256 + stt * 16 + (tid & 15)]);
    }
    if (blk + 1 < nblk) {
      const u16* pr = p.PROJ + (m + 16) * LDP;
      q8 = *(const uint4*)(pr + C_Q + h * 128 + skq);
      f8 = *(const uint4*)(pr + C_F + h * 128 + skq);
      iv16 = pr[C_I + h * 128 + q * 16 + (tid & 15)];
    }
    __builtin_amdgcn_sched_barrier(0);
#pragma unroll 4
    for (int tt = 0; tt < 16; ++tt) {
      float iv = I_[tt * 16 + rl];
      float acc = 0.f;
#pragma unroll
      for (int hlf = 0; hlf < 2; ++hlf) {
        float4 f = *(const float4*)(F_ + tt * 128 + hlf * 64 + ksl4);
        float4 g = *(const float4*)(G_ + tt * 128 + hlf * 64 + ksl4);
        float4 qq = *(const float4*)(Q_ + tt * 128 + hlf * 64 + ksl4);
        st[hlf * 4 + 0] = fmaf(st[hlf * 4 + 0], f.x, g.x * iv); NOPK(st[hlf * 4 + 0]);
        st[hlf * 4 + 1] = fmaf(st[hlf * 4 + 1], f.y, g.y * iv); NOPK(st[hlf * 4 + 1]);
        st[hlf * 4 + 2] = fmaf(st[hlf * 4 + 2], f.z, g.z * iv); NOPK(st[hlf * 4 + 2]);
        st[hlf * 4 + 3] = fmaf(st[hlf * 4 + 3], f.w, g.w * iv); NOPK(st[hlf * 4 + 3]);
        acc = fmaf(st[hlf * 4 + 0], qq.x, fmaf(st[hlf * 4 + 1], qq.y, fmaf(st[hlf * 4 + 2], qq.z, fmaf(st[hlf * 4 + 3], qq.w, acc))));
      }
      float o = sum16(acc);
      Oc[ooff + tt * ostr] = o;
    }
    __builtin_amdgcn_sched_barrier(0);
    __syncthreads();
  }
  {
    const long m = base + (nblk - 1) * 16 + stt;
    u16* dp = p.PROJ + m * LDP + C_I + h * 128 + q * 16 + (tid & 15);
    *dp = f2bf(O_[((nblk - 1) & 1) * 256 + stt * 16 + (tid & 15)]);
  }
  __syncthreads();
  {
    float* o = p.out + (s < 8 ? O_PHGRN + (((long)l * 8 + s) * 4 + h) * 16384
                              : O_SHGRN + (((long)l * 8 + (s - 8)) * 4 + h) * 16384);
#pragma unroll
    for (int i = 0; i < 8; ++i) o[((i >> 2) * 64 + ksl4 + (i & 3)) * 128 + row] = st[i];
  }
}

__device__ __forceinline__ void scan_ssd(const Params& p, int l, int s, int h, int q, float* smem) {
  const int tid = opaque_tid(), lane = tid & 63, wid = tid >> 6;
  float* B_ = smem;
  float* C_ = smem + 2048;
  float* X_ = smem + 4096;
  float* O_ = smem + 4352;
  float* DT_ = smem + 5200;
  float* DE_ = smem + 5216;
  const int rl = wid * 4 + (lane >> 4);
  const int row = q * 16 + rl;
  const int ksl4 = (lane & 15) * 4;
  const int g = h >> 2;
  const int base = seq_base(s), T = seq_len(s);
  float st[8];
#pragma unroll
  for (int i = 0; i < 8; ++i) st[i] = 0.f;
  if (s >= 8) {
    const float* sp = p.state_ssm + (((long)l * 8 + (s - 8)) * 8 + h) * 8192 + row * 128 + ksl4;
    float4 a = *(const float4*)sp, b = *(const float4*)(sp + 64);
    st[0] = a.x; st[1] = a.y; st[2] = a.z; st[3] = a.w; st[4] = b.x; st[5] = b.y; st[6] = b.z; st[7] = b.w;
  }
  const int xc_bc = (tid < 128) ? (512 + g * 128 + tid) : (768 + g * 128 + (tid - 128));
  const float* cw = p.conv_w + (long)l * 4 * 1024;
  const float cb0 = cw[xc_bc], cb1 = cw[1024 + xc_bc], cb2 = cw[2048 + xc_bc], cb3 = cw[3072 + xc_bc];
  const float cbb = p.conv_b[l * 1024 + xc_bc];
  float u3 = 0.f, u2 = 0.f, u1 = 0.f;
  const int xc_x = h * 64 + q * 16 + (tid & 15);
  const float cx0 = cw[xc_x], cx1 = cw[1024 + xc_x], cx2 = cw[2048 + xc_x], cx3 = cw[3072 + xc_x];
  const float cxb = p.conv_b[l * 1024 + xc_x];
  float x3 = 0.f, x2 = 0.f, x1 = 0.f;
  if (s >= 8) {
    const float* sc = p.state_conv + ((long)l * 8 + (s - 8)) * 3 * 1024;
    u3 = sc[xc_bc]; u2 = sc[1024 + xc_bc]; u1 = sc[2048 + xc_bc];
    x3 = sc[xc_x]; x2 = sc[1024 + xc_x]; x1 = sc[2048 + xc_x];
  }
  const float dtb = p.dt_bias[l * 8 + h];
  const float aexp = __expf(p.a_log[l * 8 + h]);
  const float dsk = p.d_skip[l * 8 + h];
  const int stt = tid >> 4;
  const int nblk = T / 16;
  u16 raw[16];
  float xr[4];
  float dtr = 0.f;
  u16 zc = 0, zn = 0;
#define SSD_LOAD(M0)                                                              \
  {                                                                               \
    const u16* col = p.PROJ + (long)(M0) * LDP + C_XBC + xc_bc;                   \
    _Pragma("unroll") for (int t = 0; t < 16; ++t) raw[t] = col[(long)t * LDP];   \
    {                                                                             \
      const long mr = (long)(M0) + stt;                                           \
      const u16* colx = p.PROJ + mr * LDP + C_XBC + xc_x;                         \
      _Pragma("unroll") for (int j = 0; j < 4; ++j) {                             \
        const long mm = mr - 3 + j;                                               \
        float vx;                                                                 \
        if (mm >= base) vx = bf2f(colx[(long)(j - 3) * LDP]);                     \
        else vx = (s >= 8) ? p.state_conv[((long)l * 8 + (s - 8)) * 3072 + (3 + (int)(mm - base)) * 1024 + xc_x] : 0.f; \
        xr[j] = vx;                                                               \
      }                                                                           \
    }                                                                             \
    if (tid < 16) dtr = p.DTRAW[((long)(M0) + tid) * 8 + h];                      \
    zn = p.PROJ[((long)(M0) + stt) * LDP + C_Z + h * 64 + q * 16 + (tid & 15)];   \
  }
#pragma unroll
  for (int t = 0; t < 16; ++t) raw[t] = 0;
  SSD_LOAD(base);
  __syncthreads();
  const bool wr = (lane & 15) == 0;
  const int ooff = wr ? rl : (512 + lane);
  const int ostr = wr ? 16 : 0;
  u16 zp = 0;
  for (int blk = 0; blk < nblk; ++blk) {
    const long m0 = base + blk * 16;
    zp = zc;
    zc = zn;
    float* Oc = O_ + (blk & 1) * 256;
    {
      float* dst = (tid < 128) ? (B_ + tid) : (C_ + (tid - 128));
#pragma unroll
      for (int t = 0; t < 16; ++t) {
        float u0 = bf2f(raw[t]);
        float y = cb0 * u3 + cb1 * u2 + cb2 * u1 + cb3 * u0 + cbb;
        dst[t * 128] = siluf_(y);
        u3 = u2; u2 = u1; u1 = u0;
      }
      {
        float y = cx0 * xr[0] + cx1 * xr[1] + cx2 * xr[2] + cx3 * xr[3] + cxb;
        X_[stt * 16 + (tid & 15)] = siluf_(y);
      }
      if (tid < 16) {
        float dtv = softplusf_(dtr + dtb);
        DT_[tid] = dtv;
        DE_[tid] = __expf(-aexp * dtv);
      }
    }
    __syncthreads();
    if (blk > 0) {
      u16* pz = p.PROJ + (m0 - 16 + stt) * LDP + C_Z + h * 64 + q * 16 + (tid & 15);
      *pz = f2bf(O_[((blk - 1) & 1) * 256 + stt * 16 + (tid & 15)] * siluf_(bf2f(zp)));
    }
    if (blk + 1 < nblk) SSD_LOAD(m0 + 16);
    __builtin_amdgcn_sched_barrier(0);
#pragma unroll 4
    for (int tt = 0; tt < 16; ++tt) {
      float xv = X_[tt * 16 + rl];
      float xd = xv * DT_[tt];
      float de = DE_[tt];
      float acc = 0.f;
#pragma unroll
      for (int hlf = 0; hlf < 2; ++hlf) {
        float4 b = *(const float4*)(B_ + tt * 128 + hlf * 64 + ksl4);
        float4 c = *(const float4*)(C_ + tt * 128 + hlf * 64 + ksl4);
        st[hlf * 4 + 0] = fmaf(st[hlf * 4 + 0], de, xd * b.x); NOPK(st[hlf * 4 + 0]);
        st[hlf * 4 + 1] = fmaf(st[hlf * 4 + 1], de, xd * b.y); NOPK(st[hlf * 4 + 1]);
        st[hlf * 4 + 2] = fmaf(st[hlf * 4 + 2], de, xd * b.z); NOPK(st[hlf * 4 + 2]);
        st[hlf * 4 + 3] = fmaf(st[hlf * 4 + 3], de, xd * b.w); NOPK(st[hlf * 4 + 3]);
        acc = fmaf(st[hlf * 4 + 0], c.x, fmaf(st[hlf * 4 + 1], c.y, fmaf(st[hlf * 4 + 2], c.z, fmaf(st[hlf * 4 + 3], c.w, acc))));
      }
      float y = sum16(acc);
      Oc[ooff + tt * ostr] = y + dsk * xv;
    }
    __builtin_amdgcn_sched_barrier(0);
    __syncthreads();
  }
  {
    const long m0 = base + (nblk - 1) * 16;
    u16* pz = p.PROJ + (m0 + stt) * LDP + C_Z + h * 64 + q * 16 + (tid & 15);
    *pz = f2bf(O_[((nblk - 1) & 1) * 256 + stt * 16 + (tid & 15)] * siluf_(bf2f(zc)));
  }
  __syncthreads();
#undef SSD_LOAD
  {
    float* o = p.out + (s < 8 ? O_PSSM + (((long)l * 8 + s) * 8 + h) * 8192
                              : O_SSSM + (((long)l * 8 + (s - 8)) * 8 + h) * 8192);
    *(float4*)(o + row * 128 + ksl4) = make_float4(st[0], st[1], st[2], st[3]);
    *(float4*)(o + row * 128 + 64 + ksl4) = make_float4(st[4], st[5], st[6], st[7]);
  }
  if (h == 0 && q == 0) {
    float* o = p.out + (s < 8 ? O_PCONV + ((long)l * 8 + s) * 3072 : O_SCONV + ((long)l * 8 + (s - 8)) * 3072);
    for (int i = tid; i < 3072; i += 256) {
      int r = i >> 10, c = i & 1023;
      o[i] = bf2f(p.PROJ[(long)(base + T - 3 + r) * LDP + C_XBC + c]);
    }
  }
}

__device__ __forceinline__ void phase_scan(const Params& p, int l, float* smem) {
  for (int u = BID, nb_ = NBLK; u < 1536; u += nb_) {
    int sample = u >= 768;
    int v = sample ? u - 768 : u;
    int type = v % 3, w = v / 3;
    if (type == 0) {
      int q = w & 3, h = (w >> 2) & 7, b = w >> 5;
      scan_rwkv(p, l, b + 8 * sample, h, q, smem);
    } else if (type == 1) {
      int q = w & 7, h = (w >> 3) & 3, b = w >> 5;
      scan_hgrn(p, l, b + 8 * sample, h, q, smem);
    } else {
      int q = w & 3, h = (w >> 2) & 7, b = w >> 5;
      scan_ssd(p, l, b + 8 * sample, h, q, smem);
    }
  }
}

__device__ __forceinline__ void phase_post(const Params& p, int l, float* smem) {
  const int tid = opaque_tid(), lane = tid & 63, wid = tid >> 6;
  float* SG = smem;
  float* RED = smem + 2048;
  for (int blk = BID, nb_ = NBLK; blk < NBLK16; blk += nb_) {
    const long m0 = (long)blk * 16;
    __syncthreads();
    if (tid < 128) {
      const u16* col = p.PROJ + m0 * LDP + C_XG + tid;
#pragma unroll
      for (int t = 0; t < 16; ++t) SG[tid * 16 + t] = bf2f(col[(long)t * LDP]);
    }
    float ys[2][16], oh[2][16];
#pragma unroll
    for (int c = 0; c < 2; ++c) {
      int ch = tid + 256 * c;
#pragma unroll
      for (int t = 0; t < 16; ++t) {
        ys[c][t] = bf2f(p.PROJ[(m0 + t) * LDP + C_Z + ch]);
        oh[c][t] = bf2f(p.PROJ[(m0 + t) * LDP + C_I + ch]);
      }
    }
#pragma unroll
    for (int t = 0; t < 16; ++t) {
      float a0 = sum64(ys[0][t] * ys[0][t]), a1 = sum64(ys[1][t] * ys[1][t]);
      float b0 = sum64(oh[0][t] * oh[0][t]), b1 = sum64(oh[1][t] * oh[1][t]);
      if (lane == 0) *(float4*)(RED + (wid * 16 + t) * 4) = make_float4(a0, a1, b0, b1);
    }
    __syncthreads();
    {
      const float nw0 = p.ssd_norm_w[l * 512 + tid], nw1 = p.ssd_norm_w[l * 512 + tid + 256];
      const float hw0 = p.hg_norm_w[l * 512 + tid], hw1 = p.hg_norm_w[l * 512 + tid + 256];
      const int pw = (wid >> 1) * 2;
#pragma unroll
      for (int t = 0; t < 16; ++t) {
        float4 r0 = *(const float4*)(RED + (0 * 16 + t) * 4), r1 = *(const float4*)(RED + (1 * 16 + t) * 4);
        float4 r2 = *(const float4*)(RED + (2 * 16 + t) * 4), r3 = *(const float4*)(RED + (3 * 16 + t) * 4);
        float g0 = r0.x + r1.x + r2.x + r3.x, g1 = r0.y + r1.y + r2.y + r3.y;
        float4 pa = *(const float4*)(RED + (pw * 16 + t) * 4), pb = *(const float4*)(RED + ((pw + 1) * 16 + t) * 4);
        float h0 = pa.z + pb.z, h1 = pa.w + pb.w;
        u16* rowp = p.PROJ + (m0 + t) * LDP;
        rowp[C_Z + tid] = f2bf(ys[0][t] * rsqrtf(g0 * (1.f / 256.f) + 1e-6f) * nw0);
        rowp[C_Z + tid + 256] = f2bf(ys[1][t] * rsqrtf(g1 * (1.f / 256.f) + 1e-6f) * nw1);
        float gg0 = bf2f(rowp[C_GG + tid]), gg1 = bf2f(rowp[C_GG + tid + 256]);
        rowp[C_GG + tid] = f2bf(oh[0][t] * rsqrtf(h0 * (1.f / 128.f) + 1e-6f) * hw0 * siluf_(gg0));
        rowp[C_GG + tid + 256] = f2bf(oh[1][t] * rsqrtf(h1 * (1.f / 128.f) + 1e-6f) * hw1 * siluf_(gg1));
      }
    }
    float ga[2][16];
#pragma unroll
    for (int c = 0; c < 2; ++c)
#pragma unroll
      for (int t = 0; t < 16; ++t) ga[c][t] = 0.f;
    {
      const float* g2 = p.rw_g2 + (long)l * 128 * 512;
      for (int i = 0; i < 128; ++i) {
        float gv[2] = {g2[i * 512 + tid], g2[i * 512 + tid + 256]};
#pragma unroll
        for (int q = 0; q < 4; ++q) {
          float4 x = *(const float4*)(SG + i * 16 + q * 4);
#pragma unroll
          for (int c = 0; c < 2; ++c) {
            ga[c][q * 4 + 0] += x.x * gv[c]; ga[c][q * 4 + 1] += x.y * gv[c];
            ga[c][q * 4 + 2] += x.z * gv[c]; ga[c][q * 4 + 3] += x.w * gv[c];
          }
        }
      }
    }
#pragma unroll
    for (int c = 0; c < 2; ++c) {
      int ch = tid + 256 * c, head = wid + 4 * c;
      float lw = p.rw_lnx_w[l * 512 + ch], lbv = p.rw_lnx_b[l * 512 + ch];
#pragma unroll
      for (int t = 0; t < 16; ++t) {
        float o = bf2f(p.ORW[(m0 + t) * 512 + ch]);
        float mean = sum64(o) * (1.f / 64.f);
        float d = o - mean;
        float var = sum64(d * d) * (1.f / 64.f);
        float ln = d * rsqrtf(var + 64e-5f) * lw + lbv;
        float v = bf2f(p.PROJ[(m0 + t) * LDP + C_V + ch]);
        float bonus = p.RKS[(m0 + t) * 8 + head] * v;
        p.PROJ[(m0 + t) * LDP + C_R + ch] = f2bf((ln + bonus) * ga[c][t]);
      }
    }
  }
}

__device__ __forceinline__ void phase_final(const Params& p) {
  const int tid = opaque_tid(), lane = tid & 63, wid = tid >> 6;
  for (int m = BID * 4 + wid, nb_ = NBLK; m < M_TOT; m += nb_ * 4) {
    float* dst;
    if (m < M_PROMPT) {
      int b = m / T_P, t = m - b * T_P;
      if (t < 16) continue;
      dst = p.out + O_YP + ((long)b * 4096 + (t - 16)) * DM;
    } else {
      dst = p.out + O_YS + (long)(m - M_PROMPT) * DM;
    }
    float x[16];
    float ss = 0.f;
#pragma unroll
    for (int j = 0; j < 2; ++j) {
      uint4 raw = *(const uint4*)(p.XB + (long)m * DM + lane * 8 + 512 * j);
      unsigned wv[4] = {raw.x, raw.y, raw.z, raw.w};
#pragma unroll
      for (int e = 0; e < 8; ++e) {
        x[j * 8 + e] = bf2f((u16)((wv[e >> 1] >> ((e & 1) * 16)) & 0xffff));
        ss += x[j * 8 + e] * x[j * 8 + e];
      }
    }
    ss = sum64(ss);
    float rs = rsqrtf(ss * (1.f / 1024.f) + 1e-6f);
#pragma unroll
    for (int j = 0; j < 2; ++j) {
      int k0 = lane * 8 + 512 * j;
      float4 w0 = *(const float4*)(p.final_w + k0), w1 = *(const float4*)(p.final_w + k0 + 4);
      *(float4*)(dst + k0) = make_float4(x[j * 8 + 0] * rs * w0.x, x[j * 8 + 1] * rs * w0.y, x[j * 8 + 2] * rs * w0.z,
                                         x[j * 8 + 3] * rs * w0.w);
      *(float4*)(dst + k0 + 4) = make_float4(x[j * 8 + 4] * rs * w1.x, x[j * 8 + 5] * rs * w1.y,
                                             x[j * 8 + 6] * rs * w1.z, x[j * 8 + 7] * rs * w1.w);
    }
  }
}


#define XB_TMO      128
#define XB_XCNT(j)  (256  + 64 * (j))
#define XB_XSUB(j)  (1280 + 64 * (j))
#define XB_XGEN(j)  (2304 + 64 * (j))
#define XB_TOP      3328
#define XB_TOPGEN   3392
#define XCD_BAR_WORDS 3456
#define XB_SPIN_CAP (1u << 22)
__device__ __forceinline__ unsigned xb_ld(unsigned* p) { return __hip_atomic_load(p, __ATOMIC_RELAXED, __HIP_MEMORY_SCOPE_AGENT); }
__device__ __forceinline__ unsigned xb_add(unsigned* p, unsigned v) { return __hip_atomic_fetch_add(p, v, __ATOMIC_RELAXED, __HIP_MEMORY_SCOPE_AGENT); }
__device__ __forceinline__ unsigned xb_xcc_id() { return (unsigned)__builtin_amdgcn_s_getreg((3 << 11) | 20) & 0xFu; }
#define XB_SPIN(cond, bar) do { unsigned _sp = 0; while (cond) { __builtin_amdgcn_s_sleep(1); \
    if ((++_sp & 255u) == 0u) { if (xb_ld(&(bar)[XB_TMO])) break; if (_sp > XB_SPIN_CAP) { atomicAdd(&(bar)[XB_TMO], 1u); break; } } } } while (0)

__device__ __forceinline__ void xcd_barrier_post(unsigned* bar) {
  if (threadIdx.x == 0) (void)xb_add(&bar[XB_XCNT(xb_xcc_id())], 1u);
}
__device__ __forceinline__ void xcd_barrier_complete(unsigned* bar, unsigned x, unsigned& nloc, unsigned& nx) {
  const unsigned G = gridDim.x;
  unsigned sum, cnt, mine, sp = 0u;
  for (;;) {
    sum = 0u; cnt = 0u; mine = 0u;
#pragma unroll
    for (unsigned j = 0; j < 16; ++j) { const unsigned c = xb_ld(&bar[XB_XCNT(j)]); sum += c; cnt += (c > 0u) ? 1u : 0u; mine = (j == x) ? c : mine; }
    if (sum == G) break;
    __builtin_amdgcn_s_sleep(1);
    if ((++sp & 255u) == 0u) { if (xb_ld(&bar[XB_TMO])) break; if (sp > XB_SPIN_CAP) { atomicAdd(&bar[XB_TMO], 1u); break; } }
  }
  nloc = mine > 0u ? mine : 1u; nx = cnt > 0u ? cnt : 1u;
}
__device__ __forceinline__ void xcd_barrier(unsigned* bar, volatile unsigned* st) {
  asm volatile("s_waitcnt vmcnt(0)" ::: "memory");
  __syncthreads();
  if (threadIdx.x == 0) {
    __builtin_amdgcn_s_waitcnt(0);
    const unsigned x = xb_xcc_id();
    unsigned nloc = st[0], nx = st[1];
    if (nloc == 0u) { xcd_barrier_complete(bar, x, nloc, nx); st[0] = nloc; st[1] = nx; }
    const unsigned old = xb_add(&bar[XB_XSUB(x)], 1u);
    const unsigned gen = old / nloc;
    if (old + 1u == (gen + 1u) * nloc) {
      __builtin_amdgcn_fence(__ATOMIC_RELEASE, "agent");
      asm volatile("s_waitcnt vmcnt(0)" ::: "memory");
      const unsigned og = xb_add(&bar[XB_TOP], 1u);
      const unsigned tg = og / nx;
      if (og + 1u == (tg + 1u) * nx) xb_add(&bar[XB_TOPGEN], 1u);
      else XB_SPIN(xb_ld(&bar[XB_TOPGEN]) == tg, bar);
      __builtin_amdgcn_fence(__ATOMIC_ACQUIRE, "agent");
      xb_add(&bar[XB_XGEN(x)], 1u);
      asm volatile("s_waitcnt vmcnt(0)" ::: "memory");
    } else {
      XB_SPIN(xb_ld(&bar[XB_XGEN(x)]) == gen, bar);
      __builtin_amdgcn_fence(__ATOMIC_ACQUIRE, "agent");
      asm volatile("s_waitcnt vmcnt(0)" ::: "memory");
    }
  }
  __syncthreads();
}

constexpr int SMEM_BYTES = 40960;
__device__ __forceinline__ void run_phase(const Params& p, int ph, char* smem) {
  if (ph == 0) { phase_embed(p); return; }
  if (ph == 19) { phase_final(p); return; }
  int l = (ph - 1) / 9, s = (ph - 1) % 9;
  float* fs = (float*)smem;
  switch (s) {
    case 0: phase_convert(p, l, fs); phase_rowstat<true>(p, l, fs); break;
    case 1: phase_gemm<1>(p, p.XB, DM, p.W1T, 1024, LDP / 128, smem); break;
    case 2: phase_pre(p, l, fs); break;
    case 3: phase_scan(p, l, fs); break;
    case 4: phase_post(p, l, fs); break;
    case 5: phase_gemm<2>(p, p.PROJ, LDP, p.WOT, 1536, 8, smem); break;
    case 6: phase_rowstat<false>(p, l, fs); break;
    case 7: phase_gemm<3>(p, p.XB, DM, p.WGU, 1024, 44, smem); break;
    case 8: phase_gemm<2>(p, p.PROJ, D_FF, p.WDT, D_FF, 8, smem); break;
  }
}
constexpr int N_PHASES = 20;

#if MEGA
__global__ void __launch_bounds__(256, 3) k_mega(Params p) {
  __shared__ __attribute__((aligned(16))) char smem[SMEM_BYTES];
  __shared__ uint4 xb_words;
  if (threadIdx.x == 0) { xb_words = make_uint4(0u, 0u, 0u, 0u); }
  __syncthreads();
  cg::grid_group grid = cg::this_grid();
  float* fs = (float*)smem;
  volatile unsigned* xst = (volatile unsigned*)&xb_words;
  xcd_barrier_post(p.bar);
  phase_embed(p);
  grid.sync();
#define GSYNC() do { unsigned* b_ = p.bar; asm volatile("" : "+s"(b_)); xcd_barrier(b_, xst); } while (0)
#pragma unroll 1
  for (int l0 = 0; l0 < 2; ++l0) {
    int l = opaque_s(l0);
    phase_convert(p, l, fs);
    phase_rowstat<true>(p, l, fs);
    GSYNC();
    l = opaque_s(l);
    phase_gemm<1>(p, p.XB, DM, p.W1T, 1024, LDP / 128, smem);
    GSYNC();
    l = opaque_s(l);
    phase_pre(p, l, fs);
    GSYNC();
    l = opaque_s(l);
    phase_scan(p, l, fs);
    GSYNC();
    l = opaque_s(l);
    phase_post(p, l, fs);
    GSYNC();
    l = opaque_s(l);
    phase_gemm<2>(p, p.PROJ, LDP, p.WOT, 1536, 8, smem);
    GSYNC();
    l = opaque_s(l);
    phase_rowstat<false>(p, l, fs);
    GSYNC();
    l = opaque_s(l);
    phase_gemm<3>(p, p.XB, DM, p.WGU, 1024, 44, smem);
    GSYNC();
    l = opaque_s(l);
    phase_gemm<2>(p, p.PROJ, D_FF, p.WDT, D_FF, 8, smem);
    GSYNC();
  }
  phase_final(p);
}
#else
template <int PH>
__global__ void __launch_bounds__(256, 3) k_phase(Params p) {
  __shared__ __attribute__((aligned(16))) char smem[SMEM_BYTES];
  run_phase(p, PH, smem);
}
template <int PH>
static void launch_all(const Params& p, int grid, hipStream_t stream) {
  hipLaunchKernelGGL(k_phase<PH>, dim3(grid), dim3(256), 0, stream, p);
  if constexpr (PH + 1 < N_PHASES) launch_all<PH + 1>(p, grid, stream);
}
#endif

extern "C" void kernel_launch(void* const* d_in, const int* in_sizes, int n_in, void* d_out, int out_size, void* d_ws,
                              size_t ws_size, hipStream_t stream) {
  Params p{};
  const float** pf = (const float**)&p;
  for (int i = 0; i < 35; ++i) pf[i] = (const float*)d_in[i];
  p.out = (float*)d_out;
  char* ws = (char*)d_ws;
  size_t off = 0;
  auto take = [&](size_t bytes) { char* r = ws + off; off += (bytes + 255) & ~(size_t)255; return r; };
  p.XB = (u16*)take((size_t)M_TOT * DM * 2);
  p.PROJ = (u16*)take((size_t)M_TOT * LDP * 2);
  p.W1T = (u16*)take((size_t)LDP * 1024 * 2);
  p.WOT = (u16*)take((size_t)1024 * 1536 * 2);
  p.WGU = (u16*)take((size_t)5632 * 1024 * 2);
  p.WDT = (u16*)take((size_t)1024 * D_FF * 2);
  p.BND = (u16*)take((size_t)NBLK16 * 1792 * 2);
  p.ORW = (u16*)take((size_t)M_TOT * 512 * 2);
  p.RS = (float*)take((size_t)M_TOT * 4);
  p.DTRAW = (float*)take((size_t)M_TOT * 8 * 4);
  p.RKS = (float*)take((size_t)M_TOT * 8 * 4);
  p.bar = (unsigned*)take((size_t)XCD_BAR_WORDS * 4);
  p.RWX = (u16*)d_out;
  if (off > ws_size) fprintf(stderr, "workspace too small: need %zu have %zu\n", off, ws_size);
#if MEGA
  static int grid_blocks = 0;
  if (!grid_blocks) {
    int dev = 0, cus = 0, per_cu = 0;
    hipGetDevice(&dev);
    hipDeviceGetAttribute(&cus, hipDeviceAttributeMultiprocessorCount, dev);
    hipOccupancyMaxActiveBlocksPerMultiprocessor(&per_cu, k_mega, 256, 0);
    if (per_cu > 3) per_cu = 3;
    grid_blocks = cus * per_cu;
  }
  hipMemsetAsync(p.bar, 0, (size_t)XCD_BAR_WORDS * 4, stream);
  void* args[] = {&p};
  hipError_t e = hipLaunchCooperativeKernel((void*)k_mega, dim3(grid_blocks), dim3(256), args, 0, stream);
  if (e != hipSuccess) fprintf(stderr, "cooperative launch failed: %s (grid %d)\n", hipGetErrorString(e), grid_blocks);
#else
  launch_all<0>(p, 768, stream);
#endif
}
```

```cpp
#include <hip/hip_runtime.h>
#include <hip/hip_bf16.h>
#include <hip/hip_cooperative_groups.h>
#include <cstdio>
namespace cg = cooperative_groups;

#ifndef MEGA
#define MEGA 1
#endif

typedef unsigned short u16;
using bf16x8 = __attribute__((ext_vector_type(8))) short;
using f32x16 = __attribute__((ext_vector_type(16))) float;

constexpr int DM = 1024;
constexpr int M_TOT = 33408;
constexpr int M_PROMPT = 32896;
constexpr int T_P = 4112;
constexpr int LDP = 5376;
constexpr int N_IN = 5384;
constexpr int D_FF = 2816;
constexpr int NBLK16 = M_TOT / 16;
constexpr int C_Z = 0, C_R = 512, C_GG = 1024, C_XBC = 1536, C_K = 2560, C_V = 3072, C_XW = 3584, C_XA = 3648,
              C_XG = 3712, C_Q = 3840, C_F = 4352, C_I = 4864;
constexpr long O_YP = 0, O_YS = 33554432, O_PSSM = 34078720, O_PCONV = 35127296, O_PRWKV = 35176448,
               O_PSHIFT = 35700736, O_PHGRN = 35729408, O_SSSM = 36777984, O_SCONV = 37826560,
               O_SRWKV = 37875712, O_SSHIFT = 38400000, O_SHGRN = 38428672;

struct Params {
  const float *x_prompt, *x_sample, *state_ssm, *state_conv, *state_rwkv, *state_shift, *state_hgrn, *meta,
      *norm1_w, *w_in, *conv_w, *conv_b, *dt_bias, *a_log, *d_skip, *ssd_norm_w, *rw_mu, *rw_w0, *rw_w2, *rw_a0,
      *rw_a2, *rw_g2, *rw_kk, *rw_ka, *rw_rk, *rw_lnx_w, *rw_lnx_b, *hg_lb, *hg_norm_w, *w_out, *norm2_w, *w_gate,
      *w_up, *w_down, *final_w;
  float* out;
  u16 *XB, *PROJ, *W1T, *WOT, *WGU, *WDT, *BND, *ORW, *RWX;
  float *RS, *DTRAW, *RKS;
  unsigned* bar;
};

__device__ __forceinline__ u16 f2bf(float f) {
  unsigned u = __float_as_uint(f);
  u += 0x7fffu + ((u >> 16) & 1u);
  return (u16)(u >> 16);
}
__device__ __forceinline__ float bf2f(u16 h) { return __uint_as_float(((unsigned)h) << 16); }
__device__ __forceinline__ float frcp_(float x) { return __builtin_amdgcn_rcpf(x); }
__device__ __forceinline__ float sigmoidf_(float x) { return frcp_(1.f + __expf(-x)); }
__device__ __forceinline__ float siluf_(float x) { return x * frcp_(1.f + __expf(-x)); }
__device__ __forceinline__ float softplusf_(float x) { return x > 20.f ? x : log1pf(__expf(x)); }

template <int CTRL>
__device__ __forceinline__ float dppf(float v) {
  return __int_as_float(__builtin_amdgcn_update_dpp(0, __float_as_int(v), CTRL, 0xF, 0xF, true));
}
__device__ __forceinline__ float sum16(float v) {
  v += dppf<0xB1>(v);
  v += dppf<0x4E>(v);
  v += dppf<0x141>(v);
  v += dppf<0x140>(v);
  return v;
}
__device__ __forceinline__ float sum64(float v) {
  v = sum16(v);
  v += __shfl_xor(v, 16);
  v += __shfl_xor(v, 32);
  return v;
}

#define NOPK(x) asm("" : "+v"(x))
__device__ __forceinline__ int opaque_tid() {
  int t = threadIdx.x;
  asm volatile("" : "+v"(t));
  return t;
}
__device__ __forceinline__ int opaque_s(int v) {
  asm volatile("" : "+s"(v));
  return v;
}
#define BID opaque_s((int)blockIdx.x)
#define NBLK opaque_s((int)gridDim.x)
__device__ __forceinline__ int seq_base(int s) { return s < 8 ? s * T_P : M_PROMPT + (s - 8) * 64; }
__device__ __forceinline__ int seq_len(int s) { return s < 8 ? T_P : 64; }

__device__ __forceinline__ void phase_embed(const Params& p) {
  const long n4 = (long)M_TOT * 256;
  for (long idx = (long)BID * 256 + threadIdx.x, st_ = (long)NBLK * 256; idx < n4; idx += st_) {
    int m = (int)(idx >> 8), c4 = ((int)idx & 255) * 4;
    const float* src;
    if (m < M_PROMPT) {
      int b = m / T_P, t = m - b * T_P;
      src = (t < 16) ? p.meta + (long)t * DM : p.x_prompt + ((long)b * 4096 + (t - 16)) * DM;
    } else {
      src = p.x_sample + (long)(m - M_PROMPT) * DM;
    }
    float4 v = *(const float4*)(src + c4);
    ushort4 o;
    o.x = f2bf(v.x); o.y = f2bf(v.y); o.z = f2bf(v.z); o.w = f2bf(v.w);
    *(ushort4*)(p.XB + (long)m * DM + c4) = o;
  }
}

template <bool HAS_SCALE>
__device__ __forceinline__ void conv_tile(const float* __restrict__ src, int ldsrc, int srccol0, const float* __restrict__ scale,
                          u16* __restrict__ dst, int K, int k0, int n0, float* tile  ) {
  const int tid = opaque_tid();
  __syncthreads();
  {
    int nn = tid & 63, kb = tid >> 6;
#pragma unroll
    for (int i = 0; i < 16; ++i) {
      int kk = kb + 4 * i;
      float v = src[(long)(k0 + kk) * ldsrc + srccol0 + nn];
      if (HAS_SCALE) v *= scale[k0 + kk];
      tile[kk * 65 + nn] = v;
    }
  }
  __syncthreads();
  {
    int nn = tid >> 2, kq = (tid & 3) * 16;
    u16* d = dst + (long)(n0 + nn) * K + k0 + kq;
#pragma unroll
    for (int j = 0; j < 16; j += 2) {
      unsigned w = f2bf(tile[(kq + j) * 65 + nn]) | ((unsigned)f2bf(tile[(kq + j + 1) * 65 + nn]) << 16);
      *(unsigned*)(d + j) = w;
    }
  }
}

__device__ __forceinline__ int w1_srccol(int n0) {
  if (n0 < 512) return n0;
  if (n0 < 1024) return n0 - 512 + 1544;
  if (n0 < 1536) return n0 - 1024 + 4872;
  if (n0 < 2560) return n0 - 1536 + 512;
  if (n0 < 3840) return n0 - 2560 + 2056;
  return n0 - 3840 + 3336;
}

constexpr int CV_W1 = 16 * 84, CV_WO = 24 * 16, CV_WGU = 16 * 88, CV_WD = 44 * 16;
constexpr int CV_TOTAL = CV_W1 + CV_WO + CV_WGU + CV_WD;

__device__ __forceinline__ void phase_convert(const Params& p, int l, float* smem) {
  for (int u = BID, nb_ = NBLK; u < CV_TOTAL; u += nb_) {
    if (u < CV_W1) {
      int kt = u % 16, nt = u / 16;
      conv_tile<true>(p.w_in + (long)l * DM * N_IN, N_IN, w1_srccol(nt * 64), p.norm1_w + l * DM, p.W1T, 1024, kt * 64,
                nt * 64, smem);
    } else if (u < CV_W1 + CV_WO) {
      int v = u - CV_W1;
      int kt = v % 24, nt = v / 24;
      conv_tile<false>(p.w_out + (long)l * 1536 * DM, DM, nt * 64, nullptr, p.WOT, 1536, kt * 64, nt * 64, smem);
    } else if (u < CV_W1 + CV_WO + CV_WGU) {
      int v = u - CV_W1 - CV_WO;
      int kt = v % 16, nt = v / 16;
      const float* wg = p.w_gate + (long)l * DM * D_FF;
      const float* wu = p.w_up + (long)l * DM * D_FF;
      const float* sc = p.norm2_w + l * DM;
      const int tid = opaque_tid();
      __syncthreads();
      {
        int nn = tid & 63, kb = tid >> 6;
        const float* src = (nn < 32) ? wg : wu;
        int col = nt * 32 + (nn & 31);
#pragma unroll
        for (int i = 0; i < 16; ++i) {
          int kk = kb + 4 * i;
          smem[kk * 65 + nn] = src[(long)(kt * 64 + kk) * D_FF + col] * sc[kt * 64 + kk];
        }
      }
      __syncthreads();
      {
        int nn = tid >> 2, kq = (tid & 3) * 16;
        u16* d = p.WGU + (long)(nt * 64 + nn) * 1024 + kt * 64 + kq;
#pragma unroll
        for (int j = 0; j < 16; j += 2) {
          unsigned w = f2bf(smem[(kq + j) * 65 + nn]) | ((unsigned)f2bf(smem[(kq + j + 1) * 65 + nn]) << 16);
          *(unsigned*)(d + j) = w;
        }
      }
    } else {
      int v = u - CV_W1 - CV_WO - CV_WGU;
      int kt = v % 44, nt = v / 44;
      conv_tile<false>(p.w_down + (long)l * D_FF * DM, DM, nt * 64, nullptr, p.WDT, D_FF, kt * 64, nt * 64, smem);
    }
  }
}

template <bool WITH_DT>
__device__ __forceinline__ void phase_rowstat(const Params& p, int l, float* smem) {
  const int tid = opaque_tid(), lane = tid & 63, wid = tid >> 6;
  float* dtw = smem;
  if (WITH_DT) {
    __syncthreads();
    const float* w = p.w_in + (long)l * DM * N_IN + 1536;
    const float* nw = p.norm1_w + l * DM;
    for (int i = tid; i < 8192; i += 256) {
      int k = i >> 3, h = i & 7;
      dtw[i] = w[(long)k * N_IN + h] * nw[k];
    }
    __syncthreads();
  }
  for (int blk = BID, nb_ = NBLK; blk < NBLK16; blk += nb_) {
    for (int rr = wid; rr < 16; rr += 4) {
      int m = blk * 16 + rr;
      float ss = 0.f;
      float d[8];
#pragma unroll
      for (int h = 0; h < 8; ++h) d[h] = 0.f;
#pragma unroll 1
      for (int j = 0; j < 4; ++j) {
        int k0 = lane * 4 + 256 * j;
        uint2 raw = *(const uint2*)(p.XB + (long)m * DM + k0);
        float xs[4] = {bf2f((u16)(raw.x & 0xffff)), bf2f((u16)(raw.x >> 16)), bf2f((u16)(raw.y & 0xffff)),
                       bf2f((u16)(raw.y >> 16))};
#pragma unroll
        for (int e = 0; e < 4; ++e) {
          float x = xs[e];
          ss += x * x;
          if (WITH_DT) {
            float4 w0 = *(const float4*)(dtw + (k0 + e) * 8);
            float4 w1 = *(const float4*)(dtw + (k0 + e) * 8 + 4);
            d[0] += x * w0.x; d[1] += x * w0.y; d[2] += x * w0.z; d[3] += x * w0.w;
            d[4] += x * w1.x; d[5] += x * w1.y; d[6] += x * w1.z; d[7] += x * w1.w;
          }
        }
      }
      ss = sum64(ss);
      float rs = rsqrtf(ss * (1.f / 1024.f) + 1e-6f);
      if (WITH_DT) {
#pragma unroll
        for (int h = 0; h < 8; ++h) d[h] = sum64(d[h]);
        if (lane == 0) {
#pragma unroll
          for (int h = 0; h < 8; ++h) p.DTRAW[(long)m * 8 + h] = d[h] * rs;
        }
      }
      if (lane == 0) p.RS[m] = rs;
    }
  }
}

constexpr int G_BK = 32, G_LDS_ROW = 80;
constexpr int G_OPER_BYTES = 128 * G_LDS_ROW;
template <int MODE>
__device__ __forceinline__ void phase_gemm(const Params& p, const u16* __restrict__ A, int lda, const u16* __restrict__ Bt, int K,
                           int nN, char* smem) {
  const int tid = opaque_tid(), lane = tid & 63, wid = tid >> 6, wm = wid >> 1, wn = wid & 1;
  const int nM = M_TOT / 128;
  const int ntiles = nM * nN;
  const int nk = K / G_BK;
  const int lrow = tid >> 2, lkc = tid & 3;
  for (int tile = BID, nb_ = NBLK; tile < ntiles; tile += nb_) {
    int grp = tile / (8 * nN);
    int first_m = grp * 8;
    int gsz = min(8, nM - first_m);
    int rem = tile - grp * 8 * nN;
    int pm = first_m + rem % gsz, pn = rem / gsz;
    const u16* gA = A + (long)(pm * 128 + lrow) * lda + lkc * 8;
    const u16* gB = Bt + (long)(pn * 128 + lrow) * K + lkc * 8;
    f32x16 acc[2][2];
#pragma unroll
    for (int i = 0; i < 2; ++i)
#pragma unroll
      for (int j = 0; j < 2; ++j)
#pragma unroll
        for (int r = 0; r < 16; ++r) acc[i][j][r] = 0.f;
    uint4 xa0, xa1, xb0, xb1, ya0, ya1, yb0, yb1;
#define G_LOAD(S, KT)                                                  \
  {                                                                    \
    S##a0 = *(const uint4*)(gA + (KT) * G_BK);                         \
    S##a1 = *(const uint4*)(gA + (long)64 * lda + (KT) * G_BK);        \
    S##b0 = *(const uint4*)(gB + (KT) * G_BK);                         \
    S##b1 = *(const uint4*)(gB + (long)64 * K + (KT) * G_BK);          \
  }
#define G_STORE(S, BUF)                                                \
  {                                                                    \
    char* dA = smem + (BUF) * 2 * G_OPER_BYTES;                        \
    char* dB = dA + G_OPER_BYTES;                                      \
    *(uint4*)(dA + lrow * G_LDS_ROW + lkc * 16) = S##a0;               \
    *(uint4*)(dA + (lrow + 64) * G_LDS_ROW + lkc * 16) = S##a1;        \
    *(uint4*)(dB + lrow * G_LDS_ROW + lkc * 16) = S##b0;               \
    *(uint4*)(dB + (lrow + 64) * G_LDS_ROW + lkc * 16) = S##b1;        \
  }
#define G_COMPUTE(BUF)                                                                           \
  {                                                                                              \
    const char* sA = smem + (BUF) * 2 * G_OPER_BYTES;                                            \
    const char* sB = sA + G_OPER_BYTES;                                                          \
    _Pragma("unroll") for (int ks = 0; ks < 2; ++ks) {                                           \
      bf16x8 af[2], bfr[2];                                                                      \
      const int koff = (ks * 16 + (lane >> 5) * 8) * 2;                                          \
      _Pragma("unroll") for (int i = 0; i < 2; ++i)                                              \
        af[i] = *(const bf16x8*)(sA + (wm * 64 + i * 32 + (lane & 31)) * G_LDS_ROW + koff);      \
      _Pragma("unroll") for (int j = 0; j < 2; ++j)                                              \
        bfr[j] = *(const bf16x8*)(sB + (wn * 64 + j * 32 + (lane & 31)) * G_LDS_ROW + koff);     \
      _Pragma("unroll") for (int i = 0; i < 2; ++i)                                              \
        _Pragma("unroll") for (int j = 0; j < 2; ++j)                                            \
          acc[i][j] = __builtin_amdgcn_mfma_f32_32x32x16_bf16(af[i], bfr[j], acc[i][j], 0, 0, 0); \
    }                                                                                            \
  }
    G_LOAD(x, 0);
    G_LOAD(y, 1);
    __builtin_amdgcn_sched_barrier(0);
    __syncthreads();
    G_STORE(x, 0);
    __syncthreads();
    for (int kt = 0; kt < nk; kt += 2) {
      if (kt + 2 < nk) G_LOAD(x, kt + 2);
      __builtin_amdgcn_sched_barrier(0);
      G_COMPUTE(0);
      __builtin_amdgcn_sched_barrier(0);
      G_STORE(y, 1);
      __syncthreads();
      if (kt + 3 < nk) G_LOAD(y, kt + 3);
      __builtin_amdgcn_sched_barrier(0);
      G_COMPUTE(1);
      __builtin_amdgcn_sched_barrier(0);
      if (kt + 2 < nk) G_STORE(x, 0);
      __syncthreads();
    }
#undef G_LOAD
#undef G_STORE
#undef G_COMPUTE
    const int colb = pn * 128 + wn * 64 + (lane & 31);
    const int rowb = pm * 128 + wm * 64 + 4 * (lane >> 5);
    if (MODE == 1) {
#pragma unroll
      for (int i = 0; i < 2; ++i)
#pragma unroll
        for (int r = 0; r < 16; ++r) {
          int row = rowb + i * 32 + (r & 3) + 8 * (r >> 2);
          float rs = p.RS[row];
#pragma unroll
          for (int j = 0; j < 2; ++j) {
            int col = colb + j * 32;
            u16 v = f2bf(acc[i][j][r] * rs);
            p.PROJ[(long)row * LDP + col] = v;
            if ((row & 15) == 15) {
              int jj = -1;
              if (col >= C_R && col < C_GG) jj = col - C_R;
              else if (col >= C_K && col < C_Q) jj = col - C_K + 512;
              if (jj >= 0) p.BND[(long)(row >> 4) * 1792 + jj] = v;
            }
          }
        }
    } else if (MODE == 2) {
#pragma unroll
      for (int i = 0; i < 2; ++i)
#pragma unroll
        for (int r = 0; r < 16; ++r) {
          int row = rowb + i * 32 + (r & 3) + 8 * (r >> 2);
#pragma unroll
          for (int j = 0; j < 2; ++j) {
            int col = colb + j * 32;
            u16* px = p.XB + (long)row * DM + col;
            *px = f2bf(bf2f(*px) + acc[i][j][r]);
          }
        }
    } else {
      const int cact = pn * 64 + wn * 32 + (lane & 31);
      u16* ACT = p.PROJ;
#pragma unroll
      for (int i = 0; i < 2; ++i)
#pragma unroll
        for (int r = 0; r < 16; ++r) {
          int row = rowb + i * 32 + (r & 3) + 8 * (r >> 2);
          float rs = p.RS[row];
          float g = acc[i][0][r] * rs, u = acc[i][1][r] * rs;
          ACT[(long)row * D_FF + cact] = f2bf(siluf_(g) * u);
        }
    }
  }
}

__device__ __forceinline__ void phase_pre(const Params& p, int l, float* smem) {
  const int tid = opaque_tid(), lane = tid & 63, wid = tid >> 6;
  float* XW = smem;
  float* XA = smem + 1024;
  const float* mu = p.rw_mu + l * 1792;
  for (int blk = BID, nb_ = NBLK; blk < NBLK16; blk += nb_) {
    const int m0 = blk * 16;
    int s, t0;
    if (m0 < M_PROMPT) { s = m0 / T_P; t0 = m0 - s * T_P; } else { s = 8 + (m0 - M_PROMPT) / 64; t0 = (m0 - M_PROMPT) & 63; }
    const bool first = (t0 == 0);
    auto prev_of = [&](int j) -> float {
      if (!first) return bf2f(p.BND[(long)(blk - 1) * 1792 + j]);
      if (s < 8) return 0.f;
      return p.state_shift[((long)l * 8 + (s - 8)) * 1792 + j];
    };
    __syncthreads();
    {
      int j = 1536 + tid;
      float mj = mu[j];
      float pv = prev_of(j);
      u16* col = p.PROJ + (long)m0 * LDP + C_XW + tid;
#pragma unroll
      for (int t = 0; t < 16; ++t) {
        float x = bf2f(col[(long)t * LDP]);
        float sh = x + (pv - x) * mj;
        pv = x;
        if (tid < 64) XW[tid * 16 + t] = tanhf(sh);
        else if (tid < 128) XA[(tid - 64) * 16 + t] = sh;
        else col[(long)t * LDP] = f2bf(sigmoidf_(sh));
      }
    }
    __syncthreads();
#pragma unroll 1
    for (int c = 0; c < 2; ++c) {
      const int ch = tid + 256 * c;
      const int head = wid + 4 * c;
      float aw[16], aa[16];
#pragma unroll
      for (int t = 0; t < 16; ++t) { aw[t] = 0.f; aa[t] = 0.f; }
      {
        const float* w2 = p.rw_w2 + (long)l * 64 * 512 + ch;
        const float* a2 = p.rw_a2 + (long)l * 64 * 512 + ch;
#pragma unroll 2
        for (int i = 0; i < 64; ++i) {
          float w2v = w2[i * 512];
          float a2v = a2[i * 512];
#pragma unroll
          for (int q = 0; q < 4; ++q) {
            float4 xw = *(const float4*)(XW + i * 16 + q * 4);
            float4 xa = *(const float4*)(XA + i * 16 + q * 4);
            aw[q * 4 + 0] += xw.x * w2v; aw[q * 4 + 1] += xw.y * w2v;
            aw[q * 4 + 2] += xw.z * w2v; aw[q * 4 + 3] += xw.w * w2v;
            aa[q * 4 + 0] += xa.x * a2v; aa[q * 4 + 1] += xa.y * a2v;
            aa[q * 4 + 2] += xa.z * a2v; aa[q * 4 + 3] += xa.w * a2v;
          }
        }
      }
      {
        float w0 = p.rw_w0[l * 512 + ch], a0 = p.rw_a0[l * 512 + ch];
#pragma unroll
        for (int t = 0; t < 16; ++t) {
          float lw = -softplusf_(-(w0 + aw[t])) - 0.5f;
          float u = -__expf(lw);
          p.RWX[(long)(m0 + t) * 1536 + ch] = f2bf(u);
          aa[t] = sigmoidf_(a0 + aa[t]);
        }
      }
      float rt[16];
      {
        float mj = mu[ch];
        float pv = prev_of(ch);
        u16* col = p.PROJ + (long)m0 * LDP + C_R + ch;
#pragma unroll
        for (int t = 0; t < 16; ++t) {
          float x = bf2f(col[(long)t * LDP]);
          rt[t] = x + (pv - x) * mj;
          pv = x;
        }
#pragma unroll
        for (int t = 0; t < 16; ++t) col[(long)t * LDP] = f2bf(rt[t]);
      }
      {
        float mj = mu[512 + ch];
        float pv = prev_of(512 + ch);
        float kkw = p.rw_kk[l * 512 + ch], kaw = p.rw_ka[l * 512 + ch], rkw = p.rw_rk[l * 512 + ch];
        u16* col = p.PROJ + (long)m0 * LDP + C_K + ch;
        float kt[16];
#pragma unroll
        for (int t = 0; t < 16; ++t) {
          float x = bf2f(col[(long)t * LDP]);
          kt[t] = x + (pv - x) * mj;
          pv = x;
        }
#pragma unroll
        for (int t = 0; t < 16; ++t) {
          float kkv = kt[t] * kkw;
          float ssq = sum64(kkv * kkv);
          float kk = kkv * rsqrtf(ssq + 1e-12f);
          float a = aa[t];
          float kp = kt[t] * (1.f + (a - 1.f) * kaw);
          float rks = sum64(rt[t] * kp * rkw);
          col[(long)t * LDP] = f2bf(kp);
          p.RWX[(long)(m0 + t) * 1536 + 512 + ch] = f2bf(kk);
          p.RWX[(long)(m0 + t) * 1536 + 1024 + ch] = f2bf(kk * a);
          if (lane == 0) p.RKS[(long)(m0 + t) * 8 + head] = rks;
        }
      }
      {
        float mj = mu[1024 + ch];
        float pv = prev_of(1024 + ch);
        u16* col = p.PROJ + (long)m0 * LDP + C_V + ch;
        float vt[16];
#pragma unroll
        for (int t = 0; t < 16; ++t) {
          float x = bf2f(col[(long)t * LDP]);
          vt[t] = x + (pv - x) * mj;
          pv = x;
        }
#pragma unroll
        for (int t = 0; t < 16; ++t) col[(long)t * LDP] = f2bf(vt[t]);
      }
    }
    if (t0 + 16 == seq_len(s)) {
      float* o = p.out + (s < 8 ? O_PSHIFT + ((long)l * 8 + s) * 1792 : O_SSHIFT + ((long)l * 8 + (s - 8)) * 1792);
      for (int j = tid; j < 1792; j += 256) o[j] = bf2f(p.BND[(long)blk * 1792 + j]);
    }
  }
}

__device__ __forceinline__ void scan_rwkv(const Params& p, int l, int s, int h, int q, float* smem) {
  const int tid = opaque_tid(), lane = tid & 63, wid = tid >> 6;
  float* R_ = smem;
  float* W_ = smem + 1024;
  float* K_ = smem + 2048;
  float* A_ = smem + 3072;
  float* B_ = smem + 4096;
  float* V_ = smem + 5120;
  float* O_ = smem + 5376;
  const int rl = wid * 4 + (lane >> 4);
  const int row = q * 16 + rl;
  const int ksl = (lane & 15) * 4;
  const int base = seq_base(s), T = seq_len(s);
  float s0 = 0.f, s1 = 0.f, s2 = 0.f, s3 = 0.f;
  if (s >= 8) {
    const float* st = p.state_rwkv + (((long)l * 8 + (s - 8)) * 8 + h) * 4096 + row * 64 + ksl;
    float4 v = *(const float4*)st;
    s0 = v.x; s1 = v.y; s2 = v.z; s3 = v.w;
  }
  const int stt = tid >> 4, skq = (tid & 15) * 4;
  const int nblk = T / 16;
  ushort4 r4, k4, u4, a4, b4;
  u16 vv;
  {
    const long m = base + stt;
    const u16* pr = p.PROJ + m * LDP;
    const u16* px = p.RWX + m * 1536;
    r4 = *(const ushort4*)(pr + C_R + h * 64 + skq);
    k4 = *(const ushort4*)(pr + C_K + h * 64 + skq);
    u4 = *(const ushort4*)(px + h * 64 + skq);
    a4 = *(const ushort4*)(px + 512 + h * 64 + skq);
    b4 = *(const ushort4*)(px + 1024 + h * 64 + skq);
    vv = pr[C_V + h * 64 + q * 16 + (tid & 15)];
  }
  __syncthreads();
  float* TR_ = smem + 5376 + 512;
  const bool wr = (lane & 15) == 0;
  const int ooff = wr ? rl : (512 + lane);
  const int ostr = wr ? 16 : 0;
  for (int blk = 0; blk < nblk; ++blk) {
    const long m = base + blk * 16 + stt;
    float* Oc = O_ + (blk & 1) * 256;
    {
      *(float4*)(R_ + stt * 64 + skq) = make_float4(bf2f(r4.x), bf2f(r4.y), bf2f(r4.z), bf2f(r4.w));
      *(float4*)(K_ + stt * 64 + skq) = make_float4(bf2f(k4.x), bf2f(k4.y), bf2f(k4.z), bf2f(k4.w));
      *(float4*)(W_ + stt * 64 + skq) =
          make_float4(__expf(bf2f(u4.x)), __expf(bf2f(u4.y)), __expf(bf2f(u4.z)), __expf(bf2f(u4.w)));
      *(float4*)(A_ + stt * 64 + skq) = make_float4(-bf2f(a4.x), -bf2f(a4.y), -bf2f(a4.z), -bf2f(a4.w));
      *(float4*)(B_ + stt * 64 + skq) = make_float4(bf2f(b4.x), bf2f(b4.y), bf2f(b4.z), bf2f(b4.w));
      V_[stt * 16 + (tid & 15)] = bf2f(vv);
    }
    __syncthreads();
    if (blk > 0)
      p.ORW[(m - 16) * 512 + h * 64 + q * 16 + (tid & 15)] = f2bf(O_[((blk - 1) & 1) * 256 + stt * 16 + (tid & 15)]);
    if (blk + 1 < nblk) {
      const u16* pr = p.PROJ + (m + 16) * LDP;
      const u16* px = p.RWX + (m + 16) * 1536;
      r4 = *(const ushort4*)(pr + C_R + h * 64 + skq);
      k4 = *(const ushort4*)(pr + C_K + h * 64 + skq);
      u4 = *(const ushort4*)(px + h * 64 + skq);
      a4 = *(const ushort4*)(px + 512 + h * 64 + skq);
      b4 = *(const ushort4*)(px + 1024 + h * 64 + skq);
      vv = pr[C_V + h * 64 + q * 16 + (tid & 15)];
    }
    __builtin_amdgcn_sched_barrier(0);
    {
      float4 a = *(const float4*)(A_ + ksl), w = *(const float4*)(W_ + ksl), b = *(const float4*)(B_ + ksl);
      float4 k = *(const float4*)(K_ + ksl), r = *(const float4*)(R_ + ksl);
      float v = V_[rl];
#pragma unroll
      for (int tt = 0; tt < 16; ++tt) {
        float4 an, wn, bn, kn, rn;
        float vn;
        if (tt + 1 < 16) {
          an = *(const float4*)(A_ + (tt + 1) * 64 + ksl); wn = *(const float4*)(W_ + (tt + 1) * 64 + ksl);
          bn = *(const float4*)(B_ + (tt + 1) * 64 + ksl); kn = *(const float4*)(K_ + (tt + 1) * 64 + ksl);
          rn = *(const float4*)(R_ + (tt + 1) * 64 + ksl); vn = V_[(tt + 1) * 16 + rl];
        }
        __builtin_amdgcn_sched_barrier(0);
        float sa = sum16(fmaf(s0, a.x, fmaf(s1, a.y, fmaf(s2, a.z, s3 * a.w))));
        s0 = fmaf(s0, w.x, fmaf(sa, b.x, v * k.x)); NOPK(s0);
        s1 = fmaf(s1, w.y, fmaf(sa, b.y, v * k.y)); NOPK(s1);
        s2 = fmaf(s2, w.z, fmaf(sa, b.z, v * k.z)); NOPK(s2);
        s3 = fmaf(s3, w.w, fmaf(sa, b.w, v * k.w)); NOPK(s3);
        float o = sum16(fmaf(s0, r.x, fmaf(s1, r.y, fmaf(s2, r.z, s3 * r.w))));
        Oc[ooff + tt * ostr] = o;
        __builtin_amdgcn_sched_barrier(0);
        if (tt + 1 < 16) { a = an; w = wn; b = bn; k = kn; r = rn; v = vn; }
      }
    }
    __builtin_amdgcn_sched_barrier(0);
    __syncthreads();
  }
  {
    const long m = base + (nblk - 1) * 16 + stt;
    p.ORW[m * 512 + h * 64 + q * 16 + (tid & 15)] = f2bf(O_[((nblk - 1) & 1) * 256 + stt * 16 + (tid & 15)]);
  }
  __syncthreads();
  {
    float* o = p.out + (s < 8 ? O_PRWKV + (((long)l * 8 + s) * 8 + h) * 4096
                              : O_SRWKV + (((long)l * 8 + (s - 8)) * 8 + h) * 4096);
    *(float4*)(o + row * 64 + ksl) = make_float4(s0, s1, s2, s3);
  }
}

__device__ __forceinline__ void scan_hgrn(const Params& p, int l, int s, int h, int q, float* smem) {
  const int tid = opaque_tid(), lane = tid & 63, wid = tid >> 6;
  float* Q_ = smem;
  float* F_ = smem + 2048;
  float* G_ = smem + 4096;
  float* I_ = smem + 6144;
  float* O_ = smem + 6400;
  const int rl = wid * 4 + (lane >> 4);
  const int row = q * 16 + rl;
  const int ksl4 = (lane & 15) * 4;
  const int base = seq_base(s), T = seq_len(s);
  float st[8];
#pragma unroll
  for (int i = 0; i < 8; ++i) st[i] = 0.f;
  if (s >= 8) {
    const float* sp = p.state_hgrn + (((long)l * 8 + (s - 8)) * 4 + h) * 16384;
#pragma unroll
    for (int i = 0; i < 8; ++i) st[i] = sp[((i >> 2) * 64 + ksl4 + (i & 3)) * 128 + row];
  }
  const int stt = tid >> 4, skq = (tid & 15) * 8;
  float lb[8];
#pragma unroll
  for (int i = 0; i < 8; ++i) {
    if (l == 0) lb[i] = 0.f;
    else {
      float x0 = p.hg_lb[h * 128 + skq + i], x1 = p.hg_lb[512 + h * 128 + skq + i];
      lb[i] = frcp_(1.f + __expf(x0 - x1));
    }
  }
  const int nblk = T / 16;
  uint4 q8, f8;
  u16 iv16;
  {
    const u16* pr = p.PROJ + (long)(base + stt) * LDP;
    q8 = *(const uint4*)(pr + C_Q + h * 128 + skq);
    f8 = *(const uint4*)(pr + C_F + h * 128 + skq);
    iv16 = pr[C_I + h * 128 + q * 16 + (tid & 15)];
  }
  __syncthreads();
  float* TR_ = smem + 6400 + 512;
  const bool wr = (lane & 15) == 0;
  const int ooff = wr ? rl : (512 + lane);
  const int ostr = wr ? 16 : 0;
  for (int blk = 0; blk < nblk; ++blk) {
    const long m = base + blk * 16 + stt;
    float* Oc = O_ + (blk & 1) * 256;
    {
      unsigned qw[4] = {q8.x, q8.y, q8.z, q8.w}, fw[4] = {f8.x, f8.y, f8.z, f8.w};
      float qv[8], fv[8], gv[8];
#pragma unroll
      for (int e = 0; e < 8; ++e) {
        qv[e] = bf2f((u16)((qw[e >> 1] >> ((e & 1) * 16)) & 0xffff));
        float fz = bf2f((u16)((fw[e >> 1] >> ((e & 1) * 16)) & 0xffff));
        float ex = __expf(-fz);
        float sg = frcp_(1.f + ex);
        float sgn = ex * sg;
        fv[e] = lb[e] + (1.f - lb[e]) * sg;
        gv[e] = (1.f - lb[e]) * sgn;
      }
      *(float4*)(Q_ + stt * 128 + skq) = make_float4(qv[0], qv[1], qv[2], qv[3]);
      *(float4*)(Q_ + stt * 128 + skq + 4) = make_float4(qv[4], qv[5], qv[6], qv[7]);
      *(float4*)(F_ + stt * 128 + skq) = make_float4(fv[0], fv[1], fv[2], fv[3]);
      *(float4*)(F_ + stt * 128 + skq + 4) = make_float4(fv[4], fv[5], fv[6], fv[7]);
      *(float4*)(G_ + stt * 128 + skq) = make_float4(gv[0], gv[1], gv[2], gv[3]);
      *(float4*)(G_ + stt * 128 + skq + 4) = make_float4(gv[4], gv[5], gv[6], gv[7]);
      I_[stt * 16 + (tid & 15)] = bf2f(iv16);
    }
    __syncthreads();
    if (blk > 0) {
      u16* dp = p.PROJ + (m - 16) * LDP + C_I + h * 128 + q * 16 + (tid & 15);
      *dp = f2bf(O_[((blk - 1) & 1) * 256 + stt * 16 + (tid & 15)]);
    }
    if (blk + 1 < nblk) {
      const u16* pr = p.PROJ + (m + 16) * LDP;
      q8 = *(const uint4*)(pr + C_Q + h * 128 + skq);
      f8 = *(const uint4*)(pr + C_F + h * 128 + skq);
      iv16 = pr[C_I + h * 128 + q * 16 + (tid & 15)];
    }
    __builtin_amdgcn_sched_barrier(0);
    {
      float4 f0 = *(const float4*)(F_ + ksl4), f1 = *(const float4*)(F_ + 64 + ksl4);
      float4 g0 = *(const float4*)(G_ + ksl4), g1 = *(const float4*)(G_ + 64 + ksl4);
      float4 q0 = *(const float4*)(Q_ + ksl4), q1 = *(const float4*)(Q_ + 64 + ksl4);
      float iv = I_[rl];
#pragma unroll
      for (int tt = 0; tt < 16; ++tt) {
        float4 f0n, f1n, g0n, g1n, q0n, q1n;
        float ivn;
        if (tt + 1 < 16) {
          const int o_ = (tt + 1) * 128;
          f0n = *(const float4*)(F_ + o_ + ksl4); f1n = *(const float4*)(F_ + o_ + 64 + ksl4);
          g0n = *(const float4*)(G_ + o_ + ksl4); g1n = *(const float4*)(G_ + o_ + 64 + ksl4);
          q0n = *(const float4*)(Q_ + o_ + ksl4); q1n = *(const float4*)(Q_ + o_ + 64 + ksl4);
          ivn = I_[(tt + 1) * 16 + rl];
        }
        __builtin_amdgcn_sched_barrier(0);
        st[0] = fmaf(st[0], f0.x, g0.x * iv); NOPK(st[0]);
        st[1] = fmaf(st[1], f0.y, g0.y * iv); NOPK(st[1]);
        st[2] = fmaf(st[2], f0.z, g0.z * iv); NOPK(st[2]);
        st[3] = fmaf(st[3], f0.w, g0.w * iv); NOPK(st[3]);
        st[4] = fmaf(st[4], f1.x, g1.x * iv); NOPK(st[4]);
        st[5] = fmaf(st[5], f1.y, g1.y * iv); NOPK(st[5]);
        st[6] = fmaf(st[6], f1.z, g1.z * iv); NOPK(st[6]);
        st[7] = fmaf(st[7], f1.w, g1.w * iv); NOPK(st[7]);
        float acc0 = fmaf(st[0], q0.x, fmaf(st[1], q0.y, fmaf(st[2], q0.z, st[3] * q0.w)));
        float acc1 = fmaf(st[4], q1.x, fmaf(st[5], q1.y, fmaf(st[6], q1.z, st[7] * q1.w)));
        float o = sum16(acc0 + acc1);
        Oc[ooff + tt * ostr] = o;
        __builtin_amdgcn_sched_barrier(0);
        if (tt + 1 < 16) { f0 = f0n; f1 = f1n; g0 = g0n; g1 = g1n; q0 = q0n; q1 = q1n; iv = ivn; }
      }
    }
    __builtin_amdgcn_sched_barrier(0);
    __syncthreads();
  }
  {
    const long m = base + (nblk - 1) * 16 + stt;
    u16* dp = p.PROJ + m * LDP + C_I + h * 128 + q * 16 + (tid & 15);
    *dp = f2bf(O_[((nblk - 1) & 1) * 256 + stt * 16 + (tid & 15)]);
  }
  __syncthreads();
  {
    float* o = p.out + (s < 8 ? O_PHGRN + (((long)l * 8 + s) * 4 + h) * 16384
                              : O_SHGRN + (((long)l * 8 + (s - 8)) * 4 + h) * 16384);
#pragma unroll
    for (int i = 0; i < 8; ++i) o[((i >> 2) * 64 + ksl4 + (i & 3)) * 128 + row] = st[i];
  }
}

__device__ __forceinline__ void scan_ssd(const Params& p, int l, int s, int h, int q, float* smem) {
  const int tid = opaque_tid(), lane = tid & 63, wid = tid >> 6;
  float* B_ = smem;
  float* C_ = smem + 2048;
  float* X_ = smem + 4096;
  float* O_ = smem + 4352;
  float* DT_ = smem + 5200;
  float* DE_ = smem + 5216;
  const int rl = wid * 4 + (lane >> 4);
  const int row = q * 16 + rl;
  const int ksl4 = (lane & 15) * 4;
  const int g = h >> 2;
  const int base = seq_base(s), T = seq_len(s);
  float st[8];
#pragma unroll
  for (int i = 0; i < 8; ++i) st[i] = 0.f;
  if (s >= 8) {
    const float* sp = p.state_ssm + (((long)l * 8 + (s - 8)) * 8 + h) * 8192 + row * 128 + ksl4;
    float4 a = *(const float4*)sp, b = *(const float4*)(sp + 64);
    st[0] = a.x; st[1] = a.y; st[2] = a.z; st[3] = a.w; st[4] = b.x; st[5] = b.y; st[6] = b.z; st[7] = b.w;
  }
  const int xc_bc = (tid < 128) ? (512 + g * 128 + tid) : (768 + g * 128 + (tid - 128));
  const float* cw = p.conv_w + (long)l * 4 * 1024;
  const float cb0 = cw[xc_bc], cb1 = cw[1024 + xc_bc], cb2 = cw[2048 + xc_bc], cb3 = cw[3072 + xc_bc];
  const float cbb = p.conv_b[l * 1024 + xc_bc];
  float u3 = 0.f, u2 = 0.f, u1 = 0.f;
  const int xc_x = h * 64 + q * 16 + (tid & 15);
  const float cx0 = cw[xc_x], cx1 = cw[1024 + xc_x], cx2 = cw[2048 + xc_x], cx3 = cw[3072 + xc_x];
  const float cxb = p.conv_b[l * 1024 + xc_x];
  float x3 = 0.f, x2 = 0.f, x1 = 0.f;
  if (s >= 8) {
    const float* sc = p.state_conv + ((long)l * 8 + (s - 8)) * 3 * 1024;
    u3 = sc[xc_bc]; u2 = sc[1024 + xc_bc]; u1 = sc[2048 + xc_bc];
    x3 = sc[xc_x]; x2 = sc[1024 + xc_x]; x1 = sc[2048 + xc_x];
  }
  const float dtb = p.dt_bias[l * 8 + h];
  const float aexp = __expf(p.a_log[l * 8 + h]);
  const float dsk = p.d_skip[l * 8 + h];
  const int stt = tid >> 4;
  const int nblk = T / 16;
  u16 raw[16];
  float xr[4];
  float dtr = 0.f;
  u16 zc = 0, zn = 0;
#define SSD_LOAD(M0)                                                              \
  {                                                                               \
    const u16* col = p.PROJ + (long)(M0) * LDP + C_XBC + xc_bc;                   \
    _Pragma("unroll") for (int t = 0; t < 16; ++t) raw[t] = col[(long)t * LDP];   \
    {                                                                             \
      const long mr = (long)(M0) + stt;                                           \
      const u16* colx = p.PROJ + mr * LDP + C_XBC + xc_x;                         \
      _Pragma("unroll") for (int j = 0; j < 4; ++j) {                             \
        const long mm = mr - 3 + j;                                               \
        float vx;                                                                 \
        if (mm >= base) vx = bf2f(colx[(long)(j - 3) * LDP]);                     \
        else vx = (s >= 8) ? p.state_conv[((long)l * 8 + (s - 8)) * 3072 + (3 + (int)(mm - base)) * 1024 + xc_x] : 0.f; \
        xr[j] = vx;                                                               \
      }                                                                           \
    }                                                                             \
    if (tid < 16) dtr = p.DTRAW[((long)(M0) + tid) * 8 + h];                      \
    zn = p.PROJ[((long)(M0) + stt) * LDP + C_Z + h * 64 + q * 16 + (tid & 15)];   \
  }
#pragma unroll
  for (int t = 0; t < 16; ++t) raw[t] = 0;
  SSD_LOAD(base);
  __syncthreads();
  const bool wr = (lane & 15) == 0;
  const int ooff = wr ? rl : (512 + lane);
  const int ostr = wr ? 16 : 0;
  u16 zp = 0;
  for (int blk = 0; blk < nblk; ++blk) {
    const long m0 = base + blk * 16;
    zp = zc;
    zc = zn;
    float* Oc = O_ + (blk & 1) * 256;
    {
      float* dst = (tid < 128) ? (B_ + tid) : (C_ + (tid - 128));
#pragma unroll
      for (int t = 0; t < 16; ++t) {
        float u0 = bf2f(raw[t]);
        float y = cb0 * u3 + cb1 * u2 + cb2 * u1 + cb3 * u0 + cbb;
        dst[t * 128] = siluf_(y);
        u3 = u2; u2 = u1; u1 = u0;
      }
      {
        float y = cx0 * xr[0] + cx1 * xr[1] + cx2 * xr[2] + cx3 * xr[3] + cxb;
        X_[stt * 16 + (tid & 15)] = siluf_(y);
      }
      if (tid < 16) {
        float dtv = softplusf_(dtr + dtb);
        DT_[tid] = dtv;
        DE_[tid] = __expf(-aexp * dtv);
      }
    }
    __syncthreads();
    if (blk > 0) {
      u16* pz = p.PROJ + (m0 - 16 + stt) * LDP + C_Z + h * 64 + q * 16 + (tid & 15);
      *pz = f2bf(O_[((blk - 1) & 1) * 256 + stt * 16 + (tid & 15)] * siluf_(bf2f(zp)));
    }
    if (blk + 1 < nblk) SSD_LOAD(m0 + 16);
    __builtin_amdgcn_sched_barrier(0);
    {
      float4 b0 = *(const float4*)(B_ + ksl4), b1 = *(const float4*)(B_ + 64 + ksl4);
      float4 c0 = *(const float4*)(C_ + ksl4), c1 = *(const float4*)(C_ + 64 + ksl4);
      float xv = X_[rl], dt = DT_[0], de = DE_[0];
#pragma unroll
      for (int tt = 0; tt < 16; ++tt) {
        float4 b0n, b1n, c0n, c1n;
        float xvn, dtn, den;
        if (tt + 1 < 16) {
          const int o_ = (tt + 1) * 128;
          b0n = *(const float4*)(B_ + o_ + ksl4); b1n = *(const float4*)(B_ + o_ + 64 + ksl4);
          c0n = *(const float4*)(C_ + o_ + ksl4); c1n = *(const float4*)(C_ + o_ + 64 + ksl4);
          xvn = X_[(tt + 1) * 16 + rl]; dtn = DT_[tt + 1]; den = DE_[tt + 1];
        }
        __builtin_amdgcn_sched_barrier(0);
        const float xd = xv * dt;
        st[0] = fmaf(st[0], de, xd * b0.x); NOPK(st[0]);
        st[1] = fmaf(st[1], de, xd * b0.y); NOPK(st[1]);
        st[2] = fmaf(st[2], de, xd * b0.z); NOPK(st[2]);
        st[3] = fmaf(st[3], de, xd * b0.w); NOPK(st[3]);
        st[4] = fmaf(st[4], de, xd * b1.x); NOPK(st[4]);
        st[5] = fmaf(st[5], de, xd * b1.y); NOPK(st[5]);
        st[6] = fmaf(st[6], de, xd * b1.z); NOPK(st[6]);
        st[7] = fmaf(st[7], de, xd * b1.w); NOPK(st[7]);
        float acc0 = fmaf(st[0], c0.x, fmaf(st[1], c0.y, fmaf(st[2], c0.z, st[3] * c0.w)));
        float acc1 = fmaf(st[4], c1.x, fmaf(st[5], c1.y, fmaf(st[6], c1.z, st[7] * c1.w)));
        float y = sum16(acc0 + acc1);
        Oc[ooff + tt * ostr] = y + dsk * xv;
        __builtin_amdgcn_sched_barrier(0);
        if (tt + 1 < 16) { b0 = b0n; b1 = b1n; c0 = c0n; c1 = c1n; xv = xvn; dt = dtn; de = den; }
      }
    }
    __builtin_amdgcn_sched_barrier(0);
    __syncthreads();
  }
  {
    const long m0 = base + (nblk - 1) * 16;
    u16* pz = p.PROJ + (m0 + stt) * LDP + C_Z + h * 64 + q * 16 + (tid & 15);
    *pz = f2bf(O_[((nblk - 1) & 1) * 256 + stt * 16 + (tid & 15)] * siluf_(bf2f(zc)));
  }
  __syncthreads();
#undef SSD_LOAD
  {
    float* o = p.out + (s < 8 ? O_PSSM + (((long)l * 8 + s) * 8 + h) * 8192
                              : O_SSSM + (((long)l * 8 + (s - 8)) * 8 + h) * 8192);
    *(float4*)(o + row * 128 + ksl4) = make_float4(st[0], st[1], st[2], st[3]);
    *(float4*)(o + row * 128 + 64 + ksl4) = make_float4(st[4], st[5], st[6], st[7]);
  }
  if (h == 0 && q == 0) {
    float* o = p.out + (s < 8 ? O_PCONV + ((long)l * 8 + s) * 3072 : O_SCONV + ((long)l * 8 + (s - 8)) * 3072);
    for (int i = tid; i < 3072; i += 256) {
      int r = i >> 10, c = i & 1023;
      o[i] = bf2f(p.PROJ[(long)(base + T - 3 + r) * LDP + C_XBC + c]);
    }
  }
}

__device__ __forceinline__ void phase_scan(const Params& p, int l, float* smem) {
  for (int u = BID, nb_ = NBLK; u < 1536; u += nb_) {
    int sample = u >= 768;
    int v = sample ? u - 768 : u;
    int type = v % 3, w = v / 3;
    if (type == 0) {
      int q = w & 3, h = (w >> 2) & 7, b = w >> 5;
      scan_rwkv(p, l, b + 8 * sample, h, q, smem);
    } else if (type == 1) {
      int q = w & 7, h = (w >> 3) & 3, b = w >> 5;
      scan_hgrn(p, l, b + 8 * sample, h, q, smem);
    } else {
      int q = w & 3, h = (w >> 2) & 7, b = w >> 5;
      scan_ssd(p, l, b + 8 * sample, h, q, smem);
    }
  }
}

__device__ __forceinline__ void phase_post(const Params& p, int l, float* smem) {
  const int tid = opaque_tid(), lane = tid & 63, wid = tid >> 6;
  float* SG = smem;
  float* RED = smem + 2048;
  for (int blk = BID, nb_ = NBLK; blk < NBLK16; blk += nb_) {
    const long m0 = (long)blk * 16;
    __syncthreads();
    if (tid < 128) {
      const u16* col = p.PROJ + m0 * LDP + C_XG + tid;
#pragma unroll
      for (int t = 0; t < 16; ++t) SG[tid * 16 + t] = bf2f(col[(long)t * LDP]);
    }
    float ys[2][16], oh[2][16];
#pragma unroll
    for (int c = 0; c < 2; ++c) {
      int ch = tid + 256 * c;
#pragma unroll
      for (int t = 0; t < 16; ++t) {
        ys[c][t] = bf2f(p.PROJ[(m0 + t) * LDP + C_Z + ch]);
        oh[c][t] = bf2f(p.PROJ[(m0 + t) * LDP + C_I + ch]);
      }
    }
#pragma unroll
    for (int t = 0; t < 16; ++t) {
      float a0 = sum64(ys[0][t] * ys[0][t]), a1 = sum64(ys[1][t] * ys[1][t]);
      float b0 = sum64(oh[0][t] * oh[0][t]), b1 = sum64(oh[1][t] * oh[1][t]);
      if (lane == 0) *(float4*)(RED + (wid * 16 + t) * 4) = make_float4(a0, a1, b0, b1);
    }
    __syncthreads();
    {
      const float nw0 = p.ssd_norm_w[l * 512 + tid], nw1 = p.ssd_norm_w[l * 512 + tid + 256];
      const float hw0 = p.hg_norm_w[l * 512 + tid], hw1 = p.hg_norm_w[l * 512 + tid + 256];
      const int pw = (wid >> 1) * 2;
#pragma unroll
      for (int t = 0; t < 16; ++t) {
        float4 r0 = *(const float4*)(RED + (0 * 16 + t) * 4), r1 = *(const float4*)(RED + (1 * 16 + t) * 4);
        float4 r2 = *(const float4*)(RED + (2 * 16 + t) * 4), r3 = *(const float4*)(RED + (3 * 16 + t) * 4);
        float g0 = r0.x + r1.x + r2.x + r3.x, g1 = r0.y + r1.y + r2.y + r3.y;
        float4 pa = *(const float4*)(RED + (pw * 16 + t) * 4), pb = *(const float4*)(RED + ((pw + 1) * 16 + t) * 4);
        float h0 = pa.z + pb.z, h1 = pa.w + pb.w;
        u16* rowp = p.PROJ + (m0 + t) * LDP;
        rowp[C_Z + tid] = f2bf(ys[0][t] * rsqrtf(g0 * (1.f / 256.f) + 1e-6f) * nw0);
        rowp[C_Z + tid + 256] = f2bf(ys[1][t] * rsqrtf(g1 * (1.f / 256.f) + 1e-6f) * nw1);
        float gg0 = bf2f(rowp[C_GG + tid]), gg1 = bf2f(rowp[C_GG + tid + 256]);
        rowp[C_GG + tid] = f2bf(oh[0][t] * rsqrtf(h0 * (1.f / 128.f) + 1e-6f) * hw0 * siluf_(gg0));
        rowp[C_GG + tid + 256] = f2bf(oh[1][t] * rsqrtf(h1 * (1.f / 128.f) + 1e-6f) * hw1 * siluf_(gg1));
      }
    }
    float ga[2][16];
#pragma unroll
    for (int c = 0; c < 2; ++c)
#pragma unroll
      for (int t = 0; t < 16; ++t) ga[c][t] = 0.f;
    {
      const float* g2 = p.rw_g2 + (long)l * 128 * 512;
      for (int i = 0; i < 128; ++i) {
        float gv[2] = {g2[i * 512 + tid], g2[i * 512 + tid + 256]};
#pragma unroll
        for (int q = 0; q < 4; ++q) {
          float4 x = *(const float4*)(SG + i * 16 + q * 4);
#pragma unroll
          for (int c = 0; c < 2; ++c) {
            ga[c][q * 4 + 0] += x.x * gv[c]; ga[c][q * 4 + 1] += x.y * gv[c];
            ga[c][q * 4 + 2] += x.z * gv[c]; ga[c][q * 4 + 3] += x.w * gv[c];
          }
        }
      }
    }
#pragma unroll
    for (int c = 0; c < 2; ++c) {
      int ch = tid + 256 * c, head = wid + 4 * c;
      float lw = p.rw_lnx_w[l * 512 + ch], lbv = p.rw_lnx_b[l * 512 + ch];
#pragma unroll
      for (int t = 0; t < 16; ++t) {
        float o = bf2f(p.ORW[(m0 + t) * 512 + ch]);
        float mean = sum64(o) * (1.f / 64.f);
        float d = o - mean;
        float var = sum64(d * d) * (1.f / 64.f);
        float ln = d * rsqrtf(var + 64e-5f) * lw + lbv;
        float v = bf2f(p.PROJ[(m0 + t) * LDP + C_V + ch]);
        float bonus = p.RKS[(m0 + t) * 8 + head] * v;
        p.PROJ[(m0 + t) * LDP + C_R + ch] = f2bf((ln + bonus) * ga[c][t]);
      }
    }
  }
}

__device__ __forceinline__ void phase_final(const Params& p) {
  const int tid = opaque_tid(), lane = tid & 63, wid = tid >> 6;
  for (int m = BID * 4 + wid, nb_ = NBLK; m < M_TOT; m += nb_ * 4) {
    float* dst;
    if (m < M_PROMPT) {
      int b = m / T_P, t = m - b * T_P;
      if (t < 16) continue;
      dst = p.out + O_YP + ((long)b * 4096 + (t - 16)) * DM;
    } else {
      dst = p.out + O_YS + (long)(m - M_PROMPT) * DM;
    }
    float x[16];
    float ss = 0.f;
#pragma unroll
    for (int j = 0; j < 2; ++j) {
      uint4 raw = *(const uint4*)(p.XB + (long)m * DM + lane * 8 + 512 * j);
      unsigned wv[4] = {raw.x, raw.y, raw.z, raw.w};
#pragma unroll
      for (int e = 0; e < 8; ++e) {
        x[j * 8 + e] = bf2f((u16)((wv[e >> 1] >> ((e & 1) * 16)) & 0xffff));
        ss += x[j * 8 + e] * x[j * 8 + e];
      }
    }
    ss = sum64(ss);
    float rs = rsqrtf(ss * (1.f / 1024.f) + 1e-6f);
#pragma unroll
    for (int j = 0; j < 2; ++j) {
      int k0 = lane * 8 + 512 * j;
      float4 w0 = *(const float4*)(p.final_w + k0), w1 = *(const float4*)(p.final_w + k0 + 4);
      *(float4*)(dst + k0) = make_float4(x[j * 8 + 0] * rs * w0.x, x[j * 8 + 1] * rs * w0.y, x[j * 8 + 2] * rs * w0.z,
                                         x[j * 8 + 3] * rs * w0.w);
      *(float4*)(dst + k0 + 4) = make_float4(x[j * 8 + 4] * rs * w1.x, x[j * 8 + 5] * rs * w1.y,
                                             x[j * 8 + 6] * rs * w1.z, x[j * 8 + 7] * rs * w1.w);
    }
  }
}


#define XB_TMO      128
#define XB_XCNT(j)  (256  + 64 * (j))
#define XB_XSUB(j)  (1280 + 64 * (j))
#define XB_XGEN(j)  (2304 + 64 * (j))
#define XB_TOP      3328
#define XB_TOPGEN   3392
#define XCD_BAR_WORDS 3456
#define XB_SPIN_CAP (1u << 22)
__device__ __forceinline__ unsigned xb_ld(unsigned* p) { return __hip_atomic_load(p, __ATOMIC_RELAXED, __HIP_MEMORY_SCOPE_AGENT); }
__device__ __forceinline__ unsigned xb_add(unsigned* p, unsigned v) { return __hip_atomic_fetch_add(p, v, __ATOMIC_RELAXED, __HIP_MEMORY_SCOPE_AGENT); }
__device__ __forceinline__ unsigned xb_xcc_id() { return (unsigned)__builtin_amdgcn_s_getreg((3 << 11) | 20) & 0xFu; }
#define XB_SPIN(cond, bar) do { unsigned _sp = 0; while (cond) { __builtin_amdgcn_s_sleep(1); \
    if ((++_sp & 255u) == 0u) { if (xb_ld(&(bar)[XB_TMO])) break; if (_sp > XB_SPIN_CAP) { atomicAdd(&(bar)[XB_TMO], 1u); break; } } } } while (0)

__device__ __forceinline__ void xcd_barrier_post(unsigned* bar) {
  if (threadIdx.x == 0) (void)xb_add(&bar[XB_XCNT(xb_xcc_id())], 1u);
}
__device__ __forceinline__ void xcd_barrier_complete(unsigned* bar, unsigned x, unsigned& nloc, unsigned& nx) {
  const unsigned G = gridDim.x;
  unsigned sum, cnt, mine, sp = 0u;
  for (;;) {
    sum = 0u; cnt = 0u; mine = 0u;
#pragma unroll
    for (unsigned j = 0; j < 16; ++j) { const unsigned c = xb_ld(&bar[XB_XCNT(j)]); sum += c; cnt += (c > 0u) ? 1u : 0u; mine = (j == x) ? c : mine; }
    if (sum == G) break;
    __builtin_amdgcn_s_sleep(1);
    if ((++sp & 255u) == 0u) { if (xb_ld(&bar[XB_TMO])) break; if (sp > XB_SPIN_CAP) { atomicAdd(&bar[XB_TMO], 1u); break; } }
  }
  nloc = mine > 0u ? mine : 1u; nx = cnt > 0u ? cnt : 1u;
}
__device__ __forceinline__ void xcd_barrier(unsigned* bar, volatile unsigned* st) {
  asm volatile("s_waitcnt vmcnt(0)" ::: "memory");
  __syncthreads();
  if (threadIdx.x == 0) {
    __builtin_amdgcn_s_waitcnt(0);
    const unsigned x = xb_xcc_id();
    unsigned nloc = st[0], nx = st[1];
    if (nloc == 0u) { xcd_barrier_complete(bar, x, nloc, nx); st[0] = nloc; st[1] = nx; }
    const unsigned old = xb_add(&bar[XB_XSUB(x)], 1u);
    const unsigned gen = old / nloc;
    if (old + 1u == (gen + 1u) * nloc) {
      __builtin_amdgcn_fence(__ATOMIC_RELEASE, "agent");
      asm volatile("s_waitcnt vmcnt(0)" ::: "memory");
      const unsigned og = xb_add(&bar[XB_TOP], 1u);
      const unsigned tg = og / nx;
      if (og + 1u == (tg + 1u) * nx) xb_add(&bar[XB_TOPGEN], 1u);
      else XB_SPIN(xb_ld(&bar[XB_TOPGEN]) == tg, bar);
      __builtin_amdgcn_fence(__ATOMIC_ACQUIRE, "agent");
      xb_add(&bar[XB_XGEN(x)], 1u);
      asm volatile("s_waitcnt vmcnt(0)" ::: "memory");
    } else {
      XB_SPIN(xb_ld(&bar[XB_XGEN(x)]) == gen, bar);
      __builtin_amdgcn_fence(__ATOMIC_ACQUIRE, "agent");
      asm volatile("s_waitcnt vmcnt(0)" ::: "memory");
    }
  }
  __syncthreads();
}

constexpr int SMEM_BYTES = 40960;
__device__ __forceinline__ void run_phase(const Params& p, int ph, char* smem) {
  if (ph == 0) { phase_embed(p); return; }
  if (ph == 19) { phase_final(p); return; }
  int l = (ph - 1) / 9, s = (ph - 1) % 9;
  float* fs = (float*)smem;
  switch (s) {
    case 0: phase_convert(p, l, fs); phase_rowstat<true>(p, l, fs); break;
    case 1: phase_gemm<1>(p, p.XB, DM, p.W1T, 1024, LDP / 128, smem); break;
    case 2: phase_pre(p, l, fs); break;
    case 3: phase_scan(p, l, fs); break;
    case 4: phase_post(p, l, fs); break;
    case 5: phase_gemm<2>(p, p.PROJ, LDP, p.WOT, 1536, 8, smem); break;
    case 6: phase_rowstat<false>(p, l, fs); break;
    case 7: phase_gemm<3>(p, p.XB, DM, p.WGU, 1024, 44, smem); break;
    case 8: phase_gemm<2>(p, p.PROJ, D_FF, p.WDT, D_FF, 8, smem); break;
  }
}
constexpr int N_PHASES = 20;

#if MEGA
__global__ void __launch_bounds__(256, 3) k_mega(Params p) {
  __shared__ __attribute__((aligned(16))) char smem[SMEM_BYTES];
  __shared__ uint4 xb_words;
  if (threadIdx.x == 0) { xb_words = make_uint4(0u, 0u, 0u, 0u); }
  __syncthreads();
  cg::grid_group grid = cg::this_grid();
  float* fs = (float*)smem;
  volatile unsigned* xst = (volatile unsigned*)&xb_words;
  xcd_barrier_post(p.bar);
  phase_embed(p);
  grid.sync();
#define GSYNC() do { unsigned* b_ = p.bar; asm volatile("" : "+s"(b_)); xcd_barrier(b_, xst); } while (0)
#pragma unroll 1
  for (int l0 = 0; l0 < 2; ++l0) {
    int l = opaque_s(l0);
    phase_convert(p, l, fs);
    phase_rowstat<true>(p, l, fs);
    GSYNC();
    l = opaque_s(l);
    phase_gemm<1>(p, p.XB, DM, p.W1T, 1024, LDP / 128, smem);
    GSYNC();
    l = opaque_s(l);
    phase_pre(p, l, fs);
    GSYNC();
    l = opaque_s(l);
    phase_scan(p, l, fs);
    GSYNC();
    l = opaque_s(l);
    phase_post(p, l, fs);
    GSYNC();
    l = opaque_s(l);
    phase_gemm<2>(p, p.PROJ, LDP, p.WOT, 1536, 8, smem);
    GSYNC();
    l = opaque_s(l);
    phase_rowstat<false>(p, l, fs);
    GSYNC();
    l = opaque_s(l);
    phase_gemm<3>(p, p.XB, DM, p.WGU, 1024, 44, smem);
    GSYNC();
    l = opaque_s(l);
    phase_gemm<2>(p, p.PROJ, D_FF, p.WDT, D_FF, 8, smem);
    GSYNC();
  }
  phase_final(p);
}
#else
template <int PH>
__global__ void __launch_bounds__(256, 3) k_phase(Params p) {
  __shared__ __attribute__((aligned(16))) char smem[SMEM_BYTES];
  run_phase(p, PH, smem);
}
template <int PH>
static void launch_all(const Params& p, int grid, hipStream_t stream) {
  hipLaunchKernelGGL(k_phase<PH>, dim3(grid), dim3(256), 0, stream, p);
  if constexpr (PH + 1 < N_PHASES) launch_all<PH + 1>(p, grid, stream);
}
#endif

extern "C" void kernel_launch(void* const* d_in, const int* in_sizes, int n_in, void* d_out, int out_size, void* d_ws,
                              size_t ws_size, hipStream_t stream) {
  Params p{};
  const float** pf = (const float**)&p;
  for (int i = 0; i < 35; ++i) pf[i] = (const float*)d_in[i];
  p.out = (float*)d_out;
  char* ws = (char*)d_ws;
  size_t off = 0;
  auto take = [&](size_t bytes) { char* r = ws + off; off += (bytes + 255) & ~(size_t)255; return r; };
  p.XB = (u16*)take((size_t)M_TOT * DM * 2);
  p.PROJ = (u16*)take((size_t)M_TOT * LDP * 2);
  p.W1T = (u16*)take((size_t)LDP * 1024 * 2);
  p.WOT = (u16*)take((size_t)1024 * 1536 * 2);
  p.WGU = (u16*)take((size_t)5632 * 1024 * 2);
  p.WDT = (u16*)take((size_t)1024 * D_FF * 2);
  p.BND = (u16*)take((size_t)NBLK16 * 1792 * 2);
  p.ORW = (u16*)take((size_t)M_TOT * 512 * 2);
  p.RS = (float*)take((size_t)M_TOT * 4);
  p.DTRAW = (float*)take((size_t)M_TOT * 8 * 4);
  p.RKS = (float*)take((size_t)M_TOT * 8 * 4);
  p.bar = (unsigned*)take((size_t)XCD_BAR_WORDS * 4);
  p.RWX = (u16*)d_out;
  if (off > ws_size) fprintf(stderr, "workspace too small: need %zu have %zu\n", off, ws_size);
#if MEGA
  static int grid_blocks = 0;
  if (!grid_blocks) {
    int dev = 0, cus = 0, per_cu = 0;
    hipGetDevice(&dev);
    hipDeviceGetAttribute(&cus, hipDeviceAttributeMultiprocessorCount, dev);
    hipOccupancyMaxActiveBlocksPerMultiprocessor(&per_cu, k_mega, 256, 0);
    if (per_cu > 3) per_cu = 3;
    grid_blocks = cus * per_cu;
  }
  hipMemsetAsync(p.bar, 0, (size_t)XCD_BAR_WORDS * 4, stream);
  void* args[] = {&p};
  hipError_t e = hipLaunchCooperativeKernel((void*)k_mega, dim3(grid_blocks), dim3(256), args, 0, stream);
  if (e != hipSuccess) fprintf(stderr, "cooperative launch failed: %s (grid %d)\n", hipGetErrorString(e), grid_blocks);
#else
  launch_all<0>(p, 768, stream);
#endif
}
```

```cpp
#include <hip/hip_runtime.h>
#include <hip/hip_bf16.h>
#include <hip/hip_cooperative_groups.h>
#include <cstdio>
namespace cg = cooperative_groups;

#ifndef MEGA
#define MEGA 1
#endif

typedef unsigned short u16;
using bf16x8 = __attribute__((ext_vector_type(8))) short;
using f32x16 = __attribute__((ext_vector_type(16))) float;

constexpr int DM = 1024;
constexpr int M_TOT = 33408;
constexpr int M_PROMPT = 32896;
constexpr int T_P = 4112;
constexpr int LDP = 5376;
constexpr int N_IN = 5384;
constexpr int D_FF = 2816;
constexpr int NBLK16 = M_TOT / 16;
constexpr int C_Z = 0, C_R = 512, C_GG = 1024, C_XBC = 1536, C_K = 2560, C_V = 3072, C_XW = 3584, C_XA = 3648,
              C_XG = 3712, C_Q = 3840, C_F = 4352, C_I = 4864;
constexpr long O_YP = 0, O_YS = 33554432, O_PSSM = 34078720, O_PCONV = 35127296, O_PRWKV = 35176448,
               O_PSHIFT = 35700736, O_PHGRN = 35729408, O_SSSM = 36777984, O_SCONV = 37826560,
               O_SRWKV = 37875712, O_SSHIFT = 38400000, O_SHGRN = 38428672;

struct Params {
  const float *x_prompt, *x_sample, *state_ssm, *state_conv, *state_rwkv, *state_shift, *state_hgrn, *meta,
      *norm1_w, *w_in, *conv_w, *conv_b, *dt_bias, *a_log, *d_skip, *ssd_norm_w, *rw_mu, *rw_w0, *rw_w2, *rw_a0,
      *rw_a2, *rw_g2, *rw_kk, *rw_ka, *rw_rk, *rw_lnx_w, *rw_lnx_b, *hg_lb, *hg_norm_w, *w_out, *norm2_w, *w_gate,
      *w_up, *w_down, *final_w;
  float* out;
  u16 *XB, *PROJ, *W1T, *WOT, *WGU, *WDT, *BND, *ORW, *RWX;
  float *RS, *DTRAW, *RKS;
  unsigned* bar;
};

__device__ __forceinline__ u16 f2bf(float f) {
  unsigned u = __float_as_uint(f);
  u += 0x7fffu + ((u >> 16) & 1u);
  return (u16)(u >> 16);
}
__device__ __forceinline__ float bf2f(u16 h) { return __uint_as_float(((unsigned)h) << 16); }
__device__ __forceinline__ float frcp_(float x) { return __builtin_amdgcn_rcpf(x); }
__device__ __forceinline__ float sigmoidf_(float x) { return frcp_(1.f + __expf(-x)); }
__device__ __forceinline__ float siluf_(float x) { return x * frcp_(1.f + __expf(-x)); }
__device__ __forceinline__ float softplusf_(float x) { return x > 20.f ? x : log1pf(__expf(x)); }

template <int CTRL>
__device__ __forceinline__ float dppf(float v) {
  return __int_as_float(__builtin_amdgcn_update_dpp(0, __float_as_int(v), CTRL, 0xF, 0xF, true));
}
__device__ __forceinline__ float sum16(float v) {
  v += dppf<0xB1>(v);
  v += dppf<0x4E>(v);
  v += dppf<0x141>(v);
  v += dppf<0x140>(v);
  return v;
}
__device__ __forceinline__ void sum16x2(float& a, float& b) {
  a += dppf<0xB1>(a); b += dppf<0xB1>(b);
  a += dppf<0x4E>(a); b += dppf<0x4E>(b);
  a += dppf<0x141>(a); b += dppf<0x141>(b);
  a += dppf<0x140>(a); b += dppf<0x140>(b);
}
__device__ __forceinline__ float sum64(float v) {
  v = sum16(v);
  v += __shfl_xor(v, 16);
  v += __shfl_xor(v, 32);
  return v;
}

#define NOPK(x) asm("" : "+v"(x))
__device__ __forceinline__ int opaque_tid() {
  int t = threadIdx.x;
  asm volatile("" : "+v"(t));
  return t;
}
__device__ __forceinline__ int opaque_s(int v) {
  asm volatile("" : "+s"(v));
  return v;
}
#define BID opaque_s((int)blockIdx.x)
#define NBLK opaque_s((int)gridDim.x)
__device__ __forceinline__ int seq_base(int s) { return s < 8 ? s * T_P : M_PROMPT + (s - 8) * 64; }
__device__ __forceinline__ int seq_len(int s) { return s < 8 ? T_P : 64; }

__device__ __forceinline__ void phase_embed(const Params& p) {
  const long n4 = (long)M_TOT * 256;
  for (long idx = (long)BID * 256 + threadIdx.x, st_ = (long)NBLK * 256; idx < n4; idx += st_) {
    int m = (int)(idx >> 8), c4 = ((int)idx & 255) * 4;
    const float* src;
    if (m < M_PROMPT) {
      int b = m / T_P, t = m - b * T_P;
      src = (t < 16) ? p.meta + (long)t * DM : p.x_prompt + ((long)b * 4096 + (t - 16)) * DM;
    } else {
      src = p.x_sample + (long)(m - M_PROMPT) * DM;
    }
    float4 v = *(const float4*)(src + c4);
    ushort4 o;
    o.x = f2bf(v.x); o.y = f2bf(v.y); o.z = f2bf(v.z); o.w = f2bf(v.w);
    *(ushort4*)(p.XB + (long)m * DM + c4) = o;
  }
}

template <bool HAS_SCALE>
__device__ __forceinline__ void conv_tile(const float* __restrict__ src, int ldsrc, int srccol0, const float* __restrict__ scale,
                          u16* __restrict__ dst, int K, int k0, int n0, float* tile  ) {
  const int tid = opaque_tid();
  __syncthreads();
  {
    int nn = tid & 63, kb = tid >> 6;
#pragma unroll
    for (int i = 0; i < 16; ++i) {
      int kk = kb + 4 * i;
      float v = src[(long)(k0 + kk) * ldsrc + srccol0 + nn];
      if (HAS_SCALE) v *= scale[k0 + kk];
      tile[kk * 65 + nn] = v;
    }
  }
  __syncthreads();
  {
    int nn = tid >> 2, kq = (tid & 3) * 16;
    u16* d = dst + (long)(n0 + nn) * K + k0 + kq;
#pragma unroll
    for (int j = 0; j < 16; j += 2) {
      unsigned w = f2bf(tile[(kq + j) * 65 + nn]) | ((unsigned)f2bf(tile[(kq + j + 1) * 65 + nn]) << 16);
      *(unsigned*)(d + j) = w;
    }
  }
}

__device__ __forceinline__ int w1_srccol(int n0) {
  if (n0 < 512) return n0;
  if (n0 < 1024) return n0 - 512 + 1544;
  if (n0 < 1536) return n0 - 1024 + 4872;
  if (n0 < 2560) return n0 - 1536 + 512;
  if (n0 < 3840) return n0 - 2560 + 2056;
  return n0 - 3840 + 3336;
}

constexpr int CV_W1 = 16 * 84, CV_WO = 24 * 16, CV_WGU = 16 * 88, CV_WD = 44 * 16;
constexpr int CV_TOTAL = CV_W1 + CV_WO + CV_WGU + CV_WD;

__device__ __forceinline__ void phase_convert(const Params& p, int l, float* smem) {
  for (int u = BID, nb_ = NBLK; u < CV_TOTAL; u += nb_) {
    if (u < CV_W1) {
      int kt = u % 16, nt = u / 16;
      conv_tile<true>(p.w_in + (long)l * DM * N_IN, N_IN, w1_srccol(nt * 64), p.norm1_w + l * DM, p.W1T, 1024, kt * 64,
                nt * 64, smem);
    } else if (u < CV_W1 + CV_WO) {
      int v = u - CV_W1;
      int kt = v % 24, nt = v / 24;
      conv_tile<false>(p.w_out + (long)l * 1536 * DM, DM, nt * 64, nullptr, p.WOT, 1536, kt * 64, nt * 64, smem);
    } else if (u < CV_W1 + CV_WO + CV_WGU) {
      int v = u - CV_W1 - CV_WO;
      int kt = v % 16, nt = v / 16;
      const float* wg = p.w_gate + (long)l * DM * D_FF;
      const float* wu = p.w_up + (long)l * DM * D_FF;
      const float* sc = p.norm2_w + l * DM;
      const int tid = opaque_tid();
      __syncthreads();
      {
        int nn = tid & 63, kb = tid >> 6;
        const float* src = (nn < 32) ? wg : wu;
        int col = nt * 32 + (nn & 31);
#pragma unroll
        for (int i = 0; i < 16; ++i) {
          int kk = kb + 4 * i;
          smem[kk * 65 + nn] = src[(long)(kt * 64 + kk) * D_FF + col] * sc[kt * 64 + kk];
        }
      }
      __syncthreads();
      {
        int nn = tid >> 2, kq = (tid & 3) * 16;
        u16* d = p.WGU + (long)(nt * 64 + nn) * 1024 + kt * 64 + kq;
#pragma unroll
        for (int j = 0; j < 16; j += 2) {
          unsigned w = f2bf(smem[(kq + j) * 65 + nn]) | ((unsigned)f2bf(smem[(kq + j + 1) * 65 + nn]) << 16);
          *(unsigned*)(d + j) = w;
        }
      }
    } else {
      int v = u - CV_W1 - CV_WO - CV_WGU;
      int kt = v % 44, nt = v / 44;
      conv_tile<false>(p.w_down + (long)l * D_FF * DM, DM, nt * 64, nullptr, p.WDT, D_FF, kt * 64, nt * 64, smem);
    }
  }
}

template <bool WITH_DT>
__device__ __forceinline__ void phase_rowstat(const Params& p, int l, float* smem) {
  const int tid = opaque_tid(), lane = tid & 63, wid = tid >> 6;
  float* dtw = smem;
  if (WITH_DT) {
    __syncthreads();
    const float* w = p.w_in + (long)l * DM * N_IN + 1536;
    const float* nw = p.norm1_w + l * DM;
    for (int i = tid; i < 8192; i += 256) {
      int k = i >> 3, h = i & 7;
      dtw[i] = w[(long)k * N_IN + h] * nw[k];
    }
    __syncthreads();
  }
  for (int blk = BID, nb_ = NBLK; blk < NBLK16; blk += nb_) {
    for (int rr = wid; rr < 16; rr += 4) {
      int m = blk * 16 + rr;
      float ss = 0.f;
      float d[8];
#pragma unroll
      for (int h = 0; h < 8; ++h) d[h] = 0.f;
#pragma unroll 1
      for (int j = 0; j < 4; ++j) {
        int k0 = lane * 4 + 256 * j;
        uint2 raw = *(const uint2*)(p.XB + (long)m * DM + k0);
        float xs[4] = {bf2f((u16)(raw.x & 0xffff)), bf2f((u16)(raw.x >> 16)), bf2f((u16)(raw.y & 0xffff)),
                       bf2f((u16)(raw.y >> 16))};
#pragma unroll
        for (int e = 0; e < 4; ++e) {
          float x = xs[e];
          ss += x * x;
          if (WITH_DT) {
            float4 w0 = *(const float4*)(dtw + (k0 + e) * 8);
            float4 w1 = *(const float4*)(dtw + (k0 + e) * 8 + 4);
            d[0] += x * w0.x; d[1] += x * w0.y; d[2] += x * w0.z; d[3] += x * w0.w;
            d[4] += x * w1.x; d[5] += x * w1.y; d[6] += x * w1.z; d[7] += x * w1.w;
          }
        }
      }
      ss = sum64(ss);
      float rs = rsqrtf(ss * (1.f / 1024.f) + 1e-6f);
      if (WITH_DT) {
#pragma unroll
        for (int h = 0; h < 8; ++h) d[h] = sum64(d[h]);
        if (lane == 0) {
#pragma unroll
          for (int h = 0; h < 8; ++h) p.DTRAW[(long)m * 8 + h] = d[h] * rs;
        }
      }
      if (lane == 0) p.RS[m] = rs;
    }
  }
}

constexpr int G_BK = 32, G_LDS_ROW = 80;
constexpr int G_OPER_BYTES = 128 * G_LDS_ROW;
template <int MODE>
__device__ __forceinline__ void phase_gemm(const Params& p, const u16* __restrict__ A, int lda, const u16* __restrict__ Bt, int K,
                           int nN, char* smem) {
  const int tid = opaque_tid(), lane = tid & 63, wid = tid >> 6, wm = wid >> 1, wn = wid & 1;
  const int nM = M_TOT / 128;
  const int ntiles = nM * nN;
  const int nk = K / G_BK;
  const int lrow = tid >> 2, lkc = tid & 3;
  for (int tile = BID, nb_ = NBLK; tile < ntiles; tile += nb_) {
    int grp = tile / (8 * nN);
    int first_m = grp * 8;
    int gsz = min(8, nM - first_m);
    int rem = tile - grp * 8 * nN;
    int pm = first_m + rem % gsz, pn = rem / gsz;
    const u16* gA = A + (long)(pm * 128 + lrow) * lda + lkc * 8;
    const u16* gB = Bt + (long)(pn * 128 + lrow) * K + lkc * 8;
    f32x16 acc[2][2];
#pragma unroll
    for (int i = 0; i < 2; ++i)
#pragma unroll
      for (int j = 0; j < 2; ++j)
#pragma unroll
        for (int r = 0; r < 16; ++r) acc[i][j][r] = 0.f;
    uint4 xa0, xa1, xb0, xb1, ya0, ya1, yb0, yb1;
#define G_LOAD(S, KT)                                                  \
  {                                                                    \
    S##a0 = *(const uint4*)(gA + (KT) * G_BK);                         \
    S##a1 = *(const uint4*)(gA + (long)64 * lda + (KT) * G_BK);        \
    S##b0 = *(const uint4*)(gB + (KT) * G_BK);                         \
    S##b1 = *(const uint4*)(gB + (long)64 * K + (KT) * G_BK);          \
  }
#define G_STORE(S, BUF)                                                \
  {                                                                    \
    char* dA = smem + (BUF) * 2 * G_OPER_BYTES;                        \
    char* dB = dA + G_OPER_BYTES;                                      \
    *(uint4*)(dA + lrow * G_LDS_ROW + lkc * 16) = S##a0;               \
    *(uint4*)(dA + (lrow + 64) * G_LDS_ROW + lkc * 16) = S##a1;        \
    *(uint4*)(dB + lrow * G_LDS_ROW + lkc * 16) = S##b0;               \
    *(uint4*)(dB + (lrow + 64) * G_LDS_ROW + lkc * 16) = S##b1;        \
  }
#define G_COMPUTE(BUF)                                                                           \
  {                                                                                              \
    const char* sA = smem + (BUF) * 2 * G_OPER_BYTES;                                            \
    const char* sB = sA + G_OPER_BYTES;                                                          \
    _Pragma("unroll") for (int ks = 0; ks < 2; ++ks) {                                           \
      bf16x8 af[2], bfr[2];                                                                      \
      const int koff = (ks * 16 + (lane >> 5) * 8) * 2;                                          \
      _Pragma("unroll") for (int i = 0; i < 2; ++i)                                              \
        af[i] = *(const bf16x8*)(sA + (wm * 64 + i * 32 + (lane & 31)) * G_LDS_ROW + koff);      \
      _Pragma("unroll") for (int j = 0; j < 2; ++j)                                              \
        bfr[j] = *(const bf16x8*)(sB + (wn * 64 + j * 32 + (lane & 31)) * G_LDS_ROW + koff);     \
      _Pragma("unroll") for (int i = 0; i < 2; ++i)                                              \
        _Pragma("unroll") for (int j = 0; j < 2; ++j)                                            \
          acc[i][j] = __builtin_amdgcn_mfma_f32_32x32x16_bf16(af[i], bfr[j], acc[i][j], 0, 0, 0); \
    }                                                                                            \
  }
    G_LOAD(x, 0);
    G_LOAD(y, 1);
    __builtin_amdgcn_sched_barrier(0);
    __syncthreads();
    G_STORE(x, 0);
    __syncthreads();
    for (int kt = 0; kt < nk; kt += 2) {
      if (kt + 2 < nk) G_LOAD(x, kt + 2);
      __builtin_amdgcn_sched_barrier(0);
      G_COMPUTE(0);
      __builtin_amdgcn_sched_barrier(0);
      G_STORE(y, 1);
      __syncthreads();
      if (kt + 3 < nk) G_LOAD(y, kt + 3);
      __builtin_amdgcn_sched_barrier(0);
      G_COMPUTE(1);
      __builtin_amdgcn_sched_barrier(0);
      if (kt + 2 < nk) G_STORE(x, 0);
      __syncthreads();
    }
#undef G_LOAD
#undef G_STORE
#undef G_COMPUTE
    const int colb = pn * 128 + wn * 64 + (lane & 31);
    const int rowb = pm * 128 + wm * 64 + 4 * (lane >> 5);
    if (MODE == 1) {
#pragma unroll
      for (int i = 0; i < 2; ++i)
#pragma unroll
        for (int r = 0; r < 16; ++r) {
          int row = rowb + i * 32 + (r & 3) + 8 * (r >> 2);
          float rs = p.RS[row];
#pragma unroll
          for (int j = 0; j < 2; ++j) {
            int col = colb + j * 32;
            u16 v = f2bf(acc[i][j][r] * rs);
            p.PROJ[(long)row * LDP + col] = v;
            if ((row & 15) == 15) {
              int jj = -1;
              if (col >= C_R && col < C_GG) jj = col - C_R;
              else if (col >= C_K && col < C_Q) jj = col - C_K + 512;
              if (jj >= 0) p.BND[(long)(row >> 4) * 1792 + jj] = v;
            }
          }
        }
    } else if (MODE == 2) {
#pragma unroll
      for (int i = 0; i < 2; ++i)
#pragma unroll
        for (int r = 0; r < 16; ++r) {
          int row = rowb + i * 32 + (r & 3) + 8 * (r >> 2);
#pragma unroll
          for (int j = 0; j < 2; ++j) {
            int col = colb + j * 32;
            u16* px = p.XB + (long)row * DM + col;
            *px = f2bf(bf2f(*px) + acc[i][j][r]);
          }
        }
    } else {
      const int cact = pn * 64 + wn * 32 + (lane & 31);
      u16* ACT = p.PROJ;
#pragma unroll
      for (int i = 0; i < 2; ++i)
#pragma unroll
        for (int r = 0; r < 16; ++r) {
          int row = rowb + i * 32 + (r & 3) + 8 * (r >> 2);
          float rs = p.RS[row];
          float g = acc[i][0][r] * rs, u = acc[i][1][r] * rs;
          ACT[(long)row * D_FF + cact] = f2bf(siluf_(g) * u);
        }
    }
  }
}

__device__ __forceinline__ void phase_pre(const Params& p, int l, float* smem) {
  const int tid = opaque_tid(), lane = tid & 63, wid = tid >> 6;
  float* XW = smem;
  float* XA = smem + 1024;
  const float* mu = p.rw_mu + l * 1792;
  for (int blk = BID, nb_ = NBLK; blk < NBLK16; blk += nb_) {
    const int m0 = blk * 16;
    int s, t0;
    if (m0 < M_PROMPT) { s = m0 / T_P; t0 = m0 - s * T_P; } else { s = 8 + (m0 - M_PROMPT) / 64; t0 = (m0 - M_PROMPT) & 63; }
    const bool first = (t0 == 0);
    auto prev_of = [&](int j) -> float {
      if (!first) return bf2f(p.BND[(long)(blk - 1) * 1792 + j]);
      if (s < 8) return 0.f;
      return p.state_shift[((long)l * 8 + (s - 8)) * 1792 + j];
    };
    __syncthreads();
    {
      int j = 1536 + tid;
      float mj = mu[j];
      float pv = prev_of(j);
      u16* col = p.PROJ + (long)m0 * LDP + C_XW + tid;
#pragma unroll
      for (int t = 0; t < 16; ++t) {
        float x = bf2f(col[(long)t * LDP]);
        float sh = x + (pv - x) * mj;
        pv = x;
        if (tid < 64) XW[tid * 16 + t] = tanhf(sh);
        else if (tid < 128) XA[(tid - 64) * 16 + t] = sh;
        else col[(long)t * LDP] = f2bf(sigmoidf_(sh));
      }
    }
    __syncthreads();
#pragma unroll 1
    for (int c = 0; c < 2; ++c) {
      const int ch = tid + 256 * c;
      const int head = wid + 4 * c;
      float aw[16], aa[16];
#pragma unroll
      for (int t = 0; t < 16; ++t) { aw[t] = 0.f; aa[t] = 0.f; }
      {
        const float* w2 = p.rw_w2 + (long)l * 64 * 512 + ch;
        const float* a2 = p.rw_a2 + (long)l * 64 * 512 + ch;
#pragma unroll 2
        for (int i = 0; i < 64; ++i) {
          float w2v = w2[i * 512];
          float a2v = a2[i * 512];
#pragma unroll
          for (int q = 0; q < 4; ++q) {
            float4 xw = *(const float4*)(XW + i * 16 + q * 4);
            float4 xa = *(const float4*)(XA + i * 16 + q * 4);
            aw[q * 4 + 0] += xw.x * w2v; aw[q * 4 + 1] += xw.y * w2v;
            aw[q * 4 + 2] += xw.z * w2v; aw[q * 4 + 3] += xw.w * w2v;
            aa[q * 4 + 0] += xa.x * a2v; aa[q * 4 + 1] += xa.y * a2v;
            aa[q * 4 + 2] += xa.z * a2v; aa[q * 4 + 3] += xa.w * a2v;
          }
        }
      }
      {
        float w0 = p.rw_w0[l * 512 + ch], a0 = p.rw_a0[l * 512 + ch];
#pragma unroll
        for (int t = 0; t < 16; ++t) {
          float lw = -softplusf_(-(w0 + aw[t])) - 0.5f;
          float u = -__expf(lw);
          p.RWX[(long)(m0 + t) * 1536 + ch] = f2bf(u);
          aa[t] = sigmoidf_(a0 + aa[t]);
        }
      }
      float rt[16];
      {
        float mj = mu[ch];
        float pv = prev_of(ch);
        u16* col = p.PROJ + (long)m0 * LDP + C_R + ch;
#pragma unroll
        for (int t = 0; t < 16; ++t) {
          float x = bf2f(col[(long)t * LDP]);
          rt[t] = x + (pv - x) * mj;
          pv = x;
        }
#pragma unroll
        for (int t = 0; t < 16; ++t) col[(long)t * LDP] = f2bf(rt[t]);
      }
      {
        float mj = mu[512 + ch];
        float pv = prev_of(512 + ch);
        float kkw = p.rw_kk[l * 512 + ch], kaw = p.rw_ka[l * 512 + ch], rkw = p.rw_rk[l * 512 + ch];
        u16* col = p.PROJ + (long)m0 * LDP + C_K + ch;
        float kt[16];
#pragma unroll
        for (int t = 0; t < 16; ++t) {
          float x = bf2f(col[(long)t * LDP]);
          kt[t] = x + (pv - x) * mj;
          pv = x;
        }
#pragma unroll
        for (int t = 0; t < 16; ++t) {
          float kkv = kt[t] * kkw;
          float ssq = sum64(kkv * kkv);
          float kk = kkv * rsqrtf(ssq + 1e-12f);
          float a = aa[t];
          float kp = kt[t] * (1.f + (a - 1.f) * kaw);
          float rks = sum64(rt[t] * kp * rkw);
          col[(long)t * LDP] = f2bf(kp);
          p.RWX[(long)(m0 + t) * 1536 + 512 + ch] = f2bf(kk);
          p.RWX[(long)(m0 + t) * 1536 + 1024 + ch] = f2bf(kk * a);
          if (lane == 0) p.RKS[(long)(m0 + t) * 8 + head] = rks;
        }
      }
      {
        float mj = mu[1024 + ch];
        float pv = prev_of(1024 + ch);
        u16* col = p.PROJ + (long)m0 * LDP + C_V + ch;
        float vt[16];
#pragma unroll
        for (int t = 0; t < 16; ++t) {
          float x = bf2f(col[(long)t * LDP]);
          vt[t] = x + (pv - x) * mj;
          pv = x;
        }
#pragma unroll
        for (int t = 0; t < 16; ++t) col[(long)t * LDP] = f2bf(vt[t]);
      }
    }
    if (t0 + 16 == seq_len(s)) {
      float* o = p.out + (s < 8 ? O_PSHIFT + ((long)l * 8 + s) * 1792 : O_SSHIFT + ((long)l * 8 + (s - 8)) * 1792);
      for (int j = tid; j < 1792; j += 256) o[j] = bf2f(p.BND[(long)blk * 1792 + j]);
    }
  }
}

__device__ __forceinline__ void scan_rwkv(const Params& p, int l, int s, int h, int q, float* smem) {
  const int tid = opaque_tid(), lane = tid & 63, wid = tid >> 6;
  float* R_ = smem;
  float* W_ = smem + 1024;
  float* K_ = smem + 2048;
  float* A_ = smem + 3072;
  float* B_ = smem + 4096;
  float* V_ = smem + 5120;
  float* O_ = smem + 5376;
  const int rl = wid * 4 + (lane >> 4);
  const int row = q * 16 + rl;
  const int ksl = (lane & 15) * 4;
  const int base = seq_base(s), T = seq_len(s);
  float s0 = 0.f, s1 = 0.f, s2 = 0.f, s3 = 0.f;
  if (s >= 8) {
    const float* st = p.state_rwkv + (((long)l * 8 + (s - 8)) * 8 + h) * 4096 + row * 64 + ksl;
    float4 v = *(const float4*)st;
    s0 = v.x; s1 = v.y; s2 = v.z; s3 = v.w;
  }
  const int stt = tid >> 4, skq = (tid & 15) * 4;
  const int nblk = T / 16;
  ushort4 r4, k4, u4, a4, b4;
  u16 vv;
  {
    const long m = base + stt;
    const u16* pr = p.PROJ + m * LDP;
    const u16* px = p.RWX + m * 1536;
    r4 = *(const ushort4*)(pr + C_R + h * 64 + skq);
    k4 = *(const ushort4*)(pr + C_K + h * 64 + skq);
    u4 = *(const ushort4*)(px + h * 64 + skq);
    a4 = *(const ushort4*)(px + 512 + h * 64 + skq);
    b4 = *(const ushort4*)(px + 1024 + h * 64 + skq);
    vv = pr[C_V + h * 64 + q * 16 + (tid & 15)];
  }
  __syncthreads();
  float* TR_ = smem + 5376 + 512;
  const bool wr = (lane & 15) == 0;
  const int ooff = wr ? rl : (512 + lane);
  const int ostr = wr ? 16 : 0;
  for (int blk = 0; blk < nblk; ++blk) {
    const long m = base + blk * 16 + stt;
    float* Oc = O_ + (blk & 1) * 256;
    {
      *(float4*)(R_ + stt * 64 + skq) = make_float4(bf2f(r4.x), bf2f(r4.y), bf2f(r4.z), bf2f(r4.w));
      *(float4*)(K_ + stt * 64 + skq) = make_float4(bf2f(k4.x), bf2f(k4.y), bf2f(k4.z), bf2f(k4.w));
      *(float4*)(W_ + stt * 64 + skq) =
          make_float4(__expf(bf2f(u4.x)), __expf(bf2f(u4.y)), __expf(bf2f(u4.z)), __expf(bf2f(u4.w)));
      *(float4*)(A_ + stt * 64 + skq) = make_float4(-bf2f(a4.x), -bf2f(a4.y), -bf2f(a4.z), -bf2f(a4.w));
      *(float4*)(B_ + stt * 64 + skq) = make_float4(bf2f(b4.x), bf2f(b4.y), bf2f(b4.z), bf2f(b4.w));
      V_[stt * 16 + (tid & 15)] = bf2f(vv);
    }
    __syncthreads();
    if (blk > 0)
      p.ORW[(m - 16) * 512 + h * 64 + q * 16 + (tid & 15)] = f2bf(O_[((blk - 1) & 1) * 256 + stt * 16 + (tid & 15)]);
    if (blk + 1 < nblk) {
      const u16* pr = p.PROJ + (m + 16) * LDP;
      const u16* px = p.RWX + (m + 16) * 1536;
      r4 = *(const ushort4*)(pr + C_R + h * 64 + skq);
      k4 = *(const ushort4*)(pr + C_K + h * 64 + skq);
      u4 = *(const ushort4*)(px + h * 64 + skq);
      a4 = *(const ushort4*)(px + 512 + h * 64 + skq);
      b4 = *(const ushort4*)(px + 1024 + h * 64 + skq);
      vv = pr[C_V + h * 64 + q * 16 + (tid & 15)];
    }
    __builtin_amdgcn_sched_barrier(0);
    {
      float4 a = *(const float4*)(A_ + ksl), w = *(const float4*)(W_ + ksl), b = *(const float4*)(B_ + ksl);
      float4 k = *(const float4*)(K_ + ksl), r = *(const float4*)(R_ + ksl);
      float v = V_[rl];
      float opart = 0.f;
#pragma unroll
      for (int tt = 0; tt < 16; ++tt) {
        float4 an, wn, bn, kn, rn;
        float vn;
        if (tt + 1 < 16) {
          an = *(const float4*)(A_ + (tt + 1) * 64 + ksl); wn = *(const float4*)(W_ + (tt + 1) * 64 + ksl);
          bn = *(const float4*)(B_ + (tt + 1) * 64 + ksl); kn = *(const float4*)(K_ + (tt + 1) * 64 + ksl);
          rn = *(const float4*)(R_ + (tt + 1) * 64 + ksl); vn = V_[(tt + 1) * 16 + rl];
        }
        __builtin_amdgcn_sched_barrier(0);
        float sa = fmaf(s0, a.x, fmaf(s1, a.y, fmaf(s2, a.z, s3 * a.w)));
        if (tt > 0) { sum16x2(sa, opart); Oc[ooff + (tt - 1) * ostr] = opart; }
        else sa = sum16(sa);
        s0 = fmaf(s0, w.x, fmaf(sa, b.x, v * k.x)); NOPK(s0);
        s1 = fmaf(s1, w.y, fmaf(sa, b.y, v * k.y)); NOPK(s1);
        s2 = fmaf(s2, w.z, fmaf(sa, b.z, v * k.z)); NOPK(s2);
        s3 = fmaf(s3, w.w, fmaf(sa, b.w, v * k.w)); NOPK(s3);
        opart = fmaf(s0, r.x, fmaf(s1, r.y, fmaf(s2, r.z, s3 * r.w)));
        if (tt == 15) { opart = sum16(opart); Oc[ooff + 15 * ostr] = opart; }
        __builtin_amdgcn_sched_barrier(0);
        if (tt + 1 < 16) { a = an; w = wn; b = bn; k = kn; r = rn; v = vn; }
      }
    }
    __builtin_amdgcn_sched_barrier(0);
    __syncthreads();
  }
  {
    const long m = base + (nblk - 1) * 16 + stt;
    p.ORW[m * 512 + h * 64 + q * 16 + (tid & 15)] = f2bf(O_[((nblk - 1) & 1) * 256 + stt * 16 + (tid & 15)]);
  }
  __syncthreads();
  {
    float* o = p.out + (s < 8 ? O_PRWKV + (((long)l * 8 + s) * 8 + h) * 4096
                              : O_SRWKV + (((long)l * 8 + (s - 8)) * 8 + h) * 4096);
    *(float4*)(o + row * 64 + ksl) = make_float4(s0, s1, s2, s3);
  }
}

__device__ __forceinline__ void scan_hgrn(const Params& p, int l, int s, int h, int q, float* smem) {
  const int tid = opaque_tid(), lane = tid & 63, wid = tid >> 6;
  float* Q_ = smem;
  float* F_ = smem + 2048;
  float* G_ = smem + 4096;
  float* I_ = smem + 6144;
  float* O_ = smem + 6400;
  const int rl = wid * 4 + (lane >> 4);
  const int row = q * 16 + rl;
  const int ksl4 = (lane & 15) * 4;
  const int base = seq_base(s), T = seq_len(s);
  float st[8];
#pragma unroll
  for (int i = 0; i < 8; ++i) st[i] = 0.f;
  if (s >= 8) {
    const float* sp = p.state_hgrn + (((long)l * 8 + (s - 8)) * 4 + h) * 16384;
#pragma unroll
    for (int i = 0; i < 8; ++i) st[i] = sp[((i >> 2) * 64 + ksl4 + (i & 3)) * 128 + row];
  }
  const int stt = tid >> 4, skq = (tid & 15) * 8;
  float lb[8];
#pragma unroll
  for (int i = 0; i < 8; ++i) {
    if (l == 0) lb[i] = 0.f;
    else {
      float x0 = p.hg_lb[h * 128 + skq + i], x1 = p.hg_lb[512 + h * 128 + skq + i];
      lb[i] = frcp_(1.f + __expf(x0 - x1));
    }
  }
  const int nblk = T / 16;
  uint4 q8, f8;
  u16 iv16;
  {
    const u16* pr = p.PROJ + (long)(base + stt) * LDP;
    q8 = *(const uint4*)(pr + C_Q + h * 128 + skq);
    f8 = *(const uint4*)(pr + C_F + h * 128 + skq);
    iv16 = pr[C_I + h * 128 + q * 16 + (tid & 15)];
  }
  __syncthreads();
  float* TR_ = smem + 6400 + 512;
  const bool wr = (lane & 15) == 0;
  const int ooff = wr ? rl : (512 + lane);
  const int ostr = wr ? 16 : 0;
  for (int blk = 0; blk < nblk; ++blk) {
    const long m = base + blk * 16 + stt;
    float* Oc = O_ + (blk & 1) * 256;
    {
      unsigned qw[4] = {q8.x, q8.y, q8.z, q8.w}, fw[4] = {f8.x, f8.y, f8.z, f8.w};
      float qv[8], fv[8], gv[8];
#pragma unroll
      for (int e = 0; e < 8; ++e) {
        qv[e] = bf2f((u16)((qw[e >> 1] >> ((e & 1) * 16)) & 0xffff));
        float fz = bf2f((u16)((fw[e >> 1] >> ((e & 1) * 16)) & 0xffff));
        float ex = __expf(-fz);
        float sg = frcp_(1.f + ex);
        float sgn = ex * sg;
        fv[e] = lb[e] + (1.f - lb[e]) * sg;
        gv[e] = (1.f - lb[e]) * sgn;
      }
      *(float4*)(Q_ + stt * 128 + skq) = make_float4(qv[0], qv[1], qv[2], qv[3]);
      *(float4*)(Q_ + stt * 128 + skq + 4) = make_float4(qv[4], qv[5], qv[6], qv[7]);
      *(float4*)(F_ + stt * 128 + skq) = make_float4(fv[0], fv[1], fv[2], fv[3]);
      *(float4*)(F_ + stt * 128 + skq + 4) = make_float4(fv[4], fv[5], fv[6], fv[7]);
      *(float4*)(G_ + stt * 128 + skq) = make_float4(gv[0], gv[1], gv[2], gv[3]);
      *(float4*)(G_ + stt * 128 + skq + 4) = make_float4(gv[4], gv[5], gv[6], gv[7]);
      I_[stt * 16 + (tid & 15)] = bf2f(iv16);
    }
    __syncthreads();
    if (blk > 0) {
      u16* dp = p.PROJ + (m - 16) * LDP + C_I + h * 128 + q * 16 + (tid & 15);
      *dp = f2bf(O_[((blk - 1) & 1) * 256 + stt * 16 + (tid & 15)]);
    }
    if (blk + 1 < nblk) {
      const u16* pr = p.PROJ + (m + 16) * LDP;
      q8 = *(const uint4*)(pr + C_Q + h * 128 + skq);
      f8 = *(const uint4*)(pr + C_F + h * 128 + skq);
      iv16 = pr[C_I + h * 128 + q * 16 + (tid & 15)];
    }
    __builtin_amdgcn_sched_barrier(0);
    {
      float4 f0 = *(const float4*)(F_ + ksl4), f1 = *(const float4*)(F_ + 64 + ksl4);
      float4 g0 = *(const float4*)(G_ + ksl4), g1 = *(const float4*)(G_ + 64 + ksl4);
      float4 q0 = *(const float4*)(Q_ + ksl4), q1 = *(const float4*)(Q_ + 64 + ksl4);
      float iv = I_[rl];
      float oprev = 0.f;
#pragma unroll
      for (int tt = 0; tt < 16; ++tt) {
        float4 f0n, f1n, g0n, g1n, q0n, q1n;
        float ivn;
        if (tt + 1 < 16) {
          const int o_ = (tt + 1) * 128;
          f0n = *(const float4*)(F_ + o_ + ksl4); f1n = *(const float4*)(F_ + o_ + 64 + ksl4);
          g0n = *(const float4*)(G_ + o_ + ksl4); g1n = *(const float4*)(G_ + o_ + 64 + ksl4);
          q0n = *(const float4*)(Q_ + o_ + ksl4); q1n = *(const float4*)(Q_ + o_ + 64 + ksl4);
          ivn = I_[(tt + 1) * 16 + rl];
        }
        __builtin_amdgcn_sched_barrier(0);
        st[0] = fmaf(st[0], f0.x, g0.x * iv); NOPK(st[0]);
        st[1] = fmaf(st[1], f0.y, g0.y * iv); NOPK(st[1]);
        st[2] = fmaf(st[2], f0.z, g0.z * iv); NOPK(st[2]);
        st[3] = fmaf(st[3], f0.w, g0.w * iv); NOPK(st[3]);
        st[4] = fmaf(st[4], f1.x, g1.x * iv); NOPK(st[4]);
        st[5] = fmaf(st[5], f1.y, g1.y * iv); NOPK(st[5]);
        st[6] = fmaf(st[6], f1.z, g1.z * iv); NOPK(st[6]);
        st[7] = fmaf(st[7], f1.w, g1.w * iv); NOPK(st[7]);
        float acc0 = fmaf(st[0], q0.x, fmaf(st[1], q0.y, fmaf(st[2], q0.z, st[3] * q0.w)));
        float acc1 = fmaf(st[4], q1.x, fmaf(st[5], q1.y, fmaf(st[6], q1.z, st[7] * q1.w)));
        float o = acc0 + acc1;
        if (tt & 1) { sum16x2(oprev, o); Oc[ooff + (tt - 1) * ostr] = oprev; Oc[ooff + tt * ostr] = o; }
        else oprev = o;
        __builtin_amdgcn_sched_barrier(0);
        if (tt + 1 < 16) { f0 = f0n; f1 = f1n; g0 = g0n; g1 = g1n; q0 = q0n; q1 = q1n; iv = ivn; }
      }
    }
    __builtin_amdgcn_sched_barrier(0);
    __syncthreads();
  }
  {
    const long m = base + (nblk - 1) * 16 + stt;
    u16* dp = p.PROJ + m * LDP + C_I + h * 128 + q * 16 + (tid & 15);
    *dp = f2bf(O_[((nblk - 1) & 1) * 256 + stt * 16 + (tid & 15)]);
  }
  __syncthreads();
  {
    float* o = p.out + (s < 8 ? O_PHGRN + (((long)l * 8 + s) * 4 + h) * 16384
                              : O_SHGRN + (((long)l * 8 + (s - 8)) * 4 + h) * 16384);
#pragma unroll
    for (int i = 0; i < 8; ++i) o[((i >> 2) * 64 + ksl4 + (i & 3)) * 128 + row] = st[i];
  }
}

__device__ __forceinline__ void scan_ssd(const Params& p, int l, int s, int h, int q, float* smem) {
  const int tid = opaque_tid(), lane = tid & 63, wid = tid >> 6;
  float* B_ = smem;
  float* C_ = smem + 2048;
  float* X_ = smem + 4096;
  float* O_ = smem + 4352;
  float* DT_ = smem + 5200;
  float* DE_ = smem + 5216;
  const int rl = wid * 4 + (lane >> 4);
  const int row = q * 16 + rl;
  const int ksl4 = (lane & 15) * 4;
  const int g = h >> 2;
  const int base = seq_base(s), T = seq_len(s);
  float st[8];
#pragma unroll
  for (int i = 0; i < 8; ++i) st[i] = 0.f;
  if (s >= 8) {
    const float* sp = p.state_ssm + (((long)l * 8 + (s - 8)) * 8 + h) * 8192 + row * 128 + ksl4;
    float4 a = *(const float4*)sp, b = *(const float4*)(sp + 64);
    st[0] = a.x; st[1] = a.y; st[2] = a.z; st[3] = a.w; st[4] = b.x; st[5] = b.y; st[6] = b.z; st[7] = b.w;
  }
  const int xc_bc = (tid < 128) ? (512 + g * 128 + tid) : (768 + g * 128 + (tid - 128));
  const float* cw = p.conv_w + (long)l * 4 * 1024;
  const float cb0 = cw[xc_bc], cb1 = cw[1024 + xc_bc], cb2 = cw[2048 + xc_bc], cb3 = cw[3072 + xc_bc];
  const float cbb = p.conv_b[l * 1024 + xc_bc];
  float u3 = 0.f, u2 = 0.f, u1 = 0.f;
  const int xc_x = h * 64 + q * 16 + (tid & 15);
  const float cx0 = cw[xc_x], cx1 = cw[1024 + xc_x], cx2 = cw[2048 + xc_x], cx3 = cw[3072 + xc_x];
  const float cxb = p.conv_b[l * 1024 + xc_x];
  float x3 = 0.f, x2 = 0.f, x1 = 0.f;
  if (s >= 8) {
    const float* sc = p.state_conv + ((long)l * 8 + (s - 8)) * 3 * 1024;
    u3 = sc[xc_bc]; u2 = sc[1024 + xc_bc]; u1 = sc[2048 + xc_bc];
    x3 = sc[xc_x]; x2 = sc[1024 + xc_x]; x1 = sc[2048 + xc_x];
  }
  const float dtb = p.dt_bias[l * 8 + h];
  const float aexp = __expf(p.a_log[l * 8 + h]);
  const float dsk = p.d_skip[l * 8 + h];
  const int stt = tid >> 4;
  const int nblk = T / 16;
  u16 raw[16];
  float xr[4];
  float dtr = 0.f;
  u16 zc = 0, zn = 0;
#define SSD_LOAD(M0)                                                              \
  {                                                                               \
    const u16* col = p.PROJ + (long)(M0) * LDP + C_XBC + xc_bc;                   \
    _Pragma("unroll") for (int t = 0; t < 16; ++t) raw[t] = col[(long)t * LDP];   \
    {                                                                             \
      const long mr = (long)(M0) + stt;                                           \
      const u16* colx = p.PROJ + mr * LDP + C_XBC + xc_x;                         \
      _Pragma("unroll") for (int j = 0; j < 4; ++j) {                             \
        const long mm = mr - 3 + j;                                               \
        float vx;                                                                 \
        if (mm >= base) vx = bf2f(colx[(long)(j - 3) * LDP]);                     \
        else vx = (s >= 8) ? p.state_conv[((long)l * 8 + (s - 8)) * 3072 + (3 + (int)(mm - base)) * 1024 + xc_x] : 0.f; \
        xr[j] = vx;                                                               \
      }                                                                           \
    }                                                                             \
    if (tid < 16) dtr = p.DTRAW[((long)(M0) + tid) * 8 + h];                      \
    zn = p.PROJ[((long)(M0) + stt) * LDP + C_Z + h * 64 + q * 16 + (tid & 15)];   \
  }
#pragma unroll
  for (int t = 0; t < 16; ++t) raw[t] = 0;
  SSD_LOAD(base);
  __syncthreads();
  const bool wr = (lane & 15) == 0;
  const int ooff = wr ? rl : (512 + lane);
  const int ostr = wr ? 16 : 0;
  u16 zp = 0;
  for (int blk = 0; blk < nblk; ++blk) {
    const long m0 = base + blk * 16;
    zp = zc;
    zc = zn;
    float* Oc = O_ + (blk & 1) * 256;
    {
      float* dst = (tid < 128) ? (B_ + tid) : (C_ + (tid - 128));
#pragma unroll
      for (int t = 0; t < 16; ++t) {
        float u0 = bf2f(raw[t]);
        float y = cb0 * u3 + cb1 * u2 + cb2 * u1 + cb3 * u0 + cbb;
        dst[t * 128] = siluf_(y);
        u3 = u2; u2 = u1; u1 = u0;
      }
      {
        float y = cx0 * xr[0] + cx1 * xr[1] + cx2 * xr[2] + cx3 * xr[3] + cxb;
        X_[stt * 16 + (tid & 15)] = siluf_(y);
      }
      if (tid < 16) {
        float dtv = softplusf_(dtr + dtb);
        DT_[tid] = dtv;
        DE_[tid] = __expf(-aexp * dtv);
      }
    }
    __syncthreads();
    if (blk > 0) {
      u16* pz = p.PROJ + (m0 - 16 + stt) * LDP + C_Z + h * 64 + q * 16 + (tid & 15);
      *pz = f2bf(O_[((blk - 1) & 1) * 256 + stt * 16 + (tid & 15)] * siluf_(bf2f(zp)));
    }
    if (blk + 1 < nblk) SSD_LOAD(m0 + 16);
    __builtin_amdgcn_sched_barrier(0);
    {
      float4 b0 = *(const float4*)(B_ + ksl4), b1 = *(const float4*)(B_ + 64 + ksl4);
      float4 c0 = *(const float4*)(C_ + ksl4), c1 = *(const float4*)(C_ + 64 + ksl4);
      float xv = X_[rl], dt = DT_[0], de = DE_[0];
      float yprev = 0.f, xvprev = 0.f;
#pragma unroll
      for (int tt = 0; tt < 16; ++tt) {
        float4 b0n, b1n, c0n, c1n;
        float xvn, dtn, den;
        if (tt + 1 < 16) {
          const int o_ = (tt + 1) * 128;
          b0n = *(const float4*)(B_ + o_ + ksl4); b1n = *(const float4*)(B_ + o_ + 64 + ksl4);
          c0n = *(const float4*)(C_ + o_ + ksl4); c1n = *(const float4*)(C_ + o_ + 64 + ksl4);
          xvn = X_[(tt + 1) * 16 + rl]; dtn = DT_[tt + 1]; den = DE_[tt + 1];
        }
        __builtin_amdgcn_sched_barrier(0);
        const float xd = xv * dt;
        st[0] = fmaf(st[0], de, xd * b0.x); NOPK(st[0]);
        st[1] = fmaf(st[1], de, xd * b0.y); NOPK(st[1]);
        st[2] = fmaf(st[2], de, xd * b0.z); NOPK(st[2]);
        st[3] = fmaf(st[3], de, xd * b0.w); NOPK(st[3]);
        st[4] = fmaf(st[4], de, xd * b1.x); NOPK(st[4]);
        st[5] = fmaf(st[5], de, xd * b1.y); NOPK(st[5]);
        st[6] = fmaf(st[6], de, xd * b1.z); NOPK(st[6]);
        st[7] = fmaf(st[7], de, xd * b1.w); NOPK(st[7]);
        float acc0 = fmaf(st[0], c0.x, fmaf(st[1], c0.y, fmaf(st[2], c0.z, st[3] * c0.w)));
        float acc1 = fmaf(st[4], c1.x, fmaf(st[5], c1.y, fmaf(st[6], c1.z, st[7] * c1.w)));
        float y = acc0 + acc1;
        if (tt & 1) { sum16x2(yprev, y); Oc[ooff + (tt - 1) * ostr] = yprev + dsk * xvprev; Oc[ooff + tt * ostr] = y + dsk * xv; }
        else { yprev = y; xvprev = xv; }
        __builtin_amdgcn_sched_barrier(0);
        if (tt + 1 < 16) { b0 = b0n; b1 = b1n; c0 = c0n; c1 = c1n; xv = xvn; dt = dtn; de = den; }
      }
    }
    __builtin_amdgcn_sched_barrier(0);
    __syncthreads();
  }
  {
    const long m0 = base + (nblk - 1) * 16;
    u16* pz = p.PROJ + (m0 + stt) * LDP + C_Z + h * 64 + q * 16 + (tid & 15);
    *pz = f2bf(O_[((nblk - 1) & 1) * 256 + stt * 16 + (tid & 15)] * siluf_(bf2f(zc)));
  }
  __syncthreads();
#undef SSD_LOAD
  {
    float* o = p.out + (s < 8 ? O_PSSM + (((long)l * 8 + s) * 8 + h) * 8192
                              : O_SSSM + (((long)l * 8 + (s - 8)) * 8 + h) * 8192);
    *(float4*)(o + row * 128 + ksl4) = make_float4(st[0], st[1], st[2], st[3]);
    *(float4*)(o + row * 128 + 64 + ksl4) = make_float4(st[4], st[5], st[6], st[7]);
  }
  if (h == 0 && q == 0) {
    float* o = p.out + (s < 8 ? O_PCONV + ((long)l * 8 + s) * 3072 : O_SCONV + ((long)l * 8 + (s - 8)) * 3072);
    for (int i = tid; i < 3072; i += 256) {
      int r = i >> 10, c = i & 1023;
      o[i] = bf2f(p.PROJ[(long)(base + T - 3 + r) * LDP + C_XBC + c]);
    }
  }
}

__device__ __forceinline__ void phase_scan(const Params& p, int l, float* smem) {
  for (int u = BID, nb_ = NBLK; u < 1536; u += nb_) {
    int sample = u >= 768;
    int v = sample ? u - 768 : u;
    int type = v % 3, w = v / 3;
    if (type == 0) {
      int q = w & 3, h = (w >> 2) & 7, b = w >> 5;
      scan_rwkv(p, l, b + 8 * sample, h, q, smem);
    } else if (type == 1) {
      int q = w & 7, h = (w >> 3) & 3, b = w >> 5;
      scan_hgrn(p, l, b + 8 * sample, h, q, smem);
    } else {
      int q = w & 3, h = (w >> 2) & 7, b = w >> 5;
      scan_ssd(p, l, b + 8 * sample, h, q, smem);
    }
  }
}

__device__ __forceinline__ void phase_post(const Params& p, int l, float* smem) {
  const int tid = opaque_tid(), lane = tid & 63, wid = tid >> 6;
  float* SG = smem;
  float* RED = smem + 2048;
  for (int blk = BID, nb_ = NBLK; blk < NBLK16; blk += nb_) {
    const long m0 = (long)blk * 16;
    __syncthreads();
    if (tid < 128) {
      const u16* col = p.PROJ + m0 * LDP + C_XG + tid;
#pragma unroll
      for (int t = 0; t < 16; ++t) SG[tid * 16 + t] = bf2f(col[(long)t * LDP]);
    }
    float ys[2][16], oh[2][16];
#pragma unroll
    for (int c = 0; c < 2; ++c) {
      int ch = tid + 256 * c;
#pragma unroll
      for (int t = 0; t < 16; ++t) {
        ys[c][t] = bf2f(p.PROJ[(m0 + t) * LDP + C_Z + ch]);
        oh[c][t] = bf2f(p.PROJ[(m0 + t) * LDP + C_I + ch]);
      }
    }
#pragma unroll
    for (int t = 0; t < 16; ++t) {
      float a0 = sum64(ys[0][t] * ys[0][t]), a1 = sum64(ys[1][t] * ys[1][t]);
      float b0 = sum64(oh[0][t] * oh[0][t]), b1 = sum64(oh[1][t] * oh[1][t]);
      if (lane == 0) *(float4*)(RED + (wid * 16 + t) * 4) = make_float4(a0, a1, b0, b1);
    }
    __syncthreads();
    {
      const float nw0 = p.ssd_norm_w[l * 512 + tid], nw1 = p.ssd_norm_w[l * 512 + tid + 256];
      const float hw0 = p.hg_norm_w[l * 512 + tid], hw1 = p.hg_norm_w[l * 512 + tid + 256];
      const int pw = (wid >> 1) * 2;
#pragma unroll
      for (int t = 0; t < 16; ++t) {
        float4 r0 = *(const float4*)(RED + (0 * 16 + t) * 4), r1 = *(const float4*)(RED + (1 * 16 + t) * 4);
        float4 r2 = *(const float4*)(RED + (2 * 16 + t) * 4), r3 = *(const float4*)(RED + (3 * 16 + t) * 4);
        float g0 = r0.x + r1.x + r2.x + r3.x, g1 = r0.y + r1.y + r2.y + r3.y;
        float4 pa = *(const float4*)(RED + (pw * 16 + t) * 4), pb = *(const float4*)(RED + ((pw + 1) * 16 + t) * 4);
        float h0 = pa.z + pb.z, h1 = pa.w + pb.w;
        u16* rowp = p.PROJ + (m0 + t) * LDP;
        rowp[C_Z + tid] = f2bf(ys[0][t] * rsqrtf(g0 * (1.f / 256.f) + 1e-6f) * nw0);
        rowp[C_Z + tid + 256] = f2bf(ys[1][t] * rsqrtf(g1 * (1.f / 256.f) + 1e-6f) * nw1);
        float gg0 = bf2f(rowp[C_GG + tid]), gg1 = bf2f(rowp[C_GG + tid + 256]);
        rowp[C_GG + tid] = f2bf(oh[0][t] * rsqrtf(h0 * (1.f / 128.f) + 1e-6f) * hw0 * siluf_(gg0));
        rowp[C_GG + tid + 256] = f2bf(oh[1][t] * rsqrtf(h1 * (1.f / 128.f) + 1e-6f) * hw1 * siluf_(gg1));
      }
    }
    float ga[2][16];
#pragma unroll
    for (int c = 0; c < 2; ++c)
#pragma unroll
      for (int t = 0; t < 16; ++t) ga[c][t] = 0.f;
    {
      const float* g2 = p.rw_g2 + (long)l * 128 * 512;
      for (int i = 0; i < 128; ++i) {
        float gv[2] = {g2[i * 512 + tid], g2[i * 512 + tid + 256]};
#pragma unroll
        for (int q = 0; q < 4; ++q) {
          float4 x = *(const float4*)(SG + i * 16 + q * 4);
#pragma unroll
          for (int c = 0; c < 2; ++c) {
            ga[c][q * 4 + 0] += x.x * gv[c]; ga[c][q * 4 + 1] += x.y * gv[c];
            ga[c][q * 4 + 2] += x.z * gv[c]; ga[c][q * 4 + 3] += x.w * gv[c];
          }
        }
      }
    }
#pragma unroll
    for (int c = 0; c < 2; ++c) {
      int ch = tid + 256 * c, head = wid + 4 * c;
      float lw = p.rw_lnx_w[l * 512 + ch], lbv = p.rw_lnx_b[l * 512 + ch];
#pragma unroll
      for (int t = 0; t < 16; ++t) {
        float o = bf2f(p.ORW[(m0 + t) * 512 + ch]);
        float mean = sum64(o) * (1.f / 64.f);
        float d = o - mean;
        float var = sum64(d * d) * (1.f / 64.f);
        float ln = d * rsqrtf(var + 64e-5f) * lw + lbv;
        float v = bf2f(p.PROJ[(m0 + t) * LDP + C_V + ch]);
        float bonus = p.RKS[(m0 + t) * 8 + head] * v;
        p.PROJ[(m0 + t) * LDP + C_R + ch] = f2bf((ln + bonus) * ga[c][t]);
      }
    }
  }
}

__device__ __forceinline__ void phase_final(const Params& p) {
  const int tid = opaque_tid(), lane = tid & 63, wid = tid >> 6;
  for (int m = BID * 4 + wid, nb_ = NBLK; m < M_TOT; m += nb_ * 4) {
    float* dst;
    if (m < M_PROMPT) {
      int b = m / T_P, t = m - b * T_P;
      if (t < 16) continue;
      dst = p.out + O_YP + ((long)b * 4096 + (t - 16)) * DM;
    } else {
      dst = p.out + O_YS + (long)(m - M_PROMPT) * DM;
    }
    float x[16];
    float ss = 0.f;
#pragma unroll
    for (int j = 0; j < 2; ++j) {
      uint4 raw = *(const uint4*)(p.XB + (long)m * DM + lane * 8 + 512 * j);
      unsigned wv[4] = {raw.x, raw.y, raw.z, raw.w};
#pragma unroll
      for (int e = 0; e < 8; ++e) {
        x[j * 8 + e] = bf2f((u16)((wv[e >> 1] >> ((e & 1) * 16)) & 0xffff));
        ss += x[j * 8 + e] * x[j * 8 + e];
      }
    }
    ss = sum64(ss);
    float rs = rsqrtf(ss * (1.f / 1024.f) + 1e-6f);
#pragma unroll
    for (int j = 0; j < 2; ++j) {
      int k0 = lane * 8 + 512 * j;
      float4 w0 = *(const float4*)(p.final_w + k0), w1 = *(const float4*)(p.final_w + k0 + 4);
      *(float4*)(dst + k0) = make_float4(x[j * 8 + 0] * rs * w0.x, x[j * 8 + 1] * rs * w0.y, x[j * 8 + 2] * rs * w0.z,
                                         x[j * 8 + 3] * rs * w0.w);
      *(float4*)(dst + k0 + 4) = make_float4(x[j * 8 + 4] * rs * w1.x, x[j * 8 + 5] * rs * w1.y,
                                             x[j * 8 + 6] * rs * w1.z, x[j * 8 + 7] * rs * w1.w);
    }
  }
}


#define XB_TMO      128
#define XB_XCNT(j)  (256  + 64 * (j))
#define XB_XSUB(j)  (1280 + 64 * (j))
#define XB_XGEN(j)  (2304 + 64 * (j))
#define XB_TOP      3328
#define XB_TOPGEN   3392
#define XCD_BAR_WORDS 3456
#define XB_SPIN_CAP (1u << 22)
__device__ __forceinline__ unsigned xb_ld(unsigned* p) { return __hip_atomic_load(p, __ATOMIC_RELAXED, __HIP_MEMORY_SCOPE_AGENT); }
__device__ __forceinline__ unsigned xb_add(unsigned* p, unsigned v) { return __hip_atomic_fetch_add(p, v, __ATOMIC_RELAXED, __HIP_MEMORY_SCOPE_AGENT); }
__device__ __forceinline__ unsigned xb_xcc_id() { return (unsigned)__builtin_amdgcn_s_getreg((3 << 11) | 20) & 0xFu; }
#define XB_SPIN(cond, bar) do { unsigned _sp = 0; while (cond) { __builtin_amdgcn_s_sleep(1); \
    if ((++_sp & 255u) == 0u) { if (xb_ld(&(bar)[XB_TMO])) break; if (_sp > XB_SPIN_CAP) { atomicAdd(&(bar)[XB_TMO], 1u); break; } } } } while (0)

__device__ __forceinline__ void xcd_barrier_post(unsigned* bar) {
  if (threadIdx.x == 0) (void)xb_add(&bar[XB_XCNT(xb_xcc_id())], 1u);
}
__device__ __forceinline__ void xcd_barrier_complete(unsigned* bar, unsigned x, unsigned& nloc, unsigned& nx) {
  const unsigned G = gridDim.x;
  unsigned sum, cnt, mine, sp = 0u;
  for (;;) {
    sum = 0u; cnt = 0u; mine = 0u;
#pragma unroll
    for (unsigned j = 0; j < 16; ++j) { const unsigned c = xb_ld(&bar[XB_XCNT(j)]); sum += c; cnt += (c > 0u) ? 1u : 0u; mine = (j == x) ? c : mine; }
    if (sum == G) break;
    __builtin_amdgcn_s_sleep(1);
    if ((++sp & 255u) == 0u) { if (xb_ld(&bar[XB_TMO])) break; if (sp > XB_SPIN_CAP) { atomicAdd(&bar[XB_TMO], 1u); break; } }
  }
  nloc = mine > 0u ? mine : 1u; nx = cnt > 0u ? cnt : 1u;
}
__device__ __forceinline__ void xcd_barrier(unsigned* bar, volatile unsigned* st) {
  asm volatile("s_waitcnt vmcnt(0)" ::: "memory");
  __syncthreads();
  if (threadIdx.x == 0) {
    __builtin_amdgcn_s_waitcnt(0);
    const unsigned x = xb_xcc_id();
    unsigned nloc = st[0], nx = st[1];
    if (nloc == 0u) { xcd_barrier_complete(bar, x, nloc, nx); st[0] = nloc; st[1] = nx; }
    const unsigned old = xb_add(&bar[XB_XSUB(x)], 1u);
    const unsigned gen = old / nloc;
    if (old + 1u == (gen + 1u) * nloc) {
      __builtin_amdgcn_fence(__ATOMIC_RELEASE, "agent");
      asm volatile("s_waitcnt vmcnt(0)" ::: "memory");
      const unsigned og = xb_add(&bar[XB_TOP], 1u);
      const unsigned tg = og / nx;
      if (og + 1u == (tg + 1u) * nx) xb_add(&bar[XB_TOPGEN], 1u);
      else XB_SPIN(xb_ld(&bar[XB_TOPGEN]) == tg, bar);
      __builtin_amdgcn_fence(__ATOMIC_ACQUIRE, "agent");
      xb_add(&bar[XB_XGEN(x)], 1u);
      asm volatile("s_waitcnt vmcnt(0)" ::: "memory");
    } else {
      XB_SPIN(xb_ld(&bar[XB_XGEN(x)]) == gen, bar);
      __builtin_amdgcn_fence(__ATOMIC_ACQUIRE, "agent");
      asm volatile("s_waitcnt vmcnt(0)" ::: "memory");
    }
  }
  __syncthreads();
}

constexpr int SMEM_BYTES = 40960;
__device__ __forceinline__ void run_phase(const Params& p, int ph, char* smem) {
  if (ph == 0) { phase_embed(p); return; }
  if (ph == 19) { phase_final(p); return; }
  int l = (ph - 1) / 9, s = (ph - 1) % 9;
  float* fs = (float*)smem;
  switch (s) {
    case 0: phase_convert(p, l, fs); phase_rowstat<true>(p, l, fs); break;
    case 1: phase_gemm<1>(p, p.XB, DM, p.W1T, 1024, LDP / 128, smem); break;
    case 2: phase_pre(p, l, fs); break;
    case 3: phase_scan(p, l, fs); break;
    case 4: phase_post(p, l, fs); break;
    case 5: phase_gemm<2>(p, p.PROJ, LDP, p.WOT, 1536, 8, smem); break;
    case 6: phase_rowstat<false>(p, l, fs); break;
    case 7: phase_gemm<3>(p, p.XB, DM, p.WGU, 1024, 44, smem); break;
    case 8: phase_gemm<2>(p, p.PROJ, D_FF, p.WDT, D_FF, 8, smem); break;
  }
}
constexpr int N_PHASES = 20;

#if MEGA
__global__ void __launch_bounds__(256, 3) k_mega(Params p) {
  __shared__ __attribute__((aligned(16))) char smem[SMEM_BYTES];
  __shared__ uint4 xb_words;
  if (threadIdx.x == 0) { xb_words = make_uint4(0u, 0u, 0u, 0u); }
  __syncthreads();
  cg::grid_group grid = cg::this_grid();
  float* fs = (float*)smem;
  volatile unsigned* xst = (volatile unsigned*)&xb_words;
  xcd_barrier_post(p.bar);
  phase_embed(p);
  grid.sync();
#define GSYNC() do { unsigned* b_ = p.bar; asm volatile("" : "+s"(b_)); xcd_barrier(b_, xst); } while (0)
#pragma unroll 1
  for (int l0 = 0; l0 < 2; ++l0) {
    int l = opaque_s(l0);
    phase_convert(p, l, fs);
    phase_rowstat<true>(p, l, fs);
    GSYNC();
    l = opaque_s(l);
    phase_gemm<1>(p, p.XB, DM, p.W1T, 1024, LDP / 128, smem);
    GSYNC();
    l = opaque_s(l);
    phase_pre(p, l, fs);
    GSYNC();
    l = opaque_s(l);
    phase_scan(p, l, fs);
    GSYNC();
    l = opaque_s(l);
    phase_post(p, l, fs);
    GSYNC();
    l = opaque_s(l);
    phase_gemm<2>(p, p.PROJ, LDP, p.WOT, 1536, 8, smem);
    GSYNC();
    l = opaque_s(l);
    phase_rowstat<false>(p, l, fs);
    GSYNC();
    l = opaque_s(l);
    phase_gemm<3>(p, p.XB, DM, p.WGU, 1024, 44, smem);
    GSYNC();
    l = opaque_s(l);
    phase_gemm<2>(p, p.PROJ, D_FF, p.WDT, D_FF, 8, smem);
    GSYNC();
  }
  phase_final(p);
}
#else
template <int PH>
__global__ void __launch_bounds__(256, 3) k_phase(Params p) {
  __shared__ __attribute__((aligned(16))) char smem[SMEM_BYTES];
  run_phase(p, PH, smem);
}
template <int PH>
static void launch_all(const Params& p, int grid, hipStream_t stream) {
  hipLaunchKernelGGL(k_phase<PH>, dim3(grid), dim3(256), 0, stream, p);
  if constexpr (PH + 1 < N_PHASES) launch_all<PH + 1>(p, grid, stream);
}
#endif

extern "C" void kernel_launch(void* const* d_in, const int* in_sizes, int n_in, void* d_out, int out_size, void* d_ws,
                              size_t ws_size, hipStream_t stream) {
  Params p{};
  const float** pf = (const float**)&p;
  for (int i = 0; i < 35; ++i) pf[i] = (const float*)d_in[i];
  p.out = (float*)d_out;
  char* ws = (char*)d_ws;
  size_t off = 0;
  auto take = [&](size_t bytes) { char* r = ws + off; off += (bytes + 255) & ~(size_t)255; return r; };
  p.XB = (u16*)take((size_t)M_TOT * DM * 2);
  p.PROJ = (u16*)take((size_t)M_TOT * LDP * 2);
  p.W1T = (u16*)take((size_t)LDP * 1024 * 2);
  p.WOT = (u16*)take((size_t)1024 * 1536 * 2);
  p.WGU = (u16*)take((size_t)5632 * 1024 * 2);
  p.WDT = (u16*)take((size_t)1024 * D_FF * 2);
  p.BND = (u16*)take((size_t)NBLK16 * 1792 * 2);
  p.ORW = (u16*)take((size_t)M_TOT * 512 * 2);
  p.RS = (float*)take((size_t)M_TOT * 4);
  p.DTRAW = (float*)take((size_t)M_TOT * 8 * 4);
  p.RKS = (float*)take((size_t)M_TOT * 8 * 4);
  p.bar = (unsigned*)take((size_t)XCD_BAR_WORDS * 4);
  p.RWX = (u16*)d_out;
  if (off > ws_size) fprintf(stderr, "workspace too small: need %zu have %zu\n", off, ws_size);
#if MEGA
  static int grid_blocks = 0;
  if (!grid_blocks) {
    int dev = 0, cus = 0, per_cu = 0;
    hipGetDevice(&dev);
    hipDeviceGetAttribute(&cus, hipDeviceAttributeMultiprocessorCount, dev);
    hipOccupancyMaxActiveBlocksPerMultiprocessor(&per_cu, k_mega, 256, 0);
    if (per_cu > 3) per_cu = 3;
    grid_blocks = cus * per_cu;
  }
  hipMemsetAsync(p.bar, 0, (size_t)XCD_BAR_WORDS * 4, stream);
  void* args[] = {&p};
  hipError_t e = hipLaunchCooperativeKernel((void*)k_mega, dim3(grid_blocks), dim3(256), args, 0, stream);
  if (e != hipSuccess) fprintf(stderr, "cooperative launch failed: %s (grid %d)\n", hipGetErrorString(e), grid_blocks);
#else
  launch_all<0>(p, 768, stream);
#endif
}
```

```cpp
#include <hip/hip_runtime.h>
#include <hip/hip_bf16.h>
#include <hip/hip_cooperative_groups.h>
#include <cstdio>
namespace cg = cooperative_groups;

#ifndef MEGA
#define MEGA 1
#endif

typedef unsigned short u16;
using bf16x8 = __attribute__((ext_vector_type(8))) short;
using f32x16 = __attribute__((ext_vector_type(16))) float;

constexpr int DM = 1024;
constexpr int M_TOT = 33408;
constexpr int M_PROMPT = 32896;
constexpr int T_P = 4112;
constexpr int LDP = 5376;
constexpr int N_IN = 5384;
constexpr int D_FF = 2816;
constexpr int NBLK16 = M_TOT / 16;
constexpr int C_Z = 0, C_R = 512, C_GG = 1024, C_XBC = 1536, C_K = 2560, C_V = 3072, C_XW = 3584, C_XA = 3648,
              C_XG = 3712, C_Q = 3840, C_F = 4352, C_I = 4864;
constexpr long O_YP = 0, O_YS = 33554432, O_PSSM = 34078720, O_PCONV = 35127296, O_PRWKV = 35176448,
               O_PSHIFT = 35700736, O_PHGRN = 35729408, O_SSSM = 36777984, O_SCONV = 37826560,
               O_SRWKV = 37875712, O_SSHIFT = 38400000, O_SHGRN = 38428672;

struct Params {
  const float *x_prompt, *x_sample, *state_ssm, *state_conv, *state_rwkv, *state_shift, *state_hgrn, *meta,
      *norm1_w, *w_in, *conv_w, *conv_b, *dt_bias, *a_log, *d_skip, *ssd_norm_w, *rw_mu, *rw_w0, *rw_w2, *rw_a0,
      *rw_a2, *rw_g2, *rw_kk, *rw_ka, *rw_rk, *rw_lnx_w, *rw_lnx_b, *hg_lb, *hg_norm_w, *w_out, *norm2_w, *w_gate,
      *w_up, *w_down, *final_w;
  float* out;
  u16 *XB, *PROJ, *W1T, *WOT, *WGU, *WDT, *BND, *ORW, *RWX;
  float *RS, *DTRAW, *RKS;
  unsigned* bar;
};

__device__ __forceinline__ u16 f2bf(float f) {
  unsigned u = __float_as_uint(f);
  u += 0x7fffu + ((u >> 16) & 1u);
  return (u16)(u >> 16);
}
__device__ __forceinline__ float bf2f(u16 h) { return __uint_as_float(((unsigned)h) << 16); }
__device__ __forceinline__ float frcp_(float x) { return __builtin_amdgcn_rcpf(x); }
__device__ __forceinline__ float sigmoidf_(float x) { return frcp_(1.f + __expf(-x)); }
__device__ __forceinline__ float siluf_(float x) { return x * frcp_(1.f + __expf(-x)); }
__device__ __forceinline__ float softplusf_(float x) { return x > 20.f ? x : log1pf(__expf(x)); }

template <int CTRL>
__device__ __forceinline__ float dppf(float v) {
  return __int_as_float(__builtin_amdgcn_update_dpp(0, __float_as_int(v), CTRL, 0xF, 0xF, true));
}
__device__ __forceinline__ float sum16(float v) {
  v += dppf<0xB1>(v);
  v += dppf<0x4E>(v);
  v += dppf<0x141>(v);
  v += dppf<0x140>(v);
  return v;
}
__device__ __forceinline__ void sum16x2(float& a, float& b) {
  a += dppf<0xB1>(a); b += dppf<0xB1>(b);
  a += dppf<0x4E>(a); b += dppf<0x4E>(b);
  a += dppf<0x141>(a); b += dppf<0x141>(b);
  a += dppf<0x140>(a); b += dppf<0x140>(b);
}
__device__ __forceinline__ float sum64(float v) {
  v = sum16(v);
  v += __shfl_xor(v, 16);
  v += __shfl_xor(v, 32);
  return v;
}

#define NOPK(x) asm("" : "+v"(x))
__device__ __forceinline__ int opaque_tid() {
  int t = threadIdx.x;
  asm volatile("" : "+v"(t));
  return t;
}
__device__ __forceinline__ int opaque_s(int v) {
  asm volatile("" : "+s"(v));
  return v;
}
#define BID opaque_s((int)blockIdx.x)
#define NBLK opaque_s((int)gridDim.x)
__device__ __forceinline__ int seq_base(int s) { return s < 8 ? s * T_P : M_PROMPT + (s - 8) * 64; }
__device__ __forceinline__ int seq_len(int s) { return s < 8 ? T_P : 64; }

__device__ __forceinline__ void phase_embed(const Params& p) {
  const long n4 = (long)M_TOT * 256;
  for (long idx = (long)BID * 256 + threadIdx.x, st_ = (long)NBLK * 256; idx < n4; idx += st_) {
    int m = (int)(idx >> 8), c4 = ((int)idx & 255) * 4;
    const float* src;
    if (m < M_PROMPT) {
      int b = m / T_P, t = m - b * T_P;
      src = (t < 16) ? p.meta + (long)t * DM : p.x_prompt + ((long)b * 4096 + (t - 16)) * DM;
    } else {
      src = p.x_sample + (long)(m - M_PROMPT) * DM;
    }
    float4 v = *(const float4*)(src + c4);
    ushort4 o;
    o.x = f2bf(v.x); o.y = f2bf(v.y); o.z = f2bf(v.z); o.w = f2bf(v.w);
    *(ushort4*)(p.XB + (long)m * DM + c4) = o;
  }
}

template <bool HAS_SCALE>
__device__ __forceinline__ void conv_tile(const float* __restrict__ src, int ldsrc, int srccol0, const float* __restrict__ scale,
                          u16* __restrict__ dst, int K, int k0, int n0, float* tile  ) {
  const int tid = opaque_tid();
  __syncthreads();
  {
    int nn = tid & 63, kb = tid >> 6;
#pragma unroll
    for (int i = 0; i < 16; ++i) {
      int kk = kb + 4 * i;
      float v = src[(long)(k0 + kk) * ldsrc + srccol0 + nn];
      if (HAS_SCALE) v *= scale[k0 + kk];
      tile[kk * 65 + nn] = v;
    }
  }
  __syncthreads();
  {
    int nn = tid >> 2, kq = (tid & 3) * 16;
    u16* d = dst + (long)(n0 + nn) * K + k0 + kq;
#pragma unroll
    for (int j = 0; j < 16; j += 2) {
      unsigned w = f2bf(tile[(kq + j) * 65 + nn]) | ((unsigned)f2bf(tile[(kq + j + 1) * 65 + nn]) << 16);
      *(unsigned*)(d + j) = w;
    }
  }
}

__device__ __forceinline__ int w1_srccol(int n0) {
  if (n0 < 512) return n0;
  if (n0 < 1024) return n0 - 512 + 1544;
  if (n0 < 1536) return n0 - 1024 + 4872;
  if (n0 < 2560) return n0 - 1536 + 512;
  if (n0 < 3840) return n0 - 2560 + 2056;
  return n0 - 3840 + 3336;
}

constexpr int CV_W1 = 16 * 84, CV_WO = 24 * 16, CV_WGU = 16 * 88, CV_WD = 44 * 16;
constexpr int CV_TOTAL = CV_W1 + CV_WO + CV_WGU + CV_WD;

__device__ __forceinline__ void phase_convert(const Params& p, int l, float* smem) {
  for (int u = BID, nb_ = NBLK; u < CV_TOTAL; u += nb_) {
    if (u < CV_W1) {
      int kt = u % 16, nt = u / 16;
      conv_tile<true>(p.w_in + (long)l * DM * N_IN, N_IN, w1_srccol(nt * 64), p.norm1_w + l * DM, p.W1T, 1024, kt * 64,
                nt * 64, smem);
    } else if (u < CV_W1 + CV_WO) {
      int v = u - CV_W1;
      int kt = v % 24, nt = v / 24;
      conv_tile<false>(p.w_out + (long)l * 1536 * DM, DM, nt * 64, nullptr, p.WOT, 1536, kt * 64, nt * 64, smem);
    } else if (u < CV_W1 + CV_WO + CV_WGU) {
      int v = u - CV_W1 - CV_WO;
      int kt = v % 16, nt = v / 16;
      const float* wg = p.w_gate + (long)l * DM * D_FF;
      const float* wu = p.w_up + (long)l * DM * D_FF;
      const float* sc = p.norm2_w + l * DM;
      const int tid = opaque_tid();
      __syncthreads();
      {
        int nn = tid & 63, kb = tid >> 6;
        const float* src = (nn < 32) ? wg : wu;
        int col = nt * 32 + (nn & 31);
#pragma unroll
        for (int i = 0; i < 16; ++i) {
          int kk = kb + 4 * i;
          smem[kk * 65 + nn] = src[(long)(kt * 64 + kk) * D_FF + col] * sc[kt * 64 + kk];
        }
      }
      __syncthreads();
      {
        int nn = tid >> 2, kq = (tid & 3) * 16;
        u16* d = p.WGU + (long)(nt * 64 + nn) * 1024 + kt * 64 + kq;
#pragma unroll
        for (int j = 0; j < 16; j += 2) {
          unsigned w = f2bf(smem[(kq + j) * 65 + nn]) | ((unsigned)f2bf(smem[(kq + j + 1) * 65 + nn]) << 16);
          *(unsigned*)(d + j) = w;
        }
      }
    } else {
      int v = u - CV_W1 - CV_WO - CV_WGU;
      int kt = v % 44, nt = v / 44;
      conv_tile<false>(p.w_down + (long)l * D_FF * DM, DM, nt * 64, nullptr, p.WDT, D_FF, kt * 64, nt * 64, smem);
    }
  }
}

template <bool WITH_DT>
__device__ __forceinline__ void phase_rowstat(const Params& p, int l, float* smem) {
  const int tid = opaque_tid(), lane = tid & 63, wid = tid >> 6;
  float* dtw = smem;
  if (WITH_DT) {
    __syncthreads();
    const float* w = p.w_in + (long)l * DM * N_IN + 1536;
    const float* nw = p.norm1_w + l * DM;
    for (int i = tid; i < 8192; i += 256) {
      int k = i >> 3, h = i & 7;
      dtw[i] = w[(long)k * N_IN + h] * nw[k];
    }
    __syncthreads();
  }
  for (int blk = BID, nb_ = NBLK; blk < NBLK16; blk += nb_) {
    for (int rr = wid; rr < 16; rr += 4) {
      int m = blk * 16 + rr;
      float ss = 0.f;
      float d[8];
#pragma unroll
      for (int h = 0; h < 8; ++h) d[h] = 0.f;
#pragma unroll 1
      for (int j = 0; j < 4; ++j) {
        int k0 = lane * 4 + 256 * j;
        uint2 raw = *(const uint2*)(p.XB + (long)m * DM + k0);
        float xs[4] = {bf2f((u16)(raw.x & 0xffff)), bf2f((u16)(raw.x >> 16)), bf2f((u16)(raw.y & 0xffff)),
                       bf2f((u16)(raw.y >> 16))};
#pragma unroll
        for (int e = 0; e < 4; ++e) {
          float x = xs[e];
          ss += x * x;
          if (WITH_DT) {
            float4 w0 = *(const float4*)(dtw + (k0 + e) * 8);
            float4 w1 = *(const float4*)(dtw + (k0 + e) * 8 + 4);
            d[0] += x * w0.x; d[1] += x * w0.y; d[2] += x * w0.z; d[3] += x * w0.w;
            d[4] += x * w1.x; d[5] += x * w1.y; d[6] += x * w1.z; d[7] += x * w1.w;
          }
        }
      }
      ss = sum64(ss);
      float rs = rsqrtf(ss * (1.f / 1024.f) + 1e-6f);
      if (WITH_DT) {
#pragma unroll
        for (int h = 0; h < 8; ++h) d[h] = sum64(d[h]);
        if (lane == 0) {
#pragma unroll
          for (int h = 0; h < 8; ++h) p.DTRAW[(long)m * 8 + h] = d[h] * rs;
        }
      }
      if (lane == 0) p.RS[m] = rs;
    }
  }
}

constexpr int G_BK = 32, G_LDS_ROW = 80;
constexpr int G_OPER_BYTES = 128 * G_LDS_ROW;
template <int MODE>
__device__ __forceinline__ void phase_gemm(const Params& p, const u16* __restrict__ A, int lda, const u16* __restrict__ Bt, int K,
                           int nN, char* smem) {
  const int tid = opaque_tid(), lane = tid & 63, wid = tid >> 6, wm = wid >> 1, wn = wid & 1;
  const int nM = M_TOT / 128;
  const int ntiles = nM * nN;
  const int nk = K / G_BK;
  const int lrow = tid >> 2, lkc = tid & 3;
  for (int tile = BID, nb_ = NBLK; tile < ntiles; tile += nb_) {
    constexpr int GM = 32;
    int grp = tile / (GM * nN);
    int first_m = grp * GM;
    int gsz = min(GM, nM - first_m);
    int rem = tile - grp * GM * nN;
    int pm = first_m + rem % gsz, pn = rem / gsz;
    const u16* gA = A + (long)(pm * 128 + lrow) * lda + lkc * 8;
    const u16* gB = Bt + (long)(pn * 128 + lrow) * K + lkc * 8;
    f32x16 acc[2][2];
#pragma unroll
    for (int i = 0; i < 2; ++i)
#pragma unroll
      for (int j = 0; j < 2; ++j)
#pragma unroll
        for (int r = 0; r < 16; ++r) acc[i][j][r] = 0.f;
    uint4 xa0, xa1, xb0, xb1, ya0, ya1, yb0, yb1;
#define G_LOAD(S, KT)                                                  \
  {                                                                    \
    S##a0 = *(const uint4*)(gA + (KT) * G_BK);                         \
    S##a1 = *(const uint4*)(gA + (long)64 * lda + (KT) * G_BK);        \
    S##b0 = *(const uint4*)(gB + (KT) * G_BK);                         \
    S##b1 = *(const uint4*)(gB + (long)64 * K + (KT) * G_BK);          \
  }
#define G_STORE(S, BUF)                                                \
  {                                                                    \
    char* dA = smem + (BUF) * 2 * G_OPER_BYTES;                        \
    char* dB = dA + G_OPER_BYTES;                                      \
    *(uint4*)(dA + lrow * G_LDS_ROW + lkc * 16) = S##a0;               \
    *(uint4*)(dA + (lrow + 64) * G_LDS_ROW + lkc * 16) = S##a1;        \
    *(uint4*)(dB + lrow * G_LDS_ROW + lkc * 16) = S##b0;               \
    *(uint4*)(dB + (lrow + 64) * G_LDS_ROW + lkc * 16) = S##b1;        \
  }
#define G_COMPUTE(BUF)                                                                           \
  {                                                                                              \
    const char* sA = smem + (BUF) * 2 * G_OPER_BYTES;                                            \
    const char* sB = sA + G_OPER_BYTES;                                                          \
    _Pragma("unroll") for (int ks = 0; ks < 2; ++ks) {                                           \
      bf16x8 af[2], bfr[2];                                                                      \
      const int koff = (ks * 16 + (lane >> 5) * 8) * 2;                                          \
      _Pragma("unroll") for (int i = 0; i < 2; ++i)                                              \
        af[i] = *(const bf16x8*)(sA + (wm * 64 + i * 32 + (lane & 31)) * G_LDS_ROW + koff);      \
      _Pragma("unroll") for (int j = 0; j < 2; ++j)                                              \
        bfr[j] = *(const bf16x8*)(sB + (wn * 64 + j * 32 + (lane & 31)) * G_LDS_ROW + koff);     \
      _Pragma("unroll") for (int i = 0; i < 2; ++i)                                              \
        _Pragma("unroll") for (int j = 0; j < 2; ++j)                                            \
          acc[i][j] = __builtin_amdgcn_mfma_f32_32x32x16_bf16(af[i], bfr[j], acc[i][j], 0, 0, 0); \
    }                                                                                            \
  }
    G_LOAD(x, 0);
    G_LOAD(y, 1);
    __builtin_amdgcn_sched_barrier(0);
    __syncthreads();
    G_STORE(x, 0);
    __syncthreads();
    for (int kt = 0; kt < nk; kt += 2) {
      if (kt + 2 < nk) G_LOAD(x, kt + 2);
      __builtin_amdgcn_sched_barrier(0);
      G_COMPUTE(0);
      __builtin_amdgcn_sched_barrier(0);
      G_STORE(y, 1);
      __syncthreads();
      if (kt + 3 < nk) G_LOAD(y, kt + 3);
      __builtin_amdgcn_sched_barrier(0);
      G_COMPUTE(1);
      __builtin_amdgcn_sched_barrier(0);
      if (kt + 2 < nk) G_STORE(x, 0);
      __syncthreads();
    }
#undef G_LOAD
#undef G_STORE
#undef G_COMPUTE
    const int colb = pn * 128 + wn * 64 + (lane & 31);
    const int rowb = pm * 128 + wm * 64 + 4 * (lane >> 5);
    if (MODE == 1) {
#pragma unroll
      for (int i = 0; i < 2; ++i)
#pragma unroll
        for (int r = 0; r < 16; ++r) {
          int row = rowb + i * 32 + (r & 3) + 8 * (r >> 2);
          float rs = p.RS[row];
#pragma unroll
          for (int j = 0; j < 2; ++j) {
            int col = colb + j * 32;
            u16 v = f2bf(acc[i][j][r] * rs);
            p.PROJ[(long)row * LDP + col] = v;
            if ((row & 15) == 15) {
              int jj = -1;
              if (col >= C_R && col < C_GG) jj = col - C_R;
              else if (col >= C_K && col < C_Q) jj = col - C_K + 512;
              if (jj >= 0) p.BND[(long)(row >> 4) * 1792 + jj] = v;
            }
          }
        }
    } else if (MODE == 2) {
#pragma unroll
      for (int i = 0; i < 2; ++i)
#pragma unroll
        for (int r = 0; r < 16; ++r) {
          int row = rowb + i * 32 + (r & 3) + 8 * (r >> 2);
#pragma unroll
          for (int j = 0; j < 2; ++j) {
            int col = colb + j * 32;
            u16* px = p.XB + (long)row * DM + col;
            *px = f2bf(bf2f(*px) + acc[i][j][r]);
          }
        }
    } else {
      const int cact = pn * 64 + wn * 32 + (lane & 31);
      u16* ACT = p.PROJ;
#pragma unroll
      for (int i = 0; i < 2; ++i)
#pragma unroll
        for (int r = 0; r < 16; ++r) {
          int row = rowb + i * 32 + (r & 3) + 8 * (r >> 2);
          float rs = p.RS[row];
          float g = acc[i][0][r] * rs, u = acc[i][1][r] * rs;
          ACT[(long)row * D_FF + cact] = f2bf(siluf_(g) * u);
        }
    }
  }
}

__device__ __forceinline__ void phase_pre(const Params& p, int l, float* smem) {
  const int tid = opaque_tid(), lane = tid & 63, wid = tid >> 6;
  float* XW = smem;
  float* XA = smem + 1024;
  const float* mu = p.rw_mu + l * 1792;
  for (int blk = BID, nb_ = NBLK; blk < NBLK16; blk += nb_) {
    const int m0 = blk * 16;
    int s, t0;
    if (m0 < M_PROMPT) { s = m0 / T_P; t0 = m0 - s * T_P; } else { s = 8 + (m0 - M_PROMPT) / 64; t0 = (m0 - M_PROMPT) & 63; }
    const bool first = (t0 == 0);
    auto prev_of = [&](int j) -> float {
      if (!first) return bf2f(p.BND[(long)(blk - 1) * 1792 + j]);
      if (s < 8) return 0.f;
      return p.state_shift[((long)l * 8 + (s - 8)) * 1792 + j];
    };
    __syncthreads();
    {
      int j = 1536 + tid;
      float mj = mu[j];
      float pv = prev_of(j);
      u16* col = p.PROJ + (long)m0 * LDP + C_XW + tid;
#pragma unroll
      for (int t = 0; t < 16; ++t) {
        float x = bf2f(col[(long)t * LDP]);
        float sh = x + (pv - x) * mj;
        pv = x;
        if (tid < 64) XW[tid * 16 + t] = tanhf(sh);
        else if (tid < 128) XA[(tid - 64) * 16 + t] = sh;
        else col[(long)t * LDP] = f2bf(sigmoidf_(sh));
      }
    }
    __syncthreads();
#pragma unroll 1
    for (int c = 0; c < 2; ++c) {
      const int ch = tid + 256 * c;
      const int head = wid + 4 * c;
      float aw[16], aa[16];
#pragma unroll
      for (int t = 0; t < 16; ++t) { aw[t] = 0.f; aa[t] = 0.f; }
      {
        const float* w2 = p.rw_w2 + (long)l * 64 * 512 + ch;
        const float* a2 = p.rw_a2 + (long)l * 64 * 512 + ch;
#pragma unroll 2
        for (int i = 0; i < 64; ++i) {
          float w2v = w2[i * 512];
          float a2v = a2[i * 512];
#pragma unroll
          for (int q = 0; q < 4; ++q) {
            float4 xw = *(const float4*)(XW + i * 16 + q * 4);
            float4 xa = *(const float4*)(XA + i * 16 + q * 4);
            aw[q * 4 + 0] += xw.x * w2v; aw[q * 4 + 1] += xw.y * w2v;
            aw[q * 4 + 2] += xw.z * w2v; aw[q * 4 + 3] += xw.w * w2v;
            aa[q * 4 + 0] += xa.x * a2v; aa[q * 4 + 1] += xa.y * a2v;
            aa[q * 4 + 2] += xa.z * a2v; aa[q * 4 + 3] += xa.w * a2v;
          }
        }
      }
      {
        float w0 = p.rw_w0[l * 512 + ch], a0 = p.rw_a0[l * 512 + ch];
#pragma unroll
        for (int t = 0; t < 16; ++t) {
          float lw = -softplusf_(-(w0 + aw[t])) - 0.5f;
          float u = -__expf(lw);
          p.RWX[(long)(m0 + t) * 1536 + ch] = f2bf(u);
          aa[t] = sigmoidf_(a0 + aa[t]);
        }
      }
      float rt[16];
      {
        float mj = mu[ch];
        float pv = prev_of(ch);
        u16* col = p.PROJ + (long)m0 * LDP + C_R + ch;
#pragma unroll
        for (int t = 0; t < 16; ++t) {
          float x = bf2f(col[(long)t * LDP]);
          rt[t] = x + (pv - x) * mj;
          pv = x;
        }
#pragma unroll
        for (int t = 0; t < 16; ++t) col[(long)t * LDP] = f2bf(rt[t]);
      }
      {
        float mj = mu[512 + ch];
        float pv = prev_of(512 + ch);
        float kkw = p.rw_kk[l * 512 + ch], kaw = p.rw_ka[l * 512 + ch], rkw = p.rw_rk[l * 512 + ch];
        u16* col = p.PROJ + (long)m0 * LDP + C_K + ch;
        float kt[16];
#pragma unroll
        for (int t = 0; t < 16; ++t) {
          float x = bf2f(col[(long)t * LDP]);
          kt[t] = x + (pv - x) * mj;
          pv = x;
        }
#pragma unroll
        for (int t = 0; t < 16; ++t) {
          float kkv = kt[t] * kkw;
          float ssq = sum64(kkv * kkv);
          float kk = kkv * rsqrtf(ssq + 1e-12f);
          float a = aa[t];
          float kp = kt[t] * (1.f + (a - 1.f) * kaw);
          float rks = sum64(rt[t] * kp * rkw);
          col[(long)t * LDP] = f2bf(kp);
          p.RWX[(long)(m0 + t) * 1536 + 512 + ch] = f2bf(kk);
          p.RWX[(long)(m0 + t) * 1536 + 1024 + ch] = f2bf(kk * a);
          if (lane == 0) p.RKS[(long)(m0 + t) * 8 + head] = rks;
        }
      }
      {
        float mj = mu[1024 + ch];
        float pv = prev_of(1024 + ch);
        u16* col = p.PROJ + (long)m0 * LDP + C_V + ch;
        float vt[16];
#pragma unroll
        for (int t = 0; t < 16; ++t) {
          float x = bf2f(col[(long)t * LDP]);
          vt[t] = x + (pv - x) * mj;
          pv = x;
        }
#pragma unroll
        for (int t = 0; t < 16; ++t) col[(long)t * LDP] = f2bf(vt[t]);
      }
    }
    if (t0 + 16 == seq_len(s)) {
      float* o = p.out + (s < 8 ? O_PSHIFT + ((long)l * 8 + s) * 1792 : O_SSHIFT + ((long)l * 8 + (s - 8)) * 1792);
      for (int j = tid; j < 1792; j += 256) o[j] = bf2f(p.BND[(long)blk * 1792 + j]);
    }
  }
}

__device__ __forceinline__ void scan_rwkv(const Params& p, int l, int s, int h, int q, float* smem) {
  const int tid = opaque_tid(), lane = tid & 63, wid = tid >> 6;
  float* R_ = smem;
  float* W_ = smem + 1024;
  float* K_ = smem + 2048;
  float* A_ = smem + 3072;
  float* B_ = smem + 4096;
  float* V_ = smem + 5120;
  float* O_ = smem + 5376;
  const int rl = wid * 4 + (lane >> 4);
  const int row = q * 16 + rl;
  const int ksl = (lane & 15) * 4;
  const int base = seq_base(s), T = seq_len(s);
  float s0 = 0.f, s1 = 0.f, s2 = 0.f, s3 = 0.f;
  if (s >= 8) {
    const float* st = p.state_rwkv + (((long)l * 8 + (s - 8)) * 8 + h) * 4096 + row * 64 + ksl;
    float4 v = *(const float4*)st;
    s0 = v.x; s1 = v.y; s2 = v.z; s3 = v.w;
  }
  const int stt = tid >> 4, skq = (tid & 15) * 4;
  const int nblk = T / 16;
  ushort4 r4, k4, u4, a4, b4;
  u16 vv;
  {
    const long m = base + stt;
    const u16* pr = p.PROJ + m * LDP;
    const u16* px = p.RWX + m * 1536;
    r4 = *(const ushort4*)(pr + C_R + h * 64 + skq);
    k4 = *(const ushort4*)(pr + C_K + h * 64 + skq);
    u4 = *(const ushort4*)(px + h * 64 + skq);
    a4 = *(const ushort4*)(px + 512 + h * 64 + skq);
    b4 = *(const ushort4*)(px + 1024 + h * 64 + skq);
    vv = pr[C_V + h * 64 + q * 16 + (tid & 15)];
  }
  __syncthreads();
  float* TR_ = smem + 5376 + 512;
  const bool wr = (lane & 15) == 0;
  const int ooff = wr ? rl : (512 + lane);
  const int ostr = wr ? 16 : 0;
  for (int blk = 0; blk < nblk; ++blk) {
    const long m = base + blk * 16 + stt;
    float* Oc = O_ + (blk & 1) * 256;
    {
      *(float4*)(R_ + stt * 64 + skq) = make_float4(bf2f(r4.x), bf2f(r4.y), bf2f(r4.z), bf2f(r4.w));
      *(float4*)(K_ + stt * 64 + skq) = make_float4(bf2f(k4.x), bf2f(k4.y), bf2f(k4.z), bf2f(k4.w));
      *(float4*)(W_ + stt * 64 + skq) =
          make_float4(__expf(bf2f(u4.x)), __expf(bf2f(u4.y)), __expf(bf2f(u4.z)), __expf(bf2f(u4.w)));
      *(float4*)(A_ + stt * 64 + skq) = make_float4(-bf2f(a4.x), -bf2f(a4.y), -bf2f(a4.z), -bf2f(a4.w));
      *(float4*)(B_ + stt * 64 + skq) = make_float4(bf2f(b4.x), bf2f(b4.y), bf2f(b4.z), bf2f(b4.w));
      V_[stt * 16 + (tid & 15)] = bf2f(vv);
    }
    __syncthreads();
    if (blk > 0)
      p.ORW[(m - 16) * 512 + h * 64 + q * 16 + (tid & 15)] = f2bf(O_[((blk - 1) & 1) * 256 + stt * 16 + (tid & 15)]);
    if (blk + 1 < nblk) {
      const u16* pr = p.PROJ + (m + 16) * LDP;
      const u16* px = p.RWX + (m + 16) * 1536;
      r4 = *(const ushort4*)(pr + C_R + h * 64 + skq);
      k4 = *(const ushort4*)(pr + C_K + h * 64 + skq);
      u4 = *(const ushort4*)(px + h * 64 + skq);
      a4 = *(const ushort4*)(px + 512 + h * 64 + skq);
      b4 = *(const ushort4*)(px + 1024 + h * 64 + skq);
      vv = pr[C_V + h * 64 + q * 16 + (tid & 15)];
    }
    __builtin_amdgcn_sched_barrier(0);
    {
      float4 a = *(const float4*)(A_ + ksl), w = *(const float4*)(W_ + ksl), b = *(const float4*)(B_ + ksl);
      float4 k = *(const float4*)(K_ + ksl), r = *(const float4*)(R_ + ksl);
      float v = V_[rl];
      float opart = 0.f;
#pragma unroll
      for (int tt = 0; tt < 16; ++tt) {
        float4 an, wn, bn, kn, rn;
        float vn;
        if (tt + 1 < 16) {
          an = *(const float4*)(A_ + (tt + 1) * 64 + ksl); wn = *(const float4*)(W_ + (tt + 1) * 64 + ksl);
          bn = *(const float4*)(B_ + (tt + 1) * 64 + ksl); kn = *(const float4*)(K_ + (tt + 1) * 64 + ksl);
          rn = *(const float4*)(R_ + (tt + 1) * 64 + ksl); vn = V_[(tt + 1) * 16 + rl];
        }
        __builtin_amdgcn_sched_barrier(0);
        float sa = fmaf(s0, a.x, fmaf(s1, a.y, fmaf(s2, a.z, s3 * a.w)));
        if (tt > 0) { sum16x2(sa, opart); Oc[ooff + (tt - 1) * ostr] = opart; }
        else sa = sum16(sa);
        s0 = fmaf(s0, w.x, fmaf(sa, b.x, v * k.x)); NOPK(s0);
        s1 = fmaf(s1, w.y, fmaf(sa, b.y, v * k.y)); NOPK(s1);
        s2 = fmaf(s2, w.z, fmaf(sa, b.z, v * k.z)); NOPK(s2);
        s3 = fmaf(s3, w.w, fmaf(sa, b.w, v * k.w)); NOPK(s3);
        opart = fmaf(s0, r.x, fmaf(s1, r.y, fmaf(s2, r.z, s3 * r.w)));
        if (tt == 15) { opart = sum16(opart); Oc[ooff + 15 * ostr] = opart; }
        __builtin_amdgcn_sched_barrier(0);
        if (tt + 1 < 16) { a = an; w = wn; b = bn; k = kn; r = rn; v = vn; }
      }
    }
    __builtin_amdgcn_sched_barrier(0);
    __syncthreads();
  }
  {
    const long m = base + (nblk - 1) * 16 + stt;
    p.ORW[m * 512 + h * 64 + q * 16 + (tid & 15)] = f2bf(O_[((nblk - 1) & 1) * 256 + stt * 16 + (tid & 15)]);
  }
  __syncthreads();
  {
    float* o = p.out + (s < 8 ? O_PRWKV + (((long)l * 8 + s) * 8 + h) * 4096
                              : O_SRWKV + (((long)l * 8 + (s - 8)) * 8 + h) * 4096);
    *(float4*)(o + row * 64 + ksl) = make_float4(s0, s1, s2, s3);
  }
}

__device__ __forceinline__ void scan_hgrn(const Params& p, int l, int s, int h, int q, float* smem) {
  const int tid = opaque_tid(), lane = tid & 63, wid = tid >> 6;
  float* Q_ = smem;
  float* F_ = smem + 2048;
  float* G_ = smem + 4096;
  float* I_ = smem + 6144;
  float* O_ = smem + 6400;
  const int rl = wid * 4 + (lane >> 4);
  const int row = q * 16 + rl;
  const int ksl4 = (lane & 15) * 4;
  const int base = seq_base(s), T = seq_len(s);
  float st[8];
#pragma unroll
  for (int i = 0; i < 8; ++i) st[i] = 0.f;
  if (s >= 8) {
    const float* sp = p.state_hgrn + (((long)l * 8 + (s - 8)) * 4 + h) * 16384;
#pragma unroll
    for (int i = 0; i < 8; ++i) st[i] = sp[((i >> 2) * 64 + ksl4 + (i & 3)) * 128 + row];
  }
  const int stt = tid >> 4, skq = (tid & 15) * 8;
  float lb[8];
#pragma unroll
  for (int i = 0; i < 8; ++i) {
    if (l == 0) lb[i] = 0.f;
    else {
      float x0 = p.hg_lb[h * 128 + skq + i], x1 = p.hg_lb[512 + h * 128 + skq + i];
      lb[i] = frcp_(1.f + __expf(x0 - x1));
    }
  }
  const int nblk = T / 16;
  uint4 q8, f8;
  u16 iv16;
  {
    const u16* pr = p.PROJ + (long)(base + stt) * LDP;
    q8 = *(const uint4*)(pr + C_Q + h * 128 + skq);
    f8 = *(const uint4*)(pr + C_F + h * 128 + skq);
    iv16 = pr[C_I + h * 128 + q * 16 + (tid & 15)];
  }
  __syncthreads();
  float* TR_ = smem + 6400 + 512;
  const bool wr = (lane & 15) == 0;
  const int ooff = wr ? rl : (512 + lane);
  const int ostr = wr ? 16 : 0;
  for (int blk = 0; blk < nblk; ++blk) {
    const long m = base + blk * 16 + stt;
    float* Oc = O_ + (blk & 1) * 256;
    {
      unsigned qw[4] = {q8.x, q8.y, q8.z, q8.w}, fw[4] = {f8.x, f8.y, f8.z, f8.w};
      float qv[8], fv[8], gv[8];
#pragma unroll
      for (int e = 0; e < 8; ++e) {
        qv[e] = bf2f((u16)((qw[e >> 1] >> ((e & 1) * 16)) & 0xffff));
        float fz = bf2f((u16)((fw[e >> 1] >> ((e & 1) * 16)) & 0xffff));
        float ex = __expf(-fz);
        float sg = frcp_(1.f + ex);
        float sgn = ex * sg;
        fv[e] = lb[e] + (1.f - lb[e]) * sg;
        gv[e] = (1.f - lb[e]) * sgn;
      }
      *(float4*)(Q_ + stt * 128 + skq) = make_float4(qv[0], qv[1], qv[2], qv[3]);
      *(float4*)(Q_ + stt * 128 + skq + 4) = make_float4(qv[4], qv[5], qv[6], qv[7]);
      *(float4*)(F_ + stt * 128 + skq) = make_float4(fv[0], fv[1], fv[2], fv[3]);
      *(float4*)(F_ + stt * 128 + skq + 4) = make_float4(fv[4], fv[5], fv[6], fv[7]);
      *(float4*)(G_ + stt * 128 + skq) = make_float4(gv[0], gv[1], gv[2], gv[3]);
      *(float4*)(G_ + stt * 128 + skq + 4) = make_float4(gv[4], gv[5], gv[6], gv[7]);
      I_[stt * 16 + (tid & 15)] = bf2f(iv16);
    }
    __syncthreads();
    if (blk > 0) {
      u16* dp = p.PROJ + (m - 16) * LDP + C_I + h * 128 + q * 16 + (tid & 15);
      *dp = f2bf(O_[((blk - 1) & 1) * 256 + stt * 16 + (tid & 15)]);
    }
    if (blk + 1 < nblk) {
      const u16* pr = p.PROJ + (m + 16) * LDP;
      q8 = *(const uint4*)(pr + C_Q + h * 128 + skq);
      f8 = *(const uint4*)(pr + C_F + h * 128 + skq);
      iv16 = pr[C_I + h * 128 + q * 16 + (tid & 15)];
    }
    __builtin_amdgcn_sched_barrier(0);
    {
      float4 f0 = *(const float4*)(F_ + ksl4), f1 = *(const float4*)(F_ + 64 + ksl4);
      float4 g0 = *(const float4*)(G_ + ksl4), g1 = *(const float4*)(G_ + 64 + ksl4);
      float4 q0 = *(const float4*)(Q_ + ksl4), q1 = *(const float4*)(Q_ + 64 + ksl4);
      float iv = I_[rl];
      float oprev = 0.f;
#pragma unroll
      for (int tt = 0; tt < 16; ++tt) {
        float4 f0n, f1n, g0n, g1n, q0n, q1n;
        float ivn;
        if (tt + 1 < 16) {
          const int o_ = (tt + 1) * 128;
          f0n = *(const float4*)(F_ + o_ + ksl4); f1n = *(const float4*)(F_ + o_ + 64 + ksl4);
          g0n = *(const float4*)(G_ + o_ + ksl4); g1n = *(const float4*)(G_ + o_ + 64 + ksl4);
          q0n = *(const float4*)(Q_ + o_ + ksl4); q1n = *(const float4*)(Q_ + o_ + 64 + ksl4);
          ivn = I_[(tt + 1) * 16 + rl];
        }
        __builtin_amdgcn_sched_barrier(0);
        st[0] = fmaf(st[0], f0.x, g0.x * iv); NOPK(st[0]);
        st[1] = fmaf(st[1], f0.y, g0.y * iv); NOPK(st[1]);
        st[2] = fmaf(st[2], f0.z, g0.z * iv); NOPK(st[2]);
        st[3] = fmaf(st[3], f0.w, g0.w * iv); NOPK(st[3]);
        st[4] = fmaf(st[4], f1.x, g1.x * iv); NOPK(st[4]);
        st[5] = fmaf(st[5], f1.y, g1.y * iv); NOPK(st[5]);
        st[6] = fmaf(st[6], f1.z, g1.z * iv); NOPK(st[6]);
        st[7] = fmaf(st[7], f1.w, g1.w * iv); NOPK(st[7]);
        float acc0 = fmaf(st[0], q0.x, fmaf(st[1], q0.y, fmaf(st[2], q0.z, st[3] * q0.w)));
        float acc1 = fmaf(st[4], q1.x, fmaf(st[5], q1.y, fmaf(st[6], q1.z, st[7] * q1.w)));
        float o = acc0 + acc1;
        if (tt & 1) { sum16x2(oprev, o); Oc[ooff + (tt - 1) * ostr] = oprev; Oc[ooff + tt * ostr] = o; }
        else oprev = o;
        __builtin_amdgcn_sched_barrier(0);
        if (tt + 1 < 16) { f0 = f0n; f1 = f1n; g0 = g0n; g1 = g1n; q0 = q0n; q1 = q1n; iv = ivn; }
      }
    }
    __builtin_amdgcn_sched_barrier(0);
    __syncthreads();
  }
  {
    const long m = base + (nblk - 1) * 16 + stt;
    u16* dp = p.PROJ + m * LDP + C_I + h * 128 + q * 16 + (tid & 15);
    *dp = f2bf(O_[((nblk - 1) & 1) * 256 + stt * 16 + (tid & 15)]);
  }
  __syncthreads();
  {
    float* o = p.out + (s < 8 ? O_PHGRN + (((long)l * 8 + s) * 4 + h) * 16384
                              : O_SHGRN + (((long)l * 8 + (s - 8)) * 4 + h) * 16384);
#pragma unroll
    for (int i = 0; i < 8; ++i) o[((i >> 2) * 64 + ksl4 + (i & 3)) * 128 + row] = st[i];
  }
}

__device__ __forceinline__ void scan_ssd(const Params& p, int l, int s, int h, int q, float* smem) {
  const int tid = opaque_tid(), lane = tid & 63, wid = tid >> 6;
  float* B_ = smem;
  float* C_ = smem + 2048;
  float* X_ = smem + 4096;
  float* O_ = smem + 4352;
  float* DT_ = smem + 5200;
  float* DE_ = smem + 5216;
  const int rl = wid * 4 + (lane >> 4);
  const int row = q * 16 + rl;
  const int ksl4 = (lane & 15) * 4;
  const int g = h >> 2;
  const int base = seq_base(s), T = seq_len(s);
  float st[8];
#pragma unroll
  for (int i = 0; i < 8; ++i) st[i] = 0.f;
  if (s >= 8) {
    const float* sp = p.state_ssm + (((long)l * 8 + (s - 8)) * 8 + h) * 8192 + row * 128 + ksl4;
    float4 a = *(const float4*)sp, b = *(const float4*)(sp + 64);
    st[0] = a.x; st[1] = a.y; st[2] = a.z; st[3] = a.w; st[4] = b.x; st[5] = b.y; st[6] = b.z; st[7] = b.w;
  }
  const int xc_bc = (tid < 128) ? (512 + g * 128 + tid) : (768 + g * 128 + (tid - 128));
  const float* cw = p.conv_w + (long)l * 4 * 1024;
  const float cb0 = cw[xc_bc], cb1 = cw[1024 + xc_bc], cb2 = cw[2048 + xc_bc], cb3 = cw[3072 + xc_bc];
  const float cbb = p.conv_b[l * 1024 + xc_bc];
  float u3 = 0.f, u2 = 0.f, u1 = 0.f;
  const int xc_x = h * 64 + q * 16 + (tid & 15);
  const float cx0 = cw[xc_x], cx1 = cw[1024 + xc_x], cx2 = cw[2048 + xc_x], cx3 = cw[3072 + xc_x];
  const float cxb = p.conv_b[l * 1024 + xc_x];
  float x3 = 0.f, x2 = 0.f, x1 = 0.f;
  if (s >= 8) {
    const float* sc = p.state_conv + ((long)l * 8 + (s - 8)) * 3 * 1024;
    u3 = sc[xc_bc]; u2 = sc[1024 + xc_bc]; u1 = sc[2048 + xc_bc];
    x3 = sc[xc_x]; x2 = sc[1024 + xc_x]; x1 = sc[2048 + xc_x];
  }
  const float dtb = p.dt_bias[l * 8 + h];
  const float aexp = __expf(p.a_log[l * 8 + h]);
  const float dsk = p.d_skip[l * 8 + h];
  const int stt = tid >> 4;
  const int nblk = T / 16;
  u16 raw[16];
  float xr[4];
  float dtr = 0.f;
  u16 zc = 0, zn = 0;
#define SSD_LOAD(M0)                                                              \
  {                                                                               \
    const u16* col = p.PROJ + (long)(M0) * LDP + C_XBC + xc_bc;                   \
    _Pragma("unroll") for (int t = 0; t < 16; ++t) raw[t] = col[(long)t * LDP];   \
    {                                                                             \
      const long mr = (long)(M0) + stt;                                           \
      const u16* colx = p.PROJ + mr * LDP + C_XBC + xc_x;                         \
      _Pragma("unroll") for (int j = 0; j < 4; ++j) {                             \
        const long mm = mr - 3 + j;                                               \
        float vx;                                                                 \
        if (mm >= base) vx = bf2f(colx[(long)(j - 3) * LDP]);                     \
        else vx = (s >= 8) ? p.state_conv[((long)l * 8 + (s - 8)) * 3072 + (3 + (int)(mm - base)) * 1024 + xc_x] : 0.f; \
        xr[j] = vx;                                                               \
      }                                                                           \
    }                                                                             \
    if (tid < 16) dtr = p.DTRAW[((long)(M0) + tid) * 8 + h];                      \
    zn = p.PROJ[((long)(M0) + stt) * LDP + C_Z + h * 64 + q * 16 + (tid & 15)];   \
  }
#pragma unroll
  for (int t = 0; t < 16; ++t) raw[t] = 0;
  SSD_LOAD(base);
  __syncthreads();
  const bool wr = (lane & 15) == 0;
  const int ooff = wr ? rl : (512 + lane);
  const int ostr = wr ? 16 : 0;
  u16 zp = 0;
  for (int blk = 0; blk < nblk; ++blk) {
    const long m0 = base + blk * 16;
    zp = zc;
    zc = zn;
    float* Oc = O_ + (blk & 1) * 256;
    {
      float* dst = (tid < 128) ? (B_ + tid) : (C_ + (tid - 128));
#pragma unroll
      for (int t = 0; t < 16; ++t) {
        float u0 = bf2f(raw[t]);
        float y = cb0 * u3 + cb1 * u2 + cb2 * u1 + cb3 * u0 + cbb;
        dst[t * 128] = siluf_(y);
        u3 = u2; u2 = u1; u1 = u0;
      }
      {
        float y = cx0 * xr[0] + cx1 * xr[1] + cx2 * xr[2] + cx3 * xr[3] + cxb;
        X_[stt * 16 + (tid & 15)] = siluf_(y);
      }
      if (tid < 16) {
        float dtv = softplusf_(dtr + dtb);
        DT_[tid] = dtv;
        DE_[tid] = __expf(-aexp * dtv);
      }
    }
    __syncthreads();
    if (blk > 0) {
      u16* pz = p.PROJ + (m0 - 16 + stt) * LDP + C_Z + h * 64 + q * 16 + (tid & 15);
      *pz = f2bf(O_[((blk - 1) & 1) * 256 + stt * 16 + (tid & 15)] * siluf_(bf2f(zp)));
    }
    if (blk + 1 < nblk) SSD_LOAD(m0 + 16);
    __builtin_amdgcn_sched_barrier(0);
    {
      float4 b0 = *(const float4*)(B_ + ksl4), b1 = *(const float4*)(B_ + 64 + ksl4);
      float4 c0 = *(const float4*)(C_ + ksl4), c1 = *(const float4*)(C_ + 64 + ksl4);
      float xv = X_[rl], dt = DT_[0], de = DE_[0];
      float yprev = 0.f, xvprev = 0.f;
#pragma unroll
      for (int tt = 0; tt < 16; ++tt) {
        float4 b0n, b1n, c0n, c1n;
        float xvn, dtn, den;
        if (tt + 1 < 16) {
          const int o_ = (tt + 1) * 128;
          b0n = *(const float4*)(B_ + o_ + ksl4); b1n = *(const float4*)(B_ + o_ + 64 + ksl4);
          c0n = *(const float4*)(C_ + o_ + ksl4); c1n = *(const float4*)(C_ + o_ + 64 + ksl4);
          xvn = X_[(tt + 1) * 16 + rl]; dtn = DT_[tt + 1]; den = DE_[tt + 1];
        }
        __builtin_amdgcn_sched_barrier(0);
        const float xd = xv * dt;
        st[0] = fmaf(st[0], de, xd * b0.x); NOPK(st[0]);
        st[1] = fmaf(st[1], de, xd * b0.y); NOPK(st[1]);
        st[2] = fmaf(st[2], de, xd * b0.z); NOPK(st[2]);
        st[3] = fmaf(st[3], de, xd * b0.w); NOPK(st[3]);
        st[4] = fmaf(st[4], de, xd * b1.x); NOPK(st[4]);
        st[5] = fmaf(st[5], de, xd * b1.y); NOPK(st[5]);
        st[6] = fmaf(st[6], de, xd * b1.z); NOPK(st[6]);
        st[7] = fmaf(st[7], de, xd * b1.w); NOPK(st[7]);
        float acc0 = fmaf(st[0], c0.x, fmaf(st[1], c0.y, fmaf(st[2], c0.z, st[3] * c0.w)));
        float acc1 = fmaf(st[4], c1.x, fmaf(st[5], c1.y, fmaf(st[6], c1.z, st[7] * c1.w)));
        float y = acc0 + acc1;
        if (tt & 1) { sum16x2(yprev, y); Oc[ooff + (tt - 1) * ostr] = yprev + dsk * xvprev; Oc[ooff + tt * ostr] = y + dsk * xv; }
        else { yprev = y; xvprev = xv; }
        __builtin_amdgcn_sched_barrier(0);
        if (tt + 1 < 16) { b0 = b0n; b1 = b1n; c0 = c0n; c1 = c1n; xv = xvn; dt = dtn; de = den; }
      }
    }
    __builtin_amdgcn_sched_barrier(0);
    __syncthreads();
  }
  {
    const long m0 = base + (nblk - 1) * 16;
    u16* pz = p.PROJ + (m0 + stt) * LDP + C_Z + h * 64 + q * 16 + (tid & 15);
    *pz = f2bf(O_[((nblk - 1) & 1) * 256 + stt * 16 + (tid & 15)] * siluf_(bf2f(zc)));
  }
  __syncthreads();
#undef SSD_LOAD
  {
    float* o = p.out + (s < 8 ? O_PSSM + (((long)l * 8 + s) * 8 + h) * 8192
                              : O_SSSM + (((long)l * 8 + (s - 8)) * 8 + h) * 8192);
    *(float4*)(o + row * 128 + ksl4) = make_float4(st[0], st[1], st[2], st[3]);
    *(float4*)(o + row * 128 + 64 + ksl4) = make_float4(st[4], st[5], st[6], st[7]);
  }
  if (h == 0 && q == 0) {
    float* o = p.out + (s < 8 ? O_PCONV + ((long)l * 8 + s) * 3072 : O_SCONV + ((long)l * 8 + (s - 8)) * 3072);
    for (int i = tid; i < 3072; i += 256) {
      int r = i >> 10, c = i & 1023;
      o[i] = bf2f(p.PROJ[(long)(base + T - 3 + r) * LDP + C_XBC + c]);
    }
  }
}

__device__ __forceinline__ void phase_scan(const Params& p, int l, float* smem) {
  for (int u = BID, nb_ = NBLK; u < 1536; u += nb_) {
    int sample = u >= 768;
    int v = sample ? u - 768 : u;
    int type = v % 3, w = v / 3;
    if (type == 0) {
      int q = w & 3, h = (w >> 2) & 7, b = w >> 5;
      scan_rwkv(p, l, b + 8 * sample, h, q, smem);
    } else if (type == 1) {
      int q = w & 7, h = (w >> 3) & 3, b = w >> 5;
      scan_hgrn(p, l, b + 8 * sample, h, q, smem);
    } else {
      int q = w & 3, h = (w >> 2) & 7, b = w >> 5;
      scan_ssd(p, l, b + 8 * sample, h, q, smem);
    }
  }
}

__device__ __forceinline__ void phase_post(const Params& p, int l, float* smem) {
  const int tid = opaque_tid(), lane = tid & 63, wid = tid >> 6;
  float* SG = smem;
  float* RED = smem + 2048;
  for (int blk = BID, nb_ = NBLK; blk < NBLK16; blk += nb_) {
    const long m0 = (long)blk * 16;
    __syncthreads();
    if (tid < 128) {
      const u16* col = p.PROJ + m0 * LDP + C_XG + tid;
#pragma unroll
      for (int t = 0; t < 16; ++t) SG[tid * 16 + t] = bf2f(col[(long)t * LDP]);
    }
    float ys[2][16], oh[2][16];
#pragma unroll
    for (int c = 0; c < 2; ++c) {
      int ch = tid + 256 * c;
#pragma unroll
      for (int t = 0; t < 16; ++t) {
        ys[c][t] = bf2f(p.PROJ[(m0 + t) * LDP + C_Z + ch]);
        oh[c][t] = bf2f(p.PROJ[(m0 + t) * LDP + C_I + ch]);
      }
    }
#pragma unroll
    for (int t = 0; t < 16; ++t) {
      float a0 = sum64(ys[0][t] * ys[0][t]), a1 = sum64(ys[1][t] * ys[1][t]);
      float b0 = sum64(oh[0][t] * oh[0][t]), b1 = sum64(oh[1][t] * oh[1][t]);
      if (lane == 0) *(float4*)(RED + (wid * 16 + t) * 4) = make_float4(a0, a1, b0, b1);
    }
    __syncthreads();
    {
      const float nw0 = p.ssd_norm_w[l * 512 + tid], nw1 = p.ssd_norm_w[l * 512 + tid + 256];
      const float hw0 = p.hg_norm_w[l * 512 + tid], hw1 = p.hg_norm_w[l * 512 + tid + 256];
      const int pw = (wid >> 1) * 2;
#pragma unroll
      for (int t = 0; t < 16; ++t) {
        float4 r0 = *(const float4*)(RED + (0 * 16 + t) * 4), r1 = *(const float4*)(RED + (1 * 16 + t) * 4);
        float4 r2 = *(const float4*)(RED + (2 * 16 + t) * 4), r3 = *(const float4*)(RED + (3 * 16 + t) * 4);
        float g0 = r0.x + r1.x + r2.x + r3.x, g1 = r0.y + r1.y + r2.y + r3.y;
        float4 pa = *(const float4*)(RED + (pw * 16 + t) * 4), pb = *(const float4*)(RED + ((pw + 1) * 16 + t) * 4);
        float h0 = pa.z + pb.z, h1 = pa.w + pb.w;
        u16* rowp = p.PROJ + (m0 + t) * LDP;
        rowp[C_Z + tid] = f2bf(ys[0][t] * rsqrtf(g0 * (1.f / 256.f) + 1e-6f) * nw0);
        rowp[C_Z + tid + 256] = f2bf(ys[1][t] * rsqrtf(g1 * (1.f / 256.f) + 1e-6f) * nw1);
        float gg0 = bf2f(rowp[C_GG + tid]), gg1 = bf2f(rowp[C_GG + tid + 256]);
        rowp[C_GG + tid] = f2bf(oh[0][t] * rsqrtf(h0 * (1.f / 128.f) + 1e-6f) * hw0 * siluf_(gg0));
        rowp[C_GG + tid + 256] = f2bf(oh[1][t] * rsqrtf(h1 * (1.f / 128.f) + 1e-6f) * hw1 * siluf_(gg1));
      }
    }
    float ga[2][16];
#pragma unroll
    for (int c = 0; c < 2; ++c)
#pragma unroll
      for (int t = 0; t < 16; ++t) ga[c][t] = 0.f;
    {
      const float* g2 = p.rw_g2 + (long)l * 128 * 512;
      for (int i = 0; i < 128; ++i) {
        float gv[2] = {g2[i * 512 + tid], g2[i * 512 + tid + 256]};
#pragma unroll
        for (int q = 0; q < 4; ++q) {
          float4 x = *(const float4*)(SG + i * 16 + q * 4);
#pragma unroll
          for (int c = 0; c < 2; ++c) {
            ga[c][q * 4 + 0] += x.x * gv[c]; ga[c][q * 4 + 1] += x.y * gv[c];
            ga[c][q * 4 + 2] += x.z * gv[c]; ga[c][q * 4 + 3] += x.w * gv[c];
          }
        }
      }
    }
#pragma unroll
    for (int c = 0; c < 2; ++c) {
      int ch = tid + 256 * c, head = wid + 4 * c;
      float lw = p.rw_lnx_w[l * 512 + ch], lbv = p.rw_lnx_b[l * 512 + ch];
#pragma unroll
      for (int t = 0; t < 16; ++t) {
        float o = bf2f(p.ORW[(m0 + t) * 512 + ch]);
        float mean = sum64(o) * (1.f / 64.f);
        float d = o - mean;
        float var = sum64(d * d) * (1.f / 64.f);
        float ln = d * rsqrtf(var + 64e-5f) * lw + lbv;
        float v = bf2f(p.PROJ[(m0 + t) * LDP + C_V + ch]);
        float bonus = p.RKS[(m0 + t) * 8 + head] * v;
        p.PROJ[(m0 + t) * LDP + C_R + ch] = f2bf((ln + bonus) * ga[c][t]);
      }
    }
  }
}

__device__ __forceinline__ void phase_final(const Params& p) {
  const int tid = opaque_tid(), lane = tid & 63, wid = tid >> 6;
  for (int m = BID * 4 + wid, nb_ = NBLK; m < M_TOT; m += nb_ * 4) {
    float* dst;
    if (m < M_PROMPT) {
      int b = m / T_P, t = m - b * T_P;
      if (t < 16) continue;
      dst = p.out + O_YP + ((long)b * 4096 + (t - 16)) * DM;
    } else {
      dst = p.out + O_YS + (long)(m - M_PROMPT) * DM;
    }
    float x[16];
    float ss = 0.f;
#pragma unroll
    for (int j = 0; j < 2; ++j) {
      uint4 raw = *(const uint4*)(p.XB + (long)m * DM + lane * 8 + 512 * j);
      unsigned wv[4] = {raw.x, raw.y, raw.z, raw.w};
#pragma unroll
      for (int e = 0; e < 8; ++e) {
        x[j * 8 + e] = bf2f((u16)((wv[e >> 1] >> ((e & 1) * 16)) & 0xffff));
        ss += x[j * 8 + e] * x[j * 8 + e];
      }
    }
    ss = sum64(ss);
    float rs = rsqrtf(ss * (1.f / 1024.f) + 1e-6f);
#pragma unroll
    for (int j = 0; j < 2; ++j) {
      int k0 = lane * 8 + 512 * j;
      float4 w0 = *(const float4*)(p.final_w + k0), w1 = *(const float4*)(p.final_w + k0 + 4);
      *(float4*)(dst + k0) = make_float4(x[j * 8 + 0] * rs * w0.x, x[j * 8 + 1] * rs * w0.y, x[j * 8 + 2] * rs * w0.z,
                                         x[j * 8 + 3] * rs * w0.w);
      *(float4*)(dst + k0 + 4) = make_float4(x[j * 8 + 4] * rs * w1.x, x[j * 8 + 5] * rs * w1.y,
                                             x[j * 8 + 6] * rs * w1.z, x[j * 8 + 7] * rs * w1.w);
    }
  }
}


#define XB_TMO      128
#define XB_XCNT(j)  (256  + 64 * (j))
#define XB_XSUB(j)  (1280 + 64 * (j))
#define XB_XGEN(j)  (2304 + 64 * (j))
#define XB_TOP      3328
#define XB_TOPGEN   3392
#define XCD_BAR_WORDS 3456
#define XB_SPIN_CAP (1u << 22)
__device__ __forceinline__ unsigned xb_ld(unsigned* p) { return __hip_atomic_load(p, __ATOMIC_RELAXED, __HIP_MEMORY_SCOPE_AGENT); }
__device__ __forceinline__ unsigned xb_add(unsigned* p, unsigned v) { return __hip_atomic_fetch_add(p, v, __ATOMIC_RELAXED, __HIP_MEMORY_SCOPE_AGENT); }
__device__ __forceinline__ unsigned xb_xcc_id() { return (unsigned)__builtin_amdgcn_s_getreg((3 << 11) | 20) & 0xFu; }
#define XB_SPIN(cond, bar) do { unsigned _sp = 0; while (cond) { __builtin_amdgcn_s_sleep(1); \
    if ((++_sp & 255u) == 0u) { if (xb_ld(&(bar)[XB_TMO])) break; if (_sp > XB_SPIN_CAP) { atomicAdd(&(bar)[XB_TMO], 1u); break; } } } } while (0)

__device__ __forceinline__ void xcd_barrier_post(unsigned* bar) {
  if (threadIdx.x == 0) (void)xb_add(&bar[XB_XCNT(xb_xcc_id())], 1u);
}
__device__ __forceinline__ void xcd_barrier_complete(unsigned* bar, unsigned x, unsigned& nloc, unsigned& nx) {
  const unsigned G = gridDim.x;
  unsigned sum, cnt, mine, sp = 0u;
  for (;;) {
    sum = 0u; cnt = 0u; mine = 0u;
#pragma unroll
    for (unsigned j = 0; j < 16; ++j) { const unsigned c = xb_ld(&bar[XB_XCNT(j)]); sum += c; cnt += (c > 0u) ? 1u : 0u; mine = (j == x) ? c : mine; }
    if (sum == G) break;
    __builtin_amdgcn_s_sleep(1);
    if ((++sp & 255u) == 0u) { if (xb_ld(&bar[XB_TMO])) break; if (sp > XB_SPIN_CAP) { atomicAdd(&bar[XB_TMO], 1u); break; } }
  }
  nloc = mine > 0u ? mine : 1u; nx = cnt > 0u ? cnt : 1u;
}
__device__ __forceinline__ void xcd_barrier(unsigned* bar, volatile unsigned* st) {
  asm volatile("s_waitcnt vmcnt(0)" ::: "memory");
  __syncthreads();
  if (threadIdx.x == 0) {
    __builtin_amdgcn_s_waitcnt(0);
    const unsigned x = xb_xcc_id();
    unsigned nloc = st[0], nx = st[1];
    if (nloc == 0u) { xcd_barrier_complete(bar, x, nloc, nx); st[0] = nloc; st[1] = nx; }
    const unsigned old = xb_add(&bar[XB_XSUB(x)], 1u);
    const unsigned gen = old / nloc;
    if (old + 1u == (gen + 1u) * nloc) {
      __builtin_amdgcn_fence(__ATOMIC_RELEASE, "agent");
      asm volatile("s_waitcnt vmcnt(0)" ::: "memory");
      const unsigned og = xb_add(&bar[XB_TOP], 1u);
      const unsigned tg = og / nx;
      if (og + 1u == (tg + 1u) * nx) xb_add(&bar[XB_TOPGEN], 1u);
      else XB_SPIN(xb_ld(&bar[XB_TOPGEN]) == tg, bar);
      __builtin_amdgcn_fence(__ATOMIC_ACQUIRE, "agent");
      xb_add(&bar[XB_XGEN(x)], 1u);
      asm volatile("s_waitcnt vmcnt(0)" ::: "memory");
    } else {
      XB_SPIN(xb_ld(&bar[XB_XGEN(x)]) == gen, bar);
      __builtin_amdgcn_fence(__ATOMIC_ACQUIRE, "agent");
      asm volatile("s_waitcnt vmcnt(0)" ::: "memory");
    }
  }
  __syncthreads();
}

constexpr int SMEM_BYTES = 40960;
__device__ __forceinline__ void run_phase(const Params& p, int ph, char* smem) {
  if (ph == 0) { phase_embed(p); return; }
  if (ph == 19) { phase_final(p); return; }
  int l = (ph - 1) / 9, s = (ph - 1) % 9;
  float* fs = (float*)smem;
  switch (s) {
    case 0: phase_convert(p, l, fs); phase_rowstat<true>(p, l, fs); break;
    case 1: phase_gemm<1>(p, p.XB, DM, p.W1T, 1024, LDP / 128, smem); break;
    case 2: phase_pre(p, l, fs); break;
    case 3: phase_scan(p, l, fs); break;
    case 4: phase_post(p, l, fs); break;
    case 5: phase_gemm<2>(p, p.PROJ, LDP, p.WOT, 1536, 8, smem); break;
    case 6: phase_rowstat<false>(p, l, fs); break;
    case 7: phase_gemm<3>(p, p.XB, DM, p.WGU, 1024, 44, smem); break;
    case 8: phase_gemm<2>(p, p.PROJ, D_FF, p.WDT, D_FF, 8, smem); break;
  }
}
constexpr int N_PHASES = 20;

#if MEGA
__global__ void __launch_bounds__(256, 3) k_mega(Params p) {
  __shared__ __attribute__((aligned(16))) char smem[SMEM_BYTES];
  __shared__ uint4 xb_words;
  if (threadIdx.x == 0) { xb_words = make_uint4(0u, 0u, 0u, 0u); }
  __syncthreads();
  cg::grid_group grid = cg::this_grid();
  float* fs = (float*)smem;
  volatile unsigned* xst = (volatile unsigned*)&xb_words;
  xcd_barrier_post(p.bar);
  phase_embed(p);
  grid.sync();
#define GSYNC() do { unsigned* b_ = p.bar; asm volatile("" : "+s"(b_)); xcd_barrier(b_, xst); } while (0)
#pragma unroll 1
  for (int l0 = 0; l0 < 2; ++l0) {
    int l = opaque_s(l0);
    phase_convert(p, l, fs);
    phase_rowstat<true>(p, l, fs);
    GSYNC();
    l = opaque_s(l);
    phase_gemm<1>(p, p.XB, DM, p.W1T, 1024, LDP / 128, smem);
    GSYNC();
    l = opaque_s(l);
    phase_pre(p, l, fs);
    GSYNC();
    l = opaque_s(l);
    phase_scan(p, l, fs);
    GSYNC();
    l = opaque_s(l);
    phase_post(p, l, fs);
    GSYNC();
    l = opaque_s(l);
    phase_gemm<2>(p, p.PROJ, LDP, p.WOT, 1536, 8, smem);
    GSYNC();
    l = opaque_s(l);
    phase_rowstat<false>(p, l, fs);
    GSYNC();
    l = opaque_s(l);
    phase_gemm<3>(p, p.XB, DM, p.WGU, 1024, 44, smem);
    GSYNC();
    l = opaque_s(l);
    phase_gemm<2>(p, p.PROJ, D_FF, p.WDT, D_FF, 8, smem);
    GSYNC();
  }
  phase_final(p);
}
#else
template <int PH>
__global__ void __launch_bounds__(256, 3) k_phase(Params p) {
  __shared__ __attribute__((aligned(16))) char smem[SMEM_BYTES];
  run_phase(p, PH, smem);
}
template <int PH>
static void launch_all(const Params& p, int grid, hipStream_t stream) {
  hipLaunchKernelGGL(k_phase<PH>, dim3(grid), dim3(256), 0, stream, p);
  if constexpr (PH + 1 < N_PHASES) launch_all<PH + 1>(p, grid, stream);
}
#endif

extern "C" void kernel_launch(void* const* d_in, const int* in_sizes, int n_in, void* d_out, int out_size, void* d_ws,
                              size_t ws_size, hipStream_t stream) {
  Params p{};
  const float** pf = (const float**)&p;
  for (int i = 0; i < 35; ++i) pf[i] = (const float*)d_in[i];
  p.out = (float*)d_out;
  char* ws = (char*)d_ws;
  size_t off = 0;
  auto take = [&](size_t bytes) { char* r = ws + off; off += (bytes + 255) & ~(size_t)255; return r; };
  p.XB = (u16*)take((size_t)M_TOT * DM * 2);
  p.PROJ = (u16*)take((size_t)M_TOT * LDP * 2);
  p.W1T = (u16*)take((size_t)LDP * 1024 * 2);
  p.WOT = (u16*)take((size_t)1024 * 1536 * 2);
  p.WGU = (u16*)take((size_t)5632 * 1024 * 2);
  p.WDT = (u16*)take((size_t)1024 * D_FF * 2);
  p.BND = (u16*)take((size_t)NBLK16 * 1792 * 2);
  p.ORW = (u16*)take((size_t)M_TOT * 512 * 2);
  p.RS = (float*)take((size_t)M_TOT * 4);
  p.DTRAW = (float*)take((size_t)M_TOT * 8 * 4);
  p.RKS = (float*)take((size_t)M_TOT * 8 * 4);
  p.bar = (unsigned*)take((size_t)XCD_BAR_WORDS * 4);
  p.RWX = (u16*)d_out;
  if (off > ws_size) fprintf(stderr, "workspace too small: need %zu have %zu\n", off, ws_size);
#if MEGA
  static int grid_blocks = 0;
  if (!grid_blocks) {
    int dev = 0, cus = 0, per_cu = 0;
    hipGetDevice(&dev);
    hipDeviceGetAttribute(&cus, hipDeviceAttributeMultiprocessorCount, dev);
    hipOccupancyMaxActiveBlocksPerMultiprocessor(&per_cu, k_mega, 256, 0);
    if (per_cu > 3) per_cu = 3;
    grid_blocks = cus * per_cu;
  }
  hipMemsetAsync(p.bar, 0, (size_t)XCD_BAR_WORDS * 4, stream);
  void* args[] = {&p};
  hipError_t e = hipLaunchCooperativeKernel((void*)k_mega, dim3(grid_blocks), dim3(256), args, 0, stream);
  if (e != hipSuccess) fprintf(stderr, "cooperative launch failed: %s (grid %d)\n", hipGetErrorString(e), grid_blocks);
#else
  launch_all<0>(p, 768, stream);
#endif
}
```

```cpp
#include <hip/hip_runtime.h>
#include <hip/hip_bf16.h>
#include <hip/hip_cooperative_groups.h>
#include <cstdio>
namespace cg = cooperative_groups;

#ifndef MEGA
#define MEGA 1
#endif

typedef unsigned short u16;
using bf16x8 = __attribute__((ext_vector_type(8))) short;
using f32x16 = __attribute__((ext_vector_type(16))) float;

constexpr int DM = 1024;
constexpr int M_TOT = 33408;
constexpr int M_PROMPT = 32896;
constexpr int T_P = 4112;
constexpr int LDP = 5376;
constexpr int N_IN = 5384;
constexpr int D_FF = 2816;
constexpr int NBLK16 = M_TOT / 16;
constexpr int C_Z = 0, C_R = 512, C_GG = 1024, C_XBC = 1536, C_K = 2560, C_V = 3072, C_XW = 3584, C_XA = 3648,
              C_XG = 3712, C_Q = 3840, C_F = 4352, C_I = 4864;
constexpr long O_YP = 0, O_YS = 33554432, O_PSSM = 34078720, O_PCONV = 35127296, O_PRWKV = 35176448,
               O_PSHIFT = 35700736, O_PHGRN = 35729408, O_SSSM = 36777984, O_SCONV = 37826560,
               O_SRWKV = 37875712, O_SSHIFT = 38400000, O_SHGRN = 38428672;

struct Params {
  const float *x_prompt, *x_sample, *state_ssm, *state_conv, *state_rwkv, *state_shift, *state_hgrn, *meta,
      *norm1_w, *w_in, *conv_w, *conv_b, *dt_bias, *a_log, *d_skip, *ssd_norm_w, *rw_mu, *rw_w0, *rw_w2, *rw_a0,
      *rw_a2, *rw_g2, *rw_kk, *rw_ka, *rw_rk, *rw_lnx_w, *rw_lnx_b, *hg_lb, *hg_norm_w, *w_out, *norm2_w, *w_gate,
      *w_up, *w_down, *final_w;
  float* out;
  u16 *XB, *PROJ, *W1T, *WOT, *WGU, *WDT, *BND, *ORW, *RWX;
  float *RS, *DTRAW, *RKS;
  unsigned* bar;
};

__device__ __forceinline__ u16 f2bf(float f) {
  unsigned u = __float_as_uint(f);
  u += 0x7fffu + ((u >> 16) & 1u);
  return (u16)(u >> 16);
}
__device__ __forceinline__ float bf2f(u16 h) { return __uint_as_float(((unsigned)h) << 16); }
__device__ __forceinline__ float frcp_(float x) { return __builtin_amdgcn_rcpf(x); }
__device__ __forceinline__ float sigmoidf_(float x) { return frcp_(1.f + __expf(-x)); }
__device__ __forceinline__ float siluf_(float x) { return x * frcp_(1.f + __expf(-x)); }
__device__ __forceinline__ float softplusf_(float x) { return x > 20.f ? x : log1pf(__expf(x)); }

template <int CTRL>
__device__ __forceinline__ float dppf(float v) {
  return __int_as_float(__builtin_amdgcn_update_dpp(0, __float_as_int(v), CTRL, 0xF, 0xF, true));
}
__device__ __forceinline__ float sum16(float v) {
  v += dppf<0xB1>(v);
  v += dppf<0x4E>(v);
  v += dppf<0x141>(v);
  v += dppf<0x140>(v);
  return v;
}
__device__ __forceinline__ void sum16x2(float& a, float& b) {
  a += dppf<0xB1>(a); b += dppf<0xB1>(b);
  a += dppf<0x4E>(a); b += dppf<0x4E>(b);
  a += dppf<0x141>(a); b += dppf<0x141>(b);
  a += dppf<0x140>(a); b += dppf<0x140>(b);
}
__device__ __forceinline__ float sum64(float v) {
  v = sum16(v);
  v += __shfl_xor(v, 16);
  v += __shfl_xor(v, 32);
  return v;
}

#define NOPK(x) asm("" : "+v"(x))
__device__ __forceinline__ int opaque_tid() {
  int t = threadIdx.x;
  asm volatile("" : "+v"(t));
  return t;
}
__device__ __forceinline__ int opaque_s(int v) {
  asm volatile("" : "+s"(v));
  return v;
}
#define BID opaque_s((int)blockIdx.x)
#define NBLK opaque_s((int)gridDim.x)
__device__ __forceinline__ int seq_base(int s) { return s < 8 ? s * T_P : M_PROMPT + (s - 8) * 64; }
__device__ __forceinline__ int seq_len(int s) { return s < 8 ? T_P : 64; }

__device__ __forceinline__ void phase_embed(const Params& p) {
  const long n4 = (long)M_TOT * 256;
  for (long idx = (long)BID * 256 + threadIdx.x, st_ = (long)NBLK * 256; idx < n4; idx += st_) {
    int m = (int)(idx >> 8), c4 = ((int)idx & 255) * 4;
    const float* src;
    if (m < M_PROMPT) {
      int b = m / T_P, t = m - b * T_P;
      src = (t < 16) ? p.meta + (long)t * DM : p.x_prompt + ((long)b * 4096 + (t - 16)) * DM;
    } else {
      src = p.x_sample + (long)(m - M_PROMPT) * DM;
    }
    float4 v = *(const float4*)(src + c4);
    ushort4 o;
    o.x = f2bf(v.x); o.y = f2bf(v.y); o.z = f2bf(v.z); o.w = f2bf(v.w);
    *(ushort4*)(p.XB + (long)m * DM + c4) = o;
  }
}

template <bool HAS_SCALE>
__device__ __forceinline__ void conv_tile(const float* __restrict__ src, int ldsrc, int srccol0, const float* __restrict__ scale,
                          u16* __restrict__ dst, int K, int k0, int n0, float* tile  ) {
  const int tid = opaque_tid();
  __syncthreads();
  {
    int nn = tid & 63, kb = tid >> 6;
#pragma unroll
    for (int i = 0; i < 16; ++i) {
      int kk = kb + 4 * i;
      float v = src[(long)(k0 + kk) * ldsrc + srccol0 + nn];
      if (HAS_SCALE) v *= scale[k0 + kk];
      tile[kk * 65 + nn] = v;
    }
  }
  __syncthreads();
  {
    int nn = tid >> 2, kq = (tid & 3) * 16;
    u16* d = dst + (long)(n0 + nn) * K + k0 + kq;
#pragma unroll
    for (int j = 0; j < 16; j += 2) {
      unsigned w = f2bf(tile[(kq + j) * 65 + nn]) | ((unsigned)f2bf(tile[(kq + j + 1) * 65 + nn]) << 16);
      *(unsigned*)(d + j) = w;
    }
  }
}

__device__ __forceinline__ int w1_srccol(int n0) {
  if (n0 < 512) return n0;
  if (n0 < 1024) return n0 - 512 + 1544;
  if (n0 < 1536) return n0 - 1024 + 4872;
  if (n0 < 2560) return n0 - 1536 + 512;
  if (n0 < 3840) return n0 - 2560 + 2056;
  return n0 - 3840 + 3336;
}

constexpr int CV_W1 = 16 * 84, CV_WO = 24 * 16, CV_WGU = 16 * 88, CV_WD = 44 * 16;
constexpr int CV_TOTAL = CV_W1 + CV_WO + CV_WGU + CV_WD;

__device__ __forceinline__ void phase_convert(const Params& p, int l, float* smem) {
  for (int u = BID, nb_ = NBLK; u < CV_TOTAL; u += nb_) {
    if (u < CV_W1) {
      int kt = u % 16, nt = u / 16;
      conv_tile<true>(p.w_in + (long)l * DM * N_IN, N_IN, w1_srccol(nt * 64), p.norm1_w + l * DM, p.W1T, 1024, kt * 64,
                nt * 64, smem);
    } else if (u < CV_W1 + CV_WO) {
      int v = u - CV_W1;
      int kt = v % 24, nt = v / 24;
      conv_tile<false>(p.w_out + (long)l * 1536 * DM, DM, nt * 64, nullptr, p.WOT, 1536, kt * 64, nt * 64, smem);
    } else if (u < CV_W1 + CV_WO + CV_WGU) {
      int v = u - CV_W1 - CV_WO;
      int kt = v % 16, nt = v / 16;
      const float* wg = p.w_gate + (long)l * DM * D_FF;
      const float* wu = p.w_up + (long)l * DM * D_FF;
      const float* sc = p.norm2_w + l * DM;
      const int tid = opaque_tid();
      __syncthreads();
      {
        int nn = tid & 63, kb = tid >> 6;
        const float* src = (nn < 32) ? wg : wu;
        int col = nt * 32 + (nn & 31);
#pragma unroll
        for (int i = 0; i < 16; ++i) {
          int kk = kb + 4 * i;
          smem[kk * 65 + nn] = src[(long)(kt * 64 + kk) * D_FF + col] * sc[kt * 64 + kk];
        }
      }
      __syncthreads();
      {
        int nn = tid >> 2, kq = (tid & 3) * 16;
        u16* d = p.WGU + (long)(nt * 64 + nn) * 1024 + kt * 64 + kq;
#pragma unroll
        for (int j = 0; j < 16; j += 2) {
          unsigned w = f2bf(smem[(kq + j) * 65 + nn]) | ((unsigned)f2bf(smem[(kq + j + 1) * 65 + nn]) << 16);
          *(unsigned*)(d + j) = w;
        }
      }
    } else {
      int v = u - CV_W1 - CV_WO - CV_WGU;
      int kt = v % 44, nt = v / 44;
      conv_tile<false>(p.w_down + (long)l * D_FF * DM, DM, nt * 64, nullptr, p.WDT, D_FF, kt * 64, nt * 64, smem);
    }
  }
}

template <bool WITH_DT>
__device__ __forceinline__ void phase_rowstat(const Params& p, int l, float* smem) {
  const int tid = opaque_tid(), lane = tid & 63, wid = tid >> 6;
  float* dtw = smem;
  if (WITH_DT) {
    __syncthreads();
    const float* w = p.w_in + (long)l * DM * N_IN + 1536;
    const float* nw = p.norm1_w + l * DM;
    for (int i = tid; i < 8192; i += 256) {
      int k = i >> 3, h = i & 7;
      dtw[i] = w[(long)k * N_IN + h] * nw[k];
    }
    __syncthreads();
  }
  for (int blk = BID, nb_ = NBLK; blk < NBLK16; blk += nb_) {
    for (int rr = wid; rr < 16; rr += 4) {
      int m = blk * 16 + rr;
      float ss = 0.f;
      float d[8];
#pragma unroll
      for (int h = 0; h < 8; ++h) d[h] = 0.f;
#pragma unroll 1
      for (int j = 0; j < 4; ++j) {
        int k0 = lane * 4 + 256 * j;
        uint2 raw = *(const uint2*)(p.XB + (long)m * DM + k0);
        float xs[4] = {bf2f((u16)(raw.x & 0xffff)), bf2f((u16)(raw.x >> 16)), bf2f((u16)(raw.y & 0xffff)),
                       bf2f((u16)(raw.y >> 16))};
#pragma unroll
        for (int e = 0; e < 4; ++e) {
          float x = xs[e];
          ss += x * x;
          if (WITH_DT) {
            float4 w0 = *(const float4*)(dtw + (k0 + e) * 8);
            float4 w1 = *(const float4*)(dtw + (k0 + e) * 8 + 4);
            d[0] += x * w0.x; d[1] += x * w0.y; d[2] += x * w0.z; d[3] += x * w0.w;
            d[4] += x * w1.x; d[5] += x * w1.y; d[6] += x * w1.z; d[7] += x * w1.w;
          }
        }
      }
      ss = sum64(ss);
      float rs = rsqrtf(ss * (1.f / 1024.f) + 1e-6f);
      if (WITH_DT) {
#pragma unroll
        for (int h = 0; h < 8; ++h) d[h] = sum64(d[h]);
        if (lane == 0) {
#pragma unroll
          for (int h = 0; h < 8; ++h) p.DTRAW[(long)m * 8 + h] = d[h] * rs;
        }
      }
      if (lane == 0) p.RS[m] = rs;
    }
  }
}

constexpr int G_BK = 32, G_LDS_ROW = 80;
constexpr int G_OPER_BYTES = 128 * G_LDS_ROW;
template <int MODE>
__device__ __forceinline__ void phase_gemm(const Params& p, const u16* __restrict__ A, int lda, const u16* __restrict__ Bt, int K,
                           int nN, char* smem) {
  const int tid = opaque_tid(), lane = tid & 63, wid = tid >> 6, wm = wid >> 1, wn = wid & 1;
  const int nM = M_TOT / 128;
  const int ntiles = nM * nN;
  const int nk = K / G_BK;
  const int lrow = tid >> 2, lkc = tid & 3;
  for (int tile = BID, nb_ = NBLK; tile < ntiles; tile += nb_) {
    constexpr int GM = 64;
    int grp = tile / (GM * nN);
    int first_m = grp * GM;
    int gsz = min(GM, nM - first_m);
    int rem = tile - grp * GM * nN;
    int pm = first_m + rem % gsz, pn = rem / gsz;
    const u16* gA = A + (long)(pm * 128 + lrow) * lda + lkc * 8;
    const u16* gB = Bt + (long)(pn * 128 + lrow) * K + lkc * 8;
    f32x16 acc[2][2];
#pragma unroll
    for (int i = 0; i < 2; ++i)
#pragma unroll
      for (int j = 0; j < 2; ++j)
#pragma unroll
        for (int r = 0; r < 16; ++r) acc[i][j][r] = 0.f;
    uint4 xa0, xa1, xb0, xb1, ya0, ya1, yb0, yb1;
#define G_LOAD(S, KT)                                                  \
  {                                                                    \
    S##a0 = *(const uint4*)(gA + (KT) * G_BK);                         \
    S##a1 = *(const uint4*)(gA + (long)64 * lda + (KT) * G_BK);        \
    S##b0 = *(const uint4*)(gB + (KT) * G_BK);                         \
    S##b1 = *(const uint4*)(gB + (long)64 * K + (KT) * G_BK);          \
  }
#define G_STORE(S, BUF)                                                \
  {                                                                    \
    char* dA = smem + (BUF) * 2 * G_OPER_BYTES;                        \
    char* dB = dA + G_OPER_BYTES;                                      \
    *(uint4*)(dA + lrow * G_LDS_ROW + lkc * 16) = S##a0;               \
    *(uint4*)(dA + (lrow + 64) * G_LDS_ROW + lkc * 16) = S##a1;        \
    *(uint4*)(dB + lrow * G_LDS_ROW + lkc * 16) = S##b0;               \
    *(uint4*)(dB + (lrow + 64) * G_LDS_ROW + lkc * 16) = S##b1;        \
  }
#define G_COMPUTE(BUF)                                                                           \
  {                                                                                              \
    const char* sA = smem + (BUF) * 2 * G_OPER_BYTES;                                            \
    const char* sB = sA + G_OPER_BYTES;                                                          \
    _Pragma("unroll") for (int ks = 0; ks < 2; ++ks) {                                           \
      bf16x8 af[2], bfr[2];                                                                      \
      const int koff = (ks * 16 + (lane >> 5) * 8) * 2;                                          \
      _Pragma("unroll") for (int i = 0; i < 2; ++i)                                              \
        af[i] = *(const bf16x8*)(sA + (wm * 64 + i * 32 + (lane & 31)) * G_LDS_ROW + koff);      \
      _Pragma("unroll") for (int j = 0; j < 2; ++j)                                              \
        bfr[j] = *(const bf16x8*)(sB + (wn * 64 + j * 32 + (lane & 31)) * G_LDS_ROW + koff);     \
      _Pragma("unroll") for (int i = 0; i < 2; ++i)                                              \
        _Pragma("unroll") for (int j = 0; j < 2; ++j)                                            \
          acc[i][j] = __builtin_amdgcn_mfma_f32_32x32x16_bf16(af[i], bfr[j], acc[i][j], 0, 0, 0); \
    }                                                                                            \
  }
    G_LOAD(x, 0);
    G_LOAD(y, 1);
    __builtin_amdgcn_sched_barrier(0);
    __syncthreads();
    G_STORE(x, 0);
    __syncthreads();
    for (int kt = 0; kt < nk; kt += 2) {
      if (kt + 2 < nk) G_LOAD(x, kt + 2);
      __builtin_amdgcn_sched_barrier(0);
      G_COMPUTE(0);
      __builtin_amdgcn_sched_barrier(0);
      G_STORE(y, 1);
      __syncthreads();
      if (kt + 3 < nk) G_LOAD(y, kt + 3);
      __builtin_amdgcn_sched_barrier(0);
      G_COMPUTE(1);
      __builtin_amdgcn_sched_barrier(0);
      if (kt + 2 < nk) G_STORE(x, 0);
      __syncthreads();
    }
#undef G_LOAD
#undef G_STORE
#undef G_COMPUTE
    const int colb = pn * 128 + wn * 64 + (lane & 31);
    const int rowb = pm * 128 + wm * 64 + 4 * (lane >> 5);
    if (MODE == 1) {
#pragma unroll
      for (int i = 0; i < 2; ++i)
#pragma unroll
        for (int r = 0; r < 16; ++r) {
          int row = rowb + i * 32 + (r & 3) + 8 * (r >> 2);
          float rs = p.RS[row];
#pragma unroll
          for (int j = 0; j < 2; ++j) {
            int col = colb + j * 32;
            u16 v = f2bf(acc[i][j][r] * rs);
            p.PROJ[(long)row * LDP + col] = v;
            if ((row & 15) == 15) {
              int jj = -1;
              if (col >= C_R && col < C_GG) jj = col - C_R;
              else if (col >= C_K && col < C_Q) jj = col - C_K + 512;
              if (jj >= 0) p.BND[(long)(row >> 4) * 1792 + jj] = v;
            }
          }
        }
    } else if (MODE == 2) {
#pragma unroll
      for (int i = 0; i < 2; ++i)
#pragma unroll
        for (int r = 0; r < 16; ++r) {
          int row = rowb + i * 32 + (r & 3) + 8 * (r >> 2);
#pragma unroll
          for (int j = 0; j < 2; ++j) {
            int col = colb + j * 32;
            u16* px = p.XB + (long)row * DM + col;
            *px = f2bf(bf2f(*px) + acc[i][j][r]);
          }
        }
    } else {
      const int cact = pn * 64 + wn * 32 + (lane & 31);
      u16* ACT = p.PROJ;
#pragma unroll
      for (int i = 0; i < 2; ++i)
#pragma unroll
        for (int r = 0; r < 16; ++r) {
          int row = rowb + i * 32 + (r & 3) + 8 * (r >> 2);
          float rs = p.RS[row];
          float g = acc[i][0][r] * rs, u = acc[i][1][r] * rs;
          ACT[(long)row * D_FF + cact] = f2bf(siluf_(g) * u);
        }
    }
  }
}

__device__ __forceinline__ void phase_pre(const Params& p, int l, float* smem) {
  const int tid = opaque_tid(), lane = tid & 63, wid = tid >> 6;
  float* XW = smem;
  float* XA = smem + 1024;
  const float* mu = p.rw_mu + l * 1792;
  for (int blk = BID, nb_ = NBLK; blk < NBLK16; blk += nb_) {
    const int m0 = blk * 16;
    int s, t0;
    if (m0 < M_PROMPT) { s = m0 / T_P; t0 = m0 - s * T_P; } else { s = 8 + (m0 - M_PROMPT) / 64; t0 = (m0 - M_PROMPT) & 63; }
    const bool first = (t0 == 0);
    auto prev_of = [&](int j) -> float {
      if (!first) return bf2f(p.BND[(long)(blk - 1) * 1792 + j]);
      if (s < 8) return 0.f;
      return p.state_shift[((long)l * 8 + (s - 8)) * 1792 + j];
    };
    __syncthreads();
    {
      int j = 1536 + tid;
      float mj = mu[j];
      float pv = prev_of(j);
      u16* col = p.PROJ + (long)m0 * LDP + C_XW + tid;
#pragma unroll
      for (int t = 0; t < 16; ++t) {
        float x = bf2f(col[(long)t * LDP]);
        float sh = x + (pv - x) * mj;
        pv = x;
        if (tid < 64) XW[tid * 16 + t] = tanhf(sh);
        else if (tid < 128) XA[(tid - 64) * 16 + t] = sh;
        else col[(long)t * LDP] = f2bf(sigmoidf_(sh));
      }
    }
    __syncthreads();
#pragma unroll 1
    for (int c = 0; c < 2; ++c) {
      const int ch = tid + 256 * c;
      const int head = wid + 4 * c;
      float aw[16], aa[16];
#pragma unroll
      for (int t = 0; t < 16; ++t) { aw[t] = 0.f; aa[t] = 0.f; }
      {
        const float* w2 = p.rw_w2 + (long)l * 64 * 512 + ch;
        const float* a2 = p.rw_a2 + (long)l * 64 * 512 + ch;
#pragma unroll 2
        for (int i = 0; i < 64; ++i) {
          float w2v = w2[i * 512];
          float a2v = a2[i * 512];
#pragma unroll
          for (int q = 0; q < 4; ++q) {
            float4 xw = *(const float4*)(XW + i * 16 + q * 4);
            float4 xa = *(const float4*)(XA + i * 16 + q * 4);
            aw[q * 4 + 0] += xw.x * w2v; aw[q * 4 + 1] += xw.y * w2v;
            aw[q * 4 + 2] += xw.z * w2v; aw[q * 4 + 3] += xw.w * w2v;
            aa[q * 4 + 0] += xa.x * a2v; aa[q * 4 + 1] += xa.y * a2v;
            aa[q * 4 + 2] += xa.z * a2v; aa[q * 4 + 3] += xa.w * a2v;
          }
        }
      }
      {
        float w0 = p.rw_w0[l * 512 + ch], a0 = p.rw_a0[l * 512 + ch];
#pragma unroll
        for (int t = 0; t < 16; ++t) {
          float lw = -softplusf_(-(w0 + aw[t])) - 0.5f;
          float u = -__expf(lw);
          p.RWX[(long)(m0 + t) * 1536 + ch] = f2bf(u);
          aa[t] = sigmoidf_(a0 + aa[t]);
        }
      }
      float rt[16];
      {
        float mj = mu[ch];
        float pv = prev_of(ch);
        u16* col = p.PROJ + (long)m0 * LDP + C_R + ch;
#pragma unroll
        for (int t = 0; t < 16; ++t) {
          float x = bf2f(col[(long)t * LDP]);
          rt[t] = x + (pv - x) * mj;
          pv = x;
        }
#pragma unroll
        for (int t = 0; t < 16; ++t) col[(long)t * LDP] = f2bf(rt[t]);
      }
      {
        float mj = mu[512 + ch];
        float pv = prev_of(512 + ch);
        float kkw = p.rw_kk[l * 512 + ch], kaw = p.rw_ka[l * 512 + ch], rkw = p.rw_rk[l * 512 + ch];
        u16* col = p.PROJ + (long)m0 * LDP + C_K + ch;
        float kt[16];
#pragma unroll
        for (int t = 0; t < 16; ++t) {
          float x = bf2f(col[(long)t * LDP]);
          kt[t] = x + (pv - x) * mj;
          pv = x;
        }
#pragma unroll
        for (int t = 0; t < 16; ++t) {
          float kkv = kt[t] * kkw;
          float ssq = sum64(kkv * kkv);
          float kk = kkv * rsqrtf(ssq + 1e-12f);
          float a = aa[t];
          float kp = kt[t] * (1.f + (a - 1.f) * kaw);
          float rks = sum64(rt[t] * kp * rkw);
          col[(long)t * LDP] = f2bf(kp);
          p.RWX[(long)(m0 + t) * 1536 + 512 + ch] = f2bf(kk);
          p.RWX[(long)(m0 + t) * 1536 + 1024 + ch] = f2bf(kk * a);
          if (lane == 0) p.RKS[(long)(m0 + t) * 8 + head] = rks;
        }
      }
      {
        float mj = mu[1024 + ch];
        float pv = prev_of(1024 + ch);
        u16* col = p.PROJ + (long)m0 * LDP + C_V + ch;
        float vt[16];
#pragma unroll
        for (int t = 0; t < 16; ++t) {
          float x = bf2f(col[(long)t * LDP]);
          vt[t] = x + (pv - x) * mj;
          pv = x;
        }
#pragma unroll
        for (int t = 0; t < 16; ++t) col[(long)t * LDP] = f2bf(vt[t]);
      }
    }
    if (t0 + 16 == seq_len(s)) {
      float* o = p.out + (s < 8 ? O_PSHIFT + ((long)l * 8 + s) * 1792 : O_SSHIFT + ((long)l * 8 + (s - 8)) * 1792);
      for (int j = tid; j < 1792; j += 256) o[j] = bf2f(p.BND[(long)blk * 1792 + j]);
    }
  }
}

__device__ __forceinline__ void scan_rwkv(const Params& p, int l, int s, int h, int q, float* smem) {
  const int tid = opaque_tid(), lane = tid & 63, wid = tid >> 6;
  float* R_ = smem;
  float* W_ = smem + 1024;
  float* K_ = smem + 2048;
  float* A_ = smem + 3072;
  float* B_ = smem + 4096;
  float* V_ = smem + 5120;
  float* O_ = smem + 5376;
  const int rl = wid * 4 + (lane >> 4);
  const int row = q * 16 + rl;
  const int ksl = (lane & 15) * 4;
  const int base = seq_base(s), T = seq_len(s);
  float s0 = 0.f, s1 = 0.f, s2 = 0.f, s3 = 0.f;
  if (s >= 8) {
    const float* st = p.state_rwkv + (((long)l * 8 + (s - 8)) * 8 + h) * 4096 + row * 64 + ksl;
    float4 v = *(const float4*)st;
    s0 = v.x; s1 = v.y; s2 = v.z; s3 = v.w;
  }
  const int stt = tid >> 4, skq = (tid & 15) * 4;
  const int nblk = T / 16;
  ushort4 r4, k4, u4, a4, b4;
  u16 vv;
  {
    const long m = base + stt;
    const u16* pr = p.PROJ + m * LDP;
    const u16* px = p.RWX + m * 1536;
    r4 = *(const ushort4*)(pr + C_R + h * 64 + skq);
    k4 = *(const ushort4*)(pr + C_K + h * 64 + skq);
    u4 = *(const ushort4*)(px + h * 64 + skq);
    a4 = *(const ushort4*)(px + 512 + h * 64 + skq);
    b4 = *(const ushort4*)(px + 1024 + h * 64 + skq);
    vv = pr[C_V + h * 64 + q * 16 + (tid & 15)];
  }
  __syncthreads();
  float* TR_ = smem + 5376 + 512;
  const bool wr = (lane & 15) == 0;
  const int ooff = wr ? rl : (512 + lane);
  const int ostr = wr ? 16 : 0;
  for (int blk = 0; blk < nblk; ++blk) {
    const long m = base + blk * 16 + stt;
    float* Oc = O_ + (blk & 1) * 256;
    {
      *(float4*)(R_ + stt * 64 + skq) = make_float4(bf2f(r4.x), bf2f(r4.y), bf2f(r4.z), bf2f(r4.w));
      *(float4*)(K_ + stt * 64 + skq) = make_float4(bf2f(k4.x), bf2f(k4.y), bf2f(k4.z), bf2f(k4.w));
      *(float4*)(W_ + stt * 64 + skq) =
          make_float4(__expf(bf2f(u4.x)), __expf(bf2f(u4.y)), __expf(bf2f(u4.z)), __expf(bf2f(u4.w)));
      *(float4*)(A_ + stt * 64 + skq) = make_float4(-bf2f(a4.x), -bf2f(a4.y), -bf2f(a4.z), -bf2f(a4.w));
      *(float4*)(B_ + stt * 64 + skq) = make_float4(bf2f(b4.x), bf2f(b4.y), bf2f(b4.z), bf2f(b4.w));
      V_[stt * 16 + (tid & 15)] = bf2f(vv);
    }
    __syncthreads();
    if (blk > 0)
      p.ORW[(m - 16) * 512 + h * 64 + q * 16 + (tid & 15)] = f2bf(O_[((blk - 1) & 1) * 256 + stt * 16 + (tid & 15)]);
    if (blk + 1 < nblk) {
      const u16* pr = p.PROJ + (m + 16) * LDP;
      const u16* px = p.RWX + (m + 16) * 1536;
      r4 = *(const ushort4*)(pr + C_R + h * 64 + skq);
      k4 = *(const ushort4*)(pr + C_K + h * 64 + skq);
      u4 = *(const ushort4*)(px + h * 64 + skq);
      a4 = *(const ushort4*)(px + 512 + h * 64 + skq);
      b4 = *(const ushort4*)(px + 1024 + h * 64 + skq);
      vv = pr[C_V + h * 64 + q * 16 + (tid & 15)];
    }
    __builtin_amdgcn_sched_barrier(0);
    {
      float4 a = *(const float4*)(A_ + ksl), w = *(const float4*)(W_ + ksl), b = *(const float4*)(B_ + ksl);
      float4 k = *(const float4*)(K_ + ksl), r = *(const float4*)(R_ + ksl);
      float v = V_[rl];
      float opart = 0.f;
#pragma unroll
      for (int tt = 0; tt < 16; ++tt) {
        float4 an, wn, bn, kn, rn;
        float vn;
        if (tt + 1 < 16) {
          an = *(const float4*)(A_ + (tt + 1) * 64 + ksl); wn = *(const float4*)(W_ + (tt + 1) * 64 + ksl);
          bn = *(const float4*)(B_ + (tt + 1) * 64 + ksl); kn = *(const float4*)(K_ + (tt + 1) * 64 + ksl);
          rn = *(const float4*)(R_ + (tt + 1) * 64 + ksl); vn = V_[(tt + 1) * 16 + rl];
        }
        __builtin_amdgcn_sched_barrier(0);
        float sa = fmaf(s0, a.x, fmaf(s1, a.y, fmaf(s2, a.z, s3 * a.w)));
        if (tt > 0) { sum16x2(sa, opart); Oc[ooff + (tt - 1) * ostr] = opart; }
        else sa = sum16(sa);
        s0 = fmaf(s0, w.x, fmaf(sa, b.x, v * k.x)); NOPK(s0);
        s1 = fmaf(s1, w.y, fmaf(sa, b.y, v * k.y)); NOPK(s1);
        s2 = fmaf(s2, w.z, fmaf(sa, b.z, v * k.z)); NOPK(s2);
        s3 = fmaf(s3, w.w, fmaf(sa, b.w, v * k.w)); NOPK(s3);
        opart = fmaf(s0, r.x, fmaf(s1, r.y, fmaf(s2, r.z, s3 * r.w)));
        if (tt == 15) { opart = sum16(opart); Oc[ooff + 15 * ostr] = opart; }
        __builtin_amdgcn_sched_barrier(0);
        if (tt + 1 < 16) { a = an; w = wn; b = bn; k = kn; r = rn; v = vn; }
      }
    }
    __builtin_amdgcn_sched_barrier(0);
    __syncthreads();
  }
  {
    const long m = base + (nblk - 1) * 16 + stt;
    p.ORW[m * 512 + h * 64 + q * 16 + (tid & 15)] = f2bf(O_[((nblk - 1) & 1) * 256 + stt * 16 + (tid & 15)]);
  }
  __syncthreads();
  {
    float* o = p.out + (s < 8 ? O_PRWKV + (((long)l * 8 + s) * 8 + h) * 4096
                              : O_SRWKV + (((long)l * 8 + (s - 8)) * 8 + h) * 4096);
    *(float4*)(o + row * 64 + ksl) = make_float4(s0, s1, s2, s3);
  }
}

__device__ __forceinline__ void scan_hgrn(const Params& p, int l, int s, int h, int q, float* smem) {
  const int tid = opaque_tid(), lane = tid & 63, wid = tid >> 6;
  float* Q_ = smem;
  float* F_ = smem + 2048;
  float* G_ = smem + 4096;
  float* I_ = smem + 6144;
  float* O_ = smem + 6400;
  const int rl = wid * 4 + (lane >> 4);
  const int row = q * 16 + rl;
  const int ksl4 = (lane & 15) * 4;
  const int base = seq_base(s), T = seq_len(s);
  float st[8];
#pragma unroll
  for (int i = 0; i < 8; ++i) st[i] = 0.f;
  if (s >= 8) {
    const float* sp = p.state_hgrn + (((long)l * 8 + (s - 8)) * 4 + h) * 16384;
#pragma unroll
    for (int i = 0; i < 8; ++i) st[i] = sp[((i >> 2) * 64 + ksl4 + (i & 3)) * 128 + row];
  }
  const int stt = tid >> 4, skq = (tid & 15) * 8;
  float lb[8];
#pragma unroll
  for (int i = 0; i < 8; ++i) {
    if (l == 0) lb[i] = 0.f;
    else {
      float x0 = p.hg_lb[h * 128 + skq + i], x1 = p.hg_lb[512 + h * 128 + skq + i];
      lb[i] = frcp_(1.f + __expf(x0 - x1));
    }
  }
  const int nblk = T / 16;
  uint4 q8, f8;
  u16 iv16;
  {
    const u16* pr = p.PROJ + (long)(base + stt) * LDP;
    q8 = *(const uint4*)(pr + C_Q + h * 128 + skq);
    f8 = *(const uint4*)(pr + C_F + h * 128 + skq);
    iv16 = pr[C_I + h * 128 + q * 16 + (tid & 15)];
  }
  __syncthreads();
  float* TR_ = smem + 6400 + 512;
  const bool wr = (lane & 15) == 0;
  const int ooff = wr ? rl : (512 + lane);
  const int ostr = wr ? 16 : 0;
  for (int blk = 0; blk < nblk; ++blk) {
    const long m = base + blk * 16 + stt;
    float* Oc = O_ + (blk & 1) * 256;
    {
      unsigned qw[4] = {q8.x, q8.y, q8.z, q8.w}, fw[4] = {f8.x, f8.y, f8.z, f8.w};
      float qv[8], fv[8], gv[8];
#pragma unroll
      for (int e = 0; e < 8; ++e) {
        qv[e] = bf2f((u16)((qw[e >> 1] >> ((e & 1) * 16)) & 0xffff));
        float fz = bf2f((u16)((fw[e >> 1] >> ((e & 1) * 16)) & 0xffff));
        float ex = __expf(-fz);
        float sg = frcp_(1.f + ex);
        float sgn = ex * sg;
        fv[e] = lb[e] + (1.f - lb[e]) * sg;
        gv[e] = (1.f - lb[e]) * sgn;
      }
      *(float4*)(Q_ + stt * 128 + skq) = make_float4(qv[0], qv[1], qv[2], qv[3]);
      *(float4*)(Q_ + stt * 128 + skq + 4) = make_float4(qv[4], qv[5], qv[6], qv[7]);
      *(float4*)(F_ + stt * 128 + skq) = make_float4(fv[0], fv[1], fv[2], fv[3]);
      *(float4*)(F_ + stt * 128 + skq + 4) = make_float4(fv[4], fv[5], fv[6], fv[7]);
      *(float4*)(G_ + stt * 128 + skq) = make_float4(gv[0], gv[1], gv[2], gv[3]);
      *(float4*)(G_ + stt * 128 + skq + 4) = make_float4(gv[4], gv[5], gv[6], gv[7]);
      I_[stt * 16 + (tid & 15)] = bf2f(iv16);
    }
    __syncthreads();
    if (blk > 0) {
      u16* dp = p.PROJ + (m - 16) * LDP + C_I + h * 128 + q * 16 + (tid & 15);
      *dp = f2bf(O_[((blk - 1) & 1) * 256 + stt * 16 + (tid & 15)]);
    }
    if (blk + 1 < nblk) {
      const u16* pr = p.PROJ + (m + 16) * LDP;
      q8 = *(const uint4*)(pr + C_Q + h * 128 + skq);
      f8 = *(const uint4*)(pr + C_F + h * 128 + skq);
      iv16 = pr[C_I + h * 128 + q * 16 + (tid & 15)];
    }
    __builtin_amdgcn_sched_barrier(0);
    {
      float4 f0 = *(const float4*)(F_ + ksl4), f1 = *(const float4*)(F_ + 64 + ksl4);
      float4 g0 = *(const float4*)(G_ + ksl4), g1 = *(const float4*)(G_ + 64 + ksl4);
      float4 q0 = *(const float4*)(Q_ + ksl4), q1 = *(const float4*)(Q_ + 64 + ksl4);
      float iv = I_[rl];
      float oprev = 0.f;
#pragma unroll
      for (int tt = 0; tt < 16; ++tt) {
        float4 f0n, f1n, g0n, g1n, q0n, q1n;
        float ivn;
        if (tt + 1 < 16) {
          const int o_ = (tt + 1) * 128;
          f0n = *(const float4*)(F_ + o_ + ksl4); f1n = *(const float4*)(F_ + o_ + 64 + ksl4);
          g0n = *(const float4*)(G_ + o_ + ksl4); g1n = *(const float4*)(G_ + o_ + 64 + ksl4);
          q0n = *(const float4*)(Q_ + o_ + ksl4); q1n = *(const float4*)(Q_ + o_ + 64 + ksl4);
          ivn = I_[(tt + 1) * 16 + rl];
        }
        __builtin_amdgcn_sched_barrier(0);
        st[0] = fmaf(st[0], f0.x, g0.x * iv); NOPK(st[0]);
        st[1] = fmaf(st[1], f0.y, g0.y * iv); NOPK(st[1]);
        st[2] = fmaf(st[2], f0.z, g0.z * iv); NOPK(st[2]);
        st[3] = fmaf(st[3], f0.w, g0.w * iv); NOPK(st[3]);
        st[4] = fmaf(st[4], f1.x, g1.x * iv); NOPK(st[4]);
        st[5] = fmaf(st[5], f1.y, g1.y * iv); NOPK(st[5]);
        st[6] = fmaf(st[6], f1.z, g1.z * iv); NOPK(st[6]);
        st[7] = fmaf(st[7], f1.w, g1.w * iv); NOPK(st[7]);
        float acc0 = fmaf(st[0], q0.x, fmaf(st[1], q0.y, fmaf(st[2], q0.z, st[3] * q0.w)));
        float acc1 = fmaf(st[4], q1.x, fmaf(st[5], q1.y, fmaf(st[6], q1.z, st[7] * q1.w)));
        float o = acc0 + acc1;
        if (tt & 1) { sum16x2(oprev, o); Oc[ooff + (tt - 1) * ostr] = oprev; Oc[ooff + tt * ostr] = o; }
        else oprev = o;
        __builtin_amdgcn_sched_barrier(0);
        if (tt + 1 < 16) { f0 = f0n; f1 = f1n; g0 = g0n; g1 = g1n; q0 = q0n; q1 = q1n; iv = ivn; }
      }
    }
    __builtin_amdgcn_sched_barrier(0);
    __syncthreads();
  }
  {
    const long m = base + (nblk - 1) * 16 + stt;
    u16* dp = p.PROJ + m * LDP + C_I + h * 128 + q * 16 + (tid & 15);
    *dp = f2bf(O_[((nblk - 1) & 1) * 256 + stt * 16 + (tid & 15)]);
  }
  __syncthreads();
  {
    float* o = p.out + (s < 8 ? O_PHGRN + (((long)l * 8 + s) * 4 + h) * 16384
                              : O_SHGRN + (((long)l * 8 + (s - 8)) * 4 + h) * 16384);
#pragma unroll
    for (int i = 0; i < 8; ++i) o[((i >> 2) * 64 + ksl4 + (i & 3)) * 128 + row] = st[i];
  }
}

__device__ __forceinline__ void scan_ssd(const Params& p, int l, int s, int h, int q, float* smem) {
  const int tid = opaque_tid(), lane = tid & 63, wid = tid >> 6;
  float* B_ = smem;
  float* C_ = smem + 2048;
  float* X_ = smem + 4096;
  float* O_ = smem + 4352;
  float* DT_ = smem + 5200;
  float* DE_ = smem + 5216;
  const int rl = wid * 4 + (lane >> 4);
  const int row = q * 16 + rl;
  const int ksl4 = (lane & 15) * 4;
  const int g = h >> 2;
  const int base = seq_base(s), T = seq_len(s);
  float st[8];
#pragma unroll
  for (int i = 0; i < 8; ++i) st[i] = 0.f;
  if (s >= 8) {
    const float* sp = p.state_ssm + (((long)l * 8 + (s - 8)) * 8 + h) * 8192 + row * 128 + ksl4;
    float4 a = *(const float4*)sp, b = *(const float4*)(sp + 64);
    st[0] = a.x; st[1] = a.y; st[2] = a.z; st[3] = a.w; st[4] = b.x; st[5] = b.y; st[6] = b.z; st[7] = b.w;
  }
  const int xc_bc = (tid < 128) ? (512 + g * 128 + tid) : (768 + g * 128 + (tid - 128));
  const float* cw = p.conv_w + (long)l * 4 * 1024;
  const float cb0 = cw[xc_bc], cb1 = cw[1024 + xc_bc], cb2 = cw[2048 + xc_bc], cb3 = cw[3072 + xc_bc];
  const float cbb = p.conv_b[l * 1024 + xc_bc];
  float u3 = 0.f, u2 = 0.f, u1 = 0.f;
  const int xc_x = h * 64 + q * 16 + (tid & 15);
  const float cx0 = cw[xc_x], cx1 = cw[1024 + xc_x], cx2 = cw[2048 + xc_x], cx3 = cw[3072 + xc_x];
  const float cxb = p.conv_b[l * 1024 + xc_x];
  float x3 = 0.f, x2 = 0.f, x1 = 0.f;
  if (s >= 8) {
    const float* sc = p.state_conv + ((long)l * 8 + (s - 8)) * 3 * 1024;
    u3 = sc[xc_bc]; u2 = sc[1024 + xc_bc]; u1 = sc[2048 + xc_bc];
    x3 = sc[xc_x]; x2 = sc[1024 + xc_x]; x1 = sc[2048 + xc_x];
  }
  const float dtb = p.dt_bias[l * 8 + h];
  const float aexp = __expf(p.a_log[l * 8 + h]);
  const float dsk = p.d_skip[l * 8 + h];
  const int stt = tid >> 4;
  const int nblk = T / 16;
  u16 raw[16];
  float xr[4];
  float dtr = 0.f;
  u16 zc = 0, zn = 0;
#define SSD_LOAD(M0)                                                              \
  {                                                                               \
    const u16* col = p.PROJ + (long)(M0) * LDP + C_XBC + xc_bc;                   \
    _Pragma("unroll") for (int t = 0; t < 16; ++t) raw[t] = col[(long)t * LDP];   \
    {                                                                             \
      const long mr = (long)(M0) + stt;                                           \
      const u16* colx = p.PROJ + mr * LDP + C_XBC + xc_x;                         \
      _Pragma("unroll") for (int j = 0; j < 4; ++j) {                             \
        const long mm = mr - 3 + j;                                               \
        float vx;                                                                 \
        if (mm >= base) vx = bf2f(colx[(long)(j - 3) * LDP]);                     \
        else vx = (s >= 8) ? p.state_conv[((long)l * 8 + (s - 8)) * 3072 + (3 + (int)(mm - base)) * 1024 + xc_x] : 0.f; \
        xr[j] = vx;                                                               \
      }                                                                           \
    }                                                                             \
    if (tid < 16) dtr = p.DTRAW[((long)(M0) + tid) * 8 + h];                      \
    zn = p.PROJ[((long)(M0) + stt) * LDP + C_Z + h * 64 + q * 16 + (tid & 15)];   \
  }
#pragma unroll
  for (int t = 0; t < 16; ++t) raw[t] = 0;
  SSD_LOAD(base);
  __syncthreads();
  const bool wr = (lane & 15) == 0;
  const int ooff = wr ? rl : (512 + lane);
  const int ostr = wr ? 16 : 0;
  u16 zp = 0;
  for (int blk = 0; blk < nblk; ++blk) {
    const long m0 = base + blk * 16;
    zp = zc;
    zc = zn;
    float* Oc = O_ + (blk & 1) * 256;
    {
      float* dst = (tid < 128) ? (B_ + tid) : (C_ + (tid - 128));
#pragma unroll
      for (int t = 0; t < 16; ++t) {
        float u0 = bf2f(raw[t]);
        float y = cb0 * u3 + cb1 * u2 + cb2 * u1 + cb3 * u0 + cbb;
        dst[t * 128] = siluf_(y);
        u3 = u2; u2 = u1; u1 = u0;
      }
      {
        float y = cx0 * xr[0] + cx1 * xr[1] + cx2 * xr[2] + cx3 * xr[3] + cxb;
        X_[stt * 16 + (tid & 15)] = siluf_(y);
      }
      if (tid < 16) {
        float dtv = softplusf_(dtr + dtb);
        DT_[tid] = dtv;
        DE_[tid] = __expf(-aexp * dtv);
      }
    }
    __syncthreads();
    if (blk > 0) {
      u16* pz = p.PROJ + (m0 - 16 + stt) * LDP + C_Z + h * 64 + q * 16 + (tid & 15);
      *pz = f2bf(O_[((blk - 1) & 1) * 256 + stt * 16 + (tid & 15)] * siluf_(bf2f(zp)));
    }
    if (blk + 1 < nblk) SSD_LOAD(m0 + 16);
    __builtin_amdgcn_sched_barrier(0);
    {
      float4 b0 = *(const float4*)(B_ + ksl4), b1 = *(const float4*)(B_ + 64 + ksl4);
      float4 c0 = *(const float4*)(C_ + ksl4), c1 = *(const float4*)(C_ + 64 + ksl4);
      float xv = X_[rl], dt = DT_[0], de = DE_[0];
      float yprev = 0.f, xvprev = 0.f;
#pragma unroll
      for (int tt = 0; tt < 16; ++tt) {
        float4 b0n, b1n, c0n, c1n;
        float xvn, dtn, den;
        if (tt + 1 < 16) {
          const int o_ = (tt + 1) * 128;
          b0n = *(const float4*)(B_ + o_ + ksl4); b1n = *(const float4*)(B_ + o_ + 64 + ksl4);
          c0n = *(const float4*)(C_ + o_ + ksl4); c1n = *(const float4*)(C_ + o_ + 64 + ksl4);
          xvn = X_[(tt + 1) * 16 + rl]; dtn = DT_[tt + 1]; den = DE_[tt + 1];
        }
        __builtin_amdgcn_sched_barrier(0);
        const float xd = xv * dt;
        st[0] = fmaf(st[0], de, xd * b0.x); NOPK(st[0]);
        st[1] = fmaf(st[1], de, xd * b0.y); NOPK(st[1]);
        st[2] = fmaf(st[2], de, xd * b0.z); NOPK(st[2]);
        st[3] = fmaf(st[3], de, xd * b0.w); NOPK(st[3]);
        st[4] = fmaf(st[4], de, xd * b1.x); NOPK(st[4]);
        st[5] = fmaf(st[5], de, xd * b1.y); NOPK(st[5]);
        st[6] = fmaf(st[6], de, xd * b1.z); NOPK(st[6]);
        st[7] = fmaf(st[7], de, xd * b1.w); NOPK(st[7]);
        float acc0 = fmaf(st[0], c0.x, fmaf(st[1], c0.y, fmaf(st[2], c0.z, st[3] * c0.w)));
        float acc1 = fmaf(st[4], c1.x, fmaf(st[5], c1.y, fmaf(st[6], c1.z, st[7] * c1.w)));
        float y = acc0 + acc1;
        if (tt & 1) { sum16x2(yprev, y); Oc[ooff + (tt - 1) * ostr] = yprev + dsk * xvprev; Oc[ooff + tt * ostr] = y + dsk * xv; }
        else { yprev = y; xvprev = xv; }
        __builtin_amdgcn_sched_barrier(0);
        if (tt + 1 < 16) { b0 = b0n; b1 = b1n; c0 = c0n; c1 = c1n; xv = xvn; dt = dtn; de = den; }
      }
    }
    __builtin_amdgcn_sched_barrier(0);
    __syncthreads();
  }
  {
    const long m0 = base + (nblk - 1) * 16;
    u16* pz = p.PROJ + (m0 + stt) * LDP + C_Z + h * 64 + q * 16 + (tid & 15);
    *pz = f2bf(O_[((nblk - 1) & 1) * 256 + stt * 16 + (tid & 15)] * siluf_(bf2f(zc)));
  }
  __syncthreads();
#undef SSD_LOAD
  {
    float* o = p.out + (s < 8 ? O_PSSM + (((long)l * 8 + s) * 8 + h) * 8192
                              : O_SSSM + (((long)l * 8 + (s - 8)) * 8 + h) * 8192);
    *(float4*)(o + row * 128 + ksl4) = make_float4(st[0], st[1], st[2], st[3]);
    *(float4*)(o + row * 128 + 64 + ksl4) = make_float4(st[4], st[5], st[6], st[7]);
  }
  if (h == 0 && q == 0) {
    float* o = p.out + (s < 8 ? O_PCONV + ((long)l * 8 + s) * 3072 : O_SCONV + ((long)l * 8 + (s - 8)) * 3072);
    for (int i = tid; i < 3072; i += 256) {
      int r = i >> 10, c = i & 1023;
      o[i] = bf2f(p.PROJ[(long)(base + T - 3 + r) * LDP + C_XBC + c]);
    }
  }
}

__device__ __forceinline__ void phase_scan(const Params& p, int l, float* smem) {
  for (int u = BID, nb_ = NBLK; u < 1536; u += nb_) {
    int sample = u >= 768;
    int v = sample ? u - 768 : u;
    int type = v % 3, w = v / 3;
    if (type == 0) {
      int q = w & 3, h = (w >> 2) & 7, b = w >> 5;
      scan_rwkv(p, l, b + 8 * sample, h, q, smem);
    } else if (type == 1) {
      int q = w & 7, h = (w >> 3) & 3, b = w >> 5;
      scan_hgrn(p, l, b + 8 * sample, h, q, smem);
    } else {
      int q = w & 3, h = (w >> 2) & 7, b = w >> 5;
      scan_ssd(p, l, b + 8 * sample, h, q, smem);
    }
  }
}

__device__ __forceinline__ void phase_post(const Params& p, int l, float* smem) {
  const int tid = opaque_tid(), lane = tid & 63, wid = tid >> 6;
  float* SG = smem;
  float* RED = smem + 2048;
  for (int blk = BID, nb_ = NBLK; blk < NBLK16; blk += nb_) {
    const long m0 = (long)blk * 16;
    __syncthreads();
    if (tid < 128) {
      const u16* col = p.PROJ + m0 * LDP + C_XG + tid;
#pragma unroll
      for (int t = 0; t < 16; ++t) SG[tid * 16 + t] = bf2f(col[(long)t * LDP]);
    }
    float ys[2][16], oh[2][16];
#pragma unroll
    for (int c = 0; c < 2; ++c) {
      int ch = tid + 256 * c;
#pragma unroll
      for (int t = 0; t < 16; ++t) {
        ys[c][t] = bf2f(p.PROJ[(m0 + t) * LDP + C_Z + ch]);
        oh[c][t] = bf2f(p.PROJ[(m0 + t) * LDP + C_I + ch]);
      }
    }
#pragma unroll
    for (int t = 0; t < 16; ++t) {
      float a0 = sum64(ys[0][t] * ys[0][t]), a1 = sum64(ys[1][t] * ys[1][t]);
      float b0 = sum64(oh[0][t] * oh[0][t]), b1 = sum64(oh[1][t] * oh[1][t]);
      if (lane == 0) *(float4*)(RED + (wid * 16 + t) * 4) = make_float4(a0, a1, b0, b1);
    }
    __syncthreads();
    {
      const float nw0 = p.ssd_norm_w[l * 512 + tid], nw1 = p.ssd_norm_w[l * 512 + tid + 256];
      const float hw0 = p.hg_norm_w[l * 512 + tid], hw1 = p.hg_norm_w[l * 512 + tid + 256];
      const int pw = (wid >> 1) * 2;
#pragma unroll
      for (int t = 0; t < 16; ++t) {
        float4 r0 = *(const float4*)(RED + (0 * 16 + t) * 4), r1 = *(const float4*)(RED + (1 * 16 + t) * 4);
        float4 r2 = *(const float4*)(RED + (2 * 16 + t) * 4), r3 = *(const float4*)(RED + (3 * 16 + t) * 4);
        float g0 = r0.x + r1.x + r2.x + r3.x, g1 = r0.y + r1.y + r2.y + r3.y;
        float4 pa = *(const float4*)(RED + (pw * 16 + t) * 4), pb = *(const float4*)(RED + ((pw + 1) * 16 + t) * 4);
        float h0 = pa.z + pb.z, h1 = pa.w + pb.w;
        u16* rowp = p.PROJ + (m0 + t) * LDP;
        rowp[C_Z + tid] = f2bf(ys[0][t] * rsqrtf(g0 * (1.f / 256.f) + 1e-6f) * nw0);
        rowp[C_Z + tid + 256] = f2bf(ys[1][t] * rsqrtf(g1 * (1.f / 256.f) + 1e-6f) * nw1);
        float gg0 = bf2f(rowp[C_GG + tid]), gg1 = bf2f(rowp[C_GG + tid + 256]);
        rowp[C_GG + tid] = f2bf(oh[0][t] * rsqrtf(h0 * (1.f / 128.f) + 1e-6f) * hw0 * siluf_(gg0));
        rowp[C_GG + tid + 256] = f2bf(oh[1][t] * rsqrtf(h1 * (1.f / 128.f) + 1e-6f) * hw1 * siluf_(gg1));
      }
    }
    float ga[2][16];
#pragma unroll
    for (int c = 0; c < 2; ++c)
#pragma unroll
      for (int t = 0; t < 16; ++t) ga[c][t] = 0.f;
    {
      const float* g2 = p.rw_g2 + (long)l * 128 * 512;
      for (int i = 0; i < 128; ++i) {
        float gv[2] = {g2[i * 512 + tid], g2[i * 512 + tid + 256]};
#pragma unroll
        for (int q = 0; q < 4; ++q) {
          float4 x = *(const float4*)(SG + i * 16 + q * 4);
#pragma unroll
          for (int c = 0; c < 2; ++c) {
            ga[c][q * 4 + 0] += x.x * gv[c]; ga[c][q * 4 + 1] += x.y * gv[c];
            ga[c][q * 4 + 2] += x.z * gv[c]; ga[c][q * 4 + 3] += x.w * gv[c];
          }
        }
      }
    }
#pragma unroll
    for (int c = 0; c < 2; ++c) {
      int ch = tid + 256 * c, head = wid + 4 * c;
      float lw = p.rw_lnx_w[l * 512 + ch], lbv = p.rw_lnx_b[l * 512 + ch];
#pragma unroll
      for (int t = 0; t < 16; ++t) {
        float o = bf2f(p.ORW[(m0 + t) * 512 + ch]);
        float mean = sum64(o) * (1.f / 64.f);
        float d = o - mean;
        float var = sum64(d * d) * (1.f / 64.f);
        float ln = d * rsqrtf(var + 64e-5f) * lw + lbv;
        float v = bf2f(p.PROJ[(m0 + t) * LDP + C_V + ch]);
        float bonus = p.RKS[(m0 + t) * 8 + head] * v;
        p.PROJ[(m0 + t) * LDP + C_R + ch] = f2bf((ln + bonus) * ga[c][t]);
      }
    }
  }
}

__device__ __forceinline__ void phase_final(const Params& p) {
  const int tid = opaque_tid(), lane = tid & 63, wid = tid >> 6;
  for (int m = BID * 4 + wid, nb_ = NBLK; m < M_TOT; m += nb_ * 4) {
    float* dst;
    if (m < M_PROMPT) {
      int b = m / T_P, t = m - b * T_P;
      if (t < 16) continue;
      dst = p.out + O_YP + ((long)b * 4096 + (t - 16)) * DM;
    } else {
      dst = p.out + O_YS + (long)(m - M_PROMPT) * DM;
    }
    float x[16];
    float ss = 0.f;
#pragma unroll
    for (int j = 0; j < 2; ++j) {
      uint4 raw = *(const uint4*)(p.XB + (long)m * DM + lane * 8 + 512 * j);
      unsigned wv[4] = {raw.x, raw.y, raw.z, raw.w};
#pragma unroll
      for (int e = 0; e < 8; ++e) {
        x[j * 8 + e] = bf2f((u16)((wv[e >> 1] >> ((e & 1) * 16)) & 0xffff));
        ss += x[j * 8 + e] * x[j * 8 + e];
      }
    }
    ss = sum64(ss);
    float rs = rsqrtf(ss * (1.f / 1024.f) + 1e-6f);
#pragma unroll
    for (int j = 0; j < 2; ++j) {
      int k0 = lane * 8 + 512 * j;
      float4 w0 = *(const float4*)(p.final_w + k0), w1 = *(const float4*)(p.final_w + k0 + 4);
      *(float4*)(dst + k0) = make_float4(x[j * 8 + 0] * rs * w0.x, x[j * 8 + 1] * rs * w0.y, x[j * 8 + 2] * rs * w0.z,
                                         x[j * 8 + 3] * rs * w0.w);
      *(float4*)(dst + k0 + 4) = make_float4(x[j * 8 + 4] * rs * w1.x, x[j * 8 + 5] * rs * w1.y,
                                             x[j * 8 + 6] * rs * w1.z, x[j * 8 + 7] * rs * w1.w);
    }
  }
}


#define XB_TMO      128
#define XB_XCNT(j)  (256  + 64 * (j))
#define XB_XSUB(j)  (1280 + 64 * (j))
#define XB_XGEN(j)  (2304 + 64 * (j))
#define XB_TOP      3328
#define XB_TOPGEN   3392
#define XCD_BAR_WORDS 3456
#define XB_SPIN_CAP (1u << 22)
__device__ __forceinline__ unsigned xb_ld(unsigned* p) { return __hip_atomic_load(p, __ATOMIC_RELAXED, __HIP_MEMORY_SCOPE_AGENT); }
__device__ __forceinline__ unsigned xb_add(unsigned* p, unsigned v) { return __hip_atomic_fetch_add(p, v, __ATOMIC_RELAXED, __HIP_MEMORY_SCOPE_AGENT); }
__device__ __forceinline__ unsigned xb_xcc_id() { return (unsigned)__builtin_amdgcn_s_getreg((3 << 11) | 20) & 0xFu; }
#define XB_SPIN(cond, bar) do { unsigned _sp = 0; while (cond) { __builtin_amdgcn_s_sleep(1); \
    if ((++_sp & 255u) == 0u) { if (xb_ld(&(bar)[XB_TMO])) break; if (_sp > XB_SPIN_CAP) { atomicAdd(&(bar)[XB_TMO], 1u); break; } } } } while (0)

__device__ __forceinline__ void xcd_barrier_post(unsigned* bar) {
  if (threadIdx.x == 0) (void)xb_add(&bar[XB_XCNT(xb_xcc_id())], 1u);
}
__device__ __forceinline__ void xcd_barrier_complete(unsigned* bar, unsigned x, unsigned& nloc, unsigned& nx) {
  const unsigned G = gridDim.x;
  unsigned sum, cnt, mine, sp = 0u;
  for (;;) {
    sum = 0u; cnt = 0u; mine = 0u;
#pragma unroll
    for (unsigned j = 0; j < 16; ++j) { const unsigned c = xb_ld(&bar[XB_XCNT(j)]); sum += c; cnt += (c > 0u) ? 1u : 0u; mine = (j == x) ? c : mine; }
    if (sum == G) break;
    __builtin_amdgcn_s_sleep(1);
    if ((++sp & 255u) == 0u) { if (xb_ld(&bar[XB_TMO])) break; if (sp > XB_SPIN_CAP) { atomicAdd(&bar[XB_TMO], 1u); break; } }
  }
  nloc = mine > 0u ? mine : 1u; nx = cnt > 0u ? cnt : 1u;
}
__device__ __forceinline__ void xcd_barrier(unsigned* bar, volatile unsigned* st) {
  asm volatile("s_waitcnt vmcnt(0)" ::: "memory");
  __syncthreads();
  if (threadIdx.x == 0) {
    __builtin_amdgcn_s_waitcnt(0);
    const unsigned x = xb_xcc_id();
    unsigned nloc = st[0], nx = st[1];
    if (nloc == 0u) { xcd_barrier_complete(bar, x, nloc, nx); st[0] = nloc; st[1] = nx; }
    const unsigned old = xb_add(&bar[XB_XSUB(x)], 1u);
    const unsigned gen = old / nloc;
    if (old + 1u == (gen + 1u) * nloc) {
      __builtin_amdgcn_fence(__ATOMIC_RELEASE, "agent");
      asm volatile("s_waitcnt vmcnt(0)" ::: "memory");
      const unsigned og = xb_add(&bar[XB_TOP], 1u);
      const unsigned tg = og / nx;
      if (og + 1u == (tg + 1u) * nx) xb_add(&bar[XB_TOPGEN], 1u);
      else XB_SPIN(xb_ld(&bar[XB_TOPGEN]) == tg, bar);
      __builtin_amdgcn_fence(__ATOMIC_ACQUIRE, "agent");
      xb_add(&bar[XB_XGEN(x)], 1u);
      asm volatile("s_waitcnt vmcnt(0)" ::: "memory");
    } else {
      XB_SPIN(xb_ld(&bar[XB_XGEN(x)]) == gen, bar);
      __builtin_amdgcn_fence(__ATOMIC_ACQUIRE, "agent");
      asm volatile("s_waitcnt vmcnt(0)" ::: "memory");
    }
  }
  __syncthreads();
}

constexpr int SMEM_BYTES = 40960;
__device__ __forceinline__ void run_phase(const Params& p, int ph, char* smem) {
  if (ph == 0) { phase_embed(p); return; }
  if (ph == 19) { phase_final(p); return; }
  int l = (ph - 1) / 9, s = (ph - 1) % 9;
  float* fs = (float*)smem;
  switch (s) {
    case 0: phase_convert(p, l, fs); phase_rowstat<true>(p, l, fs); break;
    case 1: phase_gemm<1>(p, p.XB, DM, p.W1T, 1024, LDP / 128, smem); break;
    case 2: phase_pre(p, l, fs); break;
    case 3: phase_scan(p, l, fs); break;
    case 4: phase_post(p, l, fs); break;
    case 5: phase_gemm<2>(p, p.PROJ, LDP, p.WOT, 1536, 8, smem); break;
    case 6: phase_rowstat<false>(p, l, fs); break;
    case 7: phase_gemm<3>(p, p.XB, DM, p.WGU, 1024, 44, smem); break;
    case 8: phase_gemm<2>(p, p.PROJ, D_FF, p.WDT, D_FF, 8, smem); break;
  }
}
constexpr int N_PHASES = 20;

#if MEGA
__global__ void __launch_bounds__(256, 3) k_mega(Params p) {
  __shared__ __attribute__((aligned(16))) char smem[SMEM_BYTES];
  __shared__ uint4 xb_words;
  if (threadIdx.x == 0) { xb_words = make_uint4(0u, 0u, 0u, 0u); }
  __syncthreads();
  cg::grid_group grid = cg::this_grid();
  float* fs = (float*)smem;
  volatile unsigned* xst = (volatile unsigned*)&xb_words;
  xcd_barrier_post(p.bar);
  phase_embed(p);
  grid.sync();
#define GSYNC() do { unsigned* b_ = p.bar; asm volatile("" : "+s"(b_)); xcd_barrier(b_, xst); } while (0)
#pragma unroll 1
  for (int l0 = 0; l0 < 2; ++l0) {
    int l = opaque_s(l0);
    phase_convert(p, l, fs);
    phase_rowstat<true>(p, l, fs);
    GSYNC();
    l = opaque_s(l);
    phase_gemm<1>(p, p.XB, DM, p.W1T, 1024, LDP / 128, smem);
    GSYNC();
    l = opaque_s(l);
    phase_pre(p, l, fs);
    GSYNC();
    l = opaque_s(l);
    phase_scan(p, l, fs);
    GSYNC();
    l = opaque_s(l);
    phase_post(p, l, fs);
    GSYNC();
    l = opaque_s(l);
    phase_gemm<2>(p, p.PROJ, LDP, p.WOT, 1536, 8, smem);
    GSYNC();
    l = opaque_s(l);
    phase_rowstat<false>(p, l, fs);
    GSYNC();
    l = opaque_s(l);
    phase_gemm<3>(p, p.XB, DM, p.WGU, 1024, 44, smem);
    GSYNC();
    l = opaque_s(l);
    phase_gemm<2>(p, p.PROJ, D_FF, p.WDT, D_FF, 8, smem);
    GSYNC();
  }
  phase_final(p);
}
#else
template <int PH>
__global__ void __launch_bounds__(256, 3) k_phase(Params p) {
  __shared__ __attribute__((aligned(16))) char smem[SMEM_BYTES];
  run_phase(p, PH, smem);
}
template <int PH>
static void launch_all(const Params& p, int grid, hipStream_t stream) {
  hipLaunchKernelGGL(k_phase<PH>, dim3(grid), dim3(256), 0, stream, p);
  if constexpr (PH + 1 < N_PHASES) launch_all<PH + 1>(p, grid, stream);
}
#endif

extern "C" void kernel_launch(void* const* d_in, const int* in_sizes, int n_in, void* d_out, int out_size, void* d_ws,
                              size_t ws_size, hipStream_t stream) {
  Params p{};
  const float** pf = (const float**)&p;
  for (int i = 0; i < 35; ++i) pf[i] = (const float*)d_in[i];
  p.out = (float*)d_out;
  char* ws = (char*)d_ws;
  size_t off = 0;
  auto take = [&](size_t bytes) { char* r = ws + off; off += (bytes + 255) & ~(size_t)255; return r; };
  p.XB = (u16*)take((size_t)M_TOT * DM * 2);
  p.PROJ = (u16*)take((size_t)M_TOT * LDP * 2);
  p.W1T = (u16*)take((size_t)LDP * 1024 * 2);
  p.WOT = (u16*)take((size_t)1024 * 1536 * 2);
  p.WGU = (u16*)take((size_t)5632 * 1024 * 2);
  p.WDT = (u16*)take((size_t)1024 * D_FF * 2);
  p.BND = (u16*)take((size_t)NBLK16 * 1792 * 2);
  p.ORW = (u16*)take((size_t)M_TOT * 512 * 2);
  p.RS = (float*)take((size_t)M_TOT * 4);
  p.DTRAW = (float*)take((size_t)M_TOT * 8 * 4);
  p.RKS = (float*)take((size_t)M_TOT * 8 * 4);
  p.bar = (unsigned*)take((size_t)XCD_BAR_WORDS * 4);
  p.RWX = (u16*)d_out;
  if (off > ws_size) fprintf(stderr, "workspace too small: need %zu have %zu\n", off, ws_size);
#if MEGA
  static int grid_blocks = 0;
  if (!grid_blocks) {
    int dev = 0, cus = 0, per_cu = 0;
    hipGetDevice(&dev);
    hipDeviceGetAttribute(&cus, hipDeviceAttributeMultiprocessorCount, dev);
    hipOccupancyMaxActiveBlocksPerMultiprocessor(&per_cu, k_mega, 256, 0);
    if (per_cu > 3) per_cu = 3;
    grid_blocks = cus * per_cu;
  }
  hipMemsetAsync(p.bar, 0, (size_t)XCD_BAR_WORDS * 4, stream);
  void* args[] = {&p};
  hipError_t e = hipLaunchCooperativeKernel((void*)k_mega, dim3(grid_blocks), dim3(256), args, 0, stream);
  if (e != hipSuccess) fprintf(stderr, "cooperative launch failed: %s (grid %d)\n", hipGetErrorString(e), grid_blocks);
#else
  launch_all<0>(p, 768, stream);
#endif
}
```

```cpp
#include <hip/hip_runtime.h>
#include <hip/hip_bf16.h>
#include <hip/hip_cooperative_groups.h>
#include <cstdio>
namespace cg = cooperative_groups;

#ifndef MEGA
#define MEGA 1
#endif

typedef unsigned short u16;
using bf16x8 = __attribute__((ext_vector_type(8))) short;
using f32x16 = __attribute__((ext_vector_type(16))) float;
using f32x4v = __attribute__((ext_vector_type(4))) float;

constexpr int DM = 1024;
constexpr int M_TOT = 33408;
constexpr int M_PROMPT = 32896;
constexpr int T_P = 4112;
constexpr int LDP = 5376;
constexpr int N_IN = 5384;
constexpr int D_FF = 2816;
constexpr int NBLK16 = M_TOT / 16;
constexpr int C_Z = 0, C_R = 512, C_GG = 1024, C_XBC = 1536, C_K = 2560, C_V = 3072, C_XW = 3584, C_XA = 3648,
              C_XG = 3712, C_Q = 3840, C_F = 4352, C_I = 4864;
constexpr long O_YP = 0, O_YS = 33554432, O_PSSM = 34078720, O_PCONV = 35127296, O_PRWKV = 35176448,
               O_PSHIFT = 35700736, O_PHGRN = 35729408, O_SSSM = 36777984, O_SCONV = 37826560,
               O_SRWKV = 37875712, O_SSHIFT = 38400000, O_SHGRN = 38428672;

constexpr long OFF_W1T = 0, OFF_WOT = 5505024, OFF_WGU = 7077888, OFF_WDT = 12845056, OFF_W2T = 15728640, OFF_A2T = 15761408, OFF_G2T = 15794176, WB_TOTAL = 15859712;
constexpr long FOFF_RS = 0, FOFF_DTRAW = 33408, FOFF_RKS = 300672, FB_TOTAL = 567936;
struct Params {
  const float *x_prompt, *x_sample, *state_ssm, *state_conv, *state_rwkv, *state_shift, *state_hgrn, *meta,
      *norm1_w, *w_in, *conv_w, *conv_b, *dt_bias, *a_log, *d_skip, *ssd_norm_w, *rw_mu, *rw_w0, *rw_w2, *rw_a0,
      *rw_a2, *rw_g2, *rw_kk, *rw_ka, *rw_rk, *rw_lnx_w, *rw_lnx_b, *hg_lb, *hg_norm_w, *w_out, *norm2_w, *w_gate,
      *w_up, *w_down, *final_w;
  float* out;
  u16 *XB, *PROJ, *WB, *BND, *ORW, *RWX;
  float *FB;
  unsigned* bar;
};

__device__ __forceinline__ u16 f2bf(float f) {
  unsigned u = __float_as_uint(f);
  u += 0x7fffu + ((u >> 16) & 1u);
  return (u16)(u >> 16);
}
__device__ __forceinline__ float bf2f(u16 h) { return __uint_as_float(((unsigned)h) << 16); }
__device__ __forceinline__ float frcp_(float x) { return __builtin_amdgcn_rcpf(x); }
__device__ __forceinline__ float sigmoidf_(float x) { return frcp_(1.f + __expf(-x)); }
__device__ __forceinline__ float siluf_(float x) { return x * frcp_(1.f + __expf(-x)); }
__device__ __forceinline__ float softplusf_(float x) { return x > 20.f ? x : log1pf(__expf(x)); }

template <int CTRL>
__device__ __forceinline__ float dppf(float v) {
  return __int_as_float(__builtin_amdgcn_update_dpp(0, __float_as_int(v), CTRL, 0xF, 0xF, true));
}
__device__ __forceinline__ float sum16(float v) {
  v += dppf<0xB1>(v);
  v += dppf<0x4E>(v);
  v += dppf<0x141>(v);
  v += dppf<0x140>(v);
  return v;
}
__device__ __forceinline__ void sum16x2(float& a, float& b) {
  a += dppf<0xB1>(a); b += dppf<0xB1>(b);
  a += dppf<0x4E>(a); b += dppf<0x4E>(b);
  a += dppf<0x141>(a); b += dppf<0x141>(b);
  a += dppf<0x140>(a); b += dppf<0x140>(b);
}
__device__ __forceinline__ float sum64(float v) {
  v = sum16(v);
  v += __shfl_xor(v, 16);
  v += __shfl_xor(v, 32);
  return v;
}

#define NOPK(x) asm("" : "+v"(x))
__device__ __forceinline__ int opaque_tid() {
  int t = threadIdx.x;
  asm volatile("" : "+v"(t));
  return t;
}
__device__ __forceinline__ int opaque_s(int v) {
  asm volatile("" : "+s"(v));
  return v;
}
#define BID opaque_s((int)blockIdx.x)
#define NBLK opaque_s((int)gridDim.x)
__device__ __forceinline__ int seq_base(int s) { return s < 8 ? s * T_P : M_PROMPT + (s - 8) * 64; }
__device__ __forceinline__ int seq_len(int s) { return s < 8 ? T_P : 64; }

__device__ __forceinline__ void phase_embed(const Params& p) {
  const long n4 = (long)M_TOT * 256;
  for (long idx = (long)BID * 256 + threadIdx.x, st_ = (long)NBLK * 256; idx < n4; idx += st_) {
    int m = (int)(idx >> 8), c4 = ((int)idx & 255) * 4;
    const float* src;
    if (m < M_PROMPT) {
      int b = m / T_P, t = m - b * T_P;
      src = (t < 16) ? p.meta + (long)t * DM : p.x_prompt + ((long)b * 4096 + (t - 16)) * DM;
    } else {
      src = p.x_sample + (long)(m - M_PROMPT) * DM;
    }
    float4 v = *(const float4*)(src + c4);
    ushort4 o;
    o.x = f2bf(v.x); o.y = f2bf(v.y); o.z = f2bf(v.z); o.w = f2bf(v.w);
    *(ushort4*)(p.XB + (long)m * DM + c4) = o;
  }
}

template <bool HAS_SCALE>
__device__ __forceinline__ void conv_tile(const float* __restrict__ src, int ldsrc, int srccol0, const float* __restrict__ scale,
                          u16* __restrict__ dst, int K, int k0, int n0, float* tile  ) {
  const int tid = opaque_tid();
  __syncthreads();
  {
    int nn = tid & 63, kb = tid >> 6;
#pragma unroll
    for (int i = 0; i < 16; ++i) {
      int kk = kb + 4 * i;
      float v = src[(long)(k0 + kk) * ldsrc + srccol0 + nn];
      if (HAS_SCALE) v *= scale[k0 + kk];
      tile[kk * 65 + nn] = v;
    }
  }
  __syncthreads();
  {
    int nn = tid >> 2, kq = (tid & 3) * 16;
    u16* d = dst + (long)(n0 + nn) * K + k0 + kq;
#pragma unroll
    for (int j = 0; j < 16; j += 2) {
      unsigned w = f2bf(tile[(kq + j) * 65 + nn]) | ((unsigned)f2bf(tile[(kq + j + 1) * 65 + nn]) << 16);
      *(unsigned*)(d + j) = w;
    }
  }
}

__device__ __forceinline__ int w1_srccol(int n0) {
  if (n0 < 512) return n0;
  if (n0 < 1024) return n0 - 512 + 1544;
  if (n0 < 1536) return n0 - 1024 + 4872;
  if (n0 < 2560) return n0 - 1536 + 512;
  if (n0 < 3840) return n0 - 2560 + 2056;
  return n0 - 3840 + 3336;
}

constexpr int CV_W1 = 16 * 84, CV_WO = 24 * 16, CV_WGU = 16 * 88, CV_WD = 44 * 16;
constexpr int CV_LORA = 32;
constexpr int CV_TOTAL = CV_W1 + CV_WO + CV_WGU + CV_WD + CV_LORA;

__device__ __forceinline__ void phase_convert(const Params& p, int l, float* smem) {
  for (int u = BID, nb_ = NBLK; u < CV_TOTAL; u += nb_) {
    if (u < CV_W1) {
      int kt = u % 16, nt = u / 16;
      conv_tile<true>(p.w_in + (long)l * DM * N_IN, N_IN, w1_srccol(nt * 64), p.norm1_w + l * DM, (p.WB + OFF_W1T), 1024, kt * 64,
                nt * 64, smem);
    } else if (u < CV_W1 + CV_WO) {
      int v = u - CV_W1;
      int kt = v % 24, nt = v / 24;
      conv_tile<false>(p.w_out + (long)l * 1536 * DM, DM, nt * 64, nullptr, (p.WB + OFF_WOT), 1536, kt * 64, nt * 64, smem);
    } else if (u < CV_W1 + CV_WO + CV_WGU) {
      int v = u - CV_W1 - CV_WO;
      int kt = v % 16, nt = v / 16;
      const float* wg = p.w_gate + (long)l * DM * D_FF;
      const float* wu = p.w_up + (long)l * DM * D_FF;
      const float* sc = p.norm2_w + l * DM;
      const int tid = opaque_tid();
      __syncthreads();
      {
        int nn = tid & 63, kb = tid >> 6;
        const float* src = (nn < 32) ? wg : wu;
        int col = nt * 32 + (nn & 31);
#pragma unroll
        for (int i = 0; i < 16; ++i) {
          int kk = kb + 4 * i;
          smem[kk * 65 + nn] = src[(long)(kt * 64 + kk) * D_FF + col] * sc[kt * 64 + kk];
        }
      }
      __syncthreads();
      {
        int nn = tid >> 2, kq = (tid & 3) * 16;
        u16* d = (p.WB + OFF_WGU) + (long)(nt * 64 + nn) * 1024 + kt * 64 + kq;
#pragma unroll
        for (int j = 0; j < 16; j += 2) {
          unsigned w = f2bf(smem[(kq + j) * 65 + nn]) | ((unsigned)f2bf(smem[(kq + j + 1) * 65 + nn]) << 16);
          *(unsigned*)(d + j) = w;
        }
      }
    } else if (u >= CV_W1 + CV_WO + CV_WGU + CV_WD) {
      int v = u - (CV_W1 + CV_WO + CV_WGU + CV_WD);
      const int tid = opaque_tid();
#pragma unroll 4
      for (int i = 0; i < 16; ++i) {
        int e = v * 4096 + i * 256 + tid;
        if (e < 32768) {
          int n = e >> 6, k = e & 63;
          (p.WB + OFF_W2T)[e] = f2bf(p.rw_w2[(long)l * 64 * 512 + k * 512 + n]);
        } else if (e < 65536) {
          int e2 = e - 32768, n = e2 >> 6, k = e2 & 63;
          (p.WB + OFF_A2T)[e2] = f2bf(p.rw_a2[(long)l * 64 * 512 + k * 512 + n]);
        } else {
          int e2 = e - 65536, n = e2 >> 7, k = e2 & 127;
          (p.WB + OFF_G2T)[e2] = f2bf(p.rw_g2[(long)l * 128 * 512 + k * 512 + n]);
        }
      }
    } else {
      int v = u - CV_W1 - CV_WO - CV_WGU;
      int kt = v % 44, nt = v / 44;
      conv_tile<false>(p.w_down + (long)l * D_FF * DM, DM, nt * 64, nullptr, (p.WB + OFF_WDT), D_FF, kt * 64, nt * 64, smem);
    }
  }
}

template <bool WITH_DT>
__device__ __forceinline__ void phase_rowstat(const Params& p, int l, float* smem) {
  const int tid = opaque_tid(), lane = tid & 63, wid = tid >> 6;
  float* dtw = smem;
  if (WITH_DT) {
    __syncthreads();
    const float* w = p.w_in + (long)l * DM * N_IN + 1536;
    const float* nw = p.norm1_w + l * DM;
    for (int i = tid; i < 8192; i += 256) {
      int k = i >> 3, h = i & 7;
      dtw[i] = w[(long)k * N_IN + h] * nw[k];
    }
    __syncthreads();
  }
  for (int blk = BID, nb_ = NBLK; blk < NBLK16; blk += nb_) {
    for (int rr = wid; rr < 16; rr += 4) {
      int m = blk * 16 + rr;
      float ss = 0.f;
      float d[8];
#pragma unroll
      for (int h = 0; h < 8; ++h) d[h] = 0.f;
#pragma unroll 1
      for (int j = 0; j < 4; ++j) {
        int k0 = lane * 4 + 256 * j;
        uint2 raw = *(const uint2*)(p.XB + (long)m * DM + k0);
        float xs[4] = {bf2f((u16)(raw.x & 0xffff)), bf2f((u16)(raw.x >> 16)), bf2f((u16)(raw.y & 0xffff)),
                       bf2f((u16)(raw.y >> 16))};
#pragma unroll
        for (int e = 0; e < 4; ++e) {
          float x = xs[e];
          ss += x * x;
          if (WITH_DT) {
            float4 w0 = *(const float4*)(dtw + (k0 + e) * 8);
            float4 w1 = *(const float4*)(dtw + (k0 + e) * 8 + 4);
            d[0] += x * w0.x; d[1] += x * w0.y; d[2] += x * w0.z; d[3] += x * w0.w;
            d[4] += x * w1.x; d[5] += x * w1.y; d[6] += x * w1.z; d[7] += x * w1.w;
          }
        }
      }
      ss = sum64(ss);
      float rs = rsqrtf(ss * (1.f / 1024.f) + 1e-6f);
      if (WITH_DT) {
#pragma unroll
        for (int h = 0; h < 8; ++h) d[h] = sum64(d[h]);
        if (lane == 0) {
#pragma unroll
          for (int h = 0; h < 8; ++h) (p.FB + FOFF_DTRAW)[(long)m * 8 + h] = d[h] * rs;
        }
      }
      if (lane == 0) (p.FB + FOFF_RS)[m] = rs;
    }
  }
}

constexpr int G_BK = 32, G_LDS_ROW = 80;
constexpr int G_OPER_BYTES = 128 * G_LDS_ROW;
template <int MODE>
__device__ __forceinline__ void phase_gemm(const Params& p, const u16* __restrict__ A, int lda, const u16* __restrict__ Bt, int K,
                           int nN, char* smem) {
  const int tid = opaque_tid(), lane = tid & 63, wid = tid >> 6, wm = wid >> 1, wn = wid & 1;
  const int nM = M_TOT / 128;
  const int ntiles = nM * nN;
  const int nk = K / G_BK;
  const int lrow = tid >> 2, lkc = tid & 3;
  for (int tile = BID, nb_ = NBLK; tile < ntiles; tile += nb_) {
    constexpr int GM = 32;
    int grp = tile / (GM * nN);
    int first_m = grp * GM;
    int gsz = min(GM, nM - first_m);
    int rem = tile - grp * GM * nN;
    int pm = first_m + rem % gsz, pn = rem / gsz;
    const u16* gA = A + (long)(pm * 128 + lrow) * lda + lkc * 8;
    const u16* gB = Bt + (long)(pn * 128 + lrow) * K + lkc * 8;
    f32x16 acc[2][2];
#pragma unroll
    for (int i = 0; i < 2; ++i)
#pragma unroll
      for (int j = 0; j < 2; ++j)
#pragma unroll
        for (int r = 0; r < 16; ++r) acc[i][j][r] = 0.f;
    uint4 xa0, xa1, xb0, xb1, ya0, ya1, yb0, yb1;
#define G_LOAD(S, KT)                                                  \
  {                                                                    \
    S##a0 = *(const uint4*)(gA + (KT) * G_BK);                         \
    S##a1 = *(const uint4*)(gA + (long)64 * lda + (KT) * G_BK);        \
    S##b0 = *(const uint4*)(gB + (KT) * G_BK);                         \
    S##b1 = *(const uint4*)(gB + (long)64 * K + (KT) * G_BK);          \
  }
#define G_STORE(S, BUF)                                                \
  {                                                                    \
    char* dA = smem + (BUF) * 2 * G_OPER_BYTES;                        \
    char* dB = dA + G_OPER_BYTES;                                      \
    *(uint4*)(dA + lrow * G_LDS_ROW + lkc * 16) = S##a0;               \
    *(uint4*)(dA + (lrow + 64) * G_LDS_ROW + lkc * 16) = S##a1;        \
    *(uint4*)(dB + lrow * G_LDS_ROW + lkc * 16) = S##b0;               \
    *(uint4*)(dB + (lrow + 64) * G_LDS_ROW + lkc * 16) = S##b1;        \
  }
#define G_COMPUTE(BUF)                                                                           \
  {                                                                                              \
    const char* sA = smem + (BUF) * 2 * G_OPER_BYTES;                                            \
    const char* sB = sA + G_OPER_BYTES;                                                          \
    _Pragma("unroll") for (int ks = 0; ks < 2; ++ks) {                                           \
      bf16x8 af[2], bfr[2];                                                                      \
      const int koff = (ks * 16 + (lane >> 5) * 8) * 2;                                          \
      _Pragma("unroll") for (int i = 0; i < 2; ++i)                                              \
        af[i] = *(const bf16x8*)(sA + (wm * 64 + i * 32 + (lane & 31)) * G_LDS_ROW + koff);      \
      _Pragma("unroll") for (int j = 0; j < 2; ++j)                                              \
        bfr[j] = *(const bf16x8*)(sB + (wn * 64 + j * 32 + (lane & 31)) * G_LDS_ROW + koff);     \
      _Pragma("unroll") for (int i = 0; i < 2; ++i)                                              \
        _Pragma("unroll") for (int j = 0; j < 2; ++j)                                            \
          acc[i][j] = __builtin_amdgcn_mfma_f32_32x32x16_bf16(af[i], bfr[j], acc[i][j], 0, 0, 0); \
    }                                                                                            \
  }
    G_LOAD(x, 0);
    G_LOAD(y, 1);
    __builtin_amdgcn_sched_barrier(0);
    __syncthreads();
    G_STORE(x, 0);
    __syncthreads();
    for (int kt = 0; kt < nk; kt += 2) {
      if (kt + 2 < nk) G_LOAD(x, kt + 2);
      __builtin_amdgcn_sched_barrier(0);
      G_COMPUTE(0);
      __builtin_amdgcn_sched_barrier(0);
      G_STORE(y, 1);
      __syncthreads();
      if (kt + 3 < nk) G_LOAD(y, kt + 3);
      __builtin_amdgcn_sched_barrier(0);
      G_COMPUTE(1);
      __builtin_amdgcn_sched_barrier(0);
      if (kt + 2 < nk) G_STORE(x, 0);
      __syncthreads();
    }
#undef G_LOAD
#undef G_STORE
#undef G_COMPUTE
    const int colb = pn * 128 + wn * 64 + (lane & 31);
    const int rowb = pm * 128 + wm * 64 + 4 * (lane >> 5);
    if (MODE == 1) {
#pragma unroll
      for (int i = 0; i < 2; ++i)
#pragma unroll
        for (int r = 0; r < 16; ++r) {
          int row = rowb + i * 32 + (r & 3) + 8 * (r >> 2);
          float rs = (p.FB + FOFF_RS)[row];
#pragma unroll
          for (int j = 0; j < 2; ++j) {
            int col = colb + j * 32;
            u16 v = f2bf(acc[i][j][r] * rs);
            p.PROJ[(long)row * LDP + col] = v;
            if ((row & 15) == 15) {
              int jj = -1;
              if (col >= C_R && col < C_GG) jj = col - C_R;
              else if (col >= C_K && col < C_Q) jj = col - C_K + 512;
              if (jj >= 0) p.BND[(long)(row >> 4) * 1792 + jj] = v;
            }
          }
        }
    } else if (MODE == 2) {
#pragma unroll
      for (int i = 0; i < 2; ++i)
#pragma unroll
        for (int r = 0; r < 16; ++r) {
          int row = rowb + i * 32 + (r & 3) + 8 * (r >> 2);
#pragma unroll
          for (int j = 0; j < 2; ++j) {
            int col = colb + j * 32;
            u16* px = p.XB + (long)row * DM + col;
            *px = f2bf(bf2f(*px) + acc[i][j][r]);
          }
        }
    } else {
      const int cact = pn * 64 + wn * 32 + (lane & 31);
      u16* ACT = p.PROJ;
#pragma unroll
      for (int i = 0; i < 2; ++i)
#pragma unroll
        for (int r = 0; r < 16; ++r) {
          int row = rowb + i * 32 + (r & 3) + 8 * (r >> 2);
          float rs = (p.FB + FOFF_RS)[row];
          float g = acc[i][0][r] * rs, u = acc[i][1][r] * rs;
          ACT[(long)row * D_FF + cact] = f2bf(siluf_(g) * u);
        }
    }
  }
}

__device__ __forceinline__ void phase_pre(const Params& p, int l, float* smem) {
  const int tid = opaque_tid(), lane = tid & 63, wid = tid >> 6;
  u16* XWb = (u16*)smem;
  u16* XAb = (u16*)smem + 16 * 72;
  constexpr int LDW = 260;
  float* AW = smem + 1152;
  float* AA = smem + 1152 + 16 * LDW;
  const float* mu = p.rw_mu + l * 1792;
  for (int blk = BID, nb_ = NBLK; blk < NBLK16; blk += nb_) {
    const int m0 = blk * 16;
    int s, t0;
    if (m0 < M_PROMPT) { s = m0 / T_P; t0 = m0 - s * T_P; } else { s = 8 + (m0 - M_PROMPT) / 64; t0 = (m0 - M_PROMPT) & 63; }
    const bool first = (t0 == 0);
    auto prev_of = [&](int j) -> float {
      if (!first) return bf2f(p.BND[(long)(blk - 1) * 1792 + j]);
      if (s < 8) return 0.f;
      return p.state_shift[((long)l * 8 + (s - 8)) * 1792 + j];
    };
    __syncthreads();
    {
      int j = 1536 + tid;
      float mj = mu[j];
      float pv = prev_of(j);
      u16* col = p.PROJ + (long)m0 * LDP + C_XW + tid;
#pragma unroll
      for (int t = 0; t < 16; ++t) {
        float x = bf2f(col[(long)t * LDP]);
        float sh = x + (pv - x) * mj;
        pv = x;
        if (tid < 64) XWb[t * 72 + tid] = f2bf(tanhf(sh));
        else if (tid < 128) XAb[t * 72 + (tid - 64)] = f2bf(sh);
        else col[(long)t * LDP] = f2bf(sigmoidf_(sh));
      }
    }
    __syncthreads();
#pragma unroll 1
    for (int c = 0; c < 2; ++c) {
      const int ch = tid + 256 * c;
      const int head = wid + 4 * c;
      float aw[16], aa[16];
      {
        bf16x8 axw[2], axa[2];
#pragma unroll
        for (int ks = 0; ks < 2; ++ks) {
          axw[ks] = *(const bf16x8*)(XWb + (lane & 15) * 72 + ks * 32 + (lane >> 4) * 8);
          axa[ks] = *(const bf16x8*)(XAb + (lane & 15) * 72 + ks * 32 + (lane >> 4) * 8);
        }
#pragma unroll
        for (int nt = 0; nt < 4; ++nt) {
          const int ncol = (wid * 4 + nt) * 16 + (lane & 15);
          const int n = c * 256 + ncol;
          f32x4v accw = {0.f, 0.f, 0.f, 0.f}, acca = {0.f, 0.f, 0.f, 0.f};
#pragma unroll
          for (int ks = 0; ks < 2; ++ks) {
            bf16x8 bw = *(const bf16x8*)((p.WB + OFF_W2T) + n * 64 + ks * 32 + (lane >> 4) * 8);
            bf16x8 ba = *(const bf16x8*)((p.WB + OFF_A2T) + n * 64 + ks * 32 + (lane >> 4) * 8);
            accw = __builtin_amdgcn_mfma_f32_16x16x32_bf16(axw[ks], bw, accw, 0, 0, 0);
            acca = __builtin_amdgcn_mfma_f32_16x16x32_bf16(axa[ks], ba, acca, 0, 0, 0);
          }
#pragma unroll
          for (int r = 0; r < 4; ++r) {
            AW[((lane >> 4) * 4 + r) * LDW + ncol] = accw[r];
            AA[((lane >> 4) * 4 + r) * LDW + ncol] = acca[r];
          }
        }
        __syncthreads();
#pragma unroll
        for (int t = 0; t < 16; ++t) { aw[t] = AW[t * LDW + tid]; aa[t] = AA[t * LDW + tid]; }
        __syncthreads();
      }
      {
        float w0 = p.rw_w0[l * 512 + ch], a0 = p.rw_a0[l * 512 + ch];
#pragma unroll
        for (int t = 0; t < 16; ++t) {
          float lw = -softplusf_(-(w0 + aw[t])) - 0.5f;
          float u = -__expf(lw);
          p.RWX[(long)(m0 + t) * 1536 + ch] = f2bf(u);
          aa[t] = sigmoidf_(a0 + aa[t]);
        }
      }
      float rt[16];
      {
        float mj = mu[ch];
        float pv = prev_of(ch);
        u16* col = p.PROJ + (long)m0 * LDP + C_R + ch;
#pragma unroll
        for (int t = 0; t < 16; ++t) {
          float x = bf2f(col[(long)t * LDP]);
          rt[t] = x + (pv - x) * mj;
          pv = x;
        }
#pragma unroll
        for (int t = 0; t < 16; ++t) col[(long)t * LDP] = f2bf(rt[t]);
      }
      {
        float mj = mu[512 + ch];
        float pv = prev_of(512 + ch);
        float kkw = p.rw_kk[l * 512 + ch], kaw = p.rw_ka[l * 512 + ch], rkw = p.rw_rk[l * 512 + ch];
        u16* col = p.PROJ + (long)m0 * LDP + C_K + ch;
        float kt[16];
#pragma unroll
        for (int t = 0; t < 16; ++t) {
          float x = bf2f(col[(long)t * LDP]);
          kt[t] = x + (pv - x) * mj;
          pv = x;
        }
#pragma unroll
        for (int t = 0; t < 16; ++t) {
          float kkv = kt[t] * kkw;
          float ssq = sum64(kkv * kkv);
          float kk = kkv * rsqrtf(ssq + 1e-12f);
          float a = aa[t];
          float kp = kt[t] * (1.f + (a - 1.f) * kaw);
          float rks = sum64(rt[t] * kp * rkw);
          col[(long)t * LDP] = f2bf(kp);
          p.RWX[(long)(m0 + t) * 1536 + 512 + ch] = f2bf(kk);
          p.RWX[(long)(m0 + t) * 1536 + 1024 + ch] = f2bf(kk * a);
          if (lane == 0) (p.FB + FOFF_RKS)[(long)(m0 + t) * 8 + head] = rks;
        }
      }
      {
        float mj = mu[1024 + ch];
        float pv = prev_of(1024 + ch);
        u16* col = p.PROJ + (long)m0 * LDP + C_V + ch;
        float vt[16];
#pragma unroll
        for (int t = 0; t < 16; ++t) {
          float x = bf2f(col[(long)t * LDP]);
          vt[t] = x + (pv - x) * mj;
          pv = x;
        }
#pragma unroll
        for (int t = 0; t < 16; ++t) col[(long)t * LDP] = f2bf(vt[t]);
      }
    }
    if (t0 + 16 == seq_len(s)) {
      float* o = p.out + (s < 8 ? O_PSHIFT + ((long)l * 8 + s) * 1792 : O_SSHIFT + ((long)l * 8 + (s - 8)) * 1792);
      for (int j = tid; j < 1792; j += 256) o[j] = bf2f(p.BND[(long)blk * 1792 + j]);
    }
  }
}

__device__ __forceinline__ void scan_rwkv(const Params& p, int l, int s, int h, int q, float* smem) {
  const int tid = opaque_tid(), lane = tid & 63, wid = tid >> 6;
  float* R_ = smem;
  float* W_ = smem + 1024;
  float* K_ = smem + 2048;
  float* A_ = smem + 3072;
  float* B_ = smem + 4096;
  float* V_ = smem + 5120;
  float* O_ = smem + 5376;
  const int rl = wid * 4 + (lane >> 4);
  const int row = q * 16 + rl;
  const int ksl = (lane & 15) * 4;
  const int base = seq_base(s), T = seq_len(s);
  float s0 = 0.f, s1 = 0.f, s2 = 0.f, s3 = 0.f;
  if (s >= 8) {
    const float* st = p.state_rwkv + (((long)l * 8 + (s - 8)) * 8 + h) * 4096 + row * 64 + ksl;
    float4 v = *(const float4*)st;
    s0 = v.x; s1 = v.y; s2 = v.z; s3 = v.w;
  }
  const int stt = tid >> 4, skq = (tid & 15) * 4;
  const int nblk = T / 16;
  ushort4 r4, k4, u4, a4, b4;
  u16 vv;
  {
    const long m = base + stt;
    const u16* pr = p.PROJ + m * LDP;
    const u16* px = p.RWX + m * 1536;
    r4 = *(const ushort4*)(pr + C_R + h * 64 + skq);
    k4 = *(const ushort4*)(pr + C_K + h * 64 + skq);
    u4 = *(const ushort4*)(px + h * 64 + skq);
    a4 = *(const ushort4*)(px + 512 + h * 64 + skq);
    b4 = *(const ushort4*)(px + 1024 + h * 64 + skq);
    vv = pr[C_V + h * 64 + q * 16 + (tid & 15)];
  }
  __syncthreads();
  float* TR_ = smem + 5376 + 512;
  const bool wr = (lane & 15) == 0;
  const int ooff = wr ? rl : (512 + lane);
  const int ostr = wr ? 16 : 0;
  for (int blk = 0; blk < nblk; ++blk) {
    const long m = base + blk * 16 + stt;
    float* Oc = O_ + (blk & 1) * 256;
    {
      *(float4*)(R_ + stt * 64 + skq) = make_float4(bf2f(r4.x), bf2f(r4.y), bf2f(r4.z), bf2f(r4.w));
      *(float4*)(K_ + stt * 64 + skq) = make_float4(bf2f(k4.x), bf2f(k4.y), bf2f(k4.z), bf2f(k4.w));
      *(float4*)(W_ + stt * 64 + skq) =
          make_float4(__expf(bf2f(u4.x)), __expf(bf2f(u4.y)), __expf(bf2f(u4.z)), __expf(bf2f(u4.w)));
      *(float4*)(A_ + stt * 64 + skq) = make_float4(-bf2f(a4.x), -bf2f(a4.y), -bf2f(a4.z), -bf2f(a4.w));
      *(float4*)(B_ + stt * 64 + skq) = make_float4(bf2f(b4.x), bf2f(b4.y), bf2f(b4.z), bf2f(b4.w));
      V_[stt * 16 + (tid & 15)] = bf2f(vv);
    }
    __syncthreads();
    if (blk > 0)
      p.ORW[(m - 16) * 512 + h * 64 + q * 16 + (tid & 15)] = f2bf(O_[((blk - 1) & 1) * 256 + stt * 16 + (tid & 15)]);
    if (blk + 1 < nblk) {
      const u16* pr = p.PROJ + (m + 16) * LDP;
      const u16* px = p.RWX + (m + 16) * 1536;
      r4 = *(const ushort4*)(pr + C_R + h * 64 + skq);
      k4 = *(const ushort4*)(pr + C_K + h * 64 + skq);
      u4 = *(const ushort4*)(px + h * 64 + skq);
      a4 = *(const ushort4*)(px + 512 + h * 64 + skq);
      b4 = *(const ushort4*)(px + 1024 + h * 64 + skq);
      vv = pr[C_V + h * 64 + q * 16 + (tid & 15)];
    }
    __builtin_amdgcn_sched_barrier(0);
    {
      float4 a = *(const float4*)(A_ + ksl), w = *(const float4*)(W_ + ksl), b = *(const float4*)(B_ + ksl);
      float4 k = *(const float4*)(K_ + ksl), r = *(const float4*)(R_ + ksl);
      float v = V_[rl];
      float opart = 0.f;
#pragma unroll
      for (int tt = 0; tt < 16; ++tt) {
        float4 an, wn, bn, kn, rn;
        float vn;
        if (tt + 1 < 16) {
          an = *(const float4*)(A_ + (tt + 1) * 64 + ksl); wn = *(const float4*)(W_ + (tt + 1) * 64 + ksl);
          bn = *(const float4*)(B_ + (tt + 1) * 64 + ksl); kn = *(const float4*)(K_ + (tt + 1) * 64 + ksl);
          rn = *(const float4*)(R_ + (tt + 1) * 64 + ksl); vn = V_[(tt + 1) * 16 + rl];
        }
        __builtin_amdgcn_sched_barrier(0);
        float sa = fmaf(s0, a.x, fmaf(s1, a.y, fmaf(s2, a.z, s3 * a.w)));
        if (tt > 0) { sum16x2(sa, opart); Oc[ooff + (tt - 1) * ostr] = opart; }
        else sa = sum16(sa);
        s0 = fmaf(s0, w.x, fmaf(sa, b.x, v * k.x)); NOPK(s0);
        s1 = fmaf(s1, w.y, fmaf(sa, b.y, v * k.y)); NOPK(s1);
        s2 = fmaf(s2, w.z, fmaf(sa, b.z, v * k.z)); NOPK(s2);
        s3 = fmaf(s3, w.w, fmaf(sa, b.w, v * k.w)); NOPK(s3);
        opart = fmaf(s0, r.x, fmaf(s1, r.y, fmaf(s2, r.z, s3 * r.w)));
        if (tt == 15) { opart = sum16(opart); Oc[ooff + 15 * ostr] = opart; }
        __builtin_amdgcn_sched_barrier(0);
        if (tt + 1 < 16) { a = an; w = wn; b = bn; k = kn; r = rn; v = vn; }
      }
    }
    __builtin_amdgcn_sched_barrier(0);
    __syncthreads();
  }
  {
    const long m = base + (nblk - 1) * 16 + stt;
    p.ORW[m * 512 + h * 64 + q * 16 + (tid & 15)] = f2bf(O_[((nblk - 1) & 1) * 256 + stt * 16 + (tid & 15)]);
  }
  __syncthreads();
  {
    float* o = p.out + (s < 8 ? O_PRWKV + (((long)l * 8 + s) * 8 + h) * 4096
                              : O_SRWKV + (((long)l * 8 + (s - 8)) * 8 + h) * 4096);
    *(float4*)(o + row * 64 + ksl) = make_float4(s0, s1, s2, s3);
  }
}

__device__ __forceinline__ void scan_hgrn(const Params& p, int l, int s, int h, int q, float* smem) {
  const int tid = opaque_tid(), lane = tid & 63, wid = tid >> 6;
  float* Q_ = smem;
  float* F_ = smem + 2048;
  float* G_ = smem + 4096;
  float* I_ = smem + 6144;
  float* O_ = smem + 6400;
  const int rl = wid * 4 + (lane >> 4);
  const int row = q * 16 + rl;
  const int ksl4 = (lane & 15) * 4;
  const int base = seq_base(s), T = seq_len(s);
  float st[8];
#pragma unroll
  for (int i = 0; i < 8; ++i) st[i] = 0.f;
  if (s >= 8) {
    const float* sp = p.state_hgrn + (((long)l * 8 + (s - 8)) * 4 + h) * 16384;
#pragma unroll
    for (int i = 0; i < 8; ++i) st[i] = sp[((i >> 2) * 64 + ksl4 + (i & 3)) * 128 + row];
  }
  const int stt = tid >> 4, skq = (tid & 15) * 8;
  float lb[8];
#pragma unroll
  for (int i = 0; i < 8; ++i) {
    if (l == 0) lb[i] = 0.f;
    else {
      float x0 = p.hg_lb[h * 128 + skq + i], x1 = p.hg_lb[512 + h * 128 + skq + i];
      lb[i] = frcp_(1.f + __expf(x0 - x1));
    }
  }
  const int nblk = T / 16;
  uint4 q8, f8;
  u16 iv16;
  {
    const u16* pr = p.PROJ + (long)(base + stt) * LDP;
    q8 = *(const uint4*)(pr + C_Q + h * 128 + skq);
    f8 = *(const uint4*)(pr + C_F + h * 128 + skq);
    iv16 = pr[C_I + h * 128 + q * 16 + (tid & 15)];
  }
  __syncthreads();
  float* TR_ = smem + 6400 + 512;
  const bool wr = (lane & 15) == 0;
  const int ooff = wr ? rl : (512 + lane);
  const int ostr = wr ? 16 : 0;
  for (int blk = 0; blk < nblk; ++blk) {
    const long m = base + blk * 16 + stt;
    float* Oc = O_ + (blk & 1) * 256;
    {
      unsigned qw[4] = {q8.x, q8.y, q8.z, q8.w}, fw[4] = {f8.x, f8.y, f8.z, f8.w};
      float qv[8], fv[8], gv[8];
#pragma unroll
      for (int e = 0; e < 8; ++e) {
        qv[e] = bf2f((u16)((qw[e >> 1] >> ((e & 1) * 16)) & 0xffff));
        float fz = bf2f((u16)((fw[e >> 1] >> ((e & 1) * 16)) & 0xffff));
        float ex = __expf(-fz);
        float sg = frcp_(1.f + ex);
        float sgn = ex * sg;
        fv[e] = lb[e] + (1.f - lb[e]) * sg;
        gv[e] = (1.f - lb[e]) * sgn;
      }
      *(float4*)(Q_ + stt * 128 + skq) = make_float4(qv[0], qv[1], qv[2], qv[3]);
      *(float4*)(Q_ + stt * 128 + skq + 4) = make_float4(qv[4], qv[5], qv[6], qv[7]);
      *(float4*)(F_ + stt * 128 + skq) = make_float4(fv[0], fv[1], fv[2], fv[3]);
      *(float4*)(F_ + stt * 128 + skq + 4) = make_float4(fv[4], fv[5], fv[6], fv[7]);
      *(float4*)(G_ + stt * 128 + skq) = make_float4(gv[0], gv[1], gv[2], gv[3]);
      *(float4*)(G_ + stt * 128 + skq + 4) = make_float4(gv[4], gv[5], gv[6], gv[7]);
      I_[stt * 16 + (tid & 15)] = bf2f(iv16);
    }
    __syncthreads();
    if (blk > 0) {
      u16* dp = p.PROJ + (m - 16) * LDP + C_I + h * 128 + q * 16 + (tid & 15);
      *dp = f2bf(O_[((blk - 1) & 1) * 256 + stt * 16 + (tid & 15)]);
    }
    if (blk + 1 < nblk) {
      const u16* pr = p.PROJ + (m + 16) * LDP;
      q8 = *(const uint4*)(pr + C_Q + h * 128 + skq);
      f8 = *(const uint4*)(pr + C_F + h * 128 + skq);
      iv16 = pr[C_I + h * 128 + q * 16 + (tid & 15)];
    }
    __builtin_amdgcn_sched_barrier(0);
    {
      float4 f0 = *(const float4*)(F_ + ksl4), f1 = *(const float4*)(F_ + 64 + ksl4);
      float4 g0 = *(const float4*)(G_ + ksl4), g1 = *(const float4*)(G_ + 64 + ksl4);
      float4 q0 = *(const float4*)(Q_ + ksl4), q1 = *(const float4*)(Q_ + 64 + ksl4);
      float iv = I_[rl];
      float oprev = 0.f;
#pragma unroll
      for (int tt = 0; tt < 16; ++tt) {
        float4 f0n, f1n, g0n, g1n, q0n, q1n;
        float ivn;
        if (tt + 1 < 16) {
          const int o_ = (tt + 1) * 128;
          f0n = *(const float4*)(F_ + o_ + ksl4); f1n = *(const float4*)(F_ + o_ + 64 + ksl4);
          g0n = *(const float4*)(G_ + o_ + ksl4); g1n = *(const float4*)(G_ + o_ + 64 + ksl4);
          q0n = *(const float4*)(Q_ + o_ + ksl4); q1n = *(const float4*)(Q_ + o_ + 64 + ksl4);
          ivn = I_[(tt + 1) * 16 + rl];
        }
        __builtin_amdgcn_sched_barrier(0);
        st[0] = fmaf(st[0], f0.x, g0.x * iv); NOPK(st[0]);
        st[1] = fmaf(st[1], f0.y, g0.y * iv); NOPK(st[1]);
        st[2] = fmaf(st[2], f0.z, g0.z * iv); NOPK(st[2]);
        st[3] = fmaf(st[3], f0.w, g0.w * iv); NOPK(st[3]);
        st[4] = fmaf(st[4], f1.x, g1.x * iv); NOPK(st[4]);
        st[5] = fmaf(st[5], f1.y, g1.y * iv); NOPK(st[5]);
        st[6] = fmaf(st[6], f1.z, g1.z * iv); NOPK(st[6]);
        st[7] = fmaf(st[7], f1.w, g1.w * iv); NOPK(st[7]);
        float acc0 = fmaf(st[0], q0.x, fmaf(st[1], q0.y, fmaf(st[2], q0.z, st[3] * q0.w)));
        float acc1 = fmaf(st[4], q1.x, fmaf(st[5], q1.y, fmaf(st[6], q1.z, st[7] * q1.w)));
        float o = acc0 + acc1;
        if (tt & 1) { sum16x2(oprev, o); Oc[ooff + (tt - 1) * ostr] = oprev; Oc[ooff + tt * ostr] = o; }
        else oprev = o;
        __builtin_amdgcn_sched_barrier(0);
        if (tt + 1 < 16) { f0 = f0n; f1 = f1n; g0 = g0n; g1 = g1n; q0 = q0n; q1 = q1n; iv = ivn; }
      }
    }
    __builtin_amdgcn_sched_barrier(0);
    __syncthreads();
  }
  {
    const long m = base + (nblk - 1) * 16 + stt;
    u16* dp = p.PROJ + m * LDP + C_I + h * 128 + q * 16 + (tid & 15);
    *dp = f2bf(O_[((nblk - 1) & 1) * 256 + stt * 16 + (tid & 15)]);
  }
  __syncthreads();
  {
    float* o = p.out + (s < 8 ? O_PHGRN + (((long)l * 8 + s) * 4 + h) * 16384
                              : O_SHGRN + (((long)l * 8 + (s - 8)) * 4 + h) * 16384);
#pragma unroll
    for (int i = 0; i < 8; ++i) o[((i >> 2) * 64 + ksl4 + (i & 3)) * 128 + row] = st[i];
  }
}

__device__ __forceinline__ void scan_ssd(const Params& p, int l, int s, int h, int q, float* smem) {
  const int tid = opaque_tid(), lane = tid & 63, wid = tid >> 6;
  float* B_ = smem;
  float* C_ = smem + 2048;
  float* X_ = smem + 4096;
  float* O_ = smem + 4352;
  float* DT_ = smem + 5200;
  float* DE_ = smem + 5216;
  const int rl = wid * 4 + (lane >> 4);
  const int row = q * 16 + rl;
  const int ksl4 = (lane & 15) * 4;
  const int g = h >> 2;
  const int base = seq_base(s), T = seq_len(s);
  float st[8];
#pragma unroll
  for (int i = 0; i < 8; ++i) st[i] = 0.f;
  if (s >= 8) {
    const float* sp = p.state_ssm + (((long)l * 8 + (s - 8)) * 8 + h) * 8192 + row * 128 + ksl4;
    float4 a = *(const float4*)sp, b = *(const float4*)(sp + 64);
    st[0] = a.x; st[1] = a.y; st[2] = a.z; st[3] = a.w; st[4] = b.x; st[5] = b.y; st[6] = b.z; st[7] = b.w;
  }
  const int xc_bc = (tid < 128) ? (512 + g * 128 + tid) : (768 + g * 128 + (tid - 128));
  const float* cw = p.conv_w + (long)l * 4 * 1024;
  const float cb0 = cw[xc_bc], cb1 = cw[1024 + xc_bc], cb2 = cw[2048 + xc_bc], cb3 = cw[3072 + xc_bc];
  const float cbb = p.conv_b[l * 1024 + xc_bc];
  float u3 = 0.f, u2 = 0.f, u1 = 0.f;
  const int xc_x = h * 64 + q * 16 + (tid & 15);
  const float cx0 = cw[xc_x], cx1 = cw[1024 + xc_x], cx2 = cw[2048 + xc_x], cx3 = cw[3072 + xc_x];
  const float cxb = p.conv_b[l * 1024 + xc_x];
  float x3 = 0.f, x2 = 0.f, x1 = 0.f;
  if (s >= 8) {
    const float* sc = p.state_conv + ((long)l * 8 + (s - 8)) * 3 * 1024;
    u3 = sc[xc_bc]; u2 = sc[1024 + xc_bc]; u1 = sc[2048 + xc_bc];
    x3 = sc[xc_x]; x2 = sc[1024 + xc_x]; x1 = sc[2048 + xc_x];
  }
  const float dtb = p.dt_bias[l * 8 + h];
  const float aexp = __expf(p.a_log[l * 8 + h]);
  const float dsk = p.d_skip[l * 8 + h];
  const int stt = tid >> 4;
  const int nblk = T / 16;
  u16 raw[16];
  float xr[4];
  float dtr = 0.f;
  u16 zc = 0, zn = 0;
#define SSD_LOAD(M0)                                                              \
  {                                                                               \
    const u16* col = p.PROJ + (long)(M0) * LDP + C_XBC + xc_bc;                   \
    _Pragma("unroll") for (int t = 0; t < 16; ++t) raw[t] = col[(long)t * LDP];   \
    {                                                                             \
      const long mr = (long)(M0) + stt;                                           \
      const u16* colx = p.PROJ + mr * LDP + C_XBC + xc_x;                         \
      _Pragma("unroll") for (int j = 0; j < 4; ++j) {                             \
        const long mm = mr - 3 + j;                                               \
        float vx;                                                                 \
        if (mm >= base) vx = bf2f(colx[(long)(j - 3) * LDP]);                     \
        else vx = (s >= 8) ? p.state_conv[((long)l * 8 + (s - 8)) * 3072 + (3 + (int)(mm - base)) * 1024 + xc_x] : 0.f; \
        xr[j] = vx;                                                               \
      }                                                                           \
    }                                                                             \
    if (tid < 16) dtr = (p.FB + FOFF_DTRAW)[((long)(M0) + tid) * 8 + h];                      \
    zn = p.PROJ[((long)(M0) + stt) * LDP + C_Z + h * 64 + q * 16 + (tid & 15)];   \
  }
#pragma unroll
  for (int t = 0; t < 16; ++t) raw[t] = 0;
  SSD_LOAD(base);
  __syncthreads();
  const bool wr = (lane & 15) == 0;
  const int ooff = wr ? rl : (512 + lane);
  const int ostr = wr ? 16 : 0;
  u16 zp = 0;
  for (int blk = 0; blk < nblk; ++blk) {
    const long m0 = base + blk * 16;
    zp = zc;
    zc = zn;
    float* Oc = O_ + (blk & 1) * 256;
    {
      float* dst = (tid < 128) ? (B_ + tid) : (C_ + (tid - 128));
#pragma unroll
      for (int t = 0; t < 16; ++t) {
        float u0 = bf2f(raw[t]);
        float y = cb0 * u3 + cb1 * u2 + cb2 * u1 + cb3 * u0 + cbb;
        dst[t * 128] = siluf_(y);
        u3 = u2; u2 = u1; u1 = u0;
      }
      {
        float y = cx0 * xr[0] + cx1 * xr[1] + cx2 * xr[2] + cx3 * xr[3] + cxb;
        X_[stt * 16 + (tid & 15)] = siluf_(y);
      }
      if (tid < 16) {
        float dtv = softplusf_(dtr + dtb);
        DT_[tid] = dtv;
        DE_[tid] = __expf(-aexp * dtv);
      }
    }
    __syncthreads();
    if (blk > 0) {
      u16* pz = p.PROJ + (m0 - 16 + stt) * LDP + C_Z + h * 64 + q * 16 + (tid & 15);
      *pz = f2bf(O_[((blk - 1) & 1) * 256 + stt * 16 + (tid & 15)] * siluf_(bf2f(zp)));
    }
    if (blk + 1 < nblk) SSD_LOAD(m0 + 16);
    __builtin_amdgcn_sched_barrier(0);
    {
      float4 b0 = *(const float4*)(B_ + ksl4), b1 = *(const float4*)(B_ + 64 + ksl4);
      float4 c0 = *(const float4*)(C_ + ksl4), c1 = *(const float4*)(C_ + 64 + ksl4);
      float xv = X_[rl], dt = DT_[0], de = DE_[0];
      float yprev = 0.f, xvprev = 0.f;
#pragma unroll
      for (int tt = 0; tt < 16; ++tt) {
        float4 b0n, b1n, c0n, c1n;
        float xvn, dtn, den;
        if (tt + 1 < 16) {
          const int o_ = (tt + 1) * 128;
          b0n = *(const float4*)(B_ + o_ + ksl4); b1n = *(const float4*)(B_ + o_ + 64 + ksl4);
          c0n = *(const float4*)(C_ + o_ + ksl4); c1n = *(const float4*)(C_ + o_ + 64 + ksl4);
          xvn = X_[(tt + 1) * 16 + rl]; dtn = DT_[tt + 1]; den = DE_[tt + 1];
        }
        __builtin_amdgcn_sched_barrier(0);
        const float xd = xv * dt;
        st[0] = fmaf(st[0], de, xd * b0.x); NOPK(st[0]);
        st[1] = fmaf(st[1], de, xd * b0.y); NOPK(st[1]);
        st[2] = fmaf(st[2], de, xd * b0.z); NOPK(st[2]);
        st[3] = fmaf(st[3], de, xd * b0.w); NOPK(st[3]);
        st[4] = fmaf(st[4], de, xd * b1.x); NOPK(st[4]);
        st[5] = fmaf(st[5], de, xd * b1.y); NOPK(st[5]);
        st[6] = fmaf(st[6], de, xd * b1.z); NOPK(st[6]);
        st[7] = fmaf(st[7], de, xd * b1.w); NOPK(st[7]);
        float acc0 = fmaf(st[0], c0.x, fmaf(st[1], c0.y, fmaf(st[2], c0.z, st[3] * c0.w)));
        float acc1 = fmaf(st[4], c1.x, fmaf(st[5], c1.y, fmaf(st[6], c1.z, st[7] * c1.w)));
        float y = acc0 + acc1;
        if (tt & 1) { sum16x2(yprev, y); Oc[ooff + (tt - 1) * ostr] = yprev + dsk * xvprev; Oc[ooff + tt * ostr] = y + dsk * xv; }
        else { yprev = y; xvprev = xv; }
        __builtin_amdgcn_sched_barrier(0);
        if (tt + 1 < 16) { b0 = b0n; b1 = b1n; c0 = c0n; c1 = c1n; xv = xvn; dt = dtn; de = den; }
      }
    }
    __builtin_amdgcn_sched_barrier(0);
    __syncthreads();
  }
  {
    const long m0 = base + (nblk - 1) * 16;
    u16* pz = p.PROJ + (m0 + stt) * LDP + C_Z + h * 64 + q * 16 + (tid & 15);
    *pz = f2bf(O_[((nblk - 1) & 1) * 256 + stt * 16 + (tid & 15)] * siluf_(bf2f(zc)));
  }
  __syncthreads();
#undef SSD_LOAD
  {
    float* o = p.out + (s < 8 ? O_PSSM + (((long)l * 8 + s) * 8 + h) * 8192
                              : O_SSSM + (((long)l * 8 + (s - 8)) * 8 + h) * 8192);
    *(float4*)(o + row * 128 + ksl4) = make_float4(st[0], st[1], st[2], st[3]);
    *(float4*)(o + row * 128 + 64 + ksl4) = make_float4(st[4], st[5], st[6], st[7]);
  }
  if (h == 0 && q == 0) {
    float* o = p.out + (s < 8 ? O_PCONV + ((long)l * 8 + s) * 3072 : O_SCONV + ((long)l * 8 + (s - 8)) * 3072);
    for (int i = tid; i < 3072; i += 256) {
      int r = i >> 10, c = i & 1023;
      o[i] = bf2f(p.PROJ[(long)(base + T - 3 + r) * LDP + C_XBC + c]);
    }
  }
}

__device__ __forceinline__ void phase_scan(const Params& p, int l, float* smem) {
  for (int u = BID, nb_ = NBLK; u < 1536; u += nb_) {
    int sample = u >= 768;
    int v = sample ? u - 768 : u;
    int type = v % 3, w = v / 3;
    if (type == 0) {
      int q = w & 3, h = (w >> 2) & 7, b = w >> 5;
      scan_rwkv(p, l, b + 8 * sample, h, q, smem);
    } else if (type == 1) {
      int q = w & 7, h = (w >> 3) & 3, b = w >> 5;
      scan_hgrn(p, l, b + 8 * sample, h, q, smem);
    } else {
      int q = w & 3, h = (w >> 2) & 7, b = w >> 5;
      scan_ssd(p, l, b + 8 * sample, h, q, smem);
    }
  }
}

__device__ __forceinline__ void phase_post(const Params& p, int l, float* smem) {
  const int tid = opaque_tid(), lane = tid & 63, wid = tid >> 6;
  float* RED = smem;
  constexpr int LDG = 516;
  float* GA = smem + 256;
  for (int blk = BID, nb_ = NBLK; blk < NBLK16; blk += nb_) {
    const long m0 = (long)blk * 16;
    __syncthreads();
    {
      bf16x8 ag[4];
      const u16* arow = p.PROJ + (m0 + (lane & 15)) * LDP + C_XG + (lane >> 4) * 8;
#pragma unroll
      for (int ks = 0; ks < 4; ++ks) ag[ks] = *(const bf16x8*)(arow + ks * 32);
#pragma unroll
      for (int nt = 0; nt < 8; ++nt) {
        const int n = (wid * 8 + nt) * 16 + (lane & 15);
        f32x4v acc = {0.f, 0.f, 0.f, 0.f};
#pragma unroll
        for (int ks = 0; ks < 4; ++ks) {
          bf16x8 bg = *(const bf16x8*)((p.WB + OFF_G2T) + n * 128 + ks * 32 + (lane >> 4) * 8);
          acc = __builtin_amdgcn_mfma_f32_16x16x32_bf16(ag[ks], bg, acc, 0, 0, 0);
        }
#pragma unroll
        for (int r = 0; r < 4; ++r) GA[((lane >> 4) * 4 + r) * LDG + n] = acc[r];
      }
    }
#pragma unroll 1
    for (int c = 0; c < 2; ++c) {
      const int ch = tid + 256 * c, head = wid + 4 * c;
      float ys[16], oh[16];
#pragma unroll
      for (int t = 0; t < 16; ++t) {
        ys[t] = bf2f(p.PROJ[(m0 + t) * LDP + C_Z + ch]);
        oh[t] = bf2f(p.PROJ[(m0 + t) * LDP + C_I + ch]);
      }
#pragma unroll
      for (int t = 0; t < 16; ++t) {
        float a0 = sum64(ys[t] * ys[t]);
        float b0 = sum64(oh[t] * oh[t]);
        if (lane == 0) *(float2*)(RED + (wid * 16 + t) * 2) = make_float2(a0, b0);
      }
      __syncthreads();
      {
        const float nw0 = p.ssd_norm_w[l * 512 + ch];
        const float hw0 = p.hg_norm_w[l * 512 + ch];
        const int pw = (wid >> 1) * 2;
#pragma unroll
        for (int t = 0; t < 16; ++t) {
          float2 r0 = *(const float2*)(RED + (0 * 16 + t) * 2), r1 = *(const float2*)(RED + (1 * 16 + t) * 2);
          float2 r2 = *(const float2*)(RED + (2 * 16 + t) * 2), r3 = *(const float2*)(RED + (3 * 16 + t) * 2);
          float g0 = r0.x + r1.x + r2.x + r3.x;
          float2 pa = *(const float2*)(RED + (pw * 16 + t) * 2), pb = *(const float2*)(RED + ((pw + 1) * 16 + t) * 2);
          float h0 = pa.y + pb.y;
          u16* rowp = p.PROJ + (m0 + t) * LDP;
          rowp[C_Z + ch] = f2bf(ys[t] * rsqrtf(g0 * (1.f / 256.f) + 1e-6f) * nw0);
          float gg0 = bf2f(rowp[C_GG + ch]);
          rowp[C_GG + ch] = f2bf(oh[t] * rsqrtf(h0 * (1.f / 128.f) + 1e-6f) * hw0 * siluf_(gg0));
        }
      }
      {
        float lw = p.rw_lnx_w[l * 512 + ch], lbv = p.rw_lnx_b[l * 512 + ch];
#pragma unroll
        for (int t = 0; t < 16; ++t) {
          float o = bf2f(p.ORW[(m0 + t) * 512 + ch]);
          float mean = sum64(o) * (1.f / 64.f);
          float d = o - mean;
          float var = sum64(d * d) * (1.f / 64.f);
          float ln = d * rsqrtf(var + 64e-5f) * lw + lbv;
          float v = bf2f(p.PROJ[(m0 + t) * LDP + C_V + ch]);
          float bonus = (p.FB + FOFF_RKS)[(m0 + t) * 8 + head] * v;
          p.PROJ[(m0 + t) * LDP + C_R + ch] = f2bf((ln + bonus) * GA[t * LDG + ch]);
        }
      }
      __syncthreads();
    }
  }
}

__device__ __forceinline__ void phase_final(const Params& p) {
  const int tid = opaque_tid(), lane = tid & 63, wid = tid >> 6;
  for (int m = BID * 4 + wid, nb_ = NBLK; m < M_TOT; m += nb_ * 4) {
    float* dst;
    if (m < M_PROMPT) {
      int b = m / T_P, t = m - b * T_P;
      if (t < 16) continue;
      dst = p.out + O_YP + ((long)b * 4096 + (t - 16)) * DM;
    } else {
      dst = p.out + O_YS + (long)(m - M_PROMPT) * DM;
    }
    float x[16];
    float ss = 0.f;
#pragma unroll
    for (int j = 0; j < 2; ++j) {
      uint4 raw = *(const uint4*)(p.XB + (long)m * DM + lane * 8 + 512 * j);
      unsigned wv[4] = {raw.x, raw.y, raw.z, raw.w};
#pragma unroll
      for (int e = 0; e < 8; ++e) {
        x[j * 8 + e] = bf2f((u16)((wv[e >> 1] >> ((e & 1) * 16)) & 0xffff));
        ss += x[j * 8 + e] * x[j * 8 + e];
      }
    }
    ss = sum64(ss);
    float rs = rsqrtf(ss * (1.f / 1024.f) + 1e-6f);
#pragma unroll
    for (int j = 0; j < 2; ++j) {
      int k0 = lane * 8 + 512 * j;
      float4 w0 = *(const float4*)(p.final_w + k0), w1 = *(const float4*)(p.final_w + k0 + 4);
      *(float4*)(dst + k0) = make_float4(x[j * 8 + 0] * rs * w0.x, x[j * 8 + 1] * rs * w0.y, x[j * 8 + 2] * rs * w0.z,
                                         x[j * 8 + 3] * rs * w0.w);
      *(float4*)(dst + k0 + 4) = make_float4(x[j * 8 + 4] * rs * w1.x, x[j * 8 + 5] * rs * w1.y,
                                             x[j * 8 + 6] * rs * w1.z, x[j * 8 + 7] * rs * w1.w);
    }
  }
}


#define XB_TMO      128
#define XB_XCNT(j)  (256  + 64 * (j))
#define XB_XSUB(j)  (1280 + 64 * (j))
#define XB_XGEN(j)  (2304 + 64 * (j))
#define XB_TOP      3328
#define XB_TOPGEN   3392
#define XCD_BAR_WORDS 3456
#define XB_SPIN_CAP (1u << 22)
__device__ __forceinline__ unsigned xb_ld(unsigned* p) { return __hip_atomic_load(p, __ATOMIC_RELAXED, __HIP_MEMORY_SCOPE_AGENT); }
__device__ __forceinline__ unsigned xb_add(unsigned* p, unsigned v) { return __hip_atomic_fetch_add(p, v, __ATOMIC_RELAXED, __HIP_MEMORY_SCOPE_AGENT); }
__device__ __forceinline__ unsigned xb_xcc_id() { return (unsigned)__builtin_amdgcn_s_getreg((3 << 11) | 20) & 0xFu; }
#define XB_SPIN(cond, bar) do { unsigned _sp = 0; while (cond) { __builtin_amdgcn_s_sleep(1); \
    if ((++_sp & 255u) == 0u) { if (xb_ld(&(bar)[XB_TMO])) break; if (_sp > XB_SPIN_CAP) { atomicAdd(&(bar)[XB_TMO], 1u); break; } } } } while (0)

__device__ __forceinline__ void xcd_barrier_post(unsigned* bar) {
  if (threadIdx.x == 0) (void)xb_add(&bar[XB_XCNT(xb_xcc_id())], 1u);
}
__device__ __forceinline__ void xcd_barrier_complete(unsigned* bar, unsigned x, unsigned& nloc, unsigned& nx) {
  const unsigned G = gridDim.x;
  unsigned sum, cnt, mine, sp = 0u;
  for (;;) {
    sum = 0u; cnt = 0u; mine = 0u;
#pragma unroll
    for (unsigned j = 0; j < 16; ++j) { const unsigned c = xb_ld(&bar[XB_XCNT(j)]); sum += c; cnt += (c > 0u) ? 1u : 0u; mine = (j == x) ? c : mine; }
    if (sum == G) break;
    __builtin_amdgcn_s_sleep(1);
    if ((++sp & 255u) == 0u) { if (xb_ld(&bar[XB_TMO])) break; if (sp > XB_SPIN_CAP) { atomicAdd(&bar[XB_TMO], 1u); break; } }
  }
  nloc = mine > 0u ? mine : 1u; nx = cnt > 0u ? cnt : 1u;
}
__device__ __forceinline__ void xcd_barrier(unsigned* bar, volatile unsigned* st) {
  asm volatile("s_waitcnt vmcnt(0)" ::: "memory");
  __syncthreads();
  if (threadIdx.x == 0) {
    __builtin_amdgcn_s_waitcnt(0);
    const unsigned x = xb_xcc_id();
    unsigned nloc = st[0], nx = st[1];
    if (nloc == 0u) { xcd_barrier_complete(bar, x, nloc, nx); st[0] = nloc; st[1] = nx; }
    const unsigned old = xb_add(&bar[XB_XSUB(x)], 1u);
    const unsigned gen = old / nloc;
    if (old + 1u == (gen + 1u) * nloc) {
      __builtin_amdgcn_fence(__ATOMIC_RELEASE, "agent");
      asm volatile("s_waitcnt vmcnt(0)" ::: "memory");
      const unsigned og = xb_add(&bar[XB_TOP], 1u);
      const unsigned tg = og / nx;
      if (og + 1u == (tg + 1u) * nx) xb_add(&bar[XB_TOPGEN], 1u);
      else XB_SPIN(xb_ld(&bar[XB_TOPGEN]) == tg, bar);
      __builtin_amdgcn_fence(__ATOMIC_ACQUIRE, "agent");
      xb_add(&bar[XB_XGEN(x)], 1u);
      asm volatile("s_waitcnt vmcnt(0)" ::: "memory");
    } else {
      XB_SPIN(xb_ld(&bar[XB_XGEN(x)]) == gen, bar);
      __builtin_amdgcn_fence(__ATOMIC_ACQUIRE, "agent");
      asm volatile("s_waitcnt vmcnt(0)" ::: "memory");
    }
  }
  __syncthreads();
}

constexpr int SMEM_BYTES = 40960;
__device__ __forceinline__ void run_phase(const Params& p, int ph, char* smem) {
  if (ph == 0) { phase_embed(p); return; }
  if (ph == 19) { phase_final(p); return; }
  int l = (ph - 1) / 9, s = (ph - 1) % 9;
  float* fs = (float*)smem;
  switch (s) {
    case 0: phase_convert(p, l, fs); phase_rowstat<true>(p, l, fs); break;
    case 1: phase_gemm<1>(p, p.XB, DM, (p.WB + OFF_W1T), 1024, LDP / 128, smem); break;
    case 2: phase_pre(p, l, fs); break;
    case 3: phase_scan(p, l, fs); break;
    case 4: phase_post(p, l, fs); break;
    case 5: phase_gemm<2>(p, p.PROJ, LDP, (p.WB + OFF_WOT), 1536, 8, smem); break;
    case 6: phase_rowstat<false>(p, l, fs); break;
    case 7: phase_gemm<3>(p, p.XB, DM, (p.WB + OFF_WGU), 1024, 44, smem); break;
    case 8: phase_gemm<2>(p, p.PROJ, D_FF, (p.WB + OFF_WDT), D_FF, 8, smem); break;
  }
}
constexpr int N_PHASES = 20;

#if MEGA
__global__ void __launch_bounds__(256, 3) k_mega(Params p) {
  __shared__ __attribute__((aligned(16))) char smem[SMEM_BYTES];
  __shared__ uint4 xb_words;
  if (threadIdx.x == 0) { xb_words = make_uint4(0u, 0u, 0u, 0u); }
  __syncthreads();
  cg::grid_group grid = cg::this_grid();
  float* fs = (float*)smem;
  volatile unsigned* xst = (volatile unsigned*)&xb_words;
  xcd_barrier_post(p.bar);
  phase_embed(p);
  grid.sync();
#define GSYNC() do { unsigned* b_ = p.bar; asm volatile("" : "+s"(b_)); xcd_barrier(b_, xst); } while (0)
#pragma unroll 1
  for (int l0 = 0; l0 < 2; ++l0) {
    int l = opaque_s(l0);
    phase_convert(p, l, fs);
    phase_rowstat<true>(p, l, fs);
    GSYNC();
    l = opaque_s(l);
    phase_gemm<1>(p, p.XB, DM, (p.WB + OFF_W1T), 1024, LDP / 128, smem);
    GSYNC();
    l = opaque_s(l);
    phase_pre(p, l, fs);
    GSYNC();
    l = opaque_s(l);
    phase_scan(p, l, fs);
    GSYNC();
    l = opaque_s(l);
    phase_post(p, l, fs);
    GSYNC();
    l = opaque_s(l);
    phase_gemm<2>(p, p.PROJ, LDP, (p.WB + OFF_WOT), 1536, 8, smem);
    GSYNC();
    l = opaque_s(l);
    phase_rowstat<false>(p, l, fs);
    GSYNC();
    l = opaque_s(l);
    phase_gemm<3>(p, p.XB, DM, (p.WB + OFF_WGU), 1024, 44, smem);
    GSYNC();
    l = opaque_s(l);
    phase_gemm<2>(p, p.PROJ, D_FF, (p.WB + OFF_WDT), D_FF, 8, smem);
    GSYNC();
  }
  phase_final(p);
}
#else
template <int PH>
__global__ void __launch_bounds__(256, 3) k_phase(Params p) {
  __shared__ __attribute__((aligned(16))) char smem[SMEM_BYTES];
  run_phase(p, PH, smem);
}
template <int PH>
static void launch_all(const Params& p, int grid, hipStream_t stream) {
  hipLaunchKernelGGL(k_phase<PH>, dim3(grid), dim3(256), 0, stream, p);
  if constexpr (PH + 1 < N_PHASES) launch_all<PH + 1>(p, grid, stream);
}
#endif

extern "C" void kernel_launch(void* const* d_in, const int* in_sizes, int n_in, void* d_out, int out_size, void* d_ws,
                              size_t ws_size, hipStream_t stream) {
  Params p{};
  const float** pf = (const float**)&p;
  for (int i = 0; i < 35; ++i) pf[i] = (const float*)d_in[i];
  p.out = (float*)d_out;
  char* ws = (char*)d_ws;
  size_t off = 0;
  auto take = [&](size_t bytes) { char* r = ws + off; off += (bytes + 255) & ~(size_t)255; return r; };
  p.XB = (u16*)take((size_t)M_TOT * DM * 2);
  p.PROJ = (u16*)take((size_t)M_TOT * LDP * 2);
  p.WB = (u16*)take((size_t)WB_TOTAL * 2);
  p.BND = (u16*)take((size_t)NBLK16 * 1792 * 2);
  p.ORW = (u16*)take((size_t)M_TOT * 512 * 2);
  p.FB = (float*)take((size_t)FB_TOTAL * 4);
  p.bar = (unsigned*)take((size_t)XCD_BAR_WORDS * 4);
  p.RWX = (u16*)d_out;
  if (off > ws_size) fprintf(stderr, "workspace too small: need %zu have %zu\n", off, ws_size);
#if MEGA
  static int grid_blocks = 0;
  if (!grid_blocks) {
    int dev = 0, cus = 0, per_cu = 0;
    hipGetDevice(&dev);
    hipDeviceGetAttribute(&cus, hipDeviceAttributeMultiprocessorCount, dev);
    hipOccupancyMaxActiveBlocksPerMultiprocessor(&per_cu, k_mega, 256, 0);
    if (per_cu > 3) per_cu = 3;
    grid_blocks = cus * per_cu;
  }
  hipMemsetAsync(p.bar, 0, (size_t)XCD_BAR_WORDS * 4, stream);
  void* args[] = {&p};
  hipError_t e = hipLaunchCooperativeKernel((void*)k_mega, dim3(grid_blocks), dim3(256), args, 0, stream);
  if (e != hipSuccess) fprintf(stderr, "cooperative launch failed: %s (grid %d)\n", hipGetErrorString(e), grid_blocks);
#else
  launch_all<0>(p, 768, stream);
#endif
}
```

```cpp
#include <hip/hip_runtime.h>
#include <hip/hip_bf16.h>
#include <hip/hip_cooperative_groups.h>
#include <cstdio>
namespace cg = cooperative_groups;

#ifndef MEGA
#define MEGA 1
#endif

typedef unsigned short u16;
using bf16x8 = __attribute__((ext_vector_type(8))) short;
using f32x16 = __attribute__((ext_vector_type(16))) float;
using f32x4v = __attribute__((ext_vector_type(4))) float;

constexpr int DM = 1024;
constexpr int M_TOT = 33408;
constexpr int M_PROMPT = 32896;
constexpr int T_P = 4112;
constexpr int LDP = 5376;
constexpr int N_IN = 5384;
constexpr int D_FF = 2816;
constexpr int NBLK16 = M_TOT / 16;
constexpr int C_Z = 0, C_R = 512, C_GG = 1024, C_XBC = 1536, C_K = 2560, C_V = 3072, C_XW = 3584, C_XA = 3648,
              C_XG = 3712, C_Q = 3840, C_F = 4352, C_I = 4864;
constexpr long O_YP = 0, O_YS = 33554432, O_PSSM = 34078720, O_PCONV = 35127296, O_PRWKV = 35176448,
               O_PSHIFT = 35700736, O_PHGRN = 35729408, O_SSSM = 36777984, O_SCONV = 37826560,
               O_SRWKV = 37875712, O_SSHIFT = 38400000, O_SHGRN = 38428672;

constexpr long OFF_W1T = 0, OFF_WOT = 5505024, OFF_WGU = 7077888, OFF_WDT = 12845056, OFF_W2T = 15728640, OFF_A2T = 15761408, OFF_G2T = 15794176, WB_TOTAL = 15859712;
constexpr long FOFF_RS = 0, FOFF_DTRAW = 33408, FOFF_RKS = 300672, FB_TOTAL = 567936;
struct Params {
  const float *x_prompt, *x_sample, *state_ssm, *state_conv, *state_rwkv, *state_shift, *state_hgrn, *meta,
      *norm1_w, *w_in, *conv_w, *conv_b, *dt_bias, *a_log, *d_skip, *ssd_norm_w, *rw_mu, *rw_w0, *rw_w2, *rw_a0,
      *rw_a2, *rw_g2, *rw_kk, *rw_ka, *rw_rk, *rw_lnx_w, *rw_lnx_b, *hg_lb, *hg_norm_w, *w_out, *norm2_w, *w_gate,
      *w_up, *w_down, *final_w;
  float* out;
  u16 *XB, *PROJ, *WB, *BND, *ORW, *RWX;
  float *FB;
  unsigned* bar;
};

__device__ __forceinline__ u16 f2bf(float f) {
  unsigned u = __float_as_uint(f);
  u += 0x7fffu + ((u >> 16) & 1u);
  return (u16)(u >> 16);
}
__device__ __forceinline__ float bf2f(u16 h) { return __uint_as_float(((unsigned)h) << 16); }
__device__ __forceinline__ float frcp_(float x) { return __builtin_amdgcn_rcpf(x); }
__device__ __forceinline__ float sigmoidf_(float x) { return frcp_(1.f + __expf(-x)); }
__device__ __forceinline__ float siluf_(float x) { return x * frcp_(1.f + __expf(-x)); }
__device__ __forceinline__ float softplusf_(float x) { return x > 20.f ? x : log1pf(__expf(x)); }

template <int CTRL>
__device__ __forceinline__ float dppf(float v) {
  return __int_as_float(__builtin_amdgcn_update_dpp(0, __float_as_int(v), CTRL, 0xF, 0xF, true));
}
__device__ __forceinline__ float sum16(float v) {
  v += dppf<0xB1>(v);
  v += dppf<0x4E>(v);
  v += dppf<0x141>(v);
  v += dppf<0x140>(v);
  return v;
}
__device__ __forceinline__ void sum16x2(float& a, float& b) {
  a += dppf<0xB1>(a); b += dppf<0xB1>(b);
  a += dppf<0x4E>(a); b += dppf<0x4E>(b);
  a += dppf<0x141>(a); b += dppf<0x141>(b);
  a += dppf<0x140>(a); b += dppf<0x140>(b);
}
__device__ __forceinline__ float sum64(float v) {
  v = sum16(v);
  v += __shfl_xor(v, 16);
  v += __shfl_xor(v, 32);
  return v;
}

#define NOPK(x) asm("" : "+v"(x))
__device__ __forceinline__ int opaque_tid() {
  int t = threadIdx.x;
  asm volatile("" : "+v"(t));
  return t;
}
__device__ __forceinline__ int opaque_s(int v) {
  asm volatile("" : "+s"(v));
  return v;
}
#define BID opaque_s((int)blockIdx.x)
#define NBLK opaque_s((int)gridDim.x)
__device__ __forceinline__ int seq_base(int s) { return s < 8 ? s * T_P : M_PROMPT + (s - 8) * 64; }
__device__ __forceinline__ int seq_len(int s) { return s < 8 ? T_P : 64; }

__device__ __forceinline__ void phase_embed(const Params& p) {
  const long n4 = (long)M_TOT * 256;
  for (long idx = (long)BID * 256 + threadIdx.x, st_ = (long)NBLK * 256; idx < n4; idx += st_) {
    int m = (int)(idx >> 8), c4 = ((int)idx & 255) * 4;
    const float* src;
    if (m < M_PROMPT) {
      int b = m / T_P, t = m - b * T_P;
      src = (t < 16) ? p.meta + (long)t * DM : p.x_prompt + ((long)b * 4096 + (t - 16)) * DM;
    } else {
      src = p.x_sample + (long)(m - M_PROMPT) * DM;
    }
    float4 v = *(const float4*)(src + c4);
    ushort4 o;
    o.x = f2bf(v.x); o.y = f2bf(v.y); o.z = f2bf(v.z); o.w = f2bf(v.w);
    *(ushort4*)(p.XB + (long)m * DM + c4) = o;
  }
}

template <bool HAS_SCALE>
__device__ __forceinline__ void conv_tile(const float* __restrict__ src, int ldsrc, int srccol0, const float* __restrict__ scale,
                          u16* __restrict__ dst, int K, int k0, int n0, float* tile  ) {
  const int tid = opaque_tid();
  __syncthreads();
  {
    int nn = tid & 63, kb = tid >> 6;
#pragma unroll
    for (int i = 0; i < 16; ++i) {
      int kk = kb + 4 * i;
      float v = src[(long)(k0 + kk) * ldsrc + srccol0 + nn];
      if (HAS_SCALE) v *= scale[k0 + kk];
      tile[kk * 65 + nn] = v;
    }
  }
  __syncthreads();
  {
    int nn = tid >> 2, kq = (tid & 3) * 16;
    u16* d = dst + (long)(n0 + nn) * K + k0 + kq;
#pragma unroll
    for (int j = 0; j < 16; j += 2) {
      unsigned w = f2bf(tile[(kq + j) * 65 + nn]) | ((unsigned)f2bf(tile[(kq + j + 1) * 65 + nn]) << 16);
      *(unsigned*)(d + j) = w;
    }
  }
}

__device__ __forceinline__ int w1_srccol(int n0) {
  if (n0 < 512) return n0;
  if (n0 < 1024) return n0 - 512 + 1544;
  if (n0 < 1536) return n0 - 1024 + 4872;
  if (n0 < 2560) return n0 - 1536 + 512;
  if (n0 < 3840) return n0 - 2560 + 2056;
  return n0 - 3840 + 3336;
}

constexpr int CV_W1 = 16 * 84, CV_WO = 24 * 16, CV_WGU = 16 * 88, CV_WD = 44 * 16;
constexpr int CV_LORA = 32;
constexpr int CV_TOTAL = CV_W1 + CV_WO + CV_WGU + CV_WD + CV_LORA;

__device__ __forceinline__ void phase_convert(const Params& p, int l, float* smem) {
  for (int u = BID, nb_ = NBLK; u < CV_TOTAL; u += nb_) {
    if (u < CV_W1) {
      int kt = u % 16, nt = u / 16;
      conv_tile<true>(p.w_in + (long)l * DM * N_IN, N_IN, w1_srccol(nt * 64), p.norm1_w + l * DM, (p.WB + OFF_W1T), 1024, kt * 64,
                nt * 64, smem);
    } else if (u < CV_W1 + CV_WO) {
      int v = u - CV_W1;
      int kt = v % 24, nt = v / 24;
      conv_tile<false>(p.w_out + (long)l * 1536 * DM, DM, nt * 64, nullptr, (p.WB + OFF_WOT), 1536, kt * 64, nt * 64, smem);
    } else if (u < CV_W1 + CV_WO + CV_WGU) {
      int v = u - CV_W1 - CV_WO;
      int kt = v % 16, nt = v / 16;
      const float* wg = p.w_gate + (long)l * DM * D_FF;
      const float* wu = p.w_up + (long)l * DM * D_FF;
      const float* sc = p.norm2_w + l * DM;
      const int tid = opaque_tid();
      __syncthreads();
      {
        int nn = tid & 63, kb = tid >> 6;
        const float* src = (nn < 32) ? wg : wu;
        int col = nt * 32 + (nn & 31);
#pragma unroll
        for (int i = 0; i < 16; ++i) {
          int kk = kb + 4 * i;
          smem[kk * 65 + nn] = src[(long)(kt * 64 + kk) * D_FF + col] * sc[kt * 64 + kk];
        }
      }
      __syncthreads();
      {
        int nn = tid >> 2, kq = (tid & 3) * 16;
        u16* d = (p.WB + OFF_WGU) + (long)(nt * 64 + nn) * 1024 + kt * 64 + kq;
#pragma unroll
        for (int j = 0; j < 16; j += 2) {
          unsigned w = f2bf(smem[(kq + j) * 65 + nn]) | ((unsigned)f2bf(smem[(kq + j + 1) * 65 + nn]) << 16);
          *(unsigned*)(d + j) = w;
        }
      }
    } else if (u >= CV_W1 + CV_WO + CV_WGU + CV_WD) {
      int v = u - (CV_W1 + CV_WO + CV_WGU + CV_WD);
      const int tid = opaque_tid();
#pragma unroll 4
      for (int i = 0; i < 16; ++i) {
        int e = v * 4096 + i * 256 + tid;
        if (e < 32768) {
          int n = e >> 6, k = e & 63;
          (p.WB + OFF_W2T)[e] = f2bf(p.rw_w2[(long)l * 64 * 512 + k * 512 + n]);
        } else if (e < 65536) {
          int e2 = e - 32768, n = e2 >> 6, k = e2 & 63;
          (p.WB + OFF_A2T)[e2] = f2bf(p.rw_a2[(long)l * 64 * 512 + k * 512 + n]);
        } else {
          int e2 = e - 65536, n = e2 >> 7, k = e2 & 127;
          (p.WB + OFF_G2T)[e2] = f2bf(p.rw_g2[(long)l * 128 * 512 + k * 512 + n]);
        }
      }
    } else {
      int v = u - CV_W1 - CV_WO - CV_WGU;
      int kt = v % 44, nt = v / 44;
      conv_tile<false>(p.w_down + (long)l * D_FF * DM, DM, nt * 64, nullptr, (p.WB + OFF_WDT), D_FF, kt * 64, nt * 64, smem);
    }
  }
}

template <bool WITH_DT>
__device__ __forceinline__ void phase_rowstat(const Params& p, int l, float* smem) {
  const int tid = opaque_tid(), lane = tid & 63, wid = tid >> 6;
  float* dtw = smem;
  if (WITH_DT) {
    __syncthreads();
    const float* w = p.w_in + (long)l * DM * N_IN + 1536;
    const float* nw = p.norm1_w + l * DM;
    for (int i = tid; i < 8192; i += 256) {
      int k = i >> 3, h = i & 7;
      dtw[i] = w[(long)k * N_IN + h] * nw[k];
    }
    __syncthreads();
  }
  for (int blk = BID, nb_ = NBLK; blk < NBLK16; blk += nb_) {
    for (int rr = wid; rr < 16; rr += 4) {
      int m = blk * 16 + rr;
      float ss = 0.f;
      float d[8];
#pragma unroll
      for (int h = 0; h < 8; ++h) d[h] = 0.f;
#pragma unroll 1
      for (int j = 0; j < 4; ++j) {
        int k0 = lane * 4 + 256 * j;
        uint2 raw = *(const uint2*)(p.XB + (long)m * DM + k0);
        float xs[4] = {bf2f((u16)(raw.x & 0xffff)), bf2f((u16)(raw.x >> 16)), bf2f((u16)(raw.y & 0xffff)),
                       bf2f((u16)(raw.y >> 16))};
#pragma unroll
        for (int e = 0; e < 4; ++e) {
          float x = xs[e];
          ss += x * x;
          if (WITH_DT) {
            float4 w0 = *(const float4*)(dtw + (k0 + e) * 8);
            float4 w1 = *(const float4*)(dtw + (k0 + e) * 8 + 4);
            d[0] += x * w0.x; d[1] += x * w0.y; d[2] += x * w0.z; d[3] += x * w0.w;
            d[4] += x * w1.x; d[5] += x * w1.y; d[6] += x * w1.z; d[7] += x * w1.w;
          }
        }
      }
      ss = sum64(ss);
      float rs = rsqrtf(ss * (1.f / 1024.f) + 1e-6f);
      if (WITH_DT) {
#pragma unroll
        for (int h = 0; h < 8; ++h) d[h] = sum64(d[h]);
        if (lane == 0) {
#pragma unroll
          for (int h = 0; h < 8; ++h) (p.FB + FOFF_DTRAW)[(long)m * 8 + h] = d[h] * rs;
        }
      }
      if (lane == 0) (p.FB + FOFF_RS)[m] = rs;
    }
  }
}

constexpr int G_BK = 32, G_LDS_ROW = 80;
constexpr int G_OPER_BYTES = 128 * G_LDS_ROW;
template <int MODE>
__device__ __forceinline__ void phase_gemm(const Params& p, const u16* __restrict__ A, int lda, const u16* __restrict__ Bt, int K,
                           int nN, char* smem) {
  const int tid = opaque_tid(), lane = tid & 63, wid = tid >> 6, wm = wid >> 1, wn = wid & 1;
  const int nM = M_TOT / 128;
  const int ntiles = nM * nN;
  const int nk = K / G_BK;
  const int lrow = tid >> 2, lkc = tid & 3;
  for (int tile = BID, nb_ = NBLK; tile < ntiles; tile += nb_) {
    constexpr int GM = 32;
    int grp = tile / (GM * nN);
    int first_m = grp * GM;
    int gsz = min(GM, nM - first_m);
    int rem = tile - grp * GM * nN;
    int pm = first_m + rem % gsz, pn = rem / gsz;
    const u16* gA = A + (long)(pm * 128 + lrow) * lda + lkc * 8;
    const u16* gB = Bt + (long)(pn * 128 + lrow) * K + lkc * 8;
    f32x16 acc[2][2];
#pragma unroll
    for (int i = 0; i < 2; ++i)
#pragma unroll
      for (int j = 0; j < 2; ++j)
#pragma unroll
        for (int r = 0; r < 16; ++r) acc[i][j][r] = 0.f;
    uint4 xa0, xa1, xb0, xb1, ya0, ya1, yb0, yb1;
#define G_LOAD(S, KT)                                                  \
  {                                                                    \
    S##a0 = *(const uint4*)(gA + (KT) * G_BK);                         \
    S##a1 = *(const uint4*)(gA + (long)64 * lda + (KT) * G_BK);        \
    S##b0 = *(const uint4*)(gB + (KT) * G_BK);                         \
    S##b1 = *(const uint4*)(gB + (long)64 * K + (KT) * G_BK);          \
  }
#define G_STORE(S, BUF)                                                \
  {                                                                    \
    char* dA = smem + (BUF) * 2 * G_OPER_BYTES;                        \
    char* dB = dA + G_OPER_BYTES;                                      \
    *(uint4*)(dA + lrow * G_LDS_ROW + lkc * 16) = S##a0;               \
    *(uint4*)(dA + (lrow + 64) * G_LDS_ROW + lkc * 16) = S##a1;        \
    *(uint4*)(dB + lrow * G_LDS_ROW + lkc * 16) = S##b0;               \
    *(uint4*)(dB + (lrow + 64) * G_LDS_ROW + lkc * 16) = S##b1;        \
  }
#define G_COMPUTE(BUF)                                                                           \
  {                                                                                              \
    const char* sA = smem + (BUF) * 2 * G_OPER_BYTES;                                            \
    const char* sB = sA + G_OPER_BYTES;                                                          \
    _Pragma("unroll") for (int ks = 0; ks < 2; ++ks) {                                           \
      bf16x8 af[2], bfr[2];                                                                      \
      const int koff = (ks * 16 + (lane >> 5) * 8) * 2;                                          \
      _Pragma("unroll") for (int i = 0; i < 2; ++i)                                              \
        af[i] = *(const bf16x8*)(sA + (wm * 64 + i * 32 + (lane & 31)) * G_LDS_ROW + koff);      \
      _Pragma("unroll") for (int j = 0; j < 2; ++j)                                              \
        bfr[j] = *(const bf16x8*)(sB + (wn * 64 + j * 32 + (lane & 31)) * G_LDS_ROW + koff);     \
      __builtin_amdgcn_s_setprio(1);                                                             \
      _Pragma("unroll") for (int i = 0; i < 2; ++i)                                              \
        _Pragma("unroll") for (int j = 0; j < 2; ++j)                                            \
          acc[i][j] = __builtin_amdgcn_mfma_f32_32x32x16_bf16(af[i], bfr[j], acc[i][j], 0, 0, 0); \
      __builtin_amdgcn_s_setprio(0);                                                             \
    }                                                                                            \
  }
    G_LOAD(x, 0);
    G_LOAD(y, 1);
    __builtin_amdgcn_sched_barrier(0);
    __syncthreads();
    G_STORE(x, 0);
    __syncthreads();
    for (int kt = 0; kt < nk; kt += 2) {
      if (kt + 2 < nk) G_LOAD(x, kt + 2);
      __builtin_amdgcn_sched_barrier(0);
      G_COMPUTE(0);
      __builtin_amdgcn_sched_barrier(0);
      G_STORE(y, 1);
      __syncthreads();
      if (kt + 3 < nk) G_LOAD(y, kt + 3);
      __builtin_amdgcn_sched_barrier(0);
      G_COMPUTE(1);
      __builtin_amdgcn_sched_barrier(0);
      if (kt + 2 < nk) G_STORE(x, 0);
      __syncthreads();
    }
#undef G_LOAD
#undef G_STORE
#undef G_COMPUTE
    const int colb = pn * 128 + wn * 64 + (lane & 31);
    const int rowb = pm * 128 + wm * 64 + 4 * (lane >> 5);
    if (MODE == 1) {
#pragma unroll
      for (int i = 0; i < 2; ++i)
#pragma unroll
        for (int r = 0; r < 16; ++r) {
          int row = rowb + i * 32 + (r & 3) + 8 * (r >> 2);
          float rs = (p.FB + FOFF_RS)[row];
#pragma unroll
          for (int j = 0; j < 2; ++j) {
            int col = colb + j * 32;
            u16 v = f2bf(acc[i][j][r] * rs);
            p.PROJ[(long)row * LDP + col] = v;
            if ((row & 15) == 15) {
              int jj = -1;
              if (col >= C_R && col < C_GG) jj = col - C_R;
              else if (col >= C_K && col < C_Q) jj = col - C_K + 512;
              if (jj >= 0) p.BND[(long)(row >> 4) * 1792 + jj] = v;
            }
          }
        }
    } else if (MODE == 2) {
#pragma unroll
      for (int i = 0; i < 2; ++i)
#pragma unroll
        for (int r = 0; r < 16; ++r) {
          int row = rowb + i * 32 + (r & 3) + 8 * (r >> 2);
#pragma unroll
          for (int j = 0; j < 2; ++j) {
            int col = colb + j * 32;
            u16* px = p.XB + (long)row * DM + col;
            *px = f2bf(bf2f(*px) + acc[i][j][r]);
          }
        }
    } else {
      const int cact = pn * 64 + wn * 32 + (lane & 31);
      u16* ACT = p.PROJ;
#pragma unroll
      for (int i = 0; i < 2; ++i)
#pragma unroll
        for (int r = 0; r < 16; ++r) {
          int row = rowb + i * 32 + (r & 3) + 8 * (r >> 2);
          float rs = (p.FB + FOFF_RS)[row];
          float g = acc[i][0][r] * rs, u = acc[i][1][r] * rs;
          ACT[(long)row * D_FF + cact] = f2bf(siluf_(g) * u);
        }
    }
  }
}

__device__ __forceinline__ void phase_pre(const Params& p, int l, float* smem) {
  const int tid = opaque_tid(), lane = tid & 63, wid = tid >> 6;
  u16* XWb = (u16*)smem;
  u16* XAb = (u16*)smem + 16 * 72;
  constexpr int LDW = 260;
  float* AW = smem + 1152;
  float* AA = smem + 1152 + 16 * LDW;
  const float* mu = p.rw_mu + l * 1792;
  for (int blk = BID, nb_ = NBLK; blk < NBLK16; blk += nb_) {
    const int m0 = blk * 16;
    int s, t0;
    if (m0 < M_PROMPT) { s = m0 / T_P; t0 = m0 - s * T_P; } else { s = 8 + (m0 - M_PROMPT) / 64; t0 = (m0 - M_PROMPT) & 63; }
    const bool first = (t0 == 0);
    auto prev_of = [&](int j) -> float {
      if (!first) return bf2f(p.BND[(long)(blk - 1) * 1792 + j]);
      if (s < 8) return 0.f;
      return p.state_shift[((long)l * 8 + (s - 8)) * 1792 + j];
    };
    __syncthreads();
    {
      int j = 1536 + tid;
      float mj = mu[j];
      float pv = prev_of(j);
      u16* col = p.PROJ + (long)m0 * LDP + C_XW + tid;
#pragma unroll
      for (int t = 0; t < 16; ++t) {
        float x = bf2f(col[(long)t * LDP]);
        float sh = x + (pv - x) * mj;
        pv = x;
        if (tid < 64) XWb[t * 72 + tid] = f2bf(tanhf(sh));
        else if (tid < 128) XAb[t * 72 + (tid - 64)] = f2bf(sh);
        else col[(long)t * LDP] = f2bf(sigmoidf_(sh));
      }
    }
    __syncthreads();
#pragma unroll 1
    for (int c = 0; c < 2; ++c) {
      const int ch = tid + 256 * c;
      const int head = wid + 4 * c;
      float aw[16], aa[16];
      {
        bf16x8 axw[2], axa[2];
#pragma unroll
        for (int ks = 0; ks < 2; ++ks) {
          axw[ks] = *(const bf16x8*)(XWb + (lane & 15) * 72 + ks * 32 + (lane >> 4) * 8);
          axa[ks] = *(const bf16x8*)(XAb + (lane & 15) * 72 + ks * 32 + (lane >> 4) * 8);
        }
#pragma unroll
        for (int nt = 0; nt < 4; ++nt) {
          const int ncol = (wid * 4 + nt) * 16 + (lane & 15);
          const int n = c * 256 + ncol;
          f32x4v accw = {0.f, 0.f, 0.f, 0.f}, acca = {0.f, 0.f, 0.f, 0.f};
#pragma unroll
          for (int ks = 0; ks < 2; ++ks) {
            bf16x8 bw = *(const bf16x8*)((p.WB + OFF_W2T) + n * 64 + ks * 32 + (lane >> 4) * 8);
            bf16x8 ba = *(const bf16x8*)((p.WB + OFF_A2T) + n * 64 + ks * 32 + (lane >> 4) * 8);
            accw = __builtin_amdgcn_mfma_f32_16x16x32_bf16(axw[ks], bw, accw, 0, 0, 0);
            acca = __builtin_amdgcn_mfma_f32_16x16x32_bf16(axa[ks], ba, acca, 0, 0, 0);
          }
#pragma unroll
          for (int r = 0; r < 4; ++r) {
            AW[((lane >> 4) * 4 + r) * LDW + ncol] = accw[r];
            AA[((lane >> 4) * 4 + r) * LDW + ncol] = acca[r];
          }
        }
        __syncthreads();
#pragma unroll
        for (int t = 0; t < 16; ++t) { aw[t] = AW[t * LDW + tid]; aa[t] = AA[t * LDW + tid]; }
        __syncthreads();
      }
      {
        float w0 = p.rw_w0[l * 512 + ch], a0 = p.rw_a0[l * 512 + ch];
#pragma unroll
        for (int t = 0; t < 16; ++t) {
          float lw = -softplusf_(-(w0 + aw[t])) - 0.5f;
          float u = -__expf(lw);
          p.RWX[(long)(m0 + t) * 1536 + ch] = f2bf(u);
          aa[t] = sigmoidf_(a0 + aa[t]);
        }
      }
      float rt[16];
      {
        float mj = mu[ch];
        float pv = prev_of(ch);
        u16* col = p.PROJ + (long)m0 * LDP + C_R + ch;
#pragma unroll
        for (int t = 0; t < 16; ++t) {
          float x = bf2f(col[(long)t * LDP]);
          rt[t] = x + (pv - x) * mj;
          pv = x;
        }
#pragma unroll
        for (int t = 0; t < 16; ++t) col[(long)t * LDP] = f2bf(rt[t]);
      }
      {
        float mj = mu[512 + ch];
        float pv = prev_of(512 + ch);
        float kkw = p.rw_kk[l * 512 + ch], kaw = p.rw_ka[l * 512 + ch], rkw = p.rw_rk[l * 512 + ch];
        u16* col = p.PROJ + (long)m0 * LDP + C_K + ch;
        float kt[16];
#pragma unroll
        for (int t = 0; t < 16; ++t) {
          float x = bf2f(col[(long)t * LDP]);
          kt[t] = x + (pv - x) * mj;
          pv = x;
        }
#pragma unroll
        for (int t = 0; t < 16; ++t) {
          float kkv = kt[t] * kkw;
          float ssq = sum64(kkv * kkv);
          float kk = kkv * rsqrtf(ssq + 1e-12f);
          float a = aa[t];
          float kp = kt[t] * (1.f + (a - 1.f) * kaw);
          float rks = sum64(rt[t] * kp * rkw);
          col[(long)t * LDP] = f2bf(kp);
          p.RWX[(long)(m0 + t) * 1536 + 512 + ch] = f2bf(kk);
          p.RWX[(long)(m0 + t) * 1536 + 1024 + ch] = f2bf(kk * a);
          if (lane == 0) (p.FB + FOFF_RKS)[(long)(m0 + t) * 8 + head] = rks;
        }
      }
      {
        float mj = mu[1024 + ch];
        float pv = prev_of(1024 + ch);
        u16* col = p.PROJ + (long)m0 * LDP + C_V + ch;
        float vt[16];
#pragma unroll
        for (int t = 0; t < 16; ++t) {
          float x = bf2f(col[(long)t * LDP]);
          vt[t] = x + (pv - x) * mj;
          pv = x;
        }
#pragma unroll
        for (int t = 0; t < 16; ++t) col[(long)t * LDP] = f2bf(vt[t]);
      }
    }
    if (t0 + 16 == seq_len(s)) {
      float* o = p.out + (s < 8 ? O_PSHIFT + ((long)l * 8 + s) * 1792 : O_SSHIFT + ((long)l * 8 + (s - 8)) * 1792);
      for (int j = tid; j < 1792; j += 256) o[j] = bf2f(p.BND[(long)blk * 1792 + j]);
    }
  }
}

__device__ __forceinline__ void scan_rwkv(const Params& p, int l, int s, int h, int q, float* smem) {
  const int tid = opaque_tid(), lane = tid & 63, wid = tid >> 6;
  float* R_ = smem;
  float* W_ = smem + 1024;
  float* K_ = smem + 2048;
  float* A_ = smem + 3072;
  float* B_ = smem + 4096;
  float* V_ = smem + 5120;
  float* O_ = smem + 5376;
  const int rl = wid * 4 + (lane >> 4);
  const int row = q * 16 + rl;
  const int ksl = (lane & 15) * 4;
  const int base = seq_base(s), T = seq_len(s);
  float s0 = 0.f, s1 = 0.f, s2 = 0.f, s3 = 0.f;
  if (s >= 8) {
    const float* st = p.state_rwkv + (((long)l * 8 + (s - 8)) * 8 + h) * 4096 + row * 64 + ksl;
    float4 v = *(const float4*)st;
    s0 = v.x; s1 = v.y; s2 = v.z; s3 = v.w;
  }
  const int stt = tid >> 4, skq = (tid & 15) * 4;
  const int nblk = T / 16;
  ushort4 r4, k4, u4, a4, b4;
  u16 vv;
  {
    const long m = base + stt;
    const u16* pr = p.PROJ + m * LDP;
    const u16* px = p.RWX + m * 1536;
    r4 = *(const ushort4*)(pr + C_R + h * 64 + skq);
    k4 = *(const ushort4*)(pr + C_K + h * 64 + skq);
    u4 = *(const ushort4*)(px + h * 64 + skq);
    a4 = *(const ushort4*)(px + 512 + h * 64 + skq);
    b4 = *(const ushort4*)(px + 1024 + h * 64 + skq);
    vv = pr[C_V + h * 64 + q * 16 + (tid & 15)];
  }
  __syncthreads();
  float* TR_ = smem + 5376 + 512;
  const bool wr = (lane & 15) == 0;
  const int ooff = wr ? rl : (512 + lane);
  const int ostr = wr ? 16 : 0;
  for (int blk = 0; blk < nblk; ++blk) {
    const long m = base + blk * 16 + stt;
    float* Oc = O_ + (blk & 1) * 256;
    {
      *(float4*)(R_ + stt * 64 + skq) = make_float4(bf2f(r4.x), bf2f(r4.y), bf2f(r4.z), bf2f(r4.w));
      *(float4*)(K_ + stt * 64 + skq) = make_float4(bf2f(k4.x), bf2f(k4.y), bf2f(k4.z), bf2f(k4.w));
      *(float4*)(W_ + stt * 64 + skq) =
          make_float4(__expf(bf2f(u4.x)), __expf(bf2f(u4.y)), __expf(bf2f(u4.z)), __expf(bf2f(u4.w)));
      *(float4*)(A_ + stt * 64 + skq) = make_float4(-bf2f(a4.x), -bf2f(a4.y), -bf2f(a4.z), -bf2f(a4.w));
      *(float4*)(B_ + stt * 64 + skq) = make_float4(bf2f(b4.x), bf2f(b4.y), bf2f(b4.z), bf2f(b4.w));
      V_[stt * 16 + (tid & 15)] = bf2f(vv);
    }
    __syncthreads();
    if (blk > 0)
      p.ORW[(m - 16) * 512 + h * 64 + q * 16 + (tid & 15)] = f2bf(O_[((blk - 1) & 1) * 256 + stt * 16 + (tid & 15)]);
    if (blk + 1 < nblk) {
      const u16* pr = p.PROJ + (m + 16) * LDP;
      const u16* px = p.RWX + (m + 16) * 1536;
      r4 = *(const ushort4*)(pr + C_R + h * 64 + skq);
      k4 = *(const ushort4*)(pr + C_K + h * 64 + skq);
      u4 = *(const ushort4*)(px + h * 64 + skq);
      a4 = *(const ushort4*)(px + 512 + h * 64 + skq);
      b4 = *(const ushort4*)(px + 1024 + h * 64 + skq);
      vv = pr[C_V + h * 64 + q * 16 + (tid & 15)];
    }
    __builtin_amdgcn_sched_barrier(0);
    {
      float4 a = *(const float4*)(A_ + ksl), w = *(const float4*)(W_ + ksl), b = *(const float4*)(B_ + ksl);
      float4 k = *(const float4*)(K_ + ksl), r = *(const float4*)(R_ + ksl);
      float v = V_[rl];
      float opart = 0.f;
#pragma unroll
      for (int tt = 0; tt < 16; ++tt) {
        float4 an, wn, bn, kn, rn;
        float vn;
        if (tt + 1 < 16) {
          an = *(const float4*)(A_ + (tt + 1) * 64 + ksl); wn = *(const float4*)(W_ + (tt + 1) * 64 + ksl);
          bn = *(const float4*)(B_ + (tt + 1) * 64 + ksl); kn = *(const float4*)(K_ + (tt + 1) * 64 + ksl);
          rn = *(const float4*)(R_ + (tt + 1) * 64 + ksl); vn = V_[(tt + 1) * 16 + rl];
        }
        __builtin_amdgcn_sched_barrier(0);
        float sa = fmaf(s0, a.x, fmaf(s1, a.y, fmaf(s2, a.z, s3 * a.w)));
        if (tt > 0) { sum16x2(sa, opart); Oc[ooff + (tt - 1) * ostr] = opart; }
        else sa = sum16(sa);
        s0 = fmaf(s0, w.x, fmaf(sa, b.x, v * k.x)); NOPK(s0);
        s1 = fmaf(s1, w.y, fmaf(sa, b.y, v * k.y)); NOPK(s1);
        s2 = fmaf(s2, w.z, fmaf(sa, b.z, v * k.z)); NOPK(s2);
        s3 = fmaf(s3, w.w, fmaf(sa, b.w, v * k.w)); NOPK(s3);
        opart = fmaf(s0, r.x, fmaf(s1, r.y, fmaf(s2, r.z, s3 * r.w)));
        if (tt == 15) { opart = sum16(opart); Oc[ooff + 15 * ostr] = opart; }
        __builtin_amdgcn_sched_barrier(0);
        if (tt + 1 < 16) { a = an; w = wn; b = bn; k = kn; r = rn; v = vn; }
      }
    }
    __builtin_amdgcn_sched_barrier(0);
    __syncthreads();
  }
  {
    const long m = base + (nblk - 1) * 16 + stt;
    p.ORW[m * 512 + h * 64 + q * 16 + (tid & 15)] = f2bf(O_[((nblk - 1) & 1) * 256 + stt * 16 + (tid & 15)]);
  }
  __syncthreads();
  {
    float* o = p.out + (s < 8 ? O_PRWKV + (((long)l * 8 + s) * 8 + h) * 4096
                              : O_SRWKV + (((long)l * 8 + (s - 8)) * 8 + h) * 4096);
    *(float4*)(o + row * 64 + ksl) = make_float4(s0, s1, s2, s3);
  }
}

__device__ __forceinline__ void scan_hgrn(const Params& p, int l, int s, int h, int q, float* smem) {
  const int tid = opaque_tid(), lane = tid & 63, wid = tid >> 6;
  float* Q_ = smem;
  float* F_ = smem + 2048;
  float* G_ = smem + 4096;
  float* I_ = smem + 6144;
  float* O_ = smem + 6400;
  const int rl = wid * 4 + (lane >> 4);
  const int row = q * 16 + rl;
  const int ksl4 = (lane & 15) * 4;
  const int base = seq_base(s), T = seq_len(s);
  float st[8];
#pragma unroll
  for (int i = 0; i < 8; ++i) st[i] = 0.f;
  if (s >= 8) {
    const float* sp = p.state_hgrn + (((long)l * 8 + (s - 8)) * 4 + h) * 16384;
#pragma unroll
    for (int i = 0; i < 8; ++i) st[i] = sp[((i >> 2) * 64 + ksl4 + (i & 3)) * 128 + row];
  }
  const int stt = tid >> 4, skq = (tid & 15) * 8;
  float lb[8];
#pragma unroll
  for (int i = 0; i < 8; ++i) {
    if (l == 0) lb[i] = 0.f;
    else {
      float x0 = p.hg_lb[h * 128 + skq + i], x1 = p.hg_lb[512 + h * 128 + skq + i];
      lb[i] = frcp_(1.f + __expf(x0 - x1));
    }
  }
  const int nblk = T / 16;
  uint4 q8, f8;
  u16 iv16;
  {
    const u16* pr = p.PROJ + (long)(base + stt) * LDP;
    q8 = *(const uint4*)(pr + C_Q + h * 128 + skq);
    f8 = *(const uint4*)(pr + C_F + h * 128 + skq);
    iv16 = pr[C_I + h * 128 + q * 16 + (tid & 15)];
  }
  __syncthreads();
  float* TR_ = smem + 6400 + 512;
  const bool wr = (lane & 15) == 0;
  const int ooff = wr ? rl : (512 + lane);
  const int ostr = wr ? 16 : 0;
  for (int blk = 0; blk < nblk; ++blk) {
    const long m = base + blk * 16 + stt;
    float* Oc = O_ + (blk & 1) * 256;
    {
      unsigned qw[4] = {q8.x, q8.y, q8.z, q8.w}, fw[4] = {f8.x, f8.y, f8.z, f8.w};
      float qv[8], fv[8];
#pragma unroll
      for (int e = 0; e < 8; ++e) {
        qv[e] = bf2f((u16)((qw[e >> 1] >> ((e & 1) * 16)) & 0xffff));
        float fz = bf2f((u16)((fw[e >> 1] >> ((e & 1) * 16)) & 0xffff));
        float ex = __expf(-fz);
        float sg = frcp_(1.f + ex);
        fv[e] = lb[e] + (1.f - lb[e]) * sg;
      }
      *(float4*)(Q_ + stt * 128 + skq) = make_float4(qv[0], qv[1], qv[2], qv[3]);
      *(float4*)(Q_ + stt * 128 + skq + 4) = make_float4(qv[4], qv[5], qv[6], qv[7]);
      *(float4*)(F_ + stt * 128 + skq) = make_float4(fv[0], fv[1], fv[2], fv[3]);
      *(float4*)(F_ + stt * 128 + skq + 4) = make_float4(fv[4], fv[5], fv[6], fv[7]);
      I_[stt * 16 + (tid & 15)] = bf2f(iv16);
    }
    __syncthreads();
    if (blk > 0) {
      u16* dp = p.PROJ + (m - 16) * LDP + C_I + h * 128 + q * 16 + (tid & 15);
      *dp = f2bf(O_[((blk - 1) & 1) * 256 + stt * 16 + (tid & 15)]);
    }
    if (blk + 1 < nblk) {
      const u16* pr = p.PROJ + (m + 16) * LDP;
      q8 = *(const uint4*)(pr + C_Q + h * 128 + skq);
      f8 = *(const uint4*)(pr + C_F + h * 128 + skq);
      iv16 = pr[C_I + h * 128 + q * 16 + (tid & 15)];
    }
    __builtin_amdgcn_sched_barrier(0);
    {
      float4 f0 = *(const float4*)(F_ + ksl4), f1 = *(const float4*)(F_ + 64 + ksl4);
      float4 q0 = *(const float4*)(Q_ + ksl4), q1 = *(const float4*)(Q_ + 64 + ksl4);
      float iv = I_[rl];
      float oprev = 0.f;
#pragma unroll
      for (int tt = 0; tt < 16; ++tt) {
        float4 f0n, f1n, q0n, q1n;
        float ivn;
        if (tt + 1 < 16) {
          const int o_ = (tt + 1) * 128;
          f0n = *(const float4*)(F_ + o_ + ksl4); f1n = *(const float4*)(F_ + o_ + 64 + ksl4);
          q0n = *(const float4*)(Q_ + o_ + ksl4); q1n = *(const float4*)(Q_ + o_ + 64 + ksl4);
          ivn = I_[(tt + 1) * 16 + rl];
        }
        __builtin_amdgcn_sched_barrier(0);
        st[0] = fmaf(st[0] - iv, f0.x, iv); NOPK(st[0]);
        st[1] = fmaf(st[1] - iv, f0.y, iv); NOPK(st[1]);
        st[2] = fmaf(st[2] - iv, f0.z, iv); NOPK(st[2]);
        st[3] = fmaf(st[3] - iv, f0.w, iv); NOPK(st[3]);
        st[4] = fmaf(st[4] - iv, f1.x, iv); NOPK(st[4]);
        st[5] = fmaf(st[5] - iv, f1.y, iv); NOPK(st[5]);
        st[6] = fmaf(st[6] - iv, f1.z, iv); NOPK(st[6]);
        st[7] = fmaf(st[7] - iv, f1.w, iv); NOPK(st[7]);
        float acc0 = fmaf(st[0], q0.x, fmaf(st[1], q0.y, fmaf(st[2], q0.z, st[3] * q0.w)));
        float acc1 = fmaf(st[4], q1.x, fmaf(st[5], q1.y, fmaf(st[6], q1.z, st[7] * q1.w)));
        float o = acc0 + acc1;
        if (tt & 1) { sum16x2(oprev, o); Oc[ooff + (tt - 1) * ostr] = oprev; Oc[ooff + tt * ostr] = o; }
        else oprev = o;
        __builtin_amdgcn_sched_barrier(0);
        if (tt + 1 < 16) { f0 = f0n; f1 = f1n; q0 = q0n; q1 = q1n; iv = ivn; }
      }
    }
    __builtin_amdgcn_sched_barrier(0);
    __syncthreads();
  }
  {
    const long m = base + (nblk - 1) * 16 + stt;
    u16* dp = p.PROJ + m * LDP + C_I + h * 128 + q * 16 + (tid & 15);
    *dp = f2bf(O_[((nblk - 1) & 1) * 256 + stt * 16 + (tid & 15)]);
  }
  __syncthreads();
  {
    float* o = p.out + (s < 8 ? O_PHGRN + (((long)l * 8 + s) * 4 + h) * 16384
                              : O_SHGRN + (((long)l * 8 + (s - 8)) * 4 + h) * 16384);
#pragma unroll
    for (int i = 0; i < 8; ++i) o[((i >> 2) * 64 + ksl4 + (i & 3)) * 128 + row] = st[i];
  }
}

__device__ __forceinline__ void scan_ssd(const Params& p, int l, int s, int h, int q, float* smem) {
  const int tid = opaque_tid(), lane = tid & 63, wid = tid >> 6;
  float* B_ = smem;
  float* C_ = smem + 2048;
  float* X_ = smem + 4096;
  float* O_ = smem + 4352;
  float* DT_ = smem + 5200;
  float* DE_ = smem + 5216;
  const int rl = wid * 4 + (lane >> 4);
  const int row = q * 16 + rl;
  const int ksl4 = (lane & 15) * 4;
  const int g = h >> 2;
  const int base = seq_base(s), T = seq_len(s);
  float st[8];
#pragma unroll
  for (int i = 0; i < 8; ++i) st[i] = 0.f;
  if (s >= 8) {
    const float* sp = p.state_ssm + (((long)l * 8 + (s - 8)) * 8 + h) * 8192 + row * 128 + ksl4;
    float4 a = *(const float4*)sp, b = *(const float4*)(sp + 64);
    st[0] = a.x; st[1] = a.y; st[2] = a.z; st[3] = a.w; st[4] = b.x; st[5] = b.y; st[6] = b.z; st[7] = b.w;
  }
  const int xc_bc = (tid < 128) ? (512 + g * 128 + tid) : (768 + g * 128 + (tid - 128));
  const float* cw = p.conv_w + (long)l * 4 * 1024;
  const float cb0 = cw[xc_bc], cb1 = cw[1024 + xc_bc], cb2 = cw[2048 + xc_bc], cb3 = cw[3072 + xc_bc];
  const float cbb = p.conv_b[l * 1024 + xc_bc];
  float u3 = 0.f, u2 = 0.f, u1 = 0.f;
  const int xc_x = h * 64 + q * 16 + (tid & 15);
  const float cx0 = cw[xc_x], cx1 = cw[1024 + xc_x], cx2 = cw[2048 + xc_x], cx3 = cw[3072 + xc_x];
  const float cxb = p.conv_b[l * 1024 + xc_x];
  float x3 = 0.f, x2 = 0.f, x1 = 0.f;
  if (s >= 8) {
    const float* sc = p.state_conv + ((long)l * 8 + (s - 8)) * 3 * 1024;
    u3 = sc[xc_bc]; u2 = sc[1024 + xc_bc]; u1 = sc[2048 + xc_bc];
    x3 = sc[xc_x]; x2 = sc[1024 + xc_x]; x1 = sc[2048 + xc_x];
  }
  const float dtb = p.dt_bias[l * 8 + h];
  const float aexp = __expf(p.a_log[l * 8 + h]);
  const float dsk = p.d_skip[l * 8 + h];
  const int stt = tid >> 4;
  const int nblk = T / 16;
  u16 raw[16];
  float xr[4];
  float dtr = 0.f;
  u16 zc = 0, zn = 0;
#define SSD_LOAD(M0)                                                              \
  {                                                                               \
    const u16* col = p.PROJ + (long)(M0) * LDP + C_XBC + xc_bc;                   \
    _Pragma("unroll") for (int t = 0; t < 16; ++t) raw[t] = col[(long)t * LDP];   \
    {                                                                             \
      const long mr = (long)(M0) + stt;                                           \
      const u16* colx = p.PROJ + mr * LDP + C_XBC + xc_x;                         \
      _Pragma("unroll") for (int j = 0; j < 4; ++j) {                             \
        const long mm = mr - 3 + j;                                               \
        float vx;                                                                 \
        if (mm >= base) vx = bf2f(colx[(long)(j - 3) * LDP]);                     \
        else vx = (s >= 8) ? p.state_conv[((long)l * 8 + (s - 8)) * 3072 + (3 + (int)(mm - base)) * 1024 + xc_x] : 0.f; \
        xr[j] = vx;                                                               \
      }                                                                           \
    }                                                                             \
    if (tid < 16) dtr = (p.FB + FOFF_DTRAW)[((long)(M0) + tid) * 8 + h];                      \
    zn = p.PROJ[((long)(M0) + stt) * LDP + C_Z + h * 64 + q * 16 + (tid & 15)];   \
  }
#pragma unroll
  for (int t = 0; t < 16; ++t) raw[t] = 0;
  SSD_LOAD(base);
  __syncthreads();
  const bool wr = (lane & 15) == 0;
  const int ooff = wr ? rl : (512 + lane);
  const int ostr = wr ? 16 : 0;
  u16 zp = 0;
  for (int blk = 0; blk < nblk; ++blk) {
    const long m0 = base + blk * 16;
    zp = zc;
    zc = zn;
    float* Oc = O_ + (blk & 1) * 256;
    {
      float* dst = (tid < 128) ? (B_ + tid) : (C_ + (tid - 128));
#pragma unroll
      for (int t = 0; t < 16; ++t) {
        float u0 = bf2f(raw[t]);
        float y = cb0 * u3 + cb1 * u2 + cb2 * u1 + cb3 * u0 + cbb;
        dst[t * 128] = siluf_(y);
        u3 = u2; u2 = u1; u1 = u0;
      }
      {
        float y = cx0 * xr[0] + cx1 * xr[1] + cx2 * xr[2] + cx3 * xr[3] + cxb;
        X_[stt * 16 + (tid & 15)] = siluf_(y);
      }
      if (tid < 16) {
        float dtv = softplusf_(dtr + dtb);
        DT_[tid] = dtv;
        DE_[tid] = __expf(-aexp * dtv);
      }
    }
    __syncthreads();
    if (blk > 0) {
      u16* pz = p.PROJ + (m0 - 16 + stt) * LDP + C_Z + h * 64 + q * 16 + (tid & 15);
      *pz = f2bf(O_[((blk - 1) & 1) * 256 + stt * 16 + (tid & 15)] * siluf_(bf2f(zp)));
    }
    if (blk + 1 < nblk) SSD_LOAD(m0 + 16);
    __builtin_amdgcn_sched_barrier(0);
    {
      float4 b0 = *(const float4*)(B_ + ksl4), b1 = *(const float4*)(B_ + 64 + ksl4);
      float4 c0 = *(const float4*)(C_ + ksl4), c1 = *(const float4*)(C_ + 64 + ksl4);
      float xv = X_[rl], dt = DT_[0], de = DE_[0];
      float yprev = 0.f, xvprev = 0.f;
#pragma unroll
      for (int tt = 0; tt < 16; ++tt) {
        float4 b0n, b1n, c0n, c1n;
        float xvn, dtn, den;
        if (tt + 1 < 16) {
          const int o_ = (tt + 1) * 128;
          b0n = *(const float4*)(B_ + o_ + ksl4); b1n = *(const float4*)(B_ + o_ + 64 + ksl4);
          c0n = *(const float4*)(C_ + o_ + ksl4); c1n = *(const float4*)(C_ + o_ + 64 + ksl4);
          xvn = X_[(tt + 1) * 16 + rl]; dtn = DT_[tt + 1]; den = DE_[tt + 1];
        }
        __builtin_amdgcn_sched_barrier(0);
        const float xd = xv * dt;
        st[0] = fmaf(st[0], de, xd * b0.x); NOPK(st[0]);
        st[1] = fmaf(st[1], de, xd * b0.y); NOPK(st[1]);
        st[2] = fmaf(st[2], de, xd * b0.z); NOPK(st[2]);
        st[3] = fmaf(st[3], de, xd * b0.w); NOPK(st[3]);
        st[4] = fmaf(st[4], de, xd * b1.x); NOPK(st[4]);
        st[5] = fmaf(st[5], de, xd * b1.y); NOPK(st[5]);
        st[6] = fmaf(st[6], de, xd * b1.z); NOPK(st[6]);
        st[7] = fmaf(st[7], de, xd * b1.w); NOPK(st[7]);
        float acc0 = fmaf(st[0], c0.x, fmaf(st[1], c0.y, fmaf(st[2], c0.z, st[3] * c0.w)));
        float acc1 = fmaf(st[4], c1.x, fmaf(st[5], c1.y, fmaf(st[6], c1.z, st[7] * c1.w)));
        float y = acc0 + acc1;
        if (tt & 1) { sum16x2(yprev, y); Oc[ooff + (tt - 1) * ostr] = yprev + dsk * xvprev; Oc[ooff + tt * ostr] = y + dsk * xv; }
        else { yprev = y; xvprev = xv; }
        __builtin_amdgcn_sched_barrier(0);
        if (tt + 1 < 16) { b0 = b0n; b1 = b1n; c0 = c0n; c1 = c1n; xv = xvn; dt = dtn; de = den; }
      }
    }
    __builtin_amdgcn_sched_barrier(0);
    __syncthreads();
  }
  {
    const long m0 = base + (nblk - 1) * 16;
    u16* pz = p.PROJ + (m0 + stt) * LDP + C_Z + h * 64 + q * 16 + (tid & 15);
    *pz = f2bf(O_[((nblk - 1) & 1) * 256 + stt * 16 + (tid & 15)] * siluf_(bf2f(zc)));
  }
  __syncthreads();
#undef SSD_LOAD
  {
    float* o = p.out + (s < 8 ? O_PSSM + (((long)l * 8 + s) * 8 + h) * 8192
                              : O_SSSM + (((long)l * 8 + (s - 8)) * 8 + h) * 8192);
    *(float4*)(o + row * 128 + ksl4) = make_float4(st[0], st[1], st[2], st[3]);
    *(float4*)(o + row * 128 + 64 + ksl4) = make_float4(st[4], st[5], st[6], st[7]);
  }
  if (h == 0 && q == 0) {
    float* o = p.out + (s < 8 ? O_PCONV + ((long)l * 8 + s) * 3072 : O_SCONV + ((long)l * 8 + (s - 8)) * 3072);
    for (int i = tid; i < 3072; i += 256) {
      int r = i >> 10, c = i & 1023;
      o[i] = bf2f(p.PROJ[(long)(base + T - 3 + r) * LDP + C_XBC + c]);
    }
  }
}

__device__ __forceinline__ void phase_scan(const Params& p, int l, float* smem) {
  for (int u = BID, nb_ = NBLK; u < 1536; u += nb_) {
    int sample = u >= 768;
    int v = sample ? u - 768 : u;
    int type = v % 3, w = v / 3;
    if (type == 0) {
      int q = w & 3, h = (w >> 2) & 7, b = w >> 5;
      scan_rwkv(p, l, b + 8 * sample, h, q, smem);
    } else if (type == 1) {
      int q = w & 7, h = (w >> 3) & 3, b = w >> 5;
      scan_hgrn(p, l, b + 8 * sample, h, q, smem);
    } else {
      int q = w & 3, h = (w >> 2) & 7, b = w >> 5;
      scan_ssd(p, l, b + 8 * sample, h, q, smem);
    }
  }
}

__device__ __forceinline__ void phase_post(const Params& p, int l, float* smem) {
  const int tid = opaque_tid(), lane = tid & 63, wid = tid >> 6;
  float* RED = smem;
  constexpr int LDG = 516;
  float* GA = smem + 256;
  for (int blk = BID, nb_ = NBLK; blk < NBLK16; blk += nb_) {
    const long m0 = (long)blk * 16;
    __syncthreads();
    {
      bf16x8 ag[4];
      const u16* arow = p.PROJ + (m0 + (lane & 15)) * LDP + C_XG + (lane >> 4) * 8;
#pragma unroll
      for (int ks = 0; ks < 4; ++ks) ag[ks] = *(const bf16x8*)(arow + ks * 32);
#pragma unroll
      for (int nt = 0; nt < 8; ++nt) {
        const int n = (wid * 8 + nt) * 16 + (lane & 15);
        f32x4v acc = {0.f, 0.f, 0.f, 0.f};
#pragma unroll
        for (int ks = 0; ks < 4; ++ks) {
          bf16x8 bg = *(const bf16x8*)((p.WB + OFF_G2T) + n * 128 + ks * 32 + (lane >> 4) * 8);
          acc = __builtin_amdgcn_mfma_f32_16x16x32_bf16(ag[ks], bg, acc, 0, 0, 0);
        }
#pragma unroll
        for (int r = 0; r < 4; ++r) GA[((lane >> 4) * 4 + r) * LDG + n] = acc[r];
      }
    }
#pragma unroll 1
    for (int c = 0; c < 2; ++c) {
      const int ch = tid + 256 * c, head = wid + 4 * c;
      float ys[16], oh[16];
#pragma unroll
      for (int t = 0; t < 16; ++t) {
        ys[t] = bf2f(p.PROJ[(m0 + t) * LDP + C_Z + ch]);
        oh[t] = bf2f(p.PROJ[(m0 + t) * LDP + C_I + ch]);
      }
#pragma unroll
      for (int t = 0; t < 16; ++t) {
        float a0 = sum64(ys[t] * ys[t]);
        float b0 = sum64(oh[t] * oh[t]);
        if (lane == 0) *(float2*)(RED + (wid * 16 + t) * 2) = make_float2(a0, b0);
      }
      __syncthreads();
      {
        const float nw0 = p.ssd_norm_w[l * 512 + ch];
        const float hw0 = p.hg_norm_w[l * 512 + ch];
        const int pw = (wid >> 1) * 2;
#pragma unroll
        for (int t = 0; t < 16; ++t) {
          float2 r0 = *(const float2*)(RED + (0 * 16 + t) * 2), r1 = *(const float2*)(RED + (1 * 16 + t) * 2);
          float2 r2 = *(const float2*)(RED + (2 * 16 + t) * 2), r3 = *(const float2*)(RED + (3 * 16 + t) * 2);
          float g0 = r0.x + r1.x + r2.x + r3.x;
          float2 pa = *(const float2*)(RED + (pw * 16 + t) * 2), pb = *(const float2*)(RED + ((pw + 1) * 16 + t) * 2);
          float h0 = pa.y + pb.y;
          u16* rowp = p.PROJ + (m0 + t) * LDP;
          rowp[C_Z + ch] = f2bf(ys[t] * rsqrtf(g0 * (1.f / 256.f) + 1e-6f) * nw0);
          float gg0 = bf2f(rowp[C_GG + ch]);
          rowp[C_GG + ch] = f2bf(oh[t] * rsqrtf(h0 * (1.f / 128.f) + 1e-6f) * hw0 * siluf_(gg0));
        }
      }
      {
        float lw = p.rw_lnx_w[l * 512 + ch], lbv = p.rw_lnx_b[l * 512 + ch];
#pragma unroll
        for (int t = 0; t < 16; ++t) {
          float o = bf2f(p.ORW[(m0 + t) * 512 + ch]);
          float mean = sum64(o) * (1.f / 64.f);
          float d = o - mean;
          float var = sum64(d * d) * (1.f / 64.f);
          float ln = d * rsqrtf(var + 64e-5f) * lw + lbv;
          float v = bf2f(p.PROJ[(m0 + t) * LDP + C_V + ch]);
          float bonus = (p.FB + FOFF_RKS)[(m0 + t) * 8 + head] * v;
          p.PROJ[(m0 + t) * LDP + C_R + ch] = f2bf((ln + bonus) * GA[t * LDG + ch]);
        }
      }
      __syncthreads();
    }
  }
}

__device__ __forceinline__ void phase_final(const Params& p) {
  const int tid = opaque_tid(), lane = tid & 63, wid = tid >> 6;
  for (int m = BID * 4 + wid, nb_ = NBLK; m < M_TOT; m += nb_ * 4) {
    float* dst;
    if (m < M_PROMPT) {
      int b = m / T_P, t = m - b * T_P;
      if (t < 16) continue;
      dst = p.out + O_YP + ((long)b * 4096 + (t - 16)) * DM;
    } else {
      dst = p.out + O_YS + (long)(m - M_PROMPT) * DM;
    }
    float x[16];
    float ss = 0.f;
#pragma unroll
    for (int j = 0; j < 2; ++j) {
      uint4 raw = *(const uint4*)(p.XB + (long)m * DM + lane * 8 + 512 * j);
      unsigned wv[4] = {raw.x, raw.y, raw.z, raw.w};
#pragma unroll
      for (int e = 0; e < 8; ++e) {
        x[j * 8 + e] = bf2f((u16)((wv[e >> 1] >> ((e & 1) * 16)) & 0xffff));
        ss += x[j * 8 + e] * x[j * 8 + e];
      }
    }
    ss = sum64(ss);
    float rs = rsqrtf(ss * (1.f / 1024.f) + 1e-6f);
#pragma unroll
    for (int j = 0; j < 2; ++j) {
      int k0 = lane * 8 + 512 * j;
      float4 w0 = *(const float4*)(p.final_w + k0), w1 = *(const float4*)(p.final_w + k0 + 4);
      *(float4*)(dst + k0) = make_float4(x[j * 8 + 0] * rs * w0.x, x[j * 8 + 1] * rs * w0.y, x[j * 8 + 2] * rs * w0.z,
                                         x[j * 8 + 3] * rs * w0.w);
      *(float4*)(dst + k0 + 4) = make_float4(x[j * 8 + 4] * rs * w1.x, x[j * 8 + 5] * rs * w1.y,
                                             x[j * 8 + 6] * rs * w1.z, x[j * 8 + 7] * rs * w1.w);
    }
  }
}


#define XB_TMO      128
#define XB_XCNT(j)  (256  + 64 * (j))
#define XB_XSUB(j)  (1280 + 64 * (j))
#define XB_XGEN(j)  (2304 + 64 * (j))
#define XB_TOP      3328
#define XB_TOPGEN   3392
#define XCD_BAR_WORDS 3456
#define XB_SPIN_CAP (1u << 22)
__device__ __forceinline__ unsigned xb_ld(unsigned* p) { return __hip_atomic_load(p, __ATOMIC_RELAXED, __HIP_MEMORY_SCOPE_AGENT); }
__device__ __forceinline__ unsigned xb_add(unsigned* p, unsigned v) { return __hip_atomic_fetch_add(p, v, __ATOMIC_RELAXED, __HIP_MEMORY_SCOPE_AGENT); }
__device__ __forceinline__ unsigned xb_xcc_id() { return (unsigned)__builtin_amdgcn_s_getreg((3 << 11) | 20) & 0xFu; }
#define XB_SPIN(cond, bar) do { unsigned _sp = 0; while (cond) { __builtin_amdgcn_s_sleep(1); \
    if ((++_sp & 255u) == 0u) { if (xb_ld(&(bar)[XB_TMO])) break; if (_sp > XB_SPIN_CAP) { atomicAdd(&(bar)[XB_TMO], 1u); break; } } } } while (0)

__device__ __forceinline__ void xcd_barrier_post(unsigned* bar) {
  if (threadIdx.x == 0) (void)xb_add(&bar[XB_XCNT(xb_xcc_id())], 1u);
}
__device__ __forceinline__ void xcd_barrier_complete(unsigned* bar, unsigned x, unsigned& nloc, unsigned& nx) {
  const unsigned G = gridDim.x;
  unsigned sum, cnt, mine, sp = 0u;
  for (;;) {
    sum = 0u; cnt = 0u; mine = 0u;
#pragma unroll
    for (unsigned j = 0; j < 16; ++j) { const unsigned c = xb_ld(&bar[XB_XCNT(j)]); sum += c; cnt += (c > 0u) ? 1u : 0u; mine = (j == x) ? c : mine; }
    if (sum == G) break;
    __builtin_amdgcn_s_sleep(1);
    if ((++sp & 255u) == 0u) { if (xb_ld(&bar[XB_TMO])) break; if (sp > XB_SPIN_CAP) { atomicAdd(&bar[XB_TMO], 1u); break; } }
  }
  nloc = mine > 0u ? mine : 1u; nx = cnt > 0u ? cnt : 1u;
}
__device__ __forceinline__ void xcd_barrier(unsigned* bar, volatile unsigned* st) {
  asm volatile("s_waitcnt vmcnt(0)" ::: "memory");
  __syncthreads();
  if (threadIdx.x == 0) {
    __builtin_amdgcn_s_waitcnt(0);
    const unsigned x = xb_xcc_id();
    unsigned nloc = st[0], nx = st[1];
    if (nloc == 0u) { xcd_barrier_complete(bar, x, nloc, nx); st[0] = nloc; st[1] = nx; }
    const unsigned old = xb_add(&bar[XB_XSUB(x)], 1u);
    const unsigned gen = old / nloc;
    if (old + 1u == (gen + 1u) * nloc) {
      __builtin_amdgcn_fence(__ATOMIC_RELEASE, "agent");
      asm volatile("s_waitcnt vmcnt(0)" ::: "memory");
      const unsigned og = xb_add(&bar[XB_TOP], 1u);
      const unsigned tg = og / nx;
      if (og + 1u == (tg + 1u) * nx) xb_add(&bar[XB_TOPGEN], 1u);
      else XB_SPIN(xb_ld(&bar[XB_TOPGEN]) == tg, bar);
      __builtin_amdgcn_fence(__ATOMIC_ACQUIRE, "agent");
      xb_add(&bar[XB_XGEN(x)], 1u);
      asm volatile("s_waitcnt vmcnt(0)" ::: "memory");
    } else {
      XB_SPIN(xb_ld(&bar[XB_XGEN(x)]) == gen, bar);
      __builtin_amdgcn_fence(__ATOMIC_ACQUIRE, "agent");
      asm volatile("s_waitcnt vmcnt(0)" ::: "memory");
    }
  }
  __syncthreads();
}

constexpr int SMEM_BYTES = 40960;
__device__ __forceinline__ void run_phase(const Params& p, int ph, char* smem) {
  if (ph == 0) { phase_embed(p); return; }
  if (ph == 19) { phase_final(p); return; }
  int l = (ph - 1) / 9, s = (ph - 1) % 9;
  float* fs = (float*)smem;
  switch (s) {
    case 0: phase_convert(p, l, fs); phase_rowstat<true>(p, l, fs); break;
    case 1: phase_gemm<1>(p, p.XB, DM, (p.WB + OFF_W1T), 1024, LDP / 128, smem); break;
    case 2: phase_pre(p, l, fs); break;
    case 3: phase_scan(p, l, fs); break;
    case 4: phase_post(p, l, fs); break;
    case 5: phase_gemm<2>(p, p.PROJ, LDP, (p.WB + OFF_WOT), 1536, 8, smem); break;
    case 6: phase_rowstat<false>(p, l, fs); break;
    case 7: phase_gemm<3>(p, p.XB, DM, (p.WB + OFF_WGU), 1024, 44, smem); break;
    case 8: phase_gemm<2>(p, p.PROJ, D_FF, (p.WB + OFF_WDT), D_FF, 8, smem); break;
  }
}
constexpr int N_PHASES = 20;

#if MEGA
__global__ void __launch_bounds__(256, 3) k_mega(Params p) {
  __shared__ __attribute__((aligned(16))) char smem[SMEM_BYTES];
  __shared__ uint4 xb_words;
  if (threadIdx.x == 0) { xb_words = make_uint4(0u, 0u, 0u, 0u); }
  __syncthreads();
  cg::grid_group grid = cg::this_grid();
  float* fs = (float*)smem;
  volatile unsigned* xst = (volatile unsigned*)&xb_words;
  xcd_barrier_post(p.bar);
  phase_embed(p);
  grid.sync();
#define GSYNC() do { unsigned* b_ = p.bar; asm volatile("" : "+s"(b_)); xcd_barrier(b_, xst); } while (0)
#pragma unroll 1
  for (int l0 = 0; l0 < 2; ++l0) {
    int l = opaque_s(l0);
    phase_convert(p, l, fs);
    phase_rowstat<true>(p, l, fs);
    GSYNC();
    l = opaque_s(l);
    phase_gemm<1>(p, p.XB, DM, (p.WB + OFF_W1T), 1024, LDP / 128, smem);
    GSYNC();
    l = opaque_s(l);
    phase_pre(p, l, fs);
    GSYNC();
    l = opaque_s(l);
    phase_scan(p, l, fs);
    GSYNC();
    l = opaque_s(l);
    phase_post(p, l, fs);
    GSYNC();
    l = opaque_s(l);
    phase_gemm<2>(p, p.PROJ, LDP, (p.WB + OFF_WOT), 1536, 8, smem);
    GSYNC();
    l = opaque_s(l);
    phase_rowstat<false>(p, l, fs);
    GSYNC();
    l = opaque_s(l);
    phase_gemm<3>(p, p.XB, DM, (p.WB + OFF_WGU), 1024, 44, smem);
    GSYNC();
    l = opaque_s(l);
    phase_gemm<2>(p, p.PROJ, D_FF, (p.WB + OFF_WDT), D_FF, 8, smem);
    GSYNC();
  }
  phase_final(p);
}
#else
template <int PH>
__global__ void __launch_bounds__(256, 3) k_phase(Params p) {
  __shared__ __attribute__((aligned(16))) char smem[SMEM_BYTES];
  run_phase(p, PH, smem);
}
template <int PH>
static void launch_all(const Params& p, int grid, hipStream_t stream) {
  hipLaunchKernelGGL(k_phase<PH>, dim3(grid), dim3(256), 0, stream, p);
  if constexpr (PH + 1 < N_PHASES) launch_all<PH + 1>(p, grid, stream);
}
#endif

extern "C" void kernel_launch(void* const* d_in, const int* in_sizes, int n_in, void* d_out, int out_size, void* d_ws,
                              size_t ws_size, hipStream_t stream) {
  Params p{};
  const float** pf = (const float**)&p;
  for (int i = 0; i < 35; ++i) pf[i] = (const float*)d_in[i];
  p.out = (float*)d_out;
  char* ws = (char*)d_ws;
  size_t off = 0;
  auto take = [&](size_t bytes) { char* r = ws + off; off += (bytes + 255) & ~(size_t)255; return r; };
  p.XB = (u16*)take((size_t)M_TOT * DM * 2);
  p.PROJ = (u16*)take((size_t)M_TOT * LDP * 2);
  p.WB = (u16*)take((size_t)WB_TOTAL * 2);
  p.BND = (u16*)take((size_t)NBLK16 * 1792 * 2);
  p.ORW = (u16*)take((size_t)M_TOT * 512 * 2);
  p.FB = (float*)take((size_t)FB_TOTAL * 4);
  p.bar = (unsigned*)take((size_t)XCD_BAR_WORDS * 4);
  p.RWX = (u16*)d_out;
  if (off > ws_size) fprintf(stderr, "workspace too small: need %zu have %zu\n", off, ws_size);
#if MEGA
  static int grid_blocks = 0;
  if (!grid_blocks) {
    int dev = 0, cus = 0, per_cu = 0;
    hipGetDevice(&dev);
    hipDeviceGetAttribute(&cus, hipDeviceAttributeMultiprocessorCount, dev);
    hipOccupancyMaxActiveBlocksPerMultiprocessor(&per_cu, k_mega, 256, 0);
    if (per_cu > 3) per_cu = 3;
    grid_blocks = cus * per_cu;
  }
  hipMemsetAsync(p.bar, 0, (size_t)XCD_BAR_WORDS * 4, stream);
  void* args[] = {&p};
  hipError_t e = hipLaunchCooperativeKernel((void*)k_mega, dim3(grid_blocks), dim3(256), args, 0, stream);
  if (e != hipSuccess) fprintf(stderr, "cooperative launch failed: %s (grid %d)\n", hipGetErrorString(e), grid_blocks);
#else
  launch_all<0>(p, 768, stream);
#endif
}
```

```cpp
#include <hip/hip_runtime.h>
#include <hip/hip_bf16.h>
#include <hip/hip_cooperative_groups.h>
#include <cstdio>
namespace cg = cooperative_groups;

#ifndef MEGA
#define MEGA 1
#endif

typedef unsigned short u16;
using bf16x8 = __attribute__((ext_vector_type(8))) short;
using f32x16 = __attribute__((ext_vector_type(16))) float;
using f32x4v = __attribute__((ext_vector_type(4))) float;

constexpr int DM = 1024;
constexpr int M_TOT = 33408;
constexpr int M_PROMPT = 32896;
constexpr int T_P = 4112;
constexpr int LDP = 5376;
constexpr int N_IN = 5384;
constexpr int D_FF = 2816;
constexpr int NBLK16 = M_TOT / 16;
constexpr int C_Z = 0, C_R = 512, C_GG = 1024, C_XBC = 1536, C_K = 2560, C_V = 3072, C_XW = 3584, C_XA = 3648,
              C_XG = 3712, C_Q = 3840, C_F = 4352, C_I = 4864;
constexpr long O_YP = 0, O_YS = 33554432, O_PSSM = 34078720, O_PCONV = 35127296, O_PRWKV = 35176448,
               O_PSHIFT = 35700736, O_PHGRN = 35729408, O_SSSM = 36777984, O_SCONV = 37826560,
               O_SRWKV = 37875712, O_SSHIFT = 38400000, O_SHGRN = 38428672;

constexpr long OFF_W1T = 0, OFF_WOT = 5505024, OFF_WGU = 7077888, OFF_WDT = 12845056, OFF_W2T = 15728640, OFF_A2T = 15761408, OFF_G2T = 15794176, WB_TOTAL = 15859712;
constexpr long FOFF_RS = 0, FOFF_DTRAW = 33408, FOFF_RKS = 300672, FB_TOTAL = 567936;
struct Params {
  const float *x_prompt, *x_sample, *state_ssm, *state_conv, *state_rwkv, *state_shift, *state_hgrn, *meta,
      *norm1_w, *w_in, *conv_w, *conv_b, *dt_bias, *a_log, *d_skip, *ssd_norm_w, *rw_mu, *rw_w0, *rw_w2, *rw_a0,
      *rw_a2, *rw_g2, *rw_kk, *rw_ka, *rw_rk, *rw_lnx_w, *rw_lnx_b, *hg_lb, *hg_norm_w, *w_out, *norm2_w, *w_gate,
      *w_up, *w_down, *final_w;
  float* out;
  u16 *XB, *PROJ, *WB, *BND, *BND2, *ORW, *RWX;
  float *FB;
  unsigned* bar;
};

__device__ __forceinline__ u16 f2bf(float f) {
  unsigned u = __float_as_uint(f);
  u += 0x7fffu + ((u >> 16) & 1u);
  return (u16)(u >> 16);
}
__device__ __forceinline__ float bf2f(u16 h) { return __uint_as_float(((unsigned)h) << 16); }
__device__ __forceinline__ float frcp_(float x) { return __builtin_amdgcn_rcpf(x); }
__device__ __forceinline__ float sigmoidf_(float x) { return frcp_(1.f + __expf(-x)); }
__device__ __forceinline__ float siluf_(float x) { return x * frcp_(1.f + __expf(-x)); }
__device__ __forceinline__ float softplusf_(float x) { return x > 20.f ? x : log1pf(__expf(x)); }

template <int CTRL>
__device__ __forceinline__ float dppf(float v) {
  return __int_as_float(__builtin_amdgcn_update_dpp(0, __float_as_int(v), CTRL, 0xF, 0xF, true));
}
__device__ __forceinline__ float sum16(float v) {
  v += dppf<0xB1>(v);
  v += dppf<0x4E>(v);
  v += dppf<0x141>(v);
  v += dppf<0x140>(v);
  return v;
}
__device__ __forceinline__ void sum16x2(float& a, float& b) {
  a += dppf<0xB1>(a); b += dppf<0xB1>(b);
  a += dppf<0x4E>(a); b += dppf<0x4E>(b);
  a += dppf<0x141>(a); b += dppf<0x141>(b);
  a += dppf<0x140>(a); b += dppf<0x140>(b);
}
__device__ __forceinline__ float sum64(float v) {
  v = sum16(v);
  v += __shfl_xor(v, 16);
  v += __shfl_xor(v, 32);
  return v;
}

#define NOPK(x) asm("" : "+v"(x))
__device__ __forceinline__ int opaque_tid() {
  int t = threadIdx.x;
  asm volatile("" : "+v"(t));
  return t;
}
__device__ __forceinline__ int opaque_s(int v) {
  asm volatile("" : "+s"(v));
  return v;
}
#define BID opaque_s((int)blockIdx.x)
#define NBLK opaque_s((int)gridDim.x)
__device__ __forceinline__ int seq_base(int s) { return s < 8 ? s * T_P : M_PROMPT + (s - 8) * 64; }
__device__ __forceinline__ int seq_len(int s) { return s < 8 ? T_P : 64; }

__device__ __forceinline__ void phase_embed(const Params& p) {
  const long n4 = (long)M_TOT * 256;
  for (long idx = (long)BID * 256 + threadIdx.x, st_ = (long)NBLK * 256; idx < n4; idx += st_) {
    int m = (int)(idx >> 8), c4 = ((int)idx & 255) * 4;
    const float* src;
    if (m < M_PROMPT) {
      int b = m / T_P, t = m - b * T_P;
      src = (t < 16) ? p.meta + (long)t * DM : p.x_prompt + ((long)b * 4096 + (t - 16)) * DM;
    } else {
      src = p.x_sample + (long)(m - M_PROMPT) * DM;
    }
    float4 v = *(const float4*)(src + c4);
    ushort4 o;
    o.x = f2bf(v.x); o.y = f2bf(v.y); o.z = f2bf(v.z); o.w = f2bf(v.w);
    *(ushort4*)(p.XB + (long)m * DM + c4) = o;
  }
}

template <bool HAS_SCALE>
__device__ __forceinline__ void conv_tile(const float* __restrict__ src, int ldsrc, int srccol0, const float* __restrict__ scale,
                          u16* __restrict__ dst, int K, int k0, int n0, float* tile  ) {
  const int tid = opaque_tid();
  __syncthreads();
  {
    int nn = tid & 63, kb = tid >> 6;
#pragma unroll
    for (int i = 0; i < 16; ++i) {
      int kk = kb + 4 * i;
      float v = src[(long)(k0 + kk) * ldsrc + srccol0 + nn];
      if (HAS_SCALE) v *= scale[k0 + kk];
      tile[kk * 65 + nn] = v;
    }
  }
  __syncthreads();
  {
    int nn = tid >> 2, kq = (tid & 3) * 16;
    u16* d = dst + (long)(n0 + nn) * K + k0 + kq;
#pragma unroll
    for (int j = 0; j < 16; j += 2) {
      unsigned w = f2bf(tile[(kq + j) * 65 + nn]) | ((unsigned)f2bf(tile[(kq + j + 1) * 65 + nn]) << 16);
      *(unsigned*)(d + j) = w;
    }
  }
}

__device__ __forceinline__ int w1_srccol(int n0) {
  if (n0 < 512) return n0;
  if (n0 < 1024) return n0 - 512 + 1544;
  if (n0 < 1536) return n0 - 1024 + 4872;
  if (n0 < 2560) return n0 - 1536 + 512;
  if (n0 < 3840) return n0 - 2560 + 2056;
  return n0 - 3840 + 3336;
}

constexpr int CV_W1 = 16 * 84, CV_WO = 24 * 16, CV_WGU = 16 * 88, CV_WD = 44 * 16;
constexpr int CV_LORA = 32;
constexpr int CV_TOTAL = CV_W1 + CV_WO + CV_WGU + CV_WD + CV_LORA;

__device__ __forceinline__ void phase_convert(const Params& p, int l, float* smem) {
  for (int u = BID, nb_ = NBLK; u < CV_TOTAL; u += nb_) {
    if (u < CV_W1) {
      int kt = u % 16, nt = u / 16;
      conv_tile<true>(p.w_in + (long)l * DM * N_IN, N_IN, w1_srccol(nt * 64), p.norm1_w + l * DM, (p.WB + OFF_W1T), 1024, kt * 64,
                nt * 64, smem);
    } else if (u < CV_W1 + CV_WO) {
      int v = u - CV_W1;
      int kt = v % 24, nt = v / 24;
      conv_tile<false>(p.w_out + (long)l * 1536 * DM, DM, nt * 64, nullptr, (p.WB + OFF_WOT), 1536, kt * 64, nt * 64, smem);
    } else if (u < CV_W1 + CV_WO + CV_WGU) {
      int v = u - CV_W1 - CV_WO;
      int kt = v % 16, nt = v / 16;
      const float* wg = p.w_gate + (long)l * DM * D_FF;
      const float* wu = p.w_up + (long)l * DM * D_FF;
      const float* sc = p.norm2_w + l * DM;
      const int tid = opaque_tid();
      __syncthreads();
      {
        int nn = tid & 63, kb = tid >> 6;
        const float* src = (nn < 32) ? wg : wu;
        int col = nt * 32 + (nn & 31);
#pragma unroll
        for (int i = 0; i < 16; ++i) {
          int kk = kb + 4 * i;
          smem[kk * 65 + nn] = src[(long)(kt * 64 + kk) * D_FF + col] * sc[kt * 64 + kk];
        }
      }
      __syncthreads();
      {
        int nn = tid >> 2, kq = (tid & 3) * 16;
        u16* d = (p.WB + OFF_WGU) + (long)(nt * 64 + nn) * 1024 + kt * 64 + kq;
#pragma unroll
        for (int j = 0; j < 16; j += 2) {
          unsigned w = f2bf(smem[(kq + j) * 65 + nn]) | ((unsigned)f2bf(smem[(kq + j + 1) * 65 + nn]) << 16);
          *(unsigned*)(d + j) = w;
        }
      }
    } else if (u >= CV_W1 + CV_WO + CV_WGU + CV_WD) {
      int v = u - (CV_W1 + CV_WO + CV_WGU + CV_WD);
      const int tid = opaque_tid();
#pragma unroll 4
      for (int i = 0; i < 16; ++i) {
        int e = v * 4096 + i * 256 + tid;
        if (e < 32768) {
          int n = e >> 6, k = e & 63;
          (p.WB + OFF_W2T)[e] = f2bf(p.rw_w2[(long)l * 64 * 512 + k * 512 + n]);
        } else if (e < 65536) {
          int e2 = e - 32768, n = e2 >> 6, k = e2 & 63;
          (p.WB + OFF_A2T)[e2] = f2bf(p.rw_a2[(long)l * 64 * 512 + k * 512 + n]);
        } else {
          int e2 = e - 65536, n = e2 >> 7, k = e2 & 127;
          (p.WB + OFF_G2T)[e2] = f2bf(p.rw_g2[(long)l * 128 * 512 + k * 512 + n]);
        }
      }
    } else {
      int v = u - CV_W1 - CV_WO - CV_WGU;
      int kt = v % 44, nt = v / 44;
      conv_tile<false>(p.w_down + (long)l * D_FF * DM, DM, nt * 64, nullptr, (p.WB + OFF_WDT), D_FF, kt * 64, nt * 64, smem);
    }
  }
}

template <bool WITH_DT>
__device__ __forceinline__ void phase_rowstat(const Params& p, int l, float* smem) {
  const int tid = opaque_tid(), lane = tid & 63, wid = tid >> 6;
  float* dtw = smem;
  if (WITH_DT) {
    __syncthreads();
    const float* w = p.w_in + (long)l * DM * N_IN + 1536;
    const float* nw = p.norm1_w + l * DM;
    for (int i = tid; i < 8192; i += 256) {
      int k = i >> 3, h = i & 7;
      dtw[i] = w[(long)k * N_IN + h] * nw[k];
    }
    __syncthreads();
  }
  for (int blk = BID, nb_ = NBLK; blk < NBLK16; blk += nb_) {
    for (int rr = wid; rr < 16; rr += 4) {
      int m = blk * 16 + rr;
      float ss = 0.f;
      float d[8];
#pragma unroll
      for (int h = 0; h < 8; ++h) d[h] = 0.f;
#pragma unroll 1
      for (int j = 0; j < 4; ++j) {
        int k0 = lane * 4 + 256 * j;
        uint2 raw = *(const uint2*)(p.XB + (long)m * DM + k0);
        float xs[4] = {bf2f((u16)(raw.x & 0xffff)), bf2f((u16)(raw.x >> 16)), bf2f((u16)(raw.y & 0xffff)),
                       bf2f((u16)(raw.y >> 16))};
#pragma unroll
        for (int e = 0; e < 4; ++e) {
          float x = xs[e];
          ss += x * x;
          if (WITH_DT) {
            float4 w0 = *(const float4*)(dtw + (k0 + e) * 8);
            float4 w1 = *(const float4*)(dtw + (k0 + e) * 8 + 4);
            d[0] += x * w0.x; d[1] += x * w0.y; d[2] += x * w0.z; d[3] += x * w0.w;
            d[4] += x * w1.x; d[5] += x * w1.y; d[6] += x * w1.z; d[7] += x * w1.w;
          }
        }
      }
      ss = sum64(ss);
      float rs = rsqrtf(ss * (1.f / 1024.f) + 1e-6f);
      if (WITH_DT) {
#pragma unroll
        for (int h = 0; h < 8; ++h) d[h] = sum64(d[h]);
        if (lane == 0) {
#pragma unroll
          for (int h = 0; h < 8; ++h) (p.FB + FOFF_DTRAW)[(long)m * 8 + h] = d[h] * rs;
        }
      }
      if (lane == 0) (p.FB + FOFF_RS)[m] = rs;
    }
  }
}

constexpr int G_BK = 32, G_LDS_ROW = 80;
constexpr int G_OPER_BYTES = 128 * G_LDS_ROW;
template <int MODE>
__device__ __forceinline__ void phase_gemm(const Params& p, const u16* __restrict__ A, int lda, const u16* __restrict__ Bt, int K,
                           int nN, char* smem) {
  const int tid = opaque_tid(), lane = tid & 63, wid = tid >> 6, wm = wid >> 1, wn = wid & 1;
  const int nM = M_TOT / 128;
  const int ntiles = nM * nN;
  const int nk = K / G_BK;
  const int lrow = tid >> 2, lkc = tid & 3;
  for (int tile = BID, nb_ = NBLK; tile < ntiles; tile += nb_) {
    constexpr int GM = 32;
    int grp = tile / (GM * nN);
    int first_m = grp * GM;
    int gsz = min(GM, nM - first_m);
    int rem = tile - grp * GM * nN;
    int pm = first_m + rem % gsz, pn = rem / gsz;
    const u16* gA = A + (long)(pm * 128 + lrow) * lda + lkc * 8;
    const u16* gB = Bt + (long)(pn * 128 + lrow) * K + lkc * 8;
    f32x16 acc[2][2];
#pragma unroll
    for (int i = 0; i < 2; ++i)
#pragma unroll
      for (int j = 0; j < 2; ++j)
#pragma unroll
        for (int r = 0; r < 16; ++r) acc[i][j][r] = 0.f;
    uint4 xa0, xa1, xb0, xb1, ya0, ya1, yb0, yb1;
#define G_LOAD(S, KT)                                                  \
  {                                                                    \
    S##a0 = *(const uint4*)(gA + (KT) * G_BK);                         \
    S##a1 = *(const uint4*)(gA + (long)64 * lda + (KT) * G_BK);        \
    S##b0 = *(const uint4*)(gB + (KT) * G_BK);                         \
    S##b1 = *(const uint4*)(gB + (long)64 * K + (KT) * G_BK);          \
  }
#define G_STORE(S, BUF)                                                \
  {                                                                    \
    char* dA = smem + (BUF) * 2 * G_OPER_BYTES;                        \
    char* dB = dA + G_OPER_BYTES;                                      \
    *(uint4*)(dA + lrow * G_LDS_ROW + lkc * 16) = S##a0;               \
    *(uint4*)(dA + (lrow + 64) * G_LDS_ROW + lkc * 16) = S##a1;        \
    *(uint4*)(dB + lrow * G_LDS_ROW + lkc * 16) = S##b0;               \
    *(uint4*)(dB + (lrow + 64) * G_LDS_ROW + lkc * 16) = S##b1;        \
  }
#define G_COMPUTE(BUF)                                                                           \
  {                                                                                              \
    const char* sA = smem + (BUF) * 2 * G_OPER_BYTES;                                            \
    const char* sB = sA + G_OPER_BYTES;                                                          \
    _Pragma("unroll") for (int ks = 0; ks < 2; ++ks) {                                           \
      bf16x8 af[2], bfr[2];                                                                      \
      const int koff = (ks * 16 + (lane >> 5) * 8) * 2;                                          \
      _Pragma("unroll") for (int i = 0; i < 2; ++i)                                              \
        af[i] = *(const bf16x8*)(sA + (wm * 64 + i * 32 + (lane & 31)) * G_LDS_ROW + koff);      \
      _Pragma("unroll") for (int j = 0; j < 2; ++j)                                              \
        bfr[j] = *(const bf16x8*)(sB + (wn * 64 + j * 32 + (lane & 31)) * G_LDS_ROW + koff);     \
      __builtin_amdgcn_s_setprio(1);                                                             \
      _Pragma("unroll") for (int i = 0; i < 2; ++i)                                              \
        _Pragma("unroll") for (int j = 0; j < 2; ++j)                                            \
          acc[i][j] = __builtin_amdgcn_mfma_f32_32x32x16_bf16(af[i], bfr[j], acc[i][j], 0, 0, 0); \
      __builtin_amdgcn_s_setprio(0);                                                             \
    }                                                                                            \
  }
    G_LOAD(x, 0);
    G_LOAD(y, 1);
    __builtin_amdgcn_sched_barrier(0);
    __syncthreads();
    G_STORE(x, 0);
    __syncthreads();
    for (int kt = 0; kt < nk; kt += 2) {
      if (kt + 2 < nk) G_LOAD(x, kt + 2);
      __builtin_amdgcn_sched_barrier(0);
      G_COMPUTE(0);
      __builtin_amdgcn_sched_barrier(0);
      G_STORE(y, 1);
      __syncthreads();
      if (kt + 3 < nk) G_LOAD(y, kt + 3);
      __builtin_amdgcn_sched_barrier(0);
      G_COMPUTE(1);
      __builtin_amdgcn_sched_barrier(0);
      if (kt + 2 < nk) G_STORE(x, 0);
      __syncthreads();
    }
#undef G_LOAD
#undef G_STORE
#undef G_COMPUTE
    const int colb = pn * 128 + wn * 64 + (lane & 31);
    const int rowb = pm * 128 + wm * 64 + 4 * (lane >> 5);
    if (MODE == 1) {
#pragma unroll
      for (int i = 0; i < 2; ++i)
#pragma unroll
        for (int r = 0; r < 16; ++r) {
          int row = rowb + i * 32 + (r & 3) + 8 * (r >> 2);
          float rs = (p.FB + FOFF_RS)[row];
#pragma unroll
          for (int j = 0; j < 2; ++j) {
            int col = colb + j * 32;
            u16 v = f2bf(acc[i][j][r] * rs);
            p.PROJ[(long)row * LDP + col] = v;
            if ((row & 15) == 15) {
              int jj = -1;
              if (col >= C_R && col < C_GG) jj = col - C_R;
              else if (col >= C_K && col < C_Q) jj = col - C_K + 512;
              if (jj >= 0) p.BND[(long)(row >> 4) * 1792 + jj] = v;
            }
            if ((row & 15) >= 13 && col >= C_XBC + 512 && col < C_XBC + 1024)
              p.BND2[((long)(row >> 4) * 3 + ((row & 15) - 13)) * 512 + (col - (C_XBC + 512))] = v;
          }
        }
    } else if (MODE == 2) {
#pragma unroll
      for (int i = 0; i < 2; ++i)
#pragma unroll
        for (int r = 0; r < 16; ++r) {
          int row = rowb + i * 32 + (r & 3) + 8 * (r >> 2);
#pragma unroll
          for (int j = 0; j < 2; ++j) {
            int col = colb + j * 32;
            u16* px = p.XB + (long)row * DM + col;
            *px = f2bf(bf2f(*px) + acc[i][j][r]);
          }
        }
    } else {
      const int cact = pn * 64 + wn * 32 + (lane & 31);
      u16* ACT = p.PROJ;
#pragma unroll
      for (int i = 0; i < 2; ++i)
#pragma unroll
        for (int r = 0; r < 16; ++r) {
          int row = rowb + i * 32 + (r & 3) + 8 * (r >> 2);
          float rs = (p.FB + FOFF_RS)[row];
          float g = acc[i][0][r] * rs, u = acc[i][1][r] * rs;
          ACT[(long)row * D_FF + cact] = f2bf(siluf_(g) * u);
        }
    }
  }
}

__device__ __forceinline__ void phase_pre(const Params& p, int l, float* smem) {
  const int tid = opaque_tid(), lane = tid & 63, wid = tid >> 6;
  u16* XWb = (u16*)smem;
  u16* XAb = (u16*)smem + 16 * 72;
  constexpr int LDW = 260;
  float* AW = smem + 1152;
  float* AA = smem + 1152 + 16 * LDW;
  const float* mu = p.rw_mu + l * 1792;
  for (int blk = BID, nb_ = NBLK; blk < NBLK16; blk += nb_) {
    const int m0 = blk * 16;
    int s, t0;
    if (m0 < M_PROMPT) { s = m0 / T_P; t0 = m0 - s * T_P; } else { s = 8 + (m0 - M_PROMPT) / 64; t0 = (m0 - M_PROMPT) & 63; }
    const bool first = (t0 == 0);
    auto prev_of = [&](int j) -> float {
      if (!first) return bf2f(p.BND[(long)(blk - 1) * 1792 + j]);
      if (s < 8) return 0.f;
      return p.state_shift[((long)l * 8 + (s - 8)) * 1792 + j];
    };
    __syncthreads();
    {
      int j = 1536 + tid;
      float mj = mu[j];
      float pv = prev_of(j);
      u16* col = p.PROJ + (long)m0 * LDP + C_XW + tid;
#pragma unroll
      for (int t = 0; t < 16; ++t) {
        float x = bf2f(col[(long)t * LDP]);
        float sh = x + (pv - x) * mj;
        pv = x;
        if (tid < 64) XWb[t * 72 + tid] = f2bf(tanhf(sh));
        else if (tid < 128) XAb[t * 72 + (tid - 64)] = f2bf(sh);
        else col[(long)t * LDP] = f2bf(sigmoidf_(sh));
      }
    }
    __syncthreads();
#pragma unroll 1
    for (int c = 0; c < 2; ++c) {
      const int ch = tid + 256 * c;
      const int head = wid + 4 * c;
      float aw[16], aa[16];
      {
        bf16x8 axw[2], axa[2];
#pragma unroll
        for (int ks = 0; ks < 2; ++ks) {
          axw[ks] = *(const bf16x8*)(XWb + (lane & 15) * 72 + ks * 32 + (lane >> 4) * 8);
          axa[ks] = *(const bf16x8*)(XAb + (lane & 15) * 72 + ks * 32 + (lane >> 4) * 8);
        }
#pragma unroll
        for (int nt = 0; nt < 4; ++nt) {
          const int ncol = (wid * 4 + nt) * 16 + (lane & 15);
          const int n = c * 256 + ncol;
          f32x4v accw = {0.f, 0.f, 0.f, 0.f}, acca = {0.f, 0.f, 0.f, 0.f};
#pragma unroll
          for (int ks = 0; ks < 2; ++ks) {
            bf16x8 bw = *(const bf16x8*)((p.WB + OFF_W2T) + n * 64 + ks * 32 + (lane >> 4) * 8);
            bf16x8 ba = *(const bf16x8*)((p.WB + OFF_A2T) + n * 64 + ks * 32 + (lane >> 4) * 8);
            accw = __builtin_amdgcn_mfma_f32_16x16x32_bf16(axw[ks], bw, accw, 0, 0, 0);
            acca = __builtin_amdgcn_mfma_f32_16x16x32_bf16(axa[ks], ba, acca, 0, 0, 0);
          }
#pragma unroll
          for (int r = 0; r < 4; ++r) {
            AW[((lane >> 4) * 4 + r) * LDW + ncol] = accw[r];
            AA[((lane >> 4) * 4 + r) * LDW + ncol] = acca[r];
          }
        }
        __syncthreads();
#pragma unroll
        for (int t = 0; t < 16; ++t) { aw[t] = AW[t * LDW + tid]; aa[t] = AA[t * LDW + tid]; }
        __syncthreads();
      }
      {
        float w0 = p.rw_w0[l * 512 + ch], a0 = p.rw_a0[l * 512 + ch];
#pragma unroll
        for (int t = 0; t < 16; ++t) {
          float lw = -softplusf_(-(w0 + aw[t])) - 0.5f;
          float u = -__expf(lw);
          p.RWX[(long)(m0 + t) * 1536 + ch] = f2bf(u);
          aa[t] = sigmoidf_(a0 + aa[t]);
        }
      }
      float rt[16];
      {
        float mj = mu[ch];
        float pv = prev_of(ch);
        u16* col = p.PROJ + (long)m0 * LDP + C_R + ch;
#pragma unroll
        for (int t = 0; t < 16; ++t) {
          float x = bf2f(col[(long)t * LDP]);
          rt[t] = x + (pv - x) * mj;
          pv = x;
        }
#pragma unroll
        for (int t = 0; t < 16; ++t) col[(long)t * LDP] = f2bf(rt[t]);
      }
      {
        float mj = mu[512 + ch];
        float pv = prev_of(512 + ch);
        float kkw = p.rw_kk[l * 512 + ch], kaw = p.rw_ka[l * 512 + ch], rkw = p.rw_rk[l * 512 + ch];
        u16* col = p.PROJ + (long)m0 * LDP + C_K + ch;
        float kt[16];
#pragma unroll
        for (int t = 0; t < 16; ++t) {
          float x = bf2f(col[(long)t * LDP]);
          kt[t] = x + (pv - x) * mj;
          pv = x;
        }
#pragma unroll
        for (int t = 0; t < 16; ++t) {
          float kkv = kt[t] * kkw;
          float ssq = sum64(kkv * kkv);
          float kk = kkv * rsqrtf(ssq + 1e-12f);
          float a = aa[t];
          float kp = kt[t] * (1.f + (a - 1.f) * kaw);
          float rks = sum64(rt[t] * kp * rkw);
          col[(long)t * LDP] = f2bf(kp);
          p.RWX[(long)(m0 + t) * 1536 + 512 + ch] = f2bf(kk);
          p.RWX[(long)(m0 + t) * 1536 + 1024 + ch] = f2bf(kk * a);
          if (lane == 0) (p.FB + FOFF_RKS)[(long)(m0 + t) * 8 + head] = rks;
        }
      }
      {
        float mj = mu[1024 + ch];
        float pv = prev_of(1024 + ch);
        u16* col = p.PROJ + (long)m0 * LDP + C_V + ch;
        float vt[16];
#pragma unroll
        for (int t = 0; t < 16; ++t) {
          float x = bf2f(col[(long)t * LDP]);
          vt[t] = x + (pv - x) * mj;
          pv = x;
        }
#pragma unroll
        for (int t = 0; t < 16; ++t) col[(long)t * LDP] = f2bf(vt[t]);
      }
    }
#pragma unroll 1
    for (int c = 0; c < 2; ++c) {
      const int cc = tid + 256 * c;
      const float* cw = p.conv_w + (long)l * 4096 + 512 + cc;
      const float w0 = cw[0], w1 = cw[1024], w2 = cw[2048], w3 = cw[3072];
      const float bb = p.conv_b[l * 1024 + 512 + cc];
      float u3, u2, u1;
      if (!first) {
        const u16* pb = p.BND2 + (long)(blk - 1) * 1536 + cc;
        u3 = bf2f(pb[0]); u2 = bf2f(pb[512]); u1 = bf2f(pb[1024]);
      } else if (s >= 8) {
        const float* sc = p.state_conv + ((long)l * 8 + (s - 8)) * 3072 + 512 + cc;
        u3 = sc[0]; u2 = sc[1024]; u1 = sc[2048];
      } else {
        u3 = 0.f; u2 = 0.f; u1 = 0.f;
      }
      u16* col = p.PROJ + (long)m0 * LDP + C_XBC + 512 + cc;
      float yv[16];
#pragma unroll
      for (int t = 0; t < 16; ++t) {
        float u0 = bf2f(col[(long)t * LDP]);
        yv[t] = siluf_(w0 * u3 + w1 * u2 + w2 * u1 + w3 * u0 + bb);
        u3 = u2; u2 = u1; u1 = u0;
      }
#pragma unroll
      for (int t = 0; t < 16; ++t) col[(long)t * LDP] = f2bf(yv[t]);
    }
    if (t0 + 16 == seq_len(s)) {
      float* o = p.out + (s < 8 ? O_PSHIFT + ((long)l * 8 + s) * 1792 : O_SSHIFT + ((long)l * 8 + (s - 8)) * 1792);
      for (int j = tid; j < 1792; j += 256) o[j] = bf2f(p.BND[(long)blk * 1792 + j]);
    }
  }
}

__device__ __forceinline__ void scan_rwkv(const Params& p, int l, int s, int h, int q, float* smem) {
  const int tid = opaque_tid(), lane = tid & 63, wid = tid >> 6;
  float* R_ = smem;
  float* W_ = smem + 1024;
  float* K_ = smem + 2048;
  float* A_ = smem + 3072;
  float* B_ = smem + 4096;
  float* V_ = smem + 5120;
  float* O_ = smem + 5376;
  const int rl = wid * 4 + (lane >> 4);
  const int row = q * 16 + rl;
  const int ksl = (lane & 15) * 4;
  const int base = seq_base(s), T = seq_len(s);
  float s0 = 0.f, s1 = 0.f, s2 = 0.f, s3 = 0.f;
  if (s >= 8) {
    const float* st = p.state_rwkv + (((long)l * 8 + (s - 8)) * 8 + h) * 4096 + row * 64 + ksl;
    float4 v = *(const float4*)st;
    s0 = v.x; s1 = v.y; s2 = v.z; s3 = v.w;
  }
  const int stt = tid >> 4, skq = (tid & 15) * 4;
  const int nblk = T / 16;
  ushort4 r4, k4, u4, a4, b4;
  u16 vv;
  {
    const long m = base + stt;
    const u16* pr = p.PROJ + m * LDP;
    const u16* px = p.RWX + m * 1536;
    r4 = *(const ushort4*)(pr + C_R + h * 64 + skq);
    k4 = *(const ushort4*)(pr + C_K + h * 64 + skq);
    u4 = *(const ushort4*)(px + h * 64 + skq);
    a4 = *(const ushort4*)(px + 512 + h * 64 + skq);
    b4 = *(const ushort4*)(px + 1024 + h * 64 + skq);
    vv = pr[C_V + h * 64 + q * 16 + (tid & 15)];
  }
  __syncthreads();
  float* TR_ = smem + 5376 + 512;
  const bool wr = (lane & 15) == 0;
  const int ooff = wr ? rl : (512 + lane);
  const int ostr = wr ? 16 : 0;
  for (int blk = 0; blk < nblk; ++blk) {
    const long m = base + blk * 16 + stt;
    float* Oc = O_ + (blk & 1) * 256;
    {
      *(float4*)(R_ + stt * 64 + skq) = make_float4(bf2f(r4.x), bf2f(r4.y), bf2f(r4.z), bf2f(r4.w));
      *(float4*)(K_ + stt * 64 + skq) = make_float4(bf2f(k4.x), bf2f(k4.y), bf2f(k4.z), bf2f(k4.w));
      *(float4*)(W_ + stt * 64 + skq) =
          make_float4(__expf(bf2f(u4.x)), __expf(bf2f(u4.y)), __expf(bf2f(u4.z)), __expf(bf2f(u4.w)));
      *(float4*)(A_ + stt * 64 + skq) = make_float4(-bf2f(a4.x), -bf2f(a4.y), -bf2f(a4.z), -bf2f(a4.w));
      *(float4*)(B_ + stt * 64 + skq) = make_float4(bf2f(b4.x), bf2f(b4.y), bf2f(b4.z), bf2f(b4.w));
      V_[stt * 16 + (tid & 15)] = bf2f(vv);
    }
    __syncthreads();
    if (blk > 0)
      p.ORW[(m - 16) * 512 + h * 64 + q * 16 + (tid & 15)] = f2bf(O_[((blk - 1) & 1) * 256 + stt * 16 + (tid & 15)]);
    if (blk + 1 < nblk) {
      const u16* pr = p.PROJ + (m + 16) * LDP;
      const u16* px = p.RWX + (m + 16) * 1536;
      r4 = *(const ushort4*)(pr + C_R + h * 64 + skq);
      k4 = *(const ushort4*)(pr + C_K + h * 64 + skq);
      u4 = *(const ushort4*)(px + h * 64 + skq);
      a4 = *(const ushort4*)(px + 512 + h * 64 + skq);
      b4 = *(const ushort4*)(px + 1024 + h * 64 + skq);
      vv = pr[C_V + h * 64 + q * 16 + (tid & 15)];
    }
    __builtin_amdgcn_sched_barrier(0);
    {
      float4 a = *(const float4*)(A_ + ksl), w = *(const float4*)(W_ + ksl), b = *(const float4*)(B_ + ksl);
      float4 k = *(const float4*)(K_ + ksl), r = *(const float4*)(R_ + ksl);
      float v = V_[rl];
      float opart = 0.f;
#pragma unroll
      for (int tt = 0; tt < 16; ++tt) {
        float4 an, wn, bn, kn, rn;
        float vn;
        if (tt + 1 < 16) {
          an = *(const float4*)(A_ + (tt + 1) * 64 + ksl); wn = *(const float4*)(W_ + (tt + 1) * 64 + ksl);
          bn = *(const float4*)(B_ + (tt + 1) * 64 + ksl); kn = *(const float4*)(K_ + (tt + 1) * 64 + ksl);
          rn = *(const float4*)(R_ + (tt + 1) * 64 + ksl); vn = V_[(tt + 1) * 16 + rl];
        }
        __builtin_amdgcn_sched_barrier(0);
        float sa = fmaf(s0, a.x, fmaf(s1, a.y, fmaf(s2, a.z, s3 * a.w)));
        if (tt > 0) { sum16x2(sa, opart); Oc[ooff + (tt - 1) * ostr] = opart; }
        else sa = sum16(sa);
        s0 = fmaf(s0, w.x, fmaf(sa, b.x, v * k.x)); NOPK(s0);
        s1 = fmaf(s1, w.y, fmaf(sa, b.y, v * k.y)); NOPK(s1);
        s2 = fmaf(s2, w.z, fmaf(sa, b.z, v * k.z)); NOPK(s2);
        s3 = fmaf(s3, w.w, fmaf(sa, b.w, v * k.w)); NOPK(s3);
        opart = fmaf(s0, r.x, fmaf(s1, r.y, fmaf(s2, r.z, s3 * r.w)));
        if (tt == 15) { opart = sum16(opart); Oc[ooff + 15 * ostr] = opart; }
        __builtin_amdgcn_sched_barrier(0);
        if (tt + 1 < 16) { a = an; w = wn; b = bn; k = kn; r = rn; v = vn; }
      }
    }
    __builtin_amdgcn_sched_barrier(0);
    __syncthreads();
  }
  {
    const long m = base + (nblk - 1) * 16 + stt;
    p.ORW[m * 512 + h * 64 + q * 16 + (tid & 15)] = f2bf(O_[((nblk - 1) & 1) * 256 + stt * 16 + (tid & 15)]);
  }
  __syncthreads();
  {
    float* o = p.out + (s < 8 ? O_PRWKV + (((long)l * 8 + s) * 8 + h) * 4096
                              : O_SRWKV + (((long)l * 8 + (s - 8)) * 8 + h) * 4096);
    *(float4*)(o + row * 64 + ksl) = make_float4(s0, s1, s2, s3);
  }
}

__device__ __forceinline__ void scan_hgrn(const Params& p, int l, int s, int h, int q, float* smem) {
  const int tid = opaque_tid(), lane = tid & 63, wid = tid >> 6;
  float* Q_ = smem;
  float* F_ = smem + 2048;
  float* G_ = smem + 4096;
  float* I_ = smem + 6144;
  float* O_ = smem + 6400;
  const int rl = wid * 4 + (lane >> 4);
  const int row = q * 16 + rl;
  const int ksl4 = (lane & 15) * 4;
  const int base = seq_base(s), T = seq_len(s);
  float st[8];
#pragma unroll
  for (int i = 0; i < 8; ++i) st[i] = 0.f;
  if (s >= 8) {
    const float* sp = p.state_hgrn + (((long)l * 8 + (s - 8)) * 4 + h) * 16384;
#pragma unroll
    for (int i = 0; i < 8; ++i) st[i] = sp[((i >> 2) * 64 + ksl4 + (i & 3)) * 128 + row];
  }
  const int stt = tid >> 4, skq = (tid & 15) * 8;
  float lb[8];
#pragma unroll
  for (int i = 0; i < 8; ++i) {
    if (l == 0) lb[i] = 0.f;
    else {
      float x0 = p.hg_lb[h * 128 + skq + i], x1 = p.hg_lb[512 + h * 128 + skq + i];
      lb[i] = frcp_(1.f + __expf(x0 - x1));
    }
  }
  const int nblk = T / 16;
  uint4 q8, f8;
  u16 iv16;
  {
    const u16* pr = p.PROJ + (long)(base + stt) * LDP;
    q8 = *(const uint4*)(pr + C_Q + h * 128 + skq);
    f8 = *(const uint4*)(pr + C_F + h * 128 + skq);
    iv16 = pr[C_I + h * 128 + q * 16 + (tid & 15)];
  }
  __syncthreads();
  float* TR_ = smem + 6400 + 512;
  const bool wr = (lane & 15) == 0;
  const int ooff = wr ? rl : (512 + lane);
  const int ostr = wr ? 16 : 0;
  for (int blk = 0; blk < nblk; ++blk) {
    const long m = base + blk * 16 + stt;
    float* Oc = O_ + (blk & 1) * 256;
    {
      unsigned qw[4] = {q8.x, q8.y, q8.z, q8.w}, fw[4] = {f8.x, f8.y, f8.z, f8.w};
      float qv[8], fv[8];
#pragma unroll
      for (int e = 0; e < 8; ++e) {
        qv[e] = bf2f((u16)((qw[e >> 1] >> ((e & 1) * 16)) & 0xffff));
        float fz = bf2f((u16)((fw[e >> 1] >> ((e & 1) * 16)) & 0xffff));
        float ex = __expf(-fz);
        float sg = frcp_(1.f + ex);
        fv[e] = lb[e] + (1.f - lb[e]) * sg;
      }
      *(float4*)(Q_ + stt * 128 + skq) = make_float4(qv[0], qv[1], qv[2], qv[3]);
      *(float4*)(Q_ + stt * 128 + skq + 4) = make_float4(qv[4], qv[5], qv[6], qv[7]);
      *(float4*)(F_ + stt * 128 + skq) = make_float4(fv[0], fv[1], fv[2], fv[3]);
      *(float4*)(F_ + stt * 128 + skq + 4) = make_float4(fv[4], fv[5], fv[6], fv[7]);
      I_[stt * 16 + (tid & 15)] = bf2f(iv16);
    }
    __syncthreads();
    if (blk > 0) {
      u16* dp = p.PROJ + (m - 16) * LDP + C_I + h * 128 + q * 16 + (tid & 15);
      *dp = f2bf(O_[((blk - 1) & 1) * 256 + stt * 16 + (tid & 15)]);
    }
    if (blk + 1 < nblk) {
      const u16* pr = p.PROJ + (m + 16) * LDP;
      q8 = *(const uint4*)(pr + C_Q + h * 128 + skq);
      f8 = *(const uint4*)(pr + C_F + h * 128 + skq);
      iv16 = pr[C_I + h * 128 + q * 16 + (tid & 15)];
    }
    __builtin_amdgcn_sched_barrier(0);
    {
      float4 f0 = *(const float4*)(F_ + ksl4), f1 = *(const float4*)(F_ + 64 + ksl4);
      float4 q0 = *(const float4*)(Q_ + ksl4), q1 = *(const float4*)(Q_ + 64 + ksl4);
      float iv = I_[rl];
      float oprev = 0.f;
#pragma unroll
      for (int tt = 0; tt < 16; ++tt) {
        float4 f0n, f1n, q0n, q1n;
        float ivn;
        if (tt + 1 < 16) {
          const int o_ = (tt + 1) * 128;
          f0n = *(const float4*)(F_ + o_ + ksl4); f1n = *(const float4*)(F_ + o_ + 64 + ksl4);
          q0n = *(const float4*)(Q_ + o_ + ksl4); q1n = *(const float4*)(Q_ + o_ + 64 + ksl4);
          ivn = I_[(tt + 1) * 16 + rl];
        }
        __builtin_amdgcn_sched_barrier(0);
        st[0] = fmaf(st[0] - iv, f0.x, iv); NOPK(st[0]);
        st[1] = fmaf(st[1] - iv, f0.y, iv); NOPK(st[1]);
        st[2] = fmaf(st[2] - iv, f0.z, iv); NOPK(st[2]);
        st[3] = fmaf(st[3] - iv, f0.w, iv); NOPK(st[3]);
        st[4] = fmaf(st[4] - iv, f1.x, iv); NOPK(st[4]);
        st[5] = fmaf(st[5] - iv, f1.y, iv); NOPK(st[5]);
        st[6] = fmaf(st[6] - iv, f1.z, iv); NOPK(st[6]);
        st[7] = fmaf(st[7] - iv, f1.w, iv); NOPK(st[7]);
        float acc0 = fmaf(st[0], q0.x, fmaf(st[1], q0.y, fmaf(st[2], q0.z, st[3] * q0.w)));
        float acc1 = fmaf(st[4], q1.x, fmaf(st[5], q1.y, fmaf(st[6], q1.z, st[7] * q1.w)));
        float o = acc0 + acc1;
        if (tt & 1) { sum16x2(oprev, o); Oc[ooff + (tt - 1) * ostr] = oprev; Oc[ooff + tt * ostr] = o; }
        else oprev = o;
        __builtin_amdgcn_sched_barrier(0);
        if (tt + 1 < 16) { f0 = f0n; f1 = f1n; q0 = q0n; q1 = q1n; iv = ivn; }
      }
    }
    __builtin_amdgcn_sched_barrier(0);
    __syncthreads();
  }
  {
    const long m = base + (nblk - 1) * 16 + stt;
    u16* dp = p.PROJ + m * LDP + C_I + h * 128 + q * 16 + (tid & 15);
    *dp = f2bf(O_[((nblk - 1) & 1) * 256 + stt * 16 + (tid & 15)]);
  }
  __syncthreads();
  {
    float* o = p.out + (s < 8 ? O_PHGRN + (((long)l * 8 + s) * 4 + h) * 16384
                              : O_SHGRN + (((long)l * 8 + (s - 8)) * 4 + h) * 16384);
#pragma unroll
    for (int i = 0; i < 8; ++i) o[((i >> 2) * 64 + ksl4 + (i & 3)) * 128 + row] = st[i];
  }
}

__device__ __forceinline__ void scan_ssd(const Params& p, int l, int s, int h, int q, float* smem) {
  const int tid = opaque_tid(), lane = tid & 63, wid = tid >> 6;
  float* B_ = smem;
  float* C_ = smem + 2048;
  float* X_ = smem + 4096;
  float* O_ = smem + 4352;
  float* DT_ = smem + 5200;
  float* DE_ = smem + 5216;
  const int rl = wid * 4 + (lane >> 4);
  const int row = q * 16 + rl;
  const int ksl4 = (lane & 15) * 4;
  const int g = h >> 2;
  const int base = seq_base(s), T = seq_len(s);
  float st[8];
#pragma unroll
  for (int i = 0; i < 8; ++i) st[i] = 0.f;
  if (s >= 8) {
    const float* sp = p.state_ssm + (((long)l * 8 + (s - 8)) * 8 + h) * 8192 + row * 128 + ksl4;
    float4 a = *(const float4*)sp, b = *(const float4*)(sp + 64);
    st[0] = a.x; st[1] = a.y; st[2] = a.z; st[3] = a.w; st[4] = b.x; st[5] = b.y; st[6] = b.z; st[7] = b.w;
  }
  const float* cw = p.conv_w + (long)l * 4 * 1024;
  const int skq8 = (tid & 15) * 8;
  const int xc_x = h * 64 + q * 16 + (tid & 15);
  const float cx0 = cw[xc_x], cx1 = cw[1024 + xc_x], cx2 = cw[2048 + xc_x], cx3 = cw[3072 + xc_x];
  const float cxb = p.conv_b[l * 1024 + xc_x];
  const float dtb = p.dt_bias[l * 8 + h];
  const float aexp = __expf(p.a_log[l * 8 + h]);
  const float dsk = p.d_skip[l * 8 + h];
  const int stt = tid >> 4;
  const int nblk = T / 16;
  uint4 rawb, rawc;
  float xr[4];
  float dtr = 0.f;
  u16 zc = 0, zn = 0;
#define SSD_LOAD(M0)                                                              \
  {                                                                               \
    {                                                                             \
      const u16* prow = p.PROJ + ((long)(M0) + stt) * LDP + C_XBC + g * 128 + skq8; \
      rawb = *(const uint4*)(prow + 512);                                         \
      rawc = *(const uint4*)(prow + 768);                                         \
    }                                                                             \
    {                                                                             \
      const long mr = (long)(M0) + stt;                                           \
      const u16* colx = p.PROJ + mr * LDP + C_XBC + xc_x;                         \
      _Pragma("unroll") for (int j = 0; j < 4; ++j) {                             \
        const long mm = mr - 3 + j;                                               \
        float vx;                                                                 \
        if (mm >= base) vx = bf2f(colx[(long)(j - 3) * LDP]);                     \
        else vx = (s >= 8) ? p.state_conv[((long)l * 8 + (s - 8)) * 3072 + (3 + (int)(mm - base)) * 1024 + xc_x] : 0.f; \
        xr[j] = vx;                                                               \
      }                                                                           \
    }                                                                             \
    if (tid < 16) dtr = (p.FB + FOFF_DTRAW)[((long)(M0) + tid) * 8 + h];                      \
    zn = p.PROJ[((long)(M0) + stt) * LDP + C_Z + h * 64 + q * 16 + (tid & 15)];   \
  }
  SSD_LOAD(base);
  __syncthreads();
  const bool wr = (lane & 15) == 0;
  const int ooff = wr ? rl : (512 + lane);
  const int ostr = wr ? 16 : 0;
  u16 zp = 0;
  for (int blk = 0; blk < nblk; ++blk) {
    const long m0 = base + blk * 16;
    zp = zc;
    zc = zn;
    float* Oc = O_ + (blk & 1) * 256;
    {
      {
        const unsigned bw[4] = {rawb.x, rawb.y, rawb.z, rawb.w}, cwd[4] = {rawc.x, rawc.y, rawc.z, rawc.w};
        float bv[8], cv[8];
#pragma unroll
        for (int e = 0; e < 8; ++e) {
          bv[e] = bf2f((u16)((bw[e >> 1] >> ((e & 1) * 16)) & 0xffff));
          cv[e] = bf2f((u16)((cwd[e >> 1] >> ((e & 1) * 16)) & 0xffff));
        }
        *(float4*)(B_ + stt * 128 + skq8) = make_float4(bv[0], bv[1], bv[2], bv[3]);
        *(float4*)(B_ + stt * 128 + skq8 + 4) = make_float4(bv[4], bv[5], bv[6], bv[7]);
        *(float4*)(C_ + stt * 128 + skq8) = make_float4(cv[0], cv[1], cv[2], cv[3]);
        *(float4*)(C_ + stt * 128 + skq8 + 4) = make_float4(cv[4], cv[5], cv[6], cv[7]);
      }
      {
        float y = cx0 * xr[0] + cx1 * xr[1] + cx2 * xr[2] + cx3 * xr[3] + cxb;
        X_[stt * 16 + (tid & 15)] = siluf_(y);
      }
      if (tid < 16) {
        float dtv = softplusf_(dtr + dtb);
        DT_[tid] = dtv;
        DE_[tid] = __expf(-aexp * dtv);
      }
    }
    __syncthreads();
    if (blk > 0) {
      u16* pz = p.PROJ + (m0 - 16 + stt) * LDP + C_Z + h * 64 + q * 16 + (tid & 15);
      *pz = f2bf(O_[((blk - 1) & 1) * 256 + stt * 16 + (tid & 15)] * siluf_(bf2f(zp)));
    }
    if (blk + 1 < nblk) SSD_LOAD(m0 + 16);
    __builtin_amdgcn_sched_barrier(0);
    {
      float4 b0 = *(const float4*)(B_ + ksl4), b1 = *(const float4*)(B_ + 64 + ksl4);
      float4 c0 = *(const float4*)(C_ + ksl4), c1 = *(const float4*)(C_ + 64 + ksl4);
      float xv = X_[rl], dt = DT_[0], de = DE_[0];
      float yprev = 0.f, xvprev = 0.f;
#pragma unroll
      for (int tt = 0; tt < 16; ++tt) {
        float4 b0n, b1n, c0n, c1n;
        float xvn, dtn, den;
        if (tt + 1 < 16) {
          const int o_ = (tt + 1) * 128;
          b0n = *(const float4*)(B_ + o_ + ksl4); b1n = *(const float4*)(B_ + o_ + 64 + ksl4);
          c0n = *(const float4*)(C_ + o_ + ksl4); c1n = *(const float4*)(C_ + o_ + 64 + ksl4);
          xvn = X_[(tt + 1) * 16 + rl]; dtn = DT_[tt + 1]; den = DE_[tt + 1];
        }
        __builtin_amdgcn_sched_barrier(0);
        const float xd = xv * dt;
        st[0] = fmaf(st[0], de, xd * b0.x); NOPK(st[0]);
        st[1] = fmaf(st[1], de, xd * b0.y); NOPK(st[1]);
        st[2] = fmaf(st[2], de, xd * b0.z); NOPK(st[2]);
        st[3] = fmaf(st[3], de, xd * b0.w); NOPK(st[3]);
        st[4] = fmaf(st[4], de, xd * b1.x); NOPK(st[4]);
        st[5] = fmaf(st[5], de, xd * b1.y); NOPK(st[5]);
        st[6] = fmaf(st[6], de, xd * b1.z); NOPK(st[6]);
        st[7] = fmaf(st[7], de, xd * b1.w); NOPK(st[7]);
        float acc0 = fmaf(st[0], c0.x, fmaf(st[1], c0.y, fmaf(st[2], c0.z, st[3] * c0.w)));
        float acc1 = fmaf(st[4], c1.x, fmaf(st[5], c1.y, fmaf(st[6], c1.z, st[7] * c1.w)));
        float y = acc0 + acc1;
        if (tt & 1) { sum16x2(yprev, y); Oc[ooff + (tt - 1) * ostr] = yprev + dsk * xvprev; Oc[ooff + tt * ostr] = y + dsk * xv; }
        else { yprev = y; xvprev = xv; }
        __builtin_amdgcn_sched_barrier(0);
        if (tt + 1 < 16) { b0 = b0n; b1 = b1n; c0 = c0n; c1 = c1n; xv = xvn; dt = dtn; de = den; }
      }
    }
    __builtin_amdgcn_sched_barrier(0);
    __syncthreads();
  }
  {
    const long m0 = base + (nblk - 1) * 16;
    u16* pz = p.PROJ + (m0 + stt) * LDP + C_Z + h * 64 + q * 16 + (tid & 15);
    *pz = f2bf(O_[((nblk - 1) & 1) * 256 + stt * 16 + (tid & 15)] * siluf_(bf2f(zc)));
  }
  __syncthreads();
#undef SSD_LOAD
  {
    float* o = p.out + (s < 8 ? O_PSSM + (((long)l * 8 + s) * 8 + h) * 8192
                              : O_SSSM + (((long)l * 8 + (s - 8)) * 8 + h) * 8192);
    *(float4*)(o + row * 128 + ksl4) = make_float4(st[0], st[1], st[2], st[3]);
    *(float4*)(o + row * 128 + 64 + ksl4) = make_float4(st[4], st[5], st[6], st[7]);
  }
  if (h == 0 && q == 0) {
    float* o = p.out + (s < 8 ? O_PCONV + ((long)l * 8 + s) * 3072 : O_SCONV + ((long)l * 8 + (s - 8)) * 3072);
    const long lastblk = (long)(base + T) / 16 - 1;
    for (int i = tid; i < 3072; i += 256) {
      int r = i >> 10, c = i & 1023;
      o[i] = (c < 512) ? bf2f(p.PROJ[(long)(base + T - 3 + r) * LDP + C_XBC + c])
                       : bf2f(p.BND2[(lastblk * 3 + r) * 512 + (c - 512)]);
    }
  }
}

__device__ __forceinline__ void phase_scan(const Params& p, int l, float* smem) {
  for (int u = BID, nb_ = NBLK; u < 1536; u += nb_) {
    int sample = u >= 768;
    int v = sample ? u - 768 : u;
    int type = v % 3, w = v / 3;
    if (type == 0) {
      int q = w & 3, h = (w >> 2) & 7, b = w >> 5;
      scan_rwkv(p, l, b + 8 * sample, h, q, smem);
    } else if (type == 1) {
      int q = w & 7, h = (w >> 3) & 3, b = w >> 5;
      scan_hgrn(p, l, b + 8 * sample, h, q, smem);
    } else {
      int q = w & 3, h = (w >> 2) & 7, b = w >> 5;
      scan_ssd(p, l, b + 8 * sample, h, q, smem);
    }
  }
}

__device__ __forceinline__ void phase_post(const Params& p, int l, float* smem) {
  const int tid = opaque_tid(), lane = tid & 63, wid = tid >> 6;
  float* RED = smem;
  constexpr int LDG = 516;
  float* GA = smem + 256;
  for (int blk = BID, nb_ = NBLK; blk < NBLK16; blk += nb_) {
    const long m0 = (long)blk * 16;
    __syncthreads();
    {
      bf16x8 ag[4];
      const u16* arow = p.PROJ + (m0 + (lane & 15)) * LDP + C_XG + (lane >> 4) * 8;
#pragma unroll
      for (int ks = 0; ks < 4; ++ks) ag[ks] = *(const bf16x8*)(arow + ks * 32);
#pragma unroll
      for (int nt = 0; nt < 8; ++nt) {
        const int n = (wid * 8 + nt) * 16 + (lane & 15);
        f32x4v acc = {0.f, 0.f, 0.f, 0.f};
#pragma unroll
        for (int ks = 0; ks < 4; ++ks) {
          bf16x8 bg = *(const bf16x8*)((p.WB + OFF_G2T) + n * 128 + ks * 32 + (lane >> 4) * 8);
          acc = __builtin_amdgcn_mfma_f32_16x16x32_bf16(ag[ks], bg, acc, 0, 0, 0);
        }
#pragma unroll
        for (int r = 0; r < 4; ++r) GA[((lane >> 4) * 4 + r) * LDG + n] = acc[r];
      }
    }
#pragma unroll 1
    for (int c = 0; c < 2; ++c) {
      const int ch = tid + 256 * c, head = wid + 4 * c;
      float ys[16], oh[16];
#pragma unroll
      for (int t = 0; t < 16; ++t) {
        ys[t] = bf2f(p.PROJ[(m0 + t) * LDP + C_Z + ch]);
        oh[t] = bf2f(p.PROJ[(m0 + t) * LDP + C_I + ch]);
      }
#pragma unroll
      for (int t = 0; t < 16; ++t) {
        float a0 = sum64(ys[t] * ys[t]);
        float b0 = sum64(oh[t] * oh[t]);
        if (lane == 0) *(float2*)(RED + (wid * 16 + t) * 2) = make_float2(a0, b0);
      }
      __syncthreads();
      {
        const float nw0 = p.ssd_norm_w[l * 512 + ch];
        const float hw0 = p.hg_norm_w[l * 512 + ch];
        const int pw = (wid >> 1) * 2;
#pragma unroll
        for (int t = 0; t < 16; ++t) {
          float2 r0 = *(const float2*)(RED + (0 * 16 + t) * 2), r1 = *(const float2*)(RED + (1 * 16 + t) * 2);
          float2 r2 = *(const float2*)(RED + (2 * 16 + t) * 2), r3 = *(const float2*)(RED + (3 * 16 + t) * 2);
          float g0 = r0.x + r1.x + r2.x + r3.x;
          float2 pa = *(const float2*)(RED + (pw * 16 + t) * 2), pb = *(const float2*)(RED + ((pw + 1) * 16 + t) * 2);
          float h0 = pa.y + pb.y;
          u16* rowp = p.PROJ + (m0 + t) * LDP;
          rowp[C_Z + ch] = f2bf(ys[t] * rsqrtf(g0 * (1.f / 256.f) + 1e-6f) * nw0);
          float gg0 = bf2f(rowp[C_GG + ch]);
          rowp[C_GG + ch] = f2bf(oh[t] * rsqrtf(h0 * (1.f / 128.f) + 1e-6f) * hw0 * siluf_(gg0));
        }
      }
      {
        float lw = p.rw_lnx_w[l * 512 + ch], lbv = p.rw_lnx_b[l * 512 + ch];
#pragma unroll
        for (int t = 0; t < 16; ++t) {
          float o = bf2f(p.ORW[(m0 + t) * 512 + ch]);
          float mean = sum64(o) * (1.f / 64.f);
          float d = o - mean;
          float var = sum64(d * d) * (1.f / 64.f);
          float ln = d * rsqrtf(var + 64e-5f) * lw + lbv;
          float v = bf2f(p.PROJ[(m0 + t) * LDP + C_V + ch]);
          float bonus = (p.FB + FOFF_RKS)[(m0 + t) * 8 + head] * v;
          p.PROJ[(m0 + t) * LDP + C_R + ch] = f2bf((ln + bonus) * GA[t * LDG + ch]);
        }
      }
      __syncthreads();
    }
  }
}

__device__ __forceinline__ void phase_final(const Params& p) {
  const int tid = opaque_tid(), lane = tid & 63, wid = tid >> 6;
  for (int m = BID * 4 + wid, nb_ = NBLK; m < M_TOT; m += nb_ * 4) {
    float* dst;
    if (m < M_PROMPT) {
      int b = m / T_P, t = m - b * T_P;
      if (t < 16) continue;
      dst = p.out + O_YP + ((long)b * 4096 + (t - 16)) * DM;
    } else {
      dst = p.out + O_YS + (long)(m - M_PROMPT) * DM;
    }
    float x[16];
    float ss = 0.f;
#pragma unroll
    for (int j = 0; j < 2; ++j) {
      uint4 raw = *(const uint4*)(p.XB + (long)m * DM + lane * 8 + 512 * j);
      unsigned wv[4] = {raw.x, raw.y, raw.z, raw.w};
#pragma unroll
      for (int e = 0; e < 8; ++e) {
        x[j * 8 + e] = bf2f((u16)((wv[e >> 1] >> ((e & 1) * 16)) & 0xffff));
        ss += x[j * 8 + e] * x[j * 8 + e];
      }
    }
    ss = sum64(ss);
    float rs = rsqrtf(ss * (1.f / 1024.f) + 1e-6f);
#pragma unroll
    for (int j = 0; j < 2; ++j) {
      int k0 = lane * 8 + 512 * j;
      float4 w0 = *(const float4*)(p.final_w + k0), w1 = *(const float4*)(p.final_w + k0 + 4);
      *(float4*)(dst + k0) = make_float4(x[j * 8 + 0] * rs * w0.x, x[j * 8 + 1] * rs * w0.y, x[j * 8 + 2] * rs * w0.z,
                                         x[j * 8 + 3] * rs * w0.w);
      *(float4*)(dst + k0 + 4) = make_float4(x[j * 8 + 4] * rs * w1.x, x[j * 8 + 5] * rs * w1.y,
                                             x[j * 8 + 6] * rs * w1.z, x[j * 8 + 7] * rs * w1.w);
    }
  }
}


#define XB_TMO      128
#define XB_XCNT(j)  (256  + 64 * (j))
#define XB_XSUB(j)  (1280 + 64 * (j))
#define XB_XGEN(j)  (2304 + 64 * (j))
#define XB_TOP      3328
#define XB_TOPGEN   3392
#define XCD_BAR_WORDS 3456
#define XB_SPIN_CAP (1u << 22)
__device__ __forceinline__ unsigned xb_ld(unsigned* p) { return __hip_atomic_load(p, __ATOMIC_RELAXED, __HIP_MEMORY_SCOPE_AGENT); }
__device__ __forceinline__ unsigned xb_add(unsigned* p, unsigned v) { return __hip_atomic_fetch_add(p, v, __ATOMIC_RELAXED, __HIP_MEMORY_SCOPE_AGENT); }
__device__ __forceinline__ unsigned xb_xcc_id() { return (unsigned)__builtin_amdgcn_s_getreg((3 << 11) | 20) & 0xFu; }
#define XB_SPIN(cond, bar) do { unsigned _sp = 0; while (cond) { __builtin_amdgcn_s_sleep(1); \
    if ((++_sp & 255u) == 0u) { if (xb_ld(&(bar)[XB_TMO])) break; if (_sp > XB_SPIN_CAP) { atomicAdd(&(bar)[XB_TMO], 1u); break; } } } } while (0)

__device__ __forceinline__ void xcd_barrier_post(unsigned* bar) {
  if (threadIdx.x == 0) (void)xb_add(&bar[XB_XCNT(xb_xcc_id())], 1u);
}
__device__ __forceinline__ void xcd_barrier_complete(unsigned* bar, unsigned x, unsigned& nloc, unsigned& nx) {
  const unsigned G = gridDim.x;
  unsigned sum, cnt, mine, sp = 0u;
  for (;;) {
    sum = 0u; cnt = 0u; mine = 0u;
#pragma unroll
    for (unsigned j = 0; j < 16; ++j) { const unsigned c = xb_ld(&bar[XB_XCNT(j)]); sum += c; cnt += (c > 0u) ? 1u : 0u; mine = (j == x) ? c : mine; }
    if (sum == G) break;
    __builtin_amdgcn_s_sleep(1);
    if ((++sp & 255u) == 0u) { if (xb_ld(&bar[XB_TMO])) break; if (sp > XB_SPIN_CAP) { atomicAdd(&bar[XB_TMO], 1u); break; } }
  }
  nloc = mine > 0u ? mine : 1u; nx = cnt > 0u ? cnt : 1u;
}
__device__ __forceinline__ void xcd_barrier(unsigned* bar, volatile unsigned* st) {
  asm volatile("s_waitcnt vmcnt(0)" ::: "memory");
  __syncthreads();
  if (threadIdx.x == 0) {
    __builtin_amdgcn_s_waitcnt(0);
    const unsigned x = xb_xcc_id();
    unsigned nloc = st[0], nx = st[1];
    if (nloc == 0u) { xcd_barrier_complete(bar, x, nloc, nx); st[0] = nloc; st[1] = nx; }
    const unsigned old = xb_add(&bar[XB_XSUB(x)], 1u);
    const unsigned gen = old / nloc;
    if (old + 1u == (gen + 1u) * nloc) {
      __builtin_amdgcn_fence(__ATOMIC_RELEASE, "agent");
      asm volatile("s_waitcnt vmcnt(0)" ::: "memory");
      const unsigned og = xb_add(&bar[XB_TOP], 1u);
      const unsigned tg = og / nx;
      if (og + 1u == (tg + 1u) * nx) xb_add(&bar[XB_TOPGEN], 1u);
      else XB_SPIN(xb_ld(&bar[XB_TOPGEN]) == tg, bar);
      __builtin_amdgcn_fence(__ATOMIC_ACQUIRE, "agent");
      xb_add(&bar[XB_XGEN(x)], 1u);
      asm volatile("s_waitcnt vmcnt(0)" ::: "memory");
    } else {
      XB_SPIN(xb_ld(&bar[XB_XGEN(x)]) == gen, bar);
      __builtin_amdgcn_fence(__ATOMIC_ACQUIRE, "agent");
      asm volatile("s_waitcnt vmcnt(0)" ::: "memory");
    }
  }
  __syncthreads();
}

constexpr int SMEM_BYTES = 40960;
__device__ __forceinline__ void run_phase(const Params& p, int ph, char* smem) {
  if (ph == 0) { phase_embed(p); return; }
  if (ph == 19) { phase_final(p); return; }
  int l = (ph - 1) / 9, s = (ph - 1) % 9;
  float* fs = (float*)smem;
  switch (s) {
    case 0: phase_convert(p, l, fs); phase_rowstat<true>(p, l, fs); break;
    case 1: phase_gemm<1>(p, p.XB, DM, (p.WB + OFF_W1T), 1024, LDP / 128, smem); break;
    case 2: phase_pre(p, l, fs); break;
    case 3: phase_scan(p, l, fs); break;
    case 4: phase_post(p, l, fs); break;
    case 5: phase_gemm<2>(p, p.PROJ, LDP, (p.WB + OFF_WOT), 1536, 8, smem); break;
    case 6: phase_rowstat<false>(p, l, fs); break;
    case 7: phase_gemm<3>(p, p.XB, DM, (p.WB + OFF_WGU), 1024, 44, smem); break;
    case 8: phase_gemm<2>(p, p.PROJ, D_FF, (p.WB + OFF_WDT), D_FF, 8, smem); break;
  }
}
constexpr int N_PHASES = 20;

#if MEGA
__global__ void __launch_bounds__(256, 3) k_mega(Params p) {
  __shared__ __attribute__((aligned(16))) char smem[SMEM_BYTES];
  __shared__ uint4 xb_words;
  if (threadIdx.x == 0) { xb_words = make_uint4(0u, 0u, 0u, 0u); }
  __syncthreads();
  cg::grid_group grid = cg::this_grid();
  float* fs = (float*)smem;
  volatile unsigned* xst = (volatile unsigned*)&xb_words;
  xcd_barrier_post(p.bar);
  phase_embed(p);
  grid.sync();
#define GSYNC() do { unsigned* b_ = p.bar; asm volatile("" : "+s"(b_)); xcd_barrier(b_, xst); } while (0)
#pragma unroll 1
  for (int l0 = 0; l0 < 2; ++l0) {
    int l = opaque_s(l0);
    phase_convert(p, l, fs);
    phase_rowstat<true>(p, l, fs);
    GSYNC();
    l = opaque_s(l);
    phase_gemm<1>(p, p.XB, DM, (p.WB + OFF_W1T), 1024, LDP / 128, smem);
    GSYNC();
    l = opaque_s(l);
    phase_pre(p, l, fs);
    GSYNC();
    l = opaque_s(l);
    phase_scan(p, l, fs);
    GSYNC();
    l = opaque_s(l);
    phase_post(p, l, fs);
    GSYNC();
    l = opaque_s(l);
    phase_gemm<2>(p, p.PROJ, LDP, (p.WB + OFF_WOT), 1536, 8, smem);
    GSYNC();
    l = opaque_s(l);
    phase_rowstat<false>(p, l, fs);
    GSYNC();
    l = opaque_s(l);
    phase_gemm<3>(p, p.XB, DM, (p.WB + OFF_WGU), 1024, 44, smem);
    GSYNC();
    l = opaque_s(l);
    phase_gemm<2>(p, p.PROJ, D_FF, (p.WB + OFF_WDT), D_FF, 8, smem);
    GSYNC();
  }
  phase_final(p);
}
#else
template <int PH>
__global__ void __launch_bounds__(256, 3) k_phase(Params p) {
  __shared__ __attribute__((aligned(16))) char smem[SMEM_BYTES];
  run_phase(p, PH, smem);
}
template <int PH>
static void launch_all(const Params& p, int grid, hipStream_t stream) {
  hipLaunchKernelGGL(k_phase<PH>, dim3(grid), dim3(256), 0, stream, p);
  if constexpr (PH + 1 < N_PHASES) launch_all<PH + 1>(p, grid, stream);
}
#endif

extern "C" void kernel_launch(void* const* d_in, const int* in_sizes, int n_in, void* d_out, int out_size, void* d_ws,
                              size_t ws_size, hipStream_t stream) {
  Params p{};
  const float** pf = (const float**)&p;
  for (int i = 0; i < 35; ++i) pf[i] = (const float*)d_in[i];
  p.out = (float*)d_out;
  char* ws = (char*)d_ws;
  size_t off = 0;
  auto take = [&](size_t bytes) { char* r = ws + off; off += (bytes + 255) & ~(size_t)255; return r; };
  p.XB = (u16*)take((size_t)M_TOT * DM * 2);
  p.PROJ = (u16*)take((size_t)M_TOT * LDP * 2);
  p.WB = (u16*)take((size_t)WB_TOTAL * 2);
  p.BND = (u16*)take((size_t)NBLK16 * 1792 * 2);
  p.BND2 = (u16*)take((size_t)NBLK16 * 3 * 512 * 2);
  p.ORW = (u16*)take((size_t)M_TOT * 512 * 2);
  p.FB = (float*)take((size_t)FB_TOTAL * 4);
  p.bar = (unsigned*)take((size_t)XCD_BAR_WORDS * 4);
  p.RWX = (u16*)d_out;
  if (off > ws_size) fprintf(stderr, "workspace too small: need %zu have %zu\n", off, ws_size);
#if MEGA
  static int grid_blocks = 0;
  if (!grid_blocks) {
    int dev = 0, cus = 0, per_cu = 0;
    hipGetDevice(&dev);
    hipDeviceGetAttribute(&cus, hipDeviceAttributeMultiprocessorCount, dev);
    hipOccupancyMaxActiveBlocksPerMultiprocessor(&per_cu, k_mega, 256, 0);
    if (per_cu > 3) per_cu = 3;
    grid_blocks = cus * per_cu;
  }
  hipMemsetAsync(p.bar, 0, (size_t)XCD_BAR_WORDS * 4, stream);
  void* args[] = {&p};
  hipError_t e = hipLaunchCooperativeKernel((void*)k_mega, dim3(grid_blocks), dim3(256), args, 0, stream);
  if (e != hipSuccess) fprintf(stderr, "cooperative launch failed: %s (grid %d)\n", hipGetErrorString(e), grid_blocks);
#else
  launch_all<0>(p, 768, stream);
#endif
}
```

```cpp
#include <hip/hip_runtime.h>
#include <hip/hip_bf16.h>
#include <hip/hip_cooperative_groups.h>
#include <cstdio>
namespace cg = cooperative_groups;

#ifndef MEGA
#define MEGA 1
#endif

typedef unsigned short u16;
using bf16x8 = __attribute__((ext_vector_type(8))) short;
using f32x16 = __attribute__((ext_vector_type(16))) float;
using f32x4v = __attribute__((ext_vector_type(4))) float;

constexpr int DM = 1024;
constexpr int M_TOT = 33408;
constexpr int M_PROMPT = 32896;
constexpr int T_P = 4112;
constexpr int LDP = 5376;
constexpr int N_IN = 5384;
constexpr int D_FF = 2816;
constexpr int NBLK16 = M_TOT / 16;
constexpr int C_Z = 0, C_R = 512, C_GG = 1024, C_XBC = 1536, C_K = 2560, C_V = 3072, C_XW = 3584, C_XA = 3648,
              C_XG = 3712, C_Q = 3840, C_F = 4352, C_I = 4864;
constexpr long O_YP = 0, O_YS = 33554432, O_PSSM = 34078720, O_PCONV = 35127296, O_PRWKV = 35176448,
               O_PSHIFT = 35700736, O_PHGRN = 35729408, O_SSSM = 36777984, O_SCONV = 37826560,
               O_SRWKV = 37875712, O_SSHIFT = 38400000, O_SHGRN = 38428672;

constexpr long OFF_W1T = 0, OFF_WOT = 5505024, OFF_WGU = 7077888, OFF_WDT = 12845056, OFF_W2T = 15728640, OFF_A2T = 15761408, OFF_G2T = 15794176, WB_TOTAL = 15859712;
constexpr long FOFF_RS = 0, FOFF_DTRAW = 33408, FOFF_RKS = 300672, FB_TOTAL = 567936;
struct Params {
  const float *x_prompt, *x_sample, *state_ssm, *state_conv, *state_rwkv, *state_shift, *state_hgrn, *meta,
      *norm1_w, *w_in, *conv_w, *conv_b, *dt_bias, *a_log, *d_skip, *ssd_norm_w, *rw_mu, *rw_w0, *rw_w2, *rw_a0,
      *rw_a2, *rw_g2, *rw_kk, *rw_ka, *rw_rk, *rw_lnx_w, *rw_lnx_b, *hg_lb, *hg_norm_w, *w_out, *norm2_w, *w_gate,
      *w_up, *w_down, *final_w;
  float* out;
  u16 *XB, *PROJ, *WB, *BND, *BND2, *ORW, *RWX;
  float *FB;
  unsigned* bar;
};

__device__ __forceinline__ u16 f2bf(float f) {
  unsigned u = __float_as_uint(f);
  u += 0x7fffu + ((u >> 16) & 1u);
  return (u16)(u >> 16);
}
__device__ __forceinline__ float bf2f(u16 h) { return __uint_as_float(((unsigned)h) << 16); }
__device__ __forceinline__ float frcp_(float x) { return __builtin_amdgcn_rcpf(x); }
__device__ __forceinline__ float sigmoidf_(float x) { return frcp_(1.f + __expf(-x)); }
__device__ __forceinline__ float siluf_(float x) { return x * frcp_(1.f + __expf(-x)); }
__device__ __forceinline__ float softplusf_(float x) { return x > 20.f ? x : log1pf(__expf(x)); }

template <int CTRL>
__device__ __forceinline__ float dppf(float v) {
  return __int_as_float(__builtin_amdgcn_update_dpp(0, __float_as_int(v), CTRL, 0xF, 0xF, true));
}
__device__ __forceinline__ float sum16(float v) {
  v += dppf<0xB1>(v);
  v += dppf<0x4E>(v);
  v += dppf<0x141>(v);
  v += dppf<0x140>(v);
  return v;
}
__device__ __forceinline__ void sum16x2(float& a, float& b) {
  a += dppf<0xB1>(a); b += dppf<0xB1>(b);
  a += dppf<0x4E>(a); b += dppf<0x4E>(b);
  a += dppf<0x141>(a); b += dppf<0x141>(b);
  a += dppf<0x140>(a); b += dppf<0x140>(b);
}
__device__ __forceinline__ float sum64(float v) {
  v = sum16(v);
  v += __shfl_xor(v, 16);
  v += __shfl_xor(v, 32);
  return v;
}

#define NOPK(x) asm("" : "+v"(x))
__device__ __forceinline__ int opaque_tid() {
  int t = threadIdx.x;
  asm volatile("" : "+v"(t));
  return t;
}
__device__ __forceinline__ int opaque_s(int v) {
  asm volatile("" : "+s"(v));
  return v;
}
#define BID opaque_s((int)blockIdx.x)
#define NBLK opaque_s((int)gridDim.x)
__device__ __forceinline__ int seq_base(int s) { return s < 8 ? s * T_P : M_PROMPT + (s - 8) * 64; }
__device__ __forceinline__ int seq_len(int s) { return s < 8 ? T_P : 64; }

__device__ __forceinline__ void phase_embed(const Params& p) {
  const long n4 = (long)M_TOT * 256;
  for (long idx = (long)BID * 256 + threadIdx.x, st_ = (long)NBLK * 256; idx < n4; idx += st_) {
    int m = (int)(idx >> 8), c4 = ((int)idx & 255) * 4;
    const float* src;
    if (m < M_PROMPT) {
      int b = m / T_P, t = m - b * T_P;
      src = (t < 16) ? p.meta + (long)t * DM : p.x_prompt + ((long)b * 4096 + (t - 16)) * DM;
    } else {
      src = p.x_sample + (long)(m - M_PROMPT) * DM;
    }
    float4 v = *(const float4*)(src + c4);
    ushort4 o;
    o.x = f2bf(v.x); o.y = f2bf(v.y); o.z = f2bf(v.z); o.w = f2bf(v.w);
    *(ushort4*)(p.XB + (long)m * DM + c4) = o;
  }
}

template <bool HAS_SCALE>
__device__ __forceinline__ void conv_tile(const float* __restrict__ src, int ldsrc, int srccol0, const float* __restrict__ scale,
                          u16* __restrict__ dst, int K, int k0, int n0, float* tile  ) {
  const int tid = opaque_tid();
  __syncthreads();
  {
    int nn = tid & 63, kb = tid >> 6;
#pragma unroll
    for (int i = 0; i < 16; ++i) {
      int kk = kb + 4 * i;
      float v = src[(long)(k0 + kk) * ldsrc + srccol0 + nn];
      if (HAS_SCALE) v *= scale[k0 + kk];
      tile[kk * 65 + nn] = v;
    }
  }
  __syncthreads();
  {
    int nn = tid >> 2, kq = (tid & 3) * 16;
    u16* d = dst + (long)(n0 + nn) * K + k0 + kq;
#pragma unroll
    for (int j = 0; j < 16; j += 2) {
      unsigned w = f2bf(tile[(kq + j) * 65 + nn]) | ((unsigned)f2bf(tile[(kq + j + 1) * 65 + nn]) << 16);
      *(unsigned*)(d + j) = w;
    }
  }
}

__device__ __forceinline__ int w1_srccol(int n0) {
  if (n0 < 512) return n0;
  if (n0 < 1024) return n0 - 512 + 1544;
  if (n0 < 1536) return n0 - 1024 + 4872;
  if (n0 < 2560) return n0 - 1536 + 512;
  if (n0 < 3840) return n0 - 2560 + 2056;
  return n0 - 3840 + 3336;
}

constexpr int CV_W1 = 16 * 84, CV_WO = 24 * 16, CV_WGU = 16 * 88, CV_WD = 44 * 16;
constexpr int CV_LORA = 32;
constexpr int CV_TOTAL = CV_W1 + CV_WO + CV_WGU + CV_WD + CV_LORA;

__device__ __forceinline__ void phase_convert(const Params& p, int l, float* smem) {
  for (int u = BID, nb_ = NBLK; u < CV_TOTAL; u += nb_) {
    if (u < CV_W1) {
      int kt = u % 16, nt = u / 16;
      conv_tile<true>(p.w_in + (long)l * DM * N_IN, N_IN, w1_srccol(nt * 64), p.norm1_w + l * DM, (p.WB + OFF_W1T), 1024, kt * 64,
                nt * 64, smem);
    } else if (u < CV_W1 + CV_WO) {
      int v = u - CV_W1;
      int kt = v % 24, nt = v / 24;
      conv_tile<false>(p.w_out + (long)l * 1536 * DM, DM, nt * 64, nullptr, (p.WB + OFF_WOT), 1536, kt * 64, nt * 64, smem);
    } else if (u < CV_W1 + CV_WO + CV_WGU) {
      int v = u - CV_W1 - CV_WO;
      int kt = v % 16, nt = v / 16;
      const float* wg = p.w_gate + (long)l * DM * D_FF;
      const float* wu = p.w_up + (long)l * DM * D_FF;
      const float* sc = p.norm2_w + l * DM;
      const int tid = opaque_tid();
      __syncthreads();
      {
        int nn = tid & 63, kb = tid >> 6;
        const float* src = (nn < 32) ? wg : wu;
        int col = nt * 32 + (nn & 31);
#pragma unroll
        for (int i = 0; i < 16; ++i) {
          int kk = kb + 4 * i;
          smem[kk * 65 + nn] = src[(long)(kt * 64 + kk) * D_FF + col] * sc[kt * 64 + kk];
        }
      }
      __syncthreads();
      {
        int nn = tid >> 2, kq = (tid & 3) * 16;
        u16* d = (p.WB + OFF_WGU) + (long)(nt * 64 + nn) * 1024 + kt * 64 + kq;
#pragma unroll
        for (int j = 0; j < 16; j += 2) {
          unsigned w = f2bf(smem[(kq + j) * 65 + nn]) | ((unsigned)f2bf(smem[(kq + j + 1) * 65 + nn]) << 16);
          *(unsigned*)(d + j) = w;
        }
      }
    } else if (u >= CV_W1 + CV_WO + CV_WGU + CV_WD) {
      int v = u - (CV_W1 + CV_WO + CV_WGU + CV_WD);
      const int tid = opaque_tid();
#pragma unroll 4
      for (int i = 0; i < 16; ++i) {
        int e = v * 4096 + i * 256 + tid;
        if (e < 32768) {
          int n = e >> 6, k = e & 63;
          (p.WB + OFF_W2T)[e] = f2bf(p.rw_w2[(long)l * 64 * 512 + k * 512 + n]);
        } else if (e < 65536) {
          int e2 = e - 32768, n = e2 >> 6, k = e2 & 63;
          (p.WB + OFF_A2T)[e2] = f2bf(p.rw_a2[(long)l * 64 * 512 + k * 512 + n]);
        } else {
          int e2 = e - 65536, n = e2 >> 7, k = e2 & 127;
          (p.WB + OFF_G2T)[e2] = f2bf(p.rw_g2[(long)l * 128 * 512 + k * 512 + n]);
        }
      }
    } else {
      int v = u - CV_W1 - CV_WO - CV_WGU;
      int kt = v % 44, nt = v / 44;
      conv_tile<false>(p.w_down + (long)l * D_FF * DM, DM, nt * 64, nullptr, (p.WB + OFF_WDT), D_FF, kt * 64, nt * 64, smem);
    }
  }
}

template <bool WITH_DT>
__device__ __forceinline__ void phase_rowstat(const Params& p, int l, float* smem) {
  const int tid = opaque_tid(), lane = tid & 63, wid = tid >> 6;
  float* dtw = smem;
  if (WITH_DT) {
    __syncthreads();
    const float* w = p.w_in + (long)l * DM * N_IN + 1536;
    const float* nw = p.norm1_w + l * DM;
    for (int i = tid; i < 8192; i += 256) {
      int k = i >> 3, h = i & 7;
      dtw[i] = w[(long)k * N_IN + h] * nw[k];
    }
    __syncthreads();
  }
  for (int blk = BID, nb_ = NBLK; blk < NBLK16; blk += nb_) {
    for (int rr = wid; rr < 16; rr += 4) {
      int m = blk * 16 + rr;
      float ss = 0.f;
      float d[8];
#pragma unroll
      for (int h = 0; h < 8; ++h) d[h] = 0.f;
#pragma unroll 1
      for (int j = 0; j < 4; ++j) {
        int k0 = lane * 4 + 256 * j;
        uint2 raw = *(const uint2*)(p.XB + (long)m * DM + k0);
        float xs[4] = {bf2f((u16)(raw.x & 0xffff)), bf2f((u16)(raw.x >> 16)), bf2f((u16)(raw.y & 0xffff)),
                       bf2f((u16)(raw.y >> 16))};
#pragma unroll
        for (int e = 0; e < 4; ++e) {
          float x = xs[e];
          ss += x * x;
          if (WITH_DT) {
            float4 w0 = *(const float4*)(dtw + (k0 + e) * 8);
            float4 w1 = *(const float4*)(dtw + (k0 + e) * 8 + 4);
            d[0] += x * w0.x; d[1] += x * w0.y; d[2] += x * w0.z; d[3] += x * w0.w;
            d[4] += x * w1.x; d[5] += x * w1.y; d[6] += x * w1.z; d[7] += x * w1.w;
          }
        }
      }
      ss = sum64(ss);
      float rs = rsqrtf(ss * (1.f / 1024.f) + 1e-6f);
      if (WITH_DT) {
#pragma unroll
        for (int h = 0; h < 8; ++h) d[h] = sum64(d[h]);
        if (lane == 0) {
#pragma unroll
          for (int h = 0; h < 8; ++h) (p.FB + FOFF_DTRAW)[(long)m * 8 + h] = d[h] * rs;
        }
      }
      if (lane == 0) (p.FB + FOFF_RS)[m] = rs;
    }
  }
}

constexpr int G_BK = 32, G_LDS_ROW = 80;
constexpr int G_OPER_BYTES = 128 * G_LDS_ROW;
template <int MODE>
__device__ __forceinline__ void phase_gemm(const Params& p, const u16* __restrict__ A, int lda, const u16* __restrict__ Bt, int K,
                           int nN, char* smem) {
  const int tid = opaque_tid(), lane = tid & 63, wid = tid >> 6, wm = wid >> 1, wn = wid & 1;
  const int nM = M_TOT / 128;
  const int ntiles = nM * nN;
  const int nk = K / G_BK;
  const int lrow = tid >> 2, lkc = tid & 3;
  for (int tile = BID, nb_ = NBLK; tile < ntiles; tile += nb_) {
    constexpr int GM = 32;
    int grp = tile / (GM * nN);
    int first_m = grp * GM;
    int gsz = min(GM, nM - first_m);
    int rem = tile - grp * GM * nN;
    int pm = first_m + rem % gsz, pn = rem / gsz;
    const u16* gA = A + (long)(pm * 128 + lrow) * lda + lkc * 8;
    const u16* gB = Bt + (long)(pn * 128 + lrow) * K + lkc * 8;
    f32x16 acc[2][2];
#pragma unroll
    for (int i = 0; i < 2; ++i)
#pragma unroll
      for (int j = 0; j < 2; ++j)
#pragma unroll
        for (int r = 0; r < 16; ++r) acc[i][j][r] = 0.f;
    uint4 xa0, xa1, xb0, xb1, ya0, ya1, yb0, yb1, za0, za1, zb0, zb1;
#define G_LOAD(S, KT)                                                  \
  {                                                                    \
    S##a0 = *(const uint4*)(gA + (KT) * G_BK);                         \
    S##a1 = *(const uint4*)(gA + (long)64 * lda + (KT) * G_BK);        \
    S##b0 = *(const uint4*)(gB + (KT) * G_BK);                         \
    S##b1 = *(const uint4*)(gB + (long)64 * K + (KT) * G_BK);          \
  }
#define G_STORE(S, BUF)                                                \
  {                                                                    \
    char* dA = smem + (BUF) * 2 * G_OPER_BYTES;                        \
    char* dB = dA + G_OPER_BYTES;                                      \
    *(uint4*)(dA + lrow * G_LDS_ROW + lkc * 16) = S##a0;               \
    *(uint4*)(dA + (lrow + 64) * G_LDS_ROW + lkc * 16) = S##a1;        \
    *(uint4*)(dB + lrow * G_LDS_ROW + lkc * 16) = S##b0;               \
    *(uint4*)(dB + (lrow + 64) * G_LDS_ROW + lkc * 16) = S##b1;        \
  }
#define G_COMPUTE(BUF)                                                                           \
  {                                                                                              \
    const char* sA = smem + (BUF) * 2 * G_OPER_BYTES;                                            \
    const char* sB = sA + G_OPER_BYTES;                                                          \
    _Pragma("unroll") for (int ks = 0; ks < 2; ++ks) {                                           \
      bf16x8 af[2], bfr[2];                                                                      \
      const int koff = (ks * 16 + (lane >> 5) * 8) * 2;                                          \
      _Pragma("unroll") for (int i = 0; i < 2; ++i)                                              \
        af[i] = *(const bf16x8*)(sA + (wm * 64 + i * 32 + (lane & 31)) * G_LDS_ROW + koff);      \
      _Pragma("unroll") for (int j = 0; j < 2; ++j)                                              \
        bfr[j] = *(const bf16x8*)(sB + (wn * 64 + j * 32 + (lane & 31)) * G_LDS_ROW + koff);     \
      __builtin_amdgcn_s_setprio(1);                                                             \
      _Pragma("unroll") for (int i = 0; i < 2; ++i)                                              \
        _Pragma("unroll") for (int j = 0; j < 2; ++j)                                            \
          acc[i][j] = __builtin_amdgcn_mfma_f32_32x32x16_bf16(af[i], bfr[j], acc[i][j], 0, 0, 0); \
      __builtin_amdgcn_s_setprio(0);                                                             \
    }                                                                                            \
  }
    G_LOAD(x, 0);
    G_LOAD(y, 1);
    G_LOAD(z, 2);
    __builtin_amdgcn_sched_barrier(0);
    __syncthreads();
    G_STORE(x, 0);
    __syncthreads();
#define G_STEP(T, SNEXT, SFREE, BUF)                          \
    if ((T) < nk) {                                           \
      if ((T) + 1 < nk) G_STORE(SNEXT, (BUF) ^ 1);            \
      if ((T) + 3 < nk) G_LOAD(SFREE, (T) + 3);               \
      __builtin_amdgcn_sched_barrier(0);                      \
      G_COMPUTE(BUF);                                         \
      __builtin_amdgcn_sched_barrier(0);                      \
      __syncthreads();                                        \
    }
    for (int kt = 0; kt < nk; kt += 6) {
      G_STEP(kt + 0, y, x, 0);
      G_STEP(kt + 1, z, y, 1);
      G_STEP(kt + 2, x, z, 0);
      G_STEP(kt + 3, y, x, 1);
      G_STEP(kt + 4, z, y, 0);
      G_STEP(kt + 5, x, z, 1);
    }
#undef G_STEP
#undef G_LOAD
#undef G_STORE
#undef G_COMPUTE
    const int colb = pn * 128 + wn * 64 + (lane & 31);
    const int rowb = pm * 128 + wm * 64 + 4 * (lane >> 5);
    if (MODE == 1) {
#pragma unroll
      for (int i = 0; i < 2; ++i)
#pragma unroll
        for (int r = 0; r < 16; ++r) {
          int row = rowb + i * 32 + (r & 3) + 8 * (r >> 2);
          float rs = (p.FB + FOFF_RS)[row];
#pragma unroll
          for (int j = 0; j < 2; ++j) {
            int col = colb + j * 32;
            u16 v = f2bf(acc[i][j][r] * rs);
            p.PROJ[(long)row * LDP + col] = v;
            if ((row & 15) == 15) {
              int jj = -1;
              if (col >= C_R && col < C_GG) jj = col - C_R;
              else if (col >= C_K && col < C_Q) jj = col - C_K + 512;
              if (jj >= 0) p.BND[(long)(row >> 4) * 1792 + jj] = v;
            }
            if ((row & 15) >= 13 && col >= C_XBC + 512 && col < C_XBC + 1024)
              p.BND2[((long)(row >> 4) * 3 + ((row & 15) - 13)) * 512 + (col - (C_XBC + 512))] = v;
          }
        }
    } else if (MODE == 2) {
#pragma unroll
      for (int i = 0; i < 2; ++i)
#pragma unroll
        for (int r = 0; r < 16; ++r) {
          int row = rowb + i * 32 + (r & 3) + 8 * (r >> 2);
#pragma unroll
          for (int j = 0; j < 2; ++j) {
            int col = colb + j * 32;
            u16* px = p.XB + (long)row * DM + col;
            *px = f2bf(bf2f(*px) + acc[i][j][r]);
          }
        }
    } else {
      const int cact = pn * 64 + wn * 32 + (lane & 31);
      u16* ACT = p.PROJ;
#pragma unroll
      for (int i = 0; i < 2; ++i)
#pragma unroll
        for (int r = 0; r < 16; ++r) {
          int row = rowb + i * 32 + (r & 3) + 8 * (r >> 2);
          float rs = (p.FB + FOFF_RS)[row];
          float g = acc[i][0][r] * rs, u = acc[i][1][r] * rs;
          ACT[(long)row * D_FF + cact] = f2bf(siluf_(g) * u);
        }
    }
  }
}

__device__ __forceinline__ void phase_pre(const Params& p, int l, float* smem) {
  const int tid = opaque_tid(), lane = tid & 63, wid = tid >> 6;
  u16* XWb = (u16*)smem;
  u16* XAb = (u16*)smem + 16 * 72;
  constexpr int LDW = 260;
  float* AW = smem + 1152;
  float* AA = smem + 1152 + 16 * LDW;
  const float* mu = p.rw_mu + l * 1792;
  for (int blk = BID, nb_ = NBLK; blk < NBLK16; blk += nb_) {
    const int m0 = blk * 16;
    int s, t0;
    if (m0 < M_PROMPT) { s = m0 / T_P; t0 = m0 - s * T_P; } else { s = 8 + (m0 - M_PROMPT) / 64; t0 = (m0 - M_PROMPT) & 63; }
    const bool first = (t0 == 0);
    auto prev_of = [&](int j) -> float {
      if (!first) return bf2f(p.BND[(long)(blk - 1) * 1792 + j]);
      if (s < 8) return 0.f;
      return p.state_shift[((long)l * 8 + (s - 8)) * 1792 + j];
    };
    __syncthreads();
    {
      int j = 1536 + tid;
      float mj = mu[j];
      float pv = prev_of(j);
      u16* col = p.PROJ + (long)m0 * LDP + C_XW + tid;
#pragma unroll
      for (int t = 0; t < 16; ++t) {
        float x = bf2f(col[(long)t * LDP]);
        float sh = x + (pv - x) * mj;
        pv = x;
        if (tid < 64) XWb[t * 72 + tid] = f2bf(tanhf(sh));
        else if (tid < 128) XAb[t * 72 + (tid - 64)] = f2bf(sh);
        else col[(long)t * LDP] = f2bf(sigmoidf_(sh));
      }
    }
    __syncthreads();
#pragma unroll 1
    for (int c = 0; c < 2; ++c) {
      const int ch = tid + 256 * c;
      const int head = wid + 4 * c;
      float aw[16], aa[16];
      {
        bf16x8 axw[2], axa[2];
#pragma unroll
        for (int ks = 0; ks < 2; ++ks) {
          axw[ks] = *(const bf16x8*)(XWb + (lane & 15) * 72 + ks * 32 + (lane >> 4) * 8);
          axa[ks] = *(const bf16x8*)(XAb + (lane & 15) * 72 + ks * 32 + (lane >> 4) * 8);
        }
#pragma unroll
        for (int nt = 0; nt < 4; ++nt) {
          const int ncol = (wid * 4 + nt) * 16 + (lane & 15);
          const int n = c * 256 + ncol;
          f32x4v accw = {0.f, 0.f, 0.f, 0.f}, acca = {0.f, 0.f, 0.f, 0.f};
#pragma unroll
          for (int ks = 0; ks < 2; ++ks) {
            bf16x8 bw = *(const bf16x8*)((p.WB + OFF_W2T) + n * 64 + ks * 32 + (lane >> 4) * 8);
            bf16x8 ba = *(const bf16x8*)((p.WB + OFF_A2T) + n * 64 + ks * 32 + (lane >> 4) * 8);
            accw = __builtin_amdgcn_mfma_f32_16x16x32_bf16(axw[ks], bw, accw, 0, 0, 0);
            acca = __builtin_amdgcn_mfma_f32_16x16x32_bf16(axa[ks], ba, acca, 0, 0, 0);
          }
#pragma unroll
          for (int r = 0; r < 4; ++r) {
            AW[((lane >> 4) * 4 + r) * LDW + ncol] = accw[r];
            AA[((lane >> 4) * 4 + r) * LDW + ncol] = acca[r];
          }
        }
        __syncthreads();
#pragma unroll
        for (int t = 0; t < 16; ++t) { aw[t] = AW[t * LDW + tid]; aa[t] = AA[t * LDW + tid]; }
        __syncthreads();
      }
      {
        float w0 = p.rw_w0[l * 512 + ch], a0 = p.rw_a0[l * 512 + ch];
#pragma unroll
        for (int t = 0; t < 16; ++t) {
          float lw = -softplusf_(-(w0 + aw[t])) - 0.5f;
          float u = -__expf(lw);
          p.RWX[(long)(m0 + t) * 1536 + ch] = f2bf(u);
          aa[t] = sigmoidf_(a0 + aa[t]);
        }
      }
      float rt[16];
      {
        float mj = mu[ch];
        float pv = prev_of(ch);
        u16* col = p.PROJ + (long)m0 * LDP + C_R + ch;
#pragma unroll
        for (int t = 0; t < 16; ++t) {
          float x = bf2f(col[(long)t * LDP]);
          rt[t] = x + (pv - x) * mj;
          pv = x;
        }
#pragma unroll
        for (int t = 0; t < 16; ++t) col[(long)t * LDP] = f2bf(rt[t]);
      }
      {
        float mj = mu[512 + ch];
        float pv = prev_of(512 + ch);
        float kkw = p.rw_kk[l * 512 + ch], kaw = p.rw_ka[l * 512 + ch], rkw = p.rw_rk[l * 512 + ch];
        u16* col = p.PROJ + (long)m0 * LDP + C_K + ch;
        float kt[16];
#pragma unroll
        for (int t = 0; t < 16; ++t) {
          float x = bf2f(col[(long)t * LDP]);
          kt[t] = x + (pv - x) * mj;
          pv = x;
        }
#pragma unroll
        for (int t = 0; t < 16; ++t) {
          float kkv = kt[t] * kkw;
          float ssq = sum64(kkv * kkv);
          float kk = kkv * rsqrtf(ssq + 1e-12f);
          float a = aa[t];
          float kp = kt[t] * (1.f + (a - 1.f) * kaw);
          float rks = sum64(rt[t] * kp * rkw);
          col[(long)t * LDP] = f2bf(kp);
          p.RWX[(long)(m0 + t) * 1536 + 512 + ch] = f2bf(kk);
          p.RWX[(long)(m0 + t) * 1536 + 1024 + ch] = f2bf(kk * a);
          if (lane == 0) (p.FB + FOFF_RKS)[(long)(m0 + t) * 8 + head] = rks;
        }
      }
      {
        float mj = mu[1024 + ch];
        float pv = prev_of(1024 + ch);
        u16* col = p.PROJ + (long)m0 * LDP + C_V + ch;
        float vt[16];
#pragma unroll
        for (int t = 0; t < 16; ++t) {
          float x = bf2f(col[(long)t * LDP]);
          vt[t] = x + (pv - x) * mj;
          pv = x;
        }
#pragma unroll
        for (int t = 0; t < 16; ++t) col[(long)t * LDP] = f2bf(vt[t]);
      }
    }
#pragma unroll 1
    for (int c = 0; c < 2; ++c) {
      const int cc = tid + 256 * c;
      const float* cw = p.conv_w + (long)l * 4096 + 512 + cc;
      const float w0 = cw[0], w1 = cw[1024], w2 = cw[2048], w3 = cw[3072];
      const float bb = p.conv_b[l * 1024 + 512 + cc];
      float u3, u2, u1;
      if (!first) {
        const u16* pb = p.BND2 + (long)(blk - 1) * 1536 + cc;
        u3 = bf2f(pb[0]); u2 = bf2f(pb[512]); u1 = bf2f(pb[1024]);
      } else if (s >= 8) {
        const float* sc = p.state_conv + ((long)l * 8 + (s - 8)) * 3072 + 512 + cc;
        u3 = sc[0]; u2 = sc[1024]; u1 = sc[2048];
      } else {
        u3 = 0.f; u2 = 0.f; u1 = 0.f;
      }
      u16* col = p.PROJ + (long)m0 * LDP + C_XBC + 512 + cc;
      float yv[16];
#pragma unroll
      for (int t = 0; t < 16; ++t) {
        float u0 = bf2f(col[(long)t * LDP]);
        yv[t] = siluf_(w0 * u3 + w1 * u2 + w2 * u1 + w3 * u0 + bb);
        u3 = u2; u2 = u1; u1 = u0;
      }
#pragma unroll
      for (int t = 0; t < 16; ++t) col[(long)t * LDP] = f2bf(yv[t]);
    }
    if (t0 + 16 == seq_len(s)) {
      float* o = p.out + (s < 8 ? O_PSHIFT + ((long)l * 8 + s) * 1792 : O_SSHIFT + ((long)l * 8 + (s - 8)) * 1792);
      for (int j = tid; j < 1792; j += 256) o[j] = bf2f(p.BND[(long)blk * 1792 + j]);
    }
  }
}

__device__ __forceinline__ void scan_rwkv(const Params& p, int l, int s, int h, int q, float* smem) {
  const int tid = opaque_tid(), lane = tid & 63, wid = tid >> 6;
  float* R_ = smem;
  float* W_ = smem + 1024;
  float* K_ = smem + 2048;
  float* A_ = smem + 3072;
  float* B_ = smem + 4096;
  float* V_ = smem + 5120;
  float* O_ = smem + 5376;
  const int rl = wid * 4 + (lane >> 4);
  const int row = q * 16 + rl;
  const int ksl = (lane & 15) * 4;
  const int base = seq_base(s), T = seq_len(s);
  float s0 = 0.f, s1 = 0.f, s2 = 0.f, s3 = 0.f;
  if (s >= 8) {
    const float* st = p.state_rwkv + (((long)l * 8 + (s - 8)) * 8 + h) * 4096 + row * 64 + ksl;
    float4 v = *(const float4*)st;
    s0 = v.x; s1 = v.y; s2 = v.z; s3 = v.w;
  }
  const int stt = tid >> 4, skq = (tid & 15) * 4;
  const int nblk = T / 16;
  ushort4 r4, k4, u4, a4, b4;
  u16 vv;
  {
    const long m = base + stt;
    const u16* pr = p.PROJ + m * LDP;
    const u16* px = p.RWX + m * 1536;
    r4 = *(const ushort4*)(pr + C_R + h * 64 + skq);
    k4 = *(const ushort4*)(pr + C_K + h * 64 + skq);
    u4 = *(const ushort4*)(px + h * 64 + skq);
    a4 = *(const ushort4*)(px + 512 + h * 64 + skq);
    b4 = *(const ushort4*)(px + 1024 + h * 64 + skq);
    vv = pr[C_V + h * 64 + q * 16 + (tid & 15)];
  }
  __syncthreads();
  float* TR_ = smem + 5376 + 512;
  const bool wr = (lane & 15) == 0;
  const int ooff = wr ? rl : (512 + lane);
  const int ostr = wr ? 16 : 0;
  for (int blk = 0; blk < nblk; ++blk) {
    const long m = base + blk * 16 + stt;
    float* Oc = O_ + (blk & 1) * 256;
    {
      *(float4*)(R_ + stt * 64 + skq) = make_float4(bf2f(r4.x), bf2f(r4.y), bf2f(r4.z), bf2f(r4.w));
      *(float4*)(K_ + stt * 64 + skq) = make_float4(bf2f(k4.x), bf2f(k4.y), bf2f(k4.z), bf2f(k4.w));
      *(float4*)(W_ + stt * 64 + skq) =
          make_float4(__expf(bf2f(u4.x)), __expf(bf2f(u4.y)), __expf(bf2f(u4.z)), __expf(bf2f(u4.w)));
      *(float4*)(A_ + stt * 64 + skq) = make_float4(-bf2f(a4.x), -bf2f(a4.y), -bf2f(a4.z), -bf2f(a4.w));
      *(float4*)(B_ + stt * 64 + skq) = make_float4(bf2f(b4.x), bf2f(b4.y), bf2f(b4.z), bf2f(b4.w));
      V_[stt * 16 + (tid & 15)] = bf2f(vv);
    }
    __syncthreads();
    if (blk > 0)
      p.ORW[(m - 16) * 512 + h * 64 + q * 16 + (tid & 15)] = f2bf(O_[((blk - 1) & 1) * 256 + stt * 16 + (tid & 15)]);
    if (blk + 1 < nblk) {
      const u16* pr = p.PROJ + (m + 16) * LDP;
      const u16* px = p.RWX + (m + 16) * 1536;
      r4 = *(const ushort4*)(pr + C_R + h * 64 + skq);
      k4 = *(const ushort4*)(pr + C_K + h * 64 + skq);
      u4 = *(const ushort4*)(px + h * 64 + skq);
      a4 = *(const ushort4*)(px + 512 + h * 64 + skq);
      b4 = *(const ushort4*)(px + 1024 + h * 64 + skq);
      vv = pr[C_V + h * 64 + q * 16 + (tid & 15)];
    }
    __builtin_amdgcn_sched_barrier(0);
    {
      float4 a = *(const float4*)(A_ + ksl), w = *(const float4*)(W_ + ksl), b = *(const float4*)(B_ + ksl);
      float4 k = *(const float4*)(K_ + ksl), r = *(const float4*)(R_ + ksl);
      float v = V_[rl];
      float opart = 0.f;
#pragma unroll
      for (int tt = 0; tt < 16; ++tt) {
        float4 an, wn, bn, kn, rn;
        float vn;
        if (tt + 1 < 16) {
          an = *(const float4*)(A_ + (tt + 1) * 64 + ksl); wn = *(const float4*)(W_ + (tt + 1) * 64 + ksl);
          bn = *(const float4*)(B_ + (tt + 1) * 64 + ksl); kn = *(const float4*)(K_ + (tt + 1) * 64 + ksl);
          rn = *(const float4*)(R_ + (tt + 1) * 64 + ksl); vn = V_[(tt + 1) * 16 + rl];
        }
        __builtin_amdgcn_sched_barrier(0);
        float sa = fmaf(s0, a.x, fmaf(s1, a.y, fmaf(s2, a.z, s3 * a.w)));
        if (tt > 0) { sum16x2(sa, opart); Oc[ooff + (tt - 1) * ostr] = opart; }
        else sa = sum16(sa);
        s0 = fmaf(s0, w.x, fmaf(sa, b.x, v * k.x)); NOPK(s0);
        s1 = fmaf(s1, w.y, fmaf(sa, b.y, v * k.y)); NOPK(s1);
        s2 = fmaf(s2, w.z, fmaf(sa, b.z, v * k.z)); NOPK(s2);
        s3 = fmaf(s3, w.w, fmaf(sa, b.w, v * k.w)); NOPK(s3);
        opart = fmaf(s0, r.x, fmaf(s1, r.y, fmaf(s2, r.z, s3 * r.w)));
        if (tt == 15) { opart = sum16(opart); Oc[ooff + 15 * ostr] = opart; }
        __builtin_amdgcn_sched_barrier(0);
        if (tt + 1 < 16) { a = an; w = wn; b = bn; k = kn; r = rn; v = vn; }
      }
    }
    __builtin_amdgcn_sched_barrier(0);
    __syncthreads();
  }
  {
    const long m = base + (nblk - 1) * 16 + stt;
    p.ORW[m * 512 + h * 64 + q * 16 + (tid & 15)] = f2bf(O_[((nblk - 1) & 1) * 256 + stt * 16 + (tid & 15)]);
  }
  __syncthreads();
  {
    float* o = p.out + (s < 8 ? O_PRWKV + (((long)l * 8 + s) * 8 + h) * 4096
                              : O_SRWKV + (((long)l * 8 + (s - 8)) * 8 + h) * 4096);
    *(float4*)(o + row * 64 + ksl) = make_float4(s0, s1, s2, s3);
  }
}

__device__ __forceinline__ void scan_hgrn(const Params& p, int l, int s, int h, int q, float* smem) {
  const int tid = opaque_tid(), lane = tid & 63, wid = tid >> 6;
  float* Q_ = smem;
  float* F_ = smem + 2048;
  float* G_ = smem + 4096;
  float* I_ = smem + 6144;
  float* O_ = smem + 6400;
  const int rl = wid * 4 + (lane >> 4);
  const int row = q * 16 + rl;
  const int ksl4 = (lane & 15) * 4;
  const int base = seq_base(s), T = seq_len(s);
  float st[8];
#pragma unroll
  for (int i = 0; i < 8; ++i) st[i] = 0.f;
  if (s >= 8) {
    const float* sp = p.state_hgrn + (((long)l * 8 + (s - 8)) * 4 + h) * 16384;
#pragma unroll
    for (int i = 0; i < 8; ++i) st[i] = sp[((i >> 2) * 64 + ksl4 + (i & 3)) * 128 + row];
  }
  const int stt = tid >> 4, skq = (tid & 15) * 8;
  float lb[8];
#pragma unroll
  for (int i = 0; i < 8; ++i) {
    if (l == 0) lb[i] = 0.f;
    else {
      float x0 = p.hg_lb[h * 128 + skq + i], x1 = p.hg_lb[512 + h * 128 + skq + i];
      lb[i] = frcp_(1.f + __expf(x0 - x1));
    }
  }
  const int nblk = T / 16;
  uint4 q8, f8;
  u16 iv16;
  {
    const u16* pr = p.PROJ + (long)(base + stt) * LDP;
    q8 = *(const uint4*)(pr + C_Q + h * 128 + skq);
    f8 = *(const uint4*)(pr + C_F + h * 128 + skq);
    iv16 = pr[C_I + h * 128 + q * 16 + (tid & 15)];
  }
  __syncthreads();
  float* TR_ = smem + 6400 + 512;
  const bool wr = (lane & 15) == 0;
  const int ooff = wr ? rl : (512 + lane);
  const int ostr = wr ? 16 : 0;
  for (int blk = 0; blk < nblk; ++blk) {
    const long m = base + blk * 16 + stt;
    float* Oc = O_ + (blk & 1) * 256;
    {
      unsigned qw[4] = {q8.x, q8.y, q8.z, q8.w}, fw[4] = {f8.x, f8.y, f8.z, f8.w};
      float qv[8], fv[8];
#pragma unroll
      for (int e = 0; e < 8; ++e) {
        qv[e] = bf2f((u16)((qw[e >> 1] >> ((e & 1) * 16)) & 0xffff));
        float fz = bf2f((u16)((fw[e >> 1] >> ((e & 1) * 16)) & 0xffff));
        float ex = __expf(-fz);
        float sg = frcp_(1.f + ex);
        fv[e] = lb[e] + (1.f - lb[e]) * sg;
      }
      *(float4*)(Q_ + stt * 128 + skq) = make_float4(qv[0], qv[1], qv[2], qv[3]);
      *(float4*)(Q_ + stt * 128 + skq + 4) = make_float4(qv[4], qv[5], qv[6], qv[7]);
      *(float4*)(F_ + stt * 128 + skq) = make_float4(fv[0], fv[1], fv[2], fv[3]);
      *(float4*)(F_ + stt * 128 + skq + 4) = make_float4(fv[4], fv[5], fv[6], fv[7]);
      I_[stt * 16 + (tid & 15)] = bf2f(iv16);
    }
    __syncthreads();
    if (blk > 0) {
      u16* dp = p.PROJ + (m - 16) * LDP + C_I + h * 128 + q * 16 + (tid & 15);
      *dp = f2bf(O_[((blk - 1) & 1) * 256 + stt * 16 + (tid & 15)]);
    }
    if (blk + 1 < nblk) {
      const u16* pr = p.PROJ + (m + 16) * LDP;
      q8 = *(const uint4*)(pr + C_Q + h * 128 + skq);
      f8 = *(const uint4*)(pr + C_F + h * 128 + skq);
      iv16 = pr[C_I + h * 128 + q * 16 + (tid & 15)];
    }
    __builtin_amdgcn_sched_barrier(0);
    {
      float4 f0 = *(const float4*)(F_ + ksl4), f1 = *(const float4*)(F_ + 64 + ksl4);
      float4 q0 = *(const float4*)(Q_ + ksl4), q1 = *(const float4*)(Q_ + 64 + ksl4);
      float iv = I_[rl];
      float oprev = 0.f;
#pragma unroll
      for (int tt = 0; tt < 16; ++tt) {
        float4 f0n, f1n, q0n, q1n;
        float ivn;
        if (tt + 1 < 16) {
          const int o_ = (tt + 1) * 128;
          f0n = *(const float4*)(F_ + o_ + ksl4); f1n = *(const float4*)(F_ + o_ + 64 + ksl4);
          q0n = *(const float4*)(Q_ + o_ + ksl4); q1n = *(const float4*)(Q_ + o_ + 64 + ksl4);
          ivn = I_[(tt + 1) * 16 + rl];
        }
        __builtin_amdgcn_sched_barrier(0);
        st[0] = fmaf(st[0] - iv, f0.x, iv); NOPK(st[0]);
        st[1] = fmaf(st[1] - iv, f0.y, iv); NOPK(st[1]);
        st[2] = fmaf(st[2] - iv, f0.z, iv); NOPK(st[2]);
        st[3] = fmaf(st[3] - iv, f0.w, iv); NOPK(st[3]);
        st[4] = fmaf(st[4] - iv, f1.x, iv); NOPK(st[4]);
        st[5] = fmaf(st[5] - iv, f1.y, iv); NOPK(st[5]);
        st[6] = fmaf(st[6] - iv, f1.z, iv); NOPK(st[6]);
        st[7] = fmaf(st[7] - iv, f1.w, iv); NOPK(st[7]);
        float acc0 = fmaf(st[0], q0.x, fmaf(st[1], q0.y, fmaf(st[2], q0.z, st[3] * q0.w)));
        float acc1 = fmaf(st[4], q1.x, fmaf(st[5], q1.y, fmaf(st[6], q1.z, st[7] * q1.w)));
        float o = acc0 + acc1;
        if (tt & 1) { sum16x2(oprev, o); Oc[ooff + (tt - 1) * ostr] = oprev; Oc[ooff + tt * ostr] = o; }
        else oprev = o;
        __builtin_amdgcn_sched_barrier(0);
        if (tt + 1 < 16) { f0 = f0n; f1 = f1n; q0 = q0n; q1 = q1n; iv = ivn; }
      }
    }
    __builtin_amdgcn_sched_barrier(0);
    __syncthreads();
  }
  {
    const long m = base + (nblk - 1) * 16 + stt;
    u16* dp = p.PROJ + m * LDP + C_I + h * 128 + q * 16 + (tid & 15);
    *dp = f2bf(O_[((nblk - 1) & 1) * 256 + stt * 16 + (tid & 15)]);
  }
  __syncthreads();
  {
    float* o = p.out + (s < 8 ? O_PHGRN + (((long)l * 8 + s) * 4 + h) * 16384
                              : O_SHGRN + (((long)l * 8 + (s - 8)) * 4 + h) * 16384);
#pragma unroll
    for (int i = 0; i < 8; ++i) o[((i >> 2) * 64 + ksl4 + (i & 3)) * 128 + row] = st[i];
  }
}

__device__ __forceinline__ void scan_ssd(const Params& p, int l, int s, int h, int q, float* smem) {
  const int tid = opaque_tid(), lane = tid & 63, wid = tid >> 6;
  float* B_ = smem;
  float* C_ = smem + 2048;
  float* X_ = smem + 4096;
  float* O_ = smem + 4352;
  float* DT_ = smem + 5200;
  float* DE_ = smem + 5216;
  const int rl = wid * 4 + (lane >> 4);
  const int row = q * 16 + rl;
  const int ksl4 = (lane & 15) * 4;
  const int g = h >> 2;
  const int base = seq_base(s), T = seq_len(s);
  float st[8];
#pragma unroll
  for (int i = 0; i < 8; ++i) st[i] = 0.f;
  if (s >= 8) {
    const float* sp = p.state_ssm + (((long)l * 8 + (s - 8)) * 8 + h) * 8192 + row * 128 + ksl4;
    float4 a = *(const float4*)sp, b = *(const float4*)(sp + 64);
    st[0] = a.x; st[1] = a.y; st[2] = a.z; st[3] = a.w; st[4] = b.x; st[5] = b.y; st[6] = b.z; st[7] = b.w;
  }
  const float* cw = p.conv_w + (long)l * 4 * 1024;
  const int skq8 = (tid & 15) * 8;
  const int xc_x = h * 64 + q * 16 + (tid & 15);
  const float cx0 = cw[xc_x], cx1 = cw[1024 + xc_x], cx2 = cw[2048 + xc_x], cx3 = cw[3072 + xc_x];
  const float cxb = p.conv_b[l * 1024 + xc_x];
  const float dtb = p.dt_bias[l * 8 + h];
  const float aexp = __expf(p.a_log[l * 8 + h]);
  const float dsk = p.d_skip[l * 8 + h];
  const int stt = tid >> 4;
  const int nblk = T / 16;
  uint4 rawb, rawc;
  float xr[4];
  float dtr = 0.f;
  u16 zc = 0, zn = 0;
#define SSD_LOAD(M0)                                                              \
  {                                                                               \
    {                                                                             \
      const u16* prow = p.PROJ + ((long)(M0) + stt) * LDP + C_XBC + g * 128 + skq8; \
      rawb = *(const uint4*)(prow + 512);                                         \
      rawc = *(const uint4*)(prow + 768);                                         \
    }                                                                             \
    {                                                                             \
      const long mr = (long)(M0) + stt;                                           \
      const u16* colx = p.PROJ + mr * LDP + C_XBC + xc_x;                         \
      _Pragma("unroll") for (int j = 0; j < 4; ++j) {                             \
        const long mm = mr - 3 + j;                                               \
        float vx;                                                                 \
        if (mm >= base) vx = bf2f(colx[(long)(j - 3) * LDP]);                     \
        else vx = (s >= 8) ? p.state_conv[((long)l * 8 + (s - 8)) * 3072 + (3 + (int)(mm - base)) * 1024 + xc_x] : 0.f; \
        xr[j] = vx;                                                               \
      }                                                                           \
    }                                                                             \
    if (tid < 16) dtr = (p.FB + FOFF_DTRAW)[((long)(M0) + tid) * 8 + h];                      \
    zn = p.PROJ[((long)(M0) + stt) * LDP + C_Z + h * 64 + q * 16 + (tid & 15)];   \
  }
  SSD_LOAD(base);
  __syncthreads();
  const bool wr = (lane & 15) == 0;
  const int ooff = wr ? rl : (512 + lane);
  const int ostr = wr ? 16 : 0;
  u16 zp = 0;
  for (int blk = 0; blk < nblk; ++blk) {
    const long m0 = base + blk * 16;
    zp = zc;
    zc = zn;
    float* Oc = O_ + (blk & 1) * 256;
    {
      {
        const unsigned bw[4] = {rawb.x, rawb.y, rawb.z, rawb.w}, cwd[4] = {rawc.x, rawc.y, rawc.z, rawc.w};
        float bv[8], cv[8];
#pragma unroll
        for (int e = 0; e < 8; ++e) {
          bv[e] = bf2f((u16)((bw[e >> 1] >> ((e & 1) * 16)) & 0xffff));
          cv[e] = bf2f((u16)((cwd[e >> 1] >> ((e & 1) * 16)) & 0xffff));
        }
        *(float4*)(B_ + stt * 128 + skq8) = make_float4(bv[0], bv[1], bv[2], bv[3]);
        *(float4*)(B_ + stt * 128 + skq8 + 4) = make_float4(bv[4], bv[5], bv[6], bv[7]);
        *(float4*)(C_ + stt * 128 + skq8) = make_float4(cv[0], cv[1], cv[2], cv[3]);
        *(float4*)(C_ + stt * 128 + skq8 + 4) = make_float4(cv[4], cv[5], cv[6], cv[7]);
      }
      {
        float y = cx0 * xr[0] + cx1 * xr[1] + cx2 * xr[2] + cx3 * xr[3] + cxb;
        X_[stt * 16 + (tid & 15)] = siluf_(y);
      }
      if (tid < 16) {
        float dtv = softplusf_(dtr + dtb);
        DT_[tid] = dtv;
        DE_[tid] = __expf(-aexp * dtv);
      }
    }
    __syncthreads();
    if (blk > 0) {
      u16* pz = p.PROJ + (m0 - 16 + stt) * LDP + C_Z + h * 64 + q * 16 + (tid & 15);
      *pz = f2bf(O_[((blk - 1) & 1) * 256 + stt * 16 + (tid & 15)] * siluf_(bf2f(zp)));
    }
    if (blk + 1 < nblk) SSD_LOAD(m0 + 16);
    __builtin_amdgcn_sched_barrier(0);
    {
      float4 b0 = *(const float4*)(B_ + ksl4), b1 = *(const float4*)(B_ + 64 + ksl4);
      float4 c0 = *(const float4*)(C_ + ksl4), c1 = *(const float4*)(C_ + 64 + ksl4);
      float xv = X_[rl], dt = DT_[0], de = DE_[0];
      float yprev = 0.f, xvprev = 0.f;
#pragma unroll
      for (int tt = 0; tt < 16; ++tt) {
        float4 b0n, b1n, c0n, c1n;
        float xvn, dtn, den;
        if (tt + 1 < 16) {
          const int o_ = (tt + 1) * 128;
          b0n = *(const float4*)(B_ + o_ + ksl4); b1n = *(const float4*)(B_ + o_ + 64 + ksl4);
          c0n = *(const float4*)(C_ + o_ + ksl4); c1n = *(const float4*)(C_ + o_ + 64 + ksl4);
          xvn = X_[(tt + 1) * 16 + rl]; dtn = DT_[tt + 1]; den = DE_[tt + 1];
        }
        __builtin_amdgcn_sched_barrier(0);
        const float xd = xv * dt;
        st[0] = fmaf(st[0], de, xd * b0.x); NOPK(st[0]);
        st[1] = fmaf(st[1], de, xd * b0.y); NOPK(st[1]);
        st[2] = fmaf(st[2], de, xd * b0.z); NOPK(st[2]);
        st[3] = fmaf(st[3], de, xd * b0.w); NOPK(st[3]);
        st[4] = fmaf(st[4], de, xd * b1.x); NOPK(st[4]);
        st[5] = fmaf(st[5], de, xd * b1.y); NOPK(st[5]);
        st[6] = fmaf(st[6], de, xd * b1.z); NOPK(st[6]);
        st[7] = fmaf(st[7], de, xd * b1.w); NOPK(st[7]);
        float acc0 = fmaf(st[0], c0.x, fmaf(st[1], c0.y, fmaf(st[2], c0.z, st[3] * c0.w)));
        float acc1 = fmaf(st[4], c1.x, fmaf(st[5], c1.y, fmaf(st[6], c1.z, st[7] * c1.w)));
        float y = acc0 + acc1;
        if (tt & 1) { sum16x2(yprev, y); Oc[ooff + (tt - 1) * ostr] = yprev + dsk * xvprev; Oc[ooff + tt * ostr] = y + dsk * xv; }
        else { yprev = y; xvprev = xv; }
        __builtin_amdgcn_sched_barrier(0);
        if (tt + 1 < 16) { b0 = b0n; b1 = b1n; c0 = c0n; c1 = c1n; xv = xvn; dt = dtn; de = den; }
      }
    }
    __builtin_amdgcn_sched_barrier(0);
    __syncthreads();
  }
  {
    const long m0 = base + (nblk - 1) * 16;
    u16* pz = p.PROJ + (m0 + stt) * LDP + C_Z + h * 64 + q * 16 + (tid & 15);
    *pz = f2bf(O_[((nblk - 1) & 1) * 256 + stt * 16 + (tid & 15)] * siluf_(bf2f(zc)));
  }
  __syncthreads();
#undef SSD_LOAD
  {
    float* o = p.out + (s < 8 ? O_PSSM + (((long)l * 8 + s) * 8 + h) * 8192
                              : O_SSSM + (((long)l * 8 + (s - 8)) * 8 + h) * 8192);
    *(float4*)(o + row * 128 + ksl4) = make_float4(st[0], st[1], st[2], st[3]);
    *(float4*)(o + row * 128 + 64 + ksl4) = make_float4(st[4], st[5], st[6], st[7]);
  }
  if (h == 0 && q == 0) {
    float* o = p.out + (s < 8 ? O_PCONV + ((long)l * 8 + s) * 3072 : O_SCONV + ((long)l * 8 + (s - 8)) * 3072);
    const long lastblk = (long)(base + T) / 16 - 1;
    for (int i = tid; i < 3072; i += 256) {
      int r = i >> 10, c = i & 1023;
      o[i] = (c < 512) ? bf2f(p.PROJ[(long)(base + T - 3 + r) * LDP + C_XBC + c])
                       : bf2f(p.BND2[(lastblk * 3 + r) * 512 + (c - 512)]);
    }
  }
}

__device__ __forceinline__ void phase_scan(const Params& p, int l, float* smem) {
  for (int u = BID, nb_ = NBLK; u < 1536; u += nb_) {
    int sample = u >= 768;
    int v = sample ? u - 768 : u;
    int type = v % 3, w = v / 3;
    if (type == 0) {
      int q = w & 3, h = (w >> 2) & 7, b = w >> 5;
      scan_rwkv(p, l, b + 8 * sample, h, q, smem);
    } else if (type == 1) {
      int q = w & 7, h = (w >> 3) & 3, b = w >> 5;
      scan_hgrn(p, l, b + 8 * sample, h, q, smem);
    } else {
      int q = w & 3, h = (w >> 2) & 7, b = w >> 5;
      scan_ssd(p, l, b + 8 * sample, h, q, smem);
    }
  }
}

__device__ __forceinline__ void phase_post(const Params& p, int l, float* smem) {
  const int tid = opaque_tid(), lane = tid & 63, wid = tid >> 6;
  float* RED = smem;
  constexpr int LDG = 516;
  float* GA = smem + 256;
  for (int blk = BID, nb_ = NBLK; blk < NBLK16; blk += nb_) {
    const long m0 = (long)blk * 16;
    __syncthreads();
    {
      bf16x8 ag[4];
      const u16* arow = p.PROJ + (m0 + (lane & 15)) * LDP + C_XG + (lane >> 4) * 8;
#pragma unroll
      for (int ks = 0; ks < 4; ++ks) ag[ks] = *(const bf16x8*)(arow + ks * 32);
#pragma unroll
      for (int nt = 0; nt < 8; ++nt) {
        const int n = (wid * 8 + nt) * 16 + (lane & 15);
        f32x4v acc = {0.f, 0.f, 0.f, 0.f};
#pragma unroll
        for (int ks = 0; ks < 4; ++ks) {
          bf16x8 bg = *(const bf16x8*)((p.WB + OFF_G2T) + n * 128 + ks * 32 + (lane >> 4) * 8);
          acc = __builtin_amdgcn_mfma_f32_16x16x32_bf16(ag[ks], bg, acc, 0, 0, 0);
        }
#pragma unroll
        for (int r = 0; r < 4; ++r) GA[((lane >> 4) * 4 + r) * LDG + n] = acc[r];
      }
    }
#pragma unroll 1
    for (int c = 0; c < 2; ++c) {
      const int ch = tid + 256 * c, head = wid + 4 * c;
      float ys[16], oh[16];
#pragma unroll
      for (int t = 0; t < 16; ++t) {
        ys[t] = bf2f(p.PROJ[(m0 + t) * LDP + C_Z + ch]);
        oh[t] = bf2f(p.PROJ[(m0 + t) * LDP + C_I + ch]);
      }
#pragma unroll
      for (int t = 0; t < 16; ++t) {
        float a0 = sum64(ys[t] * ys[t]);
        float b0 = sum64(oh[t] * oh[t]);
        if (lane == 0) *(float2*)(RED + (wid * 16 + t) * 2) = make_float2(a0, b0);
      }
      __syncthreads();
      {
        const float nw0 = p.ssd_norm_w[l * 512 + ch];
        const float hw0 = p.hg_norm_w[l * 512 + ch];
        const int pw = (wid >> 1) * 2;
#pragma unroll
        for (int t = 0; t < 16; ++t) {
          float2 r0 = *(const float2*)(RED + (0 * 16 + t) * 2), r1 = *(const float2*)(RED + (1 * 16 + t) * 2);
          float2 r2 = *(const float2*)(RED + (2 * 16 + t) * 2), r3 = *(const float2*)(RED + (3 * 16 + t) * 2);
          float g0 = r0.x + r1.x + r2.x + r3.x;
          float2 pa = *(const float2*)(RED + (pw * 16 + t) * 2), pb = *(const float2*)(RED + ((pw + 1) * 16 + t) * 2);
          float h0 = pa.y + pb.y;
          u16* rowp = p.PROJ + (m0 + t) * LDP;
          rowp[C_Z + ch] = f2bf(ys[t] * rsqrtf(g0 * (1.f / 256.f) + 1e-6f) * nw0);
          float gg0 = bf2f(rowp[C_GG + ch]);
          rowp[C_GG + ch] = f2bf(oh[t] * rsqrtf(h0 * (1.f / 128.f) + 1e-6f) * hw0 * siluf_(gg0));
        }
      }
      {
        float lw = p.rw_lnx_w[l * 512 + ch], lbv = p.rw_lnx_b[l * 512 + ch];
#pragma unroll
        for (int t = 0; t < 16; ++t) {
          float o = bf2f(p.ORW[(m0 + t) * 512 + ch]);
          float mean = sum64(o) * (1.f / 64.f);
          float d = o - mean;
          float var = sum64(d * d) * (1.f / 64.f);
          float ln = d * rsqrtf(var + 64e-5f) * lw + lbv;
          float v = bf2f(p.PROJ[(m0 + t) * LDP + C_V + ch]);
          float bonus = (p.FB + FOFF_RKS)[(m0 + t) * 8 + head] * v;
          p.PROJ[(m0 + t) * LDP + C_R + ch] = f2bf((ln + bonus) * GA[t * LDG + ch]);
        }
      }
      __syncthreads();
    }
  }
}

__device__ __forceinline__ void phase_final(const Params& p) {
  const int tid = opaque_tid(), lane = tid & 63, wid = tid >> 6;
  for (int m = BID * 4 + wid, nb_ = NBLK; m < M_TOT; m += nb_ * 4) {
    float* dst;
    if (m < M_PROMPT) {
      int b = m / T_P, t = m - b * T_P;
      if (t < 16) continue;
      dst = p.out + O_YP + ((long)b * 4096 + (t - 16)) * DM;
    } else {
      dst = p.out + O_YS + (long)(m - M_PROMPT) * DM;
    }
    float x[16];
    float ss = 0.f;
#pragma unroll
    for (int j = 0; j < 2; ++j) {
      uint4 raw = *(const uint4*)(p.XB + (long)m * DM + lane * 8 + 512 * j);
      unsigned wv[4] = {raw.x, raw.y, raw.z, raw.w};
#pragma unroll
      for (int e = 0; e < 8; ++e) {
        x[j * 8 + e] = bf2f((u16)((wv[e >> 1] >> ((e & 1) * 16)) & 0xffff));
        ss += x[j * 8 + e] * x[j * 8 + e];
      }
    }
    ss = sum64(ss);
    float rs = rsqrtf(ss * (1.f / 1024.f) + 1e-6f);
#pragma unroll
    for (int j = 0; j < 2; ++j) {
      int k0 = lane * 8 + 512 * j;
      float4 w0 = *(const float4*)(p.final_w + k0), w1 = *(const float4*)(p.final_w + k0 + 4);
      *(float4*)(dst + k0) = make_float4(x[j * 8 + 0] * rs * w0.x, x[j * 8 + 1] * rs * w0.y, x[j * 8 + 2] * rs * w0.z,
                                         x[j * 8 + 3] * rs * w0.w);
      *(float4*)(dst + k0 + 4) = make_float4(x[j * 8 + 4] * rs * w1.x, x[j * 8 + 5] * rs * w1.y,
                                             x[j * 8 + 6] * rs * w1.z, x[j * 8 + 7] * rs * w1.w);
    }
  }
}


#define XB_TMO      128
#define XB_XCNT(j)  (256  + 64 * (j))
#define XB_XSUB(j)  (1280 + 64 * (j))
#define XB_XGEN(j)  (2304 + 64 * (j))
#define XB_TOP      3328
#define XB_TOPGEN   3392
#define XCD_BAR_WORDS 3456
#define XB_SPIN_CAP (1u << 22)
__device__ __forceinline__ unsigned xb_ld(unsigned* p) { return __hip_atomic_load(p, __ATOMIC_RELAXED, __HIP_MEMORY_SCOPE_AGENT); }
__device__ __forceinline__ unsigned xb_add(unsigned* p, unsigned v) { return __hip_atomic_fetch_add(p, v, __ATOMIC_RELAXED, __HIP_MEMORY_SCOPE_AGENT); }
__device__ __forceinline__ unsigned xb_xcc_id() { return (unsigned)__builtin_amdgcn_s_getreg((3 << 11) | 20) & 0xFu; }
#define XB_SPIN(cond, bar) do { unsigned _sp = 0; while (cond) { __builtin_amdgcn_s_sleep(1); \
    if ((++_sp & 255u) == 0u) { if (xb_ld(&(bar)[XB_TMO])) break; if (_sp > XB_SPIN_CAP) { atomicAdd(&(bar)[XB_TMO], 1u); break; } } } } while (0)

__device__ __forceinline__ void xcd_barrier_post(unsigned* bar) {
  if (threadIdx.x == 0) (void)xb_add(&bar[XB_XCNT(xb_xcc_id())], 1u);
}
__device__ __forceinline__ void xcd_barrier_complete(unsigned* bar, unsigned x, unsigned& nloc, unsigned& nx) {
  const unsigned G = gridDim.x;
  unsigned sum, cnt, mine, sp = 0u;
  for (;;) {
    sum = 0u; cnt = 0u; mine = 0u;
#pragma unroll
    for (unsigned j = 0; j < 16; ++j) { const unsigned c = xb_ld(&bar[XB_XCNT(j)]); sum += c; cnt += (c > 0u) ? 1u : 0u; mine = (j == x) ? c : mine; }
    if (sum == G) break;
    __builtin_amdgcn_s_sleep(1);
    if ((++sp & 255u) == 0u) { if (xb_ld(&bar[XB_TMO])) break; if (sp > XB_SPIN_CAP) { atomicAdd(&bar[XB_TMO], 1u); break; } }
  }
  nloc = mine > 0u ? mine : 1u; nx = cnt > 0u ? cnt : 1u;
}
__device__ __forceinline__ void xcd_barrier(unsigned* bar, volatile unsigned* st) {
  asm volatile("s_waitcnt vmcnt(0)" ::: "memory");
  __syncthreads();
  if (threadIdx.x == 0) {
    __builtin_amdgcn_s_waitcnt(0);
    const unsigned x = xb_xcc_id();
    unsigned nloc = st[0], nx = st[1];
    if (nloc == 0u) { xcd_barrier_complete(bar, x, nloc, nx); st[0] = nloc; st[1] = nx; }
    const unsigned old = xb_add(&bar[XB_XSUB(x)], 1u);
    const unsigned gen = old / nloc;
    if (old + 1u == (gen + 1u) * nloc) {
      __builtin_amdgcn_fence(__ATOMIC_RELEASE, "agent");
      asm volatile("s_waitcnt vmcnt(0)" ::: "memory");
      const unsigned og = xb_add(&bar[XB_TOP], 1u);
      const unsigned tg = og / nx;
      if (og + 1u == (tg + 1u) * nx) xb_add(&bar[XB_TOPGEN], 1u);
      else XB_SPIN(xb_ld(&bar[XB_TOPGEN]) == tg, bar);
      __builtin_amdgcn_fence(__ATOMIC_ACQUIRE, "agent");
      xb_add(&bar[XB_XGEN(x)], 1u);
      asm volatile("s_waitcnt vmcnt(0)" ::: "memory");
    } else {
      XB_SPIN(xb_ld(&bar[XB_XGEN(x)]) == gen, bar);
      __builtin_amdgcn_fence(__ATOMIC_ACQUIRE, "agent");
      asm volatile("s_waitcnt vmcnt(0)" ::: "memory");
    }
  }
  __syncthreads();
}

constexpr int SMEM_BYTES = 40960;
__device__ __forceinline__ void run_phase(const Params& p, int ph, char* smem) {
  if (ph == 0) { phase_embed(p); return; }
  if (ph == 19) { phase_final(p); return; }
  int l = (ph - 1) / 9, s = (ph - 1) % 9;
  float* fs = (float*)smem;
  switch (s) {
    case 0: phase_convert(p, l, fs); phase_rowstat<true>(p, l, fs); break;
    case 1: phase_gemm<1>(p, p.XB, DM, (p.WB + OFF_W1T), 1024, LDP / 128, smem); break;
    case 2: phase_pre(p, l, fs); break;
    case 3: phase_scan(p, l, fs); break;
    case 4: phase_post(p, l, fs); break;
    case 5: phase_gemm<2>(p, p.PROJ, LDP, (p.WB + OFF_WOT), 1536, 8, smem); break;
    case 6: phase_rowstat<false>(p, l, fs); break;
    case 7: phase_gemm<3>(p, p.XB, DM, (p.WB + OFF_WGU), 1024, 44, smem); break;
    case 8: phase_gemm<2>(p, p.PROJ, D_FF, (p.WB + OFF_WDT), D_FF, 8, smem); break;
  }
}
constexpr int N_PHASES = 20;

#if MEGA
__global__ void __launch_bounds__(256, 3) k_mega(Params p) {
  __shared__ __attribute__((aligned(16))) char smem[SMEM_BYTES];
  __shared__ uint4 xb_words;
  if (threadIdx.x == 0) { xb_words = make_uint4(0u, 0u, 0u, 0u); }
  __syncthreads();
  cg::grid_group grid = cg::this_grid();
  float* fs = (float*)smem;
  volatile unsigned* xst = (volatile unsigned*)&xb_words;
  xcd_barrier_post(p.bar);
  phase_embed(p);
  grid.sync();
#define GSYNC() do { unsigned* b_ = p.bar; asm volatile("" : "+s"(b_)); xcd_barrier(b_, xst); } while (0)
  {
    const int L0_ = 0;
    int l = opaque_s(L0_);
    phase_convert(p, l, fs);
    phase_rowstat<true>(p, l, fs);
    GSYNC();
    l = opaque_s(l);
    phase_gemm<1>(p, p.XB, DM, (p.WB + OFF_W1T), 1024, LDP / 128, smem);
    GSYNC();
    l = opaque_s(l);
    phase_pre(p, l, fs);
    GSYNC();
    l = opaque_s(l);
    phase_scan(p, l, fs);
    GSYNC();
    l = opaque_s(l);
    phase_post(p, l, fs);
    GSYNC();
    l = opaque_s(l);
    phase_gemm<2>(p, p.PROJ, LDP, (p.WB + OFF_WOT), 1536, 8, smem);
    GSYNC();
    l = opaque_s(l);
    phase_rowstat<false>(p, l, fs);
    GSYNC();
    l = opaque_s(l);
    phase_gemm<3>(p, p.XB, DM, (p.WB + OFF_WGU), 1024, 44, smem);
    GSYNC();
    l = opaque_s(l);
    phase_gemm<2>(p, p.PROJ, D_FF, (p.WB + OFF_WDT), D_FF, 8, smem);
    GSYNC();
  }
  {
    const int L0_ = 1;
    int l = opaque_s(L0_);
    phase_convert(p, l, fs);
    phase_rowstat<true>(p, l, fs);
    GSYNC();
    l = opaque_s(l);
    phase_gemm<1>(p, p.XB, DM, (p.WB + OFF_W1T), 1024, LDP / 128, smem);
    GSYNC();
    l = opaque_s(l);
    phase_pre(p, l, fs);
    GSYNC();
    l = opaque_s(l);
    phase_scan(p, l, fs);
    GSYNC();
    l = opaque_s(l);
    phase_post(p, l, fs);
    GSYNC();
    l = opaque_s(l);
    phase_gemm<2>(p, p.PROJ, LDP, (p.WB + OFF_WOT), 1536, 8, smem);
    GSYNC();
    l = opaque_s(l);
    phase_rowstat<false>(p, l, fs);
    GSYNC();
    l = opaque_s(l);
    phase_gemm<3>(p, p.XB, DM, (p.WB + OFF_WGU), 1024, 44, smem);
    GSYNC();
    l = opaque_s(l);
    phase_gemm<2>(p, p.PROJ, D_FF, (p.WB + OFF_WDT), D_FF, 8, smem);
    GSYNC();
  }
  phase_final(p);
}
#else
template <int PH>
__global__ void __launch_bounds__(256, 3) k_phase(Params p) {
  __shared__ __attribute__((aligned(16))) char smem[SMEM_BYTES];
  run_phase(p, PH, smem);
}
template <int PH>
static void launch_all(const Params& p, int grid, hipStream_t stream) {
  hipLaunchKernelGGL(k_phase<PH>, dim3(grid), dim3(256), 0, stream, p);
  if constexpr (PH + 1 < N_PHASES) launch_all<PH + 1>(p, grid, stream);
}
#endif

extern "C" void kernel_launch(void* const* d_in, const int* in_sizes, int n_in, void* d_out, int out_size, void* d_ws,
                              size_t ws_size, hipStream_t stream) {
  Params p{};
  const float** pf = (const float**)&p;
  for (int i = 0; i < 35; ++i) pf[i] = (const float*)d_in[i];
  p.out = (float*)d_out;
  char* ws = (char*)d_ws;
  size_t off = 0;
  auto take = [&](size_t bytes) { char* r = ws + off; off += (bytes + 255) & ~(size_t)255; return r; };
  p.XB = (u16*)take((size_t)M_TOT * DM * 2);
  p.PROJ = (u16*)take((size_t)M_TOT * LDP * 2);
  p.WB = (u16*)take((size_t)WB_TOTAL * 2);
  p.BND = (u16*)take((size_t)NBLK16 * 1792 * 2);
  p.BND2 = (u16*)take((size_t)NBLK16 * 3 * 512 * 2);
  p.ORW = (u16*)take((size_t)M_TOT * 512 * 2);
  p.FB = (float*)take((size_t)FB_TOTAL * 4);
  p.bar = (unsigned*)take((size_t)XCD_BAR_WORDS * 4);
  p.RWX = (u16*)d_out;
  if (off > ws_size) fprintf(stderr, "workspace too small: need %zu have %zu\n", off, ws_size);
#if MEGA
  static int grid_blocks = 0;
  if (!grid_blocks) {
    int dev = 0, cus = 0, per_cu = 0;
    hipGetDevice(&dev);
    hipDeviceGetAttribute(&cus, hipDeviceAttributeMultiprocessorCount, dev);
    hipOccupancyMaxActiveBlocksPerMultiprocessor(&per_cu, k_mega, 256, 0);
    if (per_cu > 3) per_cu = 3;
    grid_blocks = cus * per_cu;
  }
  hipMemsetAsync(p.bar, 0, (size_t)XCD_BAR_WORDS * 4, stream);
  void* args[] = {&p};
  hipError_t e = hipLaunchCooperativeKernel((void*)k_mega, dim3(grid_blocks), dim3(256), args, 0, stream);
  if (e != hipSuccess) fprintf(stderr, "cooperative launch failed: %s (grid %d)\n", hipGetErrorString(e), grid_blocks);
#else
  launch_all<0>(p, 768, stream);
#endif
}
```

```cpp
#include <hip/hip_runtime.h>
#include <hip/hip_bf16.h>
#include <hip/hip_cooperative_groups.h>
#include <cstdio>
namespace cg = cooperative_groups;

#ifndef MEGA
#define MEGA 1
#endif

typedef unsigned short u16;
using bf16x8 = __attribute__((ext_vector_type(8))) short;
using f32x16 = __attribute__((ext_vector_type(16))) float;
using f32x4v = __attribute__((ext_vector_type(4))) float;

constexpr int DM = 1024;
constexpr int M_TOT = 33408;
constexpr int M_PROMPT = 32896;
constexpr int T_P = 4112;
constexpr int LDP = 5376;
constexpr int N_IN = 5384;
constexpr int D_FF = 2816;
constexpr int NBLK16 = M_TOT / 16;
constexpr int C_Z = 0, C_R = 512, C_GG = 1024, C_XBC = 1536, C_K = 2560, C_V = 3072, C_XW = 3584, C_XA = 3648,
              C_XG = 3712, C_Q = 3840, C_F = 4352, C_I = 4864;
constexpr long O_YP = 0, O_YS = 33554432, O_PSSM = 34078720, O_PCONV = 35127296, O_PRWKV = 35176448,
               O_PSHIFT = 35700736, O_PHGRN = 35729408, O_SSSM = 36777984, O_SCONV = 37826560,
               O_SRWKV = 37875712, O_SSHIFT = 38400000, O_SHGRN = 38428672;

constexpr long OFF_W1T = 0, OFF_WOT = 5505024, OFF_WGU = 7077888, OFF_WDT = 12845056, OFF_W2T = 15728640, OFF_A2T = 15761408, OFF_G2T = 15794176, WB_TOTAL = 15859712;
constexpr long FOFF_RS = 0, FOFF_DTRAW = 33408, FOFF_RKS = 300672, FB_TOTAL = 567936;
struct Params {
  const float *x_prompt, *x_sample, *state_ssm, *state_conv, *state_rwkv, *state_shift, *state_hgrn, *meta,
      *norm1_w, *w_in, *conv_w, *conv_b, *dt_bias, *a_log, *d_skip, *ssd_norm_w, *rw_mu, *rw_w0, *rw_w2, *rw_a0,
      *rw_a2, *rw_g2, *rw_kk, *rw_ka, *rw_rk, *rw_lnx_w, *rw_lnx_b, *hg_lb, *hg_norm_w, *w_out, *norm2_w, *w_gate,
      *w_up, *w_down, *final_w;
  float* out;
  u16 *XB, *PROJ, *WB, *BND, *BND2, *ORW, *RWX;
  float *FB;
  unsigned* bar;
};

__device__ __forceinline__ u16 f2bf(float f) {
  unsigned u = __float_as_uint(f);
  u += 0x7fffu + ((u >> 16) & 1u);
  return (u16)(u >> 16);
}
__device__ __forceinline__ float bf2f(u16 h) { return __uint_as_float(((unsigned)h) << 16); }
__device__ __forceinline__ float frcp_(float x) { return __builtin_amdgcn_rcpf(x); }
__device__ __forceinline__ float sigmoidf_(float x) { return frcp_(1.f + __expf(-x)); }
__device__ __forceinline__ float siluf_(float x) { return x * frcp_(1.f + __expf(-x)); }
__device__ __forceinline__ float softplusf_(float x) { return x > 20.f ? x : log1pf(__expf(x)); }

template <int CTRL>
__device__ __forceinline__ float dppf(float v) {
  return __int_as_float(__builtin_amdgcn_update_dpp(0, __float_as_int(v), CTRL, 0xF, 0xF, true));
}
__device__ __forceinline__ float sum16(float v) {
  v += dppf<0xB1>(v);
  v += dppf<0x4E>(v);
  v += dppf<0x141>(v);
  v += dppf<0x140>(v);
  return v;
}
__device__ __forceinline__ void sum16x2(float& a, float& b) {
  a += dppf<0xB1>(a); b += dppf<0xB1>(b);
  a += dppf<0x4E>(a); b += dppf<0x4E>(b);
  a += dppf<0x141>(a); b += dppf<0x141>(b);
  a += dppf<0x140>(a); b += dppf<0x140>(b);
}

__device__ __forceinline__ float sum8(float v) {
  v += dppf<0xB1>(v);
  v += dppf<0x4E>(v);
  v += dppf<0x141>(v);
  return v;
}
__device__ __forceinline__ void unpack8(const uint4& r, float* f) {
  f[0] = __uint_as_float(r.x << 16); f[1] = __uint_as_float(r.x & 0xffff0000u);
  f[2] = __uint_as_float(r.y << 16); f[3] = __uint_as_float(r.y & 0xffff0000u);
  f[4] = __uint_as_float(r.z << 16); f[5] = __uint_as_float(r.z & 0xffff0000u);
  f[6] = __uint_as_float(r.w << 16); f[7] = __uint_as_float(r.w & 0xffff0000u);
}
__device__ __forceinline__ uint4 pack8(const float* f) {
  uint4 r;
  r.x = f2bf(f[0]) | ((unsigned)f2bf(f[1]) << 16);
  r.y = f2bf(f[2]) | ((unsigned)f2bf(f[3]) << 16);
  r.z = f2bf(f[4]) | ((unsigned)f2bf(f[5]) << 16);
  r.w = f2bf(f[6]) | ((unsigned)f2bf(f[7]) << 16);
  return r;
}
__device__ __forceinline__ void ld8(const float* p, float* f) {
  float4 a = *(const float4*)p, b = *(const float4*)(p + 4);
  f[0] = a.x; f[1] = a.y; f[2] = a.z; f[3] = a.w; f[4] = b.x; f[5] = b.y; f[6] = b.z; f[7] = b.w;
}
__device__ __forceinline__ float sum64(float v) {
  v = sum16(v);
  v += __shfl_xor(v, 16);
  v += __shfl_xor(v, 32);
  return v;
}

#define NOPK(x) asm("" : "+v"(x))
__device__ __forceinline__ int opaque_tid() {
  int t = threadIdx.x;
  asm volatile("" : "+v"(t));
  return t;
}
__device__ __forceinline__ int opaque_s(int v) {
  asm volatile("" : "+s"(v));
  return v;
}
#define BID opaque_s((int)blockIdx.x)
#define NBLK opaque_s((int)gridDim.x)
__device__ __forceinline__ int seq_base(int s) { return s < 8 ? s * T_P : M_PROMPT + (s - 8) * 64; }
__device__ __forceinline__ int seq_len(int s) { return s < 8 ? T_P : 64; }

__device__ __forceinline__ void phase_embed(const Params& p) {
  const long n4 = (long)M_TOT * 256;
  for (long idx = (long)BID * 256 + threadIdx.x, st_ = (long)NBLK * 256; idx < n4; idx += st_) {
    int m = (int)(idx >> 8), c4 = ((int)idx & 255) * 4;
    const float* src;
    if (m < M_PROMPT) {
      int b = m / T_P, t = m - b * T_P;
      src = (t < 16) ? p.meta + (long)t * DM : p.x_prompt + ((long)b * 4096 + (t - 16)) * DM;
    } else {
      src = p.x_sample + (long)(m - M_PROMPT) * DM;
    }
    float4 v = *(const float4*)(src + c4);
    ushort4 o;
    o.x = f2bf(v.x); o.y = f2bf(v.y); o.z = f2bf(v.z); o.w = f2bf(v.w);
    *(ushort4*)(p.XB + (long)m * DM + c4) = o;
  }
}

template <bool HAS_SCALE>
__device__ __forceinline__ void conv_tile(const float* __restrict__ src, int ldsrc, int srccol0, const float* __restrict__ scale,
                          u16* __restrict__ dst, int K, int k0, int n0, float* tile  ) {
  const int tid = opaque_tid();
  __syncthreads();
  {
    int nn = tid & 63, kb = tid >> 6;
#pragma unroll
    for (int i = 0; i < 16; ++i) {
      int kk = kb + 4 * i;
      float v = src[(long)(k0 + kk) * ldsrc + srccol0 + nn];
      if (HAS_SCALE) v *= scale[k0 + kk];
      tile[kk * 65 + nn] = v;
    }
  }
  __syncthreads();
  {
    int nn = tid >> 2, kq = (tid & 3) * 16;
    u16* d = dst + (long)(n0 + nn) * K + k0 + kq;
#pragma unroll
    for (int j = 0; j < 16; j += 2) {
      unsigned w = f2bf(tile[(kq + j) * 65 + nn]) | ((unsigned)f2bf(tile[(kq + j + 1) * 65 + nn]) << 16);
      *(unsigned*)(d + j) = w;
    }
  }
}

__device__ __forceinline__ int w1_srccol(int n0) {
  if (n0 < 512) return n0;
  if (n0 < 1024) return n0 - 512 + 1544;
  if (n0 < 1536) return n0 - 1024 + 4872;
  if (n0 < 2560) return n0 - 1536 + 512;
  if (n0 < 3840) return n0 - 2560 + 2056;
  return n0 - 3840 + 3336;
}

constexpr int CV_W1 = 16 * 84, CV_WO = 24 * 16, CV_WGU = 16 * 88, CV_WD = 44 * 16;
constexpr int CV_LORA = 32;
constexpr int CV_TOTAL = CV_W1 + CV_WO + CV_WGU + CV_WD + CV_LORA;

__device__ __forceinline__ void phase_convert(const Params& p, int l, float* smem) {
  for (int u = BID, nb_ = NBLK; u < CV_TOTAL; u += nb_) {
    if (u < CV_W1) {
      int kt = u % 16, nt = u / 16;
      conv_tile<true>(p.w_in + (long)l * DM * N_IN, N_IN, w1_srccol(nt * 64), p.norm1_w + l * DM, (p.WB + OFF_W1T), 1024, kt * 64,
                nt * 64, smem);
    } else if (u < CV_W1 + CV_WO) {
      int v = u - CV_W1;
      int kt = v % 24, nt = v / 24;
      conv_tile<false>(p.w_out + (long)l * 1536 * DM, DM, nt * 64, nullptr, (p.WB + OFF_WOT), 1536, kt * 64, nt * 64, smem);
    } else if (u < CV_W1 + CV_WO + CV_WGU) {
      int v = u - CV_W1 - CV_WO;
      int kt = v % 16, nt = v / 16;
      const float* wg = p.w_gate + (long)l * DM * D_FF;
      const float* wu = p.w_up + (long)l * DM * D_FF;
      const float* sc = p.norm2_w + l * DM;
      const int tid = opaque_tid();
      __syncthreads();
      {
        int nn = tid & 63, kb = tid >> 6;
        const float* src = (nn < 32) ? wg : wu;
        int col = nt * 32 + (nn & 31);
#pragma unroll
        for (int i = 0; i < 16; ++i) {
          int kk = kb + 4 * i;
          smem[kk * 65 + nn] = src[(long)(kt * 64 + kk) * D_FF + col] * sc[kt * 64 + kk];
        }
      }
      __syncthreads();
      {
        int nn = tid >> 2, kq = (tid & 3) * 16;
        u16* d = (p.WB + OFF_WGU) + (long)(nt * 64 + nn) * 1024 + kt * 64 + kq;
#pragma unroll
        for (int j = 0; j < 16; j += 2) {
          unsigned w = f2bf(smem[(kq + j) * 65 + nn]) | ((unsigned)f2bf(smem[(kq + j + 1) * 65 + nn]) << 16);
          *(unsigned*)(d + j) = w;
        }
      }
    } else if (u >= CV_W1 + CV_WO + CV_WGU + CV_WD) {
      int v = u - (CV_W1 + CV_WO + CV_WGU + CV_WD);
      const int tid = opaque_tid();
#pragma unroll 4
      for (int i = 0; i < 16; ++i) {
        int e = v * 4096 + i * 256 + tid;
        if (e < 32768) {
          int n = e >> 6, k = e & 63;
          (p.WB + OFF_W2T)[e] = f2bf(p.rw_w2[(long)l * 64 * 512 + k * 512 + n]);
        } else if (e < 65536) {
          int e2 = e - 32768, n = e2 >> 6, k = e2 & 63;
          (p.WB + OFF_A2T)[e2] = f2bf(p.rw_a2[(long)l * 64 * 512 + k * 512 + n]);
        } else {
          int e2 = e - 65536, n = e2 >> 7, k = e2 & 127;
          (p.WB + OFF_G2T)[e2] = f2bf(p.rw_g2[(long)l * 128 * 512 + k * 512 + n]);
        }
      }
    } else {
      int v = u - CV_W1 - CV_WO - CV_WGU;
      int kt = v % 44, nt = v / 44;
      conv_tile<false>(p.w_down + (long)l * D_FF * DM, DM, nt * 64, nullptr, (p.WB + OFF_WDT), D_FF, kt * 64, nt * 64, smem);
    }
  }
}

template <bool WITH_DT>
__device__ __forceinline__ void phase_rowstat(const Params& p, int l, float* smem) {
  const int tid = opaque_tid(), lane = tid & 63, wid = tid >> 6;
  float* dtw = smem;
  if (WITH_DT) {
    __syncthreads();
    const float* w = p.w_in + (long)l * DM * N_IN + 1536;
    const float* nw = p.norm1_w + l * DM;
    for (int i = tid; i < 8192; i += 256) {
      int k = i >> 3, h = i & 7;
      dtw[i] = w[(long)k * N_IN + h] * nw[k];
    }
    __syncthreads();
  }
  for (int blk = BID, nb_ = NBLK; blk < NBLK16; blk += nb_) {
    for (int rr = wid; rr < 16; rr += 4) {
      int m = blk * 16 + rr;
      float ss = 0.f;
      float d[8];
#pragma unroll
      for (int h = 0; h < 8; ++h) d[h] = 0.f;
#pragma unroll 1
      for (int j = 0; j < 4; ++j) {
        int k0 = lane * 4 + 256 * j;
        uint2 raw = *(const uint2*)(p.XB + (long)m * DM + k0);
        float xs[4] = {bf2f((u16)(raw.x & 0xffff)), bf2f((u16)(raw.x >> 16)), bf2f((u16)(raw.y & 0xffff)),
                       bf2f((u16)(raw.y >> 16))};
#pragma unroll
        for (int e = 0; e < 4; ++e) {
          float x = xs[e];
          ss += x * x;
          if (WITH_DT) {
            float4 w0 = *(const float4*)(dtw + (k0 + e) * 8);
            float4 w1 = *(const float4*)(dtw + (k0 + e) * 8 + 4);
            d[0] += x * w0.x; d[1] += x * w0.y; d[2] += x * w0.z; d[3] += x * w0.w;
            d[4] += x * w1.x; d[5] += x * w1.y; d[6] += x * w1.z; d[7] += x * w1.w;
          }
        }
      }
      ss = sum64(ss);
      float rs = rsqrtf(ss * (1.f / 1024.f) + 1e-6f);
      if (WITH_DT) {
#pragma unroll
        for (int h = 0; h < 8; ++h) d[h] = sum64(d[h]);
        if (lane == 0) {
#pragma unroll
          for (int h = 0; h < 8; ++h) (p.FB + FOFF_DTRAW)[(long)m * 8 + h] = d[h] * rs;
        }
      }
      if (lane == 0) (p.FB + FOFF_RS)[m] = rs;
    }
  }
}

constexpr int G_BK = 32, G_LDS_ROW = 80;
constexpr int G_OPER_BYTES = 128 * G_LDS_ROW;
template <int MODE>
__device__ __forceinline__ void phase_gemm(const Params& p, const u16* __restrict__ A, int lda, const u16* __restrict__ Bt, int K,
                           int nN, char* smem) {
  const int tid = opaque_tid(), lane = tid & 63, wid = tid >> 6, wm = wid >> 1, wn = wid & 1;
  const int nM = M_TOT / 128;
  const int ntiles = nM * nN;
  const int nk = K / G_BK;
  const int lrow = tid >> 2, lkc = tid & 3;
  for (int tile = BID, nb_ = NBLK; tile < ntiles; tile += nb_) {
    constexpr int GM = 32;
    int grp = tile / (GM * nN);
    int first_m = grp * GM;
    int gsz = min(GM, nM - first_m);
    int rem = tile - grp * GM * nN;
    int pm = first_m + rem % gsz, pn = rem / gsz;
    const u16* gA = A + (long)(pm * 128 + lrow) * lda + lkc * 8;
    const u16* gB = Bt + (long)(pn * 128 + lrow) * K + lkc * 8;
    f32x16 acc[2][2];
#pragma unroll
    for (int i = 0; i < 2; ++i)
#pragma unroll
      for (int j = 0; j < 2; ++j)
#pragma unroll
        for (int r = 0; r < 16; ++r) acc[i][j][r] = 0.f;
    uint4 xa0, xa1, xb0, xb1, ya0, ya1, yb0, yb1, za0, za1, zb0, zb1;
#define G_LOAD(S, KT)                                                  \
  {                                                                    \
    S##a0 = *(const uint4*)(gA + (KT) * G_BK);                         \
    S##a1 = *(const uint4*)(gA + (long)64 * lda + (KT) * G_BK);        \
    S##b0 = *(const uint4*)(gB + (KT) * G_BK);                         \
    S##b1 = *(const uint4*)(gB + (long)64 * K + (KT) * G_BK);          \
  }
#define G_STORE(S, BUF)                                                \
  {                                                                    \
    char* dA = smem + (BUF) * 2 * G_OPER_BYTES;                        \
    char* dB = dA + G_OPER_BYTES;                                      \
    *(uint4*)(dA + lrow * G_LDS_ROW + lkc * 16) = S##a0;               \
    *(uint4*)(dA + (lrow + 64) * G_LDS_ROW + lkc * 16) = S##a1;        \
    *(uint4*)(dB + lrow * G_LDS_ROW + lkc * 16) = S##b0;               \
    *(uint4*)(dB + (lrow + 64) * G_LDS_ROW + lkc * 16) = S##b1;        \
  }
#define G_COMPUTE(BUF)                                                                           \
  {                                                                                              \
    const char* sA = smem + (BUF) * 2 * G_OPER_BYTES;                                            \
    const char* sB = sA + G_OPER_BYTES;                                                          \
    _Pragma("unroll") for (int ks = 0; ks < 2; ++ks) {                                           \
      bf16x8 af[2], bfr[2];                                                                      \
      const int koff = (ks * 16 + (lane >> 5) * 8) * 2;                                          \
      _Pragma("unroll") for (int i = 0; i < 2; ++i)                                              \
        af[i] = *(const bf16x8*)(sA + (wm * 64 + i * 32 + (lane & 31)) * G_LDS_ROW + koff);      \
      _Pragma("unroll") for (int j = 0; j < 2; ++j)                                              \
        bfr[j] = *(const bf16x8*)(sB + (wn * 64 + j * 32 + (lane & 31)) * G_LDS_ROW + koff);     \
      __builtin_amdgcn_s_setprio(1);                                                             \
      _Pragma("unroll") for (int i = 0; i < 2; ++i)                                              \
        _Pragma("unroll") for (int j = 0; j < 2; ++j)                                            \
          acc[i][j] = __builtin_amdgcn_mfma_f32_32x32x16_bf16(af[i], bfr[j], acc[i][j], 0, 0, 0); \
      __builtin_amdgcn_s_setprio(0);                                                             \
    }                                                                                            \
  }
    G_LOAD(x, 0);
    G_LOAD(y, 1);
    G_LOAD(z, 2);
    __builtin_amdgcn_sched_barrier(0);
    __syncthreads();
    G_STORE(x, 0);
    __syncthreads();
#define G_STEP(T, SNEXT, SFREE, BUF)                          \
    if ((T) < nk) {                                           \
      if ((T) + 1 < nk) G_STORE(SNEXT, (BUF) ^ 1);            \
      if ((T) + 3 < nk) G_LOAD(SFREE, (T) + 3);               \
      __builtin_amdgcn_sched_barrier(0);                      \
      G_COMPUTE(BUF);                                         \
      __builtin_amdgcn_sched_barrier(0);                      \
      __syncthreads();                                        \
    }
    for (int kt = 0; kt < nk; kt += 6) {
      G_STEP(kt + 0, y, x, 0);
      G_STEP(kt + 1, z, y, 1);
      G_STEP(kt + 2, x, z, 0);
      G_STEP(kt + 3, y, x, 1);
      G_STEP(kt + 4, z, y, 0);
      G_STEP(kt + 5, x, z, 1);
    }
#undef G_STEP
#undef G_LOAD
#undef G_STORE
#undef G_COMPUTE
    const int colb = pn * 128 + wn * 64 + (lane & 31);
    const int rowb = pm * 128 + wm * 64 + 4 * (lane >> 5);
    if (MODE == 1) {
#pragma unroll
      for (int i = 0; i < 2; ++i)
#pragma unroll
        for (int r = 0; r < 16; ++r) {
          int row = rowb + i * 32 + (r & 3) + 8 * (r >> 2);
          float rs = (p.FB + FOFF_RS)[row];
#pragma unroll
          for (int j = 0; j < 2; ++j) {
            int col = colb + j * 32;
            u16 v = f2bf(acc[i][j][r] * rs);
            p.PROJ[(long)row * LDP + col] = v;
            if ((row & 15) == 15) {
              int jj = -1;
              if (col >= C_R && col < C_GG) jj = col - C_R;
              else if (col >= C_K && col < C_Q) jj = col - C_K + 512;
              if (jj >= 0) p.BND[(long)(row >> 4) * 1792 + jj] = v;
            }
            if ((row & 15) >= 13 && col >= C_XBC + 512 && col < C_XBC + 1024)
              p.BND2[((long)(row >> 4) * 3 + ((row & 15) - 13)) * 512 + (col - (C_XBC + 512))] = v;
          }
        }
    } else if (MODE == 2) {
#pragma unroll
      for (int i = 0; i < 2; ++i)
#pragma unroll
        for (int r = 0; r < 16; ++r) {
          int row = rowb + i * 32 + (r & 3) + 8 * (r >> 2);
#pragma unroll
          for (int j = 0; j < 2; ++j) {
            int col = colb + j * 32;
            u16* px = p.XB + (long)row * DM + col;
            *px = f2bf(bf2f(*px) + acc[i][j][r]);
          }
        }
    } else {
      const int cact = pn * 64 + wn * 32 + (lane & 31);
      u16* ACT = p.PROJ;
#pragma unroll
      for (int i = 0; i < 2; ++i)
#pragma unroll
        for (int r = 0; r < 16; ++r) {
          int row = rowb + i * 32 + (r & 3) + 8 * (r >> 2);
          float rs = (p.FB + FOFF_RS)[row];
          float g = acc[i][0][r] * rs, u = acc[i][1][r] * rs;
          ACT[(long)row * D_FF + cact] = f2bf(siluf_(g) * u);
        }
    }
  }
}

__device__ __forceinline__ void phase_pre(const Params& p, int l, float* smem) {
  const int tid = opaque_tid(), lane = tid & 63, wid = tid >> 6;
  u16* XWb = (u16*)smem;
  u16* XAb = (u16*)smem + 16 * 72;
  constexpr int LDW = 260;
  float* AW = smem + 1152;
  float* AA = smem + 1152 + 16 * LDW;
  const float* mu = p.rw_mu + l * 1792;
  for (int blk = BID, nb_ = NBLK; blk < NBLK16; blk += nb_) {
    const int m0 = blk * 16;
    int s, t0;
    if (m0 < M_PROMPT) { s = m0 / T_P; t0 = m0 - s * T_P; } else { s = 8 + (m0 - M_PROMPT) / 64; t0 = (m0 - M_PROMPT) & 63; }
    const bool first = (t0 == 0);
    auto prev_of = [&](int j) -> float {
      if (!first) return bf2f(p.BND[(long)(blk - 1) * 1792 + j]);
      if (s < 8) return 0.f;
      return p.state_shift[((long)l * 8 + (s - 8)) * 1792 + j];
    };
    __syncthreads();
    {
      int j = 1536 + tid;
      float mj = mu[j];
      float pv = prev_of(j);
      u16* col = p.PROJ + (long)m0 * LDP + C_XW + tid;
#pragma unroll
      for (int t = 0; t < 16; ++t) {
        float x = bf2f(col[(long)t * LDP]);
        float sh = x + (pv - x) * mj;
        pv = x;
        if (tid < 64) XWb[t * 72 + tid] = f2bf(tanhf(sh));
        else if (tid < 128) XAb[t * 72 + (tid - 64)] = f2bf(sh);
        else col[(long)t * LDP] = f2bf(sigmoidf_(sh));
      }
    }
    __syncthreads();
#pragma unroll 1
    for (int c = 0; c < 2; ++c) {
      const int ch = tid + 256 * c;
      const int head = wid + 4 * c;
      float aw[16], aa[16];
      {
        bf16x8 axw[2], axa[2];
#pragma unroll
        for (int ks = 0; ks < 2; ++ks) {
          axw[ks] = *(const bf16x8*)(XWb + (lane & 15) * 72 + ks * 32 + (lane >> 4) * 8);
          axa[ks] = *(const bf16x8*)(XAb + (lane & 15) * 72 + ks * 32 + (lane >> 4) * 8);
        }
#pragma unroll
        for (int nt = 0; nt < 4; ++nt) {
          const int ncol = (wid * 4 + nt) * 16 + (lane & 15);
          const int n = c * 256 + ncol;
          f32x4v accw = {0.f, 0.f, 0.f, 0.f}, acca = {0.f, 0.f, 0.f, 0.f};
#pragma unroll
          for (int ks = 0; ks < 2; ++ks) {
            bf16x8 bw = *(const bf16x8*)((p.WB + OFF_W2T) + n * 64 + ks * 32 + (lane >> 4) * 8);
            bf16x8 ba = *(const bf16x8*)((p.WB + OFF_A2T) + n * 64 + ks * 32 + (lane >> 4) * 8);
            accw = __builtin_amdgcn_mfma_f32_16x16x32_bf16(axw[ks], bw, accw, 0, 0, 0);
            acca = __builtin_amdgcn_mfma_f32_16x16x32_bf16(axa[ks], ba, acca, 0, 0, 0);
          }
#pragma unroll
          for (int r = 0; r < 4; ++r) {
            AW[((lane >> 4) * 4 + r) * LDW + ncol] = accw[r];
            AA[((lane >> 4) * 4 + r) * LDW + ncol] = acca[r];
          }
        }
        __syncthreads();
#pragma unroll
        for (int t = 0; t < 16; ++t) { aw[t] = AW[t * LDW + tid]; aa[t] = AA[t * LDW + tid]; }
        __syncthreads();
      }
      {
        float w0 = p.rw_w0[l * 512 + ch], a0 = p.rw_a0[l * 512 + ch];
#pragma unroll
        for (int t = 0; t < 16; ++t) {
          float lw = -softplusf_(-(w0 + aw[t])) - 0.5f;
          float u = -__expf(lw);
          p.RWX[(long)(m0 + t) * 1536 + ch] = f2bf(u);
          aa[t] = sigmoidf_(a0 + aa[t]);
        }
      }
      float rt[16];
      {
        float mj = mu[ch];
        float pv = prev_of(ch);
        u16* col = p.PROJ + (long)m0 * LDP + C_R + ch;
#pragma unroll
        for (int t = 0; t < 16; ++t) {
          float x = bf2f(col[(long)t * LDP]);
          rt[t] = x + (pv - x) * mj;
          pv = x;
        }
#pragma unroll
        for (int t = 0; t < 16; ++t) col[(long)t * LDP] = f2bf(rt[t]);
      }
      {
        float mj = mu[512 + ch];
        float pv = prev_of(512 + ch);
        float kkw = p.rw_kk[l * 512 + ch], kaw = p.rw_ka[l * 512 + ch], rkw = p.rw_rk[l * 512 + ch];
        u16* col = p.PROJ + (long)m0 * LDP + C_K + ch;
        float kt[16];
#pragma unroll
        for (int t = 0; t < 16; ++t) {
          float x = bf2f(col[(long)t * LDP]);
          kt[t] = x + (pv - x) * mj;
          pv = x;
        }
#pragma unroll
        for (int t = 0; t < 16; ++t) {
          float kkv = kt[t] * kkw;
          float ssq = sum64(kkv * kkv);
          float kk = kkv * rsqrtf(ssq + 1e-12f);
          float a = aa[t];
          float kp = kt[t] * (1.f + (a - 1.f) * kaw);
          float rks = sum64(rt[t] * kp * rkw);
          col[(long)t * LDP] = f2bf(kp);
          p.RWX[(long)(m0 + t) * 1536 + 512 + ch] = f2bf(kk);
          p.RWX[(long)(m0 + t) * 1536 + 1024 + ch] = f2bf(kk * a);
          if (lane == 0) (p.FB + FOFF_RKS)[(long)(m0 + t) * 8 + head] = rks;
        }
      }
      {
        float mj = mu[1024 + ch];
        float pv = prev_of(1024 + ch);
        u16* col = p.PROJ + (long)m0 * LDP + C_V + ch;
        float vt[16];
#pragma unroll
        for (int t = 0; t < 16; ++t) {
          float x = bf2f(col[(long)t * LDP]);
          vt[t] = x + (pv - x) * mj;
          pv = x;
        }
#pragma unroll
        for (int t = 0; t < 16; ++t) col[(long)t * LDP] = f2bf(vt[t]);
      }
    }
#pragma unroll 1
    for (int c = 0; c < 2; ++c) {
      const int cc = tid + 256 * c;
      const float* cw = p.conv_w + (long)l * 4096 + 512 + cc;
      const float w0 = cw[0], w1 = cw[1024], w2 = cw[2048], w3 = cw[3072];
      const float bb = p.conv_b[l * 1024 + 512 + cc];
      float u3, u2, u1;
      if (!first) {
        const u16* pb = p.BND2 + (long)(blk - 1) * 1536 + cc;
        u3 = bf2f(pb[0]); u2 = bf2f(pb[512]); u1 = bf2f(pb[1024]);
      } else if (s >= 8) {
        const float* sc = p.state_conv + ((long)l * 8 + (s - 8)) * 3072 + 512 + cc;
        u3 = sc[0]; u2 = sc[1024]; u1 = sc[2048];
      } else {
        u3 = 0.f; u2 = 0.f; u1 = 0.f;
      }
      u16* col = p.PROJ + (long)m0 * LDP + C_XBC + 512 + cc;
      float yv[16];
#pragma unroll
      for (int t = 0; t < 16; ++t) {
        float u0 = bf2f(col[(long)t * LDP]);
        yv[t] = siluf_(w0 * u3 + w1 * u2 + w2 * u1 + w3 * u0 + bb);
        u3 = u2; u2 = u1; u1 = u0;
      }
#pragma unroll
      for (int t = 0; t < 16; ++t) col[(long)t * LDP] = f2bf(yv[t]);
    }
    if (t0 + 16 == seq_len(s)) {
      float* o = p.out + (s < 8 ? O_PSHIFT + ((long)l * 8 + s) * 1792 : O_SSHIFT + ((long)l * 8 + (s - 8)) * 1792);
      for (int j = tid; j < 1792; j += 256) o[j] = bf2f(p.BND[(long)blk * 1792 + j]);
    }
  }
}

__device__ __forceinline__ void scan_rwkv(const Params& p, int l, int s, int h, int q, float* smem) {
  const int tid = opaque_tid(), lane = tid & 63, wid = tid >> 6;
  float* R_ = smem;
  float* W_ = smem + 1024;
  float* K_ = smem + 2048;
  float* A_ = smem + 3072;
  float* B_ = smem + 4096;
  float* V_ = smem + 5120;
  float* O_ = smem + 5376;
  const int rl = wid * 4 + (lane >> 4);
  const int row = q * 16 + rl;
  const int ksl = (lane & 15) * 4;
  const int base = seq_base(s), T = seq_len(s);
  float s0 = 0.f, s1 = 0.f, s2 = 0.f, s3 = 0.f;
  if (s >= 8) {
    const float* st = p.state_rwkv + (((long)l * 8 + (s - 8)) * 8 + h) * 4096 + row * 64 + ksl;
    float4 v = *(const float4*)st;
    s0 = v.x; s1 = v.y; s2 = v.z; s3 = v.w;
  }
  const int stt = tid >> 4, skq = (tid & 15) * 4;
  const int nblk = T / 16;
  ushort4 r4, k4, u4, a4, b4;
  u16 vv;
  {
    const long m = base + stt;
    const u16* pr = p.PROJ + m * LDP;
    const u16* px = p.RWX + m * 1536;
    r4 = *(const ushort4*)(pr + C_R + h * 64 + skq);
    k4 = *(const ushort4*)(pr + C_K + h * 64 + skq);
    u4 = *(const ushort4*)(px + h * 64 + skq);
    a4 = *(const ushort4*)(px + 512 + h * 64 + skq);
    b4 = *(const ushort4*)(px + 1024 + h * 64 + skq);
    vv = pr[C_V + h * 64 + q * 16 + (tid & 15)];
  }
  __syncthreads();
  float* TR_ = smem + 5376 + 512;
  const bool wr = (lane & 15) == 0;
  const int ooff = wr ? rl : (512 + lane);
  const int ostr = wr ? 16 : 0;
  for (int blk = 0; blk < nblk; ++blk) {
    const long m = base + blk * 16 + stt;
    float* Oc = O_ + (blk & 1) * 256;
    {
      *(float4*)(R_ + stt * 64 + skq) = make_float4(bf2f(r4.x), bf2f(r4.y), bf2f(r4.z), bf2f(r4.w));
      *(float4*)(K_ + stt * 64 + skq) = make_float4(bf2f(k4.x), bf2f(k4.y), bf2f(k4.z), bf2f(k4.w));
      *(float4*)(W_ + stt * 64 + skq) =
          make_float4(__expf(bf2f(u4.x)), __expf(bf2f(u4.y)), __expf(bf2f(u4.z)), __expf(bf2f(u4.w)));
      *(float4*)(A_ + stt * 64 + skq) = make_float4(-bf2f(a4.x), -bf2f(a4.y), -bf2f(a4.z), -bf2f(a4.w));
      *(float4*)(B_ + stt * 64 + skq) = make_float4(bf2f(b4.x), bf2f(b4.y), bf2f(b4.z), bf2f(b4.w));
      V_[stt * 16 + (tid & 15)] = bf2f(vv);
    }
    __syncthreads();
    if (blk > 0)
      p.ORW[(m - 16) * 512 + h * 64 + q * 16 + (tid & 15)] = f2bf(O_[((blk - 1) & 1) * 256 + stt * 16 + (tid & 15)]);
    if (blk + 1 < nblk) {
      const u16* pr = p.PROJ + (m + 16) * LDP;
      const u16* px = p.RWX + (m + 16) * 1536;
      r4 = *(const ushort4*)(pr + C_R + h * 64 + skq);
      k4 = *(const ushort4*)(pr + C_K + h * 64 + skq);
      u4 = *(const ushort4*)(px + h * 64 + skq);
      a4 = *(const ushort4*)(px + 512 + h * 64 + skq);
      b4 = *(const ushort4*)(px + 1024 + h * 64 + skq);
      vv = pr[C_V + h * 64 + q * 16 + (tid & 15)];
    }
    __builtin_amdgcn_sched_barrier(0);
    {
      float4 a = *(const float4*)(A_ + ksl), w = *(const float4*)(W_ + ksl), b = *(const float4*)(B_ + ksl);
      float4 k = *(const float4*)(K_ + ksl), r = *(const float4*)(R_ + ksl);
      float v = V_[rl];
      float opart = 0.f;
#pragma unroll
      for (int tt = 0; tt < 16; ++tt) {
        float4 an, wn, bn, kn, rn;
        float vn;
        if (tt + 1 < 16) {
          an = *(const float4*)(A_ + (tt + 1) * 64 + ksl); wn = *(const float4*)(W_ + (tt + 1) * 64 + ksl);
          bn = *(const float4*)(B_ + (tt + 1) * 64 + ksl); kn = *(const float4*)(K_ + (tt + 1) * 64 + ksl);
          rn = *(const float4*)(R_ + (tt + 1) * 64 + ksl); vn = V_[(tt + 1) * 16 + rl];
        }
        __builtin_amdgcn_sched_barrier(0);
        float sa = fmaf(s0, a.x, fmaf(s1, a.y, fmaf(s2, a.z, s3 * a.w)));
        if (tt > 0) { sum16x2(sa, opart); Oc[ooff + (tt - 1) * ostr] = opart; }
        else sa = sum16(sa);
        s0 = fmaf(s0, w.x, fmaf(sa, b.x, v * k.x)); NOPK(s0);
        s1 = fmaf(s1, w.y, fmaf(sa, b.y, v * k.y)); NOPK(s1);
        s2 = fmaf(s2, w.z, fmaf(sa, b.z, v * k.z)); NOPK(s2);
        s3 = fmaf(s3, w.w, fmaf(sa, b.w, v * k.w)); NOPK(s3);
        opart = fmaf(s0, r.x, fmaf(s1, r.y, fmaf(s2, r.z, s3 * r.w)));
        if (tt == 15) { opart = sum16(opart); Oc[ooff + 15 * ostr] = opart; }
        __builtin_amdgcn_sched_barrier(0);
        if (tt + 1 < 16) { a = an; w = wn; b = bn; k = kn; r = rn; v = vn; }
      }
    }
    __builtin_amdgcn_sched_barrier(0);
    __syncthreads();
  }
  {
    const long m = base + (nblk - 1) * 16 + stt;
    p.ORW[m * 512 + h * 64 + q * 16 + (tid & 15)] = f2bf(O_[((nblk - 1) & 1) * 256 + stt * 16 + (tid & 15)]);
  }
  __syncthreads();
  {
    float* o = p.out + (s < 8 ? O_PRWKV + (((long)l * 8 + s) * 8 + h) * 4096
                              : O_SRWKV + (((long)l * 8 + (s - 8)) * 8 + h) * 4096);
    *(float4*)(o + row * 64 + ksl) = make_float4(s0, s1, s2, s3);
  }
}

__device__ __forceinline__ void scan_hgrn(const Params& p, int l, int s, int h, int q, float* smem) {
  const int tid = opaque_tid(), lane = tid & 63, wid = tid >> 6;
  float* Q_ = smem;
  float* F_ = smem + 2048;
  float* G_ = smem + 4096;
  float* I_ = smem + 6144;
  float* O_ = smem + 6400;
  const int rl = wid * 4 + (lane >> 4);
  const int row = q * 16 + rl;
  const int ksl4 = (lane & 15) * 4;
  const int base = seq_base(s), T = seq_len(s);
  float st[8];
#pragma unroll
  for (int i = 0; i < 8; ++i) st[i] = 0.f;
  if (s >= 8) {
    const float* sp = p.state_hgrn + (((long)l * 8 + (s - 8)) * 4 + h) * 16384;
#pragma unroll
    for (int i = 0; i < 8; ++i) st[i] = sp[((i >> 2) * 64 + ksl4 + (i & 3)) * 128 + row];
  }
  const int stt = tid >> 4, skq = (tid & 15) * 8;
  float lb[8];
#pragma unroll
  for (int i = 0; i < 8; ++i) {
    if (l == 0) lb[i] = 0.f;
    else {
      float x0 = p.hg_lb[h * 128 + skq + i], x1 = p.hg_lb[512 + h * 128 + skq + i];
      lb[i] = frcp_(1.f + __expf(x0 - x1));
    }
  }
  const int nblk = T / 16;
  uint4 q8, f8;
  u16 iv16;
  {
    const u16* pr = p.PROJ + (long)(base + stt) * LDP;
    q8 = *(const uint4*)(pr + C_Q + h * 128 + skq);
    f8 = *(const uint4*)(pr + C_F + h * 128 + skq);
    iv16 = pr[C_I + h * 128 + q * 16 + (tid & 15)];
  }
  __syncthreads();
  float* TR_ = smem + 6400 + 512;
  const bool wr = (lane & 15) == 0;
  const int ooff = wr ? rl : (512 + lane);
  const int ostr = wr ? 16 : 0;
  for (int blk = 0; blk < nblk; ++blk) {
    const long m = base + blk * 16 + stt;
    float* Oc = O_ + (blk & 1) * 256;
    {
      unsigned qw[4] = {q8.x, q8.y, q8.z, q8.w}, fw[4] = {f8.x, f8.y, f8.z, f8.w};
      float qv[8], fv[8];
#pragma unroll
      for (int e = 0; e < 8; ++e) {
        qv[e] = bf2f((u16)((qw[e >> 1] >> ((e & 1) * 16)) & 0xffff));
        float fz = bf2f((u16)((fw[e >> 1] >> ((e & 1) * 16)) & 0xffff));
        float ex = __expf(-fz);
        float sg = frcp_(1.f + ex);
        fv[e] = lb[e] + (1.f - lb[e]) * sg;
      }
      *(float4*)(Q_ + stt * 128 + skq) = make_float4(qv[0], qv[1], qv[2], qv[3]);
      *(float4*)(Q_ + stt * 128 + skq + 4) = make_float4(qv[4], qv[5], qv[6], qv[7]);
      *(float4*)(F_ + stt * 128 + skq) = make_float4(fv[0], fv[1], fv[2], fv[3]);
      *(float4*)(F_ + stt * 128 + skq + 4) = make_float4(fv[4], fv[5], fv[6], fv[7]);
      I_[stt * 16 + (tid & 15)] = bf2f(iv16);
    }
    __syncthreads();
    if (blk > 0) {
      u16* dp = p.PROJ + (m - 16) * LDP + C_I + h * 128 + q * 16 + (tid & 15);
      *dp = f2bf(O_[((blk - 1) & 1) * 256 + stt * 16 + (tid & 15)]);
    }
    if (blk + 1 < nblk) {
      const u16* pr = p.PROJ + (m + 16) * LDP;
      q8 = *(const uint4*)(pr + C_Q + h * 128 + skq);
      f8 = *(const uint4*)(pr + C_F + h * 128 + skq);
      iv16 = pr[C_I + h * 128 + q * 16 + (tid & 15)];
    }
    __builtin_amdgcn_sched_barrier(0);
    {
      float4 f0 = *(const float4*)(F_ + ksl4), f1 = *(const float4*)(F_ + 64 + ksl4);
      float4 q0 = *(const float4*)(Q_ + ksl4), q1 = *(const float4*)(Q_ + 64 + ksl4);
      float iv = I_[rl];
      float oprev = 0.f;
#pragma unroll
      for (int tt = 0; tt < 16; ++tt) {
        float4 f0n, f1n, q0n, q1n;
        float ivn;
        if (tt + 1 < 16) {
          const int o_ = (tt + 1) * 128;
          f0n = *(const float4*)(F_ + o_ + ksl4); f1n = *(const float4*)(F_ + o_ + 64 + ksl4);
          q0n = *(const float4*)(Q_ + o_ + ksl4); q1n = *(const float4*)(Q_ + o_ + 64 + ksl4);
          ivn = I_[(tt + 1) * 16 + rl];
        }
        __builtin_amdgcn_sched_barrier(0);
        st[0] = fmaf(st[0] - iv, f0.x, iv); NOPK(st[0]);
        st[1] = fmaf(st[1] - iv, f0.y, iv); NOPK(st[1]);
        st[2] = fmaf(st[2] - iv, f0.z, iv); NOPK(st[2]);
        st[3] = fmaf(st[3] - iv, f0.w, iv); NOPK(st[3]);
        st[4] = fmaf(st[4] - iv, f1.x, iv); NOPK(st[4]);
        st[5] = fmaf(st[5] - iv, f1.y, iv); NOPK(st[5]);
        st[6] = fmaf(st[6] - iv, f1.z, iv); NOPK(st[6]);
        st[7] = fmaf(st[7] - iv, f1.w, iv); NOPK(st[7]);
        float acc0 = fmaf(st[0], q0.x, fmaf(st[1], q0.y, fmaf(st[2], q0.z, st[3] * q0.w)));
        float acc1 = fmaf(st[4], q1.x, fmaf(st[5], q1.y, fmaf(st[6], q1.z, st[7] * q1.w)));
        float o = acc0 + acc1;
        if (tt & 1) { sum16x2(oprev, o); Oc[ooff + (tt - 1) * ostr] = oprev; Oc[ooff + tt * ostr] = o; }
        else oprev = o;
        __builtin_amdgcn_sched_barrier(0);
        if (tt + 1 < 16) { f0 = f0n; f1 = f1n; q0 = q0n; q1 = q1n; iv = ivn; }
      }
    }
    __builtin_amdgcn_sched_barrier(0);
    __syncthreads();
  }
  {
    const long m = base + (nblk - 1) * 16 + stt;
    u16* dp = p.PROJ + m * LDP + C_I + h * 128 + q * 16 + (tid & 15);
    *dp = f2bf(O_[((nblk - 1) & 1) * 256 + stt * 16 + (tid & 15)]);
  }
  __syncthreads();
  {
    float* o = p.out + (s < 8 ? O_PHGRN + (((long)l * 8 + s) * 4 + h) * 16384
                              : O_SHGRN + (((long)l * 8 + (s - 8)) * 4 + h) * 16384);
#pragma unroll
    for (int i = 0; i < 8; ++i) o[((i >> 2) * 64 + ksl4 + (i & 3)) * 128 + row] = st[i];
  }
}

__device__ __forceinline__ void scan_ssd(const Params& p, int l, int s, int h, int q, float* smem) {
  const int tid = opaque_tid(), lane = tid & 63, wid = tid >> 6;
  float* B_ = smem;
  float* C_ = smem + 2048;
  float* X_ = smem + 4096;
  float* O_ = smem + 4352;
  float* DT_ = smem + 5200;
  float* DE_ = smem + 5216;
  const int rl = wid * 4 + (lane >> 4);
  const int row = q * 16 + rl;
  const int ksl4 = (lane & 15) * 4;
  const int g = h >> 2;
  const int base = seq_base(s), T = seq_len(s);
  float st[8];
#pragma unroll
  for (int i = 0; i < 8; ++i) st[i] = 0.f;
  if (s >= 8) {
    const float* sp = p.state_ssm + (((long)l * 8 + (s - 8)) * 8 + h) * 8192 + row * 128 + ksl4;
    float4 a = *(const float4*)sp, b = *(const float4*)(sp + 64);
    st[0] = a.x; st[1] = a.y; st[2] = a.z; st[3] = a.w; st[4] = b.x; st[5] = b.y; st[6] = b.z; st[7] = b.w;
  }
  const float* cw = p.conv_w + (long)l * 4 * 1024;
  const int skq8 = (tid & 15) * 8;
  const int xc_x = h * 64 + q * 16 + (tid & 15);
  const float cx0 = cw[xc_x], cx1 = cw[1024 + xc_x], cx2 = cw[2048 + xc_x], cx3 = cw[3072 + xc_x];
  const float cxb = p.conv_b[l * 1024 + xc_x];
  const float dtb = p.dt_bias[l * 8 + h];
  const float aexp = __expf(p.a_log[l * 8 + h]);
  const float dsk = p.d_skip[l * 8 + h];
  const int stt = tid >> 4;
  const int nblk = T / 16;
  uint4 rawb, rawc;
  float xr[4];
  float dtr = 0.f;
  u16 zc = 0, zn = 0;
#define SSD_LOAD(M0)                                                              \
  {                                                                               \
    {                                                                             \
      const u16* prow = p.PROJ + ((long)(M0) + stt) * LDP + C_XBC + g * 128 + skq8; \
      rawb = *(const uint4*)(prow + 512);                                         \
      rawc = *(const uint4*)(prow + 768);                                         \
    }                                                                             \
    {                                                                             \
      const long mr = (long)(M0) + stt;                                           \
      const u16* colx = p.PROJ + mr * LDP + C_XBC + xc_x;                         \
      _Pragma("unroll") for (int j = 0; j < 4; ++j) {                             \
        const long mm = mr - 3 + j;                                               \
        float vx;                                                                 \
        if (mm >= base) vx = bf2f(colx[(long)(j - 3) * LDP]);                     \
        else vx = (s >= 8) ? p.state_conv[((long)l * 8 + (s - 8)) * 3072 + (3 + (int)(mm - base)) * 1024 + xc_x] : 0.f; \
        xr[j] = vx;                                                               \
      }                                                                           \
    }                                                                             \
    if (tid < 16) dtr = (p.FB + FOFF_DTRAW)[((long)(M0) + tid) * 8 + h];                      \
    zn = p.PROJ[((long)(M0) + stt) * LDP + C_Z + h * 64 + q * 16 + (tid & 15)];   \
  }
  SSD_LOAD(base);
  __syncthreads();
  const bool wr = (lane & 15) == 0;
  const int ooff = wr ? rl : (512 + lane);
  const int ostr = wr ? 16 : 0;
  u16 zp = 0;
  for (int blk = 0; blk < nblk; ++blk) {
    const long m0 = base + blk * 16;
    zp = zc;
    zc = zn;
    float* Oc = O_ + (blk & 1) * 256;
    {
      {
        const unsigned bw[4] = {rawb.x, rawb.y, rawb.z, rawb.w}, cwd[4] = {rawc.x, rawc.y, rawc.z, rawc.w};
        float bv[8], cv[8];
#pragma unroll
        for (int e = 0; e < 8; ++e) {
          bv[e] = bf2f((u16)((bw[e >> 1] >> ((e & 1) * 16)) & 0xffff));
          cv[e] = bf2f((u16)((cwd[e >> 1] >> ((e & 1) * 16)) & 0xffff));
        }
        *(float4*)(B_ + stt * 128 + skq8) = make_float4(bv[0], bv[1], bv[2], bv[3]);
        *(float4*)(B_ + stt * 128 + skq8 + 4) = make_float4(bv[4], bv[5], bv[6], bv[7]);
        *(float4*)(C_ + stt * 128 + skq8) = make_float4(cv[0], cv[1], cv[2], cv[3]);
        *(float4*)(C_ + stt * 128 + skq8 + 4) = make_float4(cv[4], cv[5], cv[6], cv[7]);
      }
      {
        float y = cx0 * xr[0] + cx1 * xr[1] + cx2 * xr[2] + cx3 * xr[3] + cxb;
        X_[stt * 16 + (tid & 15)] = siluf_(y);
      }
      if (tid < 16) {
        float dtv = softplusf_(dtr + dtb);
        DT_[tid] = dtv;
        DE_[tid] = __expf(-aexp * dtv);
      }
    }
    __syncthreads();
    if (blk > 0) {
      u16* pz = p.PROJ + (m0 - 16 + stt) * LDP + C_Z + h * 64 + q * 16 + (tid & 15);
      *pz = f2bf(O_[((blk - 1) & 1) * 256 + stt * 16 + (tid & 15)] * siluf_(bf2f(zp)));
    }
    if (blk + 1 < nblk) SSD_LOAD(m0 + 16);
    __builtin_amdgcn_sched_barrier(0);
    {
      float4 b0 = *(const float4*)(B_ + ksl4), b1 = *(const float4*)(B_ + 64 + ksl4);
      float4 c0 = *(const float4*)(C_ + ksl4), c1 = *(const float4*)(C_ + 64 + ksl4);
      float xv = X_[rl], dt = DT_[0], de = DE_[0];
      float yprev = 0.f, xvprev = 0.f;
#pragma unroll
      for (int tt = 0; tt < 16; ++tt) {
        float4 b0n, b1n, c0n, c1n;
        float xvn, dtn, den;
        if (tt + 1 < 16) {
          const int o_ = (tt + 1) * 128;
          b0n = *(const float4*)(B_ + o_ + ksl4); b1n = *(const float4*)(B_ + o_ + 64 + ksl4);
          c0n = *(const float4*)(C_ + o_ + ksl4); c1n = *(const float4*)(C_ + o_ + 64 + ksl4);
          xvn = X_[(tt + 1) * 16 + rl]; dtn = DT_[tt + 1]; den = DE_[tt + 1];
        }
        __builtin_amdgcn_sched_barrier(0);
        const float xd = xv * dt;
        st[0] = fmaf(st[0], de, xd * b0.x); NOPK(st[0]);
        st[1] = fmaf(st[1], de, xd * b0.y); NOPK(st[1]);
        st[2] = fmaf(st[2], de, xd * b0.z); NOPK(st[2]);
        st[3] = fmaf(st[3], de, xd * b0.w); NOPK(st[3]);
        st[4] = fmaf(st[4], de, xd * b1.x); NOPK(st[4]);
        st[5] = fmaf(st[5], de, xd * b1.y); NOPK(st[5]);
        st[6] = fmaf(st[6], de, xd * b1.z); NOPK(st[6]);
        st[7] = fmaf(st[7], de, xd * b1.w); NOPK(st[7]);
        float acc0 = fmaf(st[0], c0.x, fmaf(st[1], c0.y, fmaf(st[2], c0.z, st[3] * c0.w)));
        float acc1 = fmaf(st[4], c1.x, fmaf(st[5], c1.y, fmaf(st[6], c1.z, st[7] * c1.w)));
        float y = acc0 + acc1;
        if (tt & 1) { sum16x2(yprev, y); Oc[ooff + (tt - 1) * ostr] = yprev + dsk * xvprev; Oc[ooff + tt * ostr] = y + dsk * xv; }
        else { yprev = y; xvprev = xv; }
        __builtin_amdgcn_sched_barrier(0);
        if (tt + 1 < 16) { b0 = b0n; b1 = b1n; c0 = c0n; c1 = c1n; xv = xvn; dt = dtn; de = den; }
      }
    }
    __builtin_amdgcn_sched_barrier(0);
    __syncthreads();
  }
  {
    const long m0 = base + (nblk - 1) * 16;
    u16* pz = p.PROJ + (m0 + stt) * LDP + C_Z + h * 64 + q * 16 + (tid & 15);
    *pz = f2bf(O_[((nblk - 1) & 1) * 256 + stt * 16 + (tid & 15)] * siluf_(bf2f(zc)));
  }
  __syncthreads();
#undef SSD_LOAD
  {
    float* o = p.out + (s < 8 ? O_PSSM + (((long)l * 8 + s) * 8 + h) * 8192
                              : O_SSSM + (((long)l * 8 + (s - 8)) * 8 + h) * 8192);
    *(float4*)(o + row * 128 + ksl4) = make_float4(st[0], st[1], st[2], st[3]);
    *(float4*)(o + row * 128 + 64 + ksl4) = make_float4(st[4], st[5], st[6], st[7]);
  }
  if (h == 0 && q == 0) {
    float* o = p.out + (s < 8 ? O_PCONV + ((long)l * 8 + s) * 3072 : O_SCONV + ((long)l * 8 + (s - 8)) * 3072);
    const long lastblk = (long)(base + T) / 16 - 1;
    for (int i = tid; i < 3072; i += 256) {
      int r = i >> 10, c = i & 1023;
      o[i] = (c < 512) ? bf2f(p.PROJ[(long)(base + T - 3 + r) * LDP + C_XBC + c])
                       : bf2f(p.BND2[(lastblk * 3 + r) * 512 + (c - 512)]);
    }
  }
}

__device__ __forceinline__ void phase_scan(const Params& p, int l, float* smem) {
  for (int u = BID, nb_ = NBLK; u < 1536; u += nb_) {
    int sample = u >= 768;
    int v = sample ? u - 768 : u;
    int type = v % 3, w = v / 3;
    if (type == 0) {
      int q = w & 3, h = (w >> 2) & 7, b = w >> 5;
      scan_rwkv(p, l, b + 8 * sample, h, q, smem);
    } else if (type == 1) {
      int q = w & 7, h = (w >> 3) & 3, b = w >> 5;
      scan_hgrn(p, l, b + 8 * sample, h, q, smem);
    } else {
      int q = w & 3, h = (w >> 2) & 7, b = w >> 5;
      scan_ssd(p, l, b + 8 * sample, h, q, smem);
    }
  }
}

__device__ __forceinline__ void phase_post(const Params& p, int l, float* smem) {
  const int tid = opaque_tid(), lane = tid & 63, wid = tid >> 6;
  constexpr int LDG = 516;
  float* GA = smem;
  const int T = tid >> 4, Q = tid & 15;
  for (int blk = BID, nb_ = NBLK; blk < NBLK16; blk += nb_) {
    const long m0 = (long)blk * 16;
    const long m = m0 + T;
    __syncthreads();
    {
      bf16x8 ag[4];
      const u16* arow = p.PROJ + (m0 + (lane & 15)) * LDP + C_XG + (lane >> 4) * 8;
#pragma unroll
      for (int ks = 0; ks < 4; ++ks) ag[ks] = *(const bf16x8*)(arow + ks * 32);
#pragma unroll
      for (int nt = 0; nt < 8; ++nt) {
        const int n = (wid * 8 + nt) * 16 + (lane & 15);
        f32x4v acc = {0.f, 0.f, 0.f, 0.f};
#pragma unroll
        for (int ks = 0; ks < 4; ++ks) {
          bf16x8 bg = *(const bf16x8*)((p.WB + OFF_G2T) + n * 128 + ks * 32 + (lane >> 4) * 8);
          acc = __builtin_amdgcn_mfma_f32_16x16x32_bf16(ag[ks], bg, acc, 0, 0, 0);
        }
#pragma unroll
        for (int r = 0; r < 4; ++r) GA[((lane >> 4) * 4 + r) * LDG + n] = acc[r];
      }
    }
    __syncthreads();
    u16* row = p.PROJ + m * LDP;
#pragma unroll 1
    for (int g = 0; g < 2; ++g) {
      float y0[8], y1[8], w[8];
      const int c0 = g * 256 + Q * 8, c1 = c0 + 128;
      unpack8(*(const uint4*)(row + C_Z + c0), y0);
      unpack8(*(const uint4*)(row + C_Z + c1), y1);
      float ss = 0.f;
#pragma unroll
      for (int e = 0; e < 8; ++e) ss += y0[e] * y0[e] + y1[e] * y1[e];
      ss = sum16(ss);
      const float rs = rsqrtf(ss * (1.f / 256.f) + 1e-6f);
      ld8(p.ssd_norm_w + l * 512 + c0, w);
#pragma unroll
      for (int e = 0; e < 8; ++e) y0[e] = y0[e] * rs * w[e];
      ld8(p.ssd_norm_w + l * 512 + c1, w);
#pragma unroll
      for (int e = 0; e < 8; ++e) y1[e] = y1[e] * rs * w[e];
      *(uint4*)(row + C_Z + c0) = pack8(y0);
      *(uint4*)(row + C_Z + c1) = pack8(y1);
    }
#pragma unroll 1
    for (int j = 0; j < 4; ++j) {
      const int c0 = j * 128 + Q * 8;
      {
        float oh[8], gg[8], w[8];
        unpack8(*(const uint4*)(row + C_I + c0), oh);
        unpack8(*(const uint4*)(row + C_GG + c0), gg);
        float ss = 0.f;
#pragma unroll
        for (int e = 0; e < 8; ++e) ss += oh[e] * oh[e];
        ss = sum16(ss);
        const float rs = rsqrtf(ss * (1.f / 128.f) + 1e-6f);
        ld8(p.hg_norm_w + l * 512 + c0, w);
#pragma unroll
        for (int e = 0; e < 8; ++e) oh[e] = oh[e] * rs * w[e] * siluf_(gg[e]);
        *(uint4*)(row + C_GG + c0) = pack8(oh);
      }
      {
        float o[8], v[8], w[8], bb[8], ga[8];
        const int head = j * 2 + (Q >> 3);
        unpack8(*(const uint4*)(p.ORW + m * 512 + c0), o);
        unpack8(*(const uint4*)(row + C_V + c0), v);
        float sm = 0.f;
#pragma unroll
        for (int e = 0; e < 8; ++e) sm += o[e];
        const float mean = sum8(sm) * (1.f / 64.f);
        float sv = 0.f;
#pragma unroll
        for (int e = 0; e < 8; ++e) { o[e] -= mean; sv += o[e] * o[e]; }
        const float rstd = rsqrtf(sum8(sv) * (1.f / 64.f) + 64e-5f);
        const float rks = (p.FB + FOFF_RKS)[m * 8 + head];
        ld8(p.rw_lnx_w + l * 512 + c0, w);
        ld8(p.rw_lnx_b + l * 512 + c0, bb);
        ld8(GA + T * LDG + c0, ga);
#pragma unroll
        for (int e = 0; e < 8; ++e) o[e] = (o[e] * rstd * w[e] + bb[e] + rks * v[e]) * ga[e];
        *(uint4*)(row + C_R + c0) = pack8(o);
      }
    }
  }
}

__device__ __forceinline__ void phase_final(const Params& p) {
  const int tid = opaque_tid(), lane = tid & 63, wid = tid >> 6;
  for (int m = BID * 4 + wid, nb_ = NBLK; m < M_TOT; m += nb_ * 4) {
    float* dst;
    if (m < M_PROMPT) {
      int b = m / T_P, t = m - b * T_P;
      if (t < 16) continue;
      dst = p.out + O_YP + ((long)b * 4096 + (t - 16)) * DM;
    } else {
      dst = p.out + O_YS + (long)(m - M_PROMPT) * DM;
    }
    float x[16];
    float ss = 0.f;
#pragma unroll
    for (int j = 0; j < 2; ++j) {
      uint4 raw = *(const uint4*)(p.XB + (long)m * DM + lane * 8 + 512 * j);
      unsigned wv[4] = {raw.x, raw.y, raw.z, raw.w};
#pragma unroll
      for (int e = 0; e < 8; ++e) {
        x[j * 8 + e] = bf2f((u16)((wv[e >> 1] >> ((e & 1) * 16)) & 0xffff));
        ss += x[j * 8 + e] * x[j * 8 + e];
      }
    }
    ss = sum64(ss);
    float rs = rsqrtf(ss * (1.f / 1024.f) + 1e-6f);
#pragma unroll
    for (int j = 0; j < 2; ++j) {
      int k0 = lane * 8 + 512 * j;
      float4 w0 = *(const float4*)(p.final_w + k0), w1 = *(const float4*)(p.final_w + k0 + 4);
      *(float4*)(dst + k0) = make_float4(x[j * 8 + 0] * rs * w0.x, x[j * 8 + 1] * rs * w0.y, x[j * 8 + 2] * rs * w0.z,
                                         x[j * 8 + 3] * rs * w0.w);
      *(float4*)(dst + k0 + 4) = make_float4(x[j * 8 + 4] * rs * w1.x, x[j * 8 + 5] * rs * w1.y,
                                             x[j * 8 + 6] * rs * w1.z, x[j * 8 + 7] * rs * w1.w);
    }
  }
}


#define XB_TMO      128
#define XB_XCNT(j)  (256  + 64 * (j))
#define XB_XSUB(j)  (1280 + 64 * (j))
#define XB_XGEN(j)  (2304 + 64 * (j))
#define XB_TOP      3328
#define XB_TOPGEN   3392
#define XCD_BAR_WORDS 3456
#define XB_SPIN_CAP (1u << 22)
__device__ __forceinline__ unsigned xb_ld(unsigned* p) { return __hip_atomic_load(p, __ATOMIC_RELAXED, __HIP_MEMORY_SCOPE_AGENT); }
__device__ __forceinline__ unsigned xb_add(unsigned* p, unsigned v) { return __hip_atomic_fetch_add(p, v, __ATOMIC_RELAXED, __HIP_MEMORY_SCOPE_AGENT); }
__device__ __forceinline__ unsigned xb_xcc_id() { return (unsigned)__builtin_amdgcn_s_getreg((3 << 11) | 20) & 0xFu; }
#define XB_SPIN(cond, bar) do { unsigned _sp = 0; while (cond) { __builtin_amdgcn_s_sleep(1); \
    if ((++_sp & 255u) == 0u) { if (xb_ld(&(bar)[XB_TMO])) break; if (_sp > XB_SPIN_CAP) { atomicAdd(&(bar)[XB_TMO], 1u); break; } } } } while (0)

__device__ __forceinline__ void xcd_barrier_post(unsigned* bar) {
  if (threadIdx.x == 0) (void)xb_add(&bar[XB_XCNT(xb_xcc_id())], 1u);
}
__device__ __forceinline__ void xcd_barrier_complete(unsigned* bar, unsigned x, unsigned& nloc, unsigned& nx) {
  const unsigned G = gridDim.x;
  unsigned sum, cnt, mine, sp = 0u;
  for (;;) {
    sum = 0u; cnt = 0u; mine = 0u;
#pragma unroll
    for (unsigned j = 0; j < 16; ++j) { const unsigned c = xb_ld(&bar[XB_XCNT(j)]); sum += c; cnt += (c > 0u) ? 1u : 0u; mine = (j == x) ? c : mine; }
    if (sum == G) break;
    __builtin_amdgcn_s_sleep(1);
    if ((++sp & 255u) == 0u) { if (xb_ld(&bar[XB_TMO])) break; if (sp > XB_SPIN_CAP) { atomicAdd(&bar[XB_TMO], 1u); break; } }
  }
  nloc = mine > 0u ? mine : 1u; nx = cnt > 0u ? cnt : 1u;
}
__device__ __forceinline__ void xcd_barrier(unsigned* bar, volatile unsigned* st) {
  asm volatile("s_waitcnt vmcnt(0)" ::: "memory");
  __syncthreads();
  if (threadIdx.x == 0) {
    __builtin_amdgcn_s_waitcnt(0);
    const unsigned x = xb_xcc_id();
    unsigned nloc = st[0], nx = st[1];
    if (nloc == 0u) { xcd_barrier_complete(bar, x, nloc, nx); st[0] = nloc; st[1] = nx; }
    const unsigned old = xb_add(&bar[XB_XSUB(x)], 1u);
    const unsigned gen = old / nloc;
    if (old + 1u == (gen + 1u) * nloc) {
      __builtin_amdgcn_fence(__ATOMIC_RELEASE, "agent");
      asm volatile("s_waitcnt vmcnt(0)" ::: "memory");
      const unsigned og = xb_add(&bar[XB_TOP], 1u);
      const unsigned tg = og / nx;
      if (og + 1u == (tg + 1u) * nx) xb_add(&bar[XB_TOPGEN], 1u);
      else XB_SPIN(xb_ld(&bar[XB_TOPGEN]) == tg, bar);
      __builtin_amdgcn_fence(__ATOMIC_ACQUIRE, "agent");
      xb_add(&bar[XB_XGEN(x)], 1u);
      asm volatile("s_waitcnt vmcnt(0)" ::: "memory");
    } else {
      XB_SPIN(xb_ld(&bar[XB_XGEN(x)]) == gen, bar);
      __builtin_amdgcn_fence(__ATOMIC_ACQUIRE, "agent");
      asm volatile("s_waitcnt vmcnt(0)" ::: "memory");
    }
  }
  __syncthreads();
}

constexpr int SMEM_BYTES = 40960;
__device__ __forceinline__ void run_phase(const Params& p, int ph, char* smem) {
  if (ph == 0) { phase_embed(p); return; }
  if (ph == 19) { phase_final(p); return; }
  int l = (ph - 1) / 9, s = (ph - 1) % 9;
  float* fs = (float*)smem;
  switch (s) {
    case 0: phase_convert(p, l, fs); phase_rowstat<true>(p, l, fs); break;
    case 1: phase_gemm<1>(p, p.XB, DM, (p.WB + OFF_W1T), 1024, LDP / 128, smem); break;
    case 2: phase_pre(p, l, fs); break;
    case 3: phase_scan(p, l, fs); break;
    case 4: phase_post(p, l, fs); break;
    case 5: phase_gemm<2>(p, p.PROJ, LDP, (p.WB + OFF_WOT), 1536, 8, smem); break;
    case 6: phase_rowstat<false>(p, l, fs); break;
    case 7: phase_gemm<3>(p, p.XB, DM, (p.WB + OFF_WGU), 1024, 44, smem); break;
    case 8: phase_gemm<2>(p, p.PROJ, D_FF, (p.WB + OFF_WDT), D_FF, 8, smem); break;
  }
}
constexpr int N_PHASES = 20;

#if MEGA
__global__ void __launch_bounds__(256, 3) k_mega(Params p) {
  __shared__ __attribute__((aligned(16))) char smem[SMEM_BYTES];
  __shared__ uint4 xb_words;
  if (threadIdx.x == 0) { xb_words = make_uint4(0u, 0u, 0u, 0u); }
  __syncthreads();
  cg::grid_group grid = cg::this_grid();
  float* fs = (float*)smem;
  volatile unsigned* xst = (volatile unsigned*)&xb_words;
  xcd_barrier_post(p.bar);
  phase_embed(p);
  grid.sync();
#define GSYNC() do { unsigned* b_ = p.bar; asm volatile("" : "+s"(b_)); xcd_barrier(b_, xst); } while (0)
  {
    const int L0_ = 0;
    int l = opaque_s(L0_);
    phase_convert(p, l, fs);
    phase_rowstat<true>(p, l, fs);
    GSYNC();
    l = opaque_s(l);
    phase_gemm<1>(p, p.XB, DM, (p.WB + OFF_W1T), 1024, LDP / 128, smem);
    GSYNC();
    l = opaque_s(l);
    phase_pre(p, l, fs);
    GSYNC();
    l = opaque_s(l);
    phase_scan(p, l, fs);
    GSYNC();
    l = opaque_s(l);
    phase_post(p, l, fs);
    GSYNC();
    l = opaque_s(l);
    phase_gemm<2>(p, p.PROJ, LDP, (p.WB + OFF_WOT), 1536, 8, smem);
    GSYNC();
    l = opaque_s(l);
    phase_rowstat<false>(p, l, fs);
    GSYNC();
    l = opaque_s(l);
    phase_gemm<3>(p, p.XB, DM, (p.WB + OFF_WGU), 1024, 44, smem);
    GSYNC();
    l = opaque_s(l);
    phase_gemm<2>(p, p.PROJ, D_FF, (p.WB + OFF_WDT), D_FF, 8, smem);
    GSYNC();
  }
  {
    const int L0_ = 1;
    int l = opaque_s(L0_);
    phase_convert(p, l, fs);
    phase_rowstat<true>(p, l, fs);
    GSYNC();
    l = opaque_s(l);
    phase_gemm<1>(p, p.XB, DM, (p.WB + OFF_W1T), 1024, LDP / 128, smem);
    GSYNC();
    l = opaque_s(l);
    phase_pre(p, l, fs);
    GSYNC();
    l = opaque_s(l);
    phase_scan(p, l, fs);
    GSYNC();
    l = opaque_s(l);
    phase_post(p, l, fs);
    GSYNC();
    l = opaque_s(l);
    phase_gemm<2>(p, p.PROJ, LDP, (p.WB + OFF_WOT), 1536, 8, smem);
    GSYNC();
    l = opaque_s(l);
    phase_rowstat<false>(p, l, fs);
    GSYNC();
    l = opaque_s(l);
    phase_gemm<3>(p, p.XB, DM, (p.WB + OFF_WGU), 1024, 44, smem);
    GSYNC();
    l = opaque_s(l);
    phase_gemm<2>(p, p.PROJ, D_FF, (p.WB + OFF_WDT), D_FF, 8, smem);
    GSYNC();
  }
  phase_final(p);
}
#else
template <int PH>
__global__ void __launch_bounds__(256, 3) k_phase(Params p) {
  __shared__ __attribute__((aligned(16))) char smem[SMEM_BYTES];
  run_phase(p, PH, smem);
}
template <int PH>
static void launch_all(const Params& p, int grid, hipStream_t stream) {
  hipLaunchKernelGGL(k_phase<PH>, dim3(grid), dim3(256), 0, stream, p);
  if constexpr (PH + 1 < N_PHASES) launch_all<PH + 1>(p, grid, stream);
}
#endif

extern "C" void kernel_launch(void* const* d_in, const int* in_sizes, int n_in, void* d_out, int out_size, void* d_ws,
                              size_t ws_size, hipStream_t stream) {
  Params p{};
  const float** pf = (const float**)&p;
  for (int i = 0; i < 35; ++i) pf[i] = (const float*)d_in[i];
  p.out = (float*)d_out;
  char* ws = (char*)d_ws;
  size_t off = 0;
  auto take = [&](size_t bytes) { char* r = ws + off; off += (bytes + 255) & ~(size_t)255; return r; };
  p.XB = (u16*)take((size_t)M_TOT * DM * 2);
  p.PROJ = (u16*)take((size_t)M_TOT * LDP * 2);
  p.WB = (u16*)take((size_t)WB_TOTAL * 2);
  p.BND = (u16*)take((size_t)NBLK16 * 1792 * 2);
  p.BND2 = (u16*)take((size_t)NBLK16 * 3 * 512 * 2);
  p.ORW = (u16*)take((size_t)M_TOT * 512 * 2);
  p.FB = (float*)take((size_t)FB_TOTAL * 4);
  p.bar = (unsigned*)take((size_t)XCD_BAR_WORDS * 4);
  p.RWX = (u16*)d_out;
  if (off > ws_size) fprintf(stderr, "workspace too small: need %zu have %zu\n", off, ws_size);
#if MEGA
  static int grid_blocks = 0;
  if (!grid_blocks) {
    int dev = 0, cus = 0, per_cu = 0;
    hipGetDevice(&dev);
    hipDeviceGetAttribute(&cus, hipDeviceAttributeMultiprocessorCount, dev);
    hipOccupancyMaxActiveBlocksPerMultiprocessor(&per_cu, k_mega, 256, 0);
    if (per_cu > 3) per_cu = 3;
    grid_blocks = cus * per_cu;
  }
  hipMemsetAsync(p.bar, 0, (size_t)XCD_BAR_WORDS * 4, stream);
  void* args[] = {&p};
  hipError_t e = hipLaunchCooperativeKernel((void*)k_mega, dim3(grid_blocks), dim3(256), args, 0, stream);
  if (e != hipSuccess) fprintf(stderr, "cooperative launch failed: %s (grid %d)\n", hipGetErrorString(e), grid_blocks);
#else
  launch_all<0>(p, 768, stream);
#endif
}
```

```cpp
#include <hip/hip_runtime.h>
#include <hip/hip_bf16.h>
#include <hip/hip_cooperative_groups.h>
#include <cstdio>
namespace cg = cooperative_groups;

#ifndef MEGA
#define MEGA 1
#endif

typedef unsigned short u16;
using bf16x8 = __attribute__((ext_vector_type(8))) short;
using f32x16 = __attribute__((ext_vector_type(16))) float;
using f32x4v = __attribute__((ext_vector_type(4))) float;

constexpr int DM = 1024;
constexpr int M_TOT = 33408;
constexpr int M_PROMPT = 32896;
constexpr int T_P = 4112;
constexpr int LDP = 5376;
constexpr int N_IN = 5384;
constexpr int D_FF = 2816;
constexpr int NBLK16 = M_TOT / 16;
constexpr int C_Z = 0, C_R = 512, C_GG = 1024, C_XBC = 1536, C_K = 2560, C_V = 3072, C_XW = 3584, C_XA = 3648,
              C_XG = 3712, C_Q = 3840, C_F = 4352, C_I = 4864;
constexpr long O_YP = 0, O_YS = 33554432, O_PSSM = 34078720, O_PCONV = 35127296, O_PRWKV = 35176448,
               O_PSHIFT = 35700736, O_PHGRN = 35729408, O_SSSM = 36777984, O_SCONV = 37826560,
               O_SRWKV = 37875712, O_SSHIFT = 38400000, O_SHGRN = 38428672;

constexpr long OFF_W1T = 0, OFF_WOT = 5505024, OFF_WGU = 7077888, OFF_WDT = 12845056, OFF_W2T = 15728640, OFF_A2T = 15761408, OFF_G2T = 15794176, WB_TOTAL = 15859712;
constexpr long FOFF_RS = 0, FOFF_DTRAW = 33408, FOFF_RKS = 300672, FB_TOTAL = 567936;
struct Params {
  const float *x_prompt, *x_sample, *state_ssm, *state_conv, *state_rwkv, *state_shift, *state_hgrn, *meta,
      *norm1_w, *w_in, *conv_w, *conv_b, *dt_bias, *a_log, *d_skip, *ssd_norm_w, *rw_mu, *rw_w0, *rw_w2, *rw_a0,
      *rw_a2, *rw_g2, *rw_kk, *rw_ka, *rw_rk, *rw_lnx_w, *rw_lnx_b, *hg_lb, *hg_norm_w, *w_out, *norm2_w, *w_gate,
      *w_up, *w_down, *final_w;
  float* out;
  u16 *XB, *PROJ, *WB, *BND, *BND2, *ORW, *RWX;
  float *FB;
  unsigned* bar;
};

__device__ __forceinline__ u16 f2bf(float f) {
  unsigned u = __float_as_uint(f);
  u += 0x7fffu + ((u >> 16) & 1u);
  return (u16)(u >> 16);
}
__device__ __forceinline__ float bf2f(u16 h) { return __uint_as_float(((unsigned)h) << 16); }
__device__ __forceinline__ float frcp_(float x) { return __builtin_amdgcn_rcpf(x); }
__device__ __forceinline__ float sigmoidf_(float x) { return frcp_(1.f + __expf(-x)); }
__device__ __forceinline__ float siluf_(float x) { return x * frcp_(1.f + __expf(-x)); }
__device__ __forceinline__ float softplusf_(float x) { return x > 20.f ? x : log1pf(__expf(x)); }

template <int CTRL>
__device__ __forceinline__ float dppf(float v) {
  return __int_as_float(__builtin_amdgcn_update_dpp(0, __float_as_int(v), CTRL, 0xF, 0xF, true));
}
__device__ __forceinline__ float sum16(float v) {
  v += dppf<0xB1>(v);
  v += dppf<0x4E>(v);
  v += dppf<0x141>(v);
  v += dppf<0x140>(v);
  return v;
}
__device__ __forceinline__ void sum16x2(float& a, float& b) {
  a += dppf<0xB1>(a); b += dppf<0xB1>(b);
  a += dppf<0x4E>(a); b += dppf<0x4E>(b);
  a += dppf<0x141>(a); b += dppf<0x141>(b);
  a += dppf<0x140>(a); b += dppf<0x140>(b);
}

__device__ __forceinline__ float sum8(float v) {
  v += dppf<0xB1>(v);
  v += dppf<0x4E>(v);
  v += dppf<0x141>(v);
  return v;
}
__device__ __forceinline__ void unpack8(const uint4& r, float* f) {
  f[0] = __uint_as_float(r.x << 16); f[1] = __uint_as_float(r.x & 0xffff0000u);
  f[2] = __uint_as_float(r.y << 16); f[3] = __uint_as_float(r.y & 0xffff0000u);
  f[4] = __uint_as_float(r.z << 16); f[5] = __uint_as_float(r.z & 0xffff0000u);
  f[6] = __uint_as_float(r.w << 16); f[7] = __uint_as_float(r.w & 0xffff0000u);
}
__device__ __forceinline__ uint4 pack8(const float* f) {
  uint4 r;
  r.x = f2bf(f[0]) | ((unsigned)f2bf(f[1]) << 16);
  r.y = f2bf(f[2]) | ((unsigned)f2bf(f[3]) << 16);
  r.z = f2bf(f[4]) | ((unsigned)f2bf(f[5]) << 16);
  r.w = f2bf(f[6]) | ((unsigned)f2bf(f[7]) << 16);
  return r;
}
__device__ __forceinline__ void ld8(const float* p, float* f) {
  float4 a = *(const float4*)p, b = *(const float4*)(p + 4);
  f[0] = a.x; f[1] = a.y; f[2] = a.z; f[3] = a.w; f[4] = b.x; f[5] = b.y; f[6] = b.z; f[7] = b.w;
}

struct F8 { float v[8]; };
__device__ __forceinline__ F8 up8(const uint4& r) { F8 f; unpack8(r, f.v); return f; }
__device__ __forceinline__ F8 ldf8(const float* p) { F8 f; ld8(p, f.v); return f; }
__device__ __forceinline__ F8 zero8() { F8 f; for (int e = 0; e < 8; ++e) f.v[e] = 0.f; return f; }
__device__ __forceinline__ float sum64(float v) {
  v = sum16(v);
  v += __shfl_xor(v, 16);
  v += __shfl_xor(v, 32);
  return v;
}

#define NOPK(x) asm("" : "+v"(x))
__device__ __forceinline__ int opaque_tid() {
  int t = threadIdx.x;
  asm volatile("" : "+v"(t));
  return t;
}
__device__ __forceinline__ int opaque_s(int v) {
  asm volatile("" : "+s"(v));
  return v;
}
#define BID opaque_s((int)blockIdx.x)
#define NBLK opaque_s((int)gridDim.x)
__device__ __forceinline__ int seq_base(int s) { return s < 8 ? s * T_P : M_PROMPT + (s - 8) * 64; }
__device__ __forceinline__ int seq_len(int s) { return s < 8 ? T_P : 64; }

__device__ __forceinline__ void phase_embed(const Params& p) {
  const long n4 = (long)M_TOT * 256;
  for (long idx = (long)BID * 256 + threadIdx.x, st_ = (long)NBLK * 256; idx < n4; idx += st_) {
    int m = (int)(idx >> 8), c4 = ((int)idx & 255) * 4;
    const float* src;
    if (m < M_PROMPT) {
      int b = m / T_P, t = m - b * T_P;
      src = (t < 16) ? p.meta + (long)t * DM : p.x_prompt + ((long)b * 4096 + (t - 16)) * DM;
    } else {
      src = p.x_sample + (long)(m - M_PROMPT) * DM;
    }
    float4 v = *(const float4*)(src + c4);
    ushort4 o;
    o.x = f2bf(v.x); o.y = f2bf(v.y); o.z = f2bf(v.z); o.w = f2bf(v.w);
    *(ushort4*)(p.XB + (long)m * DM + c4) = o;
  }
}

template <bool HAS_SCALE>
__device__ __forceinline__ void conv_tile(const float* __restrict__ src, int ldsrc, int srccol0, const float* __restrict__ scale,
                          u16* __restrict__ dst, int K, int k0, int n0, float* tile  ) {
  const int tid = opaque_tid();
  __syncthreads();
  {
    int nn = tid & 63, kb = tid >> 6;
#pragma unroll
    for (int i = 0; i < 16; ++i) {
      int kk = kb + 4 * i;
      float v = src[(long)(k0 + kk) * ldsrc + srccol0 + nn];
      if (HAS_SCALE) v *= scale[k0 + kk];
      tile[kk * 65 + nn] = v;
    }
  }
  __syncthreads();
  {
    int nn = tid >> 2, kq = (tid & 3) * 16;
    u16* d = dst + (long)(n0 + nn) * K + k0 + kq;
#pragma unroll
    for (int j = 0; j < 16; j += 2) {
      unsigned w = f2bf(tile[(kq + j) * 65 + nn]) | ((unsigned)f2bf(tile[(kq + j + 1) * 65 + nn]) << 16);
      *(unsigned*)(d + j) = w;
    }
  }
}

__device__ __forceinline__ int w1_srccol(int n0) {
  if (n0 < 512) return n0;
  if (n0 < 1024) return n0 - 512 + 1544;
  if (n0 < 1536) return n0 - 1024 + 4872;
  if (n0 < 2560) return n0 - 1536 + 512;
  if (n0 < 3840) return n0 - 2560 + 2056;
  return n0 - 3840 + 3336;
}

constexpr int CV_W1 = 16 * 84, CV_WO = 24 * 16, CV_WGU = 16 * 88, CV_WD = 44 * 16;
constexpr int CV_LORA = 32;
constexpr int CV_TOTAL = CV_W1 + CV_WO + CV_WGU + CV_WD + CV_LORA;

__device__ __forceinline__ void phase_convert(const Params& p, int l, float* smem) {
  for (int u = BID, nb_ = NBLK; u < CV_TOTAL; u += nb_) {
    if (u < CV_W1) {
      int kt = u % 16, nt = u / 16;
      conv_tile<true>(p.w_in + (long)l * DM * N_IN, N_IN, w1_srccol(nt * 64), p.norm1_w + l * DM, (p.WB + OFF_W1T), 1024, kt * 64,
                nt * 64, smem);
    } else if (u < CV_W1 + CV_WO) {
      int v = u - CV_W1;
      int kt = v % 24, nt = v / 24;
      conv_tile<false>(p.w_out + (long)l * 1536 * DM, DM, nt * 64, nullptr, (p.WB + OFF_WOT), 1536, kt * 64, nt * 64, smem);
    } else if (u < CV_W1 + CV_WO + CV_WGU) {
      int v = u - CV_W1 - CV_WO;
      int kt = v % 16, nt = v / 16;
      const float* wg = p.w_gate + (long)l * DM * D_FF;
      const float* wu = p.w_up + (long)l * DM * D_FF;
      const float* sc = p.norm2_w + l * DM;
      const int tid = opaque_tid();
      __syncthreads();
      {
        int nn = tid & 63, kb = tid >> 6;
        const float* src = (nn < 32) ? wg : wu;
        int col = nt * 32 + (nn & 31);
#pragma unroll
        for (int i = 0; i < 16; ++i) {
          int kk = kb + 4 * i;
          smem[kk * 65 + nn] = src[(long)(kt * 64 + kk) * D_FF + col] * sc[kt * 64 + kk];
        }
      }
      __syncthreads();
      {
        int nn = tid >> 2, kq = (tid & 3) * 16;
        u16* d = (p.WB + OFF_WGU) + (long)(nt * 64 + nn) * 1024 + kt * 64 + kq;
#pragma unroll
        for (int j = 0; j < 16; j += 2) {
          unsigned w = f2bf(smem[(kq + j) * 65 + nn]) | ((unsigned)f2bf(smem[(kq + j + 1) * 65 + nn]) << 16);
          *(unsigned*)(d + j) = w;
        }
      }
    } else if (u >= CV_W1 + CV_WO + CV_WGU + CV_WD) {
      int v = u - (CV_W1 + CV_WO + CV_WGU + CV_WD);
      const int tid = opaque_tid();
#pragma unroll 4
      for (int i = 0; i < 16; ++i) {
        int e = v * 4096 + i * 256 + tid;
        if (e < 32768) {
          int n = e >> 6, k = e & 63;
          (p.WB + OFF_W2T)[e] = f2bf(p.rw_w2[(long)l * 64 * 512 + k * 512 + n]);
        } else if (e < 65536) {
          int e2 = e - 32768, n = e2 >> 6, k = e2 & 63;
          (p.WB + OFF_A2T)[e2] = f2bf(p.rw_a2[(long)l * 64 * 512 + k * 512 + n]);
        } else {
          int e2 = e - 65536, n = e2 >> 7, k = e2 & 127;
          (p.WB + OFF_G2T)[e2] = f2bf(p.rw_g2[(long)l * 128 * 512 + k * 512 + n]);
        }
      }
    } else {
      int v = u - CV_W1 - CV_WO - CV_WGU;
      int kt = v % 44, nt = v / 44;
      conv_tile<false>(p.w_down + (long)l * D_FF * DM, DM, nt * 64, nullptr, (p.WB + OFF_WDT), D_FF, kt * 64, nt * 64, smem);
    }
  }
}

template <bool WITH_DT>
__device__ __forceinline__ void phase_rowstat(const Params& p, int l, float* smem) {
  const int tid = opaque_tid(), lane = tid & 63, wid = tid >> 6;
  float* dtw = smem;
  if (WITH_DT) {
    __syncthreads();
    const float* w = p.w_in + (long)l * DM * N_IN + 1536;
    const float* nw = p.norm1_w + l * DM;
    for (int i = tid; i < 8192; i += 256) {
      int k = i >> 3, h = i & 7;
      dtw[i] = w[(long)k * N_IN + h] * nw[k];
    }
    __syncthreads();
  }
  for (int blk = BID, nb_ = NBLK; blk < NBLK16; blk += nb_) {
    for (int rr = wid; rr < 16; rr += 4) {
      int m = blk * 16 + rr;
      float ss = 0.f;
      float d[8];
#pragma unroll
      for (int h = 0; h < 8; ++h) d[h] = 0.f;
#pragma unroll 1
      for (int j = 0; j < 4; ++j) {
        int k0 = lane * 4 + 256 * j;
        uint2 raw = *(const uint2*)(p.XB + (long)m * DM + k0);
        float xs[4] = {bf2f((u16)(raw.x & 0xffff)), bf2f((u16)(raw.x >> 16)), bf2f((u16)(raw.y & 0xffff)),
                       bf2f((u16)(raw.y >> 16))};
#pragma unroll
        for (int e = 0; e < 4; ++e) {
          float x = xs[e];
          ss += x * x;
          if (WITH_DT) {
            float4 w0 = *(const float4*)(dtw + (k0 + e) * 8);
            float4 w1 = *(const float4*)(dtw + (k0 + e) * 8 + 4);
            d[0] += x * w0.x; d[1] += x * w0.y; d[2] += x * w0.z; d[3] += x * w0.w;
            d[4] += x * w1.x; d[5] += x * w1.y; d[6] += x * w1.z; d[7] += x * w1.w;
          }
        }
      }
      ss = sum64(ss);
      float rs = rsqrtf(ss * (1.f / 1024.f) + 1e-6f);
      if (WITH_DT) {
#pragma unroll
        for (int h = 0; h < 8; ++h) d[h] = sum64(d[h]);
        if (lane == 0) {
#pragma unroll
          for (int h = 0; h < 8; ++h) (p.FB + FOFF_DTRAW)[(long)m * 8 + h] = d[h] * rs;
        }
      }
      if (lane == 0) (p.FB + FOFF_RS)[m] = rs;
    }
  }
}

constexpr int G_BK = 32, G_LDS_ROW = 80;
constexpr int G_OPER_BYTES = 128 * G_LDS_ROW;
template <int MODE>
__device__ __forceinline__ void phase_gemm(const Params& p, const u16* __restrict__ A, int lda, const u16* __restrict__ Bt, int K,
                           int nN, char* smem) {
  const int tid = opaque_tid(), lane = tid & 63, wid = tid >> 6, wm = wid >> 1, wn = wid & 1;
  const int nM = M_TOT / 128;
  const int ntiles = nM * nN;
  const int nk = K / G_BK;
  const int lrow = tid >> 2, lkc = tid & 3;
  for (int tile = BID, nb_ = NBLK; tile < ntiles; tile += nb_) {
    constexpr int GM = 32;
    int grp = tile / (GM * nN);
    int first_m = grp * GM;
    int gsz = min(GM, nM - first_m);
    int rem = tile - grp * GM * nN;
    int pm = first_m + rem % gsz, pn = rem / gsz;
    const u16* gA = A + (long)(pm * 128 + lrow) * lda + lkc * 8;
    const u16* gB = Bt + (long)(pn * 128 + lrow) * K + lkc * 8;
    f32x16 acc[2][2];
#pragma unroll
    for (int i = 0; i < 2; ++i)
#pragma unroll
      for (int j = 0; j < 2; ++j)
#pragma unroll
        for (int r = 0; r < 16; ++r) acc[i][j][r] = 0.f;
    uint4 xa0, xa1, xb0, xb1, ya0, ya1, yb0, yb1, za0, za1, zb0, zb1;
#define G_LOAD(S, KT)                                                  \
  {                                                                    \
    S##a0 = *(const uint4*)(gA + (KT) * G_BK);                         \
    S##a1 = *(const uint4*)(gA + (long)64 * lda + (KT) * G_BK);        \
    S##b0 = *(const uint4*)(gB + (KT) * G_BK);                         \
    S##b1 = *(const uint4*)(gB + (long)64 * K + (KT) * G_BK);          \
  }
#define G_STORE(S, BUF)                                                \
  {                                                                    \
    char* dA = smem + (BUF) * 2 * G_OPER_BYTES;                        \
    char* dB = dA + G_OPER_BYTES;                                      \
    *(uint4*)(dA + lrow * G_LDS_ROW + lkc * 16) = S##a0;               \
    *(uint4*)(dA + (lrow + 64) * G_LDS_ROW + lkc * 16) = S##a1;        \
    *(uint4*)(dB + lrow * G_LDS_ROW + lkc * 16) = S##b0;               \
    *(uint4*)(dB + (lrow + 64) * G_LDS_ROW + lkc * 16) = S##b1;        \
  }
#define G_COMPUTE(BUF)                                                                           \
  {                                                                                              \
    const char* sA = smem + (BUF) * 2 * G_OPER_BYTES;                                            \
    const char* sB = sA + G_OPER_BYTES;                                                          \
    _Pragma("unroll") for (int ks = 0; ks < 2; ++ks) {                                           \
      bf16x8 af[2], bfr[2];                                                                      \
      const int koff = (ks * 16 + (lane >> 5) * 8) * 2;                                          \
      _Pragma("unroll") for (int i = 0; i < 2; ++i)                                              \
        af[i] = *(const bf16x8*)(sA + (wm * 64 + i * 32 + (lane & 31)) * G_LDS_ROW + koff);      \
      _Pragma("unroll") for (int j = 0; j < 2; ++j)                                              \
        bfr[j] = *(const bf16x8*)(sB + (wn * 64 + j * 32 + (lane & 31)) * G_LDS_ROW + koff);     \
      __builtin_amdgcn_s_setprio(1);                                                             \
      _Pragma("unroll") for (int i = 0; i < 2; ++i)                                              \
        _Pragma("unroll") for (int j = 0; j < 2; ++j)                                            \
          acc[i][j] = __builtin_amdgcn_mfma_f32_32x32x16_bf16(af[i], bfr[j], acc[i][j], 0, 0, 0); \
      __builtin_amdgcn_s_setprio(0);                                                             \
    }                                                                                            \
  }
    G_LOAD(x, 0);
    G_LOAD(y, 1);
    G_LOAD(z, 2);
    __builtin_amdgcn_sched_barrier(0);
    __syncthreads();
    G_STORE(x, 0);
    __syncthreads();
#define G_STEP(T, SNEXT, SFREE, BUF)                          \
    if ((T) < nk) {                                           \
      if ((T) + 1 < nk) G_STORE(SNEXT, (BUF) ^ 1);            \
      if ((T) + 3 < nk) G_LOAD(SFREE, (T) + 3);               \
      __builtin_amdgcn_sched_barrier(0);                      \
      G_COMPUTE(BUF);                                         \
      __builtin_amdgcn_sched_barrier(0);                      \
      __syncthreads();                                        \
    }
    for (int kt = 0; kt < nk; kt += 6) {
      G_STEP(kt + 0, y, x, 0);
      G_STEP(kt + 1, z, y, 1);
      G_STEP(kt + 2, x, z, 0);
      G_STEP(kt + 3, y, x, 1);
      G_STEP(kt + 4, z, y, 0);
      G_STEP(kt + 5, x, z, 1);
    }
#undef G_STEP
#undef G_LOAD
#undef G_STORE
#undef G_COMPUTE
    const int colb = pn * 128 + wn * 64 + (lane & 31);
    const int rowb = pm * 128 + wm * 64 + 4 * (lane >> 5);
    if (MODE == 1) {
#pragma unroll
      for (int i = 0; i < 2; ++i)
#pragma unroll
        for (int r = 0; r < 16; ++r) {
          int row = rowb + i * 32 + (r & 3) + 8 * (r >> 2);
          float rs = (p.FB + FOFF_RS)[row];
#pragma unroll
          for (int j = 0; j < 2; ++j) {
            int col = colb + j * 32;
            u16 v = f2bf(acc[i][j][r] * rs);
            p.PROJ[(long)row * LDP + col] = v;
            if ((row & 15) == 15) {
              int jj = -1;
              if (col >= C_R && col < C_GG) jj = col - C_R;
              else if (col >= C_K && col < C_Q) jj = col - C_K + 512;
              if (jj >= 0) p.BND[(long)(row >> 4) * 1792 + jj] = v;
            }
            if ((row & 15) >= 13 && col >= C_XBC + 512 && col < C_XBC + 1024)
              p.BND2[((long)(row >> 4) * 3 + ((row & 15) - 13)) * 512 + (col - (C_XBC + 512))] = v;
          }
        }
    } else if (MODE == 2) {
#pragma unroll
      for (int i = 0; i < 2; ++i)
#pragma unroll
        for (int r = 0; r < 16; ++r) {
          int row = rowb + i * 32 + (r & 3) + 8 * (r >> 2);
#pragma unroll
          for (int j = 0; j < 2; ++j) {
            int col = colb + j * 32;
            u16* px = p.XB + (long)row * DM + col;
            *px = f2bf(bf2f(*px) + acc[i][j][r]);
          }
        }
    } else {
      const int cact = pn * 64 + wn * 32 + (lane & 31);
      u16* ACT = p.PROJ;
#pragma unroll
      for (int i = 0; i < 2; ++i)
#pragma unroll
        for (int r = 0; r < 16; ++r) {
          int row = rowb + i * 32 + (r & 3) + 8 * (r >> 2);
          float rs = (p.FB + FOFF_RS)[row];
          float g = acc[i][0][r] * rs, u = acc[i][1][r] * rs;
          ACT[(long)row * D_FF + cact] = f2bf(siluf_(g) * u);
        }
    }
  }
}

__device__ __forceinline__ void phase_pre(const Params& p, int l, float* smem) {
  u16* XWb = (u16*)smem;
  u16* XAb = (u16*)smem + 16 * 72;
  constexpr int LDW = 260;
  float* AW = smem + 1152;
  float* AA = smem + 1152 + 16 * LDW;
  const float* mu = p.rw_mu + l * 1792;
  for (int blk = BID, nb_ = NBLK; blk < NBLK16; blk += nb_) {
    const int tid = opaque_tid(), lane = tid & 63, wid = tid >> 6;
    const int T = tid >> 4, Q = tid & 15;
    const int m0 = blk * 16;
    const long m = m0 + T;
    int s, t0;
    if (m0 < M_PROMPT) { s = m0 / T_P; t0 = m0 - s * T_P; } else { s = 8 + (m0 - M_PROMPT) / 64; t0 = (m0 - M_PROMPT) & 63; }
    const bool first = (t0 == 0);
    u16* row = p.PROJ + m * LDP;
    const u16* bndrow = p.BND + (long)(blk > 0 ? blk - 1 : 0) * 1792;
    const float* shrow = p.state_shift + ((long)l * 8 + (s >= 8 ? s - 8 : 0)) * 1792;
    const bool seqstart = first && (T == 0);
#define SHIFT8(DST, J, COL)                                                                 \
    {                                                                                       \
      float cur_[8], pv_[8], mj_[8];                                                        \
      unpack8(*(const uint4*)(row + (COL)), cur_);                                          \
      const u16* ps_ = (T > 0) ? (row - LDP + (COL)) : (bndrow + (J));                      \
      unpack8(*(const uint4*)ps_, pv_);                                                     \
      if (seqstart) {                                                                       \
        if (s >= 8) ld8(shrow + (J), pv_);                                                  \
        else { _Pragma("unroll") for (int e = 0; e < 8; ++e) pv_[e] = 0.f; }                \
      }                                                                                     \
      ld8(mu + (J), mj_);                                                                   \
      _Pragma("unroll") for (int e = 0; e < 8; ++e) DST[e] = cur_[e] + (pv_[e] - cur_[e]) * mj_[e]; \
    }
    __syncthreads();
    {
      float sh0[8], sh1[8];
      SHIFT8(sh0, 1536 + Q * 8, C_XW + Q * 8);
      SHIFT8(sh1, 1664 + Q * 8, C_XG + Q * 8);
      __syncthreads();
      if (Q < 8) {
#pragma unroll
        for (int e = 0; e < 8; ++e) sh0[e] = tanhf(sh0[e]);
        *(uint4*)(XWb + T * 72 + Q * 8) = pack8(sh0);
      } else {
        *(uint4*)(XAb + T * 72 + (Q - 8) * 8) = pack8(sh0);
      }
#pragma unroll
      for (int e = 0; e < 8; ++e) sh1[e] = sigmoidf_(sh1[e]);
      *(uint4*)(row + C_XG + Q * 8) = pack8(sh1);
    }
    __syncthreads();
#pragma unroll 1
    for (int c = 0; c < 2; ++c) {
      {
        bf16x8 axw[2], axa[2];
#pragma unroll
        for (int ks = 0; ks < 2; ++ks) {
          axw[ks] = *(const bf16x8*)(XWb + (lane & 15) * 72 + ks * 32 + (lane >> 4) * 8);
          axa[ks] = *(const bf16x8*)(XAb + (lane & 15) * 72 + ks * 32 + (lane >> 4) * 8);
        }
#pragma unroll
        for (int nt = 0; nt < 4; ++nt) {
          const int ncol = (wid * 4 + nt) * 16 + (lane & 15);
          const int n = c * 256 + ncol;
          f32x4v accw = {0.f, 0.f, 0.f, 0.f}, acca = {0.f, 0.f, 0.f, 0.f};
#pragma unroll
          for (int ks = 0; ks < 2; ++ks) {
            bf16x8 bw = *(const bf16x8*)((p.WB + OFF_W2T) + n * 64 + ks * 32 + (lane >> 4) * 8);
            bf16x8 ba = *(const bf16x8*)((p.WB + OFF_A2T) + n * 64 + ks * 32 + (lane >> 4) * 8);
            accw = __builtin_amdgcn_mfma_f32_16x16x32_bf16(axw[ks], bw, accw, 0, 0, 0);
            acca = __builtin_amdgcn_mfma_f32_16x16x32_bf16(axa[ks], ba, acca, 0, 0, 0);
          }
#pragma unroll
          for (int r = 0; r < 4; ++r) {
            AW[((lane >> 4) * 4 + r) * LDW + ncol] = accw[r];
            AA[((lane >> 4) * 4 + r) * LDW + ncol] = acca[r];
          }
        }
      }
#pragma unroll 1
      for (int jj = 0; jj < 2; ++jj) {
        const int ch0 = c * 256 + jj * 128 + Q * 8;
        const int head = c * 4 + jj * 2 + (Q >> 3);
        float rt[8], kt[8];
        uint4 vpk;
        SHIFT8(rt, ch0, C_R + ch0);
        SHIFT8(kt, 512 + ch0, C_K + ch0);
        {
          float vt[8];
          SHIFT8(vt, 1024 + ch0, C_V + ch0);
          vpk = pack8(vt);
        }
        __syncthreads();
        float aw[8], aa[8], w0[8], a0[8];
        ld8(AW + T * LDW + jj * 128 + Q * 8, aw);
        ld8(AA + T * LDW + jj * 128 + Q * 8, aa);
        ld8(p.rw_w0 + l * 512 + ch0, w0);
        ld8(p.rw_a0 + l * 512 + ch0, a0);
        {
          float uu[8];
#pragma unroll
          for (int e = 0; e < 8; ++e) {
            float lw = -softplusf_(-(w0[e] + aw[e])) - 0.5f;
            uu[e] = -__expf(lw);
            aa[e] = sigmoidf_(a0[e] + aa[e]);
          }
          *(uint4*)(p.RWX + m * 1536 + ch0) = pack8(uu);
        }
        *(uint4*)(row + C_R + ch0) = pack8(rt);
        *(uint4*)(row + C_V + ch0) = vpk;
        float kkw[8], kaw[8], rkw[8], kk[8], kp[8];
        ld8(p.rw_kk + l * 512 + ch0, kkw);
        ld8(p.rw_ka + l * 512 + ch0, kaw);
        ld8(p.rw_rk + l * 512 + ch0, rkw);
        float ssq = 0.f, rks = 0.f;
#pragma unroll
        for (int e = 0; e < 8; ++e) {
          kk[e] = kt[e] * kkw[e];
          ssq += kk[e] * kk[e];
          kp[e] = kt[e] * (1.f + (aa[e] - 1.f) * kaw[e]);
          rks += rt[e] * kp[e] * rkw[e];
        }
        ssq = sum8(ssq);
        rks = sum8(rks);
        const float rn = rsqrtf(ssq + 1e-12f);
        *(uint4*)(row + C_K + ch0) = pack8(kp);
#pragma unroll
        for (int e = 0; e < 8; ++e) kk[e] *= rn;
        *(uint4*)(p.RWX + m * 1536 + 512 + ch0) = pack8(kk);
#pragma unroll
        for (int e = 0; e < 8; ++e) kk[e] *= aa[e];
        *(uint4*)(p.RWX + m * 1536 + 1024 + ch0) = pack8(kk);
        if ((Q & 7) == 0) (p.FB + FOFF_RKS)[m * 8 + head] = rks;
      }
      __syncthreads();
    }
    {
      u16* CB = (u16*)(smem + 1152);
      const u16* b2row = p.BND2 + (long)(blk > 0 ? blk - 1 : 0) * 1536;
      const float* scrow = p.state_conv + ((long)l * 8 + (s >= 8 ? s - 8 : 0)) * 3072 + 512;
#pragma unroll 1
      for (int j = 0; j < 4; ++j) {
        const int cc0 = j * 128 + Q * 8;
        const float* cw = p.conv_w + (long)l * 4096 + 512 + cc0;
        float acc[8];
        ld8(p.conv_b + l * 1024 + 512 + cc0, acc);
#pragma unroll
        for (int d = 0; d < 4; ++d) {
          const int tr = T - 3 + d;
          const int trn = tr < 0 ? 3 + tr : 0;
          float u[8], w[8];
          const u16* src = (tr >= 0) ? (row + (long)(d - 3) * LDP + C_XBC + 512 + cc0) : (b2row + trn * 512 + cc0);
          unpack8(*(const uint4*)src, u);
          if (first && tr < 0) {
            if (s >= 8) ld8(scrow + trn * 1024 + cc0, u);
            else {
#pragma unroll
              for (int e = 0; e < 8; ++e) u[e] = 0.f;
            }
          }
          ld8(cw + d * 1024, w);
#pragma unroll
          for (int e = 0; e < 8; ++e) acc[e] += w[e] * u[e];
        }
#pragma unroll
        for (int e = 0; e < 8; ++e) acc[e] = siluf_(acc[e]);
        *(uint4*)(CB + T * 512 + cc0) = pack8(acc);
      }
      __syncthreads();
#pragma unroll
      for (int j = 0; j < 4; ++j)
        *(uint4*)(row + C_XBC + 512 + j * 128 + Q * 8) = *(const uint4*)(CB + T * 512 + j * 128 + Q * 8);
    }
#undef SHIFT8
    if (t0 + 16 == seq_len(s)) {
      float* o = p.out + (s < 8 ? O_PSHIFT + ((long)l * 8 + s) * 1792 : O_SSHIFT + ((long)l * 8 + (s - 8)) * 1792);
      for (int j = tid; j < 1792; j += 256) o[j] = bf2f(p.BND[(long)blk * 1792 + j]);
    }
  }
}

__device__ __forceinline__ void scan_rwkv(const Params& p, int l, int s, int h, int q, float* smem) {
  const int tid = opaque_tid(), lane = tid & 63, wid = tid >> 6;
  float* R_ = smem;
  float* W_ = smem + 1024;
  float* K_ = smem + 2048;
  float* A_ = smem + 3072;
  float* B_ = smem + 4096;
  float* V_ = smem + 5120;
  float* O_ = smem + 5376;
  const int rl = wid * 4 + (lane >> 4);
  const int row = q * 16 + rl;
  const int ksl = (lane & 15) * 4;
  const int base = seq_base(s), T = seq_len(s);
  float s0 = 0.f, s1 = 0.f, s2 = 0.f, s3 = 0.f;
  if (s >= 8) {
    const float* st = p.state_rwkv + (((long)l * 8 + (s - 8)) * 8 + h) * 4096 + row * 64 + ksl;
    float4 v = *(const float4*)st;
    s0 = v.x; s1 = v.y; s2 = v.z; s3 = v.w;
  }
  const int stt = tid >> 4, skq = (tid & 15) * 4;
  const int nblk = T / 16;
  ushort4 r4, k4, u4, a4, b4;
  u16 vv;
  {
    const long m = base + stt;
    const u16* pr = p.PROJ + m * LDP;
    const u16* px = p.RWX + m * 1536;
    r4 = *(const ushort4*)(pr + C_R + h * 64 + skq);
    k4 = *(const ushort4*)(pr + C_K + h * 64 + skq);
    u4 = *(const ushort4*)(px + h * 64 + skq);
    a4 = *(const ushort4*)(px + 512 + h * 64 + skq);
    b4 = *(const ushort4*)(px + 1024 + h * 64 + skq);
    vv = pr[C_V + h * 64 + q * 16 + (tid & 15)];
  }
  __syncthreads();
  float* TR_ = smem + 5376 + 512;
  const bool wr = (lane & 15) == 0;
  const int ooff = wr ? rl : (512 + lane);
  const int ostr = wr ? 16 : 0;
  for (int blk = 0; blk < nblk; ++blk) {
    const long m = base + blk * 16 + stt;
    float* Oc = O_ + (blk & 1) * 256;
    {
      *(float4*)(R_ + stt * 64 + skq) = make_float4(bf2f(r4.x), bf2f(r4.y), bf2f(r4.z), bf2f(r4.w));
      *(float4*)(K_ + stt * 64 + skq) = make_float4(bf2f(k4.x), bf2f(k4.y), bf2f(k4.z), bf2f(k4.w));
      *(float4*)(W_ + stt * 64 + skq) =
          make_float4(__expf(bf2f(u4.x)), __expf(bf2f(u4.y)), __expf(bf2f(u4.z)), __expf(bf2f(u4.w)));
      *(float4*)(A_ + stt * 64 + skq) = make_float4(-bf2f(a4.x), -bf2f(a4.y), -bf2f(a4.z), -bf2f(a4.w));
      *(float4*)(B_ + stt * 64 + skq) = make_float4(bf2f(b4.x), bf2f(b4.y), bf2f(b4.z), bf2f(b4.w));
      V_[stt * 16 + (tid & 15)] = bf2f(vv);
    }
    __syncthreads();
    if (blk > 0)
      p.ORW[(m - 16) * 512 + h * 64 + q * 16 + (tid & 15)] = f2bf(O_[((blk - 1) & 1) * 256 + stt * 16 + (tid & 15)]);
    if (blk + 1 < nblk) {
      const u16* pr = p.PROJ + (m + 16) * LDP;
      const u16* px = p.RWX + (m + 16) * 1536;
      r4 = *(const ushort4*)(pr + C_R + h * 64 + skq);
      k4 = *(const ushort4*)(pr + C_K + h * 64 + skq);
      u4 = *(const ushort4*)(px + h * 64 + skq);
      a4 = *(const ushort4*)(px + 512 + h * 64 + skq);
      b4 = *(const ushort4*)(px + 1024 + h * 64 + skq);
      vv = pr[C_V + h * 64 + q * 16 + (tid & 15)];
    }
    __builtin_amdgcn_sched_barrier(0);
    {
      float4 a = *(const float4*)(A_ + ksl), w = *(const float4*)(W_ + ksl), b = *(const float4*)(B_ + ksl);
      float4 k = *(const float4*)(K_ + ksl), r = *(const float4*)(R_ + ksl);
      float v = V_[rl];
      float opart = 0.f;
#pragma unroll
      for (int tt = 0; tt < 16; ++tt) {
        float4 an, wn, bn, kn, rn;
        float vn;
        if (tt + 1 < 16) {
          an = *(const float4*)(A_ + (tt + 1) * 64 + ksl); wn = *(const float4*)(W_ + (tt + 1) * 64 + ksl);
          bn = *(const float4*)(B_ + (tt + 1) * 64 + ksl); kn = *(const float4*)(K_ + (tt + 1) * 64 + ksl);
          rn = *(const float4*)(R_ + (tt + 1) * 64 + ksl); vn = V_[(tt + 1) * 16 + rl];
        }
        __builtin_amdgcn_sched_barrier(0);
        float sa = fmaf(s0, a.x, fmaf(s1, a.y, fmaf(s2, a.z, s3 * a.w)));
        if (tt > 0) { sum16x2(sa, opart); Oc[ooff + (tt - 1) * ostr] = opart; }
        else sa = sum16(sa);
        s0 = fmaf(s0, w.x, fmaf(sa, b.x, v * k.x)); NOPK(s0);
        s1 = fmaf(s1, w.y, fmaf(sa, b.y, v * k.y)); NOPK(s1);
        s2 = fmaf(s2, w.z, fmaf(sa, b.z, v * k.z)); NOPK(s2);
        s3 = fmaf(s3, w.w, fmaf(sa, b.w, v * k.w)); NOPK(s3);
        opart = fmaf(s0, r.x, fmaf(s1, r.y, fmaf(s2, r.z, s3 * r.w)));
        if (tt == 15) { opart = sum16(opart); Oc[ooff + 15 * ostr] = opart; }
        __builtin_amdgcn_sched_barrier(0);
        if (tt + 1 < 16) { a = an; w = wn; b = bn; k = kn; r = rn; v = vn; }
      }
    }
    __builtin_amdgcn_sched_barrier(0);
    __syncthreads();
  }
  {
    const long m = base + (nblk - 1) * 16 + stt;
    p.ORW[m * 512 + h * 64 + q * 16 + (tid & 15)] = f2bf(O_[((nblk - 1) & 1) * 256 + stt * 16 + (tid & 15)]);
  }
  __syncthreads();
  {
    float* o = p.out + (s < 8 ? O_PRWKV + (((long)l * 8 + s) * 8 + h) * 4096
                              : O_SRWKV + (((long)l * 8 + (s - 8)) * 8 + h) * 4096);
    *(float4*)(o + row * 64 + ksl) = make_float4(s0, s1, s2, s3);
  }
}

__device__ __forceinline__ void scan_hgrn(const Params& p, int l, int s, int h, int q, float* smem) {
  const int tid = opaque_tid(), lane = tid & 63, wid = tid >> 6;
  float* Q_ = smem;
  float* F_ = smem + 2048;
  float* G_ = smem + 4096;
  float* I_ = smem + 6144;
  float* O_ = smem + 6400;
  const int rl = wid * 4 + (lane >> 4);
  const int row = q * 16 + rl;
  const int ksl4 = (lane & 15) * 4;
  const int base = seq_base(s), T = seq_len(s);
  float st[8];
#pragma unroll
  for (int i = 0; i < 8; ++i) st[i] = 0.f;
  if (s >= 8) {
    const float* sp = p.state_hgrn + (((long)l * 8 + (s - 8)) * 4 + h) * 16384;
#pragma unroll
    for (int i = 0; i < 8; ++i) st[i] = sp[((i >> 2) * 64 + ksl4 + (i & 3)) * 128 + row];
  }
  const int stt = tid >> 4, skq = (tid & 15) * 8;
  float lb[8];
#pragma unroll
  for (int i = 0; i < 8; ++i) {
    if (l == 0) lb[i] = 0.f;
    else {
      float x0 = p.hg_lb[h * 128 + skq + i], x1 = p.hg_lb[512 + h * 128 + skq + i];
      lb[i] = frcp_(1.f + __expf(x0 - x1));
    }
  }
  const int nblk = T / 16;
  uint4 q8, f8;
  u16 iv16;
  {
    const u16* pr = p.PROJ + (long)(base + stt) * LDP;
    q8 = *(const uint4*)(pr + C_Q + h * 128 + skq);
    f8 = *(const uint4*)(pr + C_F + h * 128 + skq);
    iv16 = pr[C_I + h * 128 + q * 16 + (tid & 15)];
  }
  __syncthreads();
  float* TR_ = smem + 6400 + 512;
  const bool wr = (lane & 15) == 0;
  const int ooff = wr ? rl : (512 + lane);
  const int ostr = wr ? 16 : 0;
  for (int blk = 0; blk < nblk; ++blk) {
    const long m = base + blk * 16 + stt;
    float* Oc = O_ + (blk & 1) * 256;
    {
      unsigned qw[4] = {q8.x, q8.y, q8.z, q8.w}, fw[4] = {f8.x, f8.y, f8.z, f8.w};
      float qv[8], fv[8];
#pragma unroll
      for (int e = 0; e < 8; ++e) {
        qv[e] = bf2f((u16)((qw[e >> 1] >> ((e & 1) * 16)) & 0xffff));
        float fz = bf2f((u16)((fw[e >> 1] >> ((e & 1) * 16)) & 0xffff));
        float ex = __expf(-fz);
        float sg = frcp_(1.f + ex);
        fv[e] = lb[e] + (1.f - lb[e]) * sg;
      }
      *(float4*)(Q_ + stt * 128 + skq) = make_float4(qv[0], qv[1], qv[2], qv[3]);
      *(float4*)(Q_ + stt * 128 + skq + 4) = make_float4(qv[4], qv[5], qv[6], qv[7]);
      *(float4*)(F_ + stt * 128 + skq) = make_float4(fv[0], fv[1], fv[2], fv[3]);
      *(float4*)(F_ + stt * 128 + skq + 4) = make_float4(fv[4], fv[5], fv[6], fv[7]);
      I_[stt * 16 + (tid & 15)] = bf2f(iv16);
    }
    __syncthreads();
    if (blk > 0) {
      u16* dp = p.PROJ + (m - 16) * LDP + C_I + h * 128 + q * 16 + (tid & 15);
      *dp = f2bf(O_[((blk - 1) & 1) * 256 + stt * 16 + (tid & 15)]);
    }
    if (blk + 1 < nblk) {
      const u16* pr = p.PROJ + (m + 16) * LDP;
      q8 = *(const uint4*)(pr + C_Q + h * 128 + skq);
      f8 = *(const uint4*)(pr + C_F + h * 128 + skq);
      iv16 = pr[C_I + h * 128 + q * 16 + (tid & 15)];
    }
    __builtin_amdgcn_sched_barrier(0);
    {
      float4 f0 = *(const float4*)(F_ + ksl4), f1 = *(const float4*)(F_ + 64 + ksl4);
      float4 q0 = *(const float4*)(Q_ + ksl4), q1 = *(const float4*)(Q_ + 64 + ksl4);
      float iv = I_[rl];
      float oprev = 0.f;
#pragma unroll
      for (int tt = 0; tt < 16; ++tt) {
        float4 f0n, f1n, q0n, q1n;
        float ivn;
        if (tt + 1 < 16) {
          const int o_ = (tt + 1) * 128;
          f0n = *(const float4*)(F_ + o_ + ksl4); f1n = *(const float4*)(F_ + o_ + 64 + ksl4);
          q0n = *(const float4*)(Q_ + o_ + ksl4); q1n = *(const float4*)(Q_ + o_ + 64 + ksl4);
          ivn = I_[(tt + 1) * 16 + rl];
        }
        __builtin_amdgcn_sched_barrier(0);
        st[0] = fmaf(st[0] - iv, f0.x, iv); NOPK(st[0]);
        st[1] = fmaf(st[1] - iv, f0.y, iv); NOPK(st[1]);
        st[2] = fmaf(st[2] - iv, f0.z, iv); NOPK(st[2]);
        st[3] = fmaf(st[3] - iv, f0.w, iv); NOPK(st[3]);
        st[4] = fmaf(st[4] - iv, f1.x, iv); NOPK(st[4]);
        st[5] = fmaf(st[5] - iv, f1.y, iv); NOPK(st[5]);
        st[6] = fmaf(st[6] - iv, f1.z, iv); NOPK(st[6]);
        st[7] = fmaf(st[7] - iv, f1.w, iv); NOPK(st[7]);
        float acc0 = fmaf(st[0], q0.x, fmaf(st[1], q0.y, fmaf(st[2], q0.z, st[3] * q0.w)));
        float acc1 = fmaf(st[4], q1.x, fmaf(st[5], q1.y, fmaf(st[6], q1.z, st[7] * q1.w)));
        float o = acc0 + acc1;
        if (tt & 1) { sum16x2(oprev, o); Oc[ooff + (tt - 1) * ostr] = oprev; Oc[ooff + tt * ostr] = o; }
        else oprev = o;
        __builtin_amdgcn_sched_barrier(0);
        if (tt + 1 < 16) { f0 = f0n; f1 = f1n; q0 = q0n; q1 = q1n; iv = ivn; }
      }
    }
    __builtin_amdgcn_sched_barrier(0);
    __syncthreads();
  }
  {
    const long m = base + (nblk - 1) * 16 + stt;
    u16* dp = p.PROJ + m * LDP + C_I + h * 128 + q * 16 + (tid & 15);
    *dp = f2bf(O_[((nblk - 1) & 1) * 256 + stt * 16 + (tid & 15)]);
  }
  __syncthreads();
  {
    float* o = p.out + (s < 8 ? O_PHGRN + (((long)l * 8 + s) * 4 + h) * 16384
                              : O_SHGRN + (((long)l * 8 + (s - 8)) * 4 + h) * 16384);
#pragma unroll
    for (int i = 0; i < 8; ++i) o[((i >> 2) * 64 + ksl4 + (i & 3)) * 128 + row] = st[i];
  }
}

__device__ __forceinline__ void scan_ssd(const Params& p, int l, int s, int h, int q, float* smem) {
  const int tid = opaque_tid(), lane = tid & 63, wid = tid >> 6;
  float* B_ = smem;
  float* C_ = smem + 2048;
  float* X_ = smem + 4096;
  float* O_ = smem + 4352;
  float* DT_ = smem + 5200;
  float* DE_ = smem + 5216;
  const int rl = wid * 4 + (lane >> 4);
  const int row = q * 16 + rl;
  const int ksl4 = (lane & 15) * 4;
  const int g = h >> 2;
  const int base = seq_base(s), T = seq_len(s);
  float st[8];
#pragma unroll
  for (int i = 0; i < 8; ++i) st[i] = 0.f;
  if (s >= 8) {
    const float* sp = p.state_ssm + (((long)l * 8 + (s - 8)) * 8 + h) * 8192 + row * 128 + ksl4;
    float4 a = *(const float4*)sp, b = *(const float4*)(sp + 64);
    st[0] = a.x; st[1] = a.y; st[2] = a.z; st[3] = a.w; st[4] = b.x; st[5] = b.y; st[6] = b.z; st[7] = b.w;
  }
  const float* cw = p.conv_w + (long)l * 4 * 1024;
  const int skq8 = (tid & 15) * 8;
  const int xc_x = h * 64 + q * 16 + (tid & 15);
  const float cx0 = cw[xc_x], cx1 = cw[1024 + xc_x], cx2 = cw[2048 + xc_x], cx3 = cw[3072 + xc_x];
  const float cxb = p.conv_b[l * 1024 + xc_x];
  const float dtb = p.dt_bias[l * 8 + h];
  const float aexp = __expf(p.a_log[l * 8 + h]);
  const float dsk = p.d_skip[l * 8 + h];
  const int stt = tid >> 4;
  const int nblk = T / 16;
  uint4 rawb, rawc;
  float xr[4];
  float dtr = 0.f;
  u16 zc = 0, zn = 0;
#define SSD_LOAD(M0)                                                              \
  {                                                                               \
    {                                                                             \
      const u16* prow = p.PROJ + ((long)(M0) + stt) * LDP + C_XBC + g * 128 + skq8; \
      rawb = *(const uint4*)(prow + 512);                                         \
      rawc = *(const uint4*)(prow + 768);                                         \
    }                                                                             \
    {                                                                             \
      const long mr = (long)(M0) + stt;                                           \
      const u16* colx = p.PROJ + mr * LDP + C_XBC + xc_x;                         \
      _Pragma("unroll") for (int j = 0; j < 4; ++j) {                             \
        const long mm = mr - 3 + j;                                               \
        float vx;                                                                 \
        if (mm >= base) vx = bf2f(colx[(long)(j - 3) * LDP]);                     \
        else vx = (s >= 8) ? p.state_conv[((long)l * 8 + (s - 8)) * 3072 + (3 + (int)(mm - base)) * 1024 + xc_x] : 0.f; \
        xr[j] = vx;                                                               \
      }                                                                           \
    }                                                                             \
    if (tid < 16) dtr = (p.FB + FOFF_DTRAW)[((long)(M0) + tid) * 8 + h];                      \
    zn = p.PROJ[((long)(M0) + stt) * LDP + C_Z + h * 64 + q * 16 + (tid & 15)];   \
  }
  SSD_LOAD(base);
  __syncthreads();
  const bool wr = (lane & 15) == 0;
  const int ooff = wr ? rl : (512 + lane);
  const int ostr = wr ? 16 : 0;
  u16 zp = 0;
  for (int blk = 0; blk < nblk; ++blk) {
    const long m0 = base + blk * 16;
    zp = zc;
    zc = zn;
    float* Oc = O_ + (blk & 1) * 256;
    {
      {
        const unsigned bw[4] = {rawb.x, rawb.y, rawb.z, rawb.w}, cwd[4] = {rawc.x, rawc.y, rawc.z, rawc.w};
        float bv[8], cv[8];
#pragma unroll
        for (int e = 0; e < 8; ++e) {
          bv[e] = bf2f((u16)((bw[e >> 1] >> ((e & 1) * 16)) & 0xffff));
          cv[e] = bf2f((u16)((cwd[e >> 1] >> ((e & 1) * 16)) & 0xffff));
        }
        *(float4*)(B_ + stt * 128 + skq8) = make_float4(bv[0], bv[1], bv[2], bv[3]);
        *(float4*)(B_ + stt * 128 + skq8 + 4) = make_float4(bv[4], bv[5], bv[6], bv[7]);
        *(float4*)(C_ + stt * 128 + skq8) = make_float4(cv[0], cv[1], cv[2], cv[3]);
        *(float4*)(C_ + stt * 128 + skq8 + 4) = make_float4(cv[4], cv[5], cv[6], cv[7]);
      }
      {
        float y = cx0 * xr[0] + cx1 * xr[1] + cx2 * xr[2] + cx3 * xr[3] + cxb;
        X_[stt * 16 + (tid & 15)] = siluf_(y);
      }
      if (tid < 16) {
        float dtv = softplusf_(dtr + dtb);
        DT_[tid] = dtv;
        DE_[tid] = __expf(-aexp * dtv);
      }
    }
    __syncthreads();
    if (blk > 0) {
      u16* pz = p.PROJ + (m0 - 16 + stt) * LDP + C_Z + h * 64 + q * 16 + (tid & 15);
      *pz = f2bf(O_[((blk - 1) & 1) * 256 + stt * 16 + (tid & 15)] * siluf_(bf2f(zp)));
    }
    if (blk + 1 < nblk) SSD_LOAD(m0 + 16);
    __builtin_amdgcn_sched_barrier(0);
    {
      float4 b0 = *(const float4*)(B_ + ksl4), b1 = *(const float4*)(B_ + 64 + ksl4);
      float4 c0 = *(const float4*)(C_ + ksl4), c1 = *(const float4*)(C_ + 64 + ksl4);
      float xv = X_[rl], dt = DT_[0], de = DE_[0];
      float yprev = 0.f, xvprev = 0.f;
#pragma unroll
      for (int tt = 0; tt < 16; ++tt) {
        float4 b0n, b1n, c0n, c1n;
        float xvn, dtn, den;
        if (tt + 1 < 16) {
          const int o_ = (tt + 1) * 128;
          b0n = *(const float4*)(B_ + o_ + ksl4); b1n = *(const float4*)(B_ + o_ + 64 + ksl4);
          c0n = *(const float4*)(C_ + o_ + ksl4); c1n = *(const float4*)(C_ + o_ + 64 + ksl4);
          xvn = X_[(tt + 1) * 16 + rl]; dtn = DT_[tt + 1]; den = DE_[tt + 1];
        }
        __builtin_amdgcn_sched_barrier(0);
        const float xd = xv * dt;
        st[0] = fmaf(st[0], de, xd * b0.x); NOPK(st[0]);
        st[1] = fmaf(st[1], de, xd * b0.y); NOPK(st[1]);
        st[2] = fmaf(st[2], de, xd * b0.z); NOPK(st[2]);
        st[3] = fmaf(st[3], de, xd * b0.w); NOPK(st[3]);
        st[4] = fmaf(st[4], de, xd * b1.x); NOPK(st[4]);
        st[5] = fmaf(st[5], de, xd * b1.y); NOPK(st[5]);
        st[6] = fmaf(st[6], de, xd * b1.z); NOPK(st[6]);
        st[7] = fmaf(st[7], de, xd * b1.w); NOPK(st[7]);
        float acc0 = fmaf(st[0], c0.x, fmaf(st[1], c0.y, fmaf(st[2], c0.z, st[3] * c0.w)));
        float acc1 = fmaf(st[4], c1.x, fmaf(st[5], c1.y, fmaf(st[6], c1.z, st[7] * c1.w)));
        float y = acc0 + acc1;
        if (tt & 1) { sum16x2(yprev, y); Oc[ooff + (tt - 1) * ostr] = yprev + dsk * xvprev; Oc[ooff + tt * ostr] = y + dsk * xv; }
        else { yprev = y; xvprev = xv; }
        __builtin_amdgcn_sched_barrier(0);
        if (tt + 1 < 16) { b0 = b0n; b1 = b1n; c0 = c0n; c1 = c1n; xv = xvn; dt = dtn; de = den; }
      }
    }
    __builtin_amdgcn_sched_barrier(0);
    __syncthreads();
  }
  {
    const long m0 = base + (nblk - 1) * 16;
    u16* pz = p.PROJ + (m0 + stt) * LDP + C_Z + h * 64 + q * 16 + (tid & 15);
    *pz = f2bf(O_[((nblk - 1) & 1) * 256 + stt * 16 + (tid & 15)] * siluf_(bf2f(zc)));
  }
  __syncthreads();
#undef SSD_LOAD
  {
    float* o = p.out + (s < 8 ? O_PSSM + (((long)l * 8 + s) * 8 + h) * 8192
                              : O_SSSM + (((long)l * 8 + (s - 8)) * 8 + h) * 8192);
    *(float4*)(o + row * 128 + ksl4) = make_float4(st[0], st[1], st[2], st[3]);
    *(float4*)(o + row * 128 + 64 + ksl4) = make_float4(st[4], st[5], st[6], st[7]);
  }
  if (h == 0 && q == 0) {
    float* o = p.out + (s < 8 ? O_PCONV + ((long)l * 8 + s) * 3072 : O_SCONV + ((long)l * 8 + (s - 8)) * 3072);
    const long lastblk = (long)(base + T) / 16 - 1;
    for (int i = tid; i < 3072; i += 256) {
      int r = i >> 10, c = i & 1023;
      o[i] = (c < 512) ? bf2f(p.PROJ[(long)(base + T - 3 + r) * LDP + C_XBC + c])
                       : bf2f(p.BND2[(lastblk * 3 + r) * 512 + (c - 512)]);
    }
  }
}

__device__ __forceinline__ void phase_scan(const Params& p, int l, float* smem) {
  for (int u = BID, nb_ = NBLK; u < 1536; u += nb_) {
    int sample = u >= 768;
    int v = sample ? u - 768 : u;
    int type = v % 3, w = v / 3;
    if (type == 0) {
      int q = w & 3, h = (w >> 2) & 7, b = w >> 5;
      scan_rwkv(p, l, b + 8 * sample, h, q, smem);
    } else if (type == 1) {
      int q = w & 7, h = (w >> 3) & 3, b = w >> 5;
      scan_hgrn(p, l, b + 8 * sample, h, q, smem);
    } else {
      int q = w & 3, h = (w >> 2) & 7, b = w >> 5;
      scan_ssd(p, l, b + 8 * sample, h, q, smem);
    }
  }
}

__device__ __forceinline__ void phase_post(const Params& p, int l, float* smem) {
  constexpr int LDG = 516;
  float* GA = smem;
  for (int blk = BID, nb_ = NBLK; blk < NBLK16; blk += nb_) {
    const int tid = opaque_tid(), lane = tid & 63, wid = tid >> 6;
    const int T = tid >> 4, Q = tid & 15;
    const long m0 = (long)blk * 16;
    const long m = m0 + T;
    __syncthreads();
    {
      bf16x8 ag[4];
      const u16* arow = p.PROJ + (m0 + (lane & 15)) * LDP + C_XG + (lane >> 4) * 8;
#pragma unroll
      for (int ks = 0; ks < 4; ++ks) ag[ks] = *(const bf16x8*)(arow + ks * 32);
#pragma unroll
      for (int nt = 0; nt < 8; ++nt) {
        const int n = (wid * 8 + nt) * 16 + (lane & 15);
        f32x4v acc = {0.f, 0.f, 0.f, 0.f};
#pragma unroll
        for (int ks = 0; ks < 4; ++ks) {
          bf16x8 bg = *(const bf16x8*)((p.WB + OFF_G2T) + n * 128 + ks * 32 + (lane >> 4) * 8);
          acc = __builtin_amdgcn_mfma_f32_16x16x32_bf16(ag[ks], bg, acc, 0, 0, 0);
        }
#pragma unroll
        for (int r = 0; r < 4; ++r) GA[((lane >> 4) * 4 + r) * LDG + n] = acc[r];
      }
    }
    __syncthreads();
    u16* row = p.PROJ + m * LDP;
#pragma unroll 1
    for (int g = 0; g < 2; ++g) {
      float y0[8], y1[8], w[8];
      const int c0 = g * 256 + Q * 8, c1 = c0 + 128;
      unpack8(*(const uint4*)(row + C_Z + c0), y0);
      unpack8(*(const uint4*)(row + C_Z + c1), y1);
      float ss = 0.f;
#pragma unroll
      for (int e = 0; e < 8; ++e) ss += y0[e] * y0[e] + y1[e] * y1[e];
      ss = sum16(ss);
      const float rs = rsqrtf(ss * (1.f / 256.f) + 1e-6f);
      ld8(p.ssd_norm_w + l * 512 + c0, w);
#pragma unroll
      for (int e = 0; e < 8; ++e) y0[e] = y0[e] * rs * w[e];
      ld8(p.ssd_norm_w + l * 512 + c1, w);
#pragma unroll
      for (int e = 0; e < 8; ++e) y1[e] = y1[e] * rs * w[e];
      *(uint4*)(row + C_Z + c0) = pack8(y0);
      *(uint4*)(row + C_Z + c1) = pack8(y1);
    }
#pragma unroll 1
    for (int j = 0; j < 4; ++j) {
      const int c0 = j * 128 + Q * 8;
      {
        float oh[8], gg[8], w[8];
        unpack8(*(const uint4*)(row + C_I + c0), oh);
        unpack8(*(const uint4*)(row + C_GG + c0), gg);
        float ss = 0.f;
#pragma unroll
        for (int e = 0; e < 8; ++e) ss += oh[e] * oh[e];
        ss = sum16(ss);
        const float rs = rsqrtf(ss * (1.f / 128.f) + 1e-6f);
        ld8(p.hg_norm_w + l * 512 + c0, w);
#pragma unroll
        for (int e = 0; e < 8; ++e) oh[e] = oh[e] * rs * w[e] * siluf_(gg[e]);
        *(uint4*)(row + C_GG + c0) = pack8(oh);
      }
      {
        float o[8], v[8], w[8], bb[8], ga[8];
        const int head = j * 2 + (Q >> 3);
        unpack8(*(const uint4*)(p.ORW + m * 512 + c0), o);
        unpack8(*(const uint4*)(row + C_V + c0), v);
        float sm = 0.f;
#pragma unroll
        for (int e = 0; e < 8; ++e) sm += o[e];
        const float mean = sum8(sm) * (1.f / 64.f);
        float sv = 0.f;
#pragma unroll
        for (int e = 0; e < 8; ++e) { o[e] -= mean; sv += o[e] * o[e]; }
        const float rstd = rsqrtf(sum8(sv) * (1.f / 64.f) + 64e-5f);
        const float rks = (p.FB + FOFF_RKS)[m * 8 + head];
        ld8(p.rw_lnx_w + l * 512 + c0, w);
        ld8(p.rw_lnx_b + l * 512 + c0, bb);
        ld8(GA + T * LDG + c0, ga);
#pragma unroll
        for (int e = 0; e < 8; ++e) o[e] = (o[e] * rstd * w[e] + bb[e] + rks * v[e]) * ga[e];
        *(uint4*)(row + C_R + c0) = pack8(o);
      }
    }
  }
}

__device__ __forceinline__ void phase_final(const Params& p) {
  const int tid = opaque_tid(), lane = tid & 63, wid = tid >> 6;
  for (int m = BID * 4 + wid, nb_ = NBLK; m < M_TOT; m += nb_ * 4) {
    float* dst;
    if (m < M_PROMPT) {
      int b = m / T_P, t = m - b * T_P;
      if (t < 16) continue;
      dst = p.out + O_YP + ((long)b * 4096 + (t - 16)) * DM;
    } else {
      dst = p.out + O_YS + (long)(m - M_PROMPT) * DM;
    }
    float x[16];
    float ss = 0.f;
#pragma unroll
    for (int j = 0; j < 2; ++j) {
      uint4 raw = *(const uint4*)(p.XB + (long)m * DM + lane * 8 + 512 * j);
      unsigned wv[4] = {raw.x, raw.y, raw.z, raw.w};
#pragma unroll
      for (int e = 0; e < 8; ++e) {
        x[j * 8 + e] = bf2f((u16)((wv[e >> 1] >> ((e & 1) * 16)) & 0xffff));
        ss += x[j * 8 + e] * x[j * 8 + e];
      }
    }
    ss = sum64(ss);
    float rs = rsqrtf(ss * (1.f / 1024.f) + 1e-6f);
#pragma unroll
    for (int j = 0; j < 2; ++j) {
      int k0 = lane * 8 + 512 * j;
      float4 w0 = *(const float4*)(p.final_w + k0), w1 = *(const float4*)(p.final_w + k0 + 4);
      *(float4*)(dst + k0) = make_float4(x[j * 8 + 0] * rs * w0.x, x[j * 8 + 1] * rs * w0.y, x[j * 8 + 2] * rs * w0.z,
                                         x[j * 8 + 3] * rs * w0.w);
      *(float4*)(dst + k0 + 4) = make_float4(x[j * 8 + 4] * rs * w1.x, x[j * 8 + 5] * rs * w1.y,
                                             x[j * 8 + 6] * rs * w1.z, x[j * 8 + 7] * rs * w1.w);
    }
  }
}


#define XB_TMO      128
#define XB_XCNT(j)  (256  + 64 * (j))
#define XB_XSUB(j)  (1280 + 64 * (j))
#define XB_XGEN(j)  (2304 + 64 * (j))
#define XB_TOP      3328
#define XB_TOPGEN   3392
#define XCD_BAR_WORDS 3456
#define XB_SPIN_CAP (1u << 22)
__device__ __forceinline__ unsigned xb_ld(unsigned* p) { return __hip_atomic_load(p, __ATOMIC_RELAXED, __HIP_MEMORY_SCOPE_AGENT); }
__device__ __forceinline__ unsigned xb_add(unsigned* p, unsigned v) { return __hip_atomic_fetch_add(p, v, __ATOMIC_RELAXED, __HIP_MEMORY_SCOPE_AGENT); }
__device__ __forceinline__ unsigned xb_xcc_id() { return (unsigned)__builtin_amdgcn_s_getreg((3 << 11) | 20) & 0xFu; }
#define XB_SPIN(cond, bar) do { unsigned _sp = 0; while (cond) { __builtin_amdgcn_s_sleep(1); \
    if ((++_sp & 255u) == 0u) { if (xb_ld(&(bar)[XB_TMO])) break; if (_sp > XB_SPIN_CAP) { atomicAdd(&(bar)[XB_TMO], 1u); break; } } } } while (0)

__device__ __forceinline__ void xcd_barrier_post(unsigned* bar) {
  if (threadIdx.x == 0) (void)xb_add(&bar[XB_XCNT(xb_xcc_id())], 1u);
}
__device__ __forceinline__ void xcd_barrier_complete(unsigned* bar, unsigned x, unsigned& nloc, unsigned& nx) {
  const unsigned G = gridDim.x;
  unsigned sum, cnt, mine, sp = 0u;
  for (;;) {
    sum = 0u; cnt = 0u; mine = 0u;
#pragma unroll
    for (unsigned j = 0; j < 16; ++j) { const unsigned c = xb_ld(&bar[XB_XCNT(j)]); sum += c; cnt += (c > 0u) ? 1u : 0u; mine = (j == x) ? c : mine; }
    if (sum == G) break;
    __builtin_amdgcn_s_sleep(1);
    if ((++sp & 255u) == 0u) { if (xb_ld(&bar[XB_TMO])) break; if (sp > XB_SPIN_CAP) { atomicAdd(&bar[XB_TMO], 1u); break; } }
  }
  nloc = mine > 0u ? mine : 1u; nx = cnt > 0u ? cnt : 1u;
}
__device__ __forceinline__ void xcd_barrier(unsigned* bar, volatile unsigned* st) {
  asm volatile("s_waitcnt vmcnt(0)" ::: "memory");
  __syncthreads();
  if (threadIdx.x == 0) {
    __builtin_amdgcn_s_waitcnt(0);
    const unsigned x = xb_xcc_id();
    unsigned nloc = st[0], nx = st[1];
    if (nloc == 0u) { xcd_barrier_complete(bar, x, nloc, nx); st[0] = nloc; st[1] = nx; }
    const unsigned old = xb_add(&bar[XB_XSUB(x)], 1u);
    const unsigned gen = old / nloc;
    if (old + 1u == (gen + 1u) * nloc) {
      __builtin_amdgcn_fence(__ATOMIC_RELEASE, "agent");
      asm volatile("s_waitcnt vmcnt(0)" ::: "memory");
      const unsigned og = xb_add(&bar[XB_TOP], 1u);
      const unsigned tg = og / nx;
      if (og + 1u == (tg + 1u) * nx) xb_add(&bar[XB_TOPGEN], 1u);
      else XB_SPIN(xb_ld(&bar[XB_TOPGEN]) == tg, bar);
      __builtin_amdgcn_fence(__ATOMIC_ACQUIRE, "agent");
      xb_add(&bar[XB_XGEN(x)], 1u);
      asm volatile("s_waitcnt vmcnt(0)" ::: "memory");
    } else {
      XB_SPIN(xb_ld(&bar[XB_XGEN(x)]) == gen, bar);
      __builtin_amdgcn_fence(__ATOMIC_ACQUIRE, "agent");
      asm volatile("s_waitcnt vmcnt(0)" ::: "memory");
    }
  }
  __syncthreads();
}

constexpr int SMEM_BYTES = 40960;
__device__ __forceinline__ void run_phase(const Params& p, int ph, char* smem) {
  if (ph == 0) { phase_embed(p); return; }
  if (ph == 19) { phase_final(p); return; }
  int l = (ph - 1) / 9, s = (ph - 1) % 9;
  float* fs = (float*)smem;
  switch (s) {
    case 0: phase_convert(p, l, fs); phase_rowstat<true>(p, l, fs); break;
    case 1: phase_gemm<1>(p, p.XB, DM, (p.WB + OFF_W1T), 1024, LDP / 128, smem); break;
    case 2: phase_pre(p, l, fs); break;
    case 3: phase_scan(p, l, fs); break;
    case 4: phase_post(p, l, fs); break;
    case 5: phase_gemm<2>(p, p.PROJ, LDP, (p.WB + OFF_WOT), 1536, 8, smem); break;
    case 6: phase_rowstat<false>(p, l, fs); break;
    case 7: phase_gemm<3>(p, p.XB, DM, (p.WB + OFF_WGU), 1024, 44, smem); break;
    case 8: phase_gemm<2>(p, p.PROJ, D_FF, (p.WB + OFF_WDT), D_FF, 8, smem); break;
  }
}
constexpr int N_PHASES = 20;

#if MEGA
__global__ void __launch_bounds__(256, 3) k_mega(Params p) {
  __shared__ __attribute__((aligned(16))) char smem[SMEM_BYTES];
  __shared__ uint4 xb_words;
  if (threadIdx.x == 0) { xb_words = make_uint4(0u, 0u, 0u, 0u); }
  __syncthreads();
  cg::grid_group grid = cg::this_grid();
  float* fs = (float*)smem;
  volatile unsigned* xst = (volatile unsigned*)&xb_words;
  xcd_barrier_post(p.bar);
  phase_embed(p);
  grid.sync();
#define GSYNC() do { unsigned* b_ = p.bar; asm volatile("" : "+s"(b_)); xcd_barrier(b_, xst); } while (0)
  {
    const int L0_ = 0;
    int l = opaque_s(L0_);
    phase_convert(p, l, fs);
    phase_rowstat<true>(p, l, fs);
    GSYNC();
    l = opaque_s(l);
    phase_gemm<1>(p, p.XB, DM, (p.WB + OFF_W1T), 1024, LDP / 128, smem);
    GSYNC();
    l = opaque_s(l);
    phase_pre(p, l, fs);
    GSYNC();
    l = opaque_s(l);
    phase_scan(p, l, fs);
    GSYNC();
    l = opaque_s(l);
    phase_post(p, l, fs);
    GSYNC();
    l = opaque_s(l);
    phase_gemm<2>(p, p.PROJ, LDP, (p.WB + OFF_WOT), 1536, 8, smem);
    GSYNC();
    l = opaque_s(l);
    phase_rowstat<false>(p, l, fs);
    GSYNC();
    l = opaque_s(l);
    phase_gemm<3>(p, p.XB, DM, (p.WB + OFF_WGU), 1024, 44, smem);
    GSYNC();
    l = opaque_s(l);
    phase_gemm<2>(p, p.PROJ, D_FF, (p.WB + OFF_WDT), D_FF, 8, smem);
    GSYNC();
  }
  {
    const int L0_ = 1;
    int l = opaque_s(L0_);
    phase_convert(p, l, fs);
    phase_rowstat<true>(p, l, fs);
    GSYNC();
    l = opaque_s(l);
    phase_gemm<1>(p, p.XB, DM, (p.WB + OFF_W1T), 1024, LDP / 128, smem);
    GSYNC();
    l = opaque_s(l);
    phase_pre(p, l, fs);
    GSYNC();
    l = opaque_s(l);
    phase_scan(p, l, fs);
    GSYNC();
    l = opaque_s(l);
    phase_post(p, l, fs);
    GSYNC();
    l = opaque_s(l);
    phase_gemm<2>(p, p.PROJ, LDP, (p.WB + OFF_WOT), 1536, 8, smem);
    GSYNC();
    l = opaque_s(l);
    phase_rowstat<false>(p, l, fs);
    GSYNC();
    l = opaque_s(l);
    phase_gemm<3>(p, p.XB, DM, (p.WB + OFF_WGU), 1024, 44, smem);
    GSYNC();
    l = opaque_s(l);
    phase_gemm<2>(p, p.PROJ, D_FF, (p.WB + OFF_WDT), D_FF, 8, smem);
    GSYNC();
  }
  phase_final(p);
}
#else
template <int PH>
__global__ void __launch_bounds__(256, 3) k_phase(Params p) {
  __shared__ __attribute__((aligned(16))) char smem[SMEM_BYTES];
  run_phase(p, PH, smem);
}
template <int PH>
static void launch_all(const Params& p, int grid, hipStream_t stream) {
  hipLaunchKernelGGL(k_phase<PH>, dim3(grid), dim3(256), 0, stream, p);
  if constexpr (PH + 1 < N_PHASES) launch_all<PH + 1>(p, grid, stream);
}
#endif

extern "C" void kernel_launch(void* const* d_in, const int* in_sizes, int n_in, void* d_out, int out_size, void* d_ws,
                              size_t ws_size, hipStream_t stream) {
  Params p{};
  const float** pf = (const float**)&p;
  for (int i = 0; i < 35; ++i) pf[i] = (const float*)d_in[i];
  p.out = (float*)d_out;
  char* ws = (char*)d_ws;
  size_t off = 0;
  auto take = [&](size_t bytes) { char* r = ws + off; off += (bytes + 255) & ~(size_t)255; return r; };
  p.XB = (u16*)take((size_t)M_TOT * DM * 2);
  p.PROJ = (u16*)take((size_t)M_TOT * LDP * 2);
  p.WB = (u16*)take((size_t)WB_TOTAL * 2);
  p.BND = (u16*)take((size_t)NBLK16 * 1792 * 2);
  p.BND2 = (u16*)take((size_t)NBLK16 * 3 * 512 * 2);
  p.ORW = (u16*)take((size_t)M_TOT * 512 * 2);
  p.FB = (float*)take((size_t)FB_TOTAL * 4);
  p.bar = (unsigned*)take((size_t)XCD_BAR_WORDS * 4);
  p.RWX = (u16*)d_out;
  if (off > ws_size) fprintf(stderr, "workspace too small: need %zu have %zu\n", off, ws_size);
#if MEGA
  static int grid_blocks = 0;
  if (!grid_blocks) {
    int dev = 0, cus = 0, per_cu = 0;
    hipGetDevice(&dev);
    hipDeviceGetAttribute(&cus, hipDeviceAttributeMultiprocessorCount, dev);
    hipOccupancyMaxActiveBlocksPerMultiprocessor(&per_cu, k_mega, 256, 0);
    if (per_cu > 3) per_cu = 3;
    grid_blocks = cus * per_cu;
  }
  hipMemsetAsync(p.bar, 0, (size_t)XCD_BAR_WORDS * 4, stream);
  void* args[] = {&p};
  hipError_t e = hipLaunchCooperativeKernel((void*)k_mega, dim3(grid_blocks), dim3(256), args, 0, stream);
  if (e != hipSuccess) fprintf(stderr, "cooperative launch failed: %s (grid %d)\n", hipGetErrorString(e), grid_blocks);
#else
  launch_all<0>(p, 768, stream);
#endif
}
```

```cpp
#include <hip/hip_runtime.h>
#include <hip/hip_bf16.h>
#include <hip/hip_cooperative_groups.h>
#include <cstdio>
namespace cg = cooperative_groups;

#ifndef MEGA
#define MEGA 1
#endif

typedef unsigned short u16;
using bf16x8 = __attribute__((ext_vector_type(8))) short;
using f32x16 = __attribute__((ext_vector_type(16))) float;
using f32x4v = __attribute__((ext_vector_type(4))) float;

constexpr int DM = 1024;
constexpr int M_TOT = 33408;
constexpr int M_PROMPT = 32896;
constexpr int T_P = 4112;
constexpr int LDP = 5376;
constexpr int N_IN = 5384;
constexpr int D_FF = 2816;
constexpr int NBLK16 = M_TOT / 16;
constexpr int C_Z = 0, C_R = 512, C_GG = 1024, C_XBC = 1536, C_K = 2560, C_V = 3072, C_XW = 3584, C_XA = 3648,
              C_XG = 3712, C_Q = 3840, C_F = 4352, C_I = 4864;
constexpr long O_YP = 0, O_YS = 33554432, O_PSSM = 34078720, O_PCONV = 35127296, O_PRWKV = 35176448,
               O_PSHIFT = 35700736, O_PHGRN = 35729408, O_SSSM = 36777984, O_SCONV = 37826560,
               O_SRWKV = 37875712, O_SSHIFT = 38400000, O_SHGRN = 38428672;

constexpr long OFF_W1T = 0, OFF_WOT = 5505024, OFF_WGU = 7077888, OFF_WDT = 12845056, OFF_W2T = 15728640, OFF_A2T = 15761408, OFF_G2T = 15794176, WB_TOTAL = 15859712;
constexpr long FOFF_RS = 0, FOFF_DTRAW = 33408, FOFF_RKS = 300672, FB_TOTAL = 567936;
struct Params {
  const float *x_prompt, *x_sample, *state_ssm, *state_conv, *state_rwkv, *state_shift, *state_hgrn, *meta,
      *norm1_w, *w_in, *conv_w, *conv_b, *dt_bias, *a_log, *d_skip, *ssd_norm_w, *rw_mu, *rw_w0, *rw_w2, *rw_a0,
      *rw_a2, *rw_g2, *rw_kk, *rw_ka, *rw_rk, *rw_lnx_w, *rw_lnx_b, *hg_lb, *hg_norm_w, *w_out, *norm2_w, *w_gate,
      *w_up, *w_down, *final_w;
  float* out;
  u16 *XB, *PROJ, *WB, *BND, *BND2, *ORW, *RWX;
  float *FB;
  unsigned* bar;
};

__device__ __forceinline__ u16 f2bf(float f) {
  unsigned u = __float_as_uint(f);
  u += 0x7fffu + ((u >> 16) & 1u);
  return (u16)(u >> 16);
}
__device__ __forceinline__ float bf2f(u16 h) { return __uint_as_float(((unsigned)h) << 16); }
__device__ __forceinline__ float frcp_(float x) { return __builtin_amdgcn_rcpf(x); }
__device__ __forceinline__ float sigmoidf_(float x) { return frcp_(1.f + __expf(-x)); }
__device__ __forceinline__ float siluf_(float x) { return x * frcp_(1.f + __expf(-x)); }
__device__ __forceinline__ float softplusf_(float x) { return x > 20.f ? x : log1pf(__expf(x)); }

template <int CTRL>
__device__ __forceinline__ float dppf(float v) {
  return __int_as_float(__builtin_amdgcn_update_dpp(0, __float_as_int(v), CTRL, 0xF, 0xF, true));
}
__device__ __forceinline__ float sum16(float v) {
  v += dppf<0xB1>(v);
  v += dppf<0x4E>(v);
  v += dppf<0x141>(v);
  v += dppf<0x140>(v);
  return v;
}
__device__ __forceinline__ void sum16x2(float& a, float& b) {
  a += dppf<0xB1>(a); b += dppf<0xB1>(b);
  a += dppf<0x4E>(a); b += dppf<0x4E>(b);
  a += dppf<0x141>(a); b += dppf<0x141>(b);
  a += dppf<0x140>(a); b += dppf<0x140>(b);
}

__device__ __forceinline__ float sum8(float v) {
  v += dppf<0xB1>(v);
  v += dppf<0x4E>(v);
  v += dppf<0x141>(v);
  return v;
}
__device__ __forceinline__ void unpack8(const uint4& r, float* f) {
  f[0] = __uint_as_float(r.x << 16); f[1] = __uint_as_float(r.x & 0xffff0000u);
  f[2] = __uint_as_float(r.y << 16); f[3] = __uint_as_float(r.y & 0xffff0000u);
  f[4] = __uint_as_float(r.z << 16); f[5] = __uint_as_float(r.z & 0xffff0000u);
  f[6] = __uint_as_float(r.w << 16); f[7] = __uint_as_float(r.w & 0xffff0000u);
}
__device__ __forceinline__ uint4 pack8(const float* f) {
  uint4 r;
  r.x = f2bf(f[0]) | ((unsigned)f2bf(f[1]) << 16);
  r.y = f2bf(f[2]) | ((unsigned)f2bf(f[3]) << 16);
  r.z = f2bf(f[4]) | ((unsigned)f2bf(f[5]) << 16);
  r.w = f2bf(f[6]) | ((unsigned)f2bf(f[7]) << 16);
  return r;
}
__device__ __forceinline__ void ld8(const float* p, float* f) {
  float4 a = *(const float4*)p, b = *(const float4*)(p + 4);
  f[0] = a.x; f[1] = a.y; f[2] = a.z; f[3] = a.w; f[4] = b.x; f[5] = b.y; f[6] = b.z; f[7] = b.w;
}

struct F8 { float v[8]; };
__device__ __forceinline__ F8 up8(const uint4& r) { F8 f; unpack8(r, f.v); return f; }
__device__ __forceinline__ F8 ldf8(const float* p) { F8 f; ld8(p, f.v); return f; }
__device__ __forceinline__ F8 zero8() { F8 f; for (int e = 0; e < 8; ++e) f.v[e] = 0.f; return f; }
__device__ __forceinline__ float sum64(float v) {
  v = sum16(v);
  v += __shfl_xor(v, 16);
  v += __shfl_xor(v, 32);
  return v;
}

#define NOPK(x) asm("" : "+v"(x))
__device__ __forceinline__ int opaque_tid() {
  int t = threadIdx.x;
  asm volatile("" : "+v"(t));
  return t;
}
__device__ __forceinline__ int opaque_s(int v) {
  asm volatile("" : "+s"(v));
  return v;
}
#define BID opaque_s((int)blockIdx.x)
#define NBLK opaque_s((int)gridDim.x)
__device__ __forceinline__ int seq_base(int s) { return s < 8 ? s * T_P : M_PROMPT + (s - 8) * 64; }
__device__ __forceinline__ int seq_len(int s) { return s < 8 ? T_P : 64; }

__device__ __forceinline__ long xb_off(int m, int k);
__device__ __forceinline__ void phase_embed(const Params& p) {
  const long n4 = (long)M_TOT * 256;
  for (long idx = (long)BID * 256 + threadIdx.x, st_ = (long)NBLK * 256; idx < n4; idx += st_) {
    int m = (int)(idx >> 8), c4 = ((int)idx & 255) * 4;
    const float* src;
    if (m < M_PROMPT) {
      int b = m / T_P, t = m - b * T_P;
      src = (t < 16) ? p.meta + (long)t * DM : p.x_prompt + ((long)b * 4096 + (t - 16)) * DM;
    } else {
      src = p.x_sample + (long)(m - M_PROMPT) * DM;
    }
    float4 v = *(const float4*)(src + c4);
    ushort4 o;
    o.x = f2bf(v.x); o.y = f2bf(v.y); o.z = f2bf(v.z); o.w = f2bf(v.w);
    *(ushort4*)(p.XB + xb_off(m, c4)) = o;
  }
}

__device__ __forceinline__ long xb_off(int m, int k) { return ((long)(m >> 7) * 32 + (k >> 5)) * 4096 + (m & 127) * 32 + (k & 31); }
__device__ __forceinline__ long wtile_off(int n, int k, int K) {
  return ((long)(n >> 7) * (K >> 5) + (k >> 5)) * 4096 + (n & 127) * 32 + (k & 31);
}
template <bool HAS_SCALE>
__device__ __forceinline__ void conv_tile(const float* __restrict__ src, int ldsrc, int srccol0, const float* __restrict__ scale,
                          u16* __restrict__ dst, int K, int k0, int n0, float* tile  ) {
  const int tid = opaque_tid();
  __syncthreads();
  {
    int nn = tid & 63, kb = tid >> 6;
#pragma unroll
    for (int i = 0; i < 16; ++i) {
      int kk = kb + 4 * i;
      float v = src[(long)(k0 + kk) * ldsrc + srccol0 + nn];
      if (HAS_SCALE) v *= scale[k0 + kk];
      tile[kk * 65 + nn] = v;
    }
  }
  __syncthreads();
  {
    int nn = tid >> 2, kq = (tid & 3) * 16;
    u16* d = dst + wtile_off(n0 + nn, k0 + kq, K);
#pragma unroll
    for (int j = 0; j < 16; j += 2) {
      unsigned w = f2bf(tile[(kq + j) * 65 + nn]) | ((unsigned)f2bf(tile[(kq + j + 1) * 65 + nn]) << 16);
      *(unsigned*)(d + j) = w;
    }
  }
}

__device__ __forceinline__ int w1_srccol(int n0) {
  if (n0 < 512) return n0;
  if (n0 < 1024) return n0 - 512 + 1544;
  if (n0 < 1536) return n0 - 1024 + 4872;
  if (n0 < 2560) return n0 - 1536 + 512;
  if (n0 < 3840) return n0 - 2560 + 2056;
  return n0 - 3840 + 3336;
}

constexpr int CV_W1 = 16 * 84, CV_WO = 24 * 16, CV_WGU = 16 * 88, CV_WD = 44 * 16;
constexpr int CV_LORA = 32;
constexpr int CV_TOTAL = CV_W1 + CV_WO + CV_WGU + CV_WD + CV_LORA;

__device__ __forceinline__ void phase_convert(const Params& p, int l, float* smem) {
  for (int u = BID, nb_ = NBLK; u < CV_TOTAL; u += nb_) {
    if (u < CV_W1) {
      int kt = u % 16, nt = u / 16;
      conv_tile<true>(p.w_in + (long)l * DM * N_IN, N_IN, w1_srccol(nt * 64), p.norm1_w + l * DM, (p.WB + OFF_W1T), 1024, kt * 64,
                nt * 64, smem);
    } else if (u < CV_W1 + CV_WO) {
      int v = u - CV_W1;
      int kt = v % 24, nt = v / 24;
      conv_tile<false>(p.w_out + (long)l * 1536 * DM, DM, nt * 64, nullptr, (p.WB + OFF_WOT), 1536, kt * 64, nt * 64, smem);
    } else if (u < CV_W1 + CV_WO + CV_WGU) {
      int v = u - CV_W1 - CV_WO;
      int kt = v % 16, nt = v / 16;
      const float* wg = p.w_gate + (long)l * DM * D_FF;
      const float* wu = p.w_up + (long)l * DM * D_FF;
      const float* sc = p.norm2_w + l * DM;
      const int tid = opaque_tid();
      __syncthreads();
      {
        int nn = tid & 63, kb = tid >> 6;
        const float* src = (nn < 32) ? wg : wu;
        int col = nt * 32 + (nn & 31);
#pragma unroll
        for (int i = 0; i < 16; ++i) {
          int kk = kb + 4 * i;
          smem[kk * 65 + nn] = src[(long)(kt * 64 + kk) * D_FF + col] * sc[kt * 64 + kk];
        }
      }
      __syncthreads();
      {
        int nn = tid >> 2, kq = (tid & 3) * 16;
        u16* d = (p.WB + OFF_WGU) + wtile_off(nt * 64 + nn, kt * 64 + kq, 1024);
#pragma unroll
        for (int j = 0; j < 16; j += 2) {
          unsigned w = f2bf(smem[(kq + j) * 65 + nn]) | ((unsigned)f2bf(smem[(kq + j + 1) * 65 + nn]) << 16);
          *(unsigned*)(d + j) = w;
        }
      }
    } else if (u >= CV_W1 + CV_WO + CV_WGU + CV_WD) {
      int v = u - (CV_W1 + CV_WO + CV_WGU + CV_WD);
      const int tid = opaque_tid();
#pragma unroll 4
      for (int i = 0; i < 16; ++i) {
        int e = v * 4096 + i * 256 + tid;
        if (e < 32768) {
          int n = e >> 6, k = e & 63;
          (p.WB + OFF_W2T)[e] = f2bf(p.rw_w2[(long)l * 64 * 512 + k * 512 + n]);
        } else if (e < 65536) {
          int e2 = e - 32768, n = e2 >> 6, k = e2 & 63;
          (p.WB + OFF_A2T)[e2] = f2bf(p.rw_a2[(long)l * 64 * 512 + k * 512 + n]);
        } else {
          int e2 = e - 65536, n = e2 >> 7, k = e2 & 127;
          (p.WB + OFF_G2T)[e2] = f2bf(p.rw_g2[(long)l * 128 * 512 + k * 512 + n]);
        }
      }
    } else {
      int v = u - CV_W1 - CV_WO - CV_WGU;
      int kt = v % 44, nt = v / 44;
      conv_tile<false>(p.w_down + (long)l * D_FF * DM, DM, nt * 64, nullptr, (p.WB + OFF_WDT), D_FF, kt * 64, nt * 64, smem);
    }
  }
}

template <bool WITH_DT>
__device__ __forceinline__ void phase_rowstat(const Params& p, int l, float* smem) {
  const int tid = opaque_tid(), lane = tid & 63, wid = tid >> 6;
  float* dtw = smem;
  if (WITH_DT) {
    __syncthreads();
    const float* w = p.w_in + (long)l * DM * N_IN + 1536;
    const float* nw = p.norm1_w + l * DM;
    for (int i = tid; i < 8192; i += 256) {
      int k = i >> 3, h = i & 7;
      dtw[i] = w[(long)k * N_IN + h] * nw[k];
    }
    __syncthreads();
  }
  for (int blk = BID, nb_ = NBLK; blk < NBLK16; blk += nb_) {
    for (int rr = wid; rr < 16; rr += 4) {
      int m = blk * 16 + rr;
      float ss = 0.f;
      float d[8];
#pragma unroll
      for (int h = 0; h < 8; ++h) d[h] = 0.f;
#pragma unroll 1
      for (int j = 0; j < 4; ++j) {
        int k0 = lane * 4 + 256 * j;
        uint2 raw = *(const uint2*)(p.XB + xb_off(m, k0));
        float xs[4] = {bf2f((u16)(raw.x & 0xffff)), bf2f((u16)(raw.x >> 16)), bf2f((u16)(raw.y & 0xffff)),
                       bf2f((u16)(raw.y >> 16))};
#pragma unroll
        for (int e = 0; e < 4; ++e) {
          float x = xs[e];
          ss += x * x;
          if (WITH_DT) {
            float4 w0 = *(const float4*)(dtw + (k0 + e) * 8);
            float4 w1 = *(const float4*)(dtw + (k0 + e) * 8 + 4);
            d[0] += x * w0.x; d[1] += x * w0.y; d[2] += x * w0.z; d[3] += x * w0.w;
            d[4] += x * w1.x; d[5] += x * w1.y; d[6] += x * w1.z; d[7] += x * w1.w;
          }
        }
      }
      ss = sum64(ss);
      float rs = rsqrtf(ss * (1.f / 1024.f) + 1e-6f);
      if (WITH_DT) {
#pragma unroll
        for (int h = 0; h < 8; ++h) d[h] = sum64(d[h]);
        if (lane == 0) {
#pragma unroll
          for (int h = 0; h < 8; ++h) (p.FB + FOFF_DTRAW)[(long)m * 8 + h] = d[h] * rs;
        }
      }
      if (lane == 0) (p.FB + FOFF_RS)[m] = rs;
    }
  }
}

constexpr int G_BK = 32, G_LDS_ROW = 80;
constexpr int G_OPER_BYTES = 128 * G_LDS_ROW;
template <int MODE, bool A_TILED>
__device__ __forceinline__ void phase_gemm(const Params& p, const u16* __restrict__ A, int lda, const u16* __restrict__ Bt, int K,
                           int nN, char* smem) {
  const int tid = opaque_tid(), lane = tid & 63, wid = tid >> 6, wm = wid >> 1, wn = wid & 1;
  const int nM = M_TOT / 128;
  const int ntiles = nM * nN;
  const int nk = K / G_BK;
  const int lrow = tid >> 2, lkc = tid & 3;
  for (int tile = BID, nb_ = NBLK; tile < ntiles; tile += nb_) {
    constexpr int GM = 32;
    int grp = tile / (GM * nN);
    int first_m = grp * GM;
    int gsz = min(GM, nM - first_m);
    int rem = tile - grp * GM * nN;
    int pm = first_m + rem % gsz, pn = rem / gsz;
    const u16* gA = A_TILED ? A + (long)pm * (K >> 5) * 4096 + lrow * 32 + lkc * 8
                            : A + (long)(pm * 128 + lrow) * lda + lkc * 8;
    const u16* gB = Bt + (long)pn * (K >> 5) * 4096 + lrow * 32 + lkc * 8;
    f32x16 acc[2][2];
#pragma unroll
    for (int i = 0; i < 2; ++i)
#pragma unroll
      for (int j = 0; j < 2; ++j)
#pragma unroll
        for (int r = 0; r < 16; ++r) acc[i][j][r] = 0.f;
    uint4 xa0, xa1, xb0, xb1, ya0, ya1, yb0, yb1, za0, za1, zb0, zb1;
#define G_LOAD(S, KT)                                                  \
  {                                                                    \
    S##a0 = *(const uint4*)(A_TILED ? gA + (long)(KT) * 4096 : gA + (KT) * G_BK);                          \
    S##a1 = *(const uint4*)(A_TILED ? gA + (long)(KT) * 4096 + 2048 : gA + (long)64 * lda + (KT) * G_BK);  \
    S##b0 = *(const uint4*)(gB + (long)(KT) * 4096);                   \
    S##b1 = *(const uint4*)(gB + (long)(KT) * 4096 + 2048);            \
  }
#define G_STORE(S, BUF)                                                \
  {                                                                    \
    char* dA = smem + (BUF) * 2 * G_OPER_BYTES;                        \
    char* dB = dA + G_OPER_BYTES;                                      \
    *(uint4*)(dA + lrow * G_LDS_ROW + lkc * 16) = S##a0;               \
    *(uint4*)(dA + (lrow + 64) * G_LDS_ROW + lkc * 16) = S##a1;        \
    *(uint4*)(dB + lrow * G_LDS_ROW + lkc * 16) = S##b0;               \
    *(uint4*)(dB + (lrow + 64) * G_LDS_ROW + lkc * 16) = S##b1;        \
  }
#define G_COMPUTE(BUF)                                                                           \
  {                                                                                              \
    const char* sA = smem + (BUF) * 2 * G_OPER_BYTES;                                            \
    const char* sB = sA + G_OPER_BYTES;                                                          \
    _Pragma("unroll") for (int ks = 0; ks < 2; ++ks) {                                           \
      bf16x8 af[2], bfr[2];                                                                      \
      const int koff = (ks * 16 + (lane >> 5) * 8) * 2;                                          \
      _Pragma("unroll") for (int i = 0; i < 2; ++i)                                              \
        af[i] = *(const bf16x8*)(sA + (wm * 64 + i * 32 + (lane & 31)) * G_LDS_ROW + koff);      \
      _Pragma("unroll") for (int j = 0; j < 2; ++j)                                              \
        bfr[j] = *(const bf16x8*)(sB + (wn * 64 + j * 32 + (lane & 31)) * G_LDS_ROW + koff);     \
      __builtin_amdgcn_s_setprio(1);                                                             \
      _Pragma("unroll") for (int i = 0; i < 2; ++i)                                              \
        _Pragma("unroll") for (int j = 0; j < 2; ++j)                                            \
          acc[i][j] = __builtin_amdgcn_mfma_f32_32x32x16_bf16(af[i], bfr[j], acc[i][j], 0, 0, 0); \
      __builtin_amdgcn_s_setprio(0);                                                             \
    }                                                                                            \
  }
    G_LOAD(x, 0);
    G_LOAD(y, 1);
    G_LOAD(z, 2);
    __builtin_amdgcn_sched_barrier(0);
    __syncthreads();
    G_STORE(x, 0);
    __syncthreads();
#define G_STEP(T, SNEXT, SFREE, BUF)                          \
    if ((T) < nk) {                                           \
      if ((T) + 1 < nk) G_STORE(SNEXT, (BUF) ^ 1);            \
      if ((T) + 3 < nk) G_LOAD(SFREE, (T) + 3);               \
      __builtin_amdgcn_sched_barrier(0);                      \
      G_COMPUTE(BUF);                                         \
      __builtin_amdgcn_sched_barrier(0);                      \
      __syncthreads();                                        \
    }
    for (int kt = 0; kt < nk; kt += 6) {
      G_STEP(kt + 0, y, x, 0);
      G_STEP(kt + 1, z, y, 1);
      G_STEP(kt + 2, x, z, 0);
      G_STEP(kt + 3, y, x, 1);
      G_STEP(kt + 4, z, y, 0);
      G_STEP(kt + 5, x, z, 1);
    }
#undef G_STEP
#undef G_LOAD
#undef G_STORE
#undef G_COMPUTE
    const int colb = pn * 128 + wn * 64 + (lane & 31);
    const int rowb = pm * 128 + wm * 64 + 4 * (lane >> 5);
    if (MODE == 1) {
#pragma unroll
      for (int i = 0; i < 2; ++i)
#pragma unroll
        for (int r = 0; r < 16; ++r) {
          int row = rowb + i * 32 + (r & 3) + 8 * (r >> 2);
          float rs = (p.FB + FOFF_RS)[row];
#pragma unroll
          for (int j = 0; j < 2; ++j) {
            int col = colb + j * 32;
            u16 v = f2bf(acc[i][j][r] * rs);
            p.PROJ[(long)row * LDP + col] = v;
            if ((row & 15) == 15) {
              int jj = -1;
              if (col >= C_R && col < C_GG) jj = col - C_R;
              else if (col >= C_K && col < C_Q) jj = col - C_K + 512;
              if (jj >= 0) p.BND[(long)(row >> 4) * 1792 + jj] = v;
            }
            if ((row & 15) >= 13 && col >= C_XBC + 512 && col < C_XBC + 1024)
              p.BND2[((long)(row >> 4) * 3 + ((row & 15) - 13)) * 512 + (col - (C_XBC + 512))] = v;
          }
        }
    } else if (MODE == 2) {
#pragma unroll
      for (int i = 0; i < 2; ++i)
#pragma unroll
        for (int r = 0; r < 16; ++r) {
          int row = rowb + i * 32 + (r & 3) + 8 * (r >> 2);
#pragma unroll
          for (int j = 0; j < 2; ++j) {
            int col = colb + j * 32;
            u16* px = p.XB + xb_off(row, col);
            *px = f2bf(bf2f(*px) + acc[i][j][r]);
          }
        }
    } else {
      const int cact = pn * 64 + wn * 32 + (lane & 31);
      u16* ACT = p.PROJ;
#pragma unroll
      for (int i = 0; i < 2; ++i)
#pragma unroll
        for (int r = 0; r < 16; ++r) {
          int row = rowb + i * 32 + (r & 3) + 8 * (r >> 2);
          float rs = (p.FB + FOFF_RS)[row];
          float g = acc[i][0][r] * rs, u = acc[i][1][r] * rs;
          ACT[wtile_off(row, cact, D_FF)] = f2bf(siluf_(g) * u);
        }
    }
  }
}

__device__ __forceinline__ void phase_pre(const Params& p, int l, float* smem) {
  u16* XWb = (u16*)smem;
  u16* XAb = (u16*)smem + 16 * 72;
  constexpr int LDW = 260;
  float* AW = smem + 1152;
  float* AA = smem + 1152 + 16 * LDW;
  const float* mu = p.rw_mu + l * 1792;
  for (int blk = BID, nb_ = NBLK; blk < NBLK16; blk += nb_) {
    const int tid = opaque_tid(), lane = tid & 63, wid = tid >> 6;
    const int T = tid >> 4, Q = tid & 15;
    const int m0 = blk * 16;
    const long m = m0 + T;
    int s, t0;
    if (m0 < M_PROMPT) { s = m0 / T_P; t0 = m0 - s * T_P; } else { s = 8 + (m0 - M_PROMPT) / 64; t0 = (m0 - M_PROMPT) & 63; }
    const bool first = (t0 == 0);
    u16* row = p.PROJ + m * LDP;
    const u16* bndrow = p.BND + (long)(blk > 0 ? blk - 1 : 0) * 1792;
    const float* shrow = p.state_shift + ((long)l * 8 + (s >= 8 ? s - 8 : 0)) * 1792;
    const bool seqstart = first && (T == 0);
#define SHIFT8(DST, J, COL)                                                                 \
    {                                                                                       \
      float cur_[8], pv_[8], mj_[8];                                                        \
      unpack8(*(const uint4*)(row + (COL)), cur_);                                          \
      const u16* ps_ = (T > 0) ? (row - LDP + (COL)) : (bndrow + (J));                      \
      unpack8(*(const uint4*)ps_, pv_);                                                     \
      if (seqstart) {                                                                       \
        if (s >= 8) ld8(shrow + (J), pv_);                                                  \
        else { _Pragma("unroll") for (int e = 0; e < 8; ++e) pv_[e] = 0.f; }                \
      }                                                                                     \
      ld8(mu + (J), mj_);                                                                   \
      _Pragma("unroll") for (int e = 0; e < 8; ++e) DST[e] = cur_[e] + (pv_[e] - cur_[e]) * mj_[e]; \
    }
    __syncthreads();
    {
      float sh0[8], sh1[8];
      SHIFT8(sh0, 1536 + Q * 8, C_XW + Q * 8);
      SHIFT8(sh1, 1664 + Q * 8, C_XG + Q * 8);
      __syncthreads();
      if (Q < 8) {
#pragma unroll
        for (int e = 0; e < 8; ++e) sh0[e] = tanhf(sh0[e]);
        *(uint4*)(XWb + T * 72 + Q * 8) = pack8(sh0);
      } else {
        *(uint4*)(XAb + T * 72 + (Q - 8) * 8) = pack8(sh0);
      }
#pragma unroll
      for (int e = 0; e < 8; ++e) sh1[e] = sigmoidf_(sh1[e]);
      *(uint4*)(row + C_XG + Q * 8) = pack8(sh1);
    }
    __syncthreads();
#pragma unroll 1
    for (int c = 0; c < 2; ++c) {
      {
        bf16x8 axw[2], axa[2];
#pragma unroll
        for (int ks = 0; ks < 2; ++ks) {
          axw[ks] = *(const bf16x8*)(XWb + (lane & 15) * 72 + ks * 32 + (lane >> 4) * 8);
          axa[ks] = *(const bf16x8*)(XAb + (lane & 15) * 72 + ks * 32 + (lane >> 4) * 8);
        }
#pragma unroll
        for (int nt = 0; nt < 4; ++nt) {
          const int ncol = (wid * 4 + nt) * 16 + (lane & 15);
          const int n = c * 256 + ncol;
          f32x4v accw = {0.f, 0.f, 0.f, 0.f}, acca = {0.f, 0.f, 0.f, 0.f};
#pragma unroll
          for (int ks = 0; ks < 2; ++ks) {
            bf16x8 bw = *(const bf16x8*)((p.WB + OFF_W2T) + n * 64 + ks * 32 + (lane >> 4) * 8);
            bf16x8 ba = *(const bf16x8*)((p.WB + OFF_A2T) + n * 64 + ks * 32 + (lane >> 4) * 8);
            accw = __builtin_amdgcn_mfma_f32_16x16x32_bf16(axw[ks], bw, accw, 0, 0, 0);
            acca = __builtin_amdgcn_mfma_f32_16x16x32_bf16(axa[ks], ba, acca, 0, 0, 0);
          }
#pragma unroll
          for (int r = 0; r < 4; ++r) {
            AW[((lane >> 4) * 4 + r) * LDW + ncol] = accw[r];
            AA[((lane >> 4) * 4 + r) * LDW + ncol] = acca[r];
          }
        }
      }
#pragma unroll 1
      for (int jj = 0; jj < 2; ++jj) {
        const int ch0 = c * 256 + jj * 128 + Q * 8;
        const int head = c * 4 + jj * 2 + (Q >> 3);
        float rt[8], kt[8];
        uint4 vpk;
        SHIFT8(rt, ch0, C_R + ch0);
        SHIFT8(kt, 512 + ch0, C_K + ch0);
        {
          float vt[8];
          SHIFT8(vt, 1024 + ch0, C_V + ch0);
          vpk = pack8(vt);
        }
        __syncthreads();
        float aw[8], aa[8], w0[8], a0[8];
        ld8(AW + T * LDW + jj * 128 + Q * 8, aw);
        ld8(AA + T * LDW + jj * 128 + Q * 8, aa);
        ld8(p.rw_w0 + l * 512 + ch0, w0);
        ld8(p.rw_a0 + l * 512 + ch0, a0);
        {
          float uu[8];
#pragma unroll
          for (int e = 0; e < 8; ++e) {
            float lw = -softplusf_(-(w0[e] + aw[e])) - 0.5f;
            uu[e] = -__expf(lw);
            aa[e] = sigmoidf_(a0[e] + aa[e]);
          }
          *(uint4*)(p.RWX + m * 1536 + ch0) = pack8(uu);
        }
        *(uint4*)(row + C_R + ch0) = pack8(rt);
        *(uint4*)(row + C_V + ch0) = vpk;
        float kkw[8], kaw[8], rkw[8], kk[8], kp[8];
        ld8(p.rw_kk + l * 512 + ch0, kkw);
        ld8(p.rw_ka + l * 512 + ch0, kaw);
        ld8(p.rw_rk + l * 512 + ch0, rkw);
        float ssq = 0.f, rks = 0.f;
#pragma unroll
        for (int e = 0; e < 8; ++e) {
          kk[e] = kt[e] * kkw[e];
          ssq += kk[e] * kk[e];
          kp[e] = kt[e] * (1.f + (aa[e] - 1.f) * kaw[e]);
          rks += rt[e] * kp[e] * rkw[e];
        }
        ssq = sum8(ssq);
        rks = sum8(rks);
        const float rn = rsqrtf(ssq + 1e-12f);
        *(uint4*)(row + C_K + ch0) = pack8(kp);
#pragma unroll
        for (int e = 0; e < 8; ++e) kk[e] *= rn;
        *(uint4*)(p.RWX + m * 1536 + 512 + ch0) = pack8(kk);
#pragma unroll
        for (int e = 0; e < 8; ++e) kk[e] *= aa[e];
        *(uint4*)(p.RWX + m * 1536 + 1024 + ch0) = pack8(kk);
        if ((Q & 7) == 0) (p.FB + FOFF_RKS)[m * 8 + head] = rks;
      }
      __syncthreads();
    }
    {
      u16* CB = (u16*)(smem + 1152);
      const u16* b2row = p.BND2 + (long)(blk > 0 ? blk - 1 : 0) * 1536;
      const float* scrow = p.state_conv + ((long)l * 8 + (s >= 8 ? s - 8 : 0)) * 3072 + 512;
#pragma unroll 1
      for (int j = 0; j < 4; ++j) {
        const int cc0 = j * 128 + Q * 8;
        const float* cw = p.conv_w + (long)l * 4096 + 512 + cc0;
        float acc[8];
        ld8(p.conv_b + l * 1024 + 512 + cc0, acc);
#pragma unroll
        for (int d = 0; d < 4; ++d) {
          const int tr = T - 3 + d;
          const int trn = tr < 0 ? 3 + tr : 0;
          float u[8], w[8];
          const u16* src = (tr >= 0) ? (row + (long)(d - 3) * LDP + C_XBC + 512 + cc0) : (b2row + trn * 512 + cc0);
          unpack8(*(const uint4*)src, u);
          if (first && tr < 0) {
            if (s >= 8) ld8(scrow + trn * 1024 + cc0, u);
            else {
#pragma unroll
              for (int e = 0; e < 8; ++e) u[e] = 0.f;
            }
          }
          ld8(cw + d * 1024, w);
#pragma unroll
          for (int e = 0; e < 8; ++e) acc[e] += w[e] * u[e];
        }
#pragma unroll
        for (int e = 0; e < 8; ++e) acc[e] = siluf_(acc[e]);
        *(uint4*)(CB + T * 512 + cc0) = pack8(acc);
      }
      __syncthreads();
#pragma unroll
      for (int j = 0; j < 4; ++j)
        *(uint4*)(row + C_XBC + 512 + j * 128 + Q * 8) = *(const uint4*)(CB + T * 512 + j * 128 + Q * 8);
    }
#undef SHIFT8
    if (t0 + 16 == seq_len(s)) {
      float* o = p.out + (s < 8 ? O_PSHIFT + ((long)l * 8 + s) * 1792 : O_SSHIFT + ((long)l * 8 + (s - 8)) * 1792);
      for (int j = tid; j < 1792; j += 256) o[j] = bf2f(p.BND[(long)blk * 1792 + j]);
    }
  }
}

__device__ __forceinline__ void scan_rwkv(const Params& p, int l, int s, int h, int q, float* smem) {
  const int tid = opaque_tid(), lane = tid & 63, wid = tid >> 6;
  float* R_ = smem;
  float* W_ = smem + 1024;
  float* K_ = smem + 2048;
  float* A_ = smem + 3072;
  float* B_ = smem + 4096;
  float* V_ = smem + 5120;
  float* O_ = smem + 5376;
  const int rl = wid * 4 + (lane >> 4);
  const int row = q * 16 + rl;
  const int ksl = (lane & 15) * 4;
  const int base = seq_base(s), T = seq_len(s);
  float s0 = 0.f, s1 = 0.f, s2 = 0.f, s3 = 0.f;
  if (s >= 8) {
    const float* st = p.state_rwkv + (((long)l * 8 + (s - 8)) * 8 + h) * 4096 + row * 64 + ksl;
    float4 v = *(const float4*)st;
    s0 = v.x; s1 = v.y; s2 = v.z; s3 = v.w;
  }
  const int stt = tid >> 4, skq = (tid & 15) * 4;
  const int nblk = T / 16;
  ushort4 r4, k4, u4, a4, b4;
  u16 vv;
  {
    const long m = base + stt;
    const u16* pr = p.PROJ + m * LDP;
    const u16* px = p.RWX + m * 1536;
    r4 = *(const ushort4*)(pr + C_R + h * 64 + skq);
    k4 = *(const ushort4*)(pr + C_K + h * 64 + skq);
    u4 = *(const ushort4*)(px + h * 64 + skq);
    a4 = *(const ushort4*)(px + 512 + h * 64 + skq);
    b4 = *(const ushort4*)(px + 1024 + h * 64 + skq);
    vv = pr[C_V + h * 64 + q * 16 + (tid & 15)];
  }
  __syncthreads();
  float* TR_ = smem + 5376 + 512;
  const bool wr = (lane & 15) == 0;
  const int ooff = wr ? rl : (512 + lane);
  const int ostr = wr ? 16 : 0;
  for (int blk = 0; blk < nblk; ++blk) {
    const long m = base + blk * 16 + stt;
    float* Oc = O_ + (blk & 1) * 256;
    {
      *(float4*)(R_ + stt * 64 + skq) = make_float4(bf2f(r4.x), bf2f(r4.y), bf2f(r4.z), bf2f(r4.w));
      *(float4*)(K_ + stt * 64 + skq) = make_float4(bf2f(k4.x), bf2f(k4.y), bf2f(k4.z), bf2f(k4.w));
      *(float4*)(W_ + stt * 64 + skq) =
          make_float4(__expf(bf2f(u4.x)), __expf(bf2f(u4.y)), __expf(bf2f(u4.z)), __expf(bf2f(u4.w)));
      *(float4*)(A_ + stt * 64 + skq) = make_float4(-bf2f(a4.x), -bf2f(a4.y), -bf2f(a4.z), -bf2f(a4.w));
      *(float4*)(B_ + stt * 64 + skq) = make_float4(bf2f(b4.x), bf2f(b4.y), bf2f(b4.z), bf2f(b4.w));
      V_[stt * 16 + (tid & 15)] = bf2f(vv);
    }
    __syncthreads();
    if (blk > 0)
      p.ORW[(m - 16) * 512 + h * 64 + q * 16 + (tid & 15)] = f2bf(O_[((blk - 1) & 1) * 256 + stt * 16 + (tid & 15)]);
    if (blk + 1 < nblk) {
      const u16* pr = p.PROJ + (m + 16) * LDP;
      const u16* px = p.RWX + (m + 16) * 1536;
      r4 = *(const ushort4*)(pr + C_R + h * 64 + skq);
      k4 = *(const ushort4*)(pr + C_K + h * 64 + skq);
      u4 = *(const ushort4*)(px + h * 64 + skq);
      a4 = *(const ushort4*)(px + 512 + h * 64 + skq);
      b4 = *(const ushort4*)(px + 1024 + h * 64 + skq);
      vv = pr[C_V + h * 64 + q * 16 + (tid & 15)];
    }
    __builtin_amdgcn_sched_barrier(0);
    {
      float4 a = *(const float4*)(A_ + ksl), w = *(const float4*)(W_ + ksl), b = *(const float4*)(B_ + ksl);
      float4 k = *(const float4*)(K_ + ksl), r = *(const float4*)(R_ + ksl);
      float v = V_[rl];
      float opart = 0.f;
#pragma unroll
      for (int tt = 0; tt < 16; ++tt) {
        float4 an, wn, bn, kn, rn;
        float vn;
        if (tt + 1 < 16) {
          an = *(const float4*)(A_ + (tt + 1) * 64 + ksl); wn = *(const float4*)(W_ + (tt + 1) * 64 + ksl);
          bn = *(const float4*)(B_ + (tt + 1) * 64 + ksl); kn = *(const float4*)(K_ + (tt + 1) * 64 + ksl);
          rn = *(const float4*)(R_ + (tt + 1) * 64 + ksl); vn = V_[(tt + 1) * 16 + rl];
        }
        __builtin_amdgcn_sched_barrier(0);
        float sa = fmaf(s0, a.x, fmaf(s1, a.y, fmaf(s2, a.z, s3 * a.w)));
        if (tt > 0) { sum16x2(sa, opart); Oc[ooff + (tt - 1) * ostr] = opart; }
        else sa = sum16(sa);
        s0 = fmaf(s0, w.x, fmaf(sa, b.x, v * k.x)); NOPK(s0);
        s1 = fmaf(s1, w.y, fmaf(sa, b.y, v * k.y)); NOPK(s1);
        s2 = fmaf(s2, w.z, fmaf(sa, b.z, v * k.z)); NOPK(s2);
        s3 = fmaf(s3, w.w, fmaf(sa, b.w, v * k.w)); NOPK(s3);
        opart = fmaf(s0, r.x, fmaf(s1, r.y, fmaf(s2, r.z, s3 * r.w)));
        if (tt == 15) { opart = sum16(opart); Oc[ooff + 15 * ostr] = opart; }
        __builtin_amdgcn_sched_barrier(0);
        if (tt + 1 < 16) { a = an; w = wn; b = bn; k = kn; r = rn; v = vn; }
      }
    }
    __builtin_amdgcn_sched_barrier(0);
    __syncthreads();
  }
  {
    const long m = base + (nblk - 1) * 16 + stt;
    p.ORW[m * 512 + h * 64 + q * 16 + (tid & 15)] = f2bf(O_[((nblk - 1) & 1) * 256 + stt * 16 + (tid & 15)]);
  }
  __syncthreads();
  {
    float* o = p.out + (s < 8 ? O_PRWKV + (((long)l * 8 + s) * 8 + h) * 4096
                              : O_SRWKV + (((long)l * 8 + (s - 8)) * 8 + h) * 4096);
    *(float4*)(o + row * 64 + ksl) = make_float4(s0, s1, s2, s3);
  }
}

__device__ __forceinline__ void scan_hgrn(const Params& p, int l, int s, int h, int q, float* smem) {
  const int tid = opaque_tid(), lane = tid & 63, wid = tid >> 6;
  float* Q_ = smem;
  float* F_ = smem + 2048;
  float* G_ = smem + 4096;
  float* I_ = smem + 6144;
  float* O_ = smem + 6400;
  const int rl = wid * 4 + (lane >> 4);
  const int row = q * 16 + rl;
  const int ksl4 = (lane & 15) * 4;
  const int base = seq_base(s), T = seq_len(s);
  float st[8];
#pragma unroll
  for (int i = 0; i < 8; ++i) st[i] = 0.f;
  if (s >= 8) {
    const float* sp = p.state_hgrn + (((long)l * 8 + (s - 8)) * 4 + h) * 16384;
#pragma unroll
    for (int i = 0; i < 8; ++i) st[i] = sp[((i >> 2) * 64 + ksl4 + (i & 3)) * 128 + row];
  }
  const int stt = tid >> 4, skq = (tid & 15) * 8;
  float lb[8];
#pragma unroll
  for (int i = 0; i < 8; ++i) {
    if (l == 0) lb[i] = 0.f;
    else {
      float x0 = p.hg_lb[h * 128 + skq + i], x1 = p.hg_lb[512 + h * 128 + skq + i];
      lb[i] = frcp_(1.f + __expf(x0 - x1));
    }
  }
  const int nblk = T / 16;
  uint4 q8, f8;
  u16 iv16;
  {
    const u16* pr = p.PROJ + (long)(base + stt) * LDP;
    q8 = *(const uint4*)(pr + C_Q + h * 128 + skq);
    f8 = *(const uint4*)(pr + C_F + h * 128 + skq);
    iv16 = pr[C_I + h * 128 + q * 16 + (tid & 15)];
  }
  __syncthreads();
  float* TR_ = smem + 6400 + 512;
  const bool wr = (lane & 15) == 0;
  const int ooff = wr ? rl : (512 + lane);
  const int ostr = wr ? 16 : 0;
  for (int blk = 0; blk < nblk; ++blk) {
    const long m = base + blk * 16 + stt;
    float* Oc = O_ + (blk & 1) * 256;
    {
      unsigned qw[4] = {q8.x, q8.y, q8.z, q8.w}, fw[4] = {f8.x, f8.y, f8.z, f8.w};
      float qv[8], fv[8];
#pragma unroll
      for (int e = 0; e < 8; ++e) {
        qv[e] = bf2f((u16)((qw[e >> 1] >> ((e & 1) * 16)) & 0xffff));
        float fz = bf2f((u16)((fw[e >> 1] >> ((e & 1) * 16)) & 0xffff));
        float ex = __expf(-fz);
        float sg = frcp_(1.f + ex);
        fv[e] = lb[e] + (1.f - lb[e]) * sg;
      }
      *(float4*)(Q_ + stt * 128 + skq) = make_float4(qv[0], qv[1], qv[2], qv[3]);
      *(float4*)(Q_ + stt * 128 + skq + 4) = make_float4(qv[4], qv[5], qv[6], qv[7]);
      *(float4*)(F_ + stt * 128 + skq) = make_float4(fv[0], fv[1], fv[2], fv[3]);
      *(float4*)(F_ + stt * 128 + skq + 4) = make_float4(fv[4], fv[5], fv[6], fv[7]);
      I_[stt * 16 + (tid & 15)] = bf2f(iv16);
    }
    __syncthreads();
    if (blk > 0) {
      u16* dp = p.PROJ + (m - 16) * LDP + C_I + h * 128 + q * 16 + (tid & 15);
      *dp = f2bf(O_[((blk - 1) & 1) * 256 + stt * 16 + (tid & 15)]);
    }
    if (blk + 1 < nblk) {
      const u16* pr = p.PROJ + (m + 16) * LDP;
      q8 = *(const uint4*)(pr + C_Q + h * 128 + skq);
      f8 = *(const uint4*)(pr + C_F + h * 128 + skq);
      iv16 = pr[C_I + h * 128 + q * 16 + (tid & 15)];
    }
    __builtin_amdgcn_sched_barrier(0);
    {
      float4 f0 = *(const float4*)(F_ + ksl4), f1 = *(const float4*)(F_ + 64 + ksl4);
      float4 q0 = *(const float4*)(Q_ + ksl4), q1 = *(const float4*)(Q_ + 64 + ksl4);
      float iv = I_[rl];
      float oprev = 0.f;
#pragma unroll
      for (int tt = 0; tt < 16; ++tt) {
        float4 f0n, f1n, q0n, q1n;
        float ivn;
        if (tt + 1 < 16) {
          const int o_ = (tt + 1) * 128;
          f0n = *(const float4*)(F_ + o_ + ksl4); f1n = *(const float4*)(F_ + o_ + 64 + ksl4);
          q0n = *(const float4*)(Q_ + o_ + ksl4); q1n = *(const float4*)(Q_ + o_ + 64 + ksl4);
          ivn = I_[(tt + 1) * 16 + rl];
        }
        __builtin_amdgcn_sched_barrier(0);
        st[0] = fmaf(st[0] - iv, f0.x, iv); NOPK(st[0]);
        st[1] = fmaf(st[1] - iv, f0.y, iv); NOPK(st[1]);
        st[2] = fmaf(st[2] - iv, f0.z, iv); NOPK(st[2]);
        st[3] = fmaf(st[3] - iv, f0.w, iv); NOPK(st[3]);
        st[4] = fmaf(st[4] - iv, f1.x, iv); NOPK(st[4]);
        st[5] = fmaf(st[5] - iv, f1.y, iv); NOPK(st[5]);
        st[6] = fmaf(st[6] - iv, f1.z, iv); NOPK(st[6]);
        st[7] = fmaf(st[7] - iv, f1.w, iv); NOPK(st[7]);
        float acc0 = fmaf(st[0], q0.x, fmaf(st[1], q0.y, fmaf(st[2], q0.z, st[3] * q0.w)));
        float acc1 = fmaf(st[4], q1.x, fmaf(st[5], q1.y, fmaf(st[6], q1.z, st[7] * q1.w)));
        float o = acc0 + acc1;
        if (tt & 1) { sum16x2(oprev, o); Oc[ooff + (tt - 1) * ostr] = oprev; Oc[ooff + tt * ostr] = o; }
        else oprev = o;
        __builtin_amdgcn_sched_barrier(0);
        if (tt + 1 < 16) { f0 = f0n; f1 = f1n; q0 = q0n; q1 = q1n; iv = ivn; }
      }
    }
    __builtin_amdgcn_sched_barrier(0);
    __syncthreads();
  }
  {
    const long m = base + (nblk - 1) * 16 + stt;
    u16* dp = p.PROJ + m * LDP + C_I + h * 128 + q * 16 + (tid & 15);
    *dp = f2bf(O_[((nblk - 1) & 1) * 256 + stt * 16 + (tid & 15)]);
  }
  __syncthreads();
  {
    float* o = p.out + (s < 8 ? O_PHGRN + (((long)l * 8 + s) * 4 + h) * 16384
                              : O_SHGRN + (((long)l * 8 + (s - 8)) * 4 + h) * 16384);
#pragma unroll
    for (int i = 0; i < 8; ++i) o[((i >> 2) * 64 + ksl4 + (i & 3)) * 128 + row] = st[i];
  }
}

__device__ __forceinline__ void scan_ssd(const Params& p, int l, int s, int h, int q, float* smem) {
  const int tid = opaque_tid(), lane = tid & 63, wid = tid >> 6;
  float* B_ = smem;
  float* C_ = smem + 2048;
  float* X_ = smem + 4096;
  float* O_ = smem + 4352;
  float* DT_ = smem + 5200;
  float* DE_ = smem + 5216;
  const int rl = wid * 4 + (lane >> 4);
  const int row = q * 16 + rl;
  const int ksl4 = (lane & 15) * 4;
  const int g = h >> 2;
  const int base = seq_base(s), T = seq_len(s);
  float st[8];
#pragma unroll
  for (int i = 0; i < 8; ++i) st[i] = 0.f;
  if (s >= 8) {
    const float* sp = p.state_ssm + (((long)l * 8 + (s - 8)) * 8 + h) * 8192 + row * 128 + ksl4;
    float4 a = *(const float4*)sp, b = *(const float4*)(sp + 64);
    st[0] = a.x; st[1] = a.y; st[2] = a.z; st[3] = a.w; st[4] = b.x; st[5] = b.y; st[6] = b.z; st[7] = b.w;
  }
  const float* cw = p.conv_w + (long)l * 4 * 1024;
  const int skq8 = (tid & 15) * 8;
  const int xc_x = h * 64 + q * 16 + (tid & 15);
  const float cx0 = cw[xc_x], cx1 = cw[1024 + xc_x], cx2 = cw[2048 + xc_x], cx3 = cw[3072 + xc_x];
  const float cxb = p.conv_b[l * 1024 + xc_x];
  const float dtb = p.dt_bias[l * 8 + h];
  const float aexp = __expf(p.a_log[l * 8 + h]);
  const float dsk = p.d_skip[l * 8 + h];
  const int stt = tid >> 4;
  const int nblk = T / 16;
  uint4 rawb, rawc;
  float xr[4];
  float dtr = 0.f;
  u16 zc = 0, zn = 0;
#define SSD_LOAD(M0)                                                              \
  {                                                                               \
    {                                                                             \
      const u16* prow = p.PROJ + ((long)(M0) + stt) * LDP + C_XBC + g * 128 + skq8; \
      rawb = *(const uint4*)(prow + 512);                                         \
      rawc = *(const uint4*)(prow + 768);                                         \
    }                                                                             \
    {                                                                             \
      const long mr = (long)(M0) + stt;                                           \
      const u16* colx = p.PROJ + mr * LDP + C_XBC + xc_x;                         \
      _Pragma("unroll") for (int j = 0; j < 4; ++j) {                             \
        const long mm = mr - 3 + j;                                               \
        float vx;                                                                 \
        if (mm >= base) vx = bf2f(colx[(long)(j - 3) * LDP]);                     \
        else vx = (s >= 8) ? p.state_conv[((long)l * 8 + (s - 8)) * 3072 + (3 + (int)(mm - base)) * 1024 + xc_x] : 0.f; \
        xr[j] = vx;                                                               \
      }                                                                           \
    }                                                                             \
    if (tid < 16) dtr = (p.FB + FOFF_DTRAW)[((long)(M0) + tid) * 8 + h];                      \
    zn = p.PROJ[((long)(M0) + stt) * LDP + C_Z + h * 64 + q * 16 + (tid & 15)];   \
  }
  SSD_LOAD(base);
  __syncthreads();
  const bool wr = (lane & 15) == 0;
  const int ooff = wr ? rl : (512 + lane);
  const int ostr = wr ? 16 : 0;
  u16 zp = 0;
  for (int blk = 0; blk < nblk; ++blk) {
    const long m0 = base + blk * 16;
    zp = zc;
    zc = zn;
    float* Oc = O_ + (blk & 1) * 256;
    {
      {
        const unsigned bw[4] = {rawb.x, rawb.y, rawb.z, rawb.w}, cwd[4] = {rawc.x, rawc.y, rawc.z, rawc.w};
        float bv[8], cv[8];
#pragma unroll
        for (int e = 0; e < 8; ++e) {
          bv[e] = bf2f((u16)((bw[e >> 1] >> ((e & 1) * 16)) & 0xffff));
          cv[e] = bf2f((u16)((cwd[e >> 1] >> ((e & 1) * 16)) & 0xffff));
        }
        *(float4*)(B_ + stt * 128 + skq8) = make_float4(bv[0], bv[1], bv[2], bv[3]);
        *(float4*)(B_ + stt * 128 + skq8 + 4) = make_float4(bv[4], bv[5], bv[6], bv[7]);
        *(float4*)(C_ + stt * 128 + skq8) = make_float4(cv[0], cv[1], cv[2], cv[3]);
        *(float4*)(C_ + stt * 128 + skq8 + 4) = make_float4(cv[4], cv[5], cv[6], cv[7]);
      }
      {
        float y = cx0 * xr[0] + cx1 * xr[1] + cx2 * xr[2] + cx3 * xr[3] + cxb;
        X_[stt * 16 + (tid & 15)] = siluf_(y);
      }
      if (tid < 16) {
        float dtv = softplusf_(dtr + dtb);
        DT_[tid] = dtv;
        DE_[tid] = __expf(-aexp * dtv);
      }
    }
    __syncthreads();
    if (blk > 0) {
      u16* pz = p.PROJ + (m0 - 16 + stt) * LDP + C_Z + h * 64 + q * 16 + (tid & 15);
      *pz = f2bf(O_[((blk - 1) & 1) * 256 + stt * 16 + (tid & 15)] * siluf_(bf2f(zp)));
    }
    if (blk + 1 < nblk) SSD_LOAD(m0 + 16);
    __builtin_amdgcn_sched_barrier(0);
    {
      float4 b0 = *(const float4*)(B_ + ksl4), b1 = *(const float4*)(B_ + 64 + ksl4);
      float4 c0 = *(const float4*)(C_ + ksl4), c1 = *(const float4*)(C_ + 64 + ksl4);
      float xv = X_[rl], dt = DT_[0], de = DE_[0];
      float yprev = 0.f, xvprev = 0.f;
#pragma unroll
      for (int tt = 0; tt < 16; ++tt) {
        float4 b0n, b1n, c0n, c1n;
        float xvn, dtn, den;
        if (tt + 1 < 16) {
          const int o_ = (tt + 1) * 128;
          b0n = *(const float4*)(B_ + o_ + ksl4); b1n = *(const float4*)(B_ + o_ + 64 + ksl4);
          c0n = *(const float4*)(C_ + o_ + ksl4); c1n = *(const float4*)(C_ + o_ + 64 + ksl4);
          xvn = X_[(tt + 1) * 16 + rl]; dtn = DT_[tt + 1]; den = DE_[tt + 1];
        }
        __builtin_amdgcn_sched_barrier(0);
        const float xd = xv * dt;
        st[0] = fmaf(st[0], de, xd * b0.x); NOPK(st[0]);
        st[1] = fmaf(st[1], de, xd * b0.y); NOPK(st[1]);
        st[2] = fmaf(st[2], de, xd * b0.z); NOPK(st[2]);
        st[3] = fmaf(st[3], de, xd * b0.w); NOPK(st[3]);
        st[4] = fmaf(st[4], de, xd * b1.x); NOPK(st[4]);
        st[5] = fmaf(st[5], de, xd * b1.y); NOPK(st[5]);
        st[6] = fmaf(st[6], de, xd * b1.z); NOPK(st[6]);
        st[7] = fmaf(st[7], de, xd * b1.w); NOPK(st[7]);
        float acc0 = fmaf(st[0], c0.x, fmaf(st[1], c0.y, fmaf(st[2], c0.z, st[3] * c0.w)));
        float acc1 = fmaf(st[4], c1.x, fmaf(st[5], c1.y, fmaf(st[6], c1.z, st[7] * c1.w)));
        float y = acc0 + acc1;
        if (tt & 1) { sum16x2(yprev, y); Oc[ooff + (tt - 1) * ostr] = yprev + dsk * xvprev; Oc[ooff + tt * ostr] = y + dsk * xv; }
        else { yprev = y; xvprev = xv; }
        __builtin_amdgcn_sched_barrier(0);
        if (tt + 1 < 16) { b0 = b0n; b1 = b1n; c0 = c0n; c1 = c1n; xv = xvn; dt = dtn; de = den; }
      }
    }
    __builtin_amdgcn_sched_barrier(0);
    __syncthreads();
  }
  {
    const long m0 = base + (nblk - 1) * 16;
    u16* pz = p.PROJ + (m0 + stt) * LDP + C_Z + h * 64 + q * 16 + (tid & 15);
    *pz = f2bf(O_[((nblk - 1) & 1) * 256 + stt * 16 + (tid & 15)] * siluf_(bf2f(zc)));
  }
  __syncthreads();
#undef SSD_LOAD
  {
    float* o = p.out + (s < 8 ? O_PSSM + (((long)l * 8 + s) * 8 + h) * 8192
                              : O_SSSM + (((long)l * 8 + (s - 8)) * 8 + h) * 8192);
    *(float4*)(o + row * 128 + ksl4) = make_float4(st[0], st[1], st[2], st[3]);
    *(float4*)(o + row * 128 + 64 + ksl4) = make_float4(st[4], st[5], st[6], st[7]);
  }
  if (h == 0 && q == 0) {
    float* o = p.out + (s < 8 ? O_PCONV + ((long)l * 8 + s) * 3072 : O_SCONV + ((long)l * 8 + (s - 8)) * 3072);
    const long lastblk = (long)(base + T) / 16 - 1;
    for (int i = tid; i < 3072; i += 256) {
      int r = i >> 10, c = i & 1023;
      o[i] = (c < 512) ? bf2f(p.PROJ[(long)(base + T - 3 + r) * LDP + C_XBC + c])
                       : bf2f(p.BND2[(lastblk * 3 + r) * 512 + (c - 512)]);
    }
  }
}

__device__ __forceinline__ void phase_scan(const Params& p, int l, float* smem) {
  for (int u = BID, nb_ = NBLK; u < 1536; u += nb_) {
    int sample = u >= 768;
    int v = sample ? u - 768 : u;
    int type = v % 3, w = v / 3;
    if (type == 0) {
      int q = w & 3, h = (w >> 2) & 7, b = w >> 5;
      scan_rwkv(p, l, b + 8 * sample, h, q, smem);
    } else if (type == 1) {
      int q = w & 7, h = (w >> 3) & 3, b = w >> 5;
      scan_hgrn(p, l, b + 8 * sample, h, q, smem);
    } else {
      int q = w & 3, h = (w >> 2) & 7, b = w >> 5;
      scan_ssd(p, l, b + 8 * sample, h, q, smem);
    }
  }
}

__device__ __forceinline__ void phase_post(const Params& p, int l, float* smem) {
  constexpr int LDG = 516;
  float* GA = smem;
  for (int blk = BID, nb_ = NBLK; blk < NBLK16; blk += nb_) {
    const int tid = opaque_tid(), lane = tid & 63, wid = tid >> 6;
    const int T = tid >> 4, Q = tid & 15;
    const long m0 = (long)blk * 16;
    const long m = m0 + T;
    __syncthreads();
    {
      bf16x8 ag[4];
      const u16* arow = p.PROJ + (m0 + (lane & 15)) * LDP + C_XG + (lane >> 4) * 8;
#pragma unroll
      for (int ks = 0; ks < 4; ++ks) ag[ks] = *(const bf16x8*)(arow + ks * 32);
#pragma unroll
      for (int nt = 0; nt < 8; ++nt) {
        const int n = (wid * 8 + nt) * 16 + (lane & 15);
        f32x4v acc = {0.f, 0.f, 0.f, 0.f};
#pragma unroll
        for (int ks = 0; ks < 4; ++ks) {
          bf16x8 bg = *(const bf16x8*)((p.WB + OFF_G2T) + n * 128 + ks * 32 + (lane >> 4) * 8);
          acc = __builtin_amdgcn_mfma_f32_16x16x32_bf16(ag[ks], bg, acc, 0, 0, 0);
        }
#pragma unroll
        for (int r = 0; r < 4; ++r) GA[((lane >> 4) * 4 + r) * LDG + n] = acc[r];
      }
    }
    __syncthreads();
    u16* row = p.PROJ + m * LDP;
#pragma unroll 1
    for (int g = 0; g < 2; ++g) {
      float y0[8], y1[8], w[8];
      const int c0 = g * 256 + Q * 8, c1 = c0 + 128;
      unpack8(*(const uint4*)(row + C_Z + c0), y0);
      unpack8(*(const uint4*)(row + C_Z + c1), y1);
      float ss = 0.f;
#pragma unroll
      for (int e = 0; e < 8; ++e) ss += y0[e] * y0[e] + y1[e] * y1[e];
      ss = sum16(ss);
      const float rs = rsqrtf(ss * (1.f / 256.f) + 1e-6f);
      ld8(p.ssd_norm_w + l * 512 + c0, w);
#pragma unroll
      for (int e = 0; e < 8; ++e) y0[e] = y0[e] * rs * w[e];
      ld8(p.ssd_norm_w + l * 512 + c1, w);
#pragma unroll
      for (int e = 0; e < 8; ++e) y1[e] = y1[e] * rs * w[e];
      *(uint4*)(row + C_Z + c0) = pack8(y0);
      *(uint4*)(row + C_Z + c1) = pack8(y1);
    }
#pragma unroll 1
    for (int j = 0; j < 4; ++j) {
      const int c0 = j * 128 + Q * 8;
      {
        float oh[8], gg[8], w[8];
        unpack8(*(const uint4*)(row + C_I + c0), oh);
        unpack8(*(const uint4*)(row + C_GG + c0), gg);
        float ss = 0.f;
#pragma unroll
        for (int e = 0; e < 8; ++e) ss += oh[e] * oh[e];
        ss = sum16(ss);
        const float rs = rsqrtf(ss * (1.f / 128.f) + 1e-6f);
        ld8(p.hg_norm_w + l * 512 + c0, w);
#pragma unroll
        for (int e = 0; e < 8; ++e) oh[e] = oh[e] * rs * w[e] * siluf_(gg[e]);
        *(uint4*)(row + C_GG + c0) = pack8(oh);
      }
      {
        float o[8], v[8], w[8], bb[8], ga[8];
        const int head = j * 2 + (Q >> 3);
        unpack8(*(const uint4*)(p.ORW + m * 512 + c0), o);
        unpack8(*(const uint4*)(row + C_V + c0), v);
        float sm = 0.f;
#pragma unroll
        for (int e = 0; e < 8; ++e) sm += o[e];
        const float mean = sum8(sm) * (1.f / 64.f);
        float sv = 0.f;
#pragma unroll
        for (int e = 0; e < 8; ++e) { o[e] -= mean; sv += o[e] * o[e]; }
        const float rstd = rsqrtf(sum8(sv) * (1.f / 64.f) + 64e-5f);
        const float rks = (p.FB + FOFF_RKS)[m * 8 + head];
        ld8(p.rw_lnx_w + l * 512 + c0, w);
        ld8(p.rw_lnx_b + l * 512 + c0, bb);
        ld8(GA + T * LDG + c0, ga);
#pragma unroll
        for (int e = 0; e < 8; ++e) o[e] = (o[e] * rstd * w[e] + bb[e] + rks * v[e]) * ga[e];
        *(uint4*)(row + C_R + c0) = pack8(o);
      }
    }
  }
}

__device__ __forceinline__ void phase_final(const Params& p) {
  const int tid = opaque_tid(), lane = tid & 63, wid = tid >> 6;
  for (int m = BID * 4 + wid, nb_ = NBLK; m < M_TOT; m += nb_ * 4) {
    float* dst;
    if (m < M_PROMPT) {
      int b = m / T_P, t = m - b * T_P;
      if (t < 16) continue;
      dst = p.out + O_YP + ((long)b * 4096 + (t - 16)) * DM;
    } else {
      dst = p.out + O_YS + (long)(m - M_PROMPT) * DM;
    }
    float x[16];
    float ss = 0.f;
#pragma unroll
    for (int j = 0; j < 2; ++j) {
      uint4 raw = *(const uint4*)(p.XB + xb_off(m, lane * 8 + 512 * j));
      unsigned wv[4] = {raw.x, raw.y, raw.z, raw.w};
#pragma unroll
      for (int e = 0; e < 8; ++e) {
        x[j * 8 + e] = bf2f((u16)((wv[e >> 1] >> ((e & 1) * 16)) & 0xffff));
        ss += x[j * 8 + e] * x[j * 8 + e];
      }
    }
    ss = sum64(ss);
    float rs = rsqrtf(ss * (1.f / 1024.f) + 1e-6f);
#pragma unroll
    for (int j = 0; j < 2; ++j) {
      int k0 = lane * 8 + 512 * j;
      float4 w0 = *(const float4*)(p.final_w + k0), w1 = *(const float4*)(p.final_w + k0 + 4);
      *(float4*)(dst + k0) = make_float4(x[j * 8 + 0] * rs * w0.x, x[j * 8 + 1] * rs * w0.y, x[j * 8 + 2] * rs * w0.z,
                                         x[j * 8 + 3] * rs * w0.w);
      *(float4*)(dst + k0 + 4) = make_float4(x[j * 8 + 4] * rs * w1.x, x[j * 8 + 5] * rs * w1.y,
                                             x[j * 8 + 6] * rs * w1.z, x[j * 8 + 7] * rs * w1.w);
    }
  }
}


#define XB_TMO      128
#define XB_XCNT(j)  (256  + 64 * (j))
#define XB_XSUB(j)  (1280 + 64 * (j))
#define XB_XGEN(j)  (2304 + 64 * (j))
#define XB_TOP      3328
#define XB_TOPGEN   3392
#define XCD_BAR_WORDS 3456
#define XB_SPIN_CAP (1u << 22)
__device__ __forceinline__ unsigned xb_ld(unsigned* p) { return __hip_atomic_load(p, __ATOMIC_RELAXED, __HIP_MEMORY_SCOPE_AGENT); }
__device__ __forceinline__ unsigned xb_add(unsigned* p, unsigned v) { return __hip_atomic_fetch_add(p, v, __ATOMIC_RELAXED, __HIP_MEMORY_SCOPE_AGENT); }
__device__ __forceinline__ unsigned xb_xcc_id() { return (unsigned)__builtin_amdgcn_s_getreg((3 << 11) | 20) & 0xFu; }
#define XB_SPIN(cond, bar) do { unsigned _sp = 0; while (cond) { __builtin_amdgcn_s_sleep(1); \
    if ((++_sp & 255u) == 0u) { if (xb_ld(&(bar)[XB_TMO])) break; if (_sp > XB_SPIN_CAP) { atomicAdd(&(bar)[XB_TMO], 1u); break; } } } } while (0)

__device__ __forceinline__ void xcd_barrier_post(unsigned* bar) {
  if (threadIdx.x == 0) (void)xb_add(&bar[XB_XCNT(xb_xcc_id())], 1u);
}
__device__ __forceinline__ void xcd_barrier_complete(unsigned* bar, unsigned x, unsigned& nloc, unsigned& nx) {
  const unsigned G = gridDim.x;
  unsigned sum, cnt, mine, sp = 0u;
  for (;;) {
    sum = 0u; cnt = 0u; mine = 0u;
#pragma unroll
    for (unsigned j = 0; j < 16; ++j) { const unsigned c = xb_ld(&bar[XB_XCNT(j)]); sum += c; cnt += (c > 0u) ? 1u : 0u; mine = (j == x) ? c : mine; }
    if (sum == G) break;
    __builtin_amdgcn_s_sleep(1);
    if ((++sp & 255u) == 0u) { if (xb_ld(&bar[XB_TMO])) break; if (sp > XB_SPIN_CAP) { atomicAdd(&bar[XB_TMO], 1u); break; } }
  }
  nloc = mine > 0u ? mine : 1u; nx = cnt > 0u ? cnt : 1u;
}
__device__ __forceinline__ void xcd_barrier(unsigned* bar, volatile unsigned* st) {
  asm volatile("s_waitcnt vmcnt(0)" ::: "memory");
  __syncthreads();
  if (threadIdx.x == 0) {
    __builtin_amdgcn_s_waitcnt(0);
    const unsigned x = xb_xcc_id();
    unsigned nloc = st[0], nx = st[1];
    if (nloc == 0u) { xcd_barrier_complete(bar, x, nloc, nx); st[0] = nloc; st[1] = nx; }
    const unsigned old = xb_add(&bar[XB_XSUB(x)], 1u);
    const unsigned gen = old / nloc;
    if (old + 1u == (gen + 1u) * nloc) {
      __builtin_amdgcn_fence(__ATOMIC_RELEASE, "agent");
      asm volatile("s_waitcnt vmcnt(0)" ::: "memory");
      const unsigned og = xb_add(&bar[XB_TOP], 1u);
      const unsigned tg = og / nx;
      if (og + 1u == (tg + 1u) * nx) xb_add(&bar[XB_TOPGEN], 1u);
      else XB_SPIN(xb_ld(&bar[XB_TOPGEN]) == tg, bar);
      __builtin_amdgcn_fence(__ATOMIC_ACQUIRE, "agent");
      xb_add(&bar[XB_XGEN(x)], 1u);
      asm volatile("s_waitcnt vmcnt(0)" ::: "memory");
    } else {
      XB_SPIN(xb_ld(&bar[XB_XGEN(x)]) == gen, bar);
      __builtin_amdgcn_fence(__ATOMIC_ACQUIRE, "agent");
      asm volatile("s_waitcnt vmcnt(0)" ::: "memory");
    }
  }
  __syncthreads();
}

constexpr int SMEM_BYTES = 40960;
__device__ __forceinline__ void run_phase(const Params& p, int ph, char* smem) {
  if (ph == 0) { phase_embed(p); return; }
  if (ph == 19) { phase_final(p); return; }
  int l = (ph - 1) / 9, s = (ph - 1) % 9;
  float* fs = (float*)smem;
  switch (s) {
    case 0: phase_convert(p, l, fs); phase_rowstat<true>(p, l, fs); break;
    case 1: phase_gemm<1, true>(p, p.XB, DM, (p.WB + OFF_W1T), 1024, LDP / 128, smem); break;
    case 2: phase_pre(p, l, fs); break;
    case 3: phase_scan(p, l, fs); break;
    case 4: phase_post(p, l, fs); break;
    case 5: phase_gemm<2, false>(p, p.PROJ, LDP, (p.WB + OFF_WOT), 1536, 8, smem); break;
    case 6: phase_rowstat<false>(p, l, fs); break;
    case 7: phase_gemm<3, true>(p, p.XB, DM, (p.WB + OFF_WGU), 1024, 44, smem); break;
    case 8: phase_gemm<2, true>(p, p.PROJ, D_FF, (p.WB + OFF_WDT), D_FF, 8, smem); break;
  }
}
constexpr int N_PHASES = 20;

#if MEGA
__global__ void __launch_bounds__(256, 3) k_mega(Params p) {
  __shared__ __attribute__((aligned(16))) char smem[SMEM_BYTES];
  __shared__ uint4 xb_words;
  if (threadIdx.x == 0) { xb_words = make_uint4(0u, 0u, 0u, 0u); }
  __syncthreads();
  cg::grid_group grid = cg::this_grid();
  float* fs = (float*)smem;
  volatile unsigned* xst = (volatile unsigned*)&xb_words;
  xcd_barrier_post(p.bar);
  phase_embed(p);
  grid.sync();
#define GSYNC() do { unsigned* b_ = p.bar; asm volatile("" : "+s"(b_)); xcd_barrier(b_, xst); } while (0)
  {
    const int L0_ = 0;
    int l = opaque_s(L0_);
    phase_convert(p, l, fs);
    phase_rowstat<true>(p, l, fs);
    GSYNC();
    l = opaque_s(l);
    phase_gemm<1, true>(p, p.XB, DM, (p.WB + OFF_W1T), 1024, LDP / 128, smem);
    GSYNC();
    l = opaque_s(l);
    phase_pre(p, l, fs);
    GSYNC();
    l = opaque_s(l);
    phase_scan(p, l, fs);
    GSYNC();
    l = opaque_s(l);
    phase_post(p, l, fs);
    GSYNC();
    l = opaque_s(l);
    phase_gemm<2, false>(p, p.PROJ, LDP, (p.WB + OFF_WOT), 1536, 8, smem);
    GSYNC();
    l = opaque_s(l);
    phase_rowstat<false>(p, l, fs);
    GSYNC();
    l = opaque_s(l);
    phase_gemm<3, true>(p, p.XB, DM, (p.WB + OFF_WGU), 1024, 44, smem);
    GSYNC();
    l = opaque_s(l);
    phase_gemm<2, true>(p, p.PROJ, D_FF, (p.WB + OFF_WDT), D_FF, 8, smem);
    GSYNC();
  }
  {
    const int L0_ = 1;
    int l = opaque_s(L0_);
    phase_convert(p, l, fs);
    phase_rowstat<true>(p, l, fs);
    GSYNC();
    l = opaque_s(l);
    phase_gemm<1, true>(p, p.XB, DM, (p.WB + OFF_W1T), 1024, LDP / 128, smem);
    GSYNC();
    l = opaque_s(l);
    phase_pre(p, l, fs);
    GSYNC();
    l = opaque_s(l);
    phase_scan(p, l, fs);
    GSYNC();
    l = opaque_s(l);
    phase_post(p, l, fs);
    GSYNC();
    l = opaque_s(l);
    phase_gemm<2, false>(p, p.PROJ, LDP, (p.WB + OFF_WOT), 1536, 8, smem);
    GSYNC();
    l = opaque_s(l);
    phase_rowstat<false>(p, l, fs);
    GSYNC();
    l = opaque_s(l);
    phase_gemm<3, true>(p, p.XB, DM, (p.WB + OFF_WGU), 1024, 44, smem);
    GSYNC();
    l = opaque_s(l);
    phase_gemm<2, true>(p, p.PROJ, D_FF, (p.WB + OFF_WDT), D_FF, 8, smem);
    GSYNC();
  }
  phase_final(p);
}
#else
template <int PH>
__global__ void __launch_bounds__(256, 3) k_phase(Params p) {
  __shared__ __attribute__((aligned(16))) char smem[SMEM_BYTES];
  run_phase(p, PH, smem);
}
template <int PH>
static void launch_all(const Params& p, int grid, hipStream_t stream) {
  hipLaunchKernelGGL(k_phase<PH>, dim3(grid), dim3(256), 0, stream, p);
  if constexpr (PH + 1 < N_PHASES) launch_all<PH + 1>(p, grid, stream);
}
#endif

extern "C" void kernel_launch(void* const* d_in, const int* in_sizes, int n_in, void* d_out, int out_size, void* d_ws,
                              size_t ws_size, hipStream_t stream) {
  Params p{};
  const float** pf = (const float**)&p;
  for (int i = 0; i < 35; ++i) pf[i] = (const float*)d_in[i];
  p.out = (float*)d_out;
  char* ws = (char*)d_ws;
  size_t off = 0;
  auto take = [&](size_t bytes) { char* r = ws + off; off += (bytes + 255) & ~(size_t)255; return r; };
  p.XB = (u16*)take((size_t)M_TOT * DM * 2);
  p.PROJ = (u16*)take((size_t)M_TOT * LDP * 2);
  p.WB = (u16*)take((size_t)WB_TOTAL * 2);
  p.BND = (u16*)take((size_t)NBLK16 * 1792 * 2);
  p.BND2 = (u16*)take((size_t)NBLK16 * 3 * 512 * 2);
  p.ORW = (u16*)take((size_t)M_TOT * 512 * 2);
  p.FB = (float*)take((size_t)FB_TOTAL * 4);
  p.bar = (unsigned*)take((size_t)XCD_BAR_WORDS * 4);
  p.RWX = (u16*)d_out;
  if (off > ws_size) fprintf(stderr, "workspace too small: need %zu have %zu\n", off, ws_size);
#if MEGA
  static int grid_blocks = 0;
  if (!grid_blocks) {
    int dev = 0, cus = 0, per_cu = 0;
    hipGetDevice(&dev);
    hipDeviceGetAttribute(&cus, hipDeviceAttributeMultiprocessorCount, dev);
    hipOccupancyMaxActiveBlocksPerMultiprocessor(&per_cu, k_mega, 256, 0);
    if (per_cu > 3) per_cu = 3;
    grid_blocks = cus * per_cu;
  }
  hipMemsetAsync(p.bar, 0, (size_t)XCD_BAR_WORDS * 4, stream);
  void* args[] = {&p};
  hipError_t e = hipLaunchCooperativeKernel((void*)k_mega, dim3(grid_blocks), dim3(256), args, 0, stream);
  if (e != hipSuccess) fprintf(stderr, "cooperative launch failed: %s (grid %d)\n", hipGetErrorString(e), grid_blocks);
#else
  launch_all<0>(p, 768, stream);
#endif
}
```

```cpp
#include <hip/hip_runtime.h>
#include <hip/hip_bf16.h>
#include <hip/hip_cooperative_groups.h>
#include <cstdio>
namespace cg = cooperative_groups;

#ifndef MEGA
#define MEGA 1
#endif

typedef unsigned short u16;
using bf16x8 = __attribute__((ext_vector_type(8))) short;
using f32x16 = __attribute__((ext_vector_type(16))) float;
using f32x4v = __attribute__((ext_vector_type(4))) float;

constexpr int DM = 1024;
constexpr int M_TOT = 33408;
constexpr int M_PROMPT = 32896;
constexpr int T_P = 4112;
constexpr int LDP = 5376;
constexpr int N_IN = 5384;
constexpr int D_FF = 2816;
constexpr int NBLK16 = M_TOT / 16;
constexpr int C_Z = 0, C_R = 512, C_GG = 1024, C_XBC = 1536, C_K = 2560, C_V = 3072, C_XW = 3584, C_XA = 3648,
              C_XG = 3712, C_Q = 3840, C_F = 4352, C_I = 4864;
constexpr long O_YP = 0, O_YS = 33554432, O_PSSM = 34078720, O_PCONV = 35127296, O_PRWKV = 35176448,
               O_PSHIFT = 35700736, O_PHGRN = 35729408, O_SSSM = 36777984, O_SCONV = 37826560,
               O_SRWKV = 37875712, O_SSHIFT = 38400000, O_SHGRN = 38428672;

constexpr long OFF_W1T = 0, OFF_WOT = 5505024, OFF_WGU = 7077888, OFF_WDT = 12845056, OFF_W2T = 15728640, OFF_A2T = 15761408, OFF_G2T = 15794176, WB_TOTAL = 15859712;
constexpr long FOFF_RS = 0, FOFF_DTRAW = 33408, FOFF_RKS = 300672, FB_TOTAL = 567936;
struct Params {
  const float *x_prompt, *x_sample, *state_ssm, *state_conv, *state_rwkv, *state_shift, *state_hgrn, *meta,
      *norm1_w, *w_in, *conv_w, *conv_b, *dt_bias, *a_log, *d_skip, *ssd_norm_w, *rw_mu, *rw_w0, *rw_w2, *rw_a0,
      *rw_a2, *rw_g2, *rw_kk, *rw_ka, *rw_rk, *rw_lnx_w, *rw_lnx_b, *hg_lb, *hg_norm_w, *w_out, *norm2_w, *w_gate,
      *w_up, *w_down, *final_w;
  float* out;
  u16 *XB, *PROJ, *WB, *BND, *BND2, *ORW, *RWX;
  float *FB;
  unsigned* bar;
};

__device__ __forceinline__ u16 f2bf(float f) {
  unsigned u = __float_as_uint(f);
  u += 0x7fffu + ((u >> 16) & 1u);
  return (u16)(u >> 16);
}
__device__ __forceinline__ float bf2f(u16 h) { return __uint_as_float(((unsigned)h) << 16); }
__device__ __forceinline__ float frcp_(float x) { return __builtin_amdgcn_rcpf(x); }
__device__ __forceinline__ float sigmoidf_(float x) { return frcp_(1.f + __expf(-x)); }
__device__ __forceinline__ float siluf_(float x) { return x * frcp_(1.f + __expf(-x)); }
__device__ __forceinline__ float softplusf_(float x) { return x > 20.f ? x : log1pf(__expf(x)); }

template <int CTRL>
__device__ __forceinline__ float dppf(float v) {
  return __int_as_float(__builtin_amdgcn_update_dpp(0, __float_as_int(v), CTRL, 0xF, 0xF, true));
}
__device__ __forceinline__ float sum16(float v) {
  v += dppf<0xB1>(v);
  v += dppf<0x4E>(v);
  v += dppf<0x141>(v);
  v += dppf<0x140>(v);
  return v;
}
__device__ __forceinline__ void sum16x2(float& a, float& b) {
  a += dppf<0xB1>(a); b += dppf<0xB1>(b);
  a += dppf<0x4E>(a); b += dppf<0x4E>(b);
  a += dppf<0x141>(a); b += dppf<0x141>(b);
  a += dppf<0x140>(a); b += dppf<0x140>(b);
}

__device__ __forceinline__ float sum8(float v) {
  v += dppf<0xB1>(v);
  v += dppf<0x4E>(v);
  v += dppf<0x141>(v);
  return v;
}
__device__ __forceinline__ void unpack8(const uint4& r, float* f) {
  f[0] = __uint_as_float(r.x << 16); f[1] = __uint_as_float(r.x & 0xffff0000u);
  f[2] = __uint_as_float(r.y << 16); f[3] = __uint_as_float(r.y & 0xffff0000u);
  f[4] = __uint_as_float(r.z << 16); f[5] = __uint_as_float(r.z & 0xffff0000u);
  f[6] = __uint_as_float(r.w << 16); f[7] = __uint_as_float(r.w & 0xffff0000u);
}
__device__ __forceinline__ uint4 pack8(const float* f) {
  uint4 r;
  r.x = f2bf(f[0]) | ((unsigned)f2bf(f[1]) << 16);
  r.y = f2bf(f[2]) | ((unsigned)f2bf(f[3]) << 16);
  r.z = f2bf(f[4]) | ((unsigned)f2bf(f[5]) << 16);
  r.w = f2bf(f[6]) | ((unsigned)f2bf(f[7]) << 16);
  return r;
}
__device__ __forceinline__ void ld8(const float* p, float* f) {
  float4 a = *(const float4*)p, b = *(const float4*)(p + 4);
  f[0] = a.x; f[1] = a.y; f[2] = a.z; f[3] = a.w; f[4] = b.x; f[5] = b.y; f[6] = b.z; f[7] = b.w;
}

struct F8 { float v[8]; };
__device__ __forceinline__ F8 up8(const uint4& r) { F8 f; unpack8(r, f.v); return f; }
__device__ __forceinline__ F8 ldf8(const float* p) { F8 f; ld8(p, f.v); return f; }
__device__ __forceinline__ F8 zero8() { F8 f; for (int e = 0; e < 8; ++e) f.v[e] = 0.f; return f; }
__device__ __forceinline__ float sum64(float v) {
  v = sum16(v);
  v += __shfl_xor(v, 16);
  v += __shfl_xor(v, 32);
  return v;
}

#define NOPK(x) asm("" : "+v"(x))
__device__ __forceinline__ int opaque_tid() {
  int t = threadIdx.x;
  asm volatile("" : "+v"(t));
  return t;
}
__device__ __forceinline__ int opaque_s(int v) {
  asm volatile("" : "+s"(v));
  return v;
}
#define BID opaque_s((int)blockIdx.x)
#define NBLK opaque_s((int)gridDim.x)
__device__ __forceinline__ int seq_base(int s) { return s < 8 ? s * T_P : M_PROMPT + (s - 8) * 64; }
__device__ __forceinline__ int seq_len(int s) { return s < 8 ? T_P : 64; }

__device__ __forceinline__ long xb_off(int m, int k);
__device__ __forceinline__ void phase_embed(const Params& p) {
  const long n4 = (long)M_TOT * 256;
  for (long idx = (long)BID * 256 + threadIdx.x, st_ = (long)NBLK * 256; idx < n4; idx += st_) {
    int m = (int)(idx >> 8), c4 = ((int)idx & 255) * 4;
    const float* src;
    if (m < M_PROMPT) {
      int b = m / T_P, t = m - b * T_P;
      src = (t < 16) ? p.meta + (long)t * DM : p.x_prompt + ((long)b * 4096 + (t - 16)) * DM;
    } else {
      src = p.x_sample + (long)(m - M_PROMPT) * DM;
    }
    float4 v = *(const float4*)(src + c4);
    ushort4 o;
    o.x = f2bf(v.x); o.y = f2bf(v.y); o.z = f2bf(v.z); o.w = f2bf(v.w);
    *(ushort4*)(p.XB + xb_off(m, c4)) = o;
  }
}

__device__ __forceinline__ long xb_off(int m, int k) { return ((long)(m >> 7) * 32 + (k >> 5)) * 4096 + (m & 127) * 32 + (k & 31); }
__device__ __forceinline__ long wtile_off(int n, int k, int K) {
  return ((long)(n >> 7) * (K >> 5) + (k >> 5)) * 4096 + (n & 127) * 32 + (k & 31);
}
template <bool HAS_SCALE>
__device__ __forceinline__ void conv_tile(const float* __restrict__ src, int ldsrc, int srccol0, const float* __restrict__ scale,
                          u16* __restrict__ dst, int K, int k0, int n0, float* tile  ) {
  const int tid = opaque_tid();
  __syncthreads();
  {
    int nn = tid & 63, kb = tid >> 6;
#pragma unroll
    for (int i = 0; i < 16; ++i) {
      int kk = kb + 4 * i;
      float v = src[(long)(k0 + kk) * ldsrc + srccol0 + nn];
      if (HAS_SCALE) v *= scale[k0 + kk];
      tile[kk * 65 + nn] = v;
    }
  }
  __syncthreads();
  {
    int nn = tid >> 2, kq = (tid & 3) * 16;
    u16* d = dst + wtile_off(n0 + nn, k0 + kq, K);
#pragma unroll
    for (int j = 0; j < 16; j += 2) {
      unsigned w = f2bf(tile[(kq + j) * 65 + nn]) | ((unsigned)f2bf(tile[(kq + j + 1) * 65 + nn]) << 16);
      *(unsigned*)(d + j) = w;
    }
  }
}

__device__ __forceinline__ int w1_srccol(int n0) {
  if (n0 < 512) return n0;
  if (n0 < 1024) return n0 - 512 + 1544;
  if (n0 < 1536) return n0 - 1024 + 4872;
  if (n0 < 2560) return n0 - 1536 + 512;
  if (n0 < 3840) return n0 - 2560 + 2056;
  return n0 - 3840 + 3336;
}

constexpr int CV_W1 = 16 * 84, CV_WO = 24 * 16, CV_WGU = 16 * 88, CV_WD = 44 * 16;
constexpr int CV_LORA = 32;
constexpr int CV_TOTAL = CV_W1 + CV_WO + CV_WGU + CV_WD + CV_LORA;

__device__ __forceinline__ void phase_convert(const Params& p, int l, float* smem) {
  for (int u = BID, nb_ = NBLK; u < CV_TOTAL; u += nb_) {
    if (u < CV_W1) {
      int kt = u % 16, nt = u / 16;
      conv_tile<true>(p.w_in + (long)l * DM * N_IN, N_IN, w1_srccol(nt * 64), p.norm1_w + l * DM, (p.WB + OFF_W1T), 1024, kt * 64,
                nt * 64, smem);
    } else if (u < CV_W1 + CV_WO) {
      int v = u - CV_W1;
      int kt = v % 24, nt = v / 24;
      conv_tile<false>(p.w_out + (long)l * 1536 * DM, DM, nt * 64, nullptr, (p.WB + OFF_WOT), 1536, kt * 64, nt * 64, smem);
    } else if (u < CV_W1 + CV_WO + CV_WGU) {
      int v = u - CV_W1 - CV_WO;
      int kt = v % 16, nt = v / 16;
      const float* wg = p.w_gate + (long)l * DM * D_FF;
      const float* wu = p.w_up + (long)l * DM * D_FF;
      const float* sc = p.norm2_w + l * DM;
      const int tid = opaque_tid();
      __syncthreads();
      {
        int nn = tid & 63, kb = tid >> 6;
        const float* src = (nn < 32) ? wg : wu;
        int col = nt * 32 + (nn & 31);
#pragma unroll
        for (int i = 0; i < 16; ++i) {
          int kk = kb + 4 * i;
          smem[kk * 65 + nn] = src[(long)(kt * 64 + kk) * D_FF + col] * sc[kt * 64 + kk];
        }
      }
      __syncthreads();
      {
        int nn = tid >> 2, kq = (tid & 3) * 16;
        u16* d = (p.WB + OFF_WGU) + wtile_off(nt * 64 + nn, kt * 64 + kq, 1024);
#pragma unroll
        for (int j = 0; j < 16; j += 2) {
          unsigned w = f2bf(smem[(kq + j) * 65 + nn]) | ((unsigned)f2bf(smem[(kq + j + 1) * 65 + nn]) << 16);
          *(unsigned*)(d + j) = w;
        }
      }
    } else if (u >= CV_W1 + CV_WO + CV_WGU + CV_WD) {
      int v = u - (CV_W1 + CV_WO + CV_WGU + CV_WD);
      const int tid = opaque_tid();
#pragma unroll 4
      for (int i = 0; i < 16; ++i) {
        int e = v * 4096 + i * 256 + tid;
        if (e < 32768) {
          int n = e >> 6, k = e & 63;
          (p.WB + OFF_W2T)[e] = f2bf(p.rw_w2[(long)l * 64 * 512 + k * 512 + n]);
        } else if (e < 65536) {
          int e2 = e - 32768, n = e2 >> 6, k = e2 & 63;
          (p.WB + OFF_A2T)[e2] = f2bf(p.rw_a2[(long)l * 64 * 512 + k * 512 + n]);
        } else {
          int e2 = e - 65536, n = e2 >> 7, k = e2 & 127;
          (p.WB + OFF_G2T)[e2] = f2bf(p.rw_g2[(long)l * 128 * 512 + k * 512 + n]);
        }
      }
    } else {
      int v = u - CV_W1 - CV_WO - CV_WGU;
      int kt = v % 44, nt = v / 44;
      conv_tile<false>(p.w_down + (long)l * D_FF * DM, DM, nt * 64, nullptr, (p.WB + OFF_WDT), D_FF, kt * 64, nt * 64, smem);
    }
  }
}

template <bool WITH_DT>
__device__ __forceinline__ void phase_rowstat(const Params& p, int l, float* smem) {
  const int tid = opaque_tid(), lane = tid & 63, wid = tid >> 6;
  float* dtw = smem;
  if (WITH_DT) {
    __syncthreads();
    const float* w = p.w_in + (long)l * DM * N_IN + 1536;
    const float* nw = p.norm1_w + l * DM;
    for (int i = tid; i < 8192; i += 256) {
      int k = i >> 3, h = i & 7;
      dtw[i] = w[(long)k * N_IN + h] * nw[k];
    }
    __syncthreads();
  }
  for (int blk = BID, nb_ = NBLK; blk < NBLK16; blk += nb_) {
    for (int rr = wid; rr < 16; rr += 4) {
      int m = blk * 16 + rr;
      float ss = 0.f;
      float d[8];
#pragma unroll
      for (int h = 0; h < 8; ++h) d[h] = 0.f;
#pragma unroll 1
      for (int j = 0; j < 4; ++j) {
        int k0 = lane * 4 + 256 * j;
        uint2 raw = *(const uint2*)(p.XB + xb_off(m, k0));
        float xs[4] = {bf2f((u16)(raw.x & 0xffff)), bf2f((u16)(raw.x >> 16)), bf2f((u16)(raw.y & 0xffff)),
                       bf2f((u16)(raw.y >> 16))};
#pragma unroll
        for (int e = 0; e < 4; ++e) {
          float x = xs[e];
          ss += x * x;
          if (WITH_DT) {
            float4 w0 = *(const float4*)(dtw + (k0 + e) * 8);
            float4 w1 = *(const float4*)(dtw + (k0 + e) * 8 + 4);
            d[0] += x * w0.x; d[1] += x * w0.y; d[2] += x * w0.z; d[3] += x * w0.w;
            d[4] += x * w1.x; d[5] += x * w1.y; d[6] += x * w1.z; d[7] += x * w1.w;
          }
        }
      }
      ss = sum64(ss);
      float rs = rsqrtf(ss * (1.f / 1024.f) + 1e-6f);
      if (WITH_DT) {
#pragma unroll
        for (int h = 0; h < 8; ++h) d[h] = sum64(d[h]);
        if (lane == 0) {
#pragma unroll
          for (int h = 0; h < 8; ++h) (p.FB + FOFF_DTRAW)[(long)m * 8 + h] = d[h] * rs;
        }
      }
      if (lane == 0) (p.FB + FOFF_RS)[m] = rs;
    }
  }
}

constexpr int G_BK = 32, G_LDS_ROW = 80;
constexpr int G_OPER_BYTES = 128 * G_LDS_ROW;
template <int MODE, bool A_TILED>
__device__ __forceinline__ void phase_gemm(const Params& p, const u16* __restrict__ A, int lda, const u16* __restrict__ Bt, int K,
                           int nN, char* smem) {
  const int tid = opaque_tid(), lane = tid & 63, wid = tid >> 6, wm = wid >> 1, wn = wid & 1;
  const int nM = M_TOT / 128;
  const int ntiles = nM * nN;
  const int nk = K / G_BK;
  const int lrow = tid >> 2, lkc = tid & 3;
  for (int tile = BID, nb_ = NBLK; tile < ntiles; tile += nb_) {
    constexpr int GM = 32;
    int grp = tile / (GM * nN);
    int first_m = grp * GM;
    int gsz = min(GM, nM - first_m);
    int rem = tile - grp * GM * nN;
    int pm = first_m + rem % gsz, pn = rem / gsz;
    const u16* gA = A_TILED ? A + (long)pm * (K >> 5) * 4096 + lrow * 32 + lkc * 8
                            : A + (long)(pm * 128 + lrow) * lda + lkc * 8;
    const u16* gB = Bt + (long)pn * (K >> 5) * 4096 + lrow * 32 + lkc * 8;
    f32x16 acc[2][2];
#pragma unroll
    for (int i = 0; i < 2; ++i)
#pragma unroll
      for (int j = 0; j < 2; ++j)
#pragma unroll
        for (int r = 0; r < 16; ++r) acc[i][j][r] = 0.f;
    uint4 xa0, xa1, xb0, xb1, ya0, ya1, yb0, yb1, za0, za1, zb0, zb1;
#define G_LOAD(S, KT)                                                  \
  {                                                                    \
    S##a0 = *(const uint4*)(A_TILED ? gA + (long)(KT) * 4096 : gA + (KT) * G_BK);                          \
    S##a1 = *(const uint4*)(A_TILED ? gA + (long)(KT) * 4096 + 2048 : gA + (long)64 * lda + (KT) * G_BK);  \
    S##b0 = *(const uint4*)(gB + (long)(KT) * 4096);                   \
    S##b1 = *(const uint4*)(gB + (long)(KT) * 4096 + 2048);            \
  }
#define G_STORE(S, BUF)                                                \
  {                                                                    \
    char* dA = smem + (BUF) * 2 * G_OPER_BYTES;                        \
    char* dB = dA + G_OPER_BYTES;                                      \
    *(uint4*)(dA + lrow * G_LDS_ROW + lkc * 16) = S##a0;               \
    *(uint4*)(dA + (lrow + 64) * G_LDS_ROW + lkc * 16) = S##a1;        \
    *(uint4*)(dB + lrow * G_LDS_ROW + lkc * 16) = S##b0;               \
    *(uint4*)(dB + (lrow + 64) * G_LDS_ROW + lkc * 16) = S##b1;        \
  }
#define G_READ(BUF, KS, AF, BF)                                                                  \
  {                                                                                              \
    const char* sA = smem + (BUF) * 2 * G_OPER_BYTES;                                            \
    const char* sB = sA + G_OPER_BYTES;                                                          \
    const int koff = ((KS) * 16 + (lane >> 5) * 8) * 2;                                          \
    _Pragma("unroll") for (int i = 0; i < 2; ++i)                                                \
      AF[i] = *(const bf16x8*)(sA + (wm * 64 + i * 32 + (lane & 31)) * G_LDS_ROW + koff);        \
    _Pragma("unroll") for (int j = 0; j < 2; ++j)                                                \
      BF[j] = *(const bf16x8*)(sB + (wn * 64 + j * 32 + (lane & 31)) * G_LDS_ROW + koff);        \
  }
#define G_MMA(AF, BF)                                                                            \
  {                                                                                              \
    __builtin_amdgcn_s_setprio(1);                                                               \
    _Pragma("unroll") for (int i = 0; i < 2; ++i)                                                \
      _Pragma("unroll") for (int j = 0; j < 2; ++j)                                              \
        acc[i][j] = __builtin_amdgcn_mfma_f32_32x32x16_bf16(AF[i], BF[j], acc[i][j], 0, 0, 0);   \
    __builtin_amdgcn_s_setprio(0);                                                               \
  }
    G_LOAD(x, 0);
    G_LOAD(y, 1);
    G_LOAD(z, 2);
    __builtin_amdgcn_sched_barrier(0);
    __syncthreads();
    G_STORE(x, 0);
    __syncthreads();
#define G_STEP(T, SNEXT, SFREE, BUF)                          \
    if ((T) < nk) {                                           \
      bf16x8 af0[2], bf0[2];                                  \
      G_READ(BUF, 0, af0, bf0);                               \
      __builtin_amdgcn_sched_barrier(0);                      \
      if ((T) + 1 < nk) G_STORE(SNEXT, (BUF) ^ 1);            \
      if ((T) + 3 < nk) G_LOAD(SFREE, (T) + 3);               \
      __builtin_amdgcn_sched_barrier(0);                      \
      G_MMA(af0, bf0);                                        \
      G_READ(BUF, 1, af0, bf0);                               \
      G_MMA(af0, bf0);                                        \
      __builtin_amdgcn_sched_barrier(0);                      \
      __syncthreads();                                        \
    }
    for (int kt = 0; kt < nk; kt += 6) {
      G_STEP(kt + 0, y, x, 0);
      G_STEP(kt + 1, z, y, 1);
      G_STEP(kt + 2, x, z, 0);
      G_STEP(kt + 3, y, x, 1);
      G_STEP(kt + 4, z, y, 0);
      G_STEP(kt + 5, x, z, 1);
    }
#undef G_STEP
#undef G_LOAD
#undef G_STORE
#undef G_READ
#undef G_MMA
    const int colb = pn * 128 + wn * 64 + (lane & 31);
    const int rowb = pm * 128 + wm * 64 + 4 * (lane >> 5);
    if (MODE == 1) {
#pragma unroll
      for (int i = 0; i < 2; ++i)
#pragma unroll
        for (int r = 0; r < 16; ++r) {
          int row = rowb + i * 32 + (r & 3) + 8 * (r >> 2);
          float rs = (p.FB + FOFF_RS)[row];
#pragma unroll
          for (int j = 0; j < 2; ++j) {
            int col = colb + j * 32;
            u16 v = f2bf(acc[i][j][r] * rs);
            p.PROJ[(long)row * LDP + col] = v;
            if ((row & 15) == 15) {
              int jj = -1;
              if (col >= C_R && col < C_GG) jj = col - C_R;
              else if (col >= C_K && col < C_Q) jj = col - C_K + 512;
              if (jj >= 0) p.BND[(long)(row >> 4) * 1792 + jj] = v;
            }
            if ((row & 15) >= 13 && col >= C_XBC + 512 && col < C_XBC + 1024)
              p.BND2[((long)(row >> 4) * 3 + ((row & 15) - 13)) * 512 + (col - (C_XBC + 512))] = v;
          }
        }
    } else if (MODE == 2) {
#pragma unroll
      for (int i = 0; i < 2; ++i)
#pragma unroll
        for (int r = 0; r < 16; ++r) {
          int row = rowb + i * 32 + (r & 3) + 8 * (r >> 2);
#pragma unroll
          for (int j = 0; j < 2; ++j) {
            int col = colb + j * 32;
            u16* px = p.XB + xb_off(row, col);
            *px = f2bf(bf2f(*px) + acc[i][j][r]);
          }
        }
    } else {
      const int cact = pn * 64 + wn * 32 + (lane & 31);
      u16* ACT = p.PROJ;
#pragma unroll
      for (int i = 0; i < 2; ++i)
#pragma unroll
        for (int r = 0; r < 16; ++r) {
          int row = rowb + i * 32 + (r & 3) + 8 * (r >> 2);
          float rs = (p.FB + FOFF_RS)[row];
          float g = acc[i][0][r] * rs, u = acc[i][1][r] * rs;
          ACT[wtile_off(row, cact, D_FF)] = f2bf(siluf_(g) * u);
        }
    }
  }
}

__device__ __forceinline__ void phase_pre(const Params& p, int l, float* smem) {
  u16* XWb = (u16*)smem;
  u16* XAb = (u16*)smem + 16 * 72;
  constexpr int LDW = 260;
  float* AW = smem + 1152;
  float* AA = smem + 1152 + 16 * LDW;
  const float* mu = p.rw_mu + l * 1792;
  for (int blk = BID, nb_ = NBLK; blk < NBLK16; blk += nb_) {
    const int tid = opaque_tid(), lane = tid & 63, wid = tid >> 6;
    const int T = tid >> 4, Q = tid & 15;
    const int m0 = blk * 16;
    const long m = m0 + T;
    int s, t0;
    if (m0 < M_PROMPT) { s = m0 / T_P; t0 = m0 - s * T_P; } else { s = 8 + (m0 - M_PROMPT) / 64; t0 = (m0 - M_PROMPT) & 63; }
    const bool first = (t0 == 0);
    u16* row = p.PROJ + m * LDP;
    const u16* bndrow = p.BND + (long)(blk > 0 ? blk - 1 : 0) * 1792;
    const float* shrow = p.state_shift + ((long)l * 8 + (s >= 8 ? s - 8 : 0)) * 1792;
    const bool seqstart = first && (T == 0);
#define SHIFT8(DST, J, COL)                                                                 \
    {                                                                                       \
      float cur_[8], pv_[8], mj_[8];                                                        \
      unpack8(*(const uint4*)(row + (COL)), cur_);                                          \
      const u16* ps_ = (T > 0) ? (row - LDP + (COL)) : (bndrow + (J));                      \
      unpack8(*(const uint4*)ps_, pv_);                                                     \
      if (seqstart) {                                                                       \
        if (s >= 8) ld8(shrow + (J), pv_);                                                  \
        else { _Pragma("unroll") for (int e = 0; e < 8; ++e) pv_[e] = 0.f; }                \
      }                                                                                     \
      ld8(mu + (J), mj_);                                                                   \
      _Pragma("unroll") for (int e = 0; e < 8; ++e) DST[e] = cur_[e] + (pv_[e] - cur_[e]) * mj_[e]; \
    }
    __syncthreads();
    {
      float sh0[8], sh1[8];
      SHIFT8(sh0, 1536 + Q * 8, C_XW + Q * 8);
      SHIFT8(sh1, 1664 + Q * 8, C_XG + Q * 8);
      __syncthreads();
      if (Q < 8) {
#pragma unroll
        for (int e = 0; e < 8; ++e) sh0[e] = tanhf(sh0[e]);
        *(uint4*)(XWb + T * 72 + Q * 8) = pack8(sh0);
      } else {
        *(uint4*)(XAb + T * 72 + (Q - 8) * 8) = pack8(sh0);
      }
#pragma unroll
      for (int e = 0; e < 8; ++e) sh1[e] = sigmoidf_(sh1[e]);
      *(uint4*)(row + C_XG + Q * 8) = pack8(sh1);
    }
    __syncthreads();
#pragma unroll 1
    for (int c = 0; c < 2; ++c) {
      {
        bf16x8 axw[2], axa[2];
#pragma unroll
        for (int ks = 0; ks < 2; ++ks) {
          axw[ks] = *(const bf16x8*)(XWb + (lane & 15) * 72 + ks * 32 + (lane >> 4) * 8);
          axa[ks] = *(const bf16x8*)(XAb + (lane & 15) * 72 + ks * 32 + (lane >> 4) * 8);
        }
#pragma unroll
        for (int nt = 0; nt < 4; ++nt) {
          const int ncol = (wid * 4 + nt) * 16 + (lane & 15);
          const int n = c * 256 + ncol;
          f32x4v accw = {0.f, 0.f, 0.f, 0.f}, acca = {0.f, 0.f, 0.f, 0.f};
#pragma unroll
          for (int ks = 0; ks < 2; ++ks) {
            bf16x8 bw = *(const bf16x8*)((p.WB + OFF_W2T) + n * 64 + ks * 32 + (lane >> 4) * 8);
            bf16x8 ba = *(const bf16x8*)((p.WB + OFF_A2T) + n * 64 + ks * 32 + (lane >> 4) * 8);
            accw = __builtin_amdgcn_mfma_f32_16x16x32_bf16(axw[ks], bw, accw, 0, 0, 0);
            acca = __builtin_amdgcn_mfma_f32_16x16x32_bf16(axa[ks], ba, acca, 0, 0, 0);
          }
#pragma unroll
          for (int r = 0; r < 4; ++r) {
            AW[((lane >> 4) * 4 + r) * LDW + ncol] = accw[r];
            AA[((lane >> 4) * 4 + r) * LDW + ncol] = acca[r];
          }
        }
      }
#pragma unroll 1
      for (int jj = 0; jj < 2; ++jj) {
        const int ch0 = c * 256 + jj * 128 + Q * 8;
        const int head = c * 4 + jj * 2 + (Q >> 3);
        float rt[8], kt[8];
        uint4 vpk;
        SHIFT8(rt, ch0, C_R + ch0);
        SHIFT8(kt, 512 + ch0, C_K + ch0);
        {
          float vt[8];
          SHIFT8(vt, 1024 + ch0, C_V + ch0);
          vpk = pack8(vt);
        }
        __syncthreads();
        float aw[8], aa[8], w0[8], a0[8];
        ld8(AW + T * LDW + jj * 128 + Q * 8, aw);
        ld8(AA + T * LDW + jj * 128 + Q * 8, aa);
        ld8(p.rw_w0 + l * 512 + ch0, w0);
        ld8(p.rw_a0 + l * 512 + ch0, a0);
        {
          float uu[8];
#pragma unroll
          for (int e = 0; e < 8; ++e) {
            float lw = -softplusf_(-(w0[e] + aw[e])) - 0.5f;
            uu[e] = -__expf(lw);
            aa[e] = sigmoidf_(a0[e] + aa[e]);
          }
          *(uint4*)(p.RWX + m * 1536 + ch0) = pack8(uu);
        }
        *(uint4*)(row + C_R + ch0) = pack8(rt);
        *(uint4*)(row + C_V + ch0) = vpk;
        float kkw[8], kaw[8], rkw[8], kk[8], kp[8];
        ld8(p.rw_kk + l * 512 + ch0, kkw);
        ld8(p.rw_ka + l * 512 + ch0, kaw);
        ld8(p.rw_rk + l * 512 + ch0, rkw);
        float ssq = 0.f, rks = 0.f;
#pragma unroll
        for (int e = 0; e < 8; ++e) {
          kk[e] = kt[e] * kkw[e];
          ssq += kk[e] * kk[e];
          kp[e] = kt[e] * (1.f + (aa[e] - 1.f) * kaw[e]);
          rks += rt[e] * kp[e] * rkw[e];
        }
        ssq = sum8(ssq);
        rks = sum8(rks);
        const float rn = rsqrtf(ssq + 1e-12f);
        *(uint4*)(row + C_K + ch0) = pack8(kp);
#pragma unroll
        for (int e = 0; e < 8; ++e) kk[e] *= rn;
        *(uint4*)(p.RWX + m * 1536 + 512 + ch0) = pack8(kk);
#pragma unroll
        for (int e = 0; e < 8; ++e) kk[e] *= aa[e];
        *(uint4*)(p.RWX + m * 1536 + 1024 + ch0) = pack8(kk);
        if ((Q & 7) == 0) (p.FB + FOFF_RKS)[m * 8 + head] = rks;
      }
      __syncthreads();
    }
    {
      u16* CB = (u16*)(smem + 1152);
      const u16* b2row = p.BND2 + (long)(blk > 0 ? blk - 1 : 0) * 1536;
      const float* scrow = p.state_conv + ((long)l * 8 + (s >= 8 ? s - 8 : 0)) * 3072 + 512;
#pragma unroll 1
      for (int j = 0; j < 4; ++j) {
        const int cc0 = j * 128 + Q * 8;
        const float* cw = p.conv_w + (long)l * 4096 + 512 + cc0;
        float acc[8];
        ld8(p.conv_b + l * 1024 + 512 + cc0, acc);
#pragma unroll
        for (int d = 0; d < 4; ++d) {
          const int tr = T - 3 + d;
          const int trn = tr < 0 ? 3 + tr : 0;
          float u[8], w[8];
          const u16* src = (tr >= 0) ? (row + (long)(d - 3) * LDP + C_XBC + 512 + cc0) : (b2row + trn * 512 + cc0);
          unpack8(*(const uint4*)src, u);
          if (first && tr < 0) {
            if (s >= 8) ld8(scrow + trn * 1024 + cc0, u);
            else {
#pragma unroll
              for (int e = 0; e < 8; ++e) u[e] = 0.f;
            }
          }
          ld8(cw + d * 1024, w);
#pragma unroll
          for (int e = 0; e < 8; ++e) acc[e] += w[e] * u[e];
        }
#pragma unroll
        for (int e = 0; e < 8; ++e) acc[e] = siluf_(acc[e]);
        *(uint4*)(CB + T * 512 + cc0) = pack8(acc);
      }
      __syncthreads();
#pragma unroll
      for (int j = 0; j < 4; ++j)
        *(uint4*)(row + C_XBC + 512 + j * 128 + Q * 8) = *(const uint4*)(CB + T * 512 + j * 128 + Q * 8);
    }
#undef SHIFT8
    if (t0 + 16 == seq_len(s)) {
      float* o = p.out + (s < 8 ? O_PSHIFT + ((long)l * 8 + s) * 1792 : O_SSHIFT + ((long)l * 8 + (s - 8)) * 1792);
      for (int j = tid; j < 1792; j += 256) o[j] = bf2f(p.BND[(long)blk * 1792 + j]);
    }
  }
}

__device__ __forceinline__ void scan_rwkv(const Params& p, int l, int s, int h, int q, float* smem) {
  const int tid = opaque_tid(), lane = tid & 63, wid = tid >> 6;
  float* R_ = smem;
  float* W_ = smem + 1024;
  float* K_ = smem + 2048;
  float* A_ = smem + 3072;
  float* B_ = smem + 4096;
  float* V_ = smem + 5120;
  float* O_ = smem + 5376;
  const int rl = wid * 4 + (lane >> 4);
  const int row = q * 16 + rl;
  const int ksl = (lane & 15) * 4;
  const int base = seq_base(s), T = seq_len(s);
  float s0 = 0.f, s1 = 0.f, s2 = 0.f, s3 = 0.f;
  if (s >= 8) {
    const float* st = p.state_rwkv + (((long)l * 8 + (s - 8)) * 8 + h) * 4096 + row * 64 + ksl;
    float4 v = *(const float4*)st;
    s0 = v.x; s1 = v.y; s2 = v.z; s3 = v.w;
  }
  const int stt = tid >> 4, skq = (tid & 15) * 4;
  const int nblk = T / 16;
  ushort4 r4, k4, u4, a4, b4;
  u16 vv;
  {
    const long m = base + stt;
    const u16* pr = p.PROJ + m * LDP;
    const u16* px = p.RWX + m * 1536;
    r4 = *(const ushort4*)(pr + C_R + h * 64 + skq);
    k4 = *(const ushort4*)(pr + C_K + h * 64 + skq);
    u4 = *(const ushort4*)(px + h * 64 + skq);
    a4 = *(const ushort4*)(px + 512 + h * 64 + skq);
    b4 = *(const ushort4*)(px + 1024 + h * 64 + skq);
    vv = pr[C_V + h * 64 + q * 16 + (tid & 15)];
  }
  __syncthreads();
  float* TR_ = smem + 5376 + 512;
  const bool wr = (lane & 15) == 0;
  const int ooff = wr ? rl : (512 + lane);
  const int ostr = wr ? 16 : 0;
  for (int blk = 0; blk < nblk; ++blk) {
    const long m = base + blk * 16 + stt;
    float* Oc = O_ + (blk & 1) * 256;
    {
      *(float4*)(R_ + stt * 64 + skq) = make_float4(bf2f(r4.x), bf2f(r4.y), bf2f(r4.z), bf2f(r4.w));
      *(float4*)(K_ + stt * 64 + skq) = make_float4(bf2f(k4.x), bf2f(k4.y), bf2f(k4.z), bf2f(k4.w));
      *(float4*)(W_ + stt * 64 + skq) =
          make_float4(__expf(bf2f(u4.x)), __expf(bf2f(u4.y)), __expf(bf2f(u4.z)), __expf(bf2f(u4.w)));
      *(float4*)(A_ + stt * 64 + skq) = make_float4(-bf2f(a4.x), -bf2f(a4.y), -bf2f(a4.z), -bf2f(a4.w));
      *(float4*)(B_ + stt * 64 + skq) = make_float4(bf2f(b4.x), bf2f(b4.y), bf2f(b4.z), bf2f(b4.w));
      V_[stt * 16 + (tid & 15)] = bf2f(vv);
    }
    __syncthreads();
    if (blk > 0)
      p.ORW[(m - 16) * 512 + h * 64 + q * 16 + (tid & 15)] = f2bf(O_[((blk - 1) & 1) * 256 + stt * 16 + (tid & 15)]);
    if (blk + 1 < nblk) {
      const u16* pr = p.PROJ + (m + 16) * LDP;
      const u16* px = p.RWX + (m + 16) * 1536;
      r4 = *(const ushort4*)(pr + C_R + h * 64 + skq);
      k4 = *(const ushort4*)(pr + C_K + h * 64 + skq);
      u4 = *(const ushort4*)(px + h * 64 + skq);
      a4 = *(const ushort4*)(px + 512 + h * 64 + skq);
      b4 = *(const ushort4*)(px + 1024 + h * 64 + skq);
      vv = pr[C_V + h * 64 + q * 16 + (tid & 15)];
    }
    __builtin_amdgcn_sched_barrier(0);
    {
      float4 a = *(const float4*)(A_ + ksl), w = *(const float4*)(W_ + ksl), b = *(const float4*)(B_ + ksl);
      float4 k = *(const float4*)(K_ + ksl), r = *(const float4*)(R_ + ksl);
      float v = V_[rl];
      float opart = 0.f;
#pragma unroll
      for (int tt = 0; tt < 16; ++tt) {
        float4 an, wn, bn, kn, rn;
        float vn;
        if (tt + 1 < 16) {
          an = *(const float4*)(A_ + (tt + 1) * 64 + ksl); wn = *(const float4*)(W_ + (tt + 1) * 64 + ksl);
          bn = *(const float4*)(B_ + (tt + 1) * 64 + ksl); kn = *(const float4*)(K_ + (tt + 1) * 64 + ksl);
          rn = *(const float4*)(R_ + (tt + 1) * 64 + ksl); vn = V_[(tt + 1) * 16 + rl];
        }
        __builtin_amdgcn_sched_barrier(0);
        float sa = fmaf(s0, a.x, fmaf(s1, a.y, fmaf(s2, a.z, s3 * a.w)));
        if (tt > 0) { sum16x2(sa, opart); Oc[ooff + (tt - 1) * ostr] = opart; }
        else sa = sum16(sa);
        s0 = fmaf(s0, w.x, fmaf(sa, b.x, v * k.x)); NOPK(s0);
        s1 = fmaf(s1, w.y, fmaf(sa, b.y, v * k.y)); NOPK(s1);
        s2 = fmaf(s2, w.z, fmaf(sa, b.z, v * k.z)); NOPK(s2);
        s3 = fmaf(s3, w.w, fmaf(sa, b.w, v * k.w)); NOPK(s3);
        opart = fmaf(s0, r.x, fmaf(s1, r.y, fmaf(s2, r.z, s3 * r.w)));
        if (tt == 15) { opart = sum16(opart); Oc[ooff + 15 * ostr] = opart; }
        __builtin_amdgcn_sched_barrier(0);
        if (tt + 1 < 16) { a = an; w = wn; b = bn; k = kn; r = rn; v = vn; }
      }
    }
    __builtin_amdgcn_sched_barrier(0);
    __syncthreads();
  }
  {
    const long m = base + (nblk - 1) * 16 + stt;
    p.ORW[m * 512 + h * 64 + q * 16 + (tid & 15)] = f2bf(O_[((nblk - 1) & 1) * 256 + stt * 16 + (tid & 15)]);
  }
  __syncthreads();
  {
    float* o = p.out + (s < 8 ? O_PRWKV + (((long)l * 8 + s) * 8 + h) * 4096
                              : O_SRWKV + (((long)l * 8 + (s - 8)) * 8 + h) * 4096);
    *(float4*)(o + row * 64 + ksl) = make_float4(s0, s1, s2, s3);
  }
}

__device__ __forceinline__ void scan_hgrn(const Params& p, int l, int s, int h, int q, float* smem) {
  const int tid = opaque_tid(), lane = tid & 63, wid = tid >> 6;
  float* Q_ = smem;
  float* F_ = smem + 2048;
  float* G_ = smem + 4096;
  float* I_ = smem + 6144;
  float* O_ = smem + 6400;
  const int rl = wid * 4 + (lane >> 4);
  const int row = q * 16 + rl;
  const int ksl4 = (lane & 15) * 4;
  const int base = seq_base(s), T = seq_len(s);
  float st[8];
#pragma unroll
  for (int i = 0; i < 8; ++i) st[i] = 0.f;
  if (s >= 8) {
    const float* sp = p.state_hgrn + (((long)l * 8 + (s - 8)) * 4 + h) * 16384;
#pragma unroll
    for (int i = 0; i < 8; ++i) st[i] = sp[((i >> 2) * 64 + ksl4 + (i & 3)) * 128 + row];
  }
  const int stt = tid >> 4, skq = (tid & 15) * 8;
  float lb[8];
#pragma unroll
  for (int i = 0; i < 8; ++i) {
    if (l == 0) lb[i] = 0.f;
    else {
      float x0 = p.hg_lb[h * 128 + skq + i], x1 = p.hg_lb[512 + h * 128 + skq + i];
      lb[i] = frcp_(1.f + __expf(x0 - x1));
    }
  }
  const int nblk = T / 16;
  uint4 q8, f8;
  u16 iv16;
  {
    const u16* pr = p.PROJ + (long)(base + stt) * LDP;
    q8 = *(const uint4*)(pr + C_Q + h * 128 + skq);
    f8 = *(const uint4*)(pr + C_F + h * 128 + skq);
    iv16 = pr[C_I + h * 128 + q * 16 + (tid & 15)];
  }
  __syncthreads();
  float* TR_ = smem + 6400 + 512;
  const bool wr = (lane & 15) == 0;
  const int ooff = wr ? rl : (512 + lane);
  const int ostr = wr ? 16 : 0;
  for (int blk = 0; blk < nblk; ++blk) {
    const long m = base + blk * 16 + stt;
    float* Oc = O_ + (blk & 1) * 256;
    {
      unsigned qw[4] = {q8.x, q8.y, q8.z, q8.w}, fw[4] = {f8.x, f8.y, f8.z, f8.w};
      float qv[8], fv[8];
#pragma unroll
      for (int e = 0; e < 8; ++e) {
        qv[e] = bf2f((u16)((qw[e >> 1] >> ((e & 1) * 16)) & 0xffff));
        float fz = bf2f((u16)((fw[e >> 1] >> ((e & 1) * 16)) & 0xffff));
        float ex = __expf(-fz);
        float sg = frcp_(1.f + ex);
        fv[e] = lb[e] + (1.f - lb[e]) * sg;
      }
      *(float4*)(Q_ + stt * 128 + skq) = make_float4(qv[0], qv[1], qv[2], qv[3]);
      *(float4*)(Q_ + stt * 128 + skq + 4) = make_float4(qv[4], qv[5], qv[6], qv[7]);
      *(float4*)(F_ + stt * 128 + skq) = make_float4(fv[0], fv[1], fv[2], fv[3]);
      *(float4*)(F_ + stt * 128 + skq + 4) = make_float4(fv[4], fv[5], fv[6], fv[7]);
      I_[stt * 16 + (tid & 15)] = bf2f(iv16);
    }
    __syncthreads();
    if (blk > 0) {
      u16* dp = p.PROJ + (m - 16) * LDP + C_I + h * 128 + q * 16 + (tid & 15);
      *dp = f2bf(O_[((blk - 1) & 1) * 256 + stt * 16 + (tid & 15)]);
    }
    if (blk + 1 < nblk) {
      const u16* pr = p.PROJ + (m + 16) * LDP;
      q8 = *(const uint4*)(pr + C_Q + h * 128 + skq);
      f8 = *(const uint4*)(pr + C_F + h * 128 + skq);
      iv16 = pr[C_I + h * 128 + q * 16 + (tid & 15)];
    }
    __builtin_amdgcn_sched_barrier(0);
    {
      float4 f0 = *(const float4*)(F_ + ksl4), f1 = *(const float4*)(F_ + 64 + ksl4);
      float4 q0 = *(const float4*)(Q_ + ksl4), q1 = *(const float4*)(Q_ + 64 + ksl4);
      float iv = I_[rl];
      float oprev = 0.f;
#pragma unroll
      for (int tt = 0; tt < 16; ++tt) {
        float4 f0n, f1n, q0n, q1n;
        float ivn;
        if (tt + 1 < 16) {
          const int o_ = (tt + 1) * 128;
          f0n = *(const float4*)(F_ + o_ + ksl4); f1n = *(const float4*)(F_ + o_ + 64 + ksl4);
          q0n = *(const float4*)(Q_ + o_ + ksl4); q1n = *(const float4*)(Q_ + o_ + 64 + ksl4);
          ivn = I_[(tt + 1) * 16 + rl];
        }
        __builtin_amdgcn_sched_barrier(0);
        st[0] = fmaf(st[0] - iv, f0.x, iv); NOPK(st[0]);
        st[1] = fmaf(st[1] - iv, f0.y, iv); NOPK(st[1]);
        st[2] = fmaf(st[2] - iv, f0.z, iv); NOPK(st[2]);
        st[3] = fmaf(st[3] - iv, f0.w, iv); NOPK(st[3]);
        st[4] = fmaf(st[4] - iv, f1.x, iv); NOPK(st[4]);
        st[5] = fmaf(st[5] - iv, f1.y, iv); NOPK(st[5]);
        st[6] = fmaf(st[6] - iv, f1.z, iv); NOPK(st[6]);
        st[7] = fmaf(st[7] - iv, f1.w, iv); NOPK(st[7]);
        float acc0 = fmaf(st[0], q0.x, fmaf(st[1], q0.y, fmaf(st[2], q0.z, st[3] * q0.w)));
        float acc1 = fmaf(st[4], q1.x, fmaf(st[5], q1.y, fmaf(st[6], q1.z, st[7] * q1.w)));
        float o = acc0 + acc1;
        if (tt & 1) { sum16x2(oprev, o); Oc[ooff + (tt - 1) * ostr] = oprev; Oc[ooff + tt * ostr] = o; }
        else oprev = o;
        __builtin_amdgcn_sched_barrier(0);
        if (tt + 1 < 16) { f0 = f0n; f1 = f1n; q0 = q0n; q1 = q1n; iv = ivn; }
      }
    }
    __builtin_amdgcn_sched_barrier(0);
    __syncthreads();
  }
  {
    const long m = base + (nblk - 1) * 16 + stt;
    u16* dp = p.PROJ + m * LDP + C_I + h * 128 + q * 16 + (tid & 15);
    *dp = f2bf(O_[((nblk - 1) & 1) * 256 + stt * 16 + (tid & 15)]);
  }
  __syncthreads();
  {
    float* o = p.out + (s < 8 ? O_PHGRN + (((long)l * 8 + s) * 4 + h) * 16384
                              : O_SHGRN + (((long)l * 8 + (s - 8)) * 4 + h) * 16384);
#pragma unroll
    for (int i = 0; i < 8; ++i) o[((i >> 2) * 64 + ksl4 + (i & 3)) * 128 + row] = st[i];
  }
}

__device__ __forceinline__ void scan_ssd(const Params& p, int l, int s, int h, int q, float* smem) {
  const int tid = opaque_tid(), lane = tid & 63, wid = tid >> 6;
  float* B_ = smem;
  float* C_ = smem + 2048;
  float* X_ = smem + 4096;
  float* O_ = smem + 4352;
  float* DT_ = smem + 5200;
  float* DE_ = smem + 5216;
  const int rl = wid * 4 + (lane >> 4);
  const int row = q * 16 + rl;
  const int ksl4 = (lane & 15) * 4;
  const int g = h >> 2;
  const int base = seq_base(s), T = seq_len(s);
  float st[8];
#pragma unroll
  for (int i = 0; i < 8; ++i) st[i] = 0.f;
  if (s >= 8) {
    const float* sp = p.state_ssm + (((long)l * 8 + (s - 8)) * 8 + h) * 8192 + row * 128 + ksl4;
    float4 a = *(const float4*)sp, b = *(const float4*)(sp + 64);
    st[0] = a.x; st[1] = a.y; st[2] = a.z; st[3] = a.w; st[4] = b.x; st[5] = b.y; st[6] = b.z; st[7] = b.w;
  }
  const float* cw = p.conv_w + (long)l * 4 * 1024;
  const int skq8 = (tid & 15) * 8;
  const int xc_x = h * 64 + q * 16 + (tid & 15);
  const float cx0 = cw[xc_x], cx1 = cw[1024 + xc_x], cx2 = cw[2048 + xc_x], cx3 = cw[3072 + xc_x];
  const float cxb = p.conv_b[l * 1024 + xc_x];
  const float dtb = p.dt_bias[l * 8 + h];
  const float aexp = __expf(p.a_log[l * 8 + h]);
  const float dsk = p.d_skip[l * 8 + h];
  const int stt = tid >> 4;
  const int nblk = T / 16;
  uint4 rawb, rawc;
  float xr[4];
  float dtr = 0.f;
  u16 zc = 0, zn = 0;
#define SSD_LOAD(M0)                                                              \
  {                                                                               \
    {                                                                             \
      const u16* prow = p.PROJ + ((long)(M0) + stt) * LDP + C_XBC + g * 128 + skq8; \
      rawb = *(const uint4*)(prow + 512);                                         \
      rawc = *(const uint4*)(prow + 768);                                         \
    }                                                                             \
    {                                                                             \
      const long mr = (long)(M0) + stt;                                           \
      const u16* colx = p.PROJ + mr * LDP + C_XBC + xc_x;                         \
      _Pragma("unroll") for (int j = 0; j < 4; ++j) {                             \
        const long mm = mr - 3 + j;                                               \
        float vx;                                                                 \
        if (mm >= base) vx = bf2f(colx[(long)(j - 3) * LDP]);                     \
        else vx = (s >= 8) ? p.state_conv[((long)l * 8 + (s - 8)) * 3072 + (3 + (int)(mm - base)) * 1024 + xc_x] : 0.f; \
        xr[j] = vx;                                                               \
      }                                                                           \
    }                                                                             \
    if (tid < 16) dtr = (p.FB + FOFF_DTRAW)[((long)(M0) + tid) * 8 + h];                      \
    zn = p.PROJ[((long)(M0) + stt) * LDP + C_Z + h * 64 + q * 16 + (tid & 15)];   \
  }
  SSD_LOAD(base);
  __syncthreads();
  const bool wr = (lane & 15) == 0;
  const int ooff = wr ? rl : (512 + lane);
  const int ostr = wr ? 16 : 0;
  u16 zp = 0;
  for (int blk = 0; blk < nblk; ++blk) {
    const long m0 = base + blk * 16;
    zp = zc;
    zc = zn;
    float* Oc = O_ + (blk & 1) * 256;
    {
      {
        const unsigned bw[4] = {rawb.x, rawb.y, rawb.z, rawb.w}, cwd[4] = {rawc.x, rawc.y, rawc.z, rawc.w};
        float bv[8], cv[8];
#pragma unroll
        for (int e = 0; e < 8; ++e) {
          bv[e] = bf2f((u16)((bw[e >> 1] >> ((e & 1) * 16)) & 0xffff));
          cv[e] = bf2f((u16)((cwd[e >> 1] >> ((e & 1) * 16)) & 0xffff));
        }
        *(float4*)(B_ + stt * 128 + skq8) = make_float4(bv[0], bv[1], bv[2], bv[3]);
        *(float4*)(B_ + stt * 128 + skq8 + 4) = make_float4(bv[4], bv[5], bv[6], bv[7]);
        *(float4*)(C_ + stt * 128 + skq8) = make_float4(cv[0], cv[1], cv[2], cv[3]);
        *(float4*)(C_ + stt * 128 + skq8 + 4) = make_float4(cv[4], cv[5], cv[6], cv[7]);
      }
      {
        float y = cx0 * xr[0] + cx1 * xr[1] + cx2 * xr[2] + cx3 * xr[3] + cxb;
        X_[stt * 16 + (tid & 15)] = siluf_(y);
      }
      if (tid < 16) {
        float dtv = softplusf_(dtr + dtb);
        DT_[tid] = dtv;
        DE_[tid] = __expf(-aexp * dtv);
      }
    }
    __syncthreads();
    if (blk > 0) {
      u16* pz = p.PROJ + (m0 - 16 + stt) * LDP + C_Z + h * 64 + q * 16 + (tid & 15);
      *pz = f2bf(O_[((blk - 1) & 1) * 256 + stt * 16 + (tid & 15)] * siluf_(bf2f(zp)));
    }
    if (blk + 1 < nblk) SSD_LOAD(m0 + 16);
    __builtin_amdgcn_sched_barrier(0);
    {
      float4 b0 = *(const float4*)(B_ + ksl4), b1 = *(const float4*)(B_ + 64 + ksl4);
      float4 c0 = *(const float4*)(C_ + ksl4), c1 = *(const float4*)(C_ + 64 + ksl4);
      float xv = X_[rl], dt = DT_[0], de = DE_[0];
      float yprev = 0.f, xvprev = 0.f;
#pragma unroll
      for (int tt = 0; tt < 16; ++tt) {
        float4 b0n, b1n, c0n, c1n;
        float xvn, dtn, den;
        if (tt + 1 < 16) {
          const int o_ = (tt + 1) * 128;
          b0n = *(const float4*)(B_ + o_ + ksl4); b1n = *(const float4*)(B_ + o_ + 64 + ksl4);
          c0n = *(const float4*)(C_ + o_ + ksl4); c1n = *(const float4*)(C_ + o_ + 64 + ksl4);
          xvn = X_[(tt + 1) * 16 + rl]; dtn = DT_[tt + 1]; den = DE_[tt + 1];
        }
        __builtin_amdgcn_sched_barrier(0);
        const float xd = xv * dt;
        st[0] = fmaf(st[0], de, xd * b0.x); NOPK(st[0]);
        st[1] = fmaf(st[1], de, xd * b0.y); NOPK(st[1]);
        st[2] = fmaf(st[2], de, xd * b0.z); NOPK(st[2]);
        st[3] = fmaf(st[3], de, xd * b0.w); NOPK(st[3]);
        st[4] = fmaf(st[4], de, xd * b1.x); NOPK(st[4]);
        st[5] = fmaf(st[5], de, xd * b1.y); NOPK(st[5]);
        st[6] = fmaf(st[6], de, xd * b1.z); NOPK(st[6]);
        st[7] = fmaf(st[7], de, xd * b1.w); NOPK(st[7]);
        float acc0 = fmaf(st[0], c0.x, fmaf(st[1], c0.y, fmaf(st[2], c0.z, st[3] * c0.w)));
        float acc1 = fmaf(st[4], c1.x, fmaf(st[5], c1.y, fmaf(st[6], c1.z, st[7] * c1.w)));
        float y = acc0 + acc1;
        if (tt & 1) { sum16x2(yprev, y); Oc[ooff + (tt - 1) * ostr] = yprev + dsk * xvprev; Oc[ooff + tt * ostr] = y + dsk * xv; }
        else { yprev = y; xvprev = xv; }
        __builtin_amdgcn_sched_barrier(0);
        if (tt + 1 < 16) { b0 = b0n; b1 = b1n; c0 = c0n; c1 = c1n; xv = xvn; dt = dtn; de = den; }
      }
    }
    __builtin_amdgcn_sched_barrier(0);
    __syncthreads();
  }
  {
    const long m0 = base + (nblk - 1) * 16;
    u16* pz = p.PROJ + (m0 + stt) * LDP + C_Z + h * 64 + q * 16 + (tid & 15);
    *pz = f2bf(O_[((nblk - 1) & 1) * 256 + stt * 16 + (tid & 15)] * siluf_(bf2f(zc)));
  }
  __syncthreads();
#undef SSD_LOAD
  {
    float* o = p.out + (s < 8 ? O_PSSM + (((long)l * 8 + s) * 8 + h) * 8192
                              : O_SSSM + (((long)l * 8 + (s - 8)) * 8 + h) * 8192);
    *(float4*)(o + row * 128 + ksl4) = make_float4(st[0], st[1], st[2], st[3]);
    *(float4*)(o + row * 128 + 64 + ksl4) = make_float4(st[4], st[5], st[6], st[7]);
  }
  if (h == 0 && q == 0) {
    float* o = p.out + (s < 8 ? O_PCONV + ((long)l * 8 + s) * 3072 : O_SCONV + ((long)l * 8 + (s - 8)) * 3072);
    const long lastblk = (long)(base + T) / 16 - 1;
    for (int i = tid; i < 3072; i += 256) {
      int r = i >> 10, c = i & 1023;
      o[i] = (c < 512) ? bf2f(p.PROJ[(long)(base + T - 3 + r) * LDP + C_XBC + c])
                       : bf2f(p.BND2[(lastblk * 3 + r) * 512 + (c - 512)]);
    }
  }
}

__device__ __forceinline__ void phase_scan(const Params& p, int l, float* smem) {
  for (int u = BID, nb_ = NBLK; u < 1536; u += nb_) {
    int sample = u >= 768;
    int v = sample ? u - 768 : u;
    int type = v % 3, w = v / 3;
    if (type == 0) {
      int q = w & 3, h = (w >> 2) & 7, b = w >> 5;
      scan_rwkv(p, l, b + 8 * sample, h, q, smem);
    } else if (type == 1) {
      int q = w & 7, h = (w >> 3) & 3, b = w >> 5;
      scan_hgrn(p, l, b + 8 * sample, h, q, smem);
    } else {
      int q = w & 3, h = (w >> 2) & 7, b = w >> 5;
      scan_ssd(p, l, b + 8 * sample, h, q, smem);
    }
  }
}

__device__ __forceinline__ void phase_post(const Params& p, int l, float* smem) {
  constexpr int LDG = 516;
  float* GA = smem;
  for (int blk = BID, nb_ = NBLK; blk < NBLK16; blk += nb_) {
    const int tid = opaque_tid(), lane = tid & 63, wid = tid >> 6;
    const int T = tid >> 4, Q = tid & 15;
    const long m0 = (long)blk * 16;
    const long m = m0 + T;
    __syncthreads();
    {
      bf16x8 ag[4];
      const u16* arow = p.PROJ + (m0 + (lane & 15)) * LDP + C_XG + (lane >> 4) * 8;
#pragma unroll
      for (int ks = 0; ks < 4; ++ks) ag[ks] = *(const bf16x8*)(arow + ks * 32);
#pragma unroll
      for (int nt = 0; nt < 8; ++nt) {
        const int n = (wid * 8 + nt) * 16 + (lane & 15);
        f32x4v acc = {0.f, 0.f, 0.f, 0.f};
#pragma unroll
        for (int ks = 0; ks < 4; ++ks) {
          bf16x8 bg = *(const bf16x8*)((p.WB + OFF_G2T) + n * 128 + ks * 32 + (lane >> 4) * 8);
          acc = __builtin_amdgcn_mfma_f32_16x16x32_bf16(ag[ks], bg, acc, 0, 0, 0);
        }
#pragma unroll
        for (int r = 0; r < 4; ++r) GA[((lane >> 4) * 4 + r) * LDG + n] = acc[r];
      }
    }
    __syncthreads();
    u16* row = p.PROJ + m * LDP;
#pragma unroll 1
    for (int g = 0; g < 2; ++g) {
      float y0[8], y1[8], w[8];
      const int c0 = g * 256 + Q * 8, c1 = c0 + 128;
      unpack8(*(const uint4*)(row + C_Z + c0), y0);
      unpack8(*(const uint4*)(row + C_Z + c1), y1);
      float ss = 0.f;
#pragma unroll
      for (int e = 0; e < 8; ++e) ss += y0[e] * y0[e] + y1[e] * y1[e];
      ss = sum16(ss);
      const float rs = rsqrtf(ss * (1.f / 256.f) + 1e-6f);
      ld8(p.ssd_norm_w + l * 512 + c0, w);
#pragma unroll
      for (int e = 0; e < 8; ++e) y0[e] = y0[e] * rs * w[e];
      ld8(p.ssd_norm_w + l * 512 + c1, w);
#pragma unroll
      for (int e = 0; e < 8; ++e) y1[e] = y1[e] * rs * w[e];
      *(uint4*)(row + C_Z + c0) = pack8(y0);
      *(uint4*)(row + C_Z + c1) = pack8(y1);
    }
#pragma unroll 1
    for (int j = 0; j < 4; ++j) {
      const int c0 = j * 128 + Q * 8;
      {
        float oh[8], gg[8], w[8];
        unpack8(*(const uint4*)(row + C_I + c0), oh);
        unpack8(*(const uint4*)(row + C_GG + c0), gg);
        float ss = 0.f;
#pragma unroll
        for (int e = 0; e < 8; ++e) ss += oh[e] * oh[e];
        ss = sum16(ss);
        const float rs = rsqrtf(ss * (1.f / 128.f) + 1e-6f);
        ld8(p.hg_norm_w + l * 512 + c0, w);
#pragma unroll
        for (int e = 0; e < 8; ++e) oh[e] = oh[e] * rs * w[e] * siluf_(gg[e]);
        *(uint4*)(row + C_GG + c0) = pack8(oh);
      }
      {
        float o[8], v[8], w[8], bb[8], ga[8];
        const int head = j * 2 + (Q >> 3);
        unpack8(*(const uint4*)(p.ORW + m * 512 + c0), o);
        unpack8(*(const uint4*)(row + C_V + c0), v);
        float sm = 0.f;
#pragma unroll
        for (int e = 0; e < 8; ++e) sm += o[e];
        const float mean = sum8(sm) * (1.f / 64.f);
        float sv = 0.f;
#pragma unroll
        for (int e = 0; e < 8; ++e) { o[e] -= mean; sv += o[e] * o[e]; }
        const float rstd = rsqrtf(sum8(sv) * (1.f / 64.f) + 64e-5f);
        const float rks = (p.FB + FOFF_RKS)[m * 8 + head];
        ld8(p.rw_lnx_w + l * 512 + c0, w);
        ld8(p.rw_lnx_b + l * 512 + c0, bb);
        ld8(GA + T * LDG + c0, ga);
#pragma unroll
        for (int e = 0; e < 8; ++e) o[e] = (o[e] * rstd * w[e] + bb[e] + rks * v[e]) * ga[e];
        *(uint4*)(row + C_R + c0) = pack8(o);
      }
    }
  }
}

__device__ __forceinline__ void phase_final(const Params& p) {
  const int tid = opaque_tid(), lane = tid & 63, wid = tid >> 6;
  for (int m = BID * 4 + wid, nb_ = NBLK; m < M_TOT; m += nb_ * 4) {
    float* dst;
    if (m < M_PROMPT) {
      int b = m / T_P, t = m - b * T_P;
      if (t < 16) continue;
      dst = p.out + O_YP + ((long)b * 4096 + (t - 16)) * DM;
    } else {
      dst = p.out + O_YS + (long)(m - M_PROMPT) * DM;
    }
    float x[16];
    float ss = 0.f;
#pragma unroll
    for (int j = 0; j < 2; ++j) {
      uint4 raw = *(const uint4*)(p.XB + xb_off(m, lane * 8 + 512 * j));
      unsigned wv[4] = {raw.x, raw.y, raw.z, raw.w};
#pragma unroll
      for (int e = 0; e < 8; ++e) {
        x[j * 8 + e] = bf2f((u16)((wv[e >> 1] >> ((e & 1) * 16)) & 0xffff));
        ss += x[j * 8 + e] * x[j * 8 + e];
      }
    }
    ss = sum64(ss);
    float rs = rsqrtf(ss * (1.f / 1024.f) + 1e-6f);
#pragma unroll
    for (int j = 0; j < 2; ++j) {
      int k0 = lane * 8 + 512 * j;
      float4 w0 = *(const float4*)(p.final_w + k0), w1 = *(const float4*)(p.final_w + k0 + 4);
      *(float4*)(dst + k0) = make_float4(x[j * 8 + 0] * rs * w0.x, x[j * 8 + 1] * rs * w0.y, x[j * 8 + 2] * rs * w0.z,
                                         x[j * 8 + 3] * rs * w0.w);
      *(float4*)(dst + k0 + 4) = make_float4(x[j * 8 + 4] * rs * w1.x, x[j * 8 + 5] * rs * w1.y,
                                             x[j * 8 + 6] * rs * w1.z, x[j * 8 + 7] * rs * w1.w);
    }
  }
}


#define XB_TMO      128
#define XB_XCNT(j)  (256  + 64 * (j))
#define XB_XSUB(j)  (1280 + 64 * (j))
#define XB_XGEN(j)  (2304 + 64 * (j))
#define XB_TOP      3328
#define XB_TOPGEN   3392
#define XCD_BAR_WORDS 3456
#define XB_SPIN_CAP (1u << 22)
__device__ __forceinline__ unsigned xb_ld(unsigned* p) { return __hip_atomic_load(p, __ATOMIC_RELAXED, __HIP_MEMORY_SCOPE_AGENT); }
__device__ __forceinline__ unsigned xb_add(unsigned* p, unsigned v) { return __hip_atomic_fetch_add(p, v, __ATOMIC_RELAXED, __HIP_MEMORY_SCOPE_AGENT); }
__device__ __forceinline__ unsigned xb_xcc_id() { return (unsigned)__builtin_amdgcn_s_getreg((3 << 11) | 20) & 0xFu; }
#define XB_SPIN(cond, bar) do { unsigned _sp = 0; while (cond) { __builtin_amdgcn_s_sleep(1); \
    if ((++_sp & 255u) == 0u) { if (xb_ld(&(bar)[XB_TMO])) break; if (_sp > XB_SPIN_CAP) { atomicAdd(&(bar)[XB_TMO], 1u); break; } } } } while (0)

__device__ __forceinline__ void xcd_barrier_post(unsigned* bar) {
  if (threadIdx.x == 0) (void)xb_add(&bar[XB_XCNT(xb_xcc_id())], 1u);
}
__device__ __forceinline__ void xcd_barrier_complete(unsigned* bar, unsigned x, unsigned& nloc, unsigned& nx) {
  const unsigned G = gridDim.x;
  unsigned sum, cnt, mine, sp = 0u;
  for (;;) {
    sum = 0u; cnt = 0u; mine = 0u;
#pragma unroll
    for (unsigned j = 0; j < 16; ++j) { const unsigned c = xb_ld(&bar[XB_XCNT(j)]); sum += c; cnt += (c > 0u) ? 1u : 0u; mine = (j == x) ? c : mine; }
    if (sum == G) break;
    __builtin_amdgcn_s_sleep(1);
    if ((++sp & 255u) == 0u) { if (xb_ld(&bar[XB_TMO])) break; if (sp > XB_SPIN_CAP) { atomicAdd(&bar[XB_TMO], 1u); break; } }
  }
  nloc = mine > 0u ? mine : 1u; nx = cnt > 0u ? cnt : 1u;
}
__device__ __forceinline__ void xcd_barrier(unsigned* bar, volatile unsigned* st) {
  asm volatile("s_waitcnt vmcnt(0)" ::: "memory");
  __syncthreads();
  if (threadIdx.x == 0) {
    __builtin_amdgcn_s_waitcnt(0);
    const unsigned x = xb_xcc_id();
    unsigned nloc = st[0], nx = st[1];
    if (nloc == 0u) { xcd_barrier_complete(bar, x, nloc, nx); st[0] = nloc; st[1] = nx; }
    const unsigned old = xb_add(&bar[XB_XSUB(x)], 1u);
    const unsigned gen = old / nloc;
    if (old + 1u == (gen + 1u) * nloc) {
      __builtin_amdgcn_fence(__ATOMIC_RELEASE, "agent");
      asm volatile("s_waitcnt vmcnt(0)" ::: "memory");
      const unsigned og = xb_add(&bar[XB_TOP], 1u);
      const unsigned tg = og / nx;
      if (og + 1u == (tg + 1u) * nx) xb_add(&bar[XB_TOPGEN], 1u);
      else XB_SPIN(xb_ld(&bar[XB_TOPGEN]) == tg, bar);
      __builtin_amdgcn_fence(__ATOMIC_ACQUIRE, "agent");
      xb_add(&bar[XB_XGEN(x)], 1u);
      asm volatile("s_waitcnt vmcnt(0)" ::: "memory");
    } else {
      XB_SPIN(xb_ld(&bar[XB_XGEN(x)]) == gen, bar);
      __builtin_amdgcn_fence(__ATOMIC_ACQUIRE, "agent");
      asm volatile("s_waitcnt vmcnt(0)" ::: "memory");
    }
  }
  __syncthreads();
}

constexpr int SMEM_BYTES = 40960;
__device__ __forceinline__ void run_phase(const Params& p, int ph, char* smem) {
  if (ph == 0) { phase_embed(p); return; }
  if (ph == 19) { phase_final(p); return; }
  int l = (ph - 1) / 9, s = (ph - 1) % 9;
  float* fs = (float*)smem;
  switch (s) {
    case 0: phase_convert(p, l, fs); phase_rowstat<true>(p, l, fs); break;
    case 1: phase_gemm<1, true>(p, p.XB, DM, (p.WB + OFF_W1T), 1024, LDP / 128, smem); break;
    case 2: phase_pre(p, l, fs); break;
    case 3: phase_scan(p, l, fs); break;
    case 4: phase_post(p, l, fs); break;
    case 5: phase_gemm<2, false>(p, p.PROJ, LDP, (p.WB + OFF_WOT), 1536, 8, smem); break;
    case 6: phase_rowstat<false>(p, l, fs); break;
    case 7: phase_gemm<3, true>(p, p.XB, DM, (p.WB + OFF_WGU), 1024, 44, smem); break;
    case 8: phase_gemm<2, true>(p, p.PROJ, D_FF, (p.WB + OFF_WDT), D_FF, 8, smem); break;
  }
}
constexpr int N_PHASES = 20;

#if MEGA
__global__ void __launch_bounds__(256, 3) k_mega(Params p) {
  __shared__ __attribute__((aligned(16))) char smem[SMEM_BYTES];
  __shared__ uint4 xb_words;
  if (threadIdx.x == 0) { xb_words = make_uint4(0u, 0u, 0u, 0u); }
  __syncthreads();
  cg::grid_group grid = cg::this_grid();
  float* fs = (float*)smem;
  volatile unsigned* xst = (volatile unsigned*)&xb_words;
  xcd_barrier_post(p.bar);
  phase_embed(p);
  grid.sync();
#define GSYNC() do { unsigned* b_ = p.bar; asm volatile("" : "+s"(b_)); xcd_barrier(b_, xst); } while (0)
  {
    const int L0_ = 0;
    int l = opaque_s(L0_);
    phase_convert(p, l, fs);
    phase_rowstat<true>(p, l, fs);
    GSYNC();
    l = opaque_s(l);
    phase_gemm<1, true>(p, p.XB, DM, (p.WB + OFF_W1T), 1024, LDP / 128, smem);
    GSYNC();
    l = opaque_s(l);
    phase_pre(p, l, fs);
    GSYNC();
    l = opaque_s(l);
    phase_scan(p, l, fs);
    GSYNC();
    l = opaque_s(l);
    phase_post(p, l, fs);
    GSYNC();
    l = opaque_s(l);
    phase_gemm<2, false>(p, p.PROJ, LDP, (p.WB + OFF_WOT), 1536, 8, smem);
    GSYNC();
    l = opaque_s(l);
    phase_rowstat<false>(p, l, fs);
    GSYNC();
    l = opaque_s(l);
    phase_gemm<3, true>(p, p.XB, DM, (p.WB + OFF_WGU), 1024, 44, smem);
    GSYNC();
    l = opaque_s(l);
    phase_gemm<2, true>(p, p.PROJ, D_FF, (p.WB + OFF_WDT), D_FF, 8, smem);
    GSYNC();
  }
  {
    const int L0_ = 1;
    int l = opaque_s(L0_);
    phase_convert(p, l, fs);
    phase_rowstat<true>(p, l, fs);
    GSYNC();
    l = opaque_s(l);
    phase_gemm<1, true>(p, p.XB, DM, (p.WB + OFF_W1T), 1024, LDP / 128, smem);
    GSYNC();
    l = opaque_s(l);
    phase_pre(p, l, fs);
    GSYNC();
    l = opaque_s(l);
    phase_scan(p, l, fs);
    GSYNC();
    l = opaque_s(l);
    phase_post(p, l, fs);
    GSYNC();
    l = opaque_s(l);
    phase_gemm<2, false>(p, p.PROJ, LDP, (p.WB + OFF_WOT), 1536, 8, smem);
    GSYNC();
    l = opaque_s(l);
    phase_rowstat<false>(p, l, fs);
    GSYNC();
    l = opaque_s(l);
    phase_gemm<3, true>(p, p.XB, DM, (p.WB + OFF_WGU), 1024, 44, smem);
    GSYNC();
    l = opaque_s(l);
    phase_gemm<2, true>(p, p.PROJ, D_FF, (p.WB + OFF_WDT), D_FF, 8, smem);
    GSYNC();
  }
  phase_final(p);
}
#else
template <int PH>
__global__ void __launch_bounds__(256, 3) k_phase(Params p) {
  __shared__ __attribute__((aligned(16))) char smem[SMEM_BYTES];
  run_phase(p, PH, smem);
}
template <int PH>
static void launch_all(const Params& p, int grid, hipStream_t stream) {
  hipLaunchKernelGGL(k_phase<PH>, dim3(grid), dim3(256), 0, stream, p);
  if constexpr (PH + 1 < N_PHASES) launch_all<PH + 1>(p, grid, stream);
}
#endif

extern "C" void kernel_launch(void* const* d_in, const int* in_sizes, int n_in, void* d_out, int out_size, void* d_ws,
                              size_t ws_size, hipStream_t stream) {
  Params p{};
  const float** pf = (const float**)&p;
  for (int i = 0; i < 35; ++i) pf[i] = (const float*)d_in[i];
  p.out = (float*)d_out;
  char* ws = (char*)d_ws;
  size_t off = 0;
  auto take = [&](size_t bytes) { char* r = ws + off; off += (bytes + 255) & ~(size_t)255; return r; };
  p.XB = (u16*)take((size_t)M_TOT * DM * 2);
  p.PROJ = (u16*)take((size_t)M_TOT * LDP * 2);
  p.WB = (u16*)take((size_t)WB_TOTAL * 2);
  p.BND = (u16*)take((size_t)NBLK16 * 1792 * 2);
  p.BND2 = (u16*)take((size_t)NBLK16 * 3 * 512 * 2);
  p.ORW = (u16*)take((size_t)M_TOT * 512 * 2);
  p.FB = (float*)take((size_t)FB_TOTAL * 4);
  p.bar = (unsigned*)take((size_t)XCD_BAR_WORDS * 4);
  p.RWX = (u16*)d_out;
  if (off > ws_size) fprintf(stderr, "workspace too small: need %zu have %zu\n", off, ws_size);
#if MEGA
  static int grid_blocks = 0;
  if (!grid_blocks) {
    int dev = 0, cus = 0, per_cu = 0;
    hipGetDevice(&dev);
    hipDeviceGetAttribute(&cus, hipDeviceAttributeMultiprocessorCount, dev);
    hipOccupancyMaxActiveBlocksPerMultiprocessor(&per_cu, k_mega, 256, 0);
    if (per_cu > 3) per_cu = 3;
    grid_blocks = cus * per_cu;
  }
  hipMemsetAsync(p.bar, 0, (size_t)XCD_BAR_WORDS * 4, stream);
  void* args[] = {&p};
  hipError_t e = hipLaunchCooperativeKernel((void*)k_mega, dim3(grid_blocks), dim3(256), args, 0, stream);
  if (e != hipSuccess) fprintf(stderr, "cooperative launch failed: %s (grid %d)\n", hipGetErrorString(e), grid_blocks);
#else
  launch_all<0>(p, 768, stream);
#endif
}
```

```cpp
#include <hip/hip_runtime.h>
#include <hip/hip_bf16.h>
#include <hip/hip_cooperative_groups.h>
#include <cstdio>
namespace cg = cooperative_groups;

#ifndef MEGA
#define MEGA 1
#endif

typedef unsigned short u16;
using bf16x8 = __attribute__((ext_vector_type(8))) short;
using f32x16 = __attribute__((ext_vector_type(16))) float;
using f32x4v = __attribute__((ext_vector_type(4))) float;

constexpr int DM = 1024;
constexpr int M_TOT = 33408;
constexpr int M_PROMPT = 32896;
constexpr int T_P = 4112;
constexpr int LDP = 5376;
constexpr int N_IN = 5384;
constexpr int D_FF = 2816;
constexpr int NBLK16 = M_TOT / 16;
constexpr int C_Z = 0, C_R = 512, C_GG = 1024, C_XBC = 1536, C_K = 2560, C_V = 3072, C_XW = 3584, C_XA = 3648,
              C_XG = 3712, C_Q = 3840, C_F = 4352, C_I = 4864;
constexpr long O_YP = 0, O_YS = 33554432, O_PSSM = 34078720, O_PCONV = 35127296, O_PRWKV = 35176448,
               O_PSHIFT = 35700736, O_PHGRN = 35729408, O_SSSM = 36777984, O_SCONV = 37826560,
               O_SRWKV = 37875712, O_SSHIFT = 38400000, O_SHGRN = 38428672;

constexpr long OFF_W1T = 0, OFF_WOT = 5505024, OFF_WGU = 7077888, OFF_WDT = 12845056, OFF_W2T = 15728640, OFF_A2T = 15761408, OFF_G2T = 15794176, WB_TOTAL = 15859712;
constexpr long FOFF_RS = 0, FOFF_DTRAW = 33408, FOFF_RKS = 300672, FB_TOTAL = 567936;
struct Params {
  const float *x_prompt, *x_sample, *state_ssm, *state_conv, *state_rwkv, *state_shift, *state_hgrn, *meta,
      *norm1_w, *w_in, *conv_w, *conv_b, *dt_bias, *a_log, *d_skip, *ssd_norm_w, *rw_mu, *rw_w0, *rw_w2, *rw_a0,
      *rw_a2, *rw_g2, *rw_kk, *rw_ka, *rw_rk, *rw_lnx_w, *rw_lnx_b, *hg_lb, *hg_norm_w, *w_out, *norm2_w, *w_gate,
      *w_up, *w_down, *final_w;
  float* out;
  u16 *XB, *PROJ, *WB, *BND, *BND2, *ORW, *RWX;
  float *FB;
  unsigned* bar;
};

__device__ __forceinline__ u16 f2bf(float f) {
  unsigned u = __float_as_uint(f);
  u += 0x7fffu + ((u >> 16) & 1u);
  return (u16)(u >> 16);
}
__device__ __forceinline__ float bf2f(u16 h) { return __uint_as_float(((unsigned)h) << 16); }
__device__ __forceinline__ float frcp_(float x) { return __builtin_amdgcn_rcpf(x); }
__device__ __forceinline__ float sigmoidf_(float x) { return frcp_(1.f + __expf(-x)); }
__device__ __forceinline__ float siluf_(float x) { return x * frcp_(1.f + __expf(-x)); }
__device__ __forceinline__ float softplusf_(float x) { return x > 20.f ? x : log1pf(__expf(x)); }

template <int CTRL>
__device__ __forceinline__ float dppf(float v) {
  return __int_as_float(__builtin_amdgcn_update_dpp(0, __float_as_int(v), CTRL, 0xF, 0xF, true));
}
__device__ __forceinline__ float sum16(float v) {
  v += dppf<0xB1>(v);
  v += dppf<0x4E>(v);
  v += dppf<0x141>(v);
  v += dppf<0x140>(v);
  return v;
}
__device__ __forceinline__ void sum16x2(float& a, float& b) {
  a += dppf<0xB1>(a); b += dppf<0xB1>(b);
  a += dppf<0x4E>(a); b += dppf<0x4E>(b);
  a += dppf<0x141>(a); b += dppf<0x141>(b);
  a += dppf<0x140>(a); b += dppf<0x140>(b);
}

__device__ __forceinline__ float sum8(float v) {
  v += dppf<0xB1>(v);
  v += dppf<0x4E>(v);
  v += dppf<0x141>(v);
  return v;
}
__device__ __forceinline__ void unpack8(const uint4& r, float* f) {
  f[0] = __uint_as_float(r.x << 16); f[1] = __uint_as_float(r.x & 0xffff0000u);
  f[2] = __uint_as_float(r.y << 16); f[3] = __uint_as_float(r.y & 0xffff0000u);
  f[4] = __uint_as_float(r.z << 16); f[5] = __uint_as_float(r.z & 0xffff0000u);
  f[6] = __uint_as_float(r.w << 16); f[7] = __uint_as_float(r.w & 0xffff0000u);
}
__device__ __forceinline__ uint4 pack8(const float* f) {
  uint4 r;
  r.x = f2bf(f[0]) | ((unsigned)f2bf(f[1]) << 16);
  r.y = f2bf(f[2]) | ((unsigned)f2bf(f[3]) << 16);
  r.z = f2bf(f[4]) | ((unsigned)f2bf(f[5]) << 16);
  r.w = f2bf(f[6]) | ((unsigned)f2bf(f[7]) << 16);
  return r;
}
__device__ __forceinline__ void ld8(const float* p, float* f) {
  float4 a = *(const float4*)p, b = *(const float4*)(p + 4);
  f[0] = a.x; f[1] = a.y; f[2] = a.z; f[3] = a.w; f[4] = b.x; f[5] = b.y; f[6] = b.z; f[7] = b.w;
}

struct F8 { float v[8]; };
__device__ __forceinline__ F8 up8(const uint4& r) { F8 f; unpack8(r, f.v); return f; }
__device__ __forceinline__ F8 ldf8(const float* p) { F8 f; ld8(p, f.v); return f; }
__device__ __forceinline__ F8 zero8() { F8 f; for (int e = 0; e < 8; ++e) f.v[e] = 0.f; return f; }
__device__ __forceinline__ float sum64(float v) {
  v = sum16(v);
  v += __shfl_xor(v, 16);
  v += __shfl_xor(v, 32);
  return v;
}

#define NOPK(x) asm("" : "+v"(x))
__device__ __forceinline__ int opaque_tid() {
  int t = threadIdx.x;
  asm volatile("" : "+v"(t));
  return t;
}
__device__ __forceinline__ int opaque_s(int v) {
  asm volatile("" : "+s"(v));
  return v;
}
#define BID opaque_s((int)blockIdx.x)
#define NBLK opaque_s((int)gridDim.x)
__device__ __forceinline__ int seq_base(int s) { return s < 8 ? s * T_P : M_PROMPT + (s - 8) * 64; }
__device__ __forceinline__ int seq_len(int s) { return s < 8 ? T_P : 64; }

__device__ __forceinline__ long xb_off(int m, int k);
__device__ __forceinline__ void phase_embed(const Params& p) {
  const long n4 = (long)M_TOT * 256;
  for (long idx = (long)BID * 256 + threadIdx.x, st_ = (long)NBLK * 256; idx < n4; idx += st_) {
    int m = (int)(idx >> 8), c4 = ((int)idx & 255) * 4;
    const float* src;
    if (m < M_PROMPT) {
      int b = m / T_P, t = m - b * T_P;
      src = (t < 16) ? p.meta + (long)t * DM : p.x_prompt + ((long)b * 4096 + (t - 16)) * DM;
    } else {
      src = p.x_sample + (long)(m - M_PROMPT) * DM;
    }
    float4 v = *(const float4*)(src + c4);
    ushort4 o;
    o.x = f2bf(v.x); o.y = f2bf(v.y); o.z = f2bf(v.z); o.w = f2bf(v.w);
    *(ushort4*)(p.XB + xb_off(m, c4)) = o;
  }
}

__device__ __forceinline__ long xb_off(int m, int k) { return ((long)(m >> 7) * 32 + (k >> 5)) * 4096 + (m & 127) * 32 + (k & 31); }
__device__ __forceinline__ long wtile_off(int n, int k, int K) {
  return ((long)(n >> 7) * (K >> 5) + (k >> 5)) * 4096 + (n & 127) * 32 + (k & 31);
}
template <bool HAS_SCALE>
__device__ __forceinline__ void conv_tile(const float* __restrict__ src, int ldsrc, int srccol0, const float* __restrict__ scale,
                          u16* __restrict__ dst, int K, int k0, int n0, float* tile  ) {
  const int tid = opaque_tid();
  __syncthreads();
  {
    int nn = tid & 63, kb = tid >> 6;
#pragma unroll
    for (int i = 0; i < 16; ++i) {
      int kk = kb + 4 * i;
      float v = src[(long)(k0 + kk) * ldsrc + srccol0 + nn];
      if (HAS_SCALE) v *= scale[k0 + kk];
      tile[kk * 65 + nn] = v;
    }
  }
  __syncthreads();
  {
    int nn = tid >> 2, kq = (tid & 3) * 16;
    u16* d = dst + wtile_off(n0 + nn, k0 + kq, K);
#pragma unroll
    for (int j = 0; j < 16; j += 2) {
      unsigned w = f2bf(tile[(kq + j) * 65 + nn]) | ((unsigned)f2bf(tile[(kq + j + 1) * 65 + nn]) << 16);
      *(unsigned*)(d + j) = w;
    }
  }
}

__device__ __forceinline__ int w1_srccol(int n0) {
  if (n0 < 512) return n0;
  if (n0 < 1024) return n0 - 512 + 1544;
  if (n0 < 1536) return n0 - 1024 + 4872;
  if (n0 < 2560) return n0 - 1536 + 512;
  if (n0 < 3840) return n0 - 2560 + 2056;
  return n0 - 3840 + 3336;
}

constexpr int CV_W1 = 16 * 84, CV_WO = 24 * 16, CV_WGU = 16 * 88, CV_WD = 44 * 16;
constexpr int CV_LORA = 32;
constexpr int CV_TOTAL = CV_W1 + CV_WO + CV_WGU + CV_WD + CV_LORA;

__device__ __forceinline__ void phase_convert(const Params& p, int l, float* smem) {
  for (int u = BID, nb_ = NBLK; u < CV_TOTAL; u += nb_) {
    if (u < CV_W1) {
      int kt = u % 16, nt = u / 16;
      conv_tile<true>(p.w_in + (long)l * DM * N_IN, N_IN, w1_srccol(nt * 64), p.norm1_w + l * DM, (p.WB + OFF_W1T), 1024, kt * 64,
                nt * 64, smem);
    } else if (u < CV_W1 + CV_WO) {
      int v = u - CV_W1;
      int kt = v % 24, nt = v / 24;
      conv_tile<false>(p.w_out + (long)l * 1536 * DM, DM, nt * 64, nullptr, (p.WB + OFF_WOT), 1536, kt * 64, nt * 64, smem);
    } else if (u < CV_W1 + CV_WO + CV_WGU) {
      int v = u - CV_W1 - CV_WO;
      int kt = v % 16, nt = v / 16;
      const float* wg = p.w_gate + (long)l * DM * D_FF;
      const float* wu = p.w_up + (long)l * DM * D_FF;
      const float* sc = p.norm2_w + l * DM;
      const int tid = opaque_tid();
      __syncthreads();
      {
        int nn = tid & 63, kb = tid >> 6;
        const float* src = (nn < 32) ? wg : wu;
        int col = nt * 32 + (nn & 31);
#pragma unroll
        for (int i = 0; i < 16; ++i) {
          int kk = kb + 4 * i;
          smem[kk * 65 + nn] = src[(long)(kt * 64 + kk) * D_FF + col] * sc[kt * 64 + kk];
        }
      }
      __syncthreads();
      {
        int nn = tid >> 2, kq = (tid & 3) * 16;
        u16* d = (p.WB + OFF_WGU) + wtile_off(nt * 64 + nn, kt * 64 + kq, 1024);
#pragma unroll
        for (int j = 0; j < 16; j += 2) {
          unsigned w = f2bf(smem[(kq + j) * 65 + nn]) | ((unsigned)f2bf(smem[(kq + j + 1) * 65 + nn]) << 16);
          *(unsigned*)(d + j) = w;
        }
      }
    } else if (u >= CV_W1 + CV_WO + CV_WGU + CV_WD) {
      int v = u - (CV_W1 + CV_WO + CV_WGU + CV_WD);
      const int tid = opaque_tid();
#pragma unroll 4
      for (int i = 0; i < 16; ++i) {
        int e = v * 4096 + i * 256 + tid;
        if (e < 32768) {
          int n = e >> 6, k = e & 63;
          (p.WB + OFF_W2T)[e] = f2bf(p.rw_w2[(long)l * 64 * 512 + k * 512 + n]);
        } else if (e < 65536) {
          int e2 = e - 32768, n = e2 >> 6, k = e2 & 63;
          (p.WB + OFF_A2T)[e2] = f2bf(p.rw_a2[(long)l * 64 * 512 + k * 512 + n]);
        } else {
          int e2 = e - 65536, n = e2 >> 7, k = e2 & 127;
          (p.WB + OFF_G2T)[e2] = f2bf(p.rw_g2[(long)l * 128 * 512 + k * 512 + n]);
        }
      }
    } else {
      int v = u - CV_W1 - CV_WO - CV_WGU;
      int kt = v % 44, nt = v / 44;
      conv_tile<false>(p.w_down + (long)l * D_FF * DM, DM, nt * 64, nullptr, (p.WB + OFF_WDT), D_FF, kt * 64, nt * 64, smem);
    }
  }
}

template <bool WITH_DT>
__device__ __forceinline__ void phase_rowstat(const Params& p, int l, float* smem) {
  const int tid = opaque_tid(), lane = tid & 63, wid = tid >> 6;
  float* dtw = smem;
  if (WITH_DT) {
    __syncthreads();
    const float* w = p.w_in + (long)l * DM * N_IN + 1536;
    const float* nw = p.norm1_w + l * DM;
    for (int i = tid; i < 8192; i += 256) {
      int k = i >> 3, h = i & 7;
      dtw[i] = w[(long)k * N_IN + h] * nw[k];
    }
    __syncthreads();
  }
  for (int blk = BID, nb_ = NBLK; blk < NBLK16; blk += nb_) {
    for (int rr = wid; rr < 16; rr += 4) {
      int m = blk * 16 + rr;
      float ss = 0.f;
      float d[8];
#pragma unroll
      for (int h = 0; h < 8; ++h) d[h] = 0.f;
#pragma unroll 1
      for (int j = 0; j < 4; ++j) {
        int k0 = lane * 4 + 256 * j;
        uint2 raw = *(const uint2*)(p.XB + xb_off(m, k0));
        float xs[4] = {bf2f((u16)(raw.x & 0xffff)), bf2f((u16)(raw.x >> 16)), bf2f((u16)(raw.y & 0xffff)),
                       bf2f((u16)(raw.y >> 16))};
#pragma unroll
        for (int e = 0; e < 4; ++e) {
          float x = xs[e];
          ss += x * x;
          if (WITH_DT) {
            float4 w0 = *(const float4*)(dtw + (k0 + e) * 8);
            float4 w1 = *(const float4*)(dtw + (k0 + e) * 8 + 4);
            d[0] += x * w0.x; d[1] += x * w0.y; d[2] += x * w0.z; d[3] += x * w0.w;
            d[4] += x * w1.x; d[5] += x * w1.y; d[6] += x * w1.z; d[7] += x * w1.w;
          }
        }
      }
      ss = sum64(ss);
      float rs = rsqrtf(ss * (1.f / 1024.f) + 1e-6f);
      if (WITH_DT) {
#pragma unroll
        for (int h = 0; h < 8; ++h) d[h] = sum64(d[h]);
        if (lane == 0) {
#pragma unroll
          for (int h = 0; h < 8; ++h) (p.FB + FOFF_DTRAW)[(long)m * 8 + h] = d[h] * rs;
        }
      }
      if (lane == 0) (p.FB + FOFF_RS)[m] = rs;
    }
  }
}

constexpr int G_BK = 32, G_LDS_ROW = 80;
constexpr int G_OPER_BYTES = 128 * G_LDS_ROW;
template <int MODE, bool A_TILED>
__device__ __forceinline__ void phase_gemm(const Params& p, const u16* __restrict__ A, int lda, const u16* __restrict__ Bt, int K,
                           int nN, char* smem) {
  const int tid = opaque_tid(), lane = tid & 63, wid = tid >> 6, wm = wid >> 1, wn = wid & 1;
  const int nM = M_TOT / 128;
  const int ntiles = nM * nN;
  const int nk = K / G_BK;
  const int lrow = tid >> 2, lkc = tid & 3;
  for (int tile = BID, nb_ = NBLK; tile < ntiles; tile += nb_) {
    constexpr int GM = 32;
    int grp = tile / (GM * nN);
    int first_m = grp * GM;
    int gsz = min(GM, nM - first_m);
    int rem = tile - grp * GM * nN;
    int pm = first_m + rem % gsz, pn = rem / gsz;
    const u16* gA = A_TILED ? A + (long)pm * (K >> 5) * 4096 + lrow * 32 + lkc * 8
                            : A + (long)(pm * 128 + lrow) * lda + lkc * 8;
    const u16* gB = Bt + (long)pn * (K >> 5) * 4096 + lrow * 32 + lkc * 8;
    f32x16 acc[2][2];
#pragma unroll
    for (int i = 0; i < 2; ++i)
#pragma unroll
      for (int j = 0; j < 2; ++j)
#pragma unroll
        for (int r = 0; r < 16; ++r) acc[i][j][r] = 0.f;
    uint4 xa0, xa1, xb0, xb1, ya0, ya1, yb0, yb1, za0, za1, zb0, zb1;
#define G_LOAD(S, KT)                                                  \
  {                                                                    \
    S##a0 = *(const uint4*)(A_TILED ? gA + (long)(KT) * 4096 : gA + (KT) * G_BK);                          \
    S##a1 = *(const uint4*)(A_TILED ? gA + (long)(KT) * 4096 + 2048 : gA + (long)64 * lda + (KT) * G_BK);  \
    S##b0 = *(const uint4*)(gB + (long)(KT) * 4096);                   \
    S##b1 = *(const uint4*)(gB + (long)(KT) * 4096 + 2048);            \
  }
#define G_STORE(S, BUF)                                                \
  {                                                                    \
    char* dA = smem + (BUF) * 2 * G_OPER_BYTES;                        \
    char* dB = dA + G_OPER_BYTES;                                      \
    *(uint4*)(dA + lrow * G_LDS_ROW + lkc * 16) = S##a0;               \
    *(uint4*)(dA + (lrow + 64) * G_LDS_ROW + lkc * 16) = S##a1;        \
    *(uint4*)(dB + lrow * G_LDS_ROW + lkc * 16) = S##b0;               \
    *(uint4*)(dB + (lrow + 64) * G_LDS_ROW + lkc * 16) = S##b1;        \
  }
#define G_READ(BUF, KS, AF, BF)                                                                  \
  {                                                                                              \
    const char* sA = smem + (BUF) * 2 * G_OPER_BYTES;                                            \
    const char* sB = sA + G_OPER_BYTES;                                                          \
    const int koff = ((KS) * 16 + (lane >> 5) * 8) * 2;                                          \
    _Pragma("unroll") for (int i = 0; i < 2; ++i)                                                \
      AF[i] = *(const bf16x8*)(sA + (wm * 64 + i * 32 + (lane & 31)) * G_LDS_ROW + koff);        \
    _Pragma("unroll") for (int j = 0; j < 2; ++j)                                                \
      BF[j] = *(const bf16x8*)(sB + (wn * 64 + j * 32 + (lane & 31)) * G_LDS_ROW + koff);        \
  }
#define G_MMA(AF, BF)                                                                            \
  {                                                                                              \
    __builtin_amdgcn_s_setprio(1);                                                               \
    _Pragma("unroll") for (int i = 0; i < 2; ++i)                                                \
      _Pragma("unroll") for (int j = 0; j < 2; ++j)                                              \
        acc[i][j] = __builtin_amdgcn_mfma_f32_32x32x16_bf16(AF[i], BF[j], acc[i][j], 0, 0, 0);   \
    __builtin_amdgcn_s_setprio(0);                                                               \
  }
    G_LOAD(x, 0);
    G_LOAD(y, 1);
    G_LOAD(z, 2);
    __builtin_amdgcn_sched_barrier(0);
    __syncthreads();
    G_STORE(x, 0);
    __syncthreads();
#define G_STEP(T, SNEXT, SFREE, BUF)                          \
    if ((T) < nk) {                                           \
      bf16x8 af0[2], bf0[2];                                  \
      G_READ(BUF, 0, af0, bf0);                               \
      __builtin_amdgcn_sched_barrier(0);                      \
      if ((T) + 1 < nk) G_STORE(SNEXT, (BUF) ^ 1);            \
      if ((T) + 3 < nk) G_LOAD(SFREE, (T) + 3);               \
      __builtin_amdgcn_sched_barrier(0);                      \
      G_MMA(af0, bf0);                                        \
      G_READ(BUF, 1, af0, bf0);                               \
      G_MMA(af0, bf0);                                        \
      __builtin_amdgcn_sched_barrier(0);                      \
      __syncthreads();                                        \
    }
    for (int kt = 0; kt < nk; kt += 6) {
      G_STEP(kt + 0, y, x, 0);
      G_STEP(kt + 1, z, y, 1);
      G_STEP(kt + 2, x, z, 0);
      G_STEP(kt + 3, y, x, 1);
      G_STEP(kt + 4, z, y, 0);
      G_STEP(kt + 5, x, z, 1);
    }
#undef G_STEP
#undef G_LOAD
#undef G_STORE
#undef G_READ
#undef G_MMA
    int te = tid;
    asm volatile("" : "+v"(te));
    const int lane_e = te & 63, wm_e = te >> 7, wn_e = (te >> 6) & 1;
    const int lr0 = wm_e * 64 + 4 * (lane_e >> 5);
    const int lc0 = wn_e * 64 + (lane_e & 31);
    if (MODE == 1) {
      u16* ST = (u16*)smem;
#pragma unroll
      for (int i = 0; i < 2; ++i)
#pragma unroll
        for (int r = 0; r < 16; ++r) {
          const int lr = lr0 + i * 32 + (r & 3) + 8 * (r >> 2);
          const float rs = (p.FB + FOFF_RS)[pm * 128 + lr];
#pragma unroll
          for (int j = 0; j < 2; ++j) ST[lr * 136 + lc0 + j * 32] = f2bf(acc[i][j][r] * rs);
        }
      __syncthreads();
      const int col0 = pn * 128;
      const int bnd_j = (col0 >= C_R && col0 < C_GG) ? (col0 - C_R) : ((col0 >= C_K && col0 < C_Q) ? (col0 - C_K + 512) : -1);
      const bool bc = (col0 >= C_XBC + 512 && col0 < C_XBC + 1024);
#pragma unroll
      for (int q = 0; q < 8; ++q) {
        const int c = te + 256 * q, crow = c >> 4, cc = (c & 15) * 8;
        const uint4 v = *(const uint4*)(ST + crow * 136 + cc);
        const int row = pm * 128 + crow;
        *(uint4*)(p.PROJ + (long)row * LDP + col0 + cc) = v;
        if (bnd_j >= 0 && (crow & 15) == 15) *(uint4*)(p.BND + (long)(row >> 4) * 1792 + bnd_j + cc) = v;
        if (bc && (crow & 15) >= 13)
          *(uint4*)(p.BND2 + ((long)(row >> 4) * 3 + ((crow & 15) - 13)) * 512 + (col0 - (C_XBC + 512)) + cc) = v;
      }
    } else if (MODE == 2) {
      float* SF = (float*)smem;
#pragma unroll
      for (int i = 0; i < 2; ++i) {
        if (i) __syncthreads();
#pragma unroll
        for (int r = 0; r < 16; ++r) {
          const int l2 = wm_e * 32 + (r & 3) + 8 * (r >> 2) + 4 * (lane_e >> 5);
#pragma unroll
          for (int j = 0; j < 2; ++j) SF[l2 * 132 + lc0 + j * 32] = acc[i][j][r];
        }
        __syncthreads();
#pragma unroll
        for (int q = 0; q < 4; ++q) {
          const int c = te + 256 * q, l2 = c >> 4, cc = (c & 15) * 8;
          const int row = pm * 128 + (l2 >> 5) * 64 + i * 32 + (l2 & 31);
          float d[8], x[8];
          ld8(SF + l2 * 132 + cc, d);
          u16* px = p.XB + xb_off(row, pn * 128 + cc);
          unpack8(*(const uint4*)px, x);
#pragma unroll
          for (int e = 0; e < 8; ++e) x[e] += d[e];
          *(uint4*)px = pack8(x);
        }
      }
    } else {
      u16* ST = (u16*)smem;
      u16* ACT = p.PROJ;
#pragma unroll
      for (int i = 0; i < 2; ++i)
#pragma unroll
        for (int r = 0; r < 16; ++r) {
          const int lr = lr0 + i * 32 + (r & 3) + 8 * (r >> 2);
          const float rs = (p.FB + FOFF_RS)[pm * 128 + lr];
          const float g = acc[i][0][r] * rs, u = acc[i][1][r] * rs;
          ST[lr * 72 + wn_e * 32 + (lane_e & 31)] = f2bf(siluf_(g) * u);
        }
      __syncthreads();
#pragma unroll
      for (int q = 0; q < 4; ++q) {
        const int c = te + 256 * q, crow = c >> 3, cc = (c & 7) * 8;
        const uint4 v = *(const uint4*)(ST + crow * 72 + cc);
        *(uint4*)(ACT + wtile_off(pm * 128 + crow, pn * 64 + cc, D_FF)) = v;
      }
    }
  }
}

__device__ __forceinline__ void phase_pre(const Params& p, int l, float* smem) {
  u16* XWb = (u16*)smem;
  u16* XAb = (u16*)smem + 16 * 72;
  constexpr int LDW = 260;
  float* AW = smem + 1152;
  float* AA = smem + 1152 + 16 * LDW;
  const float* mu = p.rw_mu + l * 1792;
  for (int blk = BID, nb_ = NBLK; blk < NBLK16; blk += nb_) {
    const int tid = opaque_tid(), lane = tid & 63, wid = tid >> 6;
    const int T = tid >> 4, Q = tid & 15;
    const int m0 = blk * 16;
    const long m = m0 + T;
    int s, t0;
    if (m0 < M_PROMPT) { s = m0 / T_P; t0 = m0 - s * T_P; } else { s = 8 + (m0 - M_PROMPT) / 64; t0 = (m0 - M_PROMPT) & 63; }
    const bool first = (t0 == 0);
    u16* row = p.PROJ + m * LDP;
    const u16* bndrow = p.BND + (long)(blk > 0 ? blk - 1 : 0) * 1792;
    const float* shrow = p.state_shift + ((long)l * 8 + (s >= 8 ? s - 8 : 0)) * 1792;
    const bool seqstart = first && (T == 0);
#define SHIFT8(DST, J, COL)                                                                 \
    {                                                                                       \
      float cur_[8], pv_[8], mj_[8];                                                        \
      unpack8(*(const uint4*)(row + (COL)), cur_);                                          \
      const u16* ps_ = (T > 0) ? (row - LDP + (COL)) : (bndrow + (J));                      \
      unpack8(*(const uint4*)ps_, pv_);                                                     \
      if (seqstart) {                                                                       \
        if (s >= 8) ld8(shrow + (J), pv_);                                                  \
        else { _Pragma("unroll") for (int e = 0; e < 8; ++e) pv_[e] = 0.f; }                \
      }                                                                                     \
      ld8(mu + (J), mj_);                                                                   \
      _Pragma("unroll") for (int e = 0; e < 8; ++e) DST[e] = cur_[e] + (pv_[e] - cur_[e]) * mj_[e]; \
    }
    __syncthreads();
    {
      float sh0[8], sh1[8];
      SHIFT8(sh0, 1536 + Q * 8, C_XW + Q * 8);
      SHIFT8(sh1, 1664 + Q * 8, C_XG + Q * 8);
      __syncthreads();
      if (Q < 8) {
#pragma unroll
        for (int e = 0; e < 8; ++e) sh0[e] = tanhf(sh0[e]);
        *(uint4*)(XWb + T * 72 + Q * 8) = pack8(sh0);
      } else {
        *(uint4*)(XAb + T * 72 + (Q - 8) * 8) = pack8(sh0);
      }
#pragma unroll
      for (int e = 0; e < 8; ++e) sh1[e] = sigmoidf_(sh1[e]);
      *(uint4*)(row + C_XG + Q * 8) = pack8(sh1);
    }
    __syncthreads();
#pragma unroll 1
    for (int c = 0; c < 2; ++c) {
      {
        bf16x8 axw[2], axa[2];
#pragma unroll
        for (int ks = 0; ks < 2; ++ks) {
          axw[ks] = *(const bf16x8*)(XWb + (lane & 15) * 72 + ks * 32 + (lane >> 4) * 8);
          axa[ks] = *(const bf16x8*)(XAb + (lane & 15) * 72 + ks * 32 + (lane >> 4) * 8);
        }
#pragma unroll
        for (int nt = 0; nt < 4; ++nt) {
          const int ncol = (wid * 4 + nt) * 16 + (lane & 15);
          const int n = c * 256 + ncol;
          f32x4v accw = {0.f, 0.f, 0.f, 0.f}, acca = {0.f, 0.f, 0.f, 0.f};
#pragma unroll
          for (int ks = 0; ks < 2; ++ks) {
            bf16x8 bw = *(const bf16x8*)((p.WB + OFF_W2T) + n * 64 + ks * 32 + (lane >> 4) * 8);
            bf16x8 ba = *(const bf16x8*)((p.WB + OFF_A2T) + n * 64 + ks * 32 + (lane >> 4) * 8);
            accw = __builtin_amdgcn_mfma_f32_16x16x32_bf16(axw[ks], bw, accw, 0, 0, 0);
            acca = __builtin_amdgcn_mfma_f32_16x16x32_bf16(axa[ks], ba, acca, 0, 0, 0);
          }
#pragma unroll
          for (int r = 0; r < 4; ++r) {
            AW[((lane >> 4) * 4 + r) * LDW + ncol] = accw[r];
            AA[((lane >> 4) * 4 + r) * LDW + ncol] = acca[r];
          }
        }
      }
#pragma unroll 1
      for (int jj = 0; jj < 2; ++jj) {
        const int ch0 = c * 256 + jj * 128 + Q * 8;
        const int head = c * 4 + jj * 2 + (Q >> 3);
        float rt[8], kt[8];
        uint4 vpk;
        SHIFT8(rt, ch0, C_R + ch0);
        SHIFT8(kt, 512 + ch0, C_K + ch0);
        {
          float vt[8];
          SHIFT8(vt, 1024 + ch0, C_V + ch0);
          vpk = pack8(vt);
        }
        __syncthreads();
        float aw[8], aa[8], w0[8], a0[8];
        ld8(AW + T * LDW + jj * 128 + Q * 8, aw);
        ld8(AA + T * LDW + jj * 128 + Q * 8, aa);
        ld8(p.rw_w0 + l * 512 + ch0, w0);
        ld8(p.rw_a0 + l * 512 + ch0, a0);
        {
          float uu[8];
#pragma unroll
          for (int e = 0; e < 8; ++e) {
            float lw = -softplusf_(-(w0[e] + aw[e])) - 0.5f;
            uu[e] = -__expf(lw);
            aa[e] = sigmoidf_(a0[e] + aa[e]);
          }
          *(uint4*)(p.RWX + m * 1536 + ch0) = pack8(uu);
        }
        *(uint4*)(row + C_R + ch0) = pack8(rt);
        *(uint4*)(row + C_V + ch0) = vpk;
        float kkw[8], kaw[8], rkw[8], kk[8], kp[8];
        ld8(p.rw_kk + l * 512 + ch0, kkw);
        ld8(p.rw_ka + l * 512 + ch0, kaw);
        ld8(p.rw_rk + l * 512 + ch0, rkw);
        float ssq = 0.f, rks = 0.f;
#pragma unroll
        for (int e = 0; e < 8; ++e) {
          kk[e] = kt[e] * kkw[e];
          ssq += kk[e] * kk[e];
          kp[e] = kt[e] * (1.f + (aa[e] - 1.f) * kaw[e]);
          rks += rt[e] * kp[e] * rkw[e];
        }
        ssq = sum8(ssq);
        rks = sum8(rks);
        const float rn = rsqrtf(ssq + 1e-12f);
        *(uint4*)(row + C_K + ch0) = pack8(kp);
#pragma unroll
        for (int e = 0; e < 8; ++e) kk[e] *= rn;
        *(uint4*)(p.RWX + m * 1536 + 512 + ch0) = pack8(kk);
#pragma unroll
        for (int e = 0; e < 8; ++e) kk[e] *= aa[e];
        *(uint4*)(p.RWX + m * 1536 + 1024 + ch0) = pack8(kk);
        if ((Q & 7) == 0) (p.FB + FOFF_RKS)[m * 8 + head] = rks;
      }
      __syncthreads();
    }
    {
      u16* CB = (u16*)(smem + 1152);
      const u16* b2row = p.BND2 + (long)(blk > 0 ? blk - 1 : 0) * 1536;
      const float* scrow = p.state_conv + ((long)l * 8 + (s >= 8 ? s - 8 : 0)) * 3072 + 512;
#pragma unroll 1
      for (int j = 0; j < 4; ++j) {
        const int cc0 = j * 128 + Q * 8;
        const float* cw = p.conv_w + (long)l * 4096 + 512 + cc0;
        float acc[8];
        ld8(p.conv_b + l * 1024 + 512 + cc0, acc);
#pragma unroll
        for (int d = 0; d < 4; ++d) {
          const int tr = T - 3 + d;
          const int trn = tr < 0 ? 3 + tr : 0;
          float u[8], w[8];
          const u16* src = (tr >= 0) ? (row + (long)(d - 3) * LDP + C_XBC + 512 + cc0) : (b2row + trn * 512 + cc0);
          unpack8(*(const uint4*)src, u);
          if (first && tr < 0) {
            if (s >= 8) ld8(scrow + trn * 1024 + cc0, u);
            else {
#pragma unroll
              for (int e = 0; e < 8; ++e) u[e] = 0.f;
            }
          }
          ld8(cw + d * 1024, w);
#pragma unroll
          for (int e = 0; e < 8; ++e) acc[e] += w[e] * u[e];
        }
#pragma unroll
        for (int e = 0; e < 8; ++e) acc[e] = siluf_(acc[e]);
        *(uint4*)(CB + T * 512 + cc0) = pack8(acc);
      }
      __syncthreads();
#pragma unroll
      for (int j = 0; j < 4; ++j)
        *(uint4*)(row + C_XBC + 512 + j * 128 + Q * 8) = *(const uint4*)(CB + T * 512 + j * 128 + Q * 8);
    }
#undef SHIFT8
    if (t0 + 16 == seq_len(s)) {
      float* o = p.out + (s < 8 ? O_PSHIFT + ((long)l * 8 + s) * 1792 : O_SSHIFT + ((long)l * 8 + (s - 8)) * 1792);
      for (int j = tid; j < 1792; j += 256) o[j] = bf2f(p.BND[(long)blk * 1792 + j]);
    }
  }
}

__device__ __forceinline__ void scan_rwkv(const Params& p, int l, int s, int h, int q, float* smem) {
  const int tid = opaque_tid(), lane = tid & 63, wid = tid >> 6;
  float* R_ = smem;
  float* W_ = smem + 1024;
  float* K_ = smem + 2048;
  float* A_ = smem + 3072;
  float* B_ = smem + 4096;
  float* V_ = smem + 5120;
  float* O_ = smem + 5376;
  const int rl = wid * 4 + (lane >> 4);
  const int row = q * 16 + rl;
  const int ksl = (lane & 15) * 4;
  const int base = seq_base(s), T = seq_len(s);
  float s0 = 0.f, s1 = 0.f, s2 = 0.f, s3 = 0.f;
  if (s >= 8) {
    const float* st = p.state_rwkv + (((long)l * 8 + (s - 8)) * 8 + h) * 4096 + row * 64 + ksl;
    float4 v = *(const float4*)st;
    s0 = v.x; s1 = v.y; s2 = v.z; s3 = v.w;
  }
  const int stt = tid >> 4, skq = (tid & 15) * 4;
  const int nblk = T / 16;
  ushort4 r4, k4, u4, a4, b4;
  u16 vv;
  {
    const long m = base + stt;
    const u16* pr = p.PROJ + m * LDP;
    const u16* px = p.RWX + m * 1536;
    r4 = *(const ushort4*)(pr + C_R + h * 64 + skq);
    k4 = *(const ushort4*)(pr + C_K + h * 64 + skq);
    u4 = *(const ushort4*)(px + h * 64 + skq);
    a4 = *(const ushort4*)(px + 512 + h * 64 + skq);
    b4 = *(const ushort4*)(px + 1024 + h * 64 + skq);
    vv = pr[C_V + h * 64 + q * 16 + (tid & 15)];
  }
  __syncthreads();
  float* TR_ = smem + 5376 + 512;
  const bool wr = (lane & 15) == 0;
  const int ooff = wr ? rl : (512 + lane);
  const int ostr = wr ? 16 : 0;
  for (int blk = 0; blk < nblk; ++blk) {
    const long m = base + blk * 16 + stt;
    float* Oc = O_ + (blk & 1) * 256;
    {
      *(float4*)(R_ + stt * 64 + skq) = make_float4(bf2f(r4.x), bf2f(r4.y), bf2f(r4.z), bf2f(r4.w));
      *(float4*)(K_ + stt * 64 + skq) = make_float4(bf2f(k4.x), bf2f(k4.y), bf2f(k4.z), bf2f(k4.w));
      *(float4*)(W_ + stt * 64 + skq) =
          make_float4(__expf(bf2f(u4.x)), __expf(bf2f(u4.y)), __expf(bf2f(u4.z)), __expf(bf2f(u4.w)));
      *(float4*)(A_ + stt * 64 + skq) = make_float4(-bf2f(a4.x), -bf2f(a4.y), -bf2f(a4.z), -bf2f(a4.w));
      *(float4*)(B_ + stt * 64 + skq) = make_float4(bf2f(b4.x), bf2f(b4.y), bf2f(b4.z), bf2f(b4.w));
      V_[stt * 16 + (tid & 15)] = bf2f(vv);
    }
    __syncthreads();
    if (blk > 0)
      p.ORW[(m - 16) * 512 + h * 64 + q * 16 + (tid & 15)] = f2bf(O_[((blk - 1) & 1) * 256 + stt * 16 + (tid & 15)]);
    if (blk + 1 < nblk) {
      const u16* pr = p.PROJ + (m + 16) * LDP;
      const u16* px = p.RWX + (m + 16) * 1536;
      r4 = *(const ushort4*)(pr + C_R + h * 64 + skq);
      k4 = *(const ushort4*)(pr + C_K + h * 64 + skq);
      u4 = *(const ushort4*)(px + h * 64 + skq);
      a4 = *(const ushort4*)(px + 512 + h * 64 + skq);
      b4 = *(const ushort4*)(px + 1024 + h * 64 + skq);
      vv = pr[C_V + h * 64 + q * 16 + (tid & 15)];
    }
    __builtin_amdgcn_sched_barrier(0);
    {
      float4 a = *(const float4*)(A_ + ksl), w = *(const float4*)(W_ + ksl), b = *(const float4*)(B_ + ksl);
      float4 k = *(const float4*)(K_ + ksl), r = *(const float4*)(R_ + ksl);
      float v = V_[rl];
      float opart = 0.f;
#pragma unroll
      for (int tt = 0; tt < 16; ++tt) {
        float4 an, wn, bn, kn, rn;
        float vn;
        if (tt + 1 < 16) {
          an = *(const float4*)(A_ + (tt + 1) * 64 + ksl); wn = *(const float4*)(W_ + (tt + 1) * 64 + ksl);
          bn = *(const float4*)(B_ + (tt + 1) * 64 + ksl); kn = *(const float4*)(K_ + (tt + 1) * 64 + ksl);
          rn = *(const float4*)(R_ + (tt + 1) * 64 + ksl); vn = V_[(tt + 1) * 16 + rl];
        }
        __builtin_amdgcn_sched_barrier(0);
        float sa = fmaf(s0, a.x, fmaf(s1, a.y, fmaf(s2, a.z, s3 * a.w)));
        if (tt > 0) { sum16x2(sa, opart); Oc[ooff + (tt - 1) * ostr] = opart; }
        else sa = sum16(sa);
        s0 = fmaf(s0, w.x, fmaf(sa, b.x, v * k.x)); NOPK(s0);
        s1 = fmaf(s1, w.y, fmaf(sa, b.y, v * k.y)); NOPK(s1);
        s2 = fmaf(s2, w.z, fmaf(sa, b.z, v * k.z)); NOPK(s2);
        s3 = fmaf(s3, w.w, fmaf(sa, b.w, v * k.w)); NOPK(s3);
        opart = fmaf(s0, r.x, fmaf(s1, r.y, fmaf(s2, r.z, s3 * r.w)));
        if (tt == 15) { opart = sum16(opart); Oc[ooff + 15 * ostr] = opart; }
        __builtin_amdgcn_sched_barrier(0);
        if (tt + 1 < 16) { a = an; w = wn; b = bn; k = kn; r = rn; v = vn; }
      }
    }
    __builtin_amdgcn_sched_barrier(0);
    __syncthreads();
  }
  {
    const long m = base + (nblk - 1) * 16 + stt;
    p.ORW[m * 512 + h * 64 + q * 16 + (tid & 15)] = f2bf(O_[((nblk - 1) & 1) * 256 + stt * 16 + (tid & 15)]);
  }
  __syncthreads();
  {
    float* o = p.out + (s < 8 ? O_PRWKV + (((long)l * 8 + s) * 8 + h) * 4096
                              : O_SRWKV + (((long)l * 8 + (s - 8)) * 8 + h) * 4096);
    *(float4*)(o + row * 64 + ksl) = make_float4(s0, s1, s2, s3);
  }
}

__device__ __forceinline__ void scan_hgrn(const Params& p, int l, int s, int h, int q, float* smem) {
  const int tid = opaque_tid(), lane = tid & 63, wid = tid >> 6;
  float* Q_ = smem;
  float* F_ = smem + 2048;
  float* G_ = smem + 4096;
  float* I_ = smem + 6144;
  float* O_ = smem + 6400;
  const int rl = wid * 4 + (lane >> 4);
  const int row = q * 16 + rl;
  const int ksl4 = (lane & 15) * 4;
  const int base = seq_base(s), T = seq_len(s);
  float st[8];
#pragma unroll
  for (int i = 0; i < 8; ++i) st[i] = 0.f;
  if (s >= 8) {
    const float* sp = p.state_hgrn + (((long)l * 8 + (s - 8)) * 4 + h) * 16384;
#pragma unroll
    for (int i = 0; i < 8; ++i) st[i] = sp[((i >> 2) * 64 + ksl4 + (i & 3)) * 128 + row];
  }
  const int stt = tid >> 4, skq = (tid & 15) * 8;
  float lb[8];
#pragma unroll
  for (int i = 0; i < 8; ++i) {
    if (l == 0) lb[i] = 0.f;
    else {
      float x0 = p.hg_lb[h * 128 + skq + i], x1 = p.hg_lb[512 + h * 128 + skq + i];
      lb[i] = frcp_(1.f + __expf(x0 - x1));
    }
  }
  const int nblk = T / 16;
  uint4 q8, f8;
  u16 iv16;
  {
    const u16* pr = p.PROJ + (long)(base + stt) * LDP;
    q8 = *(const uint4*)(pr + C_Q + h * 128 + skq);
    f8 = *(const uint4*)(pr + C_F + h * 128 + skq);
    iv16 = pr[C_I + h * 128 + q * 16 + (tid & 15)];
  }
  __syncthreads();
  float* TR_ = smem + 6400 + 512;
  const bool wr = (lane & 15) == 0;
  const int ooff = wr ? rl : (512 + lane);
  const int ostr = wr ? 16 : 0;
  for (int blk = 0; blk < nblk; ++blk) {
    const long m = base + blk * 16 + stt;
    float* Oc = O_ + (blk & 1) * 256;
    {
      unsigned qw[4] = {q8.x, q8.y, q8.z, q8.w}, fw[4] = {f8.x, f8.y, f8.z, f8.w};
      float qv[8], fv[8];
#pragma unroll
      for (int e = 0; e < 8; ++e) {
        qv[e] = bf2f((u16)((qw[e >> 1] >> ((e & 1) * 16)) & 0xffff));
        float fz = bf2f((u16)((fw[e >> 1] >> ((e & 1) * 16)) & 0xffff));
        float ex = __expf(-fz);
        float sg = frcp_(1.f + ex);
        fv[e] = lb[e] + (1.f - lb[e]) * sg;
      }
      *(float4*)(Q_ + stt * 128 + skq) = make_float4(qv[0], qv[1], qv[2], qv[3]);
      *(float4*)(Q_ + stt * 128 + skq + 4) = make_float4(qv[4], qv[5], qv[6], qv[7]);
      *(float4*)(F_ + stt * 128 + skq) = make_float4(fv[0], fv[1], fv[2], fv[3]);
      *(float4*)(F_ + stt * 128 + skq + 4) = make_float4(fv[4], fv[5], fv[6], fv[7]);
      I_[stt * 16 + (tid & 15)] = bf2f(iv16);
    }
    __syncthreads();
    if (blk > 0) {
      u16* dp = p.PROJ + (m - 16) * LDP + C_I + h * 128 + q * 16 + (tid & 15);
      *dp = f2bf(O_[((blk - 1) & 1) * 256 + stt * 16 + (tid & 15)]);
    }
    if (blk + 1 < nblk) {
      const u16* pr = p.PROJ + (m + 16) * LDP;
      q8 = *(const uint4*)(pr + C_Q + h * 128 + skq);
      f8 = *(const uint4*)(pr + C_F + h * 128 + skq);
      iv16 = pr[C_I + h * 128 + q * 16 + (tid & 15)];
    }
    __builtin_amdgcn_sched_barrier(0);
    {
      float4 f0 = *(const float4*)(F_ + ksl4), f1 = *(const float4*)(F_ + 64 + ksl4);
      float4 q0 = *(const float4*)(Q_ + ksl4), q1 = *(const float4*)(Q_ + 64 + ksl4);
      float iv = I_[rl];
      float oprev = 0.f;
#pragma unroll
      for (int tt = 0; tt < 16; ++tt) {
        float4 f0n, f1n, q0n, q1n;
        float ivn;
        if (tt + 1 < 16) {
          const int o_ = (tt + 1) * 128;
          f0n = *(const float4*)(F_ + o_ + ksl4); f1n = *(const float4*)(F_ + o_ + 64 + ksl4);
          q0n = *(const float4*)(Q_ + o_ + ksl4); q1n = *(const float4*)(Q_ + o_ + 64 + ksl4);
          ivn = I_[(tt + 1) * 16 + rl];
        }
        __builtin_amdgcn_sched_barrier(0);
        st[0] = fmaf(st[0] - iv, f0.x, iv); NOPK(st[0]);
        st[1] = fmaf(st[1] - iv, f0.y, iv); NOPK(st[1]);
        st[2] = fmaf(st[2] - iv, f0.z, iv); NOPK(st[2]);
        st[3] = fmaf(st[3] - iv, f0.w, iv); NOPK(st[3]);
        st[4] = fmaf(st[4] - iv, f1.x, iv); NOPK(st[4]);
        st[5] = fmaf(st[5] - iv, f1.y, iv); NOPK(st[5]);
        st[6] = fmaf(st[6] - iv, f1.z, iv); NOPK(st[6]);
        st[7] = fmaf(st[7] - iv, f1.w, iv); NOPK(st[7]);
        float acc0 = fmaf(st[0], q0.x, fmaf(st[1], q0.y, fmaf(st[2], q0.z, st[3] * q0.w)));
        float acc1 = fmaf(st[4], q1.x, fmaf(st[5], q1.y, fmaf(st[6], q1.z, st[7] * q1.w)));
        float o = acc0 + acc1;
        if (tt & 1) { sum16x2(oprev, o); Oc[ooff + (tt - 1) * ostr] = oprev; Oc[ooff + tt * ostr] = o; }
        else oprev = o;
        __builtin_amdgcn_sched_barrier(0);
        if (tt + 1 < 16) { f0 = f0n; f1 = f1n; q0 = q0n; q1 = q1n; iv = ivn; }
      }
    }
    __builtin_amdgcn_sched_barrier(0);
    __syncthreads();
  }
  {
    const long m = base + (nblk - 1) * 16 + stt;
    u16* dp = p.PROJ + m * LDP + C_I + h * 128 + q * 16 + (tid & 15);
    *dp = f2bf(O_[((nblk - 1) & 1) * 256 + stt * 16 + (tid & 15)]);
  }
  __syncthreads();
  {
    float* o = p.out + (s < 8 ? O_PHGRN + (((long)l * 8 + s) * 4 + h) * 16384
                              : O_SHGRN + (((long)l * 8 + (s - 8)) * 4 + h) * 16384);
#pragma unroll
    for (int i = 0; i < 8; ++i) o[((i >> 2) * 64 + ksl4 + (i & 3)) * 128 + row] = st[i];
  }
}

__device__ __forceinline__ void scan_ssd(const Params& p, int l, int s, int h, int q, float* smem) {
  const int tid = opaque_tid(), lane = tid & 63, wid = tid >> 6;
  float* B_ = smem;
  float* C_ = smem + 2048;
  float* X_ = smem + 4096;
  float* O_ = smem + 4352;
  float* DT_ = smem + 5200;
  float* DE_ = smem + 5216;
  const int rl = wid * 4 + (lane >> 4);
  const int row = q * 16 + rl;
  const int ksl4 = (lane & 15) * 4;
  const int g = h >> 2;
  const int base = seq_base(s), T = seq_len(s);
  float st[8];
#pragma unroll
  for (int i = 0; i < 8; ++i) st[i] = 0.f;
  if (s >= 8) {
    const float* sp = p.state_ssm + (((long)l * 8 + (s - 8)) * 8 + h) * 8192 + row * 128 + ksl4;
    float4 a = *(const float4*)sp, b = *(const float4*)(sp + 64);
    st[0] = a.x; st[1] = a.y; st[2] = a.z; st[3] = a.w; st[4] = b.x; st[5] = b.y; st[6] = b.z; st[7] = b.w;
  }
  const float* cw = p.conv_w + (long)l * 4 * 1024;
  const int skq8 = (tid & 15) * 8;
  const int xc_x = h * 64 + q * 16 + (tid & 15);
  const float cx0 = cw[xc_x], cx1 = cw[1024 + xc_x], cx2 = cw[2048 + xc_x], cx3 = cw[3072 + xc_x];
  const float cxb = p.conv_b[l * 1024 + xc_x];
  const float dtb = p.dt_bias[l * 8 + h];
  const float aexp = __expf(p.a_log[l * 8 + h]);
  const float dsk = p.d_skip[l * 8 + h];
  const int stt = tid >> 4;
  const int nblk = T / 16;
  uint4 rawb, rawc;
  float xr[4];
  float dtr = 0.f;
  u16 zc = 0, zn = 0;
#define SSD_LOAD(M0)                                                              \
  {                                                                               \
    {                                                                             \
      const u16* prow = p.PROJ + ((long)(M0) + stt) * LDP + C_XBC + g * 128 + skq8; \
      rawb = *(const uint4*)(prow + 512);                                         \
      rawc = *(const uint4*)(prow + 768);                                         \
    }                                                                             \
    {                                                                             \
      const long mr = (long)(M0) + stt;                                           \
      const u16* colx = p.PROJ + mr * LDP + C_XBC + xc_x;                         \
      _Pragma("unroll") for (int j = 0; j < 4; ++j) {                             \
        const long mm = mr - 3 + j;                                               \
        float vx;                                                                 \
        if (mm >= base) vx = bf2f(colx[(long)(j - 3) * LDP]);                     \
        else vx = (s >= 8) ? p.state_conv[((long)l * 8 + (s - 8)) * 3072 + (3 + (int)(mm - base)) * 1024 + xc_x] : 0.f; \
        xr[j] = vx;                                                               \
      }                                                                           \
    }                                                                             \
    if (tid < 16) dtr = (p.FB + FOFF_DTRAW)[((long)(M0) + tid) * 8 + h];                      \
    zn = p.PROJ[((long)(M0) + stt) * LDP + C_Z + h * 64 + q * 16 + (tid & 15)];   \
  }
  SSD_LOAD(base);
  __syncthreads();
  const bool wr = (lane & 15) == 0;
  const int ooff = wr ? rl : (512 + lane);
  const int ostr = wr ? 16 : 0;
  u16 zp = 0;
  for (int blk = 0; blk < nblk; ++blk) {
    const long m0 = base + blk * 16;
    zp = zc;
    zc = zn;
    float* Oc = O_ + (blk & 1) * 256;
    {
      {
        const unsigned bw[4] = {rawb.x, rawb.y, rawb.z, rawb.w}, cwd[4] = {rawc.x, rawc.y, rawc.z, rawc.w};
        float bv[8], cv[8];
#pragma unroll
        for (int e = 0; e < 8; ++e) {
          bv[e] = bf2f((u16)((bw[e >> 1] >> ((e & 1) * 16)) & 0xffff));
          cv[e] = bf2f((u16)((cwd[e >> 1] >> ((e & 1) * 16)) & 0xffff));
        }
        *(float4*)(B_ + stt * 128 + skq8) = make_float4(bv[0], bv[1], bv[2], bv[3]);
        *(float4*)(B_ + stt * 128 + skq8 + 4) = make_float4(bv[4], bv[5], bv[6], bv[7]);
        *(float4*)(C_ + stt * 128 + skq8) = make_float4(cv[0], cv[1], cv[2], cv[3]);
        *(float4*)(C_ + stt * 128 + skq8 + 4) = make_float4(cv[4], cv[5], cv[6], cv[7]);
      }
      {
        float y = cx0 * xr[0] + cx1 * xr[1] + cx2 * xr[2] + cx3 * xr[3] + cxb;
        X_[stt * 16 + (tid & 15)] = siluf_(y);
      }
      if (tid < 16) {
        float dtv = softplusf_(dtr + dtb);
        DT_[tid] = dtv;
        DE_[tid] = __expf(-aexp * dtv);
      }
    }
    __syncthreads();
    if (blk > 0) {
      u16* pz = p.PROJ + (m0 - 16 + stt) * LDP + C_Z + h * 64 + q * 16 + (tid & 15);
      *pz = f2bf(O_[((blk - 1) & 1) * 256 + stt * 16 + (tid & 15)] * siluf_(bf2f(zp)));
    }
    if (blk + 1 < nblk) SSD_LOAD(m0 + 16);
    __builtin_amdgcn_sched_barrier(0);
    {
      float4 b0 = *(const float4*)(B_ + ksl4), b1 = *(const float4*)(B_ + 64 + ksl4);
      float4 c0 = *(const float4*)(C_ + ksl4), c1 = *(const float4*)(C_ + 64 + ksl4);
      float xv = X_[rl], dt = DT_[0], de = DE_[0];
      float yprev = 0.f, xvprev = 0.f;
#pragma unroll
      for (int tt = 0; tt < 16; ++tt) {
        float4 b0n, b1n, c0n, c1n;
        float xvn, dtn, den;
        if (tt + 1 < 16) {
          const int o_ = (tt + 1) * 128;
          b0n = *(const float4*)(B_ + o_ + ksl4); b1n = *(const float4*)(B_ + o_ + 64 + ksl4);
          c0n = *(const float4*)(C_ + o_ + ksl4); c1n = *(const float4*)(C_ + o_ + 64 + ksl4);
          xvn = X_[(tt + 1) * 16 + rl]; dtn = DT_[tt + 1]; den = DE_[tt + 1];
        }
        __builtin_amdgcn_sched_barrier(0);
        const float xd = xv * dt;
        st[0] = fmaf(st[0], de, xd * b0.x); NOPK(st[0]);
        st[1] = fmaf(st[1], de, xd * b0.y); NOPK(st[1]);
        st[2] = fmaf(st[2], de, xd * b0.z); NOPK(st[2]);
        st[3] = fmaf(st[3], de, xd * b0.w); NOPK(st[3]);
        st[4] = fmaf(st[4], de, xd * b1.x); NOPK(st[4]);
        st[5] = fmaf(st[5], de, xd * b1.y); NOPK(st[5]);
        st[6] = fmaf(st[6], de, xd * b1.z); NOPK(st[6]);
        st[7] = fmaf(st[7], de, xd * b1.w); NOPK(st[7]);
        float acc0 = fmaf(st[0], c0.x, fmaf(st[1], c0.y, fmaf(st[2], c0.z, st[3] * c0.w)));
        float acc1 = fmaf(st[4], c1.x, fmaf(st[5], c1.y, fmaf(st[6], c1.z, st[7] * c1.w)));
        float y = acc0 + acc1;
        if (tt & 1) { sum16x2(yprev, y); Oc[ooff + (tt - 1) * ostr] = yprev + dsk * xvprev; Oc[ooff + tt * ostr] = y + dsk * xv; }
        else { yprev = y; xvprev = xv; }
        __builtin_amdgcn_sched_barrier(0);
        if (tt + 1 < 16) { b0 = b0n; b1 = b1n; c0 = c0n; c1 = c1n; xv = xvn; dt = dtn; de = den; }
      }
    }
    __builtin_amdgcn_sched_barrier(0);
    __syncthreads();
  }
  {
    const long m0 = base + (nblk - 1) * 16;
    u16* pz = p.PROJ + (m0 + stt) * LDP + C_Z + h * 64 + q * 16 + (tid & 15);
    *pz = f2bf(O_[((nblk - 1) & 1) * 256 + stt * 16 + (tid & 15)] * siluf_(bf2f(zc)));
  }
  __syncthreads();
#undef SSD_LOAD
  {
    float* o = p.out + (s < 8 ? O_PSSM + (((long)l * 8 + s) * 8 + h) * 8192
                              : O_SSSM + (((long)l * 8 + (s - 8)) * 8 + h) * 8192);
    *(float4*)(o + row * 128 + ksl4) = make_float4(st[0], st[1], st[2], st[3]);
    *(float4*)(o + row * 128 + 64 + ksl4) = make_float4(st[4], st[5], st[6], st[7]);
  }
  if (h == 0 && q == 0) {
    float* o = p.out + (s < 8 ? O_PCONV + ((long)l * 8 + s) * 3072 : O_SCONV + ((long)l * 8 + (s - 8)) * 3072);
    const long lastblk = (long)(base + T) / 16 - 1;
    for (int i = tid; i < 3072; i += 256) {
      int r = i >> 10, c = i & 1023;
      o[i] = (c < 512) ? bf2f(p.PROJ[(long)(base + T - 3 + r) * LDP + C_XBC + c])
                       : bf2f(p.BND2[(lastblk * 3 + r) * 512 + (c - 512)]);
    }
  }
}

__device__ __forceinline__ void phase_scan(const Params& p, int l, float* smem) {
  for (int u = BID, nb_ = NBLK; u < 1536; u += nb_) {
    int sample = u >= 768;
    int v = sample ? u - 768 : u;
    int type = v % 3, w = v / 3;
    if (type == 0) {
      int q = w & 3, h = (w >> 2) & 7, b = w >> 5;
      scan_rwkv(p, l, b + 8 * sample, h, q, smem);
    } else if (type == 1) {
      int q = w & 7, h = (w >> 3) & 3, b = w >> 5;
      scan_hgrn(p, l, b + 8 * sample, h, q, smem);
    } else {
      int q = w & 3, h = (w >> 2) & 7, b = w >> 5;
      scan_ssd(p, l, b + 8 * sample, h, q, smem);
    }
  }
}

__device__ __forceinline__ void phase_post(const Params& p, int l, float* smem) {
  constexpr int LDG = 516;
  float* GA = smem;
  for (int blk = BID, nb_ = NBLK; blk < NBLK16; blk += nb_) {
    const int tid = opaque_tid(), lane = tid & 63, wid = tid >> 6;
    const int T = tid >> 4, Q = tid & 15;
    const long m0 = (long)blk * 16;
    const long m = m0 + T;
    __syncthreads();
    {
      bf16x8 ag[4];
      const u16* arow = p.PROJ + (m0 + (lane & 15)) * LDP + C_XG + (lane >> 4) * 8;
#pragma unroll
      for (int ks = 0; ks < 4; ++ks) ag[ks] = *(const bf16x8*)(arow + ks * 32);
#pragma unroll
      for (int nt = 0; nt < 8; ++nt) {
        const int n = (wid * 8 + nt) * 16 + (lane & 15);
        f32x4v acc = {0.f, 0.f, 0.f, 0.f};
#pragma unroll
        for (int ks = 0; ks < 4; ++ks) {
          bf16x8 bg = *(const bf16x8*)((p.WB + OFF_G2T) + n * 128 + ks * 32 + (lane >> 4) * 8);
          acc = __builtin_amdgcn_mfma_f32_16x16x32_bf16(ag[ks], bg, acc, 0, 0, 0);
        }
#pragma unroll
        for (int r = 0; r < 4; ++r) GA[((lane >> 4) * 4 + r) * LDG + n] = acc[r];
      }
    }
    __syncthreads();
    u16* row = p.PROJ + m * LDP;
#pragma unroll 1
    for (int g = 0; g < 2; ++g) {
      float y0[8], y1[8], w[8];
      const int c0 = g * 256 + Q * 8, c1 = c0 + 128;
      unpack8(*(const uint4*)(row + C_Z + c0), y0);
      unpack8(*(const uint4*)(row + C_Z + c1), y1);
      float ss = 0.f;
#pragma unroll
      for (int e = 0; e < 8; ++e) ss += y0[e] * y0[e] + y1[e] * y1[e];
      ss = sum16(ss);
      const float rs = rsqrtf(ss * (1.f / 256.f) + 1e-6f);
      ld8(p.ssd_norm_w + l * 512 + c0, w);
#pragma unroll
      for (int e = 0; e < 8; ++e) y0[e] = y0[e] * rs * w[e];
      ld8(p.ssd_norm_w + l * 512 + c1, w);
#pragma unroll
      for (int e = 0; e < 8; ++e) y1[e] = y1[e] * rs * w[e];
      *(uint4*)(row + C_Z + c0) = pack8(y0);
      *(uint4*)(row + C_Z + c1) = pack8(y1);
    }
#pragma unroll 1
    for (int j = 0; j < 4; ++j) {
      const int c0 = j * 128 + Q * 8;
      {
        float oh[8], gg[8], w[8];
        unpack8(*(const uint4*)(row + C_I + c0), oh);
        unpack8(*(const uint4*)(row + C_GG + c0), gg);
        float ss = 0.f;
#pragma unroll
        for (int e = 0; e < 8; ++e) ss += oh[e] * oh[e];
        ss = sum16(ss);
        const float rs = rsqrtf(ss * (1.f / 128.f) + 1e-6f);
        ld8(p.hg_norm_w + l * 512 + c0, w);
#pragma unroll
        for (int e = 0; e < 8; ++e) oh[e] = oh[e] * rs * w[e] * siluf_(gg[e]);
        *(uint4*)(row + C_GG + c0) = pack8(oh);
      }
      {
        float o[8], v[8], w[8], bb[8], ga[8];
        const int head = j * 2 + (Q >> 3);
        unpack8(*(const uint4*)(p.ORW + m * 512 + c0), o);
        unpack8(*(const uint4*)(row + C_V + c0), v);
        float sm = 0.f;
#pragma unroll
        for (int e = 0; e < 8; ++e) sm += o[e];
        const float mean = sum8(sm) * (1.f / 64.f);
        float sv = 0.f;
#pragma unroll
        for (int e = 0; e < 8; ++e) { o[e] -= mean; sv += o[e] * o[e]; }
        const float rstd = rsqrtf(sum8(sv) * (1.f / 64.f) + 64e-5f);
        const float rks = (p.FB + FOFF_RKS)[m * 8 + head];
        ld8(p.rw_lnx_w + l * 512 + c0, w);
        ld8(p.rw_lnx_b + l * 512 + c0, bb);
        ld8(GA + T * LDG + c0, ga);
#pragma unroll
        for (int e = 0; e < 8; ++e) o[e] = (o[e] * rstd * w[e] + bb[e] + rks * v[e]) * ga[e];
        *(uint4*)(row + C_R + c0) = pack8(o);
      }
    }
  }
}

__device__ __forceinline__ void phase_final(const Params& p) {
  const int tid = opaque_tid(), lane = tid & 63, wid = tid >> 6;
  for (int m = BID * 4 + wid, nb_ = NBLK; m < M_TOT; m += nb_ * 4) {
    float* dst;
    if (m < M_PROMPT) {
      int b = m / T_P, t = m - b * T_P;
      if (t < 16) continue;
      dst = p.out + O_YP + ((long)b * 4096 + (t - 16)) * DM;
    } else {
      dst = p.out + O_YS + (long)(m - M_PROMPT) * DM;
    }
    float x[16];
    float ss = 0.f;
#pragma unroll
    for (int j = 0; j < 2; ++j) {
      uint4 raw = *(const uint4*)(p.XB + xb_off(m, lane * 8 + 512 * j));
      unsigned wv[4] = {raw.x, raw.y, raw.z, raw.w};
#pragma unroll
      for (int e = 0; e < 8; ++e) {
        x[j * 8 + e] = bf2f((u16)((wv[e >> 1] >> ((e & 1) * 16)) & 0xffff));
        ss += x[j * 8 + e] * x[j * 8 + e];
      }
    }
    ss = sum64(ss);
    float rs = rsqrtf(ss * (1.f / 1024.f) + 1e-6f);
#pragma unroll
    for (int j = 0; j < 2; ++j) {
      int k0 = lane * 8 + 512 * j;
      float4 w0 = *(const float4*)(p.final_w + k0), w1 = *(const float4*)(p.final_w + k0 + 4);
      *(float4*)(dst + k0) = make_float4(x[j * 8 + 0] * rs * w0.x, x[j * 8 + 1] * rs * w0.y, x[j * 8 + 2] * rs * w0.z,
                                         x[j * 8 + 3] * rs * w0.w);
      *(float4*)(dst + k0 + 4) = make_float4(x[j * 8 + 4] * rs * w1.x, x[j * 8 + 5] * rs * w1.y,
                                             x[j * 8 + 6] * rs * w1.z, x[j * 8 + 7] * rs * w1.w);
    }
  }
}


#define XB_TMO      128
#define XB_XCNT(j)  (256  + 64 * (j))
#define XB_XSUB(j)  (1280 + 64 * (j))
#define XB_XGEN(j)  (2304 + 64 * (j))
#define XB_TOP      3328
#define XB_TOPGEN   3392
#define XCD_BAR_WORDS 3456
#define XB_SPIN_CAP (1u << 22)
__device__ __forceinline__ unsigned xb_ld(unsigned* p) { return __hip_atomic_load(p, __ATOMIC_RELAXED, __HIP_MEMORY_SCOPE_AGENT); }
__device__ __forceinline__ unsigned xb_add(unsigned* p, unsigned v) { return __hip_atomic_fetch_add(p, v, __ATOMIC_RELAXED, __HIP_MEMORY_SCOPE_AGENT); }
__device__ __forceinline__ unsigned xb_xcc_id() { return (unsigned)__builtin_amdgcn_s_getreg((3 << 11) | 20) & 0xFu; }
#define XB_SPIN(cond, bar) do { unsigned _sp = 0; while (cond) { __builtin_amdgcn_s_sleep(1); \
    if ((++_sp & 255u) == 0u) { if (xb_ld(&(bar)[XB_TMO])) break; if (_sp > XB_SPIN_CAP) { atomicAdd(&(bar)[XB_TMO], 1u); break; } } } } while (0)

__device__ __forceinline__ void xcd_barrier_post(unsigned* bar) {
  if (threadIdx.x == 0) (void)xb_add(&bar[XB_XCNT(xb_xcc_id())], 1u);
}
__device__ __forceinline__ void xcd_barrier_complete(unsigned* bar, unsigned x, unsigned& nloc, unsigned& nx) {
  const unsigned G = gridDim.x;
  unsigned sum, cnt, mine, sp = 0u;
  for (;;) {
    sum = 0u; cnt = 0u; mine = 0u;
#pragma unroll
    for (unsigned j = 0; j < 16; ++j) { const unsigned c = xb_ld(&bar[XB_XCNT(j)]); sum += c; cnt += (c > 0u) ? 1u : 0u; mine = (j == x) ? c : mine; }
    if (sum == G) break;
    __builtin_amdgcn_s_sleep(1);
    if ((++sp & 255u) == 0u) { if (xb_ld(&bar[XB_TMO])) break; if (sp > XB_SPIN_CAP) { atomicAdd(&bar[XB_TMO], 1u); break; } }
  }
  nloc = mine > 0u ? mine : 1u; nx = cnt > 0u ? cnt : 1u;
}
__device__ __forceinline__ void xcd_barrier(unsigned* bar, volatile unsigned* st) {
  asm volatile("s_waitcnt vmcnt(0)" ::: "memory");
  __syncthreads();
  if (threadIdx.x == 0) {
    __builtin_amdgcn_s_waitcnt(0);
    const unsigned x = xb_xcc_id();
    unsigned nloc = st[0], nx = st[1];
    if (nloc == 0u) { xcd_barrier_complete(bar, x, nloc, nx); st[0] = nloc; st[1] = nx; }
    const unsigned old = xb_add(&bar[XB_XSUB(x)], 1u);
    const unsigned gen = old / nloc;
    if (old + 1u == (gen + 1u) * nloc) {
      __builtin_amdgcn_fence(__ATOMIC_RELEASE, "agent");
      asm volatile("s_waitcnt vmcnt(0)" ::: "memory");
      const unsigned og = xb_add(&bar[XB_TOP], 1u);
      const unsigned tg = og / nx;
      if (og + 1u == (tg + 1u) * nx) xb_add(&bar[XB_TOPGEN], 1u);
      else XB_SPIN(xb_ld(&bar[XB_TOPGEN]) == tg, bar);
      __builtin_amdgcn_fence(__ATOMIC_ACQUIRE, "agent");
      xb_add(&bar[XB_XGEN(x)], 1u);
      asm volatile("s_waitcnt vmcnt(0)" ::: "memory");
    } else {
      XB_SPIN(xb_ld(&bar[XB_XGEN(x)]) == gen, bar);
      __builtin_amdgcn_fence(__ATOMIC_ACQUIRE, "agent");
      asm volatile("s_waitcnt vmcnt(0)" ::: "memory");
    }
  }
  __syncthreads();
}

constexpr int SMEM_BYTES = 40960;
__device__ __forceinline__ void run_phase(const Params& p, int ph, char* smem) {
  if (ph == 0) { phase_embed(p); return; }
  if (ph == 19) { phase_final(p); return; }
  int l = (ph - 1) / 9, s = (ph - 1) % 9;
  float* fs = (float*)smem;
  switch (s) {
    case 0: phase_convert(p, l, fs); phase_rowstat<true>(p, l, fs); break;
    case 1: phase_gemm<1, true>(p, p.XB, DM, (p.WB + OFF_W1T), 1024, LDP / 128, smem); break;
    case 2: phase_pre(p, l, fs); break;
    case 3: phase_scan(p, l, fs); break;
    case 4: phase_post(p, l, fs); break;
    case 5: phase_gemm<2, false>(p, p.PROJ, LDP, (p.WB + OFF_WOT), 1536, 8, smem); break;
    case 6: phase_rowstat<false>(p, l, fs); break;
    case 7: phase_gemm<3, true>(p, p.XB, DM, (p.WB + OFF_WGU), 1024, 44, smem); break;
    case 8: phase_gemm<2, true>(p, p.PROJ, D_FF, (p.WB + OFF_WDT), D_FF, 8, smem); break;
  }
}
constexpr int N_PHASES = 20;

#if MEGA
__global__ void __launch_bounds__(256, 3) k_mega(Params p) {
  __shared__ __attribute__((aligned(16))) char smem[SMEM_BYTES];
  __shared__ uint4 xb_words;
  if (threadIdx.x == 0) { xb_words = make_uint4(0u, 0u, 0u, 0u); }
  __syncthreads();
  cg::grid_group grid = cg::this_grid();
  float* fs = (float*)smem;
  volatile unsigned* xst = (volatile unsigned*)&xb_words;
  xcd_barrier_post(p.bar);
  phase_embed(p);
  grid.sync();
#define GSYNC() do { unsigned* b_ = p.bar; asm volatile("" : "+s"(b_)); xcd_barrier(b_, xst); } while (0)
  {
    const int L0_ = 0;
    int l = opaque_s(L0_);
    phase_convert(p, l, fs);
    phase_rowstat<true>(p, l, fs);
    GSYNC();
    l = opaque_s(l);
    phase_gemm<1, true>(p, p.XB, DM, (p.WB + OFF_W1T), 1024, LDP / 128, smem);
    GSYNC();
    l = opaque_s(l);
    phase_pre(p, l, fs);
    GSYNC();
    l = opaque_s(l);
    phase_scan(p, l, fs);
    GSYNC();
    l = opaque_s(l);
    phase_post(p, l, fs);
    GSYNC();
    l = opaque_s(l);
    phase_gemm<2, false>(p, p.PROJ, LDP, (p.WB + OFF_WOT), 1536, 8, smem);
    GSYNC();
    l = opaque_s(l);
    phase_rowstat<false>(p, l, fs);
    GSYNC();
    l = opaque_s(l);
    phase_gemm<3, true>(p, p.XB, DM, (p.WB + OFF_WGU), 1024, 44, smem);
    GSYNC();
    l = opaque_s(l);
    phase_gemm<2, true>(p, p.PROJ, D_FF, (p.WB + OFF_WDT), D_FF, 8, smem);
    GSYNC();
  }
  {
    const int L0_ = 1;
    int l = opaque_s(L0_);
    phase_convert(p, l, fs);
    phase_rowstat<true>(p, l, fs);
    GSYNC();
    l = opaque_s(l);
    phase_gemm<1, true>(p, p.XB, DM, (p.WB + OFF_W1T), 1024, LDP / 128, smem);
    GSYNC();
    l = opaque_s(l);
    phase_pre(p, l, fs);
    GSYNC();
    l = opaque_s(l);
    phase_scan(p, l, fs);
    GSYNC();
    l = opaque_s(l);
    phase_post(p, l, fs);
    GSYNC();
    l = opaque_s(l);
    phase_gemm<2, false>(p, p.PROJ, LDP, (p.WB + OFF_WOT), 1536, 8, smem);
    GSYNC();
    l = opaque_s(l);
    phase_rowstat<false>(p, l, fs);
    GSYNC();
    l = opaque_s(l);
    phase_gemm<3, true>(p, p.XB, DM, (p.WB + OFF_WGU), 1024, 44, smem);
    GSYNC();
    l = opaque_s(l);
    phase_gemm<2, true>(p, p.PROJ, D_FF, (p.WB + OFF_WDT), D_FF, 8, smem);
    GSYNC();
  }
  phase_final(p);
}
#else
template <int PH>
__global__ void __launch_bounds__(256, 3) k_phase(Params p) {
  __shared__ __attribute__((aligned(16))) char smem[SMEM_BYTES];
  run_phase(p, PH, smem);
}
template <int PH>
static void launch_all(const Params& p, int grid, hipStream_t stream) {
  hipLaunchKernelGGL(k_phase<PH>, dim3(grid), dim3(256), 0, stream, p);
  if constexpr (PH + 1 < N_PHASES) launch_all<PH + 1>(p, grid, stream);
}
#endif

extern "C" void kernel_launch(void* const* d_in, const int* in_sizes, int n_in, void* d_out, int out_size, void* d_ws,
                              size_t ws_size, hipStream_t stream) {
  Params p{};
  const float** pf = (const float**)&p;
  for (int i = 0; i < 35; ++i) pf[i] = (const float*)d_in[i];
  p.out = (float*)d_out;
  char* ws = (char*)d_ws;
  size_t off = 0;
  auto take = [&](size_t bytes) { char* r = ws + off; off += (bytes + 255) & ~(size_t)255; return r; };
  p.XB = (u16*)take((size_t)M_TOT * DM * 2);
  p.PROJ = (u16*)take((size_t)M_TOT * LDP * 2);
  p.WB = (u16*)take((size_t)WB_TOTAL * 2);
  p.BND = (u16*)take((size_t)NBLK16 * 1792 * 2);
  p.BND2 = (u16*)take((size_t)NBLK16 * 3 * 512 * 2);
  p.ORW = (u16*)take((size_t)M_TOT * 512 * 2);
  p.FB = (float*)take((size_t)FB_TOTAL * 4);
  p.bar = (unsigned*)take((size_t)XCD_BAR_WORDS * 4);
  p.RWX = (u16*)d_out;
  if (off > ws_size) fprintf(stderr, "workspace too small: need %zu have %zu\n", off, ws_size);
#if MEGA
  static int grid_blocks = 0;
  if (!grid_blocks) {
    int dev = 0, cus = 0, per_cu = 0;
    hipGetDevice(&dev);
    hipDeviceGetAttribute(&cus, hipDeviceAttributeMultiprocessorCount, dev);
    hipOccupancyMaxActiveBlocksPerMultiprocessor(&per_cu, k_mega, 256, 0);
    if (per_cu > 3) per_cu = 3;
    grid_blocks = cus * per_cu;
  }
  hipMemsetAsync(p.bar, 0, (size_t)XCD_BAR_WORDS * 4, stream);
  void* args[] = {&p};
  hipError_t e = hipLaunchCooperativeKernel((void*)k_mega, dim3(grid_blocks), dim3(256), args, 0, stream);
  if (e != hipSuccess) fprintf(stderr, "cooperative launch failed: %s (grid %d)\n", hipGetErrorString(e), grid_blocks);
#else
  launch_all<0>(p, 768, stream);
#endif
}
```

```cpp
#include <hip/hip_runtime.h>
#include <hip/hip_bf16.h>
#include <hip/hip_cooperative_groups.h>
#include <cstdio>
namespace cg = cooperative_groups;

#ifndef MEGA
#define MEGA 1
#endif

typedef unsigned short u16;
using bf16x8 = __attribute__((ext_vector_type(8))) short;
using f32x16 = __attribute__((ext_vector_type(16))) float;
using f32x4v = __attribute__((ext_vector_type(4))) float;

constexpr int DM = 1024;
constexpr int M_TOT = 33408;
constexpr int M_PROMPT = 32896;
constexpr int T_P = 4112;
constexpr int LDP = 5376;
constexpr int N_IN = 5384;
constexpr int D_FF = 2816;
constexpr int NBLK16 = M_TOT / 16;
constexpr int C_Z = 0, C_R = 512, C_GG = 1024, C_XBC = 1536, C_K = 2560, C_V = 3072, C_XW = 3584, C_XA = 3648,
              C_XG = 3712, C_Q = 3840, C_F = 4352, C_I = 4864;
constexpr long O_YP = 0, O_YS = 33554432, O_PSSM = 34078720, O_PCONV = 35127296, O_PRWKV = 35176448,
               O_PSHIFT = 35700736, O_PHGRN = 35729408, O_SSSM = 36777984, O_SCONV = 37826560,
               O_SRWKV = 37875712, O_SSHIFT = 38400000, O_SHGRN = 38428672;

constexpr long OFF_W1T = 0, OFF_WOT = 5505024, OFF_WGU = 7077888, OFF_WDT = 12845056, OFF_W2T = 15728640, OFF_A2T = 15761408, OFF_G2T = 15794176, WB_TOTAL = 15859712;
constexpr long FOFF_RS = 0, FOFF_DTRAW = 33408, FOFF_RKS = 300672, FB_TOTAL = 567936;
struct Params {
  const float *x_prompt, *x_sample, *state_ssm, *state_conv, *state_rwkv, *state_shift, *state_hgrn, *meta,
      *norm1_w, *w_in, *conv_w, *conv_b, *dt_bias, *a_log, *d_skip, *ssd_norm_w, *rw_mu, *rw_w0, *rw_w2, *rw_a0,
      *rw_a2, *rw_g2, *rw_kk, *rw_ka, *rw_rk, *rw_lnx_w, *rw_lnx_b, *hg_lb, *hg_norm_w, *w_out, *norm2_w, *w_gate,
      *w_up, *w_down, *final_w;
  float* out;
  u16 *XB, *PROJ, *WB, *BND, *BND2, *ORW, *RWX;
  float *FB;
  unsigned* bar;
};

__device__ __forceinline__ u16 f2bf(float f) {
  unsigned u = __float_as_uint(f);
  u += 0x7fffu + ((u >> 16) & 1u);
  return (u16)(u >> 16);
}
__device__ __forceinline__ float bf2f(u16 h) { return __uint_as_float(((unsigned)h) << 16); }
__device__ __forceinline__ float frcp_(float x) { return __builtin_amdgcn_rcpf(x); }
__device__ __forceinline__ float sigmoidf_(float x) { return frcp_(1.f + __expf(-x)); }
__device__ __forceinline__ float siluf_(float x) { return x * frcp_(1.f + __expf(-x)); }
__device__ __forceinline__ float softplusf_(float x) { return x > 20.f ? x : log1pf(__expf(x)); }

template <int CTRL>
__device__ __forceinline__ float dppf(float v) {
  return __int_as_float(__builtin_amdgcn_update_dpp(0, __float_as_int(v), CTRL, 0xF, 0xF, true));
}
__device__ __forceinline__ float sum16(float v) {
  v += dppf<0xB1>(v);
  v += dppf<0x4E>(v);
  v += dppf<0x141>(v);
  v += dppf<0x140>(v);
  return v;
}
__device__ __forceinline__ void sum16x2(float& a, float& b) {
  a += dppf<0xB1>(a); b += dppf<0xB1>(b);
  a += dppf<0x4E>(a); b += dppf<0x4E>(b);
  a += dppf<0x141>(a); b += dppf<0x141>(b);
  a += dppf<0x140>(a); b += dppf<0x140>(b);
}

__device__ __forceinline__ float sum8(float v) {
  v += dppf<0xB1>(v);
  v += dppf<0x4E>(v);
  v += dppf<0x141>(v);
  return v;
}
__device__ __forceinline__ void unpack8(const uint4& r, float* f) {
  f[0] = __uint_as_float(r.x << 16); f[1] = __uint_as_float(r.x & 0xffff0000u);
  f[2] = __uint_as_float(r.y << 16); f[3] = __uint_as_float(r.y & 0xffff0000u);
  f[4] = __uint_as_float(r.z << 16); f[5] = __uint_as_float(r.z & 0xffff0000u);
  f[6] = __uint_as_float(r.w << 16); f[7] = __uint_as_float(r.w & 0xffff0000u);
}
__device__ __forceinline__ uint4 pack8(const float* f) {
  uint4 r;
  r.x = f2bf(f[0]) | ((unsigned)f2bf(f[1]) << 16);
  r.y = f2bf(f[2]) | ((unsigned)f2bf(f[3]) << 16);
  r.z = f2bf(f[4]) | ((unsigned)f2bf(f[5]) << 16);
  r.w = f2bf(f[6]) | ((unsigned)f2bf(f[7]) << 16);
  return r;
}
__device__ __forceinline__ void ld8(const float* p, float* f) {
  float4 a = *(const float4*)p, b = *(const float4*)(p + 4);
  f[0] = a.x; f[1] = a.y; f[2] = a.z; f[3] = a.w; f[4] = b.x; f[5] = b.y; f[6] = b.z; f[7] = b.w;
}

struct F8 { float v[8]; };
__device__ __forceinline__ F8 up8(const uint4& r) { F8 f; unpack8(r, f.v); return f; }
__device__ __forceinline__ F8 ldf8(const float* p) { F8 f; ld8(p, f.v); return f; }
__device__ __forceinline__ F8 zero8() { F8 f; for (int e = 0; e < 8; ++e) f.v[e] = 0.f; return f; }
__device__ __forceinline__ float reduce4x16(float a, float b, float c, float d, int lane) {
  const bool o1 = (lane & 1) != 0, o2 = (lane & 2) != 0;
  float k0 = o1 ? b : a, s0 = o1 ? a : b;
  float k1 = o1 ? d : c, s1 = o1 ? c : d;
  k0 += dppf<0xB1>(s0);
  k1 += dppf<0xB1>(s1);
  float kp = o2 ? k1 : k0, sd = o2 ? k0 : k1;
  kp += dppf<0x4E>(sd);
  kp += dppf<0x124>(kp);
  kp += dppf<0x128>(kp);
  return kp;
}
__device__ __forceinline__ float sum64(float v) {
  v = sum16(v);
  v += __shfl_xor(v, 16);
  v += __shfl_xor(v, 32);
  return v;
}

#define NOPK(x) asm("" : "+v"(x))
__device__ __forceinline__ int opaque_tid() {
  int t = threadIdx.x;
  asm volatile("" : "+v"(t));
  return t;
}
__device__ __forceinline__ int opaque_s(int v) {
  asm volatile("" : "+s"(v));
  return v;
}
#define BID opaque_s((int)blockIdx.x)
#define NBLK opaque_s((int)gridDim.x)
__device__ __forceinline__ int seq_base(int s) { return s < 8 ? s * T_P : M_PROMPT + (s - 8) * 64; }
__device__ __forceinline__ int seq_len(int s) { return s < 8 ? T_P : 64; }

__device__ __forceinline__ long xb_off(int m, int k);
__device__ __forceinline__ void phase_embed(const Params& p) {
  const long n4 = (long)M_TOT * 256;
  for (long idx = (long)BID * 256 + threadIdx.x, st_ = (long)NBLK * 256; idx < n4; idx += st_) {
    int m = (int)(idx >> 8), c4 = ((int)idx & 255) * 4;
    const float* src;
    if (m < M_PROMPT) {
      int b = m / T_P, t = m - b * T_P;
      src = (t < 16) ? p.meta + (long)t * DM : p.x_prompt + ((long)b * 4096 + (t - 16)) * DM;
    } else {
      src = p.x_sample + (long)(m - M_PROMPT) * DM;
    }
    float4 v = *(const float4*)(src + c4);
    ushort4 o;
    o.x = f2bf(v.x); o.y = f2bf(v.y); o.z = f2bf(v.z); o.w = f2bf(v.w);
    *(ushort4*)(p.XB + xb_off(m, c4)) = o;
  }
}

__device__ __forceinline__ long xb_off(int m, int k) { return ((long)(m >> 7) * 32 + (k >> 5)) * 4096 + (m & 127) * 32 + (k & 31); }
__device__ __forceinline__ long wtile_off(int n, int k, int K) {
  return ((long)(n >> 7) * (K >> 5) + (k >> 5)) * 4096 + (n & 127) * 32 + (k & 31);
}
template <bool HAS_SCALE>
__device__ __forceinline__ void conv_tile(const float* __restrict__ src, int ldsrc, int srccol0, const float* __restrict__ scale,
                          u16* __restrict__ dst, int K, int k0, int n0, float* tile  ) {
  const int tid = opaque_tid();
  __syncthreads();
  {
    int nn = tid & 63, kb = tid >> 6;
#pragma unroll
    for (int i = 0; i < 16; ++i) {
      int kk = kb + 4 * i;
      float v = src[(long)(k0 + kk) * ldsrc + srccol0 + nn];
      if (HAS_SCALE) v *= scale[k0 + kk];
      tile[kk * 65 + nn] = v;
    }
  }
  __syncthreads();
  {
    int nn = tid >> 2, kq = (tid & 3) * 16;
    u16* d = dst + wtile_off(n0 + nn, k0 + kq, K);
#pragma unroll
    for (int j = 0; j < 16; j += 2) {
      unsigned w = f2bf(tile[(kq + j) * 65 + nn]) | ((unsigned)f2bf(tile[(kq + j + 1) * 65 + nn]) << 16);
      *(unsigned*)(d + j) = w;
    }
  }
}

__device__ __forceinline__ int w1_srccol(int n0) {
  if (n0 < 512) return n0;
  if (n0 < 1024) return n0 - 512 + 1544;
  if (n0 < 1536) return n0 - 1024 + 4872;
  if (n0 < 2560) return n0 - 1536 + 512;
  if (n0 < 3840) return n0 - 2560 + 2056;
  return n0 - 3840 + 3336;
}

constexpr int CV_W1 = 16 * 84, CV_WO = 24 * 16, CV_WGU = 16 * 88, CV_WD = 44 * 16;
constexpr int CV_LORA = 32;
constexpr int CV_TOTAL = CV_W1 + CV_WO + CV_WGU + CV_WD + CV_LORA;

__device__ __forceinline__ void phase_convert(const Params& p, int l, float* smem) {
  for (int u = BID, nb_ = NBLK; u < CV_TOTAL; u += nb_) {
    if (u < CV_W1) {
      int kt = u % 16, nt = u / 16;
      conv_tile<true>(p.w_in + (long)l * DM * N_IN, N_IN, w1_srccol(nt * 64), p.norm1_w + l * DM, (p.WB + OFF_W1T), 1024, kt * 64,
                nt * 64, smem);
    } else if (u < CV_W1 + CV_WO) {
      int v = u - CV_W1;
      int kt = v % 24, nt = v / 24;
      conv_tile<false>(p.w_out + (long)l * 1536 * DM, DM, nt * 64, nullptr, (p.WB + OFF_WOT), 1536, kt * 64, nt * 64, smem);
    } else if (u < CV_W1 + CV_WO + CV_WGU) {
      int v = u - CV_W1 - CV_WO;
      int kt = v % 16, nt = v / 16;
      const float* wg = p.w_gate + (long)l * DM * D_FF;
      const float* wu = p.w_up + (long)l * DM * D_FF;
      const float* sc = p.norm2_w + l * DM;
      const int tid = opaque_tid();
      __syncthreads();
      {
        int nn = tid & 63, kb = tid >> 6;
        const float* src = (nn < 32) ? wg : wu;
        int col = nt * 32 + (nn & 31);
#pragma unroll
        for (int i = 0; i < 16; ++i) {
          int kk = kb + 4 * i;
          smem[kk * 65 + nn] = src[(long)(kt * 64 + kk) * D_FF + col] * sc[kt * 64 + kk];
        }
      }
      __syncthreads();
      {
        int nn = tid >> 2, kq = (tid & 3) * 16;
        u16* d = (p.WB + OFF_WGU) + wtile_off(nt * 64 + nn, kt * 64 + kq, 1024);
#pragma unroll
        for (int j = 0; j < 16; j += 2) {
          unsigned w = f2bf(smem[(kq + j) * 65 + nn]) | ((unsigned)f2bf(smem[(kq + j + 1) * 65 + nn]) << 16);
          *(unsigned*)(d + j) = w;
        }
      }
    } else if (u >= CV_W1 + CV_WO + CV_WGU + CV_WD) {
      int v = u - (CV_W1 + CV_WO + CV_WGU + CV_WD);
      const int tid = opaque_tid();
#pragma unroll 4
      for (int i = 0; i < 16; ++i) {
        int e = v * 4096 + i * 256 + tid;
        if (e < 32768) {
          int n = e >> 6, k = e & 63;
          (p.WB + OFF_W2T)[e] = f2bf(p.rw_w2[(long)l * 64 * 512 + k * 512 + n]);
        } else if (e < 65536) {
          int e2 = e - 32768, n = e2 >> 6, k = e2 & 63;
          (p.WB + OFF_A2T)[e2] = f2bf(p.rw_a2[(long)l * 64 * 512 + k * 512 + n]);
        } else {
          int e2 = e - 65536, n = e2 >> 7, k = e2 & 127;
          (p.WB + OFF_G2T)[e2] = f2bf(p.rw_g2[(long)l * 128 * 512 + k * 512 + n]);
        }
      }
    } else {
      int v = u - CV_W1 - CV_WO - CV_WGU;
      int kt = v % 44, nt = v / 44;
      conv_tile<false>(p.w_down + (long)l * D_FF * DM, DM, nt * 64, nullptr, (p.WB + OFF_WDT), D_FF, kt * 64, nt * 64, smem);
    }
  }
}

template <bool WITH_DT>
__device__ __forceinline__ void phase_rowstat(const Params& p, int l, float* smem) {
  const int tid = opaque_tid(), lane = tid & 63, wid = tid >> 6;
  float* dtw = smem;
  if (WITH_DT) {
    __syncthreads();
    const float* w = p.w_in + (long)l * DM * N_IN + 1536;
    const float* nw = p.norm1_w + l * DM;
    for (int i = tid; i < 8192; i += 256) {
      int k = i >> 3, h = i & 7;
      dtw[i] = w[(long)k * N_IN + h] * nw[k];
    }
    __syncthreads();
  }
  for (int blk = BID, nb_ = NBLK; blk < NBLK16; blk += nb_) {
    for (int rr = wid; rr < 16; rr += 4) {
      int m = blk * 16 + rr;
      float ss = 0.f;
      float d[8];
#pragma unroll
      for (int h = 0; h < 8; ++h) d[h] = 0.f;
#pragma unroll 1
      for (int j = 0; j < 4; ++j) {
        int k0 = lane * 4 + 256 * j;
        uint2 raw = *(const uint2*)(p.XB + xb_off(m, k0));
        float xs[4] = {bf2f((u16)(raw.x & 0xffff)), bf2f((u16)(raw.x >> 16)), bf2f((u16)(raw.y & 0xffff)),
                       bf2f((u16)(raw.y >> 16))};
#pragma unroll
        for (int e = 0; e < 4; ++e) {
          float x = xs[e];
          ss += x * x;
          if (WITH_DT) {
            float4 w0 = *(const float4*)(dtw + (k0 + e) * 8);
            float4 w1 = *(const float4*)(dtw + (k0 + e) * 8 + 4);
            d[0] += x * w0.x; d[1] += x * w0.y; d[2] += x * w0.z; d[3] += x * w0.w;
            d[4] += x * w1.x; d[5] += x * w1.y; d[6] += x * w1.z; d[7] += x * w1.w;
          }
        }
      }
      ss = sum64(ss);
      float rs = rsqrtf(ss * (1.f / 1024.f) + 1e-6f);
      if (WITH_DT) {
#pragma unroll
        for (int h = 0; h < 8; ++h) d[h] = sum64(d[h]);
        if (lane == 0) {
#pragma unroll
          for (int h = 0; h < 8; ++h) (p.FB + FOFF_DTRAW)[(long)m * 8 + h] = d[h] * rs;
        }
      }
      if (lane == 0) (p.FB + FOFF_RS)[m] = rs;
    }
  }
}

constexpr int G_BK = 32, G_LDS_ROW = 80;
constexpr int G_OPER_BYTES = 128 * G_LDS_ROW;
template <int MODE, bool A_TILED>
__device__ __forceinline__ void phase_gemm(const Params& p, const u16* __restrict__ A, int lda, const u16* __restrict__ Bt, int K,
                           int nN, char* smem) {
  const int tid = opaque_tid(), lane = tid & 63, wid = tid >> 6, wm = wid >> 1, wn = wid & 1;
  const int nM = M_TOT / 128;
  const int ntiles = nM * nN;
  const int nk = K / G_BK;
  const int lrow = tid >> 2, lkc = tid & 3;
  for (int tile = BID, nb_ = NBLK; tile < ntiles; tile += nb_) {
    constexpr int GM = 32;
    int grp = tile / (GM * nN);
    int first_m = grp * GM;
    int gsz = min(GM, nM - first_m);
    int rem = tile - grp * GM * nN;
    int pm = first_m + rem % gsz, pn = rem / gsz;
    const u16* gA = A_TILED ? A + (long)pm * (K >> 5) * 4096 + lrow * 32 + lkc * 8
                            : A + (long)(pm * 128 + lrow) * lda + lkc * 8;
    const u16* gB = Bt + (long)pn * (K >> 5) * 4096 + lrow * 32 + lkc * 8;
    f32x16 acc[2][2];
#pragma unroll
    for (int i = 0; i < 2; ++i)
#pragma unroll
      for (int j = 0; j < 2; ++j)
#pragma unroll
        for (int r = 0; r < 16; ++r) acc[i][j][r] = 0.f;
    uint4 xa0, xa1, xb0, xb1, ya0, ya1, yb0, yb1, za0, za1, zb0, zb1;
#define G_LOAD(S, KT)                                                  \
  {                                                                    \
    S##a0 = *(const uint4*)(A_TILED ? gA + (long)(KT) * 4096 : gA + (KT) * G_BK);                          \
    S##a1 = *(const uint4*)(A_TILED ? gA + (long)(KT) * 4096 + 2048 : gA + (long)64 * lda + (KT) * G_BK);  \
    S##b0 = *(const uint4*)(gB + (long)(KT) * 4096);                   \
    S##b1 = *(const uint4*)(gB + (long)(KT) * 4096 + 2048);            \
  }
#define G_STORE(S, BUF)                                                \
  {                                                                    \
    char* dA = smem + (BUF) * 2 * G_OPER_BYTES;                        \
    char* dB = dA + G_OPER_BYTES;                                      \
    *(uint4*)(dA + lrow * G_LDS_ROW + lkc * 16) = S##a0;               \
    *(uint4*)(dA + (lrow + 64) * G_LDS_ROW + lkc * 16) = S##a1;        \
    *(uint4*)(dB + lrow * G_LDS_ROW + lkc * 16) = S##b0;               \
    *(uint4*)(dB + (lrow + 64) * G_LDS_ROW + lkc * 16) = S##b1;        \
  }
#define G_READ(BUF, KS, AF, BF)                                                                  \
  {                                                                                              \
    const char* sA = smem + (BUF) * 2 * G_OPER_BYTES;                                            \
    const char* sB = sA + G_OPER_BYTES;                                                          \
    const int koff = ((KS) * 16 + (lane >> 5) * 8) * 2;                                          \
    _Pragma("unroll") for (int i = 0; i < 2; ++i)                                                \
      AF[i] = *(const bf16x8*)(sA + (wm * 64 + i * 32 + (lane & 31)) * G_LDS_ROW + koff);        \
    _Pragma("unroll") for (int j = 0; j < 2; ++j)                                                \
      BF[j] = *(const bf16x8*)(sB + (wn * 64 + j * 32 + (lane & 31)) * G_LDS_ROW + koff);        \
  }
#define G_MMA(AF, BF)                                                                            \
  {                                                                                              \
    __builtin_amdgcn_s_setprio(1);                                                               \
    _Pragma("unroll") for (int i = 0; i < 2; ++i)                                                \
      _Pragma("unroll") for (int j = 0; j < 2; ++j)                                              \
        acc[i][j] = __builtin_amdgcn_mfma_f32_32x32x16_bf16(AF[i], BF[j], acc[i][j], 0, 0, 0);   \
    __builtin_amdgcn_s_setprio(0);                                                               \
  }
    G_LOAD(x, 0);
    G_LOAD(y, 1);
    G_LOAD(z, 2);
    __builtin_amdgcn_sched_barrier(0);
    __syncthreads();
    G_STORE(x, 0);
    __syncthreads();
#define G_STEP(T, SNEXT, SFREE, BUF)                          \
    if ((T) < nk) {                                           \
      bf16x8 af0[2], bf0[2];                                  \
      G_READ(BUF, 0, af0, bf0);                               \
      __builtin_amdgcn_sched_barrier(0);                      \
      if ((T) + 1 < nk) G_STORE(SNEXT, (BUF) ^ 1);            \
      if ((T) + 3 < nk) G_LOAD(SFREE, (T) + 3);               \
      __builtin_amdgcn_sched_barrier(0);                      \
      G_MMA(af0, bf0);                                        \
      G_READ(BUF, 1, af0, bf0);                               \
      G_MMA(af0, bf0);                                        \
      __builtin_amdgcn_sched_barrier(0);                      \
      __syncthreads();                                        \
    }
    for (int kt = 0; kt < nk; kt += 6) {
      G_STEP(kt + 0, y, x, 0);
      G_STEP(kt + 1, z, y, 1);
      G_STEP(kt + 2, x, z, 0);
      G_STEP(kt + 3, y, x, 1);
      G_STEP(kt + 4, z, y, 0);
      G_STEP(kt + 5, x, z, 1);
    }
#undef G_STEP
#undef G_LOAD
#undef G_STORE
#undef G_READ
#undef G_MMA
    int te = tid;
    asm volatile("" : "+v"(te));
    const int lane_e = te & 63, wm_e = te >> 7, wn_e = (te >> 6) & 1;
    const int lr0 = wm_e * 64 + 4 * (lane_e >> 5);
    const int lc0 = wn_e * 64 + (lane_e & 31);
    if (MODE == 1) {
      u16* ST = (u16*)smem;
#pragma unroll
      for (int i = 0; i < 2; ++i)
#pragma unroll
        for (int r = 0; r < 16; ++r) {
          const int lr = lr0 + i * 32 + (r & 3) + 8 * (r >> 2);
          const float rs = (p.FB + FOFF_RS)[pm * 128 + lr];
#pragma unroll
          for (int j = 0; j < 2; ++j) ST[lr * 136 + lc0 + j * 32] = f2bf(acc[i][j][r] * rs);
        }
      __syncthreads();
      const int col0 = pn * 128;
      const int bnd_j = (col0 >= C_R && col0 < C_GG) ? (col0 - C_R) : ((col0 >= C_K && col0 < C_Q) ? (col0 - C_K + 512) : -1);
      const bool bc = (col0 >= C_XBC + 512 && col0 < C_XBC + 1024);
#pragma unroll
      for (int q = 0; q < 8; ++q) {
        const int c = te + 256 * q, crow = c >> 4, cc = (c & 15) * 8;
        const uint4 v = *(const uint4*)(ST + crow * 136 + cc);
        const int row = pm * 128 + crow;
        *(uint4*)(p.PROJ + (long)row * LDP + col0 + cc) = v;
        if (bnd_j >= 0 && (crow & 15) == 15) *(uint4*)(p.BND + (long)(row >> 4) * 1792 + bnd_j + cc) = v;
        if (bc && (crow & 15) >= 13)
          *(uint4*)(p.BND2 + ((long)(row >> 4) * 3 + ((crow & 15) - 13)) * 512 + (col0 - (C_XBC + 512)) + cc) = v;
      }
    } else if (MODE == 2) {
      float* SF = (float*)smem;
#pragma unroll
      for (int i = 0; i < 2; ++i) {
        if (i) __syncthreads();
#pragma unroll
        for (int r = 0; r < 16; ++r) {
          const int l2 = wm_e * 32 + (r & 3) + 8 * (r >> 2) + 4 * (lane_e >> 5);
#pragma unroll
          for (int j = 0; j < 2; ++j) SF[l2 * 132 + lc0 + j * 32] = acc[i][j][r];
        }
        __syncthreads();
#pragma unroll
        for (int q = 0; q < 4; ++q) {
          const int c = te + 256 * q, l2 = c >> 4, cc = (c & 15) * 8;
          const int row = pm * 128 + (l2 >> 5) * 64 + i * 32 + (l2 & 31);
          float d[8], x[8];
          ld8(SF + l2 * 132 + cc, d);
          u16* px = p.XB + xb_off(row, pn * 128 + cc);
          unpack8(*(const uint4*)px, x);
#pragma unroll
          for (int e = 0; e < 8; ++e) x[e] += d[e];
          *(uint4*)px = pack8(x);
        }
      }
    } else {
      u16* ST = (u16*)smem;
      u16* ACT = p.PROJ;
#pragma unroll
      for (int i = 0; i < 2; ++i)
#pragma unroll
        for (int r = 0; r < 16; ++r) {
          const int lr = lr0 + i * 32 + (r & 3) + 8 * (r >> 2);
          const float rs = (p.FB + FOFF_RS)[pm * 128 + lr];
          const float g = acc[i][0][r] * rs, u = acc[i][1][r] * rs;
          ST[lr * 72 + wn_e * 32 + (lane_e & 31)] = f2bf(siluf_(g) * u);
        }
      __syncthreads();
#pragma unroll
      for (int q = 0; q < 4; ++q) {
        const int c = te + 256 * q, crow = c >> 3, cc = (c & 7) * 8;
        const uint4 v = *(const uint4*)(ST + crow * 72 + cc);
        *(uint4*)(ACT + wtile_off(pm * 128 + crow, pn * 64 + cc, D_FF)) = v;
      }
    }
  }
}

__device__ __forceinline__ void phase_pre(const Params& p, int l, float* smem) {
  u16* XWb = (u16*)smem;
  u16* XAb = (u16*)smem + 16 * 72;
  constexpr int LDW = 260;
  float* AW = smem + 1152;
  float* AA = smem + 1152 + 16 * LDW;
  const float* mu = p.rw_mu + l * 1792;
  for (int blk = BID, nb_ = NBLK; blk < NBLK16; blk += nb_) {
    const int tid = opaque_tid(), lane = tid & 63, wid = tid >> 6;
    const int T = tid >> 4, Q = tid & 15;
    const int m0 = blk * 16;
    const long m = m0 + T;
    int s, t0;
    if (m0 < M_PROMPT) { s = m0 / T_P; t0 = m0 - s * T_P; } else { s = 8 + (m0 - M_PROMPT) / 64; t0 = (m0 - M_PROMPT) & 63; }
    const bool first = (t0 == 0);
    u16* row = p.PROJ + m * LDP;
    const u16* bndrow = p.BND + (long)(blk > 0 ? blk - 1 : 0) * 1792;
    const float* shrow = p.state_shift + ((long)l * 8 + (s >= 8 ? s - 8 : 0)) * 1792;
    const bool seqstart = first && (T == 0);
#define SHIFT8(DST, J, COL)                                                                 \
    {                                                                                       \
      float cur_[8], pv_[8], mj_[8];                                                        \
      unpack8(*(const uint4*)(row + (COL)), cur_);                                          \
      const u16* ps_ = (T > 0) ? (row - LDP + (COL)) : (bndrow + (J));                      \
      unpack8(*(const uint4*)ps_, pv_);                                                     \
      if (seqstart) {                                                                       \
        if (s >= 8) ld8(shrow + (J), pv_);                                                  \
        else { _Pragma("unroll") for (int e = 0; e < 8; ++e) pv_[e] = 0.f; }                \
      }                                                                                     \
      ld8(mu + (J), mj_);                                                                   \
      _Pragma("unroll") for (int e = 0; e < 8; ++e) DST[e] = cur_[e] + (pv_[e] - cur_[e]) * mj_[e]; \
    }
    __syncthreads();
    {
      float sh0[8], sh1[8];
      SHIFT8(sh0, 1536 + Q * 8, C_XW + Q * 8);
      SHIFT8(sh1, 1664 + Q * 8, C_XG + Q * 8);
      __syncthreads();
      if (Q < 8) {
#pragma unroll
        for (int e = 0; e < 8; ++e) sh0[e] = tanhf(sh0[e]);
        *(uint4*)(XWb + T * 72 + Q * 8) = pack8(sh0);
      } else {
        *(uint4*)(XAb + T * 72 + (Q - 8) * 8) = pack8(sh0);
      }
#pragma unroll
      for (int e = 0; e < 8; ++e) sh1[e] = sigmoidf_(sh1[e]);
      *(uint4*)(row + C_XG + Q * 8) = pack8(sh1);
    }
    __syncthreads();
#pragma unroll 1
    for (int c = 0; c < 2; ++c) {
      {
        bf16x8 axw[2], axa[2];
#pragma unroll
        for (int ks = 0; ks < 2; ++ks) {
          axw[ks] = *(const bf16x8*)(XWb + (lane & 15) * 72 + ks * 32 + (lane >> 4) * 8);
          axa[ks] = *(const bf16x8*)(XAb + (lane & 15) * 72 + ks * 32 + (lane >> 4) * 8);
        }
#pragma unroll
        for (int nt = 0; nt < 4; ++nt) {
          const int ncol = (wid * 4 + nt) * 16 + (lane & 15);
          const int n = c * 256 + ncol;
          f32x4v accw = {0.f, 0.f, 0.f, 0.f}, acca = {0.f, 0.f, 0.f, 0.f};
#pragma unroll
          for (int ks = 0; ks < 2; ++ks) {
            bf16x8 bw = *(const bf16x8*)((p.WB + OFF_W2T) + n * 64 + ks * 32 + (lane >> 4) * 8);
            bf16x8 ba = *(const bf16x8*)((p.WB + OFF_A2T) + n * 64 + ks * 32 + (lane >> 4) * 8);
            accw = __builtin_amdgcn_mfma_f32_16x16x32_bf16(axw[ks], bw, accw, 0, 0, 0);
            acca = __builtin_amdgcn_mfma_f32_16x16x32_bf16(axa[ks], ba, acca, 0, 0, 0);
          }
#pragma unroll
          for (int r = 0; r < 4; ++r) {
            AW[((lane >> 4) * 4 + r) * LDW + ncol] = accw[r];
            AA[((lane >> 4) * 4 + r) * LDW + ncol] = acca[r];
          }
        }
      }
#pragma unroll 1
      for (int jj = 0; jj < 2; ++jj) {
        const int ch0 = c * 256 + jj * 128 + Q * 8;
        const int head = c * 4 + jj * 2 + (Q >> 3);
        float rt[8], kt[8];
        uint4 vpk;
        SHIFT8(rt, ch0, C_R + ch0);
        SHIFT8(kt, 512 + ch0, C_K + ch0);
        {
          float vt[8];
          SHIFT8(vt, 1024 + ch0, C_V + ch0);
          vpk = pack8(vt);
        }
        __syncthreads();
        float aw[8], aa[8], w0[8], a0[8];
        ld8(AW + T * LDW + jj * 128 + Q * 8, aw);
        ld8(AA + T * LDW + jj * 128 + Q * 8, aa);
        ld8(p.rw_w0 + l * 512 + ch0, w0);
        ld8(p.rw_a0 + l * 512 + ch0, a0);
        {
          float uu[8];
#pragma unroll
          for (int e = 0; e < 8; ++e) {
            float lw = -softplusf_(-(w0[e] + aw[e])) - 0.5f;
            uu[e] = -__expf(lw);
            aa[e] = sigmoidf_(a0[e] + aa[e]);
          }
          *(uint4*)(p.RWX + m * 1536 + ch0) = pack8(uu);
        }
        *(uint4*)(row + C_R + ch0) = pack8(rt);
        *(uint4*)(row + C_V + ch0) = vpk;
        float kkw[8], kaw[8], rkw[8], kk[8], kp[8];
        ld8(p.rw_kk + l * 512 + ch0, kkw);
        ld8(p.rw_ka + l * 512 + ch0, kaw);
        ld8(p.rw_rk + l * 512 + ch0, rkw);
        float ssq = 0.f, rks = 0.f;
#pragma unroll
        for (int e = 0; e < 8; ++e) {
          kk[e] = kt[e] * kkw[e];
          ssq += kk[e] * kk[e];
          kp[e] = kt[e] * (1.f + (aa[e] - 1.f) * kaw[e]);
          rks += rt[e] * kp[e] * rkw[e];
        }
        ssq = sum8(ssq);
        rks = sum8(rks);
        const float rn = rsqrtf(ssq + 1e-12f);
        *(uint4*)(row + C_K + ch0) = pack8(kp);
#pragma unroll
        for (int e = 0; e < 8; ++e) kk[e] *= rn;
        *(uint4*)(p.RWX + m * 1536 + 512 + ch0) = pack8(kk);
#pragma unroll
        for (int e = 0; e < 8; ++e) kk[e] *= aa[e];
        *(uint4*)(p.RWX + m * 1536 + 1024 + ch0) = pack8(kk);
        if ((Q & 7) == 0) (p.FB + FOFF_RKS)[m * 8 + head] = rks;
      }
      __syncthreads();
    }
    {
      u16* CB = (u16*)(smem + 1152);
      const u16* b2row = p.BND2 + (long)(blk > 0 ? blk - 1 : 0) * 1536;
      const float* scrow = p.state_conv + ((long)l * 8 + (s >= 8 ? s - 8 : 0)) * 3072 + 512;
#pragma unroll 1
      for (int j = 0; j < 4; ++j) {
        const int cc0 = j * 128 + Q * 8;
        const float* cw = p.conv_w + (long)l * 4096 + 512 + cc0;
        float acc[8];
        ld8(p.conv_b + l * 1024 + 512 + cc0, acc);
#pragma unroll
        for (int d = 0; d < 4; ++d) {
          const int tr = T - 3 + d;
          const int trn = tr < 0 ? 3 + tr : 0;
          float u[8], w[8];
          const u16* src = (tr >= 0) ? (row + (long)(d - 3) * LDP + C_XBC + 512 + cc0) : (b2row + trn * 512 + cc0);
          unpack8(*(const uint4*)src, u);
          if (first && tr < 0) {
            if (s >= 8) ld8(scrow + trn * 1024 + cc0, u);
            else {
#pragma unroll
              for (int e = 0; e < 8; ++e) u[e] = 0.f;
            }
          }
          ld8(cw + d * 1024, w);
#pragma unroll
          for (int e = 0; e < 8; ++e) acc[e] += w[e] * u[e];
        }
#pragma unroll
        for (int e = 0; e < 8; ++e) acc[e] = siluf_(acc[e]);
        *(uint4*)(CB + T * 512 + cc0) = pack8(acc);
      }
      __syncthreads();
#pragma unroll
      for (int j = 0; j < 4; ++j)
        *(uint4*)(row + C_XBC + 512 + j * 128 + Q * 8) = *(const uint4*)(CB + T * 512 + j * 128 + Q * 8);
    }
#undef SHIFT8
    if (t0 + 16 == seq_len(s)) {
      float* o = p.out + (s < 8 ? O_PSHIFT + ((long)l * 8 + s) * 1792 : O_SSHIFT + ((long)l * 8 + (s - 8)) * 1792);
      for (int j = tid; j < 1792; j += 256) o[j] = bf2f(p.BND[(long)blk * 1792 + j]);
    }
  }
}

__device__ __forceinline__ void scan_rwkv(const Params& p, int l, int s, int h, int q, float* smem) {
  const int tid = opaque_tid(), lane = tid & 63, wid = tid >> 6;
  float* R_ = smem;
  float* W_ = smem + 1024;
  float* K_ = smem + 2048;
  float* A_ = smem + 3072;
  float* B_ = smem + 4096;
  float* V_ = smem + 5120;
  float* O_ = smem + 5376;
  const int rl = wid * 4 + (lane >> 4);
  const int row = q * 16 + rl;
  const int ksl = (lane & 15) * 4;
  const int base = seq_base(s), T = seq_len(s);
  float s0 = 0.f, s1 = 0.f, s2 = 0.f, s3 = 0.f;
  if (s >= 8) {
    const float* st = p.state_rwkv + (((long)l * 8 + (s - 8)) * 8 + h) * 4096 + row * 64 + ksl;
    float4 v = *(const float4*)st;
    s0 = v.x; s1 = v.y; s2 = v.z; s3 = v.w;
  }
  const int stt = tid >> 4, skq = (tid & 15) * 4;
  const int nblk = T / 16;
  ushort4 r4, k4, u4, a4, b4;
  u16 vv;
  {
    const long m = base + stt;
    const u16* pr = p.PROJ + m * LDP;
    const u16* px = p.RWX + m * 1536;
    r4 = *(const ushort4*)(pr + C_R + h * 64 + skq);
    k4 = *(const ushort4*)(pr + C_K + h * 64 + skq);
    u4 = *(const ushort4*)(px + h * 64 + skq);
    a4 = *(const ushort4*)(px + 512 + h * 64 + skq);
    b4 = *(const ushort4*)(px + 1024 + h * 64 + skq);
    vv = pr[C_V + h * 64 + q * 16 + (tid & 15)];
  }
  __syncthreads();
  float* TR_ = smem + 5376 + 512;
  const bool wr = (lane & 15) == 0;
  const int ooff = wr ? rl : (512 + lane);
  const int ostr = wr ? 16 : 0;
  for (int blk = 0; blk < nblk; ++blk) {
    const long m = base + blk * 16 + stt;
    float* Oc = O_ + (blk & 1) * 256;
    {
      *(float4*)(R_ + stt * 64 + skq) = make_float4(bf2f(r4.x), bf2f(r4.y), bf2f(r4.z), bf2f(r4.w));
      *(float4*)(K_ + stt * 64 + skq) = make_float4(bf2f(k4.x), bf2f(k4.y), bf2f(k4.z), bf2f(k4.w));
      *(float4*)(W_ + stt * 64 + skq) =
          make_float4(__expf(bf2f(u4.x)), __expf(bf2f(u4.y)), __expf(bf2f(u4.z)), __expf(bf2f(u4.w)));
      *(float4*)(A_ + stt * 64 + skq) = make_float4(-bf2f(a4.x), -bf2f(a4.y), -bf2f(a4.z), -bf2f(a4.w));
      *(float4*)(B_ + stt * 64 + skq) = make_float4(bf2f(b4.x), bf2f(b4.y), bf2f(b4.z), bf2f(b4.w));
      V_[stt * 16 + (tid & 15)] = bf2f(vv);
    }
    __syncthreads();
    if (blk > 0)
      p.ORW[(m - 16) * 512 + h * 64 + q * 16 + (tid & 15)] = f2bf(O_[((blk - 1) & 1) * 256 + stt * 16 + (tid & 15)]);
    if (blk + 1 < nblk) {
      const u16* pr = p.PROJ + (m + 16) * LDP;
      const u16* px = p.RWX + (m + 16) * 1536;
      r4 = *(const ushort4*)(pr + C_R + h * 64 + skq);
      k4 = *(const ushort4*)(pr + C_K + h * 64 + skq);
      u4 = *(const ushort4*)(px + h * 64 + skq);
      a4 = *(const ushort4*)(px + 512 + h * 64 + skq);
      b4 = *(const ushort4*)(px + 1024 + h * 64 + skq);
      vv = pr[C_V + h * 64 + q * 16 + (tid & 15)];
    }
    __builtin_amdgcn_sched_barrier(0);
    {
      float4 a = *(const float4*)(A_ + ksl), w = *(const float4*)(W_ + ksl), b = *(const float4*)(B_ + ksl);
      float4 k = *(const float4*)(K_ + ksl), r = *(const float4*)(R_ + ksl);
      float v = V_[rl];
      float opart = 0.f;
#pragma unroll
      for (int tt = 0; tt < 16; ++tt) {
        float4 an, wn, bn, kn, rn;
        float vn;
        if (tt + 1 < 16) {
          an = *(const float4*)(A_ + (tt + 1) * 64 + ksl); wn = *(const float4*)(W_ + (tt + 1) * 64 + ksl);
          bn = *(const float4*)(B_ + (tt + 1) * 64 + ksl); kn = *(const float4*)(K_ + (tt + 1) * 64 + ksl);
          rn = *(const float4*)(R_ + (tt + 1) * 64 + ksl); vn = V_[(tt + 1) * 16 + rl];
        }
        __builtin_amdgcn_sched_barrier(0);
        float sa = fmaf(s0, a.x, fmaf(s1, a.y, fmaf(s2, a.z, s3 * a.w)));
        if (tt > 0) { sum16x2(sa, opart); Oc[ooff + (tt - 1) * ostr] = opart; }
        else sa = sum16(sa);
        s0 = fmaf(s0, w.x, fmaf(sa, b.x, v * k.x)); NOPK(s0);
        s1 = fmaf(s1, w.y, fmaf(sa, b.y, v * k.y)); NOPK(s1);
        s2 = fmaf(s2, w.z, fmaf(sa, b.z, v * k.z)); NOPK(s2);
        s3 = fmaf(s3, w.w, fmaf(sa, b.w, v * k.w)); NOPK(s3);
        opart = fmaf(s0, r.x, fmaf(s1, r.y, fmaf(s2, r.z, s3 * r.w)));
        if (tt == 15) { opart = sum16(opart); Oc[ooff + 15 * ostr] = opart; }
        __builtin_amdgcn_sched_barrier(0);
        if (tt + 1 < 16) { a = an; w = wn; b = bn; k = kn; r = rn; v = vn; }
      }
    }
    __builtin_amdgcn_sched_barrier(0);
    __syncthreads();
  }
  {
    const long m = base + (nblk - 1) * 16 + stt;
    p.ORW[m * 512 + h * 64 + q * 16 + (tid & 15)] = f2bf(O_[((nblk - 1) & 1) * 256 + stt * 16 + (tid & 15)]);
  }
  __syncthreads();
  {
    float* o = p.out + (s < 8 ? O_PRWKV + (((long)l * 8 + s) * 8 + h) * 4096
                              : O_SRWKV + (((long)l * 8 + (s - 8)) * 8 + h) * 4096);
    *(float4*)(o + row * 64 + ksl) = make_float4(s0, s1, s2, s3);
  }
}

__device__ __forceinline__ void scan_hgrn(const Params& p, int l, int s, int h, int q, float* smem) {
  const int tid = opaque_tid(), lane = tid & 63, wid = tid >> 6;
  float* Q_ = smem;
  float* F_ = smem + 2048;
  float* G_ = smem + 4096;
  float* I_ = smem + 6144;
  float* O_ = smem + 6400;
  const int rl = wid * 4 + (lane >> 4);
  const int row = q * 16 + rl;
  const int ksl4 = (lane & 15) * 4;
  const int base = seq_base(s), T = seq_len(s);
  float st[8];
#pragma unroll
  for (int i = 0; i < 8; ++i) st[i] = 0.f;
  if (s >= 8) {
    const float* sp = p.state_hgrn + (((long)l * 8 + (s - 8)) * 4 + h) * 16384;
#pragma unroll
    for (int i = 0; i < 8; ++i) st[i] = sp[((i >> 2) * 64 + ksl4 + (i & 3)) * 128 + row];
  }
  const int stt = tid >> 4, skq = (tid & 15) * 8;
  float lb[8];
#pragma unroll
  for (int i = 0; i < 8; ++i) {
    if (l == 0) lb[i] = 0.f;
    else {
      float x0 = p.hg_lb[h * 128 + skq + i], x1 = p.hg_lb[512 + h * 128 + skq + i];
      lb[i] = frcp_(1.f + __expf(x0 - x1));
    }
  }
  const int nblk = T / 16;
  uint4 q8, f8;
  u16 iv16;
  {
    const u16* pr = p.PROJ + (long)(base + stt) * LDP;
    q8 = *(const uint4*)(pr + C_Q + h * 128 + skq);
    f8 = *(const uint4*)(pr + C_F + h * 128 + skq);
    iv16 = pr[C_I + h * 128 + q * 16 + (tid & 15)];
  }
  __syncthreads();
  float* TR_ = smem + 6400 + 512;
  const bool wr = (lane & 15) == 0;
  const int ooff = wr ? rl : (512 + lane);
  const int ostr = wr ? 16 : 0;
  const bool wr4 = (lane & 15) < 4;
  const int ooff4 = wr4 ? (rl + (lane & 3) * 16) : (512 + lane);
  const int ostr4 = wr4 ? 16 : 0;
  for (int blk = 0; blk < nblk; ++blk) {
    const long m = base + blk * 16 + stt;
    float* Oc = O_ + (blk & 1) * 256;
    {
      unsigned qw[4] = {q8.x, q8.y, q8.z, q8.w}, fw[4] = {f8.x, f8.y, f8.z, f8.w};
      float qv[8], fv[8];
#pragma unroll
      for (int e = 0; e < 8; ++e) {
        qv[e] = bf2f((u16)((qw[e >> 1] >> ((e & 1) * 16)) & 0xffff));
        float fz = bf2f((u16)((fw[e >> 1] >> ((e & 1) * 16)) & 0xffff));
        float ex = __expf(-fz);
        float sg = frcp_(1.f + ex);
        fv[e] = lb[e] + (1.f - lb[e]) * sg;
      }
      *(float4*)(Q_ + stt * 128 + skq) = make_float4(qv[0], qv[1], qv[2], qv[3]);
      *(float4*)(Q_ + stt * 128 + skq + 4) = make_float4(qv[4], qv[5], qv[6], qv[7]);
      *(float4*)(F_ + stt * 128 + skq) = make_float4(fv[0], fv[1], fv[2], fv[3]);
      *(float4*)(F_ + stt * 128 + skq + 4) = make_float4(fv[4], fv[5], fv[6], fv[7]);
      I_[stt * 16 + (tid & 15)] = bf2f(iv16);
    }
    __syncthreads();
    if (blk > 0) {
      u16* dp = p.PROJ + (m - 16) * LDP + C_I + h * 128 + q * 16 + (tid & 15);
      *dp = f2bf(O_[((blk - 1) & 1) * 256 + stt * 16 + (tid & 15)]);
    }
    if (blk + 1 < nblk) {
      const u16* pr = p.PROJ + (m + 16) * LDP;
      q8 = *(const uint4*)(pr + C_Q + h * 128 + skq);
      f8 = *(const uint4*)(pr + C_F + h * 128 + skq);
      iv16 = pr[C_I + h * 128 + q * 16 + (tid & 15)];
    }
    __builtin_amdgcn_sched_barrier(0);
    {
      float4 f0 = *(const float4*)(F_ + ksl4), f1 = *(const float4*)(F_ + 64 + ksl4);
      float4 q0 = *(const float4*)(Q_ + ksl4), q1 = *(const float4*)(Q_ + 64 + ksl4);
      float iv = I_[rl];
      float op4[4] = {0.f, 0.f, 0.f, 0.f};
#pragma unroll
      for (int tt = 0; tt < 16; ++tt) {
        float4 f0n, f1n, q0n, q1n;
        float ivn;
        if (tt + 1 < 16) {
          const int o_ = (tt + 1) * 128;
          f0n = *(const float4*)(F_ + o_ + ksl4); f1n = *(const float4*)(F_ + o_ + 64 + ksl4);
          q0n = *(const float4*)(Q_ + o_ + ksl4); q1n = *(const float4*)(Q_ + o_ + 64 + ksl4);
          ivn = I_[(tt + 1) * 16 + rl];
        }
        __builtin_amdgcn_sched_barrier(0);
        st[0] = fmaf(st[0] - iv, f0.x, iv); NOPK(st[0]);
        st[1] = fmaf(st[1] - iv, f0.y, iv); NOPK(st[1]);
        st[2] = fmaf(st[2] - iv, f0.z, iv); NOPK(st[2]);
        st[3] = fmaf(st[3] - iv, f0.w, iv); NOPK(st[3]);
        st[4] = fmaf(st[4] - iv, f1.x, iv); NOPK(st[4]);
        st[5] = fmaf(st[5] - iv, f1.y, iv); NOPK(st[5]);
        st[6] = fmaf(st[6] - iv, f1.z, iv); NOPK(st[6]);
        st[7] = fmaf(st[7] - iv, f1.w, iv); NOPK(st[7]);
        float acc0 = fmaf(st[0], q0.x, fmaf(st[1], q0.y, fmaf(st[2], q0.z, st[3] * q0.w)));
        float acc1 = fmaf(st[4], q1.x, fmaf(st[5], q1.y, fmaf(st[6], q1.z, st[7] * q1.w)));
        op4[tt & 3] = acc0 + acc1;
        if ((tt & 3) == 3) {
          const float r4 = reduce4x16(op4[0], op4[1], op4[2], op4[3], lane);
          Oc[ooff4 + (tt - 3) * ostr4] = r4;
        }
        __builtin_amdgcn_sched_barrier(0);
        if (tt + 1 < 16) { f0 = f0n; f1 = f1n; q0 = q0n; q1 = q1n; iv = ivn; }
      }
    }
    __builtin_amdgcn_sched_barrier(0);
    __syncthreads();
  }
  {
    const long m = base + (nblk - 1) * 16 + stt;
    u16* dp = p.PROJ + m * LDP + C_I + h * 128 + q * 16 + (tid & 15);
    *dp = f2bf(O_[((nblk - 1) & 1) * 256 + stt * 16 + (tid & 15)]);
  }
  __syncthreads();
  {
    float* o = p.out + (s < 8 ? O_PHGRN + (((long)l * 8 + s) * 4 + h) * 16384
                              : O_SHGRN + (((long)l * 8 + (s - 8)) * 4 + h) * 16384);
#pragma unroll
    for (int i = 0; i < 8; ++i) o[((i >> 2) * 64 + ksl4 + (i & 3)) * 128 + row] = st[i];
  }
}

__device__ __forceinline__ void scan_ssd(const Params& p, int l, int s, int h, int q, float* smem) {
  const int tid = opaque_tid(), lane = tid & 63, wid = tid >> 6;
  float* B_ = smem;
  float* C_ = smem + 2048;
  float* X_ = smem + 4096;
  float* O_ = smem + 4352;
  float* DT_ = smem + 5200;
  float* DE_ = smem + 5216;
  const int rl = wid * 4 + (lane >> 4);
  const int row = q * 16 + rl;
  const int ksl4 = (lane & 15) * 4;
  const int g = h >> 2;
  const int base = seq_base(s), T = seq_len(s);
  float st[8];
#pragma unroll
  for (int i = 0; i < 8; ++i) st[i] = 0.f;
  if (s >= 8) {
    const float* sp = p.state_ssm + (((long)l * 8 + (s - 8)) * 8 + h) * 8192 + row * 128 + ksl4;
    float4 a = *(const float4*)sp, b = *(const float4*)(sp + 64);
    st[0] = a.x; st[1] = a.y; st[2] = a.z; st[3] = a.w; st[4] = b.x; st[5] = b.y; st[6] = b.z; st[7] = b.w;
  }
  const float* cw = p.conv_w + (long)l * 4 * 1024;
  const int skq8 = (tid & 15) * 8;
  const int xc_x = h * 64 + q * 16 + (tid & 15);
  const float cx0 = cw[xc_x], cx1 = cw[1024 + xc_x], cx2 = cw[2048 + xc_x], cx3 = cw[3072 + xc_x];
  const float cxb = p.conv_b[l * 1024 + xc_x];
  const float dtb = p.dt_bias[l * 8 + h];
  const float aexp = __expf(p.a_log[l * 8 + h]);
  const float dsk = p.d_skip[l * 8 + h];
  const int stt = tid >> 4;
  const int nblk = T / 16;
  uint4 rawb, rawc;
  float xr[4];
  float dtr = 0.f;
  u16 zc = 0, zn = 0;
#define SSD_LOAD(M0)                                                              \
  {                                                                               \
    {                                                                             \
      const u16* prow = p.PROJ + ((long)(M0) + stt) * LDP + C_XBC + g * 128 + skq8; \
      rawb = *(const uint4*)(prow + 512);                                         \
      rawc = *(const uint4*)(prow + 768);                                         \
    }                                                                             \
    {                                                                             \
      const long mr = (long)(M0) + stt;                                           \
      const u16* colx = p.PROJ + mr * LDP + C_XBC + xc_x;                         \
      _Pragma("unroll") for (int j = 0; j < 4; ++j) {                             \
        const long mm = mr - 3 + j;                                               \
        float vx;                                                                 \
        if (mm >= base) vx = bf2f(colx[(long)(j - 3) * LDP]);                     \
        else vx = (s >= 8) ? p.state_conv[((long)l * 8 + (s - 8)) * 3072 + (3 + (int)(mm - base)) * 1024 + xc_x] : 0.f; \
        xr[j] = vx;                                                               \
      }                                                                           \
    }                                                                             \
    if (tid < 16) dtr = (p.FB + FOFF_DTRAW)[((long)(M0) + tid) * 8 + h];                      \
    zn = p.PROJ[((long)(M0) + stt) * LDP + C_Z + h * 64 + q * 16 + (tid & 15)];   \
  }
  SSD_LOAD(base);
  __syncthreads();
  const bool wr = (lane & 15) == 0;
  const int ooff = wr ? rl : (512 + lane);
  const int ostr = wr ? 16 : 0;
  const bool wr4 = (lane & 15) < 4;
  const int ooff4 = wr4 ? (rl + (lane & 3) * 16) : (512 + lane);
  const int ostr4 = wr4 ? 16 : 0;
  u16 zp = 0;
  for (int blk = 0; blk < nblk; ++blk) {
    const long m0 = base + blk * 16;
    zp = zc;
    zc = zn;
    float* Oc = O_ + (blk & 1) * 256;
    {
      {
        const unsigned bw[4] = {rawb.x, rawb.y, rawb.z, rawb.w}, cwd[4] = {rawc.x, rawc.y, rawc.z, rawc.w};
        float bv[8], cv[8];
#pragma unroll
        for (int e = 0; e < 8; ++e) {
          bv[e] = bf2f((u16)((bw[e >> 1] >> ((e & 1) * 16)) & 0xffff));
          cv[e] = bf2f((u16)((cwd[e >> 1] >> ((e & 1) * 16)) & 0xffff));
        }
        *(float4*)(B_ + stt * 128 + skq8) = make_float4(bv[0], bv[1], bv[2], bv[3]);
        *(float4*)(B_ + stt * 128 + skq8 + 4) = make_float4(bv[4], bv[5], bv[6], bv[7]);
        *(float4*)(C_ + stt * 128 + skq8) = make_float4(cv[0], cv[1], cv[2], cv[3]);
        *(float4*)(C_ + stt * 128 + skq8 + 4) = make_float4(cv[4], cv[5], cv[6], cv[7]);
      }
      {
        float y = cx0 * xr[0] + cx1 * xr[1] + cx2 * xr[2] + cx3 * xr[3] + cxb;
        X_[stt * 16 + (tid & 15)] = siluf_(y);
      }
      if (tid < 16) {
        float dtv = softplusf_(dtr + dtb);
        DT_[tid] = dtv;
        DE_[tid] = __expf(-aexp * dtv);
      }
    }
    __syncthreads();
    if (blk > 0) {
      u16* pz = p.PROJ + (m0 - 16 + stt) * LDP + C_Z + h * 64 + q * 16 + (tid & 15);
      *pz = f2bf(O_[((blk - 1) & 1) * 256 + stt * 16 + (tid & 15)] * siluf_(bf2f(zp)));
    }
    if (blk + 1 < nblk) SSD_LOAD(m0 + 16);
    __builtin_amdgcn_sched_barrier(0);
    {
      float4 b0 = *(const float4*)(B_ + ksl4), b1 = *(const float4*)(B_ + 64 + ksl4);
      float4 c0 = *(const float4*)(C_ + ksl4), c1 = *(const float4*)(C_ + 64 + ksl4);
      float xv = X_[rl], dt = DT_[0], de = DE_[0];
      float yp4[4] = {0.f, 0.f, 0.f, 0.f};
      const float dsk16 = dsk * (1.f / 16.f);
#pragma unroll
      for (int tt = 0; tt < 16; ++tt) {
        float4 b0n, b1n, c0n, c1n;
        float xvn, dtn, den;
        if (tt + 1 < 16) {
          const int o_ = (tt + 1) * 128;
          b0n = *(const float4*)(B_ + o_ + ksl4); b1n = *(const float4*)(B_ + o_ + 64 + ksl4);
          c0n = *(const float4*)(C_ + o_ + ksl4); c1n = *(const float4*)(C_ + o_ + 64 + ksl4);
          xvn = X_[(tt + 1) * 16 + rl]; dtn = DT_[tt + 1]; den = DE_[tt + 1];
        }
        __builtin_amdgcn_sched_barrier(0);
        const float xd = xv * dt;
        st[0] = fmaf(st[0], de, xd * b0.x); NOPK(st[0]);
        st[1] = fmaf(st[1], de, xd * b0.y); NOPK(st[1]);
        st[2] = fmaf(st[2], de, xd * b0.z); NOPK(st[2]);
        st[3] = fmaf(st[3], de, xd * b0.w); NOPK(st[3]);
        st[4] = fmaf(st[4], de, xd * b1.x); NOPK(st[4]);
        st[5] = fmaf(st[5], de, xd * b1.y); NOPK(st[5]);
        st[6] = fmaf(st[6], de, xd * b1.z); NOPK(st[6]);
        st[7] = fmaf(st[7], de, xd * b1.w); NOPK(st[7]);
        float acc0 = fmaf(st[0], c0.x, fmaf(st[1], c0.y, fmaf(st[2], c0.z, st[3] * c0.w)));
        float acc1 = fmaf(st[4], c1.x, fmaf(st[5], c1.y, fmaf(st[6], c1.z, st[7] * c1.w)));
        yp4[tt & 3] = fmaf(dsk16, xv, acc0 + acc1);
        if ((tt & 3) == 3) {
          const float r4 = reduce4x16(yp4[0], yp4[1], yp4[2], yp4[3], lane);
          Oc[ooff4 + (tt - 3) * ostr4] = r4;
        }
        __builtin_amdgcn_sched_barrier(0);
        if (tt + 1 < 16) { b0 = b0n; b1 = b1n; c0 = c0n; c1 = c1n; xv = xvn; dt = dtn; de = den; }
      }
    }
    __builtin_amdgcn_sched_barrier(0);
    __syncthreads();
  }
  {
    const long m0 = base + (nblk - 1) * 16;
    u16* pz = p.PROJ + (m0 + stt) * LDP + C_Z + h * 64 + q * 16 + (tid & 15);
    *pz = f2bf(O_[((nblk - 1) & 1) * 256 + stt * 16 + (tid & 15)] * siluf_(bf2f(zc)));
  }
  __syncthreads();
#undef SSD_LOAD
  {
    float* o = p.out + (s < 8 ? O_PSSM + (((long)l * 8 + s) * 8 + h) * 8192
                              : O_SSSM + (((long)l * 8 + (s - 8)) * 8 + h) * 8192);
    *(float4*)(o + row * 128 + ksl4) = make_float4(st[0], st[1], st[2], st[3]);
    *(float4*)(o + row * 128 + 64 + ksl4) = make_float4(st[4], st[5], st[6], st[7]);
  }
  if (h == 0 && q == 0) {
    float* o = p.out + (s < 8 ? O_PCONV + ((long)l * 8 + s) * 3072 : O_SCONV + ((long)l * 8 + (s - 8)) * 3072);
    const long lastblk = (long)(base + T) / 16 - 1;
    for (int i = tid; i < 3072; i += 256) {
      int r = i >> 10, c = i & 1023;
      o[i] = (c < 512) ? bf2f(p.PROJ[(long)(base + T - 3 + r) * LDP + C_XBC + c])
                       : bf2f(p.BND2[(lastblk * 3 + r) * 512 + (c - 512)]);
    }
  }
}

__device__ __forceinline__ void phase_scan(const Params& p, int l, float* smem) {
  for (int u = BID, nb_ = NBLK; u < 1536; u += nb_) {
    int sample = u >= 768;
    int v = sample ? u - 768 : u;
    int type = v % 3, w = v / 3;
    if (type == 0) {
      int q = w & 3, h = (w >> 2) & 7, b = w >> 5;
      scan_rwkv(p, l, b + 8 * sample, h, q, smem);
    } else if (type == 1) {
      int q = w & 7, h = (w >> 3) & 3, b = w >> 5;
      scan_hgrn(p, l, b + 8 * sample, h, q, smem);
    } else {
      int q = w & 3, h = (w >> 2) & 7, b = w >> 5;
      scan_ssd(p, l, b + 8 * sample, h, q, smem);
    }
  }
}

__device__ __forceinline__ void phase_post(const Params& p, int l, float* smem) {
  constexpr int LDG = 516;
  float* GA = smem;
  for (int blk = BID, nb_ = NBLK; blk < NBLK16; blk += nb_) {
    const int tid = opaque_tid(), lane = tid & 63, wid = tid >> 6;
    const int T = tid >> 4, Q = tid & 15;
    const long m0 = (long)blk * 16;
    const long m = m0 + T;
    __syncthreads();
    {
      bf16x8 ag[4];
      const u16* arow = p.PROJ + (m0 + (lane & 15)) * LDP + C_XG + (lane >> 4) * 8;
#pragma unroll
      for (int ks = 0; ks < 4; ++ks) ag[ks] = *(const bf16x8*)(arow + ks * 32);
#pragma unroll
      for (int nt = 0; nt < 8; ++nt) {
        const int n = (wid * 8 + nt) * 16 + (lane & 15);
        f32x4v acc = {0.f, 0.f, 0.f, 0.f};
#pragma unroll
        for (int ks = 0; ks < 4; ++ks) {
          bf16x8 bg = *(const bf16x8*)((p.WB + OFF_G2T) + n * 128 + ks * 32 + (lane >> 4) * 8);
          acc = __builtin_amdgcn_mfma_f32_16x16x32_bf16(ag[ks], bg, acc, 0, 0, 0);
        }
#pragma unroll
        for (int r = 0; r < 4; ++r) GA[((lane >> 4) * 4 + r) * LDG + n] = acc[r];
      }
    }
    __syncthreads();
    u16* row = p.PROJ + m * LDP;
#pragma unroll 1
    for (int g = 0; g < 2; ++g) {
      float y0[8], y1[8], w[8];
      const int c0 = g * 256 + Q * 8, c1 = c0 + 128;
      unpack8(*(const uint4*)(row + C_Z + c0), y0);
      unpack8(*(const uint4*)(row + C_Z + c1), y1);
      float ss = 0.f;
#pragma unroll
      for (int e = 0; e < 8; ++e) ss += y0[e] * y0[e] + y1[e] * y1[e];
      ss = sum16(ss);
      const float rs = rsqrtf(ss * (1.f / 256.f) + 1e-6f);
      ld8(p.ssd_norm_w + l * 512 + c0, w);
#pragma unroll
      for (int e = 0; e < 8; ++e) y0[e] = y0[e] * rs * w[e];
      ld8(p.ssd_norm_w + l * 512 + c1, w);
#pragma unroll
      for (int e = 0; e < 8; ++e) y1[e] = y1[e] * rs * w[e];
      *(uint4*)(row + C_Z + c0) = pack8(y0);
      *(uint4*)(row + C_Z + c1) = pack8(y1);
    }
#pragma unroll 1
    for (int j = 0; j < 4; ++j) {
      const int c0 = j * 128 + Q * 8;
      {
        float oh[8], gg[8], w[8];
        unpack8(*(const uint4*)(row + C_I + c0), oh);
        unpack8(*(const uint4*)(row + C_GG + c0), gg);
        float ss = 0.f;
#pragma unroll
        for (int e = 0; e < 8; ++e) ss += oh[e] * oh[e];
        ss = sum16(ss);
        const float rs = rsqrtf(ss * (1.f / 128.f) + 1e-6f);
        ld8(p.hg_norm_w + l * 512 + c0, w);
#pragma unroll
        for (int e = 0; e < 8; ++e) oh[e] = oh[e] * rs * w[e] * siluf_(gg[e]);
        *(uint4*)(row + C_GG + c0) = pack8(oh);
      }
      {
        float o[8], v[8], w[8], bb[8], ga[8];
        const int head = j * 2 + (Q >> 3);
        unpack8(*(const uint4*)(p.ORW + m * 512 + c0), o);
        unpack8(*(const uint4*)(row + C_V + c0), v);
        float sm = 0.f;
#pragma unroll
        for (int e = 0; e < 8; ++e) sm += o[e];
        const float mean = sum8(sm) * (1.f / 64.f);
        float sv = 0.f;
#pragma unroll
        for (int e = 0; e < 8; ++e) { o[e] -= mean; sv += o[e] * o[e]; }
        const float rstd = rsqrtf(sum8(sv) * (1.f / 64.f) + 64e-5f);
        const float rks = (p.FB + FOFF_RKS)[m * 8 + head];
        ld8(p.rw_lnx_w + l * 512 + c0, w);
        ld8(p.rw_lnx_b + l * 512 + c0, bb);
        ld8(GA + T * LDG + c0, ga);
#pragma unroll
        for (int e = 0; e < 8; ++e) o[e] = (o[e] * rstd * w[e] + bb[e] + rks * v[e]) * ga[e];
        *(uint4*)(row + C_R + c0) = pack8(o);
      }
    }
  }
}

__device__ __forceinline__ void phase_final(const Params& p) {
  const int tid = opaque_tid(), lane = tid & 63, wid = tid >> 6;
  for (int m = BID * 4 + wid, nb_ = NBLK; m < M_TOT; m += nb_ * 4) {
    float* dst;
    if (m < M_PROMPT) {
      int b = m / T_P, t = m - b * T_P;
      if (t < 16) continue;
      dst = p.out + O_YP + ((long)b * 4096 + (t - 16)) * DM;
    } else {
      dst = p.out + O_YS + (long)(m - M_PROMPT) * DM;
    }
    float x[16];
    float ss = 0.f;
#pragma unroll
    for (int j = 0; j < 2; ++j) {
      uint4 raw = *(const uint4*)(p.XB + xb_off(m, lane * 8 + 512 * j));
      unsigned wv[4] = {raw.x, raw.y, raw.z, raw.w};
#pragma unroll
      for (int e = 0; e < 8; ++e) {
        x[j * 8 + e] = bf2f((u16)((wv[e >> 1] >> ((e & 1) * 16)) & 0xffff));
        ss += x[j * 8 + e] * x[j * 8 + e];
      }
    }
    ss = sum64(ss);
    float rs = rsqrtf(ss * (1.f / 1024.f) + 1e-6f);
#pragma unroll
    for (int j = 0; j < 2; ++j) {
      int k0 = lane * 8 + 512 * j;
      float4 w0 = *(const float4*)(p.final_w + k0), w1 = *(const float4*)(p.final_w + k0 + 4);
      *(float4*)(dst + k0) = make_float4(x[j * 8 + 0] * rs * w0.x, x[j * 8 + 1] * rs * w0.y, x[j * 8 + 2] * rs * w0.z,
                                         x[j * 8 + 3] * rs * w0.w);
      *(float4*)(dst + k0 + 4) = make_float4(x[j * 8 + 4] * rs * w1.x, x[j * 8 + 5] * rs * w1.y,
                                             x[j * 8 + 6] * rs * w1.z, x[j * 8 + 7] * rs * w1.w);
    }
  }
}


#define XB_TMO      128
#define XB_XCNT(j)  (256  + 64 * (j))
#define XB_XSUB(j)  (1280 + 64 * (j))
#define XB_XGEN(j)  (2304 + 64 * (j))
#define XB_TOP      3328
#define XB_TOPGEN   3392
#define XCD_BAR_WORDS 3456
#define XB_SPIN_CAP (1u << 22)
__device__ __forceinline__ unsigned xb_ld(unsigned* p) { return __hip_atomic_load(p, __ATOMIC_RELAXED, __HIP_MEMORY_SCOPE_AGENT); }
__device__ __forceinline__ unsigned xb_add(unsigned* p, unsigned v) { return __hip_atomic_fetch_add(p, v, __ATOMIC_RELAXED, __HIP_MEMORY_SCOPE_AGENT); }
__device__ __forceinline__ unsigned xb_xcc_id() { return (unsigned)__builtin_amdgcn_s_getreg((3 << 11) | 20) & 0xFu; }
#define XB_SPIN(cond, bar) do { unsigned _sp = 0; while (cond) { __builtin_amdgcn_s_sleep(1); \
    if ((++_sp & 255u) == 0u) { if (xb_ld(&(bar)[XB_TMO])) break; if (_sp > XB_SPIN_CAP) { atomicAdd(&(bar)[XB_TMO], 1u); break; } } } } while (0)

__device__ __forceinline__ void xcd_barrier_post(unsigned* bar) {
  if (threadIdx.x == 0) (void)xb_add(&bar[XB_XCNT(xb_xcc_id())], 1u);
}
__device__ __forceinline__ void xcd_barrier_complete(unsigned* bar, unsigned x, unsigned& nloc, unsigned& nx) {
  const unsigned G = gridDim.x;
  unsigned sum, cnt, mine, sp = 0u;
  for (;;) {
    sum = 0u; cnt = 0u; mine = 0u;
#pragma unroll
    for (unsigned j = 0; j < 16; ++j) { const unsigned c = xb_ld(&bar[XB_XCNT(j)]); sum += c; cnt += (c > 0u) ? 1u : 0u; mine = (j == x) ? c : mine; }
    if (sum == G) break;
    __builtin_amdgcn_s_sleep(1);
    if ((++sp & 255u) == 0u) { if (xb_ld(&bar[XB_TMO])) break; if (sp > XB_SPIN_CAP) { atomicAdd(&bar[XB_TMO], 1u); break; } }
  }
  nloc = mine > 0u ? mine : 1u; nx = cnt > 0u ? cnt : 1u;
}
__device__ __forceinline__ void xcd_barrier(unsigned* bar, volatile unsigned* st) {
  asm volatile("s_waitcnt vmcnt(0)" ::: "memory");
  __syncthreads();
  if (threadIdx.x == 0) {
    __builtin_amdgcn_s_waitcnt(0);
    const unsigned x = xb_xcc_id();
    unsigned nloc = st[0], nx = st[1];
    if (nloc == 0u) { xcd_barrier_complete(bar, x, nloc, nx); st[0] = nloc; st[1] = nx; }
    const unsigned old = xb_add(&bar[XB_XSUB(x)], 1u);
    const unsigned gen = old / nloc;
    if (old + 1u == (gen + 1u) * nloc) {
      __builtin_amdgcn_fence(__ATOMIC_RELEASE, "agent");
      asm volatile("s_waitcnt vmcnt(0)" ::: "memory");
      const unsigned og = xb_add(&bar[XB_TOP], 1u);
      const unsigned tg = og / nx;
      if (og + 1u == (tg + 1u) * nx) xb_add(&bar[XB_TOPGEN], 1u);
      else XB_SPIN(xb_ld(&bar[XB_TOPGEN]) == tg, bar);
      __builtin_amdgcn_fence(__ATOMIC_ACQUIRE, "agent");
      xb_add(&bar[XB_XGEN(x)], 1u);
      asm volatile("s_waitcnt vmcnt(0)" ::: "memory");
    } else {
      XB_SPIN(xb_ld(&bar[XB_XGEN(x)]) == gen, bar);
      __builtin_amdgcn_fence(__ATOMIC_ACQUIRE, "agent");
      asm volatile("s_waitcnt vmcnt(0)" ::: "memory");
    }
  }
  __syncthreads();
}

constexpr int SMEM_BYTES = 40960;
__device__ __forceinline__ void run_phase(const Params& p, int ph, char* smem) {
  if (ph == 0) { phase_embed(p); return; }
  if (ph == 19) { phase_final(p); return; }
  int l = (ph - 1) / 9, s = (ph - 1) % 9;
  float* fs = (float*)smem;
  switch (s) {
    case 0: phase_convert(p, l, fs); phase_rowstat<true>(p, l, fs); break;
    case 1: phase_gemm<1, true>(p, p.XB, DM, (p.WB + OFF_W1T), 1024, LDP / 128, smem); break;
    case 2: phase_pre(p, l, fs); break;
    case 3: phase_scan(p, l, fs); break;
    case 4: phase_post(p, l, fs); break;
    case 5: phase_gemm<2, false>(p, p.PROJ, LDP, (p.WB + OFF_WOT), 1536, 8, smem); break;
    case 6: phase_rowstat<false>(p, l, fs); break;
    case 7: phase_gemm<3, true>(p, p.XB, DM, (p.WB + OFF_WGU), 1024, 44, smem); break;
    case 8: phase_gemm<2, true>(p, p.PROJ, D_FF, (p.WB + OFF_WDT), D_FF, 8, smem); break;
  }
}
constexpr int N_PHASES = 20;

#if MEGA
__global__ void __launch_bounds__(256, 3) k_mega(Params p) {
  __shared__ __attribute__((aligned(16))) char smem[SMEM_BYTES];
  __shared__ uint4 xb_words;
  if (threadIdx.x == 0) { xb_words = make_uint4(0u, 0u, 0u, 0u); }
  __syncthreads();
  cg::grid_group grid = cg::this_grid();
  float* fs = (float*)smem;
  volatile unsigned* xst = (volatile unsigned*)&xb_words;
  xcd_barrier_post(p.bar);
  phase_embed(p);
  grid.sync();
#define GSYNC() do { unsigned* b_ = p.bar; asm volatile("" : "+s"(b_)); xcd_barrier(b_, xst); } while (0)
  {
    const int L0_ = 0;
    int l = opaque_s(L0_);
    phase_convert(p, l, fs);
    phase_rowstat<true>(p, l, fs);
    GSYNC();
    l = opaque_s(l);
    phase_gemm<1, true>(p, p.XB, DM, (p.WB + OFF_W1T), 1024, LDP / 128, smem);
    GSYNC();
    l = opaque_s(l);
    phase_pre(p, l, fs);
    GSYNC();
    l = opaque_s(l);
    phase_scan(p, l, fs);
    GSYNC();
    l = opaque_s(l);
    phase_post(p, l, fs);
    GSYNC();
    l = opaque_s(l);
    phase_gemm<2, false>(p, p.PROJ, LDP, (p.WB + OFF_WOT), 1536, 8, smem);
    GSYNC();
    l = opaque_s(l);
    phase_rowstat<false>(p, l, fs);
    GSYNC();
    l = opaque_s(l);
    phase_gemm<3, true>(p, p.XB, DM, (p.WB + OFF_WGU), 1024, 44, smem);
    GSYNC();
    l = opaque_s(l);
    phase_gemm<2, true>(p, p.PROJ, D_FF, (p.WB + OFF_WDT), D_FF, 8, smem);
    GSYNC();
  }
  {
    const int L0_ = 1;
    int l = opaque_s(L0_);
    phase_convert(p, l, fs);
    phase_rowstat<true>(p, l, fs);
    GSYNC();
    l = opaque_s(l);
    phase_gemm<1, true>(p, p.XB, DM, (p.WB + OFF_W1T), 1024, LDP / 128, smem);
    GSYNC();
    l = opaque_s(l);
    phase_pre(p, l, fs);
    GSYNC();
    l = opaque_s(l);
    phase_scan(p, l, fs);
    GSYNC();
    l = opaque_s(l);
    phase_post(p, l, fs);
    GSYNC();
    l = opaque_s(l);
    phase_gemm<2, false>(p, p.PROJ, LDP, (p.WB + OFF_WOT), 1536, 8, smem);
    GSYNC();
    l = opaque_s(l);
    phase_rowstat<false>(p, l, fs);
    GSYNC();
    l = opaque_s(l);
    phase_gemm<3, true>(p, p.XB, DM, (p.WB + OFF_WGU), 1024, 44, smem);
    GSYNC();
    l = opaque_s(l);
    phase_gemm<2, true>(p, p.PROJ, D_FF, (p.WB + OFF_WDT), D_FF, 8, smem);
    GSYNC();
  }
  phase_final(p);
}
#else
template <int PH>
__global__ void __launch_bounds__(256, 3) k_phase(Params p) {
  __shared__ __attribute__((aligned(16))) char smem[SMEM_BYTES];
  run_phase(p, PH, smem);
}
template <int PH>
static void launch_all(const Params& p, int grid, hipStream_t stream) {
  hipLaunchKernelGGL(k_phase<PH>, dim3(grid), dim3(256), 0, stream, p);
  if constexpr (PH + 1 < N_PHASES) launch_all<PH + 1>(p, grid, stream);
}
#endif

extern "C" void kernel_launch(void* const* d_in, const int* in_sizes, int n_in, void* d_out, int out_size, void* d_ws,
                              size_t ws_size, hipStream_t stream) {
  Params p{};
  const float** pf = (const float**)&p;
  for (int i = 0; i < 35; ++i) pf[i] = (const float*)d_in[i];
  p.out = (float*)d_out;
  char* ws = (char*)d_ws;
  size_t off = 0;
  auto take = [&](size_t bytes) { char* r = ws + off; off += (bytes + 255) & ~(size_t)255; return r; };
  p.XB = (u16*)take((size_t)M_TOT * DM * 2);
  p.PROJ = (u16*)take((size_t)M_TOT * LDP * 2);
  p.WB = (u16*)take((size_t)WB_TOTAL * 2);
  p.BND = (u16*)take((size_t)NBLK16 * 1792 * 2);
  p.BND2 = (u16*)take((size_t)NBLK16 * 3 * 512 * 2);
  p.ORW = (u16*)take((size_t)M_TOT * 512 * 2);
  p.FB = (float*)take((size_t)FB_TOTAL * 4);
  p.bar = (unsigned*)take((size_t)XCD_BAR_WORDS * 4);
  p.RWX = (u16*)d_out;
  if (off > ws_size) fprintf(stderr, "workspace too small: need %zu have %zu\n", off, ws_size);
#if MEGA
  static int grid_blocks = 0;
  if (!grid_blocks) {
    int dev = 0, cus = 0, per_cu = 0;
    hipGetDevice(&dev);
    hipDeviceGetAttribute(&cus, hipDeviceAttributeMultiprocessorCount, dev);
    hipOccupancyMaxActiveBlocksPerMultiprocessor(&per_cu, k_mega, 256, 0);
    if (per_cu > 3) per_cu = 3;
    grid_blocks = cus * per_cu;
  }
  hipMemsetAsync(p.bar, 0, (size_t)XCD_BAR_WORDS * 4, stream);
  void* args[] = {&p};
  hipError_t e = hipLaunchCooperativeKernel((void*)k_mega, dim3(grid_blocks), dim3(256), args, 0, stream);
  if (e != hipSuccess) fprintf(stderr, "cooperative launch failed: %s (grid %d)\n", hipGetErrorString(e), grid_blocks);
#else
  launch_all<0>(p, 768, stream);
#endif
}
```

```cpp
#include <hip/hip_runtime.h>
#include <hip/hip_bf16.h>
#include <hip/hip_cooperative_groups.h>
#include <cstdio>
namespace cg = cooperative_groups;

#ifndef MEGA
#define MEGA 1
#endif

typedef unsigned short u16;
using bf16x8 = __attribute__((ext_vector_type(8))) short;
using f32x16 = __attribute__((ext_vector_type(16))) float;
using f32x4v = __attribute__((ext_vector_type(4))) float;

constexpr int DM = 1024;
constexpr int M_TOT = 33408;
constexpr int M_PROMPT = 32896;
constexpr int T_P = 4112;
constexpr int LDP = 5376;
constexpr int N_IN = 5384;
constexpr int D_FF = 2816;
constexpr int NBLK16 = M_TOT / 16;
constexpr int C_Z = 0, C_R = 512, C_GG = 1024, C_XBC = 1536, C_K = 2560, C_V = 3072, C_XW = 3584, C_XA = 3648,
              C_XG = 3712, C_Q = 3840, C_F = 4352, C_I = 4864;
constexpr long O_YP = 0, O_YS = 33554432, O_PSSM = 34078720, O_PCONV = 35127296, O_PRWKV = 35176448,
               O_PSHIFT = 35700736, O_PHGRN = 35729408, O_SSSM = 36777984, O_SCONV = 37826560,
               O_SRWKV = 37875712, O_SSHIFT = 38400000, O_SHGRN = 38428672;

constexpr long OFF_W1T = 0, OFF_WOT = 5505024, OFF_WGU = 7077888, OFF_WDT = 12845056, OFF_W2T = 15728640, OFF_A2T = 15761408, OFF_G2T = 15794176, WB_TOTAL = 15859712;
constexpr long FOFF_RS = 0, FOFF_DTRAW = 33408, FOFF_RKS = 300672, FB_TOTAL = 567936;
struct Params {
  const float *x_prompt, *x_sample, *state_ssm, *state_conv, *state_rwkv, *state_shift, *state_hgrn, *meta,
      *norm1_w, *w_in, *conv_w, *conv_b, *dt_bias, *a_log, *d_skip, *ssd_norm_w, *rw_mu, *rw_w0, *rw_w2, *rw_a0,
      *rw_a2, *rw_g2, *rw_kk, *rw_ka, *rw_rk, *rw_lnx_w, *rw_lnx_b, *hg_lb, *hg_norm_w, *w_out, *norm2_w, *w_gate,
      *w_up, *w_down, *final_w;
  float* out;
  u16 *XB, *PROJ, *WB, *BND, *BND2, *ORW, *RWX;
  float *FB;
  unsigned* bar;
};

typedef __bf16 bf16x2_t __attribute__((ext_vector_type(2)));
typedef float f32x2_t __attribute__((ext_vector_type(2)));
__device__ __forceinline__ unsigned cvt2bf(float a, float b) {
  f32x2_t v = {a, b};
  bf16x2_t r = __builtin_convertvector(v, bf16x2_t);
  return __builtin_bit_cast(unsigned, r);
}
__device__ __forceinline__ u16 f2bf(float f) { return (u16)(cvt2bf(f, f) & 0xffffu); }
__device__ __forceinline__ float bf2f(u16 h) { return __uint_as_float(((unsigned)h) << 16); }
__device__ __forceinline__ float frcp_(float x) { return __builtin_amdgcn_rcpf(x); }
__device__ __forceinline__ float sigmoidf_(float x) { return frcp_(1.f + __expf(-x)); }
__device__ __forceinline__ float siluf_(float x) { return x * frcp_(1.f + __expf(-x)); }
__device__ __forceinline__ float softplusf_(float x) { return x > 20.f ? x : __logf(1.f + __expf(x)); }
__device__ __forceinline__ float tanhf_(float x) { return 1.f - 2.f * __builtin_amdgcn_rcpf(1.f + __expf(2.f * x)); }

template <int CTRL>
__device__ __forceinline__ float dppf(float v) {
  return __int_as_float(__builtin_amdgcn_update_dpp(0, __float_as_int(v), CTRL, 0xF, 0xF, true));
}
__device__ __forceinline__ float sum16(float v) {
  v += dppf<0xB1>(v);
  v += dppf<0x4E>(v);
  v += dppf<0x141>(v);
  v += dppf<0x140>(v);
  return v;
}
__device__ __forceinline__ void sum16x2(float& a, float& b) {
  a += dppf<0xB1>(a); b += dppf<0xB1>(b);
  a += dppf<0x4E>(a); b += dppf<0x4E>(b);
  a += dppf<0x141>(a); b += dppf<0x141>(b);
  a += dppf<0x140>(a); b += dppf<0x140>(b);
}

__device__ __forceinline__ float sum8(float v) {
  v += dppf<0xB1>(v);
  v += dppf<0x4E>(v);
  v += dppf<0x141>(v);
  return v;
}
__device__ __forceinline__ void unpack8(const uint4& r, float* f) {
  f[0] = __uint_as_float(r.x << 16); f[1] = __uint_as_float(r.x & 0xffff0000u);
  f[2] = __uint_as_float(r.y << 16); f[3] = __uint_as_float(r.y & 0xffff0000u);
  f[4] = __uint_as_float(r.z << 16); f[5] = __uint_as_float(r.z & 0xffff0000u);
  f[6] = __uint_as_float(r.w << 16); f[7] = __uint_as_float(r.w & 0xffff0000u);
}
__device__ __forceinline__ uint4 pack8(const float* f) {
  uint4 r;
  r.x = cvt2bf(f[0], f[1]);
  r.y = cvt2bf(f[2], f[3]);
  r.z = cvt2bf(f[4], f[5]);
  r.w = cvt2bf(f[6], f[7]);
  return r;
}
__device__ __forceinline__ void ld8(const float* p, float* f) {
  float4 a = *(const float4*)p, b = *(const float4*)(p + 4);
  f[0] = a.x; f[1] = a.y; f[2] = a.z; f[3] = a.w; f[4] = b.x; f[5] = b.y; f[6] = b.z; f[7] = b.w;
}

struct F8 { float v[8]; };
__device__ __forceinline__ F8 up8(const uint4& r) { F8 f; unpack8(r, f.v); return f; }
__device__ __forceinline__ F8 ldf8(const float* p) { F8 f; ld8(p, f.v); return f; }
__device__ __forceinline__ F8 zero8() { F8 f; for (int e = 0; e < 8; ++e) f.v[e] = 0.f; return f; }
__device__ __forceinline__ float reduce4x16(float a, float b, float c, float d, int lane) {
  const bool o1 = (lane & 1) != 0, o2 = (lane & 2) != 0;
  float k0 = o1 ? b : a, s0 = o1 ? a : b;
  float k1 = o1 ? d : c, s1 = o1 ? c : d;
  k0 += dppf<0xB1>(s0);
  k1 += dppf<0xB1>(s1);
  float kp = o2 ? k1 : k0, sd = o2 ? k0 : k1;
  kp += dppf<0x4E>(sd);
  kp += dppf<0x124>(kp);
  kp += dppf<0x128>(kp);
  return kp;
}
__device__ __forceinline__ float sum64(float v) {
  v = sum16(v);
  v += __shfl_xor(v, 16);
  v += __shfl_xor(v, 32);
  return v;
}

#define NOPK(x) asm("" : "+v"(x))
__device__ __forceinline__ int opaque_tid() {
  int t = threadIdx.x;
  asm volatile("" : "+v"(t));
  return t;
}
__device__ __forceinline__ int opaque_s(int v) {
  asm volatile("" : "+s"(v));
  return v;
}
#define BID opaque_s((int)blockIdx.x)
#define NBLK opaque_s((int)gridDim.x)
__device__ __forceinline__ int seq_base(int s) { return s < 8 ? s * T_P : M_PROMPT + (s - 8) * 64; }
__device__ __forceinline__ int seq_len(int s) { return s < 8 ? T_P : 64; }

__device__ __forceinline__ long xb_off(int m, int k);
__device__ __forceinline__ void phase_embed(const Params& p) {
  const long n4 = (long)M_TOT * 256;
  for (long idx = (long)BID * 256 + threadIdx.x, st_ = (long)NBLK * 256; idx < n4; idx += st_) {
    int m = (int)(idx >> 8), c4 = ((int)idx & 255) * 4;
    const float* src;
    if (m < M_PROMPT) {
      int b = m / T_P, t = m - b * T_P;
      src = (t < 16) ? p.meta + (long)t * DM : p.x_prompt + ((long)b * 4096 + (t - 16)) * DM;
    } else {
      src = p.x_sample + (long)(m - M_PROMPT) * DM;
    }
    float4 v = *(const float4*)(src + c4);
    ushort4 o;
    o.x = f2bf(v.x); o.y = f2bf(v.y); o.z = f2bf(v.z); o.w = f2bf(v.w);
    *(ushort4*)(p.XB + xb_off(m, c4)) = o;
  }
}

__device__ __forceinline__ long xb_off(int m, int k) { return ((long)(m >> 7) * 32 + (k >> 5)) * 4096 + (m & 127) * 32 + (k & 31); }
__device__ __forceinline__ long wtile_off(int n, int k, int K) {
  return ((long)(n >> 7) * (K >> 5) + (k >> 5)) * 4096 + (n & 127) * 32 + (k & 31);
}
template <bool HAS_SCALE>
__device__ __forceinline__ void conv_tile(const float* __restrict__ src, int ldsrc, int srccol0, const float* __restrict__ scale,
                          u16* __restrict__ dst, int K, int k0, int n0, float* tile  ) {
  const int tid = opaque_tid();
  __syncthreads();
  {
    int nn = tid & 63, kb = tid >> 6;
#pragma unroll
    for (int i = 0; i < 16; ++i) {
      int kk = kb + 4 * i;
      float v = src[(long)(k0 + kk) * ldsrc + srccol0 + nn];
      if (HAS_SCALE) v *= scale[k0 + kk];
      tile[kk * 65 + nn] = v;
    }
  }
  __syncthreads();
  {
    int nn = tid >> 2, kq = (tid & 3) * 16;
    u16* d = dst + wtile_off(n0 + nn, k0 + kq, K);
#pragma unroll
    for (int j = 0; j < 16; j += 2) {
      unsigned w = f2bf(tile[(kq + j) * 65 + nn]) | ((unsigned)f2bf(tile[(kq + j + 1) * 65 + nn]) << 16);
      *(unsigned*)(d + j) = w;
    }
  }
}

__device__ __forceinline__ int w1_srccol(int n0) {
  if (n0 < 512) return n0;
  if (n0 < 1024) return n0 - 512 + 1544;
  if (n0 < 1536) return n0 - 1024 + 4872;
  if (n0 < 2560) return n0 - 1536 + 512;
  if (n0 < 3840) return n0 - 2560 + 2056;
  return n0 - 3840 + 3336;
}

constexpr int CV_W1 = 16 * 84, CV_WO = 24 * 16, CV_WGU = 16 * 88, CV_WD = 44 * 16;
constexpr int CV_LORA = 32;
constexpr int CV_TOTAL = CV_W1 + CV_WO + CV_WGU + CV_WD + CV_LORA;

__device__ __forceinline__ void phase_convert(const Params& p, int l, float* smem) {
  for (int u = BID, nb_ = NBLK; u < CV_TOTAL; u += nb_) {
    if (u < CV_W1) {
      int kt = u % 16, nt = u / 16;
      conv_tile<true>(p.w_in + (long)l * DM * N_IN, N_IN, w1_srccol(nt * 64), p.norm1_w + l * DM, (p.WB + OFF_W1T), 1024, kt * 64,
                nt * 64, smem);
    } else if (u < CV_W1 + CV_WO) {
      int v = u - CV_W1;
      int kt = v % 24, nt = v / 24;
      conv_tile<false>(p.w_out + (long)l * 1536 * DM, DM, nt * 64, nullptr, (p.WB + OFF_WOT), 1536, kt * 64, nt * 64, smem);
    } else if (u < CV_W1 + CV_WO + CV_WGU) {
      int v = u - CV_W1 - CV_WO;
      int kt = v % 16, nt = v / 16;
      const float* wg = p.w_gate + (long)l * DM * D_FF;
      const float* wu = p.w_up + (long)l * DM * D_FF;
      const float* sc = p.norm2_w + l * DM;
      const int tid = opaque_tid();
      __syncthreads();
      {
        int nn = tid & 63, kb = tid >> 6;
        const float* src = (nn < 32) ? wg : wu;
        int col = nt * 32 + (nn & 31);
#pragma unroll
        for (int i = 0; i < 16; ++i) {
          int kk = kb + 4 * i;
          smem[kk * 65 + nn] = src[(long)(kt * 64 + kk) * D_FF + col] * sc[kt * 64 + kk];
        }
      }
      __syncthreads();
      {
        int nn = tid >> 2, kq = (tid & 3) * 16;
        u16* d = (p.WB + OFF_WGU) + wtile_off(nt * 64 + nn, kt * 64 + kq, 1024);
#pragma unroll
        for (int j = 0; j < 16; j += 2) {
          unsigned w = f2bf(smem[(kq + j) * 65 + nn]) | ((unsigned)f2bf(smem[(kq + j + 1) * 65 + nn]) << 16);
          *(unsigned*)(d + j) = w;
        }
      }
    } else if (u >= CV_W1 + CV_WO + CV_WGU + CV_WD) {
      int v = u - (CV_W1 + CV_WO + CV_WGU + CV_WD);
      const int tid = opaque_tid();
#pragma unroll 4
      for (int i = 0; i < 16; ++i) {
        int e = v * 4096 + i * 256 + tid;
        if (e < 32768) {
          int n = e >> 6, k = e & 63;
          (p.WB + OFF_W2T)[e] = f2bf(p.rw_w2[(long)l * 64 * 512 + k * 512 + n]);
        } else if (e < 65536) {
          int e2 = e - 32768, n = e2 >> 6, k = e2 & 63;
          (p.WB + OFF_A2T)[e2] = f2bf(p.rw_a2[(long)l * 64 * 512 + k * 512 + n]);
        } else {
          int e2 = e - 65536, n = e2 >> 7, k = e2 & 127;
          (p.WB + OFF_G2T)[e2] = f2bf(p.rw_g2[(long)l * 128 * 512 + k * 512 + n]);
        }
      }
    } else {
      int v = u - CV_W1 - CV_WO - CV_WGU;
      int kt = v % 44, nt = v / 44;
      conv_tile<false>(p.w_down + (long)l * D_FF * DM, DM, nt * 64, nullptr, (p.WB + OFF_WDT), D_FF, kt * 64, nt * 64, smem);
    }
  }
}

template <bool WITH_DT>
__device__ __forceinline__ void phase_rowstat(const Params& p, int l, float* smem) {
  const int tid = opaque_tid(), lane = tid & 63, wid = tid >> 6;
  float* dtw = smem;
  if (WITH_DT) {
    __syncthreads();
    const float* w = p.w_in + (long)l * DM * N_IN + 1536;
    const float* nw = p.norm1_w + l * DM;
    for (int i = tid; i < 8192; i += 256) {
      int k = i >> 3, h = i & 7;
      dtw[i] = w[(long)k * N_IN + h] * nw[k];
    }
    __syncthreads();
  }
  for (int blk = BID, nb_ = NBLK; blk < NBLK16; blk += nb_) {
    for (int rr = wid; rr < 16; rr += 4) {
      int m = blk * 16 + rr;
      float ss = 0.f;
      float d[8];
#pragma unroll
      for (int h = 0; h < 8; ++h) d[h] = 0.f;
#pragma unroll 1
      for (int j = 0; j < 4; ++j) {
        int k0 = lane * 4 + 256 * j;
        uint2 raw = *(const uint2*)(p.XB + xb_off(m, k0));
        float xs[4] = {bf2f((u16)(raw.x & 0xffff)), bf2f((u16)(raw.x >> 16)), bf2f((u16)(raw.y & 0xffff)),
                       bf2f((u16)(raw.y >> 16))};
#pragma unroll
        for (int e = 0; e < 4; ++e) {
          float x = xs[e];
          ss += x * x;
          if (WITH_DT) {
            float4 w0 = *(const float4*)(dtw + (k0 + e) * 8);
            float4 w1 = *(const float4*)(dtw + (k0 + e) * 8 + 4);
            d[0] += x * w0.x; d[1] += x * w0.y; d[2] += x * w0.z; d[3] += x * w0.w;
            d[4] += x * w1.x; d[5] += x * w1.y; d[6] += x * w1.z; d[7] += x * w1.w;
          }
        }
      }
      ss = sum64(ss);
      float rs = rsqrtf(ss * (1.f / 1024.f) + 1e-6f);
      if (WITH_DT) {
#pragma unroll
        for (int h = 0; h < 8; ++h) d[h] = sum64(d[h]);
        if (lane == 0) {
#pragma unroll
          for (int h = 0; h < 8; ++h) (p.FB + FOFF_DTRAW)[(long)m * 8 + h] = d[h] * rs;
        }
      }
      if (lane == 0) (p.FB + FOFF_RS)[m] = rs;
    }
  }
}

constexpr int G_BK = 32, G_LDS_ROW = 80;
constexpr int G_OPER_BYTES = 128 * G_LDS_ROW;
template <int MODE, bool A_TILED>
__device__ __forceinline__ void phase_gemm(const Params& p, const u16* __restrict__ A, int lda, const u16* __restrict__ Bt, int K,
                           int nN, char* smem) {
  const int tid = opaque_tid(), lane = tid & 63, wid = tid >> 6, wm = wid >> 1, wn = wid & 1;
  const int nM = M_TOT / 128;
  const int ntiles = nM * nN;
  const int nk = K / G_BK;
  const int lrow = tid >> 2, lkc = tid & 3;
  for (int tile = BID, nb_ = NBLK; tile < ntiles; tile += nb_) {
    constexpr int GM = 32;
    int grp = tile / (GM * nN);
    int first_m = grp * GM;
    int gsz = min(GM, nM - first_m);
    int rem = tile - grp * GM * nN;
    int pm = first_m + rem % gsz, pn = rem / gsz;
    const u16* gA = A_TILED ? A + (long)pm * (K >> 5) * 4096 + lrow * 32 + lkc * 8
                            : A + (long)(pm * 128 + lrow) * lda + lkc * 8;
    const u16* gB = Bt + (long)pn * (K >> 5) * 4096 + lrow * 32 + lkc * 8;
    f32x16 acc[2][2];
#pragma unroll
    for (int i = 0; i < 2; ++i)
#pragma unroll
      for (int j = 0; j < 2; ++j)
#pragma unroll
        for (int r = 0; r < 16; ++r) acc[i][j][r] = 0.f;
    uint4 xa0, xa1, xb0, xb1, ya0, ya1, yb0, yb1, za0, za1, zb0, zb1;
#define G_LOAD(S, KT)                                                  \
  {                                                                    \
    S##a0 = *(const uint4*)(A_TILED ? gA + (long)(KT) * 4096 : gA + (KT) * G_BK);                          \
    S##a1 = *(const uint4*)(A_TILED ? gA + (long)(KT) * 4096 + 2048 : gA + (long)64 * lda + (KT) * G_BK);  \
    S##b0 = *(const uint4*)(gB + (long)(KT) * 4096);                   \
    S##b1 = *(const uint4*)(gB + (long)(KT) * 4096 + 2048);            \
  }
#define G_STORE(S, BUF)                                                \
  {                                                                    \
    char* dA = smem + (BUF) * 2 * G_OPER_BYTES;                        \
    char* dB = dA + G_OPER_BYTES;                                      \
    *(uint4*)(dA + lrow * G_LDS_ROW + lkc * 16) = S##a0;               \
    *(uint4*)(dA + (lrow + 64) * G_LDS_ROW + lkc * 16) = S##a1;        \
    *(uint4*)(dB + lrow * G_LDS_ROW + lkc * 16) = S##b0;               \
    *(uint4*)(dB + (lrow + 64) * G_LDS_ROW + lkc * 16) = S##b1;        \
  }
#define G_READ(BUF, KS, AF, BF)                                                                  \
  {                                                                                              \
    const char* sA = smem + (BUF) * 2 * G_OPER_BYTES;                                            \
    const char* sB = sA + G_OPER_BYTES;                                                          \
    const int koff = ((KS) * 16 + (lane >> 5) * 8) * 2;                                          \
    _Pragma("unroll") for (int i = 0; i < 2; ++i)                                                \
      AF[i] = *(const bf16x8*)(sA + (wm * 64 + i * 32 + (lane & 31)) * G_LDS_ROW + koff);        \
    _Pragma("unroll") for (int j = 0; j < 2; ++j)                                                \
      BF[j] = *(const bf16x8*)(sB + (wn * 64 + j * 32 + (lane & 31)) * G_LDS_ROW + koff);        \
  }
#define G_MMA(AF, BF)                                                                            \
  {                                                                                              \
    __builtin_amdgcn_s_setprio(1);                                                               \
    _Pragma("unroll") for (int i = 0; i < 2; ++i)                                                \
      _Pragma("unroll") for (int j = 0; j < 2; ++j)                                              \
        acc[i][j] = __builtin_amdgcn_mfma_f32_32x32x16_bf16(AF[i], BF[j], acc[i][j], 0, 0, 0);   \
    __builtin_amdgcn_s_setprio(0);                                                               \
  }
    G_LOAD(x, 0);
    G_LOAD(y, 1);
    G_LOAD(z, 2);
    __builtin_amdgcn_sched_barrier(0);
    __syncthreads();
    G_STORE(x, 0);
    __syncthreads();
#define G_STEP(T, SNEXT, SFREE, BUF)                          \
    if ((T) < nk) {                                           \
      bf16x8 af0[2], bf0[2];                                  \
      G_READ(BUF, 0, af0, bf0);                               \
      __builtin_amdgcn_sched_barrier(0);                      \
      if ((T) + 1 < nk) G_STORE(SNEXT, (BUF) ^ 1);            \
      if ((T) + 3 < nk) G_LOAD(SFREE, (T) + 3);               \
      __builtin_amdgcn_sched_barrier(0);                      \
      G_MMA(af0, bf0);                                        \
      G_READ(BUF, 1, af0, bf0);                               \
      G_MMA(af0, bf0);                                        \
      __builtin_amdgcn_sched_barrier(0);                      \
      __syncthreads();                                        \
    }
    for (int kt = 0; kt < nk; kt += 6) {
      G_STEP(kt + 0, y, x, 0);
      G_STEP(kt + 1, z, y, 1);
      G_STEP(kt + 2, x, z, 0);
      G_STEP(kt + 3, y, x, 1);
      G_STEP(kt + 4, z, y, 0);
      G_STEP(kt + 5, x, z, 1);
    }
#undef G_STEP
#undef G_LOAD
#undef G_STORE
#undef G_READ
#undef G_MMA
    int te = tid;
    asm volatile("" : "+v"(te));
    const int lane_e = te & 63, wm_e = te >> 7, wn_e = (te >> 6) & 1;
    const int lr0 = wm_e * 64 + 4 * (lane_e >> 5);
    const int lc0 = wn_e * 64 + (lane_e & 31);
    if (MODE == 1) {
      u16* ST = (u16*)smem;
#pragma unroll
      for (int i = 0; i < 2; ++i)
#pragma unroll
        for (int r = 0; r < 16; ++r) {
          const int lr = lr0 + i * 32 + (r & 3) + 8 * (r >> 2);
          const float rs = (p.FB + FOFF_RS)[pm * 128 + lr];
#pragma unroll
          for (int j = 0; j < 2; ++j) ST[lr * 136 + lc0 + j * 32] = f2bf(acc[i][j][r] * rs);
        }
      __syncthreads();
      const int col0 = pn * 128;
      const int bnd_j = (col0 >= C_R && col0 < C_GG) ? (col0 - C_R) : ((col0 >= C_K && col0 < C_Q) ? (col0 - C_K + 512) : -1);
      const bool bc = (col0 >= C_XBC + 512 && col0 < C_XBC + 1024);
#pragma unroll
      for (int q = 0; q < 8; ++q) {
        const int c = te + 256 * q, crow = c >> 4, cc = (c & 15) * 8;
        const uint4 v = *(const uint4*)(ST + crow * 136 + cc);
        const int row = pm * 128 + crow;
        *(uint4*)(p.PROJ + (long)row * LDP + col0 + cc) = v;
        if (bnd_j >= 0 && (crow & 15) == 15) *(uint4*)(p.BND + (long)(row >> 4) * 1792 + bnd_j + cc) = v;
        if (bc && (crow & 15) >= 13)
          *(uint4*)(p.BND2 + ((long)(row >> 4) * 3 + ((crow & 15) - 13)) * 512 + (col0 - (C_XBC + 512)) + cc) = v;
      }
    } else if (MODE == 2) {
      float* SF = (float*)smem;
#pragma unroll
      for (int i = 0; i < 2; ++i) {
        if (i) __syncthreads();
#pragma unroll
        for (int r = 0; r < 16; ++r) {
          const int l2 = wm_e * 32 + (r & 3) + 8 * (r >> 2) + 4 * (lane_e >> 5);
#pragma unroll
          for (int j = 0; j < 2; ++j) SF[l2 * 132 + lc0 + j * 32] = acc[i][j][r];
        }
        __syncthreads();
#pragma unroll
        for (int q = 0; q < 4; ++q) {
          const int c = te + 256 * q, l2 = c >> 4, cc = (c & 15) * 8;
          const int row = pm * 128 + (l2 >> 5) * 64 + i * 32 + (l2 & 31);
          float d[8], x[8];
          ld8(SF + l2 * 132 + cc, d);
          u16* px = p.XB + xb_off(row, pn * 128 + cc);
          unpack8(*(const uint4*)px, x);
#pragma unroll
          for (int e = 0; e < 8; ++e) x[e] += d[e];
          *(uint4*)px = pack8(x);
        }
      }
    } else {
      u16* ST = (u16*)smem;
      u16* ACT = p.PROJ;
#pragma unroll
      for (int i = 0; i < 2; ++i)
#pragma unroll
        for (int r = 0; r < 16; ++r) {
          const int lr = lr0 + i * 32 + (r & 3) + 8 * (r >> 2);
          const float rs = (p.FB + FOFF_RS)[pm * 128 + lr];
          const float g = acc[i][0][r] * rs, u = acc[i][1][r] * rs;
          ST[lr * 72 + wn_e * 32 + (lane_e & 31)] = f2bf(siluf_(g) * u);
        }
      __syncthreads();
#pragma unroll
      for (int q = 0; q < 4; ++q) {
        const int c = te + 256 * q, crow = c >> 3, cc = (c & 7) * 8;
        const uint4 v = *(const uint4*)(ST + crow * 72 + cc);
        *(uint4*)(ACT + wtile_off(pm * 128 + crow, pn * 64 + cc, D_FF)) = v;
      }
    }
  }
}

__device__ __forceinline__ void phase_pre(const Params& p, int l, float* smem) {
  u16* XWb = (u16*)smem;
  u16* XAb = (u16*)smem + 16 * 72;
  constexpr int LDW = 260;
  float* AW = smem + 1152;
  float* AA = smem + 1152 + 16 * LDW;
  const float* mu = p.rw_mu + l * 1792;
  for (int blk = BID, nb_ = NBLK; blk < NBLK16; blk += nb_) {
    const int tid = opaque_tid(), lane = tid & 63, wid = tid >> 6;
    const int T = tid >> 4, Q = tid & 15;
    const int m0 = blk * 16;
    const long m = m0 + T;
    int s, t0;
    if (m0 < M_PROMPT) { s = m0 / T_P; t0 = m0 - s * T_P; } else { s = 8 + (m0 - M_PROMPT) / 64; t0 = (m0 - M_PROMPT) & 63; }
    const bool first = (t0 == 0);
    u16* row = p.PROJ + m * LDP;
    const u16* bndrow = p.BND + (long)(blk > 0 ? blk - 1 : 0) * 1792;
    const float* shrow = p.state_shift + ((long)l * 8 + (s >= 8 ? s - 8 : 0)) * 1792;
    const bool seqstart = first && (T == 0);
#define SHIFT8(DST, J, COL)                                                                 \
    {                                                                                       \
      float cur_[8], pv_[8], mj_[8];                                                        \
      unpack8(*(const uint4*)(row + (COL)), cur_);                                          \
      const u16* ps_ = (T > 0) ? (row - LDP + (COL)) : (bndrow + (J));                      \
      unpack8(*(const uint4*)ps_, pv_);                                                     \
      if (seqstart) {                                                                       \
        if (s >= 8) ld8(shrow + (J), pv_);                                                  \
        else { _Pragma("unroll") for (int e = 0; e < 8; ++e) pv_[e] = 0.f; }                \
      }                                                                                     \
      ld8(mu + (J), mj_);                                                                   \
      _Pragma("unroll") for (int e = 0; e < 8; ++e) DST[e] = cur_[e] + (pv_[e] - cur_[e]) * mj_[e]; \
    }
    __syncthreads();
    {
      float sh0[8], sh1[8];
      SHIFT8(sh0, 1536 + Q * 8, C_XW + Q * 8);
      SHIFT8(sh1, 1664 + Q * 8, C_XG + Q * 8);
      __syncthreads();
      if (Q < 8) {
#pragma unroll
        for (int e = 0; e < 8; ++e) sh0[e] = tanhf_(sh0[e]);
        *(uint4*)(XWb + T * 72 + Q * 8) = pack8(sh0);
      } else {
        *(uint4*)(XAb + T * 72 + (Q - 8) * 8) = pack8(sh0);
      }
#pragma unroll
      for (int e = 0; e < 8; ++e) sh1[e] = sigmoidf_(sh1[e]);
      *(uint4*)(row + C_XG + Q * 8) = pack8(sh1);
    }
    __syncthreads();
#pragma unroll 1
    for (int c = 0; c < 2; ++c) {
      {
        bf16x8 axw[2], axa[2];
#pragma unroll
        for (int ks = 0; ks < 2; ++ks) {
          axw[ks] = *(const bf16x8*)(XWb + (lane & 15) * 72 + ks * 32 + (lane >> 4) * 8);
          axa[ks] = *(const bf16x8*)(XAb + (lane & 15) * 72 + ks * 32 + (lane >> 4) * 8);
        }
#pragma unroll
        for (int nt = 0; nt < 4; ++nt) {
          const int ncol = (wid * 4 + nt) * 16 + (lane & 15);
          const int n = c * 256 + ncol;
          f32x4v accw = {0.f, 0.f, 0.f, 0.f}, acca = {0.f, 0.f, 0.f, 0.f};
#pragma unroll
          for (int ks = 0; ks < 2; ++ks) {
            bf16x8 bw = *(const bf16x8*)((p.WB + OFF_W2T) + n * 64 + ks * 32 + (lane >> 4) * 8);
            bf16x8 ba = *(const bf16x8*)((p.WB + OFF_A2T) + n * 64 + ks * 32 + (lane >> 4) * 8);
            accw = __builtin_amdgcn_mfma_f32_16x16x32_bf16(axw[ks], bw, accw, 0, 0, 0);
            acca = __builtin_amdgcn_mfma_f32_16x16x32_bf16(axa[ks], ba, acca, 0, 0, 0);
          }
#pragma unroll
          for (int r = 0; r < 4; ++r) {
            AW[((lane >> 4) * 4 + r) * LDW + ncol] = accw[r];
            AA[((lane >> 4) * 4 + r) * LDW + ncol] = acca[r];
          }
        }
      }
#pragma unroll 1
      for (int jj = 0; jj < 2; ++jj) {
        const int ch0 = c * 256 + jj * 128 + Q * 8;
        const int head = c * 4 + jj * 2 + (Q >> 3);
        float rt[8], kt[8];
        uint4 vpk;
        SHIFT8(rt, ch0, C_R + ch0);
        SHIFT8(kt, 512 + ch0, C_K + ch0);
        {
          float vt[8];
          SHIFT8(vt, 1024 + ch0, C_V + ch0);
          vpk = pack8(vt);
        }
        __syncthreads();
        float aw[8], aa[8], w0[8], a0[8];
        ld8(AW + T * LDW + jj * 128 + Q * 8, aw);
        ld8(AA + T * LDW + jj * 128 + Q * 8, aa);
        ld8(p.rw_w0 + l * 512 + ch0, w0);
        ld8(p.rw_a0 + l * 512 + ch0, a0);
        {
          float uu[8];
#pragma unroll
          for (int e = 0; e < 8; ++e) {
            float lw = -softplusf_(-(w0[e] + aw[e])) - 0.5f;
            uu[e] = -__expf(lw);
            aa[e] = sigmoidf_(a0[e] + aa[e]);
          }
          *(uint4*)(p.RWX + m * 1536 + ch0) = pack8(uu);
        }
        *(uint4*)(row + C_R + ch0) = pack8(rt);
        *(uint4*)(row + C_V + ch0) = vpk;
        float kkw[8], kaw[8], rkw[8], kk[8], kp[8];
        ld8(p.rw_kk + l * 512 + ch0, kkw);
        ld8(p.rw_ka + l * 512 + ch0, kaw);
        ld8(p.rw_rk + l * 512 + ch0, rkw);
        float ssq = 0.f, rks = 0.f;
#pragma unroll
        for (int e = 0; e < 8; ++e) {
          kk[e] = kt[e] * kkw[e];
          ssq += kk[e] * kk[e];
          kp[e] = kt[e] * (1.f + (aa[e] - 1.f) * kaw[e]);
          rks += rt[e] * kp[e] * rkw[e];
        }
        ssq = sum8(ssq);
        rks = sum8(rks);
        const float rn = rsqrtf(ssq + 1e-12f);
        *(uint4*)(row + C_K + ch0) = pack8(kp);
#pragma unroll
        for (int e = 0; e < 8; ++e) kk[e] *= rn;
        *(uint4*)(p.RWX + m * 1536 + 512 + ch0) = pack8(kk);
#pragma unroll
        for (int e = 0; e < 8; ++e) kk[e] *= aa[e];
        *(uint4*)(p.RWX + m * 1536 + 1024 + ch0) = pack8(kk);
        if ((Q & 7) == 0) (p.FB + FOFF_RKS)[m * 8 + head] = rks;
      }
      __syncthreads();
    }
    {
      u16* CB = (u16*)(smem + 1152);
      const u16* b2row = p.BND2 + (long)(blk > 0 ? blk - 1 : 0) * 1536;
      const float* scrow = p.state_conv + ((long)l * 8 + (s >= 8 ? s - 8 : 0)) * 3072 + 512;
#pragma unroll 1
      for (int j = 0; j < 4; ++j) {
        const int cc0 = j * 128 + Q * 8;
        const float* cw = p.conv_w + (long)l * 4096 + 512 + cc0;
        float acc[8];
        ld8(p.conv_b + l * 1024 + 512 + cc0, acc);
#pragma unroll
        for (int d = 0; d < 4; ++d) {
          const int tr = T - 3 + d;
          const int trn = tr < 0 ? 3 + tr : 0;
          float u[8], w[8];
          const u16* src = (tr >= 0) ? (row + (long)(d - 3) * LDP + C_XBC + 512 + cc0) : (b2row + trn * 512 + cc0);
          unpack8(*(const uint4*)src, u);
          if (first && tr < 0) {
            if (s >= 8) ld8(scrow + trn * 1024 + cc0, u);
            else {
#pragma unroll
              for (int e = 0; e < 8; ++e) u[e] = 0.f;
            }
          }
          ld8(cw + d * 1024, w);
#pragma unroll
          for (int e = 0; e < 8; ++e) acc[e] += w[e] * u[e];
        }
#pragma unroll
        for (int e = 0; e < 8; ++e) acc[e] = siluf_(acc[e]);
        *(uint4*)(CB + T * 512 + cc0) = pack8(acc);
      }
      __syncthreads();
#pragma unroll
      for (int j = 0; j < 4; ++j)
        *(uint4*)(row + C_XBC + 512 + j * 128 + Q * 8) = *(const uint4*)(CB + T * 512 + j * 128 + Q * 8);
    }
#undef SHIFT8
    if (t0 + 16 == seq_len(s)) {
      float* o = p.out + (s < 8 ? O_PSHIFT + ((long)l * 8 + s) * 1792 : O_SSHIFT + ((long)l * 8 + (s - 8)) * 1792);
      for (int j = tid; j < 1792; j += 256) o[j] = bf2f(p.BND[(long)blk * 1792 + j]);
    }
  }
}

__device__ __forceinline__ void scan_rwkv(const Params& p, int l, int s, int h, int q, float* smem) {
  const int tid = opaque_tid(), lane = tid & 63, wid = tid >> 6;
  float* R_ = smem;
  float* W_ = smem + 1024;
  float* K_ = smem + 2048;
  float* A_ = smem + 3072;
  float* B_ = smem + 4096;
  float* V_ = smem + 5120;
  float* O_ = smem + 5376;
  const int rl = wid * 4 + (lane >> 4);
  const int row = q * 16 + rl;
  const int ksl = (lane & 15) * 4;
  const int base = seq_base(s), T = seq_len(s);
  float s0 = 0.f, s1 = 0.f, s2 = 0.f, s3 = 0.f;
  if (s >= 8) {
    const float* st = p.state_rwkv + (((long)l * 8 + (s - 8)) * 8 + h) * 4096 + row * 64 + ksl;
    float4 v = *(const float4*)st;
    s0 = v.x; s1 = v.y; s2 = v.z; s3 = v.w;
  }
  const int stt = tid >> 4, skq = (tid & 15) * 4;
  const int nblk = T / 16;
  ushort4 r4, k4, u4, a4, b4;
  u16 vv;
  {
    const long m = base + stt;
    const u16* pr = p.PROJ + m * LDP;
    const u16* px = p.RWX + m * 1536;
    r4 = *(const ushort4*)(pr + C_R + h * 64 + skq);
    k4 = *(const ushort4*)(pr + C_K + h * 64 + skq);
    u4 = *(const ushort4*)(px + h * 64 + skq);
    a4 = *(const ushort4*)(px + 512 + h * 64 + skq);
    b4 = *(const ushort4*)(px + 1024 + h * 64 + skq);
    vv = pr[C_V + h * 64 + q * 16 + (tid & 15)];
  }
  __syncthreads();
  float* TR_ = smem + 5376 + 512;
  const bool wr = (lane & 15) == 0;
  const int ooff = wr ? rl : (512 + lane);
  const int ostr = wr ? 16 : 0;
  for (int blk = 0; blk < nblk; ++blk) {
    const long m = base + blk * 16 + stt;
    float* Oc = O_ + (blk & 1) * 256;
    {
      *(float4*)(R_ + stt * 64 + skq) = make_float4(bf2f(r4.x), bf2f(r4.y), bf2f(r4.z), bf2f(r4.w));
      *(float4*)(K_ + stt * 64 + skq) = make_float4(bf2f(k4.x), bf2f(k4.y), bf2f(k4.z), bf2f(k4.w));
      *(float4*)(W_ + stt * 64 + skq) =
          make_float4(__expf(bf2f(u4.x)), __expf(bf2f(u4.y)), __expf(bf2f(u4.z)), __expf(bf2f(u4.w)));
      *(float4*)(A_ + stt * 64 + skq) = make_float4(-bf2f(a4.x), -bf2f(a4.y), -bf2f(a4.z), -bf2f(a4.w));
      *(float4*)(B_ + stt * 64 + skq) = make_float4(bf2f(b4.x), bf2f(b4.y), bf2f(b4.z), bf2f(b4.w));
      V_[stt * 16 + (tid & 15)] = bf2f(vv);
    }
    __syncthreads();
    if (blk > 0)
      p.ORW[(m - 16) * 512 + h * 64 + q * 16 + (tid & 15)] = f2bf(O_[((blk - 1) & 1) * 256 + stt * 16 + (tid & 15)]);
    if (blk + 1 < nblk) {
      const u16* pr = p.PROJ + (m + 16) * LDP;
      const u16* px = p.RWX + (m + 16) * 1536;
      r4 = *(const ushort4*)(pr + C_R + h * 64 + skq);
      k4 = *(const ushort4*)(pr + C_K + h * 64 + skq);
      u4 = *(const ushort4*)(px + h * 64 + skq);
      a4 = *(const ushort4*)(px + 512 + h * 64 + skq);
      b4 = *(const ushort4*)(px + 1024 + h * 64 + skq);
      vv = pr[C_V + h * 64 + q * 16 + (tid & 15)];
    }
    __builtin_amdgcn_sched_barrier(0);
    {
      float4 a = *(const float4*)(A_ + ksl), w = *(const float4*)(W_ + ksl), b = *(const float4*)(B_ + ksl);
      float4 k = *(const float4*)(K_ + ksl), r = *(const float4*)(R_ + ksl);
      float v = V_[rl];
      float opart = 0.f;
#pragma unroll
      for (int tt = 0; tt < 16; ++tt) {
        float4 an, wn, bn, kn, rn;
        float vn;
        if (tt + 1 < 16) {
          an = *(const float4*)(A_ + (tt + 1) * 64 + ksl); wn = *(const float4*)(W_ + (tt + 1) * 64 + ksl);
          bn = *(const float4*)(B_ + (tt + 1) * 64 + ksl); kn = *(const float4*)(K_ + (tt + 1) * 64 + ksl);
          rn = *(const float4*)(R_ + (tt + 1) * 64 + ksl); vn = V_[(tt + 1) * 16 + rl];
        }
        __builtin_amdgcn_sched_barrier(0);
        float sa = fmaf(s0, a.x, fmaf(s1, a.y, fmaf(s2, a.z, s3 * a.w)));
        if (tt > 0) { sum16x2(sa, opart); Oc[ooff + (tt - 1) * ostr] = opart; }
        else sa = sum16(sa);
        s0 = fmaf(s0, w.x, fmaf(sa, b.x, v * k.x)); NOPK(s0);
        s1 = fmaf(s1, w.y, fmaf(sa, b.y, v * k.y)); NOPK(s1);
        s2 = fmaf(s2, w.z, fmaf(sa, b.z, v * k.z)); NOPK(s2);
        s3 = fmaf(s3, w.w, fmaf(sa, b.w, v * k.w)); NOPK(s3);
        opart = fmaf(s0, r.x, fmaf(s1, r.y, fmaf(s2, r.z, s3 * r.w)));
        if (tt == 15) { opart = sum16(opart); Oc[ooff + 15 * ostr] = opart; }
        __builtin_amdgcn_sched_barrier(0);
        if (tt + 1 < 16) { a = an; w = wn; b = bn; k = kn; r = rn; v = vn; }
      }
    }
    __builtin_amdgcn_sched_barrier(0);
    __syncthreads();
  }
  {
    const long m = base + (nblk - 1) * 16 + stt;
    p.ORW[m * 512 + h * 64 + q * 16 + (tid & 15)] = f2bf(O_[((nblk - 1) & 1) * 256 + stt * 16 + (tid & 15)]);
  }
  __syncthreads();
  {
    float* o = p.out + (s < 8 ? O_PRWKV + (((long)l * 8 + s) * 8 + h) * 4096
                              : O_SRWKV + (((long)l * 8 + (s - 8)) * 8 + h) * 4096);
    *(float4*)(o + row * 64 + ksl) = make_float4(s0, s1, s2, s3);
  }
}

__device__ __forceinline__ void scan_hgrn(const Params& p, int l, int s, int h, int q, float* smem) {
  const int tid = opaque_tid(), lane = tid & 63, wid = tid >> 6;
  float* Q_ = smem;
  float* F_ = smem + 2048;
  float* G_ = smem + 4096;
  float* I_ = smem + 6144;
  float* O_ = smem + 6400;
  const int rl = wid * 4 + (lane >> 4);
  const int row = q * 16 + rl;
  const int ksl4 = (lane & 15) * 4;
  const int base = seq_base(s), T = seq_len(s);
  float st[8];
#pragma unroll
  for (int i = 0; i < 8; ++i) st[i] = 0.f;
  if (s >= 8) {
    const float* sp = p.state_hgrn + (((long)l * 8 + (s - 8)) * 4 + h) * 16384;
#pragma unroll
    for (int i = 0; i < 8; ++i) st[i] = sp[((i >> 2) * 64 + ksl4 + (i & 3)) * 128 + row];
  }
  const int stt = tid >> 4, skq = (tid & 15) * 8;
  float lb[8];
#pragma unroll
  for (int i = 0; i < 8; ++i) {
    if (l == 0) lb[i] = 0.f;
    else {
      float x0 = p.hg_lb[h * 128 + skq + i], x1 = p.hg_lb[512 + h * 128 + skq + i];
      lb[i] = frcp_(1.f + __expf(x0 - x1));
    }
  }
  const int nblk = T / 16;
  uint4 q8, f8;
  u16 iv16;
  {
    const u16* pr = p.PROJ + (long)(base + stt) * LDP;
    q8 = *(const uint4*)(pr + C_Q + h * 128 + skq);
    f8 = *(const uint4*)(pr + C_F + h * 128 + skq);
    iv16 = pr[C_I + h * 128 + q * 16 + (tid & 15)];
  }
  __syncthreads();
  float* TR_ = smem + 6400 + 512;
  const bool wr = (lane & 15) == 0;
  const int ooff = wr ? rl : (512 + lane);
  const int ostr = wr ? 16 : 0;
  const bool wr4 = (lane & 15) < 4;
  const int ooff4 = wr4 ? (rl + (lane & 3) * 16) : (512 + lane);
  const int ostr4 = wr4 ? 16 : 0;
  for (int blk = 0; blk < nblk; ++blk) {
    const long m = base + blk * 16 + stt;
    float* Oc = O_ + (blk & 1) * 256;
    {
      unsigned qw[4] = {q8.x, q8.y, q8.z, q8.w}, fw[4] = {f8.x, f8.y, f8.z, f8.w};
      float qv[8], fv[8];
#pragma unroll
      for (int e = 0; e < 8; ++e) {
        qv[e] = bf2f((u16)((qw[e >> 1] >> ((e & 1) * 16)) & 0xffff));
        float fz = bf2f((u16)((fw[e >> 1] >> ((e & 1) * 16)) & 0xffff));
        float ex = __expf(-fz);
        float sg = frcp_(1.f + ex);
        fv[e] = lb[e] + (1.f - lb[e]) * sg;
      }
      *(float4*)(Q_ + stt * 128 + skq) = make_float4(qv[0], qv[1], qv[2], qv[3]);
      *(float4*)(Q_ + stt * 128 + skq + 4) = make_float4(qv[4], qv[5], qv[6], qv[7]);
      *(float4*)(F_ + stt * 128 + skq) = make_float4(fv[0], fv[1], fv[2], fv[3]);
      *(float4*)(F_ + stt * 128 + skq + 4) = make_float4(fv[4], fv[5], fv[6], fv[7]);
      I_[stt * 16 + (tid & 15)] = bf2f(iv16);
    }
    __syncthreads();
    if (blk > 0) {
      u16* dp = p.PROJ + (m - 16) * LDP + C_I + h * 128 + q * 16 + (tid & 15);
      *dp = f2bf(O_[((blk - 1) & 1) * 256 + stt * 16 + (tid & 15)]);
    }
    if (blk + 1 < nblk) {
      const u16* pr = p.PROJ + (m + 16) * LDP;
      q8 = *(const uint4*)(pr + C_Q + h * 128 + skq);
      f8 = *(const uint4*)(pr + C_F + h * 128 + skq);
      iv16 = pr[C_I + h * 128 + q * 16 + (tid & 15)];
    }
    __builtin_amdgcn_sched_barrier(0);
    {
      float4 f0 = *(const float4*)(F_ + ksl4), f1 = *(const float4*)(F_ + 64 + ksl4);
      float4 q0 = *(const float4*)(Q_ + ksl4), q1 = *(const float4*)(Q_ + 64 + ksl4);
      float iv = I_[rl];
      float op4[4] = {0.f, 0.f, 0.f, 0.f};
#pragma unroll
      for (int tt = 0; tt < 16; ++tt) {
        float4 f0n, f1n, q0n, q1n;
        float ivn;
        if (tt + 1 < 16) {
          const int o_ = (tt + 1) * 128;
          f0n = *(const float4*)(F_ + o_ + ksl4); f1n = *(const float4*)(F_ + o_ + 64 + ksl4);
          q0n = *(const float4*)(Q_ + o_ + ksl4); q1n = *(const float4*)(Q_ + o_ + 64 + ksl4);
          ivn = I_[(tt + 1) * 16 + rl];
        }
        __builtin_amdgcn_sched_barrier(0);
        st[0] = fmaf(st[0] - iv, f0.x, iv); NOPK(st[0]);
        st[1] = fmaf(st[1] - iv, f0.y, iv); NOPK(st[1]);
        st[2] = fmaf(st[2] - iv, f0.z, iv); NOPK(st[2]);
        st[3] = fmaf(st[3] - iv, f0.w, iv); NOPK(st[3]);
        st[4] = fmaf(st[4] - iv, f1.x, iv); NOPK(st[4]);
        st[5] = fmaf(st[5] - iv, f1.y, iv); NOPK(st[5]);
        st[6] = fmaf(st[6] - iv, f1.z, iv); NOPK(st[6]);
        st[7] = fmaf(st[7] - iv, f1.w, iv); NOPK(st[7]);
        float acc0 = fmaf(st[0], q0.x, fmaf(st[1], q0.y, fmaf(st[2], q0.z, st[3] * q0.w)));
        float acc1 = fmaf(st[4], q1.x, fmaf(st[5], q1.y, fmaf(st[6], q1.z, st[7] * q1.w)));
        op4[tt & 3] = acc0 + acc1;
        if ((tt & 3) == 3) {
          const float r4 = reduce4x16(op4[0], op4[1], op4[2], op4[3], lane);
          Oc[ooff4 + (tt - 3) * ostr4] = r4;
        }
        __builtin_amdgcn_sched_barrier(0);
        if (tt + 1 < 16) { f0 = f0n; f1 = f1n; q0 = q0n; q1 = q1n; iv = ivn; }
      }
    }
    __builtin_amdgcn_sched_barrier(0);
    __syncthreads();
  }
  {
    const long m = base + (nblk - 1) * 16 + stt;
    u16* dp = p.PROJ + m * LDP + C_I + h * 128 + q * 16 + (tid & 15);
    *dp = f2bf(O_[((nblk - 1) & 1) * 256 + stt * 16 + (tid & 15)]);
  }
  __syncthreads();
  {
    float* o = p.out + (s < 8 ? O_PHGRN + (((long)l * 8 + s) * 4 + h) * 16384
                              : O_SHGRN + (((long)l * 8 + (s - 8)) * 4 + h) * 16384);
#pragma unroll
    for (int i = 0; i < 8; ++i) o[((i >> 2) * 64 + ksl4 + (i & 3)) * 128 + row] = st[i];
  }
}

__device__ __forceinline__ void scan_ssd(const Params& p, int l, int s, int h, int q, float* smem) {
  const int tid = opaque_tid(), lane = tid & 63, wid = tid >> 6;
  float* B_ = smem;
  float* C_ = smem + 2048;
  float* X_ = smem + 4096;
  float* O_ = smem + 4352;
  float* DT_ = smem + 5200;
  float* DE_ = smem + 5216;
  const int rl = wid * 4 + (lane >> 4);
  const int row = q * 16 + rl;
  const int ksl4 = (lane & 15) * 4;
  const int g = h >> 2;
  const int base = seq_base(s), T = seq_len(s);
  float st[8];
#pragma unroll
  for (int i = 0; i < 8; ++i) st[i] = 0.f;
  if (s >= 8) {
    const float* sp = p.state_ssm + (((long)l * 8 + (s - 8)) * 8 + h) * 8192 + row * 128 + ksl4;
    float4 a = *(const float4*)sp, b = *(const float4*)(sp + 64);
    st[0] = a.x; st[1] = a.y; st[2] = a.z; st[3] = a.w; st[4] = b.x; st[5] = b.y; st[6] = b.z; st[7] = b.w;
  }
  const float* cw = p.conv_w + (long)l * 4 * 1024;
  const int skq8 = (tid & 15) * 8;
  const int xc_x = h * 64 + q * 16 + (tid & 15);
  const float cx0 = cw[xc_x], cx1 = cw[1024 + xc_x], cx2 = cw[2048 + xc_x], cx3 = cw[3072 + xc_x];
  const float cxb = p.conv_b[l * 1024 + xc_x];
  const float dtb = p.dt_bias[l * 8 + h];
  const float aexp = __expf(p.a_log[l * 8 + h]);
  const float dsk = p.d_skip[l * 8 + h];
  const int stt = tid >> 4;
  const int nblk = T / 16;
  uint4 rawb, rawc;
  float xr[4];
  float dtr = 0.f;
  u16 zc = 0, zn = 0;
#define SSD_LOAD(M0)                                                              \
  {                                                                               \
    {                                                                             \
      const u16* prow = p.PROJ + ((long)(M0) + stt) * LDP + C_XBC + g * 128 + skq8; \
      rawb = *(const uint4*)(prow + 512);                                         \
      rawc = *(const uint4*)(prow + 768);                                         \
    }                                                                             \
    {                                                                             \
      const long mr = (long)(M0) + stt;                                           \
      const u16* colx = p.PROJ + mr * LDP + C_XBC + xc_x;                         \
      _Pragma("unroll") for (int j = 0; j < 4; ++j) {                             \
        const long mm = mr - 3 + j;                                               \
        float vx;                                                                 \
        if (mm >= base) vx = bf2f(colx[(long)(j - 3) * LDP]);                     \
        else vx = (s >= 8) ? p.state_conv[((long)l * 8 + (s - 8)) * 3072 + (3 + (int)(mm - base)) * 1024 + xc_x] : 0.f; \
        xr[j] = vx;                                                               \
      }                                                                           \
    }                                                                             \
    if (tid < 16) dtr = (p.FB + FOFF_DTRAW)[((long)(M0) + tid) * 8 + h];                      \
    zn = p.PROJ[((long)(M0) + stt) * LDP + C_Z + h * 64 + q * 16 + (tid & 15)];   \
  }
  SSD_LOAD(base);
  __syncthreads();
  const bool wr = (lane & 15) == 0;
  const int ooff = wr ? rl : (512 + lane);
  const int ostr = wr ? 16 : 0;
  const bool wr4 = (lane & 15) < 4;
  const int ooff4 = wr4 ? (rl + (lane & 3) * 16) : (512 + lane);
  const int ostr4 = wr4 ? 16 : 0;
  u16 zp = 0;
  for (int blk = 0; blk < nblk; ++blk) {
    const long m0 = base + blk * 16;
    zp = zc;
    zc = zn;
    float* Oc = O_ + (blk & 1) * 256;
    {
      {
        const unsigned bw[4] = {rawb.x, rawb.y, rawb.z, rawb.w}, cwd[4] = {rawc.x, rawc.y, rawc.z, rawc.w};
        float bv[8], cv[8];
#pragma unroll
        for (int e = 0; e < 8; ++e) {
          bv[e] = bf2f((u16)((bw[e >> 1] >> ((e & 1) * 16)) & 0xffff));
          cv[e] = bf2f((u16)((cwd[e >> 1] >> ((e & 1) * 16)) & 0xffff));
        }
        *(float4*)(B_ + stt * 128 + skq8) = make_float4(bv[0], bv[1], bv[2], bv[3]);
        *(float4*)(B_ + stt * 128 + skq8 + 4) = make_float4(bv[4], bv[5], bv[6], bv[7]);
        *(float4*)(C_ + stt * 128 + skq8) = make_float4(cv[0], cv[1], cv[2], cv[3]);
        *(float4*)(C_ + stt * 128 + skq8 + 4) = make_float4(cv[4], cv[5], cv[6], cv[7]);
      }
      {
        float y = cx0 * xr[0] + cx1 * xr[1] + cx2 * xr[2] + cx3 * xr[3] + cxb;
        X_[stt * 16 + (tid & 15)] = siluf_(y);
      }
      if (tid < 16) {
        float dtv = softplusf_(dtr + dtb);
        DT_[tid] = dtv;
        DE_[tid] = __expf(-aexp * dtv);
      }
    }
    __syncthreads();
    if (blk > 0) {
      u16* pz = p.PROJ + (m0 - 16 + stt) * LDP + C_Z + h * 64 + q * 16 + (tid & 15);
      *pz = f2bf(O_[((blk - 1) & 1) * 256 + stt * 16 + (tid & 15)] * siluf_(bf2f(zp)));
    }
    if (blk + 1 < nblk) SSD_LOAD(m0 + 16);
    __builtin_amdgcn_sched_barrier(0);
    {
      float4 b0 = *(const float4*)(B_ + ksl4), b1 = *(const float4*)(B_ + 64 + ksl4);
      float4 c0 = *(const float4*)(C_ + ksl4), c1 = *(const float4*)(C_ + 64 + ksl4);
      float xv = X_[rl], dt = DT_[0], de = DE_[0];
      float yp4[4] = {0.f, 0.f, 0.f, 0.f};
      const float dsk16 = dsk * (1.f / 16.f);
#pragma unroll
      for (int tt = 0; tt < 16; ++tt) {
        float4 b0n, b1n, c0n, c1n;
        float xvn, dtn, den;
        if (tt + 1 < 16) {
          const int o_ = (tt + 1) * 128;
          b0n = *(const float4*)(B_ + o_ + ksl4); b1n = *(const float4*)(B_ + o_ + 64 + ksl4);
          c0n = *(const float4*)(C_ + o_ + ksl4); c1n = *(const float4*)(C_ + o_ + 64 + ksl4);
          xvn = X_[(tt + 1) * 16 + rl]; dtn = DT_[tt + 1]; den = DE_[tt + 1];
        }
        __builtin_amdgcn_sched_barrier(0);
        const float xd = xv * dt;
        st[0] = fmaf(st[0], de, xd * b0.x); NOPK(st[0]);
        st[1] = fmaf(st[1], de, xd * b0.y); NOPK(st[1]);
        st[2] = fmaf(st[2], de, xd * b0.z); NOPK(st[2]);
        st[3] = fmaf(st[3], de, xd * b0.w); NOPK(st[3]);
        st[4] = fmaf(st[4], de, xd * b1.x); NOPK(st[4]);
        st[5] = fmaf(st[5], de, xd * b1.y); NOPK(st[5]);
        st[6] = fmaf(st[6], de, xd * b1.z); NOPK(st[6]);
        st[7] = fmaf(st[7], de, xd * b1.w); NOPK(st[7]);
        float acc0 = fmaf(st[0], c0.x, fmaf(st[1], c0.y, fmaf(st[2], c0.z, st[3] * c0.w)));
        float acc1 = fmaf(st[4], c1.x, fmaf(st[5], c1.y, fmaf(st[6], c1.z, st[7] * c1.w)));
        yp4[tt & 3] = fmaf(dsk16, xv, acc0 + acc1);
        if ((tt & 3) == 3) {
          const float r4 = reduce4x16(yp4[0], yp4[1], yp4[2], yp4[3], lane);
          Oc[ooff4 + (tt - 3) * ostr4] = r4;
        }
        __builtin_amdgcn_sched_barrier(0);
        if (tt + 1 < 16) { b0 = b0n; b1 = b1n; c0 = c0n; c1 = c1n; xv = xvn; dt = dtn; de = den; }
      }
    }
    __builtin_amdgcn_sched_barrier(0);
    __syncthreads();
  }
  {
    const long m0 = base + (nblk - 1) * 16;
    u16* pz = p.PROJ + (m0 + stt) * LDP + C_Z + h * 64 + q * 16 + (tid & 15);
    *pz = f2bf(O_[((nblk - 1) & 1) * 256 + stt * 16 + (tid & 15)] * siluf_(bf2f(zc)));
  }
  __syncthreads();
#undef SSD_LOAD
  {
    float* o = p.out + (s < 8 ? O_PSSM + (((long)l * 8 + s) * 8 + h) * 8192
                              : O_SSSM + (((long)l * 8 + (s - 8)) * 8 + h) * 8192);
    *(float4*)(o + row * 128 + ksl4) = make_float4(st[0], st[1], st[2], st[3]);
    *(float4*)(o + row * 128 + 64 + ksl4) = make_float4(st[4], st[5], st[6], st[7]);
  }
  if (h == 0 && q == 0) {
    float* o = p.out + (s < 8 ? O_PCONV + ((long)l * 8 + s) * 3072 : O_SCONV + ((long)l * 8 + (s - 8)) * 3072);
    const long lastblk = (long)(base + T) / 16 - 1;
    for (int i = tid; i < 3072; i += 256) {
      int r = i >> 10, c = i & 1023;
      o[i] = (c < 512) ? bf2f(p.PROJ[(long)(base + T - 3 + r) * LDP + C_XBC + c])
                       : bf2f(p.BND2[(lastblk * 3 + r) * 512 + (c - 512)]);
    }
  }
}

__device__ __forceinline__ void phase_scan(const Params& p, int l, float* smem) {
  for (int u = BID, nb_ = NBLK; u < 1536; u += nb_) {
    int sample = u >= 768;
    int v = sample ? u - 768 : u;
    int type = v % 3, w = v / 3;
    if (type == 0) {
      int q = w & 3, h = (w >> 2) & 7, b = w >> 5;
      scan_rwkv(p, l, b + 8 * sample, h, q, smem);
    } else if (type == 1) {
      int q = w & 7, h = (w >> 3) & 3, b = w >> 5;
      scan_hgrn(p, l, b + 8 * sample, h, q, smem);
    } else {
      int q = w & 3, h = (w >> 2) & 7, b = w >> 5;
      scan_ssd(p, l, b + 8 * sample, h, q, smem);
    }
  }
}

__device__ __forceinline__ void phase_post(const Params& p, int l, float* smem) {
  constexpr int LDG = 516;
  float* GA = smem;
  for (int blk = BID, nb_ = NBLK; blk < NBLK16; blk += nb_) {
    const int tid = opaque_tid(), lane = tid & 63, wid = tid >> 6;
    const int T = tid >> 4, Q = tid & 15;
    const long m0 = (long)blk * 16;
    const long m = m0 + T;
    __syncthreads();
    {
      bf16x8 ag[4];
      const u16* arow = p.PROJ + (m0 + (lane & 15)) * LDP + C_XG + (lane >> 4) * 8;
#pragma unroll
      for (int ks = 0; ks < 4; ++ks) ag[ks] = *(const bf16x8*)(arow + ks * 32);
#pragma unroll
      for (int nt = 0; nt < 8; ++nt) {
        const int n = (wid * 8 + nt) * 16 + (lane & 15);
        f32x4v acc = {0.f, 0.f, 0.f, 0.f};
#pragma unroll
        for (int ks = 0; ks < 4; ++ks) {
          bf16x8 bg = *(const bf16x8*)((p.WB + OFF_G2T) + n * 128 + ks * 32 + (lane >> 4) * 8);
          acc = __builtin_amdgcn_mfma_f32_16x16x32_bf16(ag[ks], bg, acc, 0, 0, 0);
        }
#pragma unroll
        for (int r = 0; r < 4; ++r) GA[((lane >> 4) * 4 + r) * LDG + n] = acc[r];
      }
    }
    __syncthreads();
    u16* row = p.PROJ + m * LDP;
#pragma unroll 1
    for (int g = 0; g < 2; ++g) {
      float y0[8], y1[8], w[8];
      const int c0 = g * 256 + Q * 8, c1 = c0 + 128;
      unpack8(*(const uint4*)(row + C_Z + c0), y0);
      unpack8(*(const uint4*)(row + C_Z + c1), y1);
      float ss = 0.f;
#pragma unroll
      for (int e = 0; e < 8; ++e) ss += y0[e] * y0[e] + y1[e] * y1[e];
      ss = sum16(ss);
      const float rs = rsqrtf(ss * (1.f / 256.f) + 1e-6f);
      ld8(p.ssd_norm_w + l * 512 + c0, w);
#pragma unroll
      for (int e = 0; e < 8; ++e) y0[e] = y0[e] * rs * w[e];
      ld8(p.ssd_norm_w + l * 512 + c1, w);
#pragma unroll
      for (int e = 0; e < 8; ++e) y1[e] = y1[e] * rs * w[e];
      *(uint4*)(row + C_Z + c0) = pack8(y0);
      *(uint4*)(row + C_Z + c1) = pack8(y1);
    }
#pragma unroll 1
    for (int j = 0; j < 4; ++j) {
      const int c0 = j * 128 + Q * 8;
      {
        float oh[8], gg[8], w[8];
        unpack8(*(const uint4*)(row + C_I + c0), oh);
        unpack8(*(const uint4*)(row + C_GG + c0), gg);
        float ss = 0.f;
#pragma unroll
        for (int e = 0; e < 8; ++e) ss += oh[e] * oh[e];
        ss = sum16(ss);
        const float rs = rsqrtf(ss * (1.f / 128.f) + 1e-6f);
        ld8(p.hg_norm_w + l * 512 + c0, w);
#pragma unroll
        for (int e = 0; e < 8; ++e) oh[e] = oh[e] * rs * w[e] * siluf_(gg[e]);
        *(uint4*)(row + C_GG + c0) = pack8(oh);
      }
      {
        float o[8], v[8], w[8], bb[8], ga[8];
        const int head = j * 2 + (Q >> 3);
        unpack8(*(const uint4*)(p.ORW + m * 512 + c0), o);
        unpack8(*(const uint4*)(row + C_V + c0), v);
        float sm = 0.f;
#pragma unroll
        for (int e = 0; e < 8; ++e) sm += o[e];
        const float mean = sum8(sm) * (1.f / 64.f);
        float sv = 0.f;
#pragma unroll
        for (int e = 0; e < 8; ++e) { o[e] -= mean; sv += o[e] * o[e]; }
        const float rstd = rsqrtf(sum8(sv) * (1.f / 64.f) + 64e-5f);
        const float rks = (p.FB + FOFF_RKS)[m * 8 + head];
        ld8(p.rw_lnx_w + l * 512 + c0, w);
        ld8(p.rw_lnx_b + l * 512 + c0, bb);
        ld8(GA + T * LDG + c0, ga);
#pragma unroll
        for (int e = 0; e < 8; ++e) o[e] = (o[e] * rstd * w[e] + bb[e] + rks * v[e]) * ga[e];
        *(uint4*)(row + C_R + c0) = pack8(o);
      }
    }
  }
}

__device__ __forceinline__ void phase_final(const Params& p) {
  const int tid = opaque_tid(), lane = tid & 63, wid = tid >> 6;
  for (int m = BID * 4 + wid, nb_ = NBLK; m < M_TOT; m += nb_ * 4) {
    float* dst;
    if (m < M_PROMPT) {
      int b = m / T_P, t = m - b * T_P;
      if (t < 16) continue;
      dst = p.out + O_YP + ((long)b * 4096 + (t - 16)) * DM;
    } else {
      dst = p.out + O_YS + (long)(m - M_PROMPT) * DM;
    }
    float x[16];
    float ss = 0.f;
#pragma unroll
    for (int j = 0; j < 2; ++j) {
      uint4 raw = *(const uint4*)(p.XB + xb_off(m, lane * 8 + 512 * j));
      unsigned wv[4] = {raw.x, raw.y, raw.z, raw.w};
#pragma unroll
      for (int e = 0; e < 8; ++e) {
        x[j * 8 + e] = bf2f((u16)((wv[e >> 1] >> ((e & 1) * 16)) & 0xffff));
        ss += x[j * 8 + e] * x[j * 8 + e];
      }
    }
    ss = sum64(ss);
    float rs = rsqrtf(ss * (1.f / 1024.f) + 1e-6f);
#pragma unroll
    for (int j = 0; j < 2; ++j) {
      int k0 = lane * 8 + 512 * j;
      float4 w0 = *(const float4*)(p.final_w + k0), w1 = *(const float4*)(p.final_w + k0 + 4);
      *(float4*)(dst + k0) = make_float4(x[j * 8 + 0] * rs * w0.x, x[j * 8 + 1] * rs * w0.y, x[j * 8 + 2] * rs * w0.z,
                                         x[j * 8 + 3] * rs * w0.w);
      *(float4*)(dst + k0 + 4) = make_float4(x[j * 8 + 4] * rs * w1.x, x[j * 8 + 5] * rs * w1.y,
                                             x[j * 8 + 6] * rs * w1.z, x[j * 8 + 7] * rs * w1.w);
    }
  }
}


#define XB_TMO      128
#define XB_XCNT(j)  (256  + 64 * (j))
#define XB_XSUB(j)  (1280 + 64 * (j))
#define XB_XGEN(j)  (2304 + 64 * (j))
#define XB_TOP      3328
#define XB_TOPGEN   3392
#define XCD_BAR_WORDS 3456
#define XB_SPIN_CAP (1u << 22)
__device__ __forceinline__ unsigned xb_ld(unsigned* p) { return __hip_atomic_load(p, __ATOMIC_RELAXED, __HIP_MEMORY_SCOPE_AGENT); }
__device__ __forceinline__ unsigned xb_add(unsigned* p, unsigned v) { return __hip_atomic_fetch_add(p, v, __ATOMIC_RELAXED, __HIP_MEMORY_SCOPE_AGENT); }
__device__ __forceinline__ unsigned xb_xcc_id() { return (unsigned)__builtin_amdgcn_s_getreg((3 << 11) | 20) & 0xFu; }
#define XB_SPIN(cond, bar) do { unsigned _sp = 0; while (cond) { __builtin_amdgcn_s_sleep(1); \
    if ((++_sp & 255u) == 0u) { if (xb_ld(&(bar)[XB_TMO])) break; if (_sp > XB_SPIN_CAP) { atomicAdd(&(bar)[XB_TMO], 1u); break; } } } } while (0)

__device__ __forceinline__ void xcd_barrier_post(unsigned* bar) {
  if (threadIdx.x == 0) (void)xb_add(&bar[XB_XCNT(xb_xcc_id())], 1u);
}
__device__ __forceinline__ void xcd_barrier_complete(unsigned* bar, unsigned x, unsigned& nloc, unsigned& nx) {
  const unsigned G = gridDim.x;
  unsigned sum, cnt, mine, sp = 0u;
  for (;;) {
    sum = 0u; cnt = 0u; mine = 0u;
#pragma unroll
    for (unsigned j = 0; j < 16; ++j) { const unsigned c = xb_ld(&bar[XB_XCNT(j)]); sum += c; cnt += (c > 0u) ? 1u : 0u; mine = (j == x) ? c : mine; }
    if (sum == G) break;
    __builtin_amdgcn_s_sleep(1);
    if ((++sp & 255u) == 0u) { if (xb_ld(&bar[XB_TMO])) break; if (sp > XB_SPIN_CAP) { atomicAdd(&bar[XB_TMO], 1u); break; } }
  }
  nloc = mine > 0u ? mine : 1u; nx = cnt > 0u ? cnt : 1u;
}
__device__ __forceinline__ void xcd_barrier(unsigned* bar, volatile unsigned* st) {
  asm volatile("s_waitcnt vmcnt(0)" ::: "memory");
  __syncthreads();
  if (threadIdx.x == 0) {
    __builtin_amdgcn_s_waitcnt(0);
    const unsigned x = xb_xcc_id();
    unsigned nloc = st[0], nx = st[1];
    if (nloc == 0u) { xcd_barrier_complete(bar, x, nloc, nx); st[0] = nloc; st[1] = nx; }
    const unsigned old = xb_add(&bar[XB_XSUB(x)], 1u);
    const unsigned gen = old / nloc;
    if (old + 1u == (gen + 1u) * nloc) {
      __builtin_amdgcn_fence(__ATOMIC_RELEASE, "agent");
      asm volatile("s_waitcnt vmcnt(0)" ::: "memory");
      const unsigned og = xb_add(&bar[XB_TOP], 1u);
      const unsigned tg = og / nx;
      if (og + 1u == (tg + 1u) * nx) xb_add(&bar[XB_TOPGEN], 1u);
      else XB_SPIN(xb_ld(&bar[XB_TOPGEN]) == tg, bar);
      __builtin_amdgcn_fence(__ATOMIC_ACQUIRE, "agent");
      xb_add(&bar[XB_XGEN(x)], 1u);
      asm volatile("s_waitcnt vmcnt(0)" ::: "memory");
    } else {
      XB_SPIN(xb_ld(&bar[XB_XGEN(x)]) == gen, bar);
      __builtin_amdgcn_fence(__ATOMIC_ACQUIRE, "agent");
      asm volatile("s_waitcnt vmcnt(0)" ::: "memory");
    }
  }
  __syncthreads();
}

constexpr int SMEM_BYTES = 40960;
__device__ __forceinline__ void run_phase(const Params& p, int ph, char* smem) {
  if (ph == 0) { phase_embed(p); return; }
  if (ph == 19) { phase_final(p); return; }
  int l = (ph - 1) / 9, s = (ph - 1) % 9;
  float* fs = (float*)smem;
  switch (s) {
    case 0: phase_convert(p, l, fs); phase_rowstat<true>(p, l, fs); break;
    case 1: phase_gemm<1, true>(p, p.XB, DM, (p.WB + OFF_W1T), 1024, LDP / 128, smem); break;
    case 2: phase_pre(p, l, fs); break;
    case 3: phase_scan(p, l, fs); break;
    case 4: phase_post(p, l, fs); break;
    case 5: phase_gemm<2, false>(p, p.PROJ, LDP, (p.WB + OFF_WOT), 1536, 8, smem); break;
    case 6: phase_rowstat<false>(p, l, fs); break;
    case 7: phase_gemm<3, true>(p, p.XB, DM, (p.WB + OFF_WGU), 1024, 44, smem); break;
    case 8: phase_gemm<2, true>(p, p.PROJ, D_FF, (p.WB + OFF_WDT), D_FF, 8, smem); break;
  }
}
constexpr int N_PHASES = 20;

#if MEGA
__global__ void __launch_bounds__(256, 3) k_mega(Params p) {
  __shared__ __attribute__((aligned(16))) char smem[SMEM_BYTES];
  __shared__ uint4 xb_words;
  if (threadIdx.x == 0) { xb_words = make_uint4(0u, 0u, 0u, 0u); }
  __syncthreads();
  cg::grid_group grid = cg::this_grid();
  float* fs = (float*)smem;
  volatile unsigned* xst = (volatile unsigned*)&xb_words;
  xcd_barrier_post(p.bar);
  phase_embed(p);
  grid.sync();
#define GSYNC() do { unsigned* b_ = p.bar; asm volatile("" : "+s"(b_)); xcd_barrier(b_, xst); } while (0)
  {
    const int L0_ = 0;
    int l = opaque_s(L0_);
    phase_convert(p, l, fs);
    phase_rowstat<true>(p, l, fs);
    GSYNC();
    l = opaque_s(l);
    phase_gemm<1, true>(p, p.XB, DM, (p.WB + OFF_W1T), 1024, LDP / 128, smem);
    GSYNC();
    l = opaque_s(l);
    phase_pre(p, l, fs);
    GSYNC();
    l = opaque_s(l);
    phase_scan(p, l, fs);
    GSYNC();
    l = opaque_s(l);
    phase_post(p, l, fs);
    GSYNC();
    l = opaque_s(l);
    phase_gemm<2, false>(p, p.PROJ, LDP, (p.WB + OFF_WOT), 1536, 8, smem);
    GSYNC();
    l = opaque_s(l);
    phase_rowstat<false>(p, l, fs);
    GSYNC();
    l = opaque_s(l);
    phase_gemm<3, true>(p, p.XB, DM, (p.WB + OFF_WGU), 1024, 44, smem);
    GSYNC();
    l = opaque_s(l);
    phase_gemm<2, true>(p, p.PROJ, D_FF, (p.WB + OFF_WDT), D_FF, 8, smem);
    GSYNC();
  }
  {
    const int L0_ = 1;
    int l = opaque_s(L0_);
    phase_convert(p, l, fs);
    phase_rowstat<true>(p, l, fs);
    GSYNC();
    l = opaque_s(l);
    phase_gemm<1, true>(p, p.XB, DM, (p.WB + OFF_W1T), 1024, LDP / 128, smem);
    GSYNC();
    l = opaque_s(l);
    phase_pre(p, l, fs);
    GSYNC();
    l = opaque_s(l);
    phase_scan(p, l, fs);
    GSYNC();
    l = opaque_s(l);
    phase_post(p, l, fs);
    GSYNC();
    l = opaque_s(l);
    phase_gemm<2, false>(p, p.PROJ, LDP, (p.WB + OFF_WOT), 1536, 8, smem);
    GSYNC();
    l = opaque_s(l);
    phase_rowstat<false>(p, l, fs);
    GSYNC();
    l = opaque_s(l);
    phase_gemm<3, true>(p, p.XB, DM, (p.WB + OFF_WGU), 1024, 44, smem);
    GSYNC();
    l = opaque_s(l);
    phase_gemm<2, true>(p, p.PROJ, D_FF, (p.WB + OFF_WDT), D_FF, 8, smem);
    GSYNC();
  }
  phase_final(p);
}
#else
template <int PH>
__global__ void __launch_bounds__(256, 3) k_phase(Params p) {
  __shared__ __attribute__((aligned(16))) char smem[SMEM_BYTES];
  run_phase(p, PH, smem);
}
template <int PH>
static void launch_all(const Params& p, int grid, hipStream_t stream) {
  hipLaunchKernelGGL(k_phase<PH>, dim3(grid), dim3(256), 0, stream, p);
  if constexpr (PH + 1 < N_PHASES) launch_all<PH + 1>(p, grid, stream);
}
#endif

extern "C" void kernel_launch(void* const* d_in, const int* in_sizes, int n_in, void* d_out, int out_size, void* d_ws,
                              size_t ws_size, hipStream_t stream) {
  Params p{};
  const float** pf = (const float**)&p;
  for (int i = 0; i < 35; ++i) pf[i] = (const float*)d_in[i];
  p.out = (float*)d_out;
  char* ws = (char*)d_ws;
  size_t off = 0;
  auto take = [&](size_t bytes) { char* r = ws + off; off += (bytes + 255) & ~(size_t)255; return r; };
  p.XB = (u16*)take((size_t)M_TOT * DM * 2);
  p.PROJ = (u16*)take((size_t)M_TOT * LDP * 2);
  p.WB = (u16*)take((size_t)WB_TOTAL * 2);
  p.BND = (u16*)take((size_t)NBLK16 * 1792 * 2);
  p.BND2 = (u16*)take((size_t)NBLK16 * 3 * 512 * 2);
  p.ORW = (u16*)take((size_t)M_TOT * 512 * 2);
  p.FB = (float*)take((size_t)FB_TOTAL * 4);
  p.bar = (unsigned*)take((size_t)XCD_BAR_WORDS * 4);
  p.RWX = (u16*)d_out;
  if (off > ws_size) fprintf(stderr, "workspace too small: need %zu have %zu\n", off, ws_size);
#if MEGA
  static int grid_blocks = 0;
  if (!grid_blocks) {
    int dev = 0, cus = 0, per_cu = 0;
    hipGetDevice(&dev);
    hipDeviceGetAttribute(&cus, hipDeviceAttributeMultiprocessorCount, dev);
    hipOccupancyMaxActiveBlocksPerMultiprocessor(&per_cu, k_mega, 256, 0);
    if (per_cu > 3) per_cu = 3;
    grid_blocks = cus * per_cu;
  }
  hipMemsetAsync(p.bar, 0, (size_t)XCD_BAR_WORDS * 4, stream);
  void* args[] = {&p};
  hipError_t e = hipLaunchCooperativeKernel((void*)k_mega, dim3(grid_blocks), dim3(256), args, 0, stream);
  if (e != hipSuccess) fprintf(stderr, "cooperative launch failed: %s (grid %d)\n", hipGetErrorString(e), grid_blocks);
#else
  launch_all<0>(p, 768, stream);
#endif
}
```

```cpp
#include <hip/hip_runtime.h>
#include <hip/hip_bf16.h>
#include <hip/hip_cooperative_groups.h>
#include <cstdio>
namespace cg = cooperative_groups;

#ifndef MEGA
#define MEGA 1
#endif

typedef unsigned short u16;
using bf16x8 = __attribute__((ext_vector_type(8))) short;
using f32x16 = __attribute__((ext_vector_type(16))) float;
using f32x4v = __attribute__((ext_vector_type(4))) float;

constexpr int DM = 1024;
constexpr int M_TOT = 33408;
constexpr int M_PROMPT = 32896;
constexpr int T_P = 4112;
constexpr int LDP = 5376;
constexpr int N_IN = 5384;
constexpr int D_FF = 2816;
constexpr int NBLK16 = M_TOT / 16;
constexpr int C_Z = 0, C_R = 512, C_GG = 1024, C_XBC = 1536, C_K = 2560, C_V = 3072, C_XW = 3584, C_XA = 3648,
              C_XG = 3712, C_Q = 3840, C_F = 4352, C_I = 4864;
constexpr long O_YP = 0, O_YS = 33554432, O_PSSM = 34078720, O_PCONV = 35127296, O_PRWKV = 35176448,
               O_PSHIFT = 35700736, O_PHGRN = 35729408, O_SSSM = 36777984, O_SCONV = 37826560,
               O_SRWKV = 37875712, O_SSHIFT = 38400000, O_SHGRN = 38428672;

constexpr long OFF_W1T = 0, OFF_WOT = 5505024, OFF_WGU = 7077888, OFF_WDT = 12845056, OFF_W2T = 15728640, OFF_A2T = 15761408, OFF_G2T = 15794176, WB_TOTAL = 15859712;
constexpr long FOFF_RS = 0, FOFF_DTRAW = 33408, FOFF_RKS = 300672, FOFF_SS = 567936, FB_TOTAL = 601344;
struct Params {
  const float *x_prompt, *x_sample, *state_ssm, *state_conv, *state_rwkv, *state_shift, *state_hgrn, *meta,
      *norm1_w, *w_in, *conv_w, *conv_b, *dt_bias, *a_log, *d_skip, *ssd_norm_w, *rw_mu, *rw_w0, *rw_w2, *rw_a0,
      *rw_a2, *rw_g2, *rw_kk, *rw_ka, *rw_rk, *rw_lnx_w, *rw_lnx_b, *hg_lb, *hg_norm_w, *w_out, *norm2_w, *w_gate,
      *w_up, *w_down, *final_w;
  float* out;
  u16 *XB, *PROJ, *WB, *BND, *BND2, *ORW, *RWX;
  float *FB;
  unsigned* bar;
};

typedef __bf16 bf16x2_t __attribute__((ext_vector_type(2)));
typedef float f32x2_t __attribute__((ext_vector_type(2)));
__device__ __forceinline__ unsigned cvt2bf(float a, float b) {
  f32x2_t v = {a, b};
  bf16x2_t r = __builtin_convertvector(v, bf16x2_t);
  return __builtin_bit_cast(unsigned, r);
}
__device__ __forceinline__ u16 f2bf(float f) { return (u16)(cvt2bf(f, f) & 0xffffu); }
__device__ __forceinline__ float bf2f(u16 h) { return __uint_as_float(((unsigned)h) << 16); }
__device__ __forceinline__ float frcp_(float x) { return __builtin_amdgcn_rcpf(x); }
__device__ __forceinline__ float sigmoidf_(float x) { return frcp_(1.f + __expf(-x)); }
__device__ __forceinline__ float siluf_(float x) { return x * frcp_(1.f + __expf(-x)); }
__device__ __forceinline__ float softplusf_(float x) { return x > 20.f ? x : __logf(1.f + __expf(x)); }
__device__ __forceinline__ float tanhf_(float x) { return 1.f - 2.f * __builtin_amdgcn_rcpf(1.f + __expf(2.f * x)); }

template <int CTRL>
__device__ __forceinline__ float dppf(float v) {
  return __int_as_float(__builtin_amdgcn_update_dpp(0, __float_as_int(v), CTRL, 0xF, 0xF, true));
}
__device__ __forceinline__ float sum16(float v) {
  v += dppf<0xB1>(v);
  v += dppf<0x4E>(v);
  v += dppf<0x141>(v);
  v += dppf<0x140>(v);
  return v;
}
__device__ __forceinline__ void sum16x2(float& a, float& b) {
  a += dppf<0xB1>(a); b += dppf<0xB1>(b);
  a += dppf<0x4E>(a); b += dppf<0x4E>(b);
  a += dppf<0x141>(a); b += dppf<0x141>(b);
  a += dppf<0x140>(a); b += dppf<0x140>(b);
}

__device__ __forceinline__ float sum8(float v) {
  v += dppf<0xB1>(v);
  v += dppf<0x4E>(v);
  v += dppf<0x141>(v);
  return v;
}
__device__ __forceinline__ void unpack8(const uint4& r, float* f) {
  f[0] = __uint_as_float(r.x << 16); f[1] = __uint_as_float(r.x & 0xffff0000u);
  f[2] = __uint_as_float(r.y << 16); f[3] = __uint_as_float(r.y & 0xffff0000u);
  f[4] = __uint_as_float(r.z << 16); f[5] = __uint_as_float(r.z & 0xffff0000u);
  f[6] = __uint_as_float(r.w << 16); f[7] = __uint_as_float(r.w & 0xffff0000u);
}
__device__ __forceinline__ uint4 pack8(const float* f) {
  uint4 r;
  r.x = cvt2bf(f[0], f[1]);
  r.y = cvt2bf(f[2], f[3]);
  r.z = cvt2bf(f[4], f[5]);
  r.w = cvt2bf(f[6], f[7]);
  return r;
}
__device__ __forceinline__ void ld8(const float* p, float* f) {
  float4 a = *(const float4*)p, b = *(const float4*)(p + 4);
  f[0] = a.x; f[1] = a.y; f[2] = a.z; f[3] = a.w; f[4] = b.x; f[5] = b.y; f[6] = b.z; f[7] = b.w;
}

struct F8 { float v[8]; };
__device__ __forceinline__ F8 up8(const uint4& r) { F8 f; unpack8(r, f.v); return f; }
__device__ __forceinline__ F8 ldf8(const float* p) { F8 f; ld8(p, f.v); return f; }
__device__ __forceinline__ F8 zero8() { F8 f; for (int e = 0; e < 8; ++e) f.v[e] = 0.f; return f; }
__device__ __forceinline__ float reduce4x16(float a, float b, float c, float d, int lane) {
  const bool o1 = (lane & 1) != 0, o2 = (lane & 2) != 0;
  float k0 = o1 ? b : a, s0 = o1 ? a : b;
  float k1 = o1 ? d : c, s1 = o1 ? c : d;
  k0 += dppf<0xB1>(s0);
  k1 += dppf<0xB1>(s1);
  float kp = o2 ? k1 : k0, sd = o2 ? k0 : k1;
  kp += dppf<0x4E>(sd);
  kp += dppf<0x124>(kp);
  kp += dppf<0x128>(kp);
  return kp;
}
__device__ __forceinline__ float sum64(float v) {
  v = sum16(v);
  v += __shfl_xor(v, 16);
  v += __shfl_xor(v, 32);
  return v;
}

#define NOPK(x) asm("" : "+v"(x))
__device__ __forceinline__ int opaque_tid() {
  int t = threadIdx.x;
  asm volatile("" : "+v"(t));
  return t;
}
__device__ __forceinline__ int opaque_s(int v) {
  asm volatile("" : "+s"(v));
  return v;
}
#define BID opaque_s((int)blockIdx.x)
#define NBLK opaque_s((int)gridDim.x)
__device__ __forceinline__ int seq_base(int s) { return s < 8 ? s * T_P : M_PROMPT + (s - 8) * 64; }
__device__ __forceinline__ int seq_len(int s) { return s < 8 ? T_P : 64; }

__device__ __forceinline__ long xb_off(int m, int k);
__device__ __forceinline__ void phase_embed(const Params& p) {
  const long n4 = (long)M_TOT * 256;
  for (long idx = (long)BID * 256 + threadIdx.x, st_ = (long)NBLK * 256; idx < n4; idx += st_) {
    int m = (int)(idx >> 8), c4 = ((int)idx & 255) * 4;
    const float* src;
    if (m < M_PROMPT) {
      int b = m / T_P, t = m - b * T_P;
      src = (t < 16) ? p.meta + (long)t * DM : p.x_prompt + ((long)b * 4096 + (t - 16)) * DM;
    } else {
      src = p.x_sample + (long)(m - M_PROMPT) * DM;
    }
    float4 v = *(const float4*)(src + c4);
    ushort4 o;
    o.x = f2bf(v.x); o.y = f2bf(v.y); o.z = f2bf(v.z); o.w = f2bf(v.w);
    *(ushort4*)(p.XB + xb_off(m, c4)) = o;
  }
}

__device__ __forceinline__ long xb_off(int m, int k) { return ((long)(m >> 7) * 32 + (k >> 5)) * 4096 + (m & 127) * 32 + (k & 31); }
__device__ __forceinline__ long wtile_off(int n, int k, int K) {
  return ((long)(n >> 7) * (K >> 5) + (k >> 5)) * 4096 + (n & 127) * 32 + (k & 31);
}
template <bool HAS_SCALE>
__device__ __forceinline__ void conv_tile(const float* __restrict__ src, int ldsrc, int srccol0, const float* __restrict__ scale,
                          u16* __restrict__ dst, int K, int k0, int n0, float* tile  ) {
  const int tid = opaque_tid();
  __syncthreads();
  {
    int nn = tid & 63, kb = tid >> 6;
#pragma unroll
    for (int i = 0; i < 16; ++i) {
      int kk = kb + 4 * i;
      float v = src[(long)(k0 + kk) * ldsrc + srccol0 + nn];
      if (HAS_SCALE) v *= scale[k0 + kk];
      tile[kk * 65 + nn] = v;
    }
  }
  __syncthreads();
  {
    int nn = tid >> 2, kq = (tid & 3) * 16;
    u16* d = dst + wtile_off(n0 + nn, k0 + kq, K);
#pragma unroll
    for (int j = 0; j < 16; j += 2) {
      unsigned w = f2bf(tile[(kq + j) * 65 + nn]) | ((unsigned)f2bf(tile[(kq + j + 1) * 65 + nn]) << 16);
      *(unsigned*)(d + j) = w;
    }
  }
}

__device__ __forceinline__ int w1_srccol(int n0) {
  if (n0 < 512) return n0;
  if (n0 < 1024) return n0 - 512 + 1544;
  if (n0 < 1536) return n0 - 1024 + 4872;
  if (n0 < 2560) return n0 - 1536 + 512;
  if (n0 < 3840) return n0 - 2560 + 2056;
  return n0 - 3840 + 3336;
}

constexpr int CV_W1 = 16 * 84, CV_WO = 24 * 16, CV_WGU = 16 * 88, CV_WD = 44 * 16;
constexpr int CV_LORA = 32;
constexpr int CV_TOTAL = CV_W1 + CV_WO + CV_WGU + CV_WD + CV_LORA;

__device__ __forceinline__ void phase_convert(const Params& p, int l, float* smem) {
  for (int u = BID, nb_ = NBLK; u < CV_TOTAL; u += nb_) {
    if (u < CV_W1) {
      int kt = u % 16, nt = u / 16;
      conv_tile<true>(p.w_in + (long)l * DM * N_IN, N_IN, w1_srccol(nt * 64), p.norm1_w + l * DM, (p.WB + OFF_W1T), 1024, kt * 64,
                nt * 64, smem);
    } else if (u < CV_W1 + CV_WO) {
      int v = u - CV_W1;
      int kt = v % 24, nt = v / 24;
      conv_tile<false>(p.w_out + (long)l * 1536 * DM, DM, nt * 64, nullptr, (p.WB + OFF_WOT), 1536, kt * 64, nt * 64, smem);
    } else if (u < CV_W1 + CV_WO + CV_WGU) {
      int v = u - CV_W1 - CV_WO;
      int kt = v % 16, nt = v / 16;
      const float* wg = p.w_gate + (long)l * DM * D_FF;
      const float* wu = p.w_up + (long)l * DM * D_FF;
      const float* sc = p.norm2_w + l * DM;
      const int tid = opaque_tid();
      __syncthreads();
      {
        int nn = tid & 63, kb = tid >> 6;
        const float* src = (nn < 32) ? wg : wu;
        int col = nt * 32 + (nn & 31);
#pragma unroll
        for (int i = 0; i < 16; ++i) {
          int kk = kb + 4 * i;
          smem[kk * 65 + nn] = src[(long)(kt * 64 + kk) * D_FF + col] * sc[kt * 64 + kk];
        }
      }
      __syncthreads();
      {
        int nn = tid >> 2, kq = (tid & 3) * 16;
        u16* d = (p.WB + OFF_WGU) + wtile_off(nt * 64 + nn, kt * 64 + kq, 1024);
#pragma unroll
        for (int j = 0; j < 16; j += 2) {
          unsigned w = f2bf(smem[(kq + j) * 65 + nn]) | ((unsigned)f2bf(smem[(kq + j + 1) * 65 + nn]) << 16);
          *(unsigned*)(d + j) = w;
        }
      }
    } else if (u >= CV_W1 + CV_WO + CV_WGU + CV_WD) {
      int v = u - (CV_W1 + CV_WO + CV_WGU + CV_WD);
      const int tid = opaque_tid();
#pragma unroll 4
      for (int i = 0; i < 16; ++i) {
        int e = v * 4096 + i * 256 + tid;
        if (e < 32768) {
          int n = e >> 6, k = e & 63;
          (p.WB + OFF_W2T)[e] = f2bf(p.rw_w2[(long)l * 64 * 512 + k * 512 + n]);
        } else if (e < 65536) {
          int e2 = e - 32768, n = e2 >> 6, k = e2 & 63;
          (p.WB + OFF_A2T)[e2] = f2bf(p.rw_a2[(long)l * 64 * 512 + k * 512 + n]);
        } else {
          int e2 = e - 65536, n = e2 >> 7, k = e2 & 127;
          (p.WB + OFF_G2T)[e2] = f2bf(p.rw_g2[(long)l * 128 * 512 + k * 512 + n]);
        }
      }
    } else {
      int v = u - CV_W1 - CV_WO - CV_WGU;
      int kt = v % 44, nt = v / 44;
      conv_tile<false>(p.w_down + (long)l * D_FF * DM, DM, nt * 64, nullptr, (p.WB + OFF_WDT), D_FF, kt * 64, nt * 64, smem);
    }
  }
}

template <bool WITH_DT, bool EMB = false>
__device__ __forceinline__ void phase_rowstat(const Params& p, int l, float* smem) {
  const int tid = opaque_tid(), lane = tid & 63, wid = tid >> 6;
  float* dtw = smem;
  if (WITH_DT) {
    __syncthreads();
    const float* w = p.w_in + (long)l * DM * N_IN + 1536;
    const float* nw = p.norm1_w + l * DM;
    for (int i = tid; i < 8192; i += 256) {
      int k = i >> 3, h = i & 7;
      dtw[i] = w[(long)k * N_IN + h] * nw[k];
    }
    __syncthreads();
  }
  for (int blk = BID, nb_ = NBLK; blk < NBLK16; blk += nb_) {
    for (int rr = wid; rr < 16; rr += 4) {
      int m = blk * 16 + rr;
      float ss = 0.f;
      float d[8];
#pragma unroll
      for (int h = 0; h < 8; ++h) d[h] = 0.f;
      const float* srow = nullptr;
      if (EMB) {
        if (m < M_PROMPT) {
          int b = m / T_P, t = m - b * T_P;
          srow = (t < 16) ? p.meta + (long)t * DM : p.x_prompt + ((long)b * 4096 + (t - 16)) * DM;
        } else {
          srow = p.x_sample + (long)(m - M_PROMPT) * DM;
        }
      }
#pragma unroll 1
      for (int j = 0; j < 4; ++j) {
        int k0 = lane * 4 + 256 * j;
        uint2 raw;
        if (EMB) {
          const float4 v = *(const float4*)(srow + k0);
          raw.x = cvt2bf(v.x, v.y);
          raw.y = cvt2bf(v.z, v.w);
          *(uint2*)(p.XB + xb_off(m, k0)) = raw;
        } else {
          raw = *(const uint2*)(p.XB + xb_off(m, k0));
        }
        float xs[4] = {bf2f((u16)(raw.x & 0xffff)), bf2f((u16)(raw.x >> 16)), bf2f((u16)(raw.y & 0xffff)),
                       bf2f((u16)(raw.y >> 16))};
#pragma unroll
        for (int e = 0; e < 4; ++e) {
          float x = xs[e];
          ss += x * x;
          if (WITH_DT) {
            float4 w0 = *(const float4*)(dtw + (k0 + e) * 8);
            float4 w1 = *(const float4*)(dtw + (k0 + e) * 8 + 4);
            d[0] += x * w0.x; d[1] += x * w0.y; d[2] += x * w0.z; d[3] += x * w0.w;
            d[4] += x * w1.x; d[5] += x * w1.y; d[6] += x * w1.z; d[7] += x * w1.w;
          }
        }
      }
      ss = sum64(ss);
      float rs = rsqrtf(ss * (1.f / 1024.f) + 1e-6f);
      if (WITH_DT) {
#pragma unroll
        for (int h = 0; h < 8; ++h) d[h] = sum64(d[h]);
        if (lane == 0) {
#pragma unroll
          for (int h = 0; h < 8; ++h) (p.FB + FOFF_DTRAW)[(long)m * 8 + h] = d[h] * rs;
        }
      }
      if (lane == 0) (p.FB + FOFF_RS)[m] = rs;
    }
  }
}

constexpr int G_BK = 32, G_LDS_ROW = 80;
constexpr int G_OPER_BYTES = 128 * G_LDS_ROW;
template <int MODE, bool A_TILED, bool ACC_SS = false>
__device__ __forceinline__ void phase_gemm(const Params& p, const u16* __restrict__ A, int lda, const u16* __restrict__ Bt, int K,
                           int nN, char* smem) {
  const int tid = opaque_tid(), lane = tid & 63, wid = tid >> 6, wm = wid >> 1, wn = wid & 1;
  const int nM = M_TOT / 128;
  const int ntiles = nM * nN;
  const int nk = K / G_BK;
  const int lrow = tid >> 2, lkc = tid & 3;
  for (int tile = BID, nb_ = NBLK; tile < ntiles; tile += nb_) {
    constexpr int GM = 32;
    int grp = tile / (GM * nN);
    int first_m = grp * GM;
    int gsz = min(GM, nM - first_m);
    int rem = tile - grp * GM * nN;
    int pm = first_m + rem % gsz, pn = rem / gsz;
    const u16* gA = A_TILED ? A + (long)pm * (K >> 5) * 4096 + lrow * 32 + lkc * 8
                            : A + (long)(pm * 128 + lrow) * lda + lkc * 8;
    const u16* gB = Bt + (long)pn * (K >> 5) * 4096 + lrow * 32 + lkc * 8;
    f32x16 acc[2][2];
#pragma unroll
    for (int i = 0; i < 2; ++i)
#pragma unroll
      for (int j = 0; j < 2; ++j)
#pragma unroll
        for (int r = 0; r < 16; ++r) acc[i][j][r] = 0.f;
    uint4 xa0, xa1, xb0, xb1, ya0, ya1, yb0, yb1, za0, za1, zb0, zb1;
#define G_LOAD(S, KT)                                                  \
  {                                                                    \
    S##a0 = *(const uint4*)(A_TILED ? gA + (long)(KT) * 4096 : gA + (KT) * G_BK);                          \
    S##a1 = *(const uint4*)(A_TILED ? gA + (long)(KT) * 4096 + 2048 : gA + (long)64 * lda + (KT) * G_BK);  \
    S##b0 = *(const uint4*)(gB + (long)(KT) * 4096);                   \
    S##b1 = *(const uint4*)(gB + (long)(KT) * 4096 + 2048);            \
  }
#define G_STORE(S, BUF)                                                \
  {                                                                    \
    char* dA = smem + (BUF) * 2 * G_OPER_BYTES;                        \
    char* dB = dA + G_OPER_BYTES;                                      \
    *(uint4*)(dA + lrow * G_LDS_ROW + lkc * 16) = S##a0;               \
    *(uint4*)(dA + (lrow + 64) * G_LDS_ROW + lkc * 16) = S##a1;        \
    *(uint4*)(dB + lrow * G_LDS_ROW + lkc * 16) = S##b0;               \
    *(uint4*)(dB + (lrow + 64) * G_LDS_ROW + lkc * 16) = S##b1;        \
  }
#define G_READ(BUF, KS, AF, BF)                                                                  \
  {                                                                                              \
    const char* sA = smem + (BUF) * 2 * G_OPER_BYTES;                                            \
    const char* sB = sA + G_OPER_BYTES;                                                          \
    const int koff = ((KS) * 16 + (lane >> 5) * 8) * 2;                                          \
    _Pragma("unroll") for (int i = 0; i < 2; ++i)                                                \
      AF[i] = *(const bf16x8*)(sA + (wm * 64 + i * 32 + (lane & 31)) * G_LDS_ROW + koff);        \
    _Pragma("unroll") for (int j = 0; j < 2; ++j)                                                \
      BF[j] = *(const bf16x8*)(sB + (wn * 64 + j * 32 + (lane & 31)) * G_LDS_ROW + koff);        \
  }
#define G_MMA(AF, BF)                                                                            \
  {                                                                                              \
    __builtin_amdgcn_s_setprio(1);                                                               \
    _Pragma("unroll") for (int i = 0; i < 2; ++i)                                                \
      _Pragma("unroll") for (int j = 0; j < 2; ++j)                                              \
        acc[i][j] = __builtin_amdgcn_mfma_f32_32x32x16_bf16(AF[i], BF[j], acc[i][j], 0, 0, 0);   \
    __builtin_amdgcn_s_setprio(0);                                                               \
  }
    G_LOAD(x, 0);
    G_LOAD(y, 1);
    G_LOAD(z, 2);
    __builtin_amdgcn_sched_barrier(0);
    __syncthreads();
    G_STORE(x, 0);
    __syncthreads();
#define G_STEP(T, SNEXT, SFREE, BUF)                          \
    if ((T) < nk) {                                           \
      bf16x8 af0[2], bf0[2];                                  \
      G_READ(BUF, 0, af0, bf0);                               \
      __builtin_amdgcn_sched_barrier(0);                      \
      if ((T) + 1 < nk) G_STORE(SNEXT, (BUF) ^ 1);            \
      if ((T) + 3 < nk) G_LOAD(SFREE, (T) + 3);               \
      __builtin_amdgcn_sched_barrier(0);                      \
      G_MMA(af0, bf0);                                        \
      G_READ(BUF, 1, af0, bf0);                               \
      G_MMA(af0, bf0);                                        \
      __builtin_amdgcn_sched_barrier(0);                      \
      __syncthreads();                                        \
    }
    for (int kt = 0; kt < nk; kt += 6) {
      G_STEP(kt + 0, y, x, 0);
      G_STEP(kt + 1, z, y, 1);
      G_STEP(kt + 2, x, z, 0);
      G_STEP(kt + 3, y, x, 1);
      G_STEP(kt + 4, z, y, 0);
      G_STEP(kt + 5, x, z, 1);
    }
#undef G_STEP
#undef G_LOAD
#undef G_STORE
#undef G_READ
#undef G_MMA
    int te = tid;
    asm volatile("" : "+v"(te));
    const int lane_e = te & 63, wm_e = te >> 7, wn_e = (te >> 6) & 1;
    const int lr0 = wm_e * 64 + 4 * (lane_e >> 5);
    const int lc0 = wn_e * 64 + (lane_e & 31);
    if (MODE == 1) {
      u16* ST = (u16*)smem;
#pragma unroll
      for (int i = 0; i < 2; ++i)
#pragma unroll
        for (int r = 0; r < 16; ++r) {
          const int lr = lr0 + i * 32 + (r & 3) + 8 * (r >> 2);
          const float rs = (p.FB + FOFF_RS)[pm * 128 + lr];
#pragma unroll
          for (int j = 0; j < 2; ++j) ST[lr * 136 + lc0 + j * 32] = f2bf(acc[i][j][r] * rs);
        }
      __syncthreads();
      const int col0 = pn * 128;
      const int bnd_j = (col0 >= C_R && col0 < C_GG) ? (col0 - C_R) : ((col0 >= C_K && col0 < C_Q) ? (col0 - C_K + 512) : -1);
      const bool bc = (col0 >= C_XBC && col0 < C_XBC + 1024);
#pragma unroll
      for (int q = 0; q < 8; ++q) {
        const int c = te + 256 * q, crow = c >> 4, cc = (c & 15) * 8;
        const uint4 v = *(const uint4*)(ST + crow * 136 + cc);
        const int row = pm * 128 + crow;
        *(uint4*)(p.PROJ + (long)row * LDP + col0 + cc) = v;
        if (bnd_j >= 0 && (crow & 15) == 15) *(uint4*)(p.BND + (long)(row >> 4) * 1792 + bnd_j + cc) = v;
        if (bc && (crow & 15) >= 13)
          *(uint4*)(p.BND2 + ((long)(row >> 4) * 3 + ((crow & 15) - 13)) * 1024 + (col0 - C_XBC) + cc) = v;
      }
    } else if (MODE == 2) {
      float* SF = (float*)smem;
#pragma unroll
      for (int i = 0; i < 2; ++i) {
        if (i) __syncthreads();
#pragma unroll
        for (int r = 0; r < 16; ++r) {
          const int l2 = wm_e * 32 + (r & 3) + 8 * (r >> 2) + 4 * (lane_e >> 5);
#pragma unroll
          for (int j = 0; j < 2; ++j) SF[l2 * 132 + lc0 + j * 32] = acc[i][j][r];
        }
        __syncthreads();
#pragma unroll
        for (int q = 0; q < 4; ++q) {
          const int c = te + 256 * q, l2 = c >> 4, cc = (c & 15) * 8;
          const int row = pm * 128 + (l2 >> 5) * 64 + i * 32 + (l2 & 31);
          float d[8], x[8];
          ld8(SF + l2 * 132 + cc, d);
          u16* px = p.XB + xb_off(row, pn * 128 + cc);
          unpack8(*(const uint4*)px, x);
#pragma unroll
          for (int e = 0; e < 8; ++e) x[e] += d[e];
          const uint4 xp = pack8(x);
          *(uint4*)px = xp;
          if (ACC_SS) {
            float xr[8];
            unpack8(xp, xr);
            float ss = 0.f;
#pragma unroll
            for (int e = 0; e < 8; ++e) ss += xr[e] * xr[e];
            ss = sum16(ss);
            if ((te & 15) == 0) atomicAdd((p.FB + FOFF_SS) + row, ss);
          }
        }
      }
    } else {
      u16* ST = (u16*)smem;
      u16* ACT = p.PROJ;
#pragma unroll
      for (int i = 0; i < 2; ++i)
#pragma unroll
        for (int r = 0; r < 16; ++r) {
          const int lr = lr0 + i * 32 + (r & 3) + 8 * (r >> 2);
          const float rs = rsqrtf((p.FB + FOFF_SS)[pm * 128 + lr] * (1.f / 1024.f) + 1e-6f);
          const float g = acc[i][0][r] * rs, u = acc[i][1][r] * rs;
          ST[lr * 72 + wn_e * 32 + (lane_e & 31)] = f2bf(siluf_(g) * u);
        }
      __syncthreads();
#pragma unroll
      for (int q = 0; q < 4; ++q) {
        const int c = te + 256 * q, crow = c >> 3, cc = (c & 7) * 8;
        const uint4 v = *(const uint4*)(ST + crow * 72 + cc);
        *(uint4*)(ACT + wtile_off(pm * 128 + crow, pn * 64 + cc, D_FF)) = v;
      }
    }
  }
}

__device__ __forceinline__ void phase_pre(const Params& p, int l, float* smem) {
  u16* XWb = (u16*)smem;
  u16* XAb = (u16*)smem + 16 * 72;
  constexpr int LDW = 260;
  float* AW = smem + 1152;
  float* AA = smem + 1152 + 16 * LDW;
  const float* mu = p.rw_mu + l * 1792;
  for (int blk = BID, nb_ = NBLK; blk < NBLK16; blk += nb_) {
    const int tid = opaque_tid(), lane = tid & 63, wid = tid >> 6;
    const int T = tid >> 4, Q = tid & 15;
    const int m0 = blk * 16;
    const long m = m0 + T;
    int s, t0;
    if (m0 < M_PROMPT) { s = m0 / T_P; t0 = m0 - s * T_P; } else { s = 8 + (m0 - M_PROMPT) / 64; t0 = (m0 - M_PROMPT) & 63; }
    const bool first = (t0 == 0);
    u16* row = p.PROJ + m * LDP;
    const u16* bndrow = p.BND + (long)(blk > 0 ? blk - 1 : 0) * 1792;
    const float* shrow = p.state_shift + ((long)l * 8 + (s >= 8 ? s - 8 : 0)) * 1792;
    const bool seqstart = first && (T == 0);
#define SHIFT8(DST, J, COL)                                                                 \
    {                                                                                       \
      float cur_[8], pv_[8], mj_[8];                                                        \
      unpack8(*(const uint4*)(row + (COL)), cur_);                                          \
      const u16* ps_ = (T > 0) ? (row - LDP + (COL)) : (bndrow + (J));                      \
      unpack8(*(const uint4*)ps_, pv_);                                                     \
      if (seqstart) {                                                                       \
        if (s >= 8) ld8(shrow + (J), pv_);                                                  \
        else { _Pragma("unroll") for (int e = 0; e < 8; ++e) pv_[e] = 0.f; }                \
      }                                                                                     \
      ld8(mu + (J), mj_);                                                                   \
      _Pragma("unroll") for (int e = 0; e < 8; ++e) DST[e] = cur_[e] + (pv_[e] - cur_[e]) * mj_[e]; \
    }
    __syncthreads();
    {
      float sh0[8], sh1[8];
      SHIFT8(sh0, 1536 + Q * 8, C_XW + Q * 8);
      SHIFT8(sh1, 1664 + Q * 8, C_XG + Q * 8);
      __syncthreads();
      if (Q < 8) {
#pragma unroll
        for (int e = 0; e < 8; ++e) sh0[e] = tanhf_(sh0[e]);
        *(uint4*)(XWb + T * 72 + Q * 8) = pack8(sh0);
      } else {
        *(uint4*)(XAb + T * 72 + (Q - 8) * 8) = pack8(sh0);
      }
#pragma unroll
      for (int e = 0; e < 8; ++e) sh1[e] = sigmoidf_(sh1[e]);
      *(uint4*)(row + C_XG + Q * 8) = pack8(sh1);
    }
    __syncthreads();
#pragma unroll 1
    for (int c = 0; c < 2; ++c) {
      {
        bf16x8 axw[2], axa[2];
#pragma unroll
        for (int ks = 0; ks < 2; ++ks) {
          axw[ks] = *(const bf16x8*)(XWb + (lane & 15) * 72 + ks * 32 + (lane >> 4) * 8);
          axa[ks] = *(const bf16x8*)(XAb + (lane & 15) * 72 + ks * 32 + (lane >> 4) * 8);
        }
#pragma unroll
        for (int nt = 0; nt < 4; ++nt) {
          const int ncol = (wid * 4 + nt) * 16 + (lane & 15);
          const int n = c * 256 + ncol;
          f32x4v accw = {0.f, 0.f, 0.f, 0.f}, acca = {0.f, 0.f, 0.f, 0.f};
#pragma unroll
          for (int ks = 0; ks < 2; ++ks) {
            bf16x8 bw = *(const bf16x8*)((p.WB + OFF_W2T) + n * 64 + ks * 32 + (lane >> 4) * 8);
            bf16x8 ba = *(const bf16x8*)((p.WB + OFF_A2T) + n * 64 + ks * 32 + (lane >> 4) * 8);
            accw = __builtin_amdgcn_mfma_f32_16x16x32_bf16(axw[ks], bw, accw, 0, 0, 0);
            acca = __builtin_amdgcn_mfma_f32_16x16x32_bf16(axa[ks], ba, acca, 0, 0, 0);
          }
#pragma unroll
          for (int r = 0; r < 4; ++r) {
            AW[((lane >> 4) * 4 + r) * LDW + ncol] = accw[r];
            AA[((lane >> 4) * 4 + r) * LDW + ncol] = acca[r];
          }
        }
      }
#pragma unroll 1
      for (int jj = 0; jj < 2; ++jj) {
        const int ch0 = c * 256 + jj * 128 + Q * 8;
        const int head = c * 4 + jj * 2 + (Q >> 3);
        float rt[8], kt[8];
        uint4 vpk;
        SHIFT8(rt, ch0, C_R + ch0);
        SHIFT8(kt, 512 + ch0, C_K + ch0);
        {
          float vt[8];
          SHIFT8(vt, 1024 + ch0, C_V + ch0);
          vpk = pack8(vt);
        }
        __syncthreads();
        float aw[8], aa[8], w0[8], a0[8];
        ld8(AW + T * LDW + jj * 128 + Q * 8, aw);
        ld8(AA + T * LDW + jj * 128 + Q * 8, aa);
        ld8(p.rw_w0 + l * 512 + ch0, w0);
        ld8(p.rw_a0 + l * 512 + ch0, a0);
        {
          float uu[8];
#pragma unroll
          for (int e = 0; e < 8; ++e) {
            float lw = -softplusf_(-(w0[e] + aw[e])) - 0.5f;
            uu[e] = -__expf(lw);
            aa[e] = sigmoidf_(a0[e] + aa[e]);
          }
          *(uint4*)(p.RWX + m * 1536 + ch0) = pack8(uu);
        }
        *(uint4*)(row + C_R + ch0) = pack8(rt);
        *(uint4*)(row + C_V + ch0) = vpk;
        float kkw[8], kaw[8], rkw[8], kk[8], kp[8];
        ld8(p.rw_kk + l * 512 + ch0, kkw);
        ld8(p.rw_ka + l * 512 + ch0, kaw);
        ld8(p.rw_rk + l * 512 + ch0, rkw);
        float ssq = 0.f, rks = 0.f;
#pragma unroll
        for (int e = 0; e < 8; ++e) {
          kk[e] = kt[e] * kkw[e];
          ssq += kk[e] * kk[e];
          kp[e] = kt[e] * (1.f + (aa[e] - 1.f) * kaw[e]);
          rks += rt[e] * kp[e] * rkw[e];
        }
        ssq = sum8(ssq);
        rks = sum8(rks);
        const float rn = rsqrtf(ssq + 1e-12f);
        *(uint4*)(row + C_K + ch0) = pack8(kp);
#pragma unroll
        for (int e = 0; e < 8; ++e) kk[e] *= rn;
        *(uint4*)(p.RWX + m * 1536 + 512 + ch0) = pack8(kk);
#pragma unroll
        for (int e = 0; e < 8; ++e) kk[e] *= aa[e];
        *(uint4*)(p.RWX + m * 1536 + 1024 + ch0) = pack8(kk);
        if ((Q & 7) == 0) (p.FB + FOFF_RKS)[m * 8 + head] = rks;
      }
      __syncthreads();
    }
    {
      u16* CB = (u16*)(smem + 1152);
      const u16* b2row = p.BND2 + (long)(blk > 0 ? blk - 1 : 0) * 3072;
      const float* scrow = p.state_conv + ((long)l * 8 + (s >= 8 ? s - 8 : 0)) * 3072;
#pragma unroll 1
      for (int j = 0; j < 8; ++j) {
        const int cc0 = j * 128 + Q * 8;
        const float* cw = p.conv_w + (long)l * 4096 + cc0;
        float acc[8];
        ld8(p.conv_b + l * 1024 + cc0, acc);
#pragma unroll
        for (int d = 0; d < 4; ++d) {
          const int tr = T - 3 + d;
          const int trn = tr < 0 ? 3 + tr : 0;
          float u[8], w[8];
          const u16* src = (tr >= 0) ? (row + (long)(d - 3) * LDP + C_XBC + cc0) : (b2row + trn * 1024 + cc0);
          unpack8(*(const uint4*)src, u);
          if (first && tr < 0) {
            if (s >= 8) ld8(scrow + trn * 1024 + cc0, u);
            else {
#pragma unroll
              for (int e = 0; e < 8; ++e) u[e] = 0.f;
            }
          }
          ld8(cw + d * 1024, w);
#pragma unroll
          for (int e = 0; e < 8; ++e) acc[e] += w[e] * u[e];
        }
#pragma unroll
        for (int e = 0; e < 8; ++e) acc[e] = siluf_(acc[e]);
        *(uint4*)(CB + T * 1024 + cc0) = pack8(acc);
      }
      __syncthreads();
#pragma unroll
      for (int j = 0; j < 8; ++j)
        *(uint4*)(row + C_XBC + j * 128 + Q * 8) = *(const uint4*)(CB + T * 1024 + j * 128 + Q * 8);
    }
#undef SHIFT8
    if (t0 + 16 == seq_len(s)) {
      float* o = p.out + (s < 8 ? O_PSHIFT + ((long)l * 8 + s) * 1792 : O_SSHIFT + ((long)l * 8 + (s - 8)) * 1792);
      for (int j = tid; j < 1792; j += 256) o[j] = bf2f(p.BND[(long)blk * 1792 + j]);
      float* oc = p.out + (s < 8 ? O_PCONV + ((long)l * 8 + s) * 3072 : O_SCONV + ((long)l * 8 + (s - 8)) * 3072);
      for (int i = tid; i < 3072; i += 256) oc[i] = bf2f(p.BND2[(long)blk * 3072 + i]);
    }
  }
}

__device__ __forceinline__ void scan_rwkv(const Params& p, int l, int s, int h, int q, float* smem) {
  const int tid = opaque_tid(), lane = tid & 63, wid = tid >> 6;
  float* R_ = smem;
  float* W_ = smem + 1024;
  float* K_ = smem + 2048;
  float* A_ = smem + 3072;
  float* B_ = smem + 4096;
  float* V_ = smem + 5120;
  float* O_ = smem + 5376;
  const int rl = wid * 4 + (lane >> 4);
  const int row = q * 16 + rl;
  const int ksl = (lane & 15) * 4;
  const int base = seq_base(s), T = seq_len(s);
  float s0 = 0.f, s1 = 0.f, s2 = 0.f, s3 = 0.f;
  if (s >= 8) {
    const float* st = p.state_rwkv + (((long)l * 8 + (s - 8)) * 8 + h) * 4096 + row * 64 + ksl;
    float4 v = *(const float4*)st;
    s0 = v.x; s1 = v.y; s2 = v.z; s3 = v.w;
  }
  const int stt = tid >> 4, skq = (tid & 15) * 4;
  const int nblk = T / 16;
  ushort4 r4, k4, u4, a4, b4;
  u16 vv;
  {
    const long m = base + stt;
    const u16* pr = p.PROJ + m * LDP;
    const u16* px = p.RWX + m * 1536;
    r4 = *(const ushort4*)(pr + C_R + h * 64 + skq);
    k4 = *(const ushort4*)(pr + C_K + h * 64 + skq);
    u4 = *(const ushort4*)(px + h * 64 + skq);
    a4 = *(const ushort4*)(px + 512 + h * 64 + skq);
    b4 = *(const ushort4*)(px + 1024 + h * 64 + skq);
    vv = pr[C_V + h * 64 + q * 16 + (tid & 15)];
  }
  __syncthreads();
  float* TR_ = smem + 5376 + 512;
  const bool wr = (lane & 15) == 0;
  const int ooff = wr ? rl : (512 + lane);
  const int ostr = wr ? 16 : 0;
  for (int blk = 0; blk < nblk; ++blk) {
    const long m = base + blk * 16 + stt;
    float* Oc = O_ + (blk & 1) * 256;
    {
      *(float4*)(R_ + stt * 64 + skq) = make_float4(bf2f(r4.x), bf2f(r4.y), bf2f(r4.z), bf2f(r4.w));
      *(float4*)(K_ + stt * 64 + skq) = make_float4(bf2f(k4.x), bf2f(k4.y), bf2f(k4.z), bf2f(k4.w));
      *(float4*)(W_ + stt * 64 + skq) =
          make_float4(__expf(bf2f(u4.x)), __expf(bf2f(u4.y)), __expf(bf2f(u4.z)), __expf(bf2f(u4.w)));
      *(float4*)(A_ + stt * 64 + skq) = make_float4(-bf2f(a4.x), -bf2f(a4.y), -bf2f(a4.z), -bf2f(a4.w));
      *(float4*)(B_ + stt * 64 + skq) = make_float4(bf2f(b4.x), bf2f(b4.y), bf2f(b4.z), bf2f(b4.w));
      V_[stt * 16 + (tid & 15)] = bf2f(vv);
    }
    __syncthreads();
    if (blk > 0)
      p.ORW[(m - 16) * 512 + h * 64 + q * 16 + (tid & 15)] = f2bf(O_[((blk - 1) & 1) * 256 + stt * 16 + (tid & 15)]);
    if (blk + 1 < nblk) {
      const u16* pr = p.PROJ + (m + 16) * LDP;
      const u16* px = p.RWX + (m + 16) * 1536;
      r4 = *(const ushort4*)(pr + C_R + h * 64 + skq);
      k4 = *(const ushort4*)(pr + C_K + h * 64 + skq);
      u4 = *(const ushort4*)(px + h * 64 + skq);
      a4 = *(const ushort4*)(px + 512 + h * 64 + skq);
      b4 = *(const ushort4*)(px + 1024 + h * 64 + skq);
      vv = pr[C_V + h * 64 + q * 16 + (tid & 15)];
    }
    __builtin_amdgcn_sched_barrier(0);
    {
      float4 a = *(const float4*)(A_ + ksl), w = *(const float4*)(W_ + ksl), b = *(const float4*)(B_ + ksl);
      float4 k = *(const float4*)(K_ + ksl), r = *(const float4*)(R_ + ksl);
      float v = V_[rl];
      float opart = 0.f;
#pragma unroll
      for (int tt = 0; tt < 16; ++tt) {
        float4 an, wn, bn, kn, rn;
        float vn;
        if (tt + 1 < 16) {
          an = *(const float4*)(A_ + (tt + 1) * 64 + ksl); wn = *(const float4*)(W_ + (tt + 1) * 64 + ksl);
          bn = *(const float4*)(B_ + (tt + 1) * 64 + ksl); kn = *(const float4*)(K_ + (tt + 1) * 64 + ksl);
          rn = *(const float4*)(R_ + (tt + 1) * 64 + ksl); vn = V_[(tt + 1) * 16 + rl];
        }
        __builtin_amdgcn_sched_barrier(0);
        float sa = fmaf(s0, a.x, fmaf(s1, a.y, fmaf(s2, a.z, s3 * a.w)));
        if (tt > 0) { sum16x2(sa, opart); Oc[ooff + (tt - 1) * ostr] = opart; }
        else sa = sum16(sa);
        s0 = fmaf(s0, w.x, fmaf(sa, b.x, v * k.x)); NOPK(s0);
        s1 = fmaf(s1, w.y, fmaf(sa, b.y, v * k.y)); NOPK(s1);
        s2 = fmaf(s2, w.z, fmaf(sa, b.z, v * k.z)); NOPK(s2);
        s3 = fmaf(s3, w.w, fmaf(sa, b.w, v * k.w)); NOPK(s3);
        opart = fmaf(s0, r.x, fmaf(s1, r.y, fmaf(s2, r.z, s3 * r.w)));
        if (tt == 15) { opart = sum16(opart); Oc[ooff + 15 * ostr] = opart; }
        __builtin_amdgcn_sched_barrier(0);
        if (tt + 1 < 16) { a = an; w = wn; b = bn; k = kn; r = rn; v = vn; }
      }
    }
    __builtin_amdgcn_sched_barrier(0);
    __syncthreads();
  }
  {
    const long m = base + (nblk - 1) * 16 + stt;
    p.ORW[m * 512 + h * 64 + q * 16 + (tid & 15)] = f2bf(O_[((nblk - 1) & 1) * 256 + stt * 16 + (tid & 15)]);
  }
  __syncthreads();
  {
    float* o = p.out + (s < 8 ? O_PRWKV + (((long)l * 8 + s) * 8 + h) * 4096
                              : O_SRWKV + (((long)l * 8 + (s - 8)) * 8 + h) * 4096);
    *(float4*)(o + row * 64 + ksl) = make_float4(s0, s1, s2, s3);
  }
}

__device__ __forceinline__ void scan_hgrn(const Params& p, int l, int s, int h, int q, float* smem) {
  const int tid = opaque_tid(), lane = tid & 63, wid = tid >> 6;
  float* Q_ = smem;
  float* F_ = smem + 2048;
  float* G_ = smem + 4096;
  float* I_ = smem + 6144;
  float* O_ = smem + 6400;
  const int rl = wid * 4 + (lane >> 4);
  const int row = q * 16 + rl;
  const int ksl4 = (lane & 15) * 4;
  const int base = seq_base(s), T = seq_len(s);
  float st[8];
#pragma unroll
  for (int i = 0; i < 8; ++i) st[i] = 0.f;
  if (s >= 8) {
    const float* sp = p.state_hgrn + (((long)l * 8 + (s - 8)) * 4 + h) * 16384;
#pragma unroll
    for (int i = 0; i < 8; ++i) st[i] = sp[((i >> 2) * 64 + ksl4 + (i & 3)) * 128 + row];
  }
  const int stt = tid >> 4, skq = (tid & 15) * 8;
  float lb[8];
#pragma unroll
  for (int i = 0; i < 8; ++i) {
    if (l == 0) lb[i] = 0.f;
    else {
      float x0 = p.hg_lb[h * 128 + skq + i], x1 = p.hg_lb[512 + h * 128 + skq + i];
      lb[i] = frcp_(1.f + __expf(x0 - x1));
    }
  }
  const int nblk = T / 16;
  uint4 q8, f8;
  u16 iv16;
  {
    const u16* pr = p.PROJ + (long)(base + stt) * LDP;
    q8 = *(const uint4*)(pr + C_Q + h * 128 + skq);
    f8 = *(const uint4*)(pr + C_F + h * 128 + skq);
    iv16 = pr[C_I + h * 128 + q * 16 + (tid & 15)];
  }
  __syncthreads();
  float* TR_ = smem + 6400 + 512;
  const bool wr = (lane & 15) == 0;
  const int ooff = wr ? rl : (512 + lane);
  const int ostr = wr ? 16 : 0;
  const bool wr4 = (lane & 15) < 4;
  const int ooff4 = wr4 ? (rl + (lane & 3) * 16) : (512 + lane);
  const int ostr4 = wr4 ? 16 : 0;
  for (int blk = 0; blk < nblk; ++blk) {
    const long m = base + blk * 16 + stt;
    float* Oc = O_ + (blk & 1) * 256;
    {
      unsigned qw[4] = {q8.x, q8.y, q8.z, q8.w}, fw[4] = {f8.x, f8.y, f8.z, f8.w};
      float qv[8], fv[8];
#pragma unroll
      for (int e = 0; e < 8; ++e) {
        qv[e] = bf2f((u16)((qw[e >> 1] >> ((e & 1) * 16)) & 0xffff));
        float fz = bf2f((u16)((fw[e >> 1] >> ((e & 1) * 16)) & 0xffff));
        float ex = __expf(-fz);
        float sg = frcp_(1.f + ex);
        fv[e] = lb[e] + (1.f - lb[e]) * sg;
      }
      *(float4*)(Q_ + stt * 128 + skq) = make_float4(qv[0], qv[1], qv[2], qv[3]);
      *(float4*)(Q_ + stt * 128 + skq + 4) = make_float4(qv[4], qv[5], qv[6], qv[7]);
      *(float4*)(F_ + stt * 128 + skq) = make_float4(fv[0], fv[1], fv[2], fv[3]);
      *(float4*)(F_ + stt * 128 + skq + 4) = make_float4(fv[4], fv[5], fv[6], fv[7]);
      I_[stt * 16 + (tid & 15)] = bf2f(iv16);
    }
    __syncthreads();
    if (blk > 0) {
      u16* dp = p.PROJ + (m - 16) * LDP + C_I + h * 128 + q * 16 + (tid & 15);
      *dp = f2bf(O_[((blk - 1) & 1) * 256 + stt * 16 + (tid & 15)]);
    }
    if (blk + 1 < nblk) {
      const u16* pr = p.PROJ + (m + 16) * LDP;
      q8 = *(const uint4*)(pr + C_Q + h * 128 + skq);
      f8 = *(const uint4*)(pr + C_F + h * 128 + skq);
      iv16 = pr[C_I + h * 128 + q * 16 + (tid & 15)];
    }
    __builtin_amdgcn_sched_barrier(0);
    {
      float4 f0 = *(const float4*)(F_ + ksl4), f1 = *(const float4*)(F_ + 64 + ksl4);
      float4 q0 = *(const float4*)(Q_ + ksl4), q1 = *(const float4*)(Q_ + 64 + ksl4);
      float iv = I_[rl];
      float op4[4] = {0.f, 0.f, 0.f, 0.f};
#pragma unroll
      for (int tt = 0; tt < 16; ++tt) {
        float4 f0n, f1n, q0n, q1n;
        float ivn;
        if (tt + 1 < 16) {
          const int o_ = (tt + 1) * 128;
          f0n = *(const float4*)(F_ + o_ + ksl4); f1n = *(const float4*)(F_ + o_ + 64 + ksl4);
          q0n = *(const float4*)(Q_ + o_ + ksl4); q1n = *(const float4*)(Q_ + o_ + 64 + ksl4);
          ivn = I_[(tt + 1) * 16 + rl];
        }
        __builtin_amdgcn_sched_barrier(0);
        st[0] = fmaf(st[0] - iv, f0.x, iv); NOPK(st[0]);
        st[1] = fmaf(st[1] - iv, f0.y, iv); NOPK(st[1]);
        st[2] = fmaf(st[2] - iv, f0.z, iv); NOPK(st[2]);
        st[3] = fmaf(st[3] - iv, f0.w, iv); NOPK(st[3]);
        st[4] = fmaf(st[4] - iv, f1.x, iv); NOPK(st[4]);
        st[5] = fmaf(st[5] - iv, f1.y, iv); NOPK(st[5]);
        st[6] = fmaf(st[6] - iv, f1.z, iv); NOPK(st[6]);
        st[7] = fmaf(st[7] - iv, f1.w, iv); NOPK(st[7]);
        float acc0 = fmaf(st[0], q0.x, fmaf(st[1], q0.y, fmaf(st[2], q0.z, st[3] * q0.w)));
        float acc1 = fmaf(st[4], q1.x, fmaf(st[5], q1.y, fmaf(st[6], q1.z, st[7] * q1.w)));
        op4[tt & 3] = acc0 + acc1;
        if ((tt & 3) == 3) {
          const float r4 = reduce4x16(op4[0], op4[1], op4[2], op4[3], lane);
          Oc[ooff4 + (tt - 3) * ostr4] = r4;
        }
        __builtin_amdgcn_sched_barrier(0);
        if (tt + 1 < 16) { f0 = f0n; f1 = f1n; q0 = q0n; q1 = q1n; iv = ivn; }
      }
    }
    __builtin_amdgcn_sched_barrier(0);
    __syncthreads();
  }
  {
    const long m = base + (nblk - 1) * 16 + stt;
    u16* dp = p.PROJ + m * LDP + C_I + h * 128 + q * 16 + (tid & 15);
    *dp = f2bf(O_[((nblk - 1) & 1) * 256 + stt * 16 + (tid & 15)]);
  }
  __syncthreads();
  {
    float* o = p.out + (s < 8 ? O_PHGRN + (((long)l * 8 + s) * 4 + h) * 16384
                              : O_SHGRN + (((long)l * 8 + (s - 8)) * 4 + h) * 16384);
#pragma unroll
    for (int i = 0; i < 8; ++i) o[((i >> 2) * 64 + ksl4 + (i & 3)) * 128 + row] = st[i];
  }
}

__device__ __forceinline__ void scan_ssd(const Params& p, int l, int s, int h, int q, float* smem) {
  const int tid = opaque_tid(), lane = tid & 63, wid = tid >> 6;
  float* B_ = smem;
  float* C_ = smem + 2048;
  float* X_ = smem + 4096;
  float* O_ = smem + 4352;
  float* DT_ = smem + 5200;
  float* DE_ = smem + 5216;
  const int rl = wid * 4 + (lane >> 4);
  const int row = q * 16 + rl;
  const int ksl4 = (lane & 15) * 4;
  const int g = h >> 2;
  const int base = seq_base(s), T = seq_len(s);
  float st[8];
#pragma unroll
  for (int i = 0; i < 8; ++i) st[i] = 0.f;
  if (s >= 8) {
    const float* sp = p.state_ssm + (((long)l * 8 + (s - 8)) * 8 + h) * 8192 + row * 128 + ksl4;
    float4 a = *(const float4*)sp, b = *(const float4*)(sp + 64);
    st[0] = a.x; st[1] = a.y; st[2] = a.z; st[3] = a.w; st[4] = b.x; st[5] = b.y; st[6] = b.z; st[7] = b.w;
  }
  const float* cw = p.conv_w + (long)l * 4 * 1024;
  const int skq8 = (tid & 15) * 8;
  const int xc_x = h * 64 + q * 16 + (tid & 15);
  const float dtb = p.dt_bias[l * 8 + h];
  const float aexp = __expf(p.a_log[l * 8 + h]);
  const float dsk = p.d_skip[l * 8 + h];
  const int stt = tid >> 4;
  const int nblk = T / 16;
  uint4 rawb, rawc;
  u16 xraw = 0;
  float dtr = 0.f;
  u16 zc = 0, zn = 0;
#define SSD_LOAD(M0)                                                              \
  {                                                                               \
    {                                                                             \
      const u16* prow = p.PROJ + ((long)(M0) + stt) * LDP + C_XBC + g * 128 + skq8; \
      rawb = *(const uint4*)(prow + 512);                                         \
      rawc = *(const uint4*)(prow + 768);                                         \
    }                                                                             \
    xraw = p.PROJ[((long)(M0) + stt) * LDP + C_XBC + xc_x];                     \
    if (tid < 16) dtr = (p.FB + FOFF_DTRAW)[((long)(M0) + tid) * 8 + h];                      \
    zn = p.PROJ[((long)(M0) + stt) * LDP + C_Z + h * 64 + q * 16 + (tid & 15)];   \
  }
  SSD_LOAD(base);
  __syncthreads();
  const bool wr = (lane & 15) == 0;
  const int ooff = wr ? rl : (512 + lane);
  const int ostr = wr ? 16 : 0;
  const bool wr4 = (lane & 15) < 4;
  const int ooff4 = wr4 ? (rl + (lane & 3) * 16) : (512 + lane);
  const int ostr4 = wr4 ? 16 : 0;
  u16 zp = 0;
  for (int blk = 0; blk < nblk; ++blk) {
    const long m0 = base + blk * 16;
    zp = zc;
    zc = zn;
    float* Oc = O_ + (blk & 1) * 256;
    {
      {
        const unsigned bw[4] = {rawb.x, rawb.y, rawb.z, rawb.w}, cwd[4] = {rawc.x, rawc.y, rawc.z, rawc.w};
        float bv[8], cv[8];
#pragma unroll
        for (int e = 0; e < 8; ++e) {
          bv[e] = bf2f((u16)((bw[e >> 1] >> ((e & 1) * 16)) & 0xffff));
          cv[e] = bf2f((u16)((cwd[e >> 1] >> ((e & 1) * 16)) & 0xffff));
        }
        *(float4*)(B_ + stt * 128 + skq8) = make_float4(bv[0], bv[1], bv[2], bv[3]);
        *(float4*)(B_ + stt * 128 + skq8 + 4) = make_float4(bv[4], bv[5], bv[6], bv[7]);
        *(float4*)(C_ + stt * 128 + skq8) = make_float4(cv[0], cv[1], cv[2], cv[3]);
        *(float4*)(C_ + stt * 128 + skq8 + 4) = make_float4(cv[4], cv[5], cv[6], cv[7]);
      }
      X_[stt * 16 + (tid & 15)] = bf2f(xraw);
      if (tid < 16) {
        float dtv = softplusf_(dtr + dtb);
        DT_[tid] = dtv;
        DE_[tid] = __expf(-aexp * dtv);
      }
    }
    __syncthreads();
    if (blk > 0) {
      u16* pz = p.PROJ + (m0 - 16 + stt) * LDP + C_Z + h * 64 + q * 16 + (tid & 15);
      *pz = f2bf(O_[((blk - 1) & 1) * 256 + stt * 16 + (tid & 15)] * siluf_(bf2f(zp)));
    }
    if (blk + 1 < nblk) SSD_LOAD(m0 + 16);
    __builtin_amdgcn_sched_barrier(0);
    {
      float4 b0 = *(const float4*)(B_ + ksl4), b1 = *(const float4*)(B_ + 64 + ksl4);
      float4 c0 = *(const float4*)(C_ + ksl4), c1 = *(const float4*)(C_ + 64 + ksl4);
      float xv = X_[rl], dt = DT_[0], de = DE_[0];
      float yp4[4] = {0.f, 0.f, 0.f, 0.f};
      const float dsk16 = dsk * (1.f / 16.f);
#pragma unroll
      for (int tt = 0; tt < 16; ++tt) {
        float4 b0n, b1n, c0n, c1n;
        float xvn, dtn, den;
        if (tt + 1 < 16) {
          const int o_ = (tt + 1) * 128;
          b0n = *(const float4*)(B_ + o_ + ksl4); b1n = *(const float4*)(B_ + o_ + 64 + ksl4);
          c0n = *(const float4*)(C_ + o_ + ksl4); c1n = *(const float4*)(C_ + o_ + 64 + ksl4);
          xvn = X_[(tt + 1) * 16 + rl]; dtn = DT_[tt + 1]; den = DE_[tt + 1];
        }
        __builtin_amdgcn_sched_barrier(0);
        const float xd = xv * dt;
        st[0] = fmaf(st[0], de, xd * b0.x); NOPK(st[0]);
        st[1] = fmaf(st[1], de, xd * b0.y); NOPK(st[1]);
        st[2] = fmaf(st[2], de, xd * b0.z); NOPK(st[2]);
        st[3] = fmaf(st[3], de, xd * b0.w); NOPK(st[3]);
        st[4] = fmaf(st[4], de, xd * b1.x); NOPK(st[4]);
        st[5] = fmaf(st[5], de, xd * b1.y); NOPK(st[5]);
        st[6] = fmaf(st[6], de, xd * b1.z); NOPK(st[6]);
        st[7] = fmaf(st[7], de, xd * b1.w); NOPK(st[7]);
        float acc0 = fmaf(st[0], c0.x, fmaf(st[1], c0.y, fmaf(st[2], c0.z, st[3] * c0.w)));
        float acc1 = fmaf(st[4], c1.x, fmaf(st[5], c1.y, fmaf(st[6], c1.z, st[7] * c1.w)));
        yp4[tt & 3] = fmaf(dsk16, xv, acc0 + acc1);
        if ((tt & 3) == 3) {
          const float r4 = reduce4x16(yp4[0], yp4[1], yp4[2], yp4[3], lane);
          Oc[ooff4 + (tt - 3) * ostr4] = r4;
        }
        __builtin_amdgcn_sched_barrier(0);
        if (tt + 1 < 16) { b0 = b0n; b1 = b1n; c0 = c0n; c1 = c1n; xv = xvn; dt = dtn; de = den; }
      }
    }
    __builtin_amdgcn_sched_barrier(0);
    __syncthreads();
  }
  {
    const long m0 = base + (nblk - 1) * 16;
    u16* pz = p.PROJ + (m0 + stt) * LDP + C_Z + h * 64 + q * 16 + (tid & 15);
    *pz = f2bf(O_[((nblk - 1) & 1) * 256 + stt * 16 + (tid & 15)] * siluf_(bf2f(zc)));
  }
  __syncthreads();
#undef SSD_LOAD
  {
    float* o = p.out + (s < 8 ? O_PSSM + (((long)l * 8 + s) * 8 + h) * 8192
                              : O_SSSM + (((long)l * 8 + (s - 8)) * 8 + h) * 8192);
    *(float4*)(o + row * 128 + ksl4) = make_float4(st[0], st[1], st[2], st[3]);
    *(float4*)(o + row * 128 + 64 + ksl4) = make_float4(st[4], st[5], st[6], st[7]);
  }
}

__device__ __forceinline__ void phase_scan(const Params& p, int l, float* smem) {
  for (int u = BID, nb_ = NBLK; u < 1536; u += nb_) {
    int sample = u >= 768;
    int v = sample ? u - 768 : u;
    int type = v % 3, w = v / 3;
    if (type == 0) {
      int q = w & 3, h = (w >> 2) & 7, b = w >> 5;
      scan_rwkv(p, l, b + 8 * sample, h, q, smem);
    } else if (type == 1) {
      int q = w & 7, h = (w >> 3) & 3, b = w >> 5;
      scan_hgrn(p, l, b + 8 * sample, h, q, smem);
    } else {
      int q = w & 3, h = (w >> 2) & 7, b = w >> 5;
      scan_ssd(p, l, b + 8 * sample, h, q, smem);
    }
  }
}

__device__ __forceinline__ void phase_post(const Params& p, int l, float* smem) {
  constexpr int LDG = 516;
  float* GA = smem;
  for (int blk = BID, nb_ = NBLK; blk < NBLK16; blk += nb_) {
    const int tid = opaque_tid(), lane = tid & 63, wid = tid >> 6;
    const int T = tid >> 4, Q = tid & 15;
    const long m0 = (long)blk * 16;
    const long m = m0 + T;
    if (tid < 16) (p.FB + FOFF_SS)[m0 + tid] = 0.f;
    __syncthreads();
    {
      bf16x8 ag[4];
      const u16* arow = p.PROJ + (m0 + (lane & 15)) * LDP + C_XG + (lane >> 4) * 8;
#pragma unroll
      for (int ks = 0; ks < 4; ++ks) ag[ks] = *(const bf16x8*)(arow + ks * 32);
#pragma unroll
      for (int nt = 0; nt < 8; ++nt) {
        const int n = (wid * 8 + nt) * 16 + (lane & 15);
        f32x4v acc = {0.f, 0.f, 0.f, 0.f};
#pragma unroll
        for (int ks = 0; ks < 4; ++ks) {
          bf16x8 bg = *(const bf16x8*)((p.WB + OFF_G2T) + n * 128 + ks * 32 + (lane >> 4) * 8);
          acc = __builtin_amdgcn_mfma_f32_16x16x32_bf16(ag[ks], bg, acc, 0, 0, 0);
        }
#pragma unroll
        for (int r = 0; r < 4; ++r) GA[((lane >> 4) * 4 + r) * LDG + n] = acc[r];
      }
    }
    __syncthreads();
    u16* row = p.PROJ + m * LDP;
#pragma unroll 1
    for (int g = 0; g < 2; ++g) {
      float y0[8], y1[8], w[8];
      const int c0 = g * 256 + Q * 8, c1 = c0 + 128;
      unpack8(*(const uint4*)(row + C_Z + c0), y0);
      unpack8(*(const uint4*)(row + C_Z + c1), y1);
      float ss = 0.f;
#pragma unroll
      for (int e = 0; e < 8; ++e) ss += y0[e] * y0[e] + y1[e] * y1[e];
      ss = sum16(ss);
      const float rs = rsqrtf(ss * (1.f / 256.f) + 1e-6f);
      ld8(p.ssd_norm_w + l * 512 + c0, w);
#pragma unroll
      for (int e = 0; e < 8; ++e) y0[e] = y0[e] * rs * w[e];
      ld8(p.ssd_norm_w + l * 512 + c1, w);
#pragma unroll
      for (int e = 0; e < 8; ++e) y1[e] = y1[e] * rs * w[e];
      *(uint4*)(row + C_Z + c0) = pack8(y0);
      *(uint4*)(row + C_Z + c1) = pack8(y1);
    }
#pragma unroll 1
    for (int j = 0; j < 4; ++j) {
      const int c0 = j * 128 + Q * 8;
      {
        float oh[8], gg[8], w[8];
        unpack8(*(const uint4*)(row + C_I + c0), oh);
        unpack8(*(const uint4*)(row + C_GG + c0), gg);
        float ss = 0.f;
#pragma unroll
        for (int e = 0; e < 8; ++e) ss += oh[e] * oh[e];
        ss = sum16(ss);
        const float rs = rsqrtf(ss * (1.f / 128.f) + 1e-6f);
        ld8(p.hg_norm_w + l * 512 + c0, w);
#pragma unroll
        for (int e = 0; e < 8; ++e) oh[e] = oh[e] * rs * w[e] * siluf_(gg[e]);
        *(uint4*)(row + C_GG + c0) = pack8(oh);
      }
      {
        float o[8], v[8], w[8], bb[8], ga[8];
        const int head = j * 2 + (Q >> 3);
        unpack8(*(const uint4*)(p.ORW + m * 512 + c0), o);
        unpack8(*(const uint4*)(row + C_V + c0), v);
        float sm = 0.f;
#pragma unroll
        for (int e = 0; e < 8; ++e) sm += o[e];
        const float mean = sum8(sm) * (1.f / 64.f);
        float sv = 0.f;
#pragma unroll
        for (int e = 0; e < 8; ++e) { o[e] -= mean; sv += o[e] * o[e]; }
        const float rstd = rsqrtf(sum8(sv) * (1.f / 64.f) + 64e-5f);
        const float rks = (p.FB + FOFF_RKS)[m * 8 + head];
        ld8(p.rw_lnx_w + l * 512 + c0, w);
        ld8(p.rw_lnx_b + l * 512 + c0, bb);
        ld8(GA + T * LDG + c0, ga);
#pragma unroll
        for (int e = 0; e < 8; ++e) o[e] = (o[e] * rstd * w[e] + bb[e] + rks * v[e]) * ga[e];
        *(uint4*)(row + C_R + c0) = pack8(o);
      }
    }
  }
}

__device__ __forceinline__ void phase_final(const Params& p) {
  const int tid = opaque_tid(), lane = tid & 63, wid = tid >> 6;
  for (int m = BID * 4 + wid, nb_ = NBLK; m < M_TOT; m += nb_ * 4) {
    float* dst;
    if (m < M_PROMPT) {
      int b = m / T_P, t = m - b * T_P;
      if (t < 16) continue;
      dst = p.out + O_YP + ((long)b * 4096 + (t - 16)) * DM;
    } else {
      dst = p.out + O_YS + (long)(m - M_PROMPT) * DM;
    }
    float x[16];
    float ss = 0.f;
#pragma unroll
    for (int j = 0; j < 2; ++j) {
      uint4 raw = *(const uint4*)(p.XB + xb_off(m, lane * 8 + 512 * j));
      unsigned wv[4] = {raw.x, raw.y, raw.z, raw.w};
#pragma unroll
      for (int e = 0; e < 8; ++e) {
        x[j * 8 + e] = bf2f((u16)((wv[e >> 1] >> ((e & 1) * 16)) & 0xffff));
        ss += x[j * 8 + e] * x[j * 8 + e];
      }
    }
    ss = sum64(ss);
    float rs = rsqrtf(ss * (1.f / 1024.f) + 1e-6f);
#pragma unroll
    for (int j = 0; j < 2; ++j) {
      int k0 = lane * 8 + 512 * j;
      float4 w0 = *(const float4*)(p.final_w + k0), w1 = *(const float4*)(p.final_w + k0 + 4);
      typedef float f4nt __attribute__((ext_vector_type(4)));
      f4nt o0 = {x[j * 8 + 0] * rs * w0.x, x[j * 8 + 1] * rs * w0.y, x[j * 8 + 2] * rs * w0.z, x[j * 8 + 3] * rs * w0.w};
      f4nt o1 = {x[j * 8 + 4] * rs * w1.x, x[j * 8 + 5] * rs * w1.y, x[j * 8 + 6] * rs * w1.z, x[j * 8 + 7] * rs * w1.w};
      __builtin_nontemporal_store(o0, (f4nt*)(dst + k0));
      __builtin_nontemporal_store(o1, (f4nt*)(dst + k0 + 4));
    }
  }
}


#define XB_TMO      128
#define XB_XCNT(j)  (256  + 64 * (j))
#define XB_XSUB(j)  (1280 + 64 * (j))
#define XB_XGEN(j)  (2304 + 64 * (j))
#define XB_TOP      3328
#define XB_TOPGEN   3392
#define XCD_BAR_WORDS 3456
#define XB_SPIN_CAP (1u << 22)
__device__ __forceinline__ unsigned xb_ld(unsigned* p) { return __hip_atomic_load(p, __ATOMIC_RELAXED, __HIP_MEMORY_SCOPE_AGENT); }
__device__ __forceinline__ unsigned xb_add(unsigned* p, unsigned v) { return __hip_atomic_fetch_add(p, v, __ATOMIC_RELAXED, __HIP_MEMORY_SCOPE_AGENT); }
__device__ __forceinline__ unsigned xb_xcc_id() { return (unsigned)__builtin_amdgcn_s_getreg((3 << 11) | 20) & 0xFu; }
#define XB_SPIN(cond, bar) do { unsigned _sp = 0; while (cond) { __builtin_amdgcn_s_sleep(8); \
    if ((++_sp & 255u) == 0u) { if (xb_ld(&(bar)[XB_TMO])) break; if (_sp > XB_SPIN_CAP) { atomicAdd(&(bar)[XB_TMO], 1u); break; } } } } while (0)

__device__ __forceinline__ void xcd_barrier_post(unsigned* bar) {
  if (threadIdx.x == 0) (void)xb_add(&bar[XB_XCNT(xb_xcc_id())], 1u);
}
__device__ __forceinline__ void xcd_barrier_complete(unsigned* bar, unsigned x, unsigned& nloc, unsigned& nx) {
  const unsigned G = gridDim.x;
  unsigned sum, cnt, mine, sp = 0u;
  for (;;) {
    sum = 0u; cnt = 0u; mine = 0u;
#pragma unroll
    for (unsigned j = 0; j < 16; ++j) { const unsigned c = xb_ld(&bar[XB_XCNT(j)]); sum += c; cnt += (c > 0u) ? 1u : 0u; mine = (j == x) ? c : mine; }
    if (sum == G) break;
    __builtin_amdgcn_s_sleep(1);
    if ((++sp & 255u) == 0u) { if (xb_ld(&bar[XB_TMO])) break; if (sp > XB_SPIN_CAP) { atomicAdd(&bar[XB_TMO], 1u); break; } }
  }
  nloc = mine > 0u ? mine : 1u; nx = cnt > 0u ? cnt : 1u;
}
__device__ __forceinline__ void xcd_barrier(unsigned* bar, volatile unsigned* st) {
  asm volatile("s_waitcnt vmcnt(0)" ::: "memory");
  __syncthreads();
  if (threadIdx.x == 0) {
    __builtin_amdgcn_s_waitcnt(0);
    const unsigned x = xb_xcc_id();
    unsigned nloc = st[0], nx = st[1];
    if (nloc == 0u) { xcd_barrier_complete(bar, x, nloc, nx); st[0] = nloc; st[1] = nx; }
    const unsigned old = xb_add(&bar[XB_XSUB(x)], 1u);
    const unsigned gen = old / nloc;
    if (old + 1u == (gen + 1u) * nloc) {
      __builtin_amdgcn_fence(__ATOMIC_RELEASE, "agent");
      asm volatile("s_waitcnt vmcnt(0)" ::: "memory");
      const unsigned og = xb_add(&bar[XB_TOP], 1u);
      const unsigned tg = og / nx;
      if (og + 1u == (tg + 1u) * nx) xb_add(&bar[XB_TOPGEN], 1u);
      else XB_SPIN(xb_ld(&bar[XB_TOPGEN]) == tg, bar);
      __builtin_amdgcn_fence(__ATOMIC_ACQUIRE, "agent");
      xb_add(&bar[XB_XGEN(x)], 1u);
      asm volatile("s_waitcnt vmcnt(0)" ::: "memory");
    } else {
      XB_SPIN(xb_ld(&bar[XB_XGEN(x)]) == gen, bar);
      __builtin_amdgcn_fence(__ATOMIC_ACQUIRE, "agent");
      asm volatile("s_waitcnt vmcnt(0)" ::: "memory");
    }
  }
  __syncthreads();
}

constexpr int SMEM_BYTES = 40960;
__device__ __forceinline__ void run_phase(const Params& p, int ph, char* smem) {
  if (ph == 0) { phase_embed(p); return; }
  if (ph == 19) { phase_final(p); return; }
  int l = (ph - 1) / 9, s = (ph - 1) % 9;
  float* fs = (float*)smem;
  switch (s) {
    case 0: phase_convert(p, l, fs); phase_rowstat<true>(p, l, fs); break;
    case 1: phase_gemm<1, true>(p, p.XB, DM, (p.WB + OFF_W1T), 1024, LDP / 128, smem); break;
    case 2: phase_pre(p, l, fs); break;
    case 3: phase_scan(p, l, fs); break;
    case 4: phase_post(p, l, fs); break;
    case 5: phase_gemm<2, false, true>(p, p.PROJ, LDP, (p.WB + OFF_WOT), 1536, 8, smem); break;
    case 6: break;
    case 7: phase_gemm<3, true>(p, p.XB, DM, (p.WB + OFF_WGU), 1024, 44, smem); break;
    case 8: phase_gemm<2, true>(p, p.PROJ, D_FF, (p.WB + OFF_WDT), D_FF, 8, smem); break;
  }
}
constexpr int N_PHASES = 20;

#if MEGA
__global__ void __launch_bounds__(256, 3) k_mega(Params p) {
  __shared__ __attribute__((aligned(16))) char smem[SMEM_BYTES];
  __shared__ uint4 xb_words;
  if (threadIdx.x == 0) { xb_words = make_uint4(0u, 0u, 0u, 0u); }
  __syncthreads();
  cg::grid_group grid = cg::this_grid();
  float* fs = (float*)smem;
  volatile unsigned* xst = (volatile unsigned*)&xb_words;
  xcd_barrier_post(p.bar);
#define GSYNC() do { unsigned* b_ = p.bar; asm volatile("" : "+s"(b_)); xcd_barrier(b_, xst); } while (0)
  {
    const int L0_ = 0;
    int l = opaque_s(L0_);
    phase_convert(p, l, fs);
    phase_rowstat<true, true>(p, l, fs);
    grid.sync();
    l = opaque_s(l);
    phase_gemm<1, true>(p, p.XB, DM, (p.WB + OFF_W1T), 1024, LDP / 128, smem);
    GSYNC();
    l = opaque_s(l);
    phase_pre(p, l, fs);
    GSYNC();
    l = opaque_s(l);
    phase_scan(p, l, fs);
    GSYNC();
    l = opaque_s(l);
    phase_post(p, l, fs);
    GSYNC();
    l = opaque_s(l);
    phase_gemm<2, false, true>(p, p.PROJ, LDP, (p.WB + OFF_WOT), 1536, 8, smem);
    GSYNC();
    l = opaque_s(l);
    phase_gemm<3, true>(p, p.XB, DM, (p.WB + OFF_WGU), 1024, 44, smem);
    GSYNC();
    l = opaque_s(l);
    phase_gemm<2, true>(p, p.PROJ, D_FF, (p.WB + OFF_WDT), D_FF, 8, smem);
    GSYNC();
  }
  {
    const int L0_ = 1;
    int l = opaque_s(L0_);
    phase_convert(p, l, fs);
    phase_rowstat<true>(p, l, fs);
    GSYNC();
    l = opaque_s(l);
    phase_gemm<1, true>(p, p.XB, DM, (p.WB + OFF_W1T), 1024, LDP / 128, smem);
    GSYNC();
    l = opaque_s(l);
    phase_pre(p, l, fs);
    GSYNC();
    l = opaque_s(l);
    phase_scan(p, l, fs);
    GSYNC();
    l = opaque_s(l);
    phase_post(p, l, fs);
    GSYNC();
    l = opaque_s(l);
    phase_gemm<2, false, true>(p, p.PROJ, LDP, (p.WB + OFF_WOT), 1536, 8, smem);
    GSYNC();
    l = opaque_s(l);
    phase_gemm<3, true>(p, p.XB, DM, (p.WB + OFF_WGU), 1024, 44, smem);
    GSYNC();
    l = opaque_s(l);
    phase_gemm<2, true>(p, p.PROJ, D_FF, (p.WB + OFF_WDT), D_FF, 8, smem);
    GSYNC();
  }
  phase_final(p);
}
#else
template <int PH>
__global__ void __launch_bounds__(256, 3) k_phase(Params p) {
  __shared__ __attribute__((aligned(16))) char smem[SMEM_BYTES];
  run_phase(p, PH, smem);
}
template <int PH>
static void launch_all(const Params& p, int grid, hipStream_t stream) {
  hipLaunchKernelGGL(k_phase<PH>, dim3(grid), dim3(256), 0, stream, p);
  if constexpr (PH + 1 < N_PHASES) launch_all<PH + 1>(p, grid, stream);
}
#endif

extern "C" void kernel_launch(void* const* d_in, const int* in_sizes, int n_in, void* d_out, int out_size, void* d_ws,
                              size_t ws_size, hipStream_t stream) {
  Params p{};
  const float** pf = (const float**)&p;
  for (int i = 0; i < 35; ++i) pf[i] = (const float*)d_in[i];
  p.out = (float*)d_out;
  char* ws = (char*)d_ws;
  size_t off = 0;
  auto take = [&](size_t bytes) { char* r = ws + off; off += (bytes + 255) & ~(size_t)255; return r; };
  p.XB = (u16*)take((size_t)M_TOT * DM * 2);
  p.PROJ = (u16*)take((size_t)M_TOT * LDP * 2);
  p.WB = (u16*)take((size_t)WB_TOTAL * 2);
  p.BND = (u16*)take((size_t)NBLK16 * 1792 * 2);
  p.BND2 = (u16*)take((size_t)NBLK16 * 3 * 1024 * 2);
  p.ORW = (u16*)take((size_t)M_TOT * 512 * 2);
  p.FB = (float*)take((size_t)FB_TOTAL * 4);
  p.bar = (unsigned*)take((size_t)XCD_BAR_WORDS * 4);
  p.RWX = (u16*)d_out;
  if (off > ws_size) fprintf(stderr, "workspace too small: need %zu have %zu\n", off, ws_size);
#if MEGA
  static int grid_blocks = 0;
  if (!grid_blocks) {
    int dev = 0, cus = 0, per_cu = 0;
    hipGetDevice(&dev);
    hipDeviceGetAttribute(&cus, hipDeviceAttributeMultiprocessorCount, dev);
    hipOccupancyMaxActiveBlocksPerMultiprocessor(&per_cu, k_mega, 256, 0);
    if (per_cu > 3) per_cu = 3;
    grid_blocks = cus * per_cu;
  }
  hipMemsetAsync(p.bar, 0, (size_t)XCD_BAR_WORDS * 4, stream);
  void* args[] = {&p};
  hipError_t e = hipLaunchCooperativeKernel((void*)k_mega, dim3(grid_blocks), dim3(256), args, 0, stream);
  if (e != hipSuccess) fprintf(stderr, "cooperative launch failed: %s (grid %d)\n", hipGetErrorString(e), grid_blocks);
#else
  launch_all<0>(p, 768, stream);
#endif
}
```

```cpp
#include <hip/hip_runtime.h>
#include <hip/hip_bf16.h>
#include <hip/hip_cooperative_groups.h>
#include <cstdio>
namespace cg = cooperative_groups;

#ifndef MEGA
#define MEGA 1
#endif

typedef unsigned short u16;
using bf16x8 = __attribute__((ext_vector_type(8))) short;
using f32x16 = __attribute__((ext_vector_type(16))) float;
using f32x4v = __attribute__((ext_vector_type(4))) float;

constexpr int DM = 1024;
constexpr int M_TOT = 33408;
constexpr int M_PROMPT = 32896;
constexpr int T_P = 4112;
constexpr int LDP = 5376;
constexpr int N_IN = 5384;
constexpr int D_FF = 2816;
constexpr int NBLK16 = M_TOT / 16;
constexpr int C_Z = 0, C_R = 512, C_GG = 1024, C_XBC = 1536, C_K = 2560, C_V = 3072, C_XW = 3584, C_XA = 3648,
              C_XG = 3712, C_Q = 3840, C_F = 4352, C_I = 4864;
constexpr long O_YP = 0, O_YS = 33554432, O_PSSM = 34078720, O_PCONV = 35127296, O_PRWKV = 35176448,
               O_PSHIFT = 35700736, O_PHGRN = 35729408, O_SSSM = 36777984, O_SCONV = 37826560,
               O_SRWKV = 37875712, O_SSHIFT = 38400000, O_SHGRN = 38428672;

constexpr long OFF_W1T = 0, OFF_WOT = 5505024, OFF_WGU = 7077888, OFF_WDT = 12845056, OFF_W2T = 15728640, OFF_A2T = 15761408, OFF_G2T = 15794176, WB_TOTAL = 15859712;
constexpr long FOFF_RS = 0, FOFF_DTRAW = 33408, FOFF_RKS = 300672, FOFF_SS = 567936, FB_TOTAL = 601344;
struct Params {
  const float *x_prompt, *x_sample, *state_ssm, *state_conv, *state_rwkv, *state_shift, *state_hgrn, *meta,
      *norm1_w, *w_in, *conv_w, *conv_b, *dt_bias, *a_log, *d_skip, *ssd_norm_w, *rw_mu, *rw_w0, *rw_w2, *rw_a0,
      *rw_a2, *rw_g2, *rw_kk, *rw_ka, *rw_rk, *rw_lnx_w, *rw_lnx_b, *hg_lb, *hg_norm_w, *w_out, *norm2_w, *w_gate,
      *w_up, *w_down, *final_w;
  float* out;
  u16 *XB, *PROJ, *WB, *BND, *BND2, *ORW, *RWX;
  float *FB;
  unsigned* bar;
};

typedef __bf16 bf16x2_t __attribute__((ext_vector_type(2)));
typedef float f32x2_t __attribute__((ext_vector_type(2)));
__device__ __forceinline__ unsigned cvt2bf(float a, float b) {
  f32x2_t v = {a, b};
  bf16x2_t r = __builtin_convertvector(v, bf16x2_t);
  return __builtin_bit_cast(unsigned, r);
}
__device__ __forceinline__ u16 f2bf(float f) { return (u16)(cvt2bf(f, f) & 0xffffu); }
__device__ __forceinline__ float bf2f(u16 h) { return __uint_as_float(((unsigned)h) << 16); }
__device__ __forceinline__ float frcp_(float x) { return __builtin_amdgcn_rcpf(x); }
__device__ __forceinline__ float sigmoidf_(float x) { return frcp_(1.f + __expf(-x)); }
__device__ __forceinline__ float siluf_(float x) { return x * frcp_(1.f + __expf(-x)); }
__device__ __forceinline__ float softplusf_(float x) { return x > 20.f ? x : __logf(1.f + __expf(x)); }
__device__ __forceinline__ float tanhf_(float x) { return 1.f - 2.f * __builtin_amdgcn_rcpf(1.f + __expf(2.f * x)); }

template <int CTRL>
__device__ __forceinline__ float dppf(float v) {
  return __int_as_float(__builtin_amdgcn_update_dpp(0, __float_as_int(v), CTRL, 0xF, 0xF, true));
}
__device__ __forceinline__ float sum16(float v) {
  v += dppf<0xB1>(v);
  v += dppf<0x4E>(v);
  v += dppf<0x141>(v);
  v += dppf<0x140>(v);
  return v;
}
__device__ __forceinline__ void sum16x2(float& a, float& b) {
  a += dppf<0xB1>(a); b += dppf<0xB1>(b);
  a += dppf<0x4E>(a); b += dppf<0x4E>(b);
  a += dppf<0x141>(a); b += dppf<0x141>(b);
  a += dppf<0x140>(a); b += dppf<0x140>(b);
}

__device__ __forceinline__ float sum8(float v) {
  v += dppf<0xB1>(v);
  v += dppf<0x4E>(v);
  v += dppf<0x141>(v);
  return v;
}
__device__ __forceinline__ void unpack8(const uint4& r, float* f) {
  f[0] = __uint_as_float(r.x << 16); f[1] = __uint_as_float(r.x & 0xffff0000u);
  f[2] = __uint_as_float(r.y << 16); f[3] = __uint_as_float(r.y & 0xffff0000u);
  f[4] = __uint_as_float(r.z << 16); f[5] = __uint_as_float(r.z & 0xffff0000u);
  f[6] = __uint_as_float(r.w << 16); f[7] = __uint_as_float(r.w & 0xffff0000u);
}
__device__ __forceinline__ uint4 pack8(const float* f) {
  uint4 r;
  r.x = cvt2bf(f[0], f[1]);
  r.y = cvt2bf(f[2], f[3]);
  r.z = cvt2bf(f[4], f[5]);
  r.w = cvt2bf(f[6], f[7]);
  return r;
}
__device__ __forceinline__ void ld8(const float* p, float* f) {
  float4 a = *(const float4*)p, b = *(const float4*)(p + 4);
  f[0] = a.x; f[1] = a.y; f[2] = a.z; f[3] = a.w; f[4] = b.x; f[5] = b.y; f[6] = b.z; f[7] = b.w;
}

struct F8 { float v[8]; };
__device__ __forceinline__ F8 up8(const uint4& r) { F8 f; unpack8(r, f.v); return f; }
__device__ __forceinline__ F8 ldf8(const float* p) { F8 f; ld8(p, f.v); return f; }
__device__ __forceinline__ F8 zero8() { F8 f; for (int e = 0; e < 8; ++e) f.v[e] = 0.f; return f; }
__device__ __forceinline__ float reduce4x16(float a, float b, float c, float d, int lane) {
  const bool o1 = (lane & 1) != 0, o2 = (lane & 2) != 0;
  float k0 = o1 ? b : a, s0 = o1 ? a : b;
  float k1 = o1 ? d : c, s1 = o1 ? c : d;
  k0 += dppf<0xB1>(s0);
  k1 += dppf<0xB1>(s1);
  float kp = o2 ? k1 : k0, sd = o2 ? k0 : k1;
  kp += dppf<0x4E>(sd);
  kp += dppf<0x124>(kp);
  kp += dppf<0x128>(kp);
  return kp;
}
__device__ __forceinline__ float sum64(float v) {
  v = sum16(v);
  v += __shfl_xor(v, 16);
  v += __shfl_xor(v, 32);
  return v;
}

#define NOPK(x) asm("" : "+v"(x))
__device__ __forceinline__ int opaque_tid() {
  int t = threadIdx.x;
  asm volatile("" : "+v"(t));
  return t;
}
__device__ __forceinline__ int opaque_s(int v) {
  asm volatile("" : "+s"(v));
  return v;
}
#define BID opaque_s((int)blockIdx.x)
#define NBLK opaque_s((int)gridDim.x)
__device__ __forceinline__ int seq_base(int s) { return s < 8 ? s * T_P : M_PROMPT + (s - 8) * 64; }
__device__ __forceinline__ int seq_len(int s) { return s < 8 ? T_P : 64; }

__device__ __forceinline__ long xb_off(int m, int k);
__device__ __forceinline__ void phase_embed(const Params& p) {
  const long n4 = (long)M_TOT * 256;
  for (long idx = (long)BID * 256 + threadIdx.x, st_ = (long)NBLK * 256; idx < n4; idx += st_) {
    int m = (int)(idx >> 8), c4 = ((int)idx & 255) * 4;
    const float* src;
    if (m < M_PROMPT) {
      int b = m / T_P, t = m - b * T_P;
      src = (t < 16) ? p.meta + (long)t * DM : p.x_prompt + ((long)b * 4096 + (t - 16)) * DM;
    } else {
      src = p.x_sample + (long)(m - M_PROMPT) * DM;
    }
    float4 v = *(const float4*)(src + c4);
    ushort4 o;
    o.x = f2bf(v.x); o.y = f2bf(v.y); o.z = f2bf(v.z); o.w = f2bf(v.w);
    *(ushort4*)(p.XB + xb_off(m, c4)) = o;
  }
}

__device__ __forceinline__ long xb_off(int m, int k) { return ((long)(m >> 7) * 32 + (k >> 5)) * 4096 + (m & 127) * 32 + (k & 31); }
__device__ __forceinline__ long wtile_off(int n, int k, int K) {
  return ((long)(n >> 7) * (K >> 5) + (k >> 5)) * 4096 + (n & 127) * 32 + (k & 31);
}
template <bool HAS_SCALE>
__device__ __forceinline__ void conv_tile(const float* __restrict__ src, int ldsrc, int srccol0, const float* __restrict__ scale,
                          u16* __restrict__ dst, int K, int k0, int n0, float* tile  ) {
  const int tid = opaque_tid();
  __syncthreads();
  {
    int nn = tid & 63, kb = tid >> 6;
#pragma unroll
    for (int i = 0; i < 16; ++i) {
      int kk = kb + 4 * i;
      float v = src[(long)(k0 + kk) * ldsrc + srccol0 + nn];
      if (HAS_SCALE) v *= scale[k0 + kk];
      tile[kk * 65 + nn] = v;
    }
  }
  __syncthreads();
  {
    int nn = tid >> 2, kq = (tid & 3) * 16;
    u16* d = dst + wtile_off(n0 + nn, k0 + kq, K);
#pragma unroll
    for (int j = 0; j < 16; j += 2) {
      unsigned w = f2bf(tile[(kq + j) * 65 + nn]) | ((unsigned)f2bf(tile[(kq + j + 1) * 65 + nn]) << 16);
      *(unsigned*)(d + j) = w;
    }
  }
}

__device__ __forceinline__ int w1_srccol(int n0) {
  if (n0 < 512) return n0;
  if (n0 < 1024) return n0 - 512 + 1544;
  if (n0 < 1536) return n0 - 1024 + 4872;
  if (n0 < 2560) return n0 - 1536 + 512;
  if (n0 < 3840) return n0 - 2560 + 2056;
  return n0 - 3840 + 3336;
}

constexpr int CV_W1 = 16 * 84, CV_WO = 24 * 16, CV_WGU = 16 * 88, CV_WD = 44 * 16;
constexpr int CV_LORA = 32;
constexpr int CV_TOTAL = CV_W1 + CV_WO + CV_WGU + CV_WD + CV_LORA;

__device__ __forceinline__ void phase_convert(const Params& p, int l, float* smem) {
  for (int u = BID, nb_ = NBLK; u < CV_TOTAL; u += nb_) {
    if (u < CV_W1) {
      int kt = u % 16, nt = u / 16;
      conv_tile<true>(p.w_in + (long)l * DM * N_IN, N_IN, w1_srccol(nt * 64), p.norm1_w + l * DM, (p.WB + OFF_W1T), 1024, kt * 64,
                nt * 64, smem);
    } else if (u < CV_W1 + CV_WO) {
      int v = u - CV_W1;
      int kt = v % 24, nt = v / 24;
      conv_tile<false>(p.w_out + (long)l * 1536 * DM, DM, nt * 64, nullptr, (p.WB + OFF_WOT), 1536, kt * 64, nt * 64, smem);
    } else if (u < CV_W1 + CV_WO + CV_WGU) {
      int v = u - CV_W1 - CV_WO;
      int kt = v % 16, nt = v / 16;
      const float* wg = p.w_gate + (long)l * DM * D_FF;
      const float* wu = p.w_up + (long)l * DM * D_FF;
      const float* sc = p.norm2_w + l * DM;
      const int tid = opaque_tid();
      __syncthreads();
      {
        int nn = tid & 63, kb = tid >> 6;
        const float* src = (nn < 32) ? wg : wu;
        int col = nt * 32 + (nn & 31);
#pragma unroll
        for (int i = 0; i < 16; ++i) {
          int kk = kb + 4 * i;
          smem[kk * 65 + nn] = src[(long)(kt * 64 + kk) * D_FF + col] * sc[kt * 64 + kk];
        }
      }
      __syncthreads();
      {
        int nn = tid >> 2, kq = (tid & 3) * 16;
        u16* d = (p.WB + OFF_WGU) + wtile_off(nt * 64 + nn, kt * 64 + kq, 1024);
#pragma unroll
        for (int j = 0; j < 16; j += 2) {
          unsigned w = f2bf(smem[(kq + j) * 65 + nn]) | ((unsigned)f2bf(smem[(kq + j + 1) * 65 + nn]) << 16);
          *(unsigned*)(d + j) = w;
        }
      }
    } else if (u >= CV_W1 + CV_WO + CV_WGU + CV_WD) {
      int v = u - (CV_W1 + CV_WO + CV_WGU + CV_WD);
      const int tid = opaque_tid();
#pragma unroll 4
      for (int i = 0; i < 16; ++i) {
        int e = v * 4096 + i * 256 + tid;
        if (e < 32768) {
          int n = e >> 6, k = e & 63;
          (p.WB + OFF_W2T)[e] = f2bf(p.rw_w2[(long)l * 64 * 512 + k * 512 + n]);
        } else if (e < 65536) {
          int e2 = e - 32768, n = e2 >> 6, k = e2 & 63;
          (p.WB + OFF_A2T)[e2] = f2bf(p.rw_a2[(long)l * 64 * 512 + k * 512 + n]);
        } else {
          int e2 = e - 65536, n = e2 >> 7, k = e2 & 127;
          (p.WB + OFF_G2T)[e2] = f2bf(p.rw_g2[(long)l * 128 * 512 + k * 512 + n]);
        }
      }
    } else {
      int v = u - CV_W1 - CV_WO - CV_WGU;
      int kt = v % 44, nt = v / 44;
      conv_tile<false>(p.w_down + (long)l * D_FF * DM, DM, nt * 64, nullptr, (p.WB + OFF_WDT), D_FF, kt * 64, nt * 64, smem);
    }
  }
}

template <bool WITH_DT, bool EMB = false>
__device__ __forceinline__ void phase_rowstat(const Params& p, int l, float* smem) {
  const int tid = opaque_tid(), lane = tid & 63, wid = tid >> 6;
  float* dtw = smem;
  if (WITH_DT) {
    __syncthreads();
    const float* w = p.w_in + (long)l * DM * N_IN + 1536;
    const float* nw = p.norm1_w + l * DM;
    for (int i = tid; i < 8192; i += 256) {
      int k = i >> 3, h = i & 7;
      dtw[i] = w[(long)k * N_IN + h] * nw[k];
    }
    __syncthreads();
  }
  for (int blk = BID, nb_ = NBLK; blk < NBLK16; blk += nb_) {
    for (int rr = wid; rr < 16; rr += 4) {
      int m = blk * 16 + rr;
      float ss = 0.f;
      float d[8];
#pragma unroll
      for (int h = 0; h < 8; ++h) d[h] = 0.f;
      const float* srow = nullptr;
      if (EMB) {
        if (m < M_PROMPT) {
          int b = m / T_P, t = m - b * T_P;
          srow = (t < 16) ? p.meta + (long)t * DM : p.x_prompt + ((long)b * 4096 + (t - 16)) * DM;
        } else {
          srow = p.x_sample + (long)(m - M_PROMPT) * DM;
        }
      }
#pragma unroll 1
      for (int j = 0; j < 4; ++j) {
        int k0 = lane * 4 + 256 * j;
        uint2 raw;
        if (EMB) {
          const float4 v = *(const float4*)(srow + k0);
          raw.x = cvt2bf(v.x, v.y);
          raw.y = cvt2bf(v.z, v.w);
          *(uint2*)(p.XB + xb_off(m, k0)) = raw;
        } else {
          raw = *(const uint2*)(p.XB + xb_off(m, k0));
        }
        float xs[4] = {bf2f((u16)(raw.x & 0xffff)), bf2f((u16)(raw.x >> 16)), bf2f((u16)(raw.y & 0xffff)),
                       bf2f((u16)(raw.y >> 16))};
#pragma unroll
        for (int e = 0; e < 4; ++e) {
          float x = xs[e];
          ss += x * x;
          if (WITH_DT) {
            float4 w0 = *(const float4*)(dtw + (k0 + e) * 8);
            float4 w1 = *(const float4*)(dtw + (k0 + e) * 8 + 4);
            d[0] += x * w0.x; d[1] += x * w0.y; d[2] += x * w0.z; d[3] += x * w0.w;
            d[4] += x * w1.x; d[5] += x * w1.y; d[6] += x * w1.z; d[7] += x * w1.w;
          }
        }
      }
      ss = sum64(ss);
      float rs = rsqrtf(ss * (1.f / 1024.f) + 1e-6f);
      if (WITH_DT) {
#pragma unroll
        for (int h = 0; h < 8; ++h) d[h] = sum64(d[h]);
        if (lane == 0) {
#pragma unroll
          for (int h = 0; h < 8; ++h) (p.FB + FOFF_DTRAW)[(long)m * 8 + h] = d[h] * rs;
        }
      }
      if (lane == 0) (p.FB + FOFF_RS)[m] = rs;
    }
  }
}

constexpr int G_BK = 32, G_LDS_ROW = 80;
constexpr int G_OPER_BYTES = 128 * G_LDS_ROW;
template <int MODE, bool A_TILED, bool ACC_SS = false>
__device__ __forceinline__ void phase_gemm(const Params& p, const u16* __restrict__ A, int lda, const u16* __restrict__ Bt, int K,
                           int nN, char* smem) {
  const int tid = opaque_tid(), lane = tid & 63, wid = tid >> 6, wm = wid >> 1, wn = wid & 1;
  const int nM = M_TOT / 128;
  const int ntiles = nM * nN;
  const int nk = K / G_BK;
  const int lrow = tid >> 2, lkc = tid & 3;
  for (int tile = BID, nb_ = NBLK; tile < ntiles; tile += nb_) {
    constexpr int GM = 32;
    int grp = tile / (GM * nN);
    int first_m = grp * GM;
    int gsz = min(GM, nM - first_m);
    int rem = tile - grp * GM * nN;
    int pm = first_m + rem % gsz, pn = rem / gsz;
    const u16* gA = A_TILED ? A + (long)pm * (K >> 5) * 4096 + lrow * 32 + lkc * 8
                            : A + (long)(pm * 128 + lrow) * lda + lkc * 8;
    const u16* gB = Bt + (long)pn * (K >> 5) * 4096 + lrow * 32 + lkc * 8;
    f32x16 acc[2][2];
#pragma unroll
    for (int i = 0; i < 2; ++i)
#pragma unroll
      for (int j = 0; j < 2; ++j)
#pragma unroll
        for (int r = 0; r < 16; ++r) acc[i][j][r] = 0.f;
    uint4 xa0, xa1, xb0, xb1, ya0, ya1, yb0, yb1, za0, za1, zb0, zb1;
#define G_LOAD(S, KT)                                                  \
  {                                                                    \
    S##a0 = *(const uint4*)(A_TILED ? gA + (long)(KT) * 4096 : gA + (KT) * G_BK);                          \
    S##a1 = *(const uint4*)(A_TILED ? gA + (long)(KT) * 4096 + 2048 : gA + (long)64 * lda + (KT) * G_BK);  \
    S##b0 = *(const uint4*)(gB + (long)(KT) * 4096);                   \
    S##b1 = *(const uint4*)(gB + (long)(KT) * 4096 + 2048);            \
  }
#define G_STORE(S, BUF)                                                \
  {                                                                    \
    char* dA = smem + (BUF) * 2 * G_OPER_BYTES;                        \
    char* dB = dA + G_OPER_BYTES;                                      \
    *(uint4*)(dA + lrow * G_LDS_ROW + lkc * 16) = S##a0;               \
    *(uint4*)(dA + (lrow + 64) * G_LDS_ROW + lkc * 16) = S##a1;        \
    *(uint4*)(dB + lrow * G_LDS_ROW + lkc * 16) = S##b0;               \
    *(uint4*)(dB + (lrow + 64) * G_LDS_ROW + lkc * 16) = S##b1;        \
  }
#define G_READ(BUF, KS, AF, BF)                                                                  \
  {                                                                                              \
    const char* sA = smem + (BUF) * 2 * G_OPER_BYTES;                                            \
    const char* sB = sA + G_OPER_BYTES;                                                          \
    const int koff = ((KS) * 16 + (lane >> 5) * 8) * 2;                                          \
    _Pragma("unroll") for (int i = 0; i < 2; ++i)                                                \
      AF[i] = *(const bf16x8*)(sA + (wm * 64 + i * 32 + (lane & 31)) * G_LDS_ROW + koff);        \
    _Pragma("unroll") for (int j = 0; j < 2; ++j)                                                \
      BF[j] = *(const bf16x8*)(sB + (wn * 64 + j * 32 + (lane & 31)) * G_LDS_ROW + koff);        \
  }
#define G_MMA(AF, BF)                                                                            \
  {                                                                                              \
    __builtin_amdgcn_s_setprio(1);                                                               \
    _Pragma("unroll") for (int i = 0; i < 2; ++i)                                                \
      _Pragma("unroll") for (int j = 0; j < 2; ++j)                                              \
        acc[i][j] = __builtin_amdgcn_mfma_f32_32x32x16_bf16(AF[i], BF[j], acc[i][j], 0, 0, 0);   \
    __builtin_amdgcn_s_setprio(0);                                                               \
  }
    G_LOAD(x, 0);
    G_LOAD(y, 1);
    G_LOAD(z, 2);
    __builtin_amdgcn_sched_barrier(0);
    __syncthreads();
    G_STORE(x, 0);
    __syncthreads();
#define G_STEP(T, SNEXT, SFREE, BUF)                          \
    if ((T) < nk) {                                           \
      bf16x8 af0[2], bf0[2];                                  \
      G_READ(BUF, 0, af0, bf0);                               \
      __builtin_amdgcn_sched_barrier(0);                      \
      if ((T) + 1 < nk) G_STORE(SNEXT, (BUF) ^ 1);            \
      if ((T) + 3 < nk) G_LOAD(SFREE, (T) + 3);               \
      __builtin_amdgcn_sched_barrier(0);                      \
      G_MMA(af0, bf0);                                        \
      G_READ(BUF, 1, af0, bf0);                               \
      G_MMA(af0, bf0);                                        \
      __builtin_amdgcn_sched_barrier(0);                      \
      __syncthreads();                                        \
    }
    for (int kt = 0; kt < nk; kt += 6) {
      G_STEP(kt + 0, y, x, 0);
      G_STEP(kt + 1, z, y, 1);
      G_STEP(kt + 2, x, z, 0);
      G_STEP(kt + 3, y, x, 1);
      G_STEP(kt + 4, z, y, 0);
      G_STEP(kt + 5, x, z, 1);
    }
#undef G_STEP
#undef G_LOAD
#undef G_STORE
#undef G_READ
#undef G_MMA
    int te = tid;
    asm volatile("" : "+v"(te));
    const int lane_e = te & 63, wm_e = te >> 7, wn_e = (te >> 6) & 1;
    const int lr0 = wm_e * 64 + 4 * (lane_e >> 5);
    const int lc0 = wn_e * 64 + (lane_e & 31);
    if (MODE == 1) {
      u16* ST = (u16*)smem;
#pragma unroll
      for (int i = 0; i < 2; ++i)
#pragma unroll
        for (int r = 0; r < 16; ++r) {
          const int lr = lr0 + i * 32 + (r & 3) + 8 * (r >> 2);
          const float rs = (p.FB + FOFF_RS)[pm * 128 + lr];
#pragma unroll
          for (int j = 0; j < 2; ++j) ST[lr * 136 + lc0 + j * 32] = f2bf(acc[i][j][r] * rs);
        }
      __syncthreads();
      const int col0 = pn * 128;
      const int bnd_j = (col0 >= C_R && col0 < C_GG) ? (col0 - C_R) : ((col0 >= C_K && col0 < C_Q) ? (col0 - C_K + 512) : -1);
      const bool bc = (col0 >= C_XBC && col0 < C_XBC + 1024);
#pragma unroll
      for (int q = 0; q < 8; ++q) {
        const int c = te + 256 * q, crow = c >> 4, cc = (c & 15) * 8;
        const uint4 v = *(const uint4*)(ST + crow * 136 + cc);
        const int row = pm * 128 + crow;
        *(uint4*)(p.PROJ + (long)row * LDP + col0 + cc) = v;
        if (bnd_j >= 0 && (crow & 15) == 15) *(uint4*)(p.BND + (long)(row >> 4) * 1792 + bnd_j + cc) = v;
        if (bc && (crow & 15) >= 13)
          *(uint4*)(p.BND2 + ((long)(row >> 4) * 3 + ((crow & 15) - 13)) * 1024 + (col0 - C_XBC) + cc) = v;
      }
    } else if (MODE == 2) {
      float* SF = (float*)smem;
#pragma unroll
      for (int i = 0; i < 2; ++i) {
        if (i) __syncthreads();
#pragma unroll
        for (int r = 0; r < 16; ++r) {
          const int l2 = wm_e * 32 + (r & 3) + 8 * (r >> 2) + 4 * (lane_e >> 5);
#pragma unroll
          for (int j = 0; j < 2; ++j) SF[l2 * 132 + lc0 + j * 32] = acc[i][j][r];
        }
        __syncthreads();
#pragma unroll
        for (int q = 0; q < 4; ++q) {
          const int c = te + 256 * q, l2 = c >> 4, cc = (c & 15) * 8;
          const int row = pm * 128 + (l2 >> 5) * 64 + i * 32 + (l2 & 31);
          float d[8], x[8];
          ld8(SF + l2 * 132 + cc, d);
          u16* px = p.XB + xb_off(row, pn * 128 + cc);
          unpack8(*(const uint4*)px, x);
#pragma unroll
          for (int e = 0; e < 8; ++e) x[e] += d[e];
          const uint4 xp = pack8(x);
          *(uint4*)px = xp;
          if (ACC_SS) {
            float xr[8];
            unpack8(xp, xr);
            float ss = 0.f;
#pragma unroll
            for (int e = 0; e < 8; ++e) ss += xr[e] * xr[e];
            ss = sum16(ss);
            if ((te & 15) == 0) atomicAdd((p.FB + FOFF_SS) + row, ss);
          }
        }
      }
    } else {
      u16* ST = (u16*)smem;
      u16* ACT = p.PROJ;
#pragma unroll
      for (int i = 0; i < 2; ++i)
#pragma unroll
        for (int r = 0; r < 16; ++r) {
          const int lr = lr0 + i * 32 + (r & 3) + 8 * (r >> 2);
          const float rs = rsqrtf((p.FB + FOFF_SS)[pm * 128 + lr] * (1.f / 1024.f) + 1e-6f);
          const float g = acc[i][0][r] * rs, u = acc[i][1][r] * rs;
          ST[lr * 72 + wn_e * 32 + (lane_e & 31)] = f2bf(siluf_(g) * u);
        }
      __syncthreads();
#pragma unroll
      for (int q = 0; q < 4; ++q) {
        const int c = te + 256 * q, crow = c >> 3, cc = (c & 7) * 8;
        const uint4 v = *(const uint4*)(ST + crow * 72 + cc);
        *(uint4*)(ACT + wtile_off(pm * 128 + crow, pn * 64 + cc, D_FF)) = v;
      }
    }
  }
}

__device__ __forceinline__ void phase_pre(const Params& p, int l, float* smem) {
  u16* XWb = (u16*)smem;
  u16* XAb = (u16*)smem + 16 * 72;
  constexpr int LDW = 260;
  float* AW = smem + 1152;
  float* AA = smem + 1152 + 16 * LDW;
  const float* mu = p.rw_mu + l * 1792;
  for (int blk = BID, nb_ = NBLK; blk < NBLK16; blk += nb_) {
    const int tid = opaque_tid(), lane = tid & 63, wid = tid >> 6;
    const int T = tid >> 4, Q = tid & 15;
    const int m0 = blk * 16;
    const long m = m0 + T;
    int s, t0;
    if (m0 < M_PROMPT) { s = m0 / T_P; t0 = m0 - s * T_P; } else { s = 8 + (m0 - M_PROMPT) / 64; t0 = (m0 - M_PROMPT) & 63; }
    const bool first = (t0 == 0);
    u16* row = p.PROJ + m * LDP;
    const u16* bndrow = p.BND + (long)(blk > 0 ? blk - 1 : 0) * 1792;
    const float* shrow = p.state_shift + ((long)l * 8 + (s >= 8 ? s - 8 : 0)) * 1792;
    const bool seqstart = first && (T == 0);
#define SHIFT8(DST, J, COL)                                                                 \
    {                                                                                       \
      float cur_[8], pv_[8], mj_[8];                                                        \
      unpack8(*(const uint4*)(row + (COL)), cur_);                                          \
      const u16* ps_ = (T > 0) ? (row - LDP + (COL)) : (bndrow + (J));                      \
      unpack8(*(const uint4*)ps_, pv_);                                                     \
      if (seqstart) {                                                                       \
        if (s >= 8) ld8(shrow + (J), pv_);                                                  \
        else { _Pragma("unroll") for (int e = 0; e < 8; ++e) pv_[e] = 0.f; }                \
      }                                                                                     \
      ld8(mu + (J), mj_);                                                                   \
      _Pragma("unroll") for (int e = 0; e < 8; ++e) DST[e] = cur_[e] + (pv_[e] - cur_[e]) * mj_[e]; \
    }
    __syncthreads();
    {
      float sh0[8], sh1[8];
      SHIFT8(sh0, 1536 + Q * 8, C_XW + Q * 8);
      SHIFT8(sh1, 1664 + Q * 8, C_XG + Q * 8);
      __syncthreads();
      if (Q < 8) {
#pragma unroll
        for (int e = 0; e < 8; ++e) sh0[e] = tanhf_(sh0[e]);
        *(uint4*)(XWb + T * 72 + Q * 8) = pack8(sh0);
      } else {
        *(uint4*)(XAb + T * 72 + (Q - 8) * 8) = pack8(sh0);
      }
#pragma unroll
      for (int e = 0; e < 8; ++e) sh1[e] = sigmoidf_(sh1[e]);
      *(uint4*)(row + C_XG + Q * 8) = pack8(sh1);
    }
    __syncthreads();
#pragma unroll 1
    for (int c = 0; c < 2; ++c) {
      {
        bf16x8 axw[2], axa[2];
#pragma unroll
        for (int ks = 0; ks < 2; ++ks) {
          axw[ks] = *(const bf16x8*)(XWb + (lane & 15) * 72 + ks * 32 + (lane >> 4) * 8);
          axa[ks] = *(const bf16x8*)(XAb + (lane & 15) * 72 + ks * 32 + (lane >> 4) * 8);
        }
#pragma unroll
        for (int nt = 0; nt < 4; ++nt) {
          const int ncol = (wid * 4 + nt) * 16 + (lane & 15);
          const int n = c * 256 + ncol;
          f32x4v accw = {0.f, 0.f, 0.f, 0.f}, acca = {0.f, 0.f, 0.f, 0.f};
#pragma unroll
          for (int ks = 0; ks < 2; ++ks) {
            bf16x8 bw = *(const bf16x8*)((p.WB + OFF_W2T) + n * 64 + ks * 32 + (lane >> 4) * 8);
            bf16x8 ba = *(const bf16x8*)((p.WB + OFF_A2T) + n * 64 + ks * 32 + (lane >> 4) * 8);
            accw = __builtin_amdgcn_mfma_f32_16x16x32_bf16(axw[ks], bw, accw, 0, 0, 0);
            acca = __builtin_amdgcn_mfma_f32_16x16x32_bf16(axa[ks], ba, acca, 0, 0, 0);
          }
#pragma unroll
          for (int r = 0; r < 4; ++r) {
            AW[((lane >> 4) * 4 + r) * LDW + ncol] = accw[r];
            AA[((lane >> 4) * 4 + r) * LDW + ncol] = acca[r];
          }
        }
      }
#pragma unroll 1
      for (int jj = 0; jj < 2; ++jj) {
        const int ch0 = c * 256 + jj * 128 + Q * 8;
        const int head = c * 4 + jj * 2 + (Q >> 3);
        float rt[8], kt[8];
        uint4 vpk;
        SHIFT8(rt, ch0, C_R + ch0);
        SHIFT8(kt, 512 + ch0, C_K + ch0);
        {
          float vt[8];
          SHIFT8(vt, 1024 + ch0, C_V + ch0);
          vpk = pack8(vt);
        }
        __syncthreads();
        float aw[8], aa[8], w0[8], a0[8];
        ld8(AW + T * LDW + jj * 128 + Q * 8, aw);
        ld8(AA + T * LDW + jj * 128 + Q * 8, aa);
        ld8(p.rw_w0 + l * 512 + ch0, w0);
        ld8(p.rw_a0 + l * 512 + ch0, a0);
        {
          float uu[8];
#pragma unroll
          for (int e = 0; e < 8; ++e) {
            float lw = -softplusf_(-(w0[e] + aw[e])) - 0.5f;
            uu[e] = -__expf(lw);
            aa[e] = sigmoidf_(a0[e] + aa[e]);
          }
          *(uint4*)(p.RWX + m * 1536 + ch0) = pack8(uu);
        }
        *(uint4*)(row + C_R + ch0) = pack8(rt);
        *(uint4*)(row + C_V + ch0) = vpk;
        float kkw[8], kaw[8], rkw[8], kk[8], kp[8];
        ld8(p.rw_kk + l * 512 + ch0, kkw);
        ld8(p.rw_ka + l * 512 + ch0, kaw);
        ld8(p.rw_rk + l * 512 + ch0, rkw);
        float ssq = 0.f, rks = 0.f;
#pragma unroll
        for (int e = 0; e < 8; ++e) {
          kk[e] = kt[e] * kkw[e];
          ssq += kk[e] * kk[e];
          kp[e] = kt[e] * (1.f + (aa[e] - 1.f) * kaw[e]);
          rks += rt[e] * kp[e] * rkw[e];
        }
        ssq = sum8(ssq);
        rks = sum8(rks);
        const float rn = rsqrtf(ssq + 1e-12f);
        *(uint4*)(row + C_K + ch0) = pack8(kp);
#pragma unroll
        for (int e = 0; e < 8; ++e) kk[e] *= rn;
        *(uint4*)(p.RWX + m * 1536 + 512 + ch0) = pack8(kk);
#pragma unroll
        for (int e = 0; e < 8; ++e) kk[e] *= aa[e];
        *(uint4*)(p.RWX + m * 1536 + 1024 + ch0) = pack8(kk);
        if ((Q & 7) == 0) (p.FB + FOFF_RKS)[m * 8 + head] = rks;
      }
      __syncthreads();
    }
    {
      u16* CB = (u16*)(smem + 1152);
      const u16* b2row = p.BND2 + (long)(blk > 0 ? blk - 1 : 0) * 3072;
      const float* scrow = p.state_conv + ((long)l * 8 + (s >= 8 ? s - 8 : 0)) * 3072;
#pragma unroll 1
      for (int j = 0; j < 8; ++j) {
        const int cc0 = j * 128 + Q * 8;
        const float* cw = p.conv_w + (long)l * 4096 + cc0;
        float acc[8];
        ld8(p.conv_b + l * 1024 + cc0, acc);
#pragma unroll
        for (int d = 0; d < 4; ++d) {
          const int tr = T - 3 + d;
          const int trn = tr < 0 ? 3 + tr : 0;
          float u[8], w[8];
          const u16* src = (tr >= 0) ? (row + (long)(d - 3) * LDP + C_XBC + cc0) : (b2row + trn * 1024 + cc0);
          unpack8(*(const uint4*)src, u);
          if (first && tr < 0) {
            if (s >= 8) ld8(scrow + trn * 1024 + cc0, u);
            else {
#pragma unroll
              for (int e = 0; e < 8; ++e) u[e] = 0.f;
            }
          }
          ld8(cw + d * 1024, w);
#pragma unroll
          for (int e = 0; e < 8; ++e) acc[e] += w[e] * u[e];
        }
#pragma unroll
        for (int e = 0; e < 8; ++e) acc[e] = siluf_(acc[e]);
        *(uint4*)(CB + T * 1024 + cc0) = pack8(acc);
      }
      __syncthreads();
#pragma unroll
      for (int j = 0; j < 8; ++j)
        *(uint4*)(row + C_XBC + j * 128 + Q * 8) = *(const uint4*)(CB + T * 1024 + j * 128 + Q * 8);
    }
#undef SHIFT8
    if (t0 + 16 == seq_len(s)) {
      float* o = p.out + (s < 8 ? O_PSHIFT + ((long)l * 8 + s) * 1792 : O_SSHIFT + ((long)l * 8 + (s - 8)) * 1792);
      for (int j = tid; j < 1792; j += 256) o[j] = bf2f(p.BND[(long)blk * 1792 + j]);
    }
  }
}

__device__ __forceinline__ void scan_rwkv(const Params& p, int l, int s, int h, int q, float* smem) {
  const int tid = opaque_tid(), lane = tid & 63, wid = tid >> 6;
  float* R_ = smem;
  float* W_ = smem + 1024;
  float* K_ = smem + 2048;
  float* A_ = smem + 3072;
  float* B_ = smem + 4096;
  float* V_ = smem + 5120;
  float* O_ = smem + 5376;
  const int rl = wid * 4 + (lane >> 4);
  const int row = q * 16 + rl;
  const int ksl = (lane & 15) * 4;
  const int base = seq_base(s), T = seq_len(s);
  float s0 = 0.f, s1 = 0.f, s2 = 0.f, s3 = 0.f;
  if (s >= 8) {
    const float* st = p.state_rwkv + (((long)l * 8 + (s - 8)) * 8 + h) * 4096 + row * 64 + ksl;
    float4 v = *(const float4*)st;
    s0 = v.x; s1 = v.y; s2 = v.z; s3 = v.w;
  }
  const int stt = tid >> 4, skq = (tid & 15) * 4;
  const int nblk = T / 16;
  ushort4 r4, k4, u4, a4, b4;
  u16 vv;
  {
    const long m = base + stt;
    const u16* pr = p.PROJ + m * LDP;
    const u16* px = p.RWX + m * 1536;
    r4 = *(const ushort4*)(pr + C_R + h * 64 + skq);
    k4 = *(const ushort4*)(pr + C_K + h * 64 + skq);
    u4 = *(const ushort4*)(px + h * 64 + skq);
    a4 = *(const ushort4*)(px + 512 + h * 64 + skq);
    b4 = *(const ushort4*)(px + 1024 + h * 64 + skq);
    vv = pr[C_V + h * 64 + q * 16 + (tid & 15)];
  }
  __syncthreads();
  float* TR_ = smem + 5376 + 512;
  const bool wr = (lane & 15) == 0;
  const int ooff = wr ? rl : (512 + lane);
  const int ostr = wr ? 16 : 0;
  for (int blk = 0; blk < nblk; ++blk) {
    const long m = base + blk * 16 + stt;
    float* Oc = O_ + (blk & 1) * 256;
    {
      *(float4*)(R_ + stt * 64 + skq) = make_float4(bf2f(r4.x), bf2f(r4.y), bf2f(r4.z), bf2f(r4.w));
      *(float4*)(K_ + stt * 64 + skq) = make_float4(bf2f(k4.x), bf2f(k4.y), bf2f(k4.z), bf2f(k4.w));
      *(float4*)(W_ + stt * 64 + skq) =
          make_float4(__expf(bf2f(u4.x)), __expf(bf2f(u4.y)), __expf(bf2f(u4.z)), __expf(bf2f(u4.w)));
      *(float4*)(A_ + stt * 64 + skq) = make_float4(-bf2f(a4.x), -bf2f(a4.y), -bf2f(a4.z), -bf2f(a4.w));
      *(float4*)(B_ + stt * 64 + skq) = make_float4(bf2f(b4.x), bf2f(b4.y), bf2f(b4.z), bf2f(b4.w));
      V_[stt * 16 + (tid & 15)] = bf2f(vv);
    }
    __syncthreads();
    if (blk > 0)
      p.ORW[(m - 16) * 512 + h * 64 + q * 16 + (tid & 15)] = f2bf(O_[((blk - 1) & 1) * 256 + stt * 16 + (tid & 15)]);
    if (blk + 1 < nblk) {
      const u16* pr = p.PROJ + (m + 16) * LDP;
      const u16* px = p.RWX + (m + 16) * 1536;
      r4 = *(const ushort4*)(pr + C_R + h * 64 + skq);
      k4 = *(const ushort4*)(pr + C_K + h * 64 + skq);
      u4 = *(const ushort4*)(px + h * 64 + skq);
      a4 = *(const ushort4*)(px + 512 + h * 64 + skq);
      b4 = *(const ushort4*)(px + 1024 + h * 64 + skq);
      vv = pr[C_V + h * 64 + q * 16 + (tid & 15)];
    }
    __builtin_amdgcn_sched_barrier(0);
    {
      float4 a = *(const float4*)(A_ + ksl), w = *(const float4*)(W_ + ksl), b = *(const float4*)(B_ + ksl);
      float4 k = *(const float4*)(K_ + ksl), r = *(const float4*)(R_ + ksl);
      float v = V_[rl];
      float opart = 0.f;
#pragma unroll
      for (int tt = 0; tt < 16; ++tt) {
        float4 an, wn, bn, kn, rn;
        float vn;
        if (tt + 1 < 16) {
          an = *(const float4*)(A_ + (tt + 1) * 64 + ksl); wn = *(const float4*)(W_ + (tt + 1) * 64 + ksl);
          bn = *(const float4*)(B_ + (tt + 1) * 64 + ksl); kn = *(const float4*)(K_ + (tt + 1) * 64 + ksl);
          rn = *(const float4*)(R_ + (tt + 1) * 64 + ksl); vn = V_[(tt + 1) * 16 + rl];
        }
        __builtin_amdgcn_sched_barrier(0);
        float sa = fmaf(s0, a.x, fmaf(s1, a.y, fmaf(s2, a.z, s3 * a.w)));
        if (tt > 0) { sum16x2(sa, opart); Oc[ooff + (tt - 1) * ostr] = opart; }
        else sa = sum16(sa);
        s0 = fmaf(s0, w.x, fmaf(sa, b.x, v * k.x)); NOPK(s0);
        s1 = fmaf(s1, w.y, fmaf(sa, b.y, v * k.y)); NOPK(s1);
        s2 = fmaf(s2, w.z, fmaf(sa, b.z, v * k.z)); NOPK(s2);
        s3 = fmaf(s3, w.w, fmaf(sa, b.w, v * k.w)); NOPK(s3);
        opart = fmaf(s0, r.x, fmaf(s1, r.y, fmaf(s2, r.z, s3 * r.w)));
        if (tt == 15) { opart = sum16(opart); Oc[ooff + 15 * ostr] = opart; }
        __builtin_amdgcn_sched_barrier(0);
        if (tt + 1 < 16) { a = an; w = wn; b = bn; k = kn; r = rn; v = vn; }
      }
    }
    __builtin_amdgcn_sched_barrier(0);
    __syncthreads();
  }
  {
    const long m = base + (nblk - 1) * 16 + stt;
    p.ORW[m * 512 + h * 64 + q * 16 + (tid & 15)] = f2bf(O_[((nblk - 1) & 1) * 256 + stt * 16 + (tid & 15)]);
  }
  __syncthreads();
  {
    float* o = p.out + (s < 8 ? O_PRWKV + (((long)l * 8 + s) * 8 + h) * 4096
                              : O_SRWKV + (((long)l * 8 + (s - 8)) * 8 + h) * 4096);
    *(float4*)(o + row * 64 + ksl) = make_float4(s0, s1, s2, s3);
  }
}

__device__ __forceinline__ void scan_hgrn(const Params& p, int l, int s, int h, int q, float* smem) {
  const int tid = opaque_tid(), lane = tid & 63, wid = tid >> 6;
  float* Q_ = smem;
  float* F_ = smem + 2048;
  float* G_ = smem + 4096;
  float* I_ = smem + 6144;
  float* O_ = smem + 6400;
  const int rl = wid * 4 + (lane >> 4);
  const int row = q * 16 + rl;
  const int ksl4 = (lane & 15) * 4;
  const int base = seq_base(s), T = seq_len(s);
  float st[8];
#pragma unroll
  for (int i = 0; i < 8; ++i) st[i] = 0.f;
  if (s >= 8) {
    const float* sp = p.state_hgrn + (((long)l * 8 + (s - 8)) * 4 + h) * 16384;
#pragma unroll
    for (int i = 0; i < 8; ++i) st[i] = sp[((i >> 2) * 64 + ksl4 + (i & 3)) * 128 + row];
  }
  const int stt = tid >> 4, skq = (tid & 15) * 8;
  float lb[8];
#pragma unroll
  for (int i = 0; i < 8; ++i) {
    if (l == 0) lb[i] = 0.f;
    else {
      float x0 = p.hg_lb[h * 128 + skq + i], x1 = p.hg_lb[512 + h * 128 + skq + i];
      lb[i] = frcp_(1.f + __expf(x0 - x1));
    }
  }
  const int nblk = T / 16;
  uint4 q8, f8;
  u16 iv16;
  {
    const u16* pr = p.PROJ + (long)(base + stt) * LDP;
    q8 = *(const uint4*)(pr + C_Q + h * 128 + skq);
    f8 = *(const uint4*)(pr + C_F + h * 128 + skq);
    iv16 = pr[C_I + h * 128 + q * 16 + (tid & 15)];
  }
  __syncthreads();
  float* TR_ = smem + 6400 + 512;
  const bool wr = (lane & 15) == 0;
  const int ooff = wr ? rl : (512 + lane);
  const int ostr = wr ? 16 : 0;
  const bool wr4 = (lane & 15) < 4;
  const int ooff4 = wr4 ? (rl + (lane & 3) * 16) : (512 + lane);
  const int ostr4 = wr4 ? 16 : 0;
  for (int blk = 0; blk < nblk; ++blk) {
    const long m = base + blk * 16 + stt;
    float* Oc = O_ + (blk & 1) * 256;
    {
      unsigned qw[4] = {q8.x, q8.y, q8.z, q8.w}, fw[4] = {f8.x, f8.y, f8.z, f8.w};
      float qv[8], fv[8];
#pragma unroll
      for (int e = 0; e < 8; ++e) {
        qv[e] = bf2f((u16)((qw[e >> 1] >> ((e & 1) * 16)) & 0xffff));
        float fz = bf2f((u16)((fw[e >> 1] >> ((e & 1) * 16)) & 0xffff));
        float ex = __expf(-fz);
        float sg = frcp_(1.f + ex);
        fv[e] = lb[e] + (1.f - lb[e]) * sg;
      }
      *(float4*)(Q_ + stt * 128 + skq) = make_float4(qv[0], qv[1], qv[2], qv[3]);
      *(float4*)(Q_ + stt * 128 + skq + 4) = make_float4(qv[4], qv[5], qv[6], qv[7]);
      *(float4*)(F_ + stt * 128 + skq) = make_float4(fv[0], fv[1], fv[2], fv[3]);
      *(float4*)(F_ + stt * 128 + skq + 4) = make_float4(fv[4], fv[5], fv[6], fv[7]);
      I_[stt * 16 + (tid & 15)] = bf2f(iv16);
    }
    __syncthreads();
    if (blk > 0) {
      u16* dp = p.PROJ + (m - 16) * LDP + C_I + h * 128 + q * 16 + (tid & 15);
      *dp = f2bf(O_[((blk - 1) & 1) * 256 + stt * 16 + (tid & 15)]);
    }
    if (blk + 1 < nblk) {
      const u16* pr = p.PROJ + (m + 16) * LDP;
      q8 = *(const uint4*)(pr + C_Q + h * 128 + skq);
      f8 = *(const uint4*)(pr + C_F + h * 128 + skq);
      iv16 = pr[C_I + h * 128 + q * 16 + (tid & 15)];
    }
    __builtin_amdgcn_sched_barrier(0);
    {
      float4 f0 = *(const float4*)(F_ + ksl4), f1 = *(const float4*)(F_ + 64 + ksl4);
      float4 q0 = *(const float4*)(Q_ + ksl4), q1 = *(const float4*)(Q_ + 64 + ksl4);
      float iv = I_[rl];
      float op4[4] = {0.f, 0.f, 0.f, 0.f};
#pragma unroll
      for (int tt = 0; tt < 16; ++tt) {
        float4 f0n, f1n, q0n, q1n;
        float ivn;
        if (tt + 1 < 16) {
          const int o_ = (tt + 1) * 128;
          f0n = *(const float4*)(F_ + o_ + ksl4); f1n = *(const float4*)(F_ + o_ + 64 + ksl4);
          q0n = *(const float4*)(Q_ + o_ + ksl4); q1n = *(const float4*)(Q_ + o_ + 64 + ksl4);
          ivn = I_[(tt + 1) * 16 + rl];
        }
        __builtin_amdgcn_sched_barrier(0);
        st[0] = fmaf(st[0] - iv, f0.x, iv); NOPK(st[0]);
        st[1] = fmaf(st[1] - iv, f0.y, iv); NOPK(st[1]);
        st[2] = fmaf(st[2] - iv, f0.z, iv); NOPK(st[2]);
        st[3] = fmaf(st[3] - iv, f0.w, iv); NOPK(st[3]);
        st[4] = fmaf(st[4] - iv, f1.x, iv); NOPK(st[4]);
        st[5] = fmaf(st[5] - iv, f1.y, iv); NOPK(st[5]);
        st[6] = fmaf(st[6] - iv, f1.z, iv); NOPK(st[6]);
        st[7] = fmaf(st[7] - iv, f1.w, iv); NOPK(st[7]);
        float acc0 = fmaf(st[0], q0.x, fmaf(st[1], q0.y, fmaf(st[2], q0.z, st[3] * q0.w)));
        float acc1 = fmaf(st[4], q1.x, fmaf(st[5], q1.y, fmaf(st[6], q1.z, st[7] * q1.w)));
        op4[tt & 3] = acc0 + acc1;
        if ((tt & 3) == 3) {
          const float r4 = reduce4x16(op4[0], op4[1], op4[2], op4[3], lane);
          Oc[ooff4 + (tt - 3) * ostr4] = r4;
        }
        __builtin_amdgcn_sched_barrier(0);
        if (tt + 1 < 16) { f0 = f0n; f1 = f1n; q0 = q0n; q1 = q1n; iv = ivn; }
      }
    }
    __builtin_amdgcn_sched_barrier(0);
    __syncthreads();
  }
  {
    const long m = base + (nblk - 1) * 16 + stt;
    u16* dp = p.PROJ + m * LDP + C_I + h * 128 + q * 16 + (tid & 15);
    *dp = f2bf(O_[((nblk - 1) & 1) * 256 + stt * 16 + (tid & 15)]);
  }
  __syncthreads();
  {
    float* o = p.out + (s < 8 ? O_PHGRN + (((long)l * 8 + s) * 4 + h) * 16384
                              : O_SHGRN + (((long)l * 8 + (s - 8)) * 4 + h) * 16384);
#pragma unroll
    for (int i = 0; i < 8; ++i) o[((i >> 2) * 64 + ksl4 + (i & 3)) * 128 + row] = st[i];
  }
}

__device__ __forceinline__ void scan_ssd(const Params& p, int l, int s, int h, int q, float* smem) {
  const int tid = opaque_tid(), lane = tid & 63, wid = tid >> 6;
  float* B_ = smem;
  float* C_ = smem + 2048;
  float2* X2_ = (float2*)(smem + 5248);
  float* O_ = smem + 4352;
  float* DT_ = smem + 5200;
  float* DE_ = smem + 5216;
  const int rl = wid * 4 + (lane >> 4);
  const int row = q * 16 + rl;
  const int ksl4 = (lane & 15) * 4;
  const int g = h >> 2;
  const int base = seq_base(s), T = seq_len(s);
  float st[8];
#pragma unroll
  for (int i = 0; i < 8; ++i) st[i] = 0.f;
  if (s >= 8) {
    const float* sp = p.state_ssm + (((long)l * 8 + (s - 8)) * 8 + h) * 8192 + row * 128 + ksl4;
    float4 a = *(const float4*)sp, b = *(const float4*)(sp + 64);
    st[0] = a.x; st[1] = a.y; st[2] = a.z; st[3] = a.w; st[4] = b.x; st[5] = b.y; st[6] = b.z; st[7] = b.w;
  }
  const float* cw = p.conv_w + (long)l * 4 * 1024;
  const int skq8 = (tid & 15) * 8;
  const int xc_x = h * 64 + q * 16 + (tid & 15);
  const float dtb = p.dt_bias[l * 8 + h];
  const float aexp = __expf(p.a_log[l * 8 + h]);
  const float dsk = p.d_skip[l * 8 + h];
  const int stt = tid >> 4;
  const int nblk = T / 16;
  uint4 rawb, rawc;
  u16 xraw = 0;
  float dtr = 0.f;
  u16 zc = 0, zn = 0;
#define SSD_LOAD(M0)                                                              \
  {                                                                               \
    {                                                                             \
      const u16* prow = p.PROJ + ((long)(M0) + stt) * LDP + C_XBC + g * 128 + skq8; \
      rawb = *(const uint4*)(prow + 512);                                         \
      rawc = *(const uint4*)(prow + 768);                                         \
    }                                                                             \
    xraw = p.PROJ[((long)(M0) + stt) * LDP + C_XBC + xc_x];                     \
    dtr = (p.FB + FOFF_DTRAW)[((long)(M0) + stt) * 8 + h];                                    \
    zn = p.PROJ[((long)(M0) + stt) * LDP + C_Z + h * 64 + q * 16 + (tid & 15)];   \
  }
  SSD_LOAD(base);
  __syncthreads();
  const bool wr = (lane & 15) == 0;
  const int ooff = wr ? rl : (512 + lane);
  const int ostr = wr ? 16 : 0;
  const bool wr4 = (lane & 15) < 4;
  const int ooff4 = wr4 ? (rl + (lane & 3) * 16) : (512 + lane);
  const int ostr4 = wr4 ? 16 : 0;
  u16 zp = 0;
  for (int blk = 0; blk < nblk; ++blk) {
    const long m0 = base + blk * 16;
    zp = zc;
    zc = zn;
    float* Oc = O_ + (blk & 1) * 256;
    {
      {
        const unsigned bw[4] = {rawb.x, rawb.y, rawb.z, rawb.w}, cwd[4] = {rawc.x, rawc.y, rawc.z, rawc.w};
        float bv[8], cv[8];
#pragma unroll
        for (int e = 0; e < 8; ++e) {
          bv[e] = bf2f((u16)((bw[e >> 1] >> ((e & 1) * 16)) & 0xffff));
          cv[e] = bf2f((u16)((cwd[e >> 1] >> ((e & 1) * 16)) & 0xffff));
        }
        *(float4*)(B_ + stt * 128 + skq8) = make_float4(bv[0], bv[1], bv[2], bv[3]);
        *(float4*)(B_ + stt * 128 + skq8 + 4) = make_float4(bv[4], bv[5], bv[6], bv[7]);
        *(float4*)(C_ + stt * 128 + skq8) = make_float4(cv[0], cv[1], cv[2], cv[3]);
        *(float4*)(C_ + stt * 128 + skq8 + 4) = make_float4(cv[4], cv[5], cv[6], cv[7]);
      }
      {
        const float dtv = softplusf_(dtr + dtb);
        const float xv_ = bf2f(xraw);
        X2_[stt * 16 + (tid & 15)] = make_float2(xv_, xv_ * dtv);
        if ((tid & 15) == 0) DE_[stt] = __expf(-aexp * dtv);
      }
    }
    __syncthreads();
    if (blk > 0) {
      u16* pz = p.PROJ + (m0 - 16 + stt) * LDP + C_Z + h * 64 + q * 16 + (tid & 15);
      *pz = f2bf(O_[((blk - 1) & 1) * 256 + stt * 16 + (tid & 15)] * siluf_(bf2f(zp)));
    }
    if (blk + 1 < nblk) SSD_LOAD(m0 + 16);
    __builtin_amdgcn_sched_barrier(0);
    {
      float4 b0 = *(const float4*)(B_ + ksl4), b1 = *(const float4*)(B_ + 64 + ksl4);
      float4 c0 = *(const float4*)(C_ + ksl4), c1 = *(const float4*)(C_ + 64 + ksl4);
      float2 xx = X2_[rl];
      float de = DE_[0];
      float yp4[4] = {0.f, 0.f, 0.f, 0.f};
      const float dsk16 = dsk * (1.f / 16.f);
#pragma unroll
      for (int tt = 0; tt < 16; ++tt) {
        float4 b0n, b1n, c0n, c1n;
        float2 xxn;
        float den;
        if (tt + 1 < 16) {
          const int o_ = (tt + 1) * 128;
          b0n = *(const float4*)(B_ + o_ + ksl4); b1n = *(const float4*)(B_ + o_ + 64 + ksl4);
          c0n = *(const float4*)(C_ + o_ + ksl4); c1n = *(const float4*)(C_ + o_ + 64 + ksl4);
          xxn = X2_[(tt + 1) * 16 + rl]; den = DE_[tt + 1];
        }
        __builtin_amdgcn_sched_barrier(0);
        const float xv = xx.x, xd = xx.y;
        st[0] = fmaf(st[0], de, xd * b0.x); NOPK(st[0]);
        st[1] = fmaf(st[1], de, xd * b0.y); NOPK(st[1]);
        st[2] = fmaf(st[2], de, xd * b0.z); NOPK(st[2]);
        st[3] = fmaf(st[3], de, xd * b0.w); NOPK(st[3]);
        st[4] = fmaf(st[4], de, xd * b1.x); NOPK(st[4]);
        st[5] = fmaf(st[5], de, xd * b1.y); NOPK(st[5]);
        st[6] = fmaf(st[6], de, xd * b1.z); NOPK(st[6]);
        st[7] = fmaf(st[7], de, xd * b1.w); NOPK(st[7]);
        float acc0 = fmaf(st[0], c0.x, fmaf(st[1], c0.y, fmaf(st[2], c0.z, st[3] * c0.w)));
        float acc1 = fmaf(st[4], c1.x, fmaf(st[5], c1.y, fmaf(st[6], c1.z, st[7] * c1.w)));
        yp4[tt & 3] = fmaf(dsk16, xv, acc0 + acc1);
        if ((tt & 3) == 3) {
          const float r4 = reduce4x16(yp4[0], yp4[1], yp4[2], yp4[3], lane);
          Oc[ooff4 + (tt - 3) * ostr4] = r4;
        }
        __builtin_amdgcn_sched_barrier(0);
        if (tt + 1 < 16) { b0 = b0n; b1 = b1n; c0 = c0n; c1 = c1n; xx = xxn; de = den; }
      }
    }
    __builtin_amdgcn_sched_barrier(0);
    __syncthreads();
  }
  {
    const long m0 = base + (nblk - 1) * 16;
    u16* pz = p.PROJ + (m0 + stt) * LDP + C_Z + h * 64 + q * 16 + (tid & 15);
    *pz = f2bf(O_[((nblk - 1) & 1) * 256 + stt * 16 + (tid & 15)] * siluf_(bf2f(zc)));
  }
  __syncthreads();
#undef SSD_LOAD
  {
    float* o = p.out + (s < 8 ? O_PSSM + (((long)l * 8 + s) * 8 + h) * 8192
                              : O_SSSM + (((long)l * 8 + (s - 8)) * 8 + h) * 8192);
    *(float4*)(o + row * 128 + ksl4) = make_float4(st[0], st[1], st[2], st[3]);
    *(float4*)(o + row * 128 + 64 + ksl4) = make_float4(st[4], st[5], st[6], st[7]);
  }
  if (h == 0 && q == 0) {
    float* o = p.out + (s < 8 ? O_PCONV + ((long)l * 8 + s) * 3072 : O_SCONV + ((long)l * 8 + (s - 8)) * 3072);
    const long lastblk = (long)(base + T) / 16 - 1;
    for (int i = tid; i < 3072; i += 256) {
      int r = i >> 10, c = i & 1023;
      o[i] = bf2f(p.BND2[(lastblk * 3 + r) * 1024 + c]);
    }
  }
}

__device__ __forceinline__ void phase_scan(const Params& p, int l, float* smem) {
  for (int u = BID, nb_ = NBLK; u < 1536; u += nb_) {
    int sample = u >= 768;
    int v = sample ? u - 768 : u;
    int type = v % 3, w = v / 3;
    if (type == 0) {
      int q = w & 3, h = (w >> 2) & 7, b = w >> 5;
      scan_rwkv(p, l, b + 8 * sample, h, q, smem);
    } else if (type == 1) {
      int q = w & 7, h = (w >> 3) & 3, b = w >> 5;
      scan_hgrn(p, l, b + 8 * sample, h, q, smem);
    } else {
      int q = w & 3, h = (w >> 2) & 7, b = w >> 5;
      scan_ssd(p, l, b + 8 * sample, h, q, smem);
    }
  }
}

__device__ __forceinline__ void phase_post(const Params& p, int l, float* smem) {
  constexpr int LDG = 516;
  float* GA = smem;
  for (int blk = BID, nb_ = NBLK; blk < NBLK16; blk += nb_) {
    const int tid = opaque_tid(), lane = tid & 63, wid = tid >> 6;
    const int T = tid >> 4, Q = tid & 15;
    const long m0 = (long)blk * 16;
    const long m = m0 + T;
    if (tid < 16) (p.FB + FOFF_SS)[m0 + tid] = 0.f;
    __syncthreads();
    {
      bf16x8 ag[4];
      const u16* arow = p.PROJ + (m0 + (lane & 15)) * LDP + C_XG + (lane >> 4) * 8;
#pragma unroll
      for (int ks = 0; ks < 4; ++ks) ag[ks] = *(const bf16x8*)(arow + ks * 32);
#pragma unroll
      for (int nt = 0; nt < 8; ++nt) {
        const int n = (wid * 8 + nt) * 16 + (lane & 15);
        f32x4v acc = {0.f, 0.f, 0.f, 0.f};
#pragma unroll
        for (int ks = 0; ks < 4; ++ks) {
          bf16x8 bg = *(const bf16x8*)((p.WB + OFF_G2T) + n * 128 + ks * 32 + (lane >> 4) * 8);
          acc = __builtin_amdgcn_mfma_f32_16x16x32_bf16(ag[ks], bg, acc, 0, 0, 0);
        }
#pragma unroll
        for (int r = 0; r < 4; ++r) GA[((lane >> 4) * 4 + r) * LDG + n] = acc[r];
      }
    }
    __syncthreads();
    u16* row = p.PROJ + m * LDP;
#pragma unroll 1
    for (int g = 0; g < 2; ++g) {
      float y0[8], y1[8], w[8];
      const int c0 = g * 256 + Q * 8, c1 = c0 + 128;
      unpack8(*(const uint4*)(row + C_Z + c0), y0);
      unpack8(*(const uint4*)(row + C_Z + c1), y1);
      float ss = 0.f;
#pragma unroll
      for (int e = 0; e < 8; ++e) ss += y0[e] * y0[e] + y1[e] * y1[e];
      ss = sum16(ss);
      const float rs = rsqrtf(ss * (1.f / 256.f) + 1e-6f);
      ld8(p.ssd_norm_w + l * 512 + c0, w);
#pragma unroll
      for (int e = 0; e < 8; ++e) y0[e] = y0[e] * rs * w[e];
      ld8(p.ssd_norm_w + l * 512 + c1, w);
#pragma unroll
      for (int e = 0; e < 8; ++e) y1[e] = y1[e] * rs * w[e];
      *(uint4*)(row + C_Z + c0) = pack8(y0);
      *(uint4*)(row + C_Z + c1) = pack8(y1);
    }
#pragma unroll 1
    for (int j = 0; j < 4; ++j) {
      const int c0 = j * 128 + Q * 8;
      {
        float oh[8], gg[8], w[8];
        unpack8(*(const uint4*)(row + C_I + c0), oh);
        unpack8(*(const uint4*)(row + C_GG + c0), gg);
        float ss = 0.f;
#pragma unroll
        for (int e = 0; e < 8; ++e) ss += oh[e] * oh[e];
        ss = sum16(ss);
        const float rs = rsqrtf(ss * (1.f / 128.f) + 1e-6f);
        ld8(p.hg_norm_w + l * 512 + c0, w);
#pragma unroll
        for (int e = 0; e < 8; ++e) oh[e] = oh[e] * rs * w[e] * siluf_(gg[e]);
        *(uint4*)(row + C_GG + c0) = pack8(oh);
      }
      {
        float o[8], v[8], w[8], bb[8], ga[8];
        const int head = j * 2 + (Q >> 3);
        unpack8(*(const uint4*)(p.ORW + m * 512 + c0), o);
        unpack8(*(const uint4*)(row + C_V + c0), v);
        float sm = 0.f;
#pragma unroll
        for (int e = 0; e < 8; ++e) sm += o[e];
        const float mean = sum8(sm) * (1.f / 64.f);
        float sv = 0.f;
#pragma unroll
        for (int e = 0; e < 8; ++e) { o[e] -= mean; sv += o[e] * o[e]; }
        const float rstd = rsqrtf(sum8(sv) * (1.f / 64.f) + 64e-5f);
        const float rks = (p.FB + FOFF_RKS)[m * 8 + head];
        ld8(p.rw_lnx_w + l * 512 + c0, w);
        ld8(p.rw_lnx_b + l * 512 + c0, bb);
        ld8(GA + T * LDG + c0, ga);
#pragma unroll
        for (int e = 0; e < 8; ++e) o[e] = (o[e] * rstd * w[e] + bb[e] + rks * v[e]) * ga[e];
        *(uint4*)(row + C_R + c0) = pack8(o);
      }
    }
  }
}

__device__ __forceinline__ void phase_final(const Params& p) {
  const int tid = opaque_tid(), lane = tid & 63, wid = tid >> 6;
  for (int m = BID * 4 + wid, nb_ = NBLK; m < M_TOT; m += nb_ * 4) {
    float* dst;
    if (m < M_PROMPT) {
      int b = m / T_P, t = m - b * T_P;
      if (t < 16) continue;
      dst = p.out + O_YP + ((long)b * 4096 + (t - 16)) * DM;
    } else {
      dst = p.out + O_YS + (long)(m - M_PROMPT) * DM;
    }
    float x[16];
    float ss = 0.f;
#pragma unroll
    for (int j = 0; j < 2; ++j) {
      uint4 raw = *(const uint4*)(p.XB + xb_off(m, lane * 8 + 512 * j));
      unsigned wv[4] = {raw.x, raw.y, raw.z, raw.w};
#pragma unroll
      for (int e = 0; e < 8; ++e) {
        x[j * 8 + e] = bf2f((u16)((wv[e >> 1] >> ((e & 1) * 16)) & 0xffff));
        ss += x[j * 8 + e] * x[j * 8 + e];
      }
    }
    ss = sum64(ss);
    float rs = rsqrtf(ss * (1.f / 1024.f) + 1e-6f);
#pragma unroll
    for (int j = 0; j < 2; ++j) {
      int k0 = lane * 8 + 512 * j;
      float4 w0 = *(const float4*)(p.final_w + k0), w1 = *(const float4*)(p.final_w + k0 + 4);
      *(float4*)(dst + k0) = make_float4(x[j * 8 + 0] * rs * w0.x, x[j * 8 + 1] * rs * w0.y, x[j * 8 + 2] * rs * w0.z,
                                         x[j * 8 + 3] * rs * w0.w);
      *(float4*)(dst + k0 + 4) = make_float4(x[j * 8 + 4] * rs * w1.x, x[j * 8 + 5] * rs * w1.y,
                                             x[j * 8 + 6] * rs * w1.z, x[j * 8 + 7] * rs * w1.w);
    }
  }
}


#define XB_TMO      128
#define XB_XCNT(j)  (256  + 64 * (j))
#define XB_XSUB(j)  (1280 + 64 * (j))
#define XB_XGEN(j)  (2304 + 64 * (j))
#define XB_TOP      3328
#define XB_TOPGEN   3392
#define XCD_BAR_WORDS 3456
#define XB_SPIN_CAP (1u << 22)
__device__ __forceinline__ unsigned xb_ld(unsigned* p) { return __hip_atomic_load(p, __ATOMIC_RELAXED, __HIP_MEMORY_SCOPE_AGENT); }
__device__ __forceinline__ unsigned xb_add(unsigned* p, unsigned v) { return __hip_atomic_fetch_add(p, v, __ATOMIC_RELAXED, __HIP_MEMORY_SCOPE_AGENT); }
__device__ __forceinline__ unsigned xb_xcc_id() { return (unsigned)__builtin_amdgcn_s_getreg((3 << 11) | 20) & 0xFu; }
#define XB_SPIN(cond, bar) do { unsigned _sp = 0; while (cond) { __builtin_amdgcn_s_sleep(8); \
    if ((++_sp & 255u) == 0u) { if (xb_ld(&(bar)[XB_TMO])) break; if (_sp > XB_SPIN_CAP) { atomicAdd(&(bar)[XB_TMO], 1u); break; } } } } while (0)

__device__ __forceinline__ void xcd_barrier_post(unsigned* bar) {
  if (threadIdx.x == 0) (void)xb_add(&bar[XB_XCNT(xb_xcc_id())], 1u);
}
__device__ __forceinline__ void xcd_barrier_complete(unsigned* bar, unsigned x, unsigned& nloc, unsigned& nx) {
  const unsigned G = gridDim.x;
  unsigned sum, cnt, mine, sp = 0u;
  for (;;) {
    sum = 0u; cnt = 0u; mine = 0u;
#pragma unroll
    for (unsigned j = 0; j < 16; ++j) { const unsigned c = xb_ld(&bar[XB_XCNT(j)]); sum += c; cnt += (c > 0u) ? 1u : 0u; mine = (j == x) ? c : mine; }
    if (sum == G) break;
    __builtin_amdgcn_s_sleep(1);
    if ((++sp & 255u) == 0u) { if (xb_ld(&bar[XB_TMO])) break; if (sp > XB_SPIN_CAP) { atomicAdd(&bar[XB_TMO], 1u); break; } }
  }
  nloc = mine > 0u ? mine : 1u; nx = cnt > 0u ? cnt : 1u;
}
__device__ __forceinline__ void xcd_barrier(unsigned* bar, volatile unsigned* st) {
  asm volatile("s_waitcnt vmcnt(0)" ::: "memory");
  __syncthreads();
  if (threadIdx.x == 0) {
    __builtin_amdgcn_s_waitcnt(0);
    const unsigned x = xb_xcc_id();
    unsigned nloc = st[0], nx = st[1];
    if (nloc == 0u) { xcd_barrier_complete(bar, x, nloc, nx); st[0] = nloc; st[1] = nx; }
    const unsigned old = xb_add(&bar[XB_XSUB(x)], 1u);
    const unsigned gen = old / nloc;
    if (old + 1u == (gen + 1u) * nloc) {
      __builtin_amdgcn_fence(__ATOMIC_RELEASE, "agent");
      asm volatile("s_waitcnt vmcnt(0)" ::: "memory");
      const unsigned og = xb_add(&bar[XB_TOP], 1u);
      const unsigned tg = og / nx;
      if (og + 1u == (tg + 1u) * nx) xb_add(&bar[XB_TOPGEN], 1u);
      else XB_SPIN(xb_ld(&bar[XB_TOPGEN]) == tg, bar);
      __builtin_amdgcn_fence(__ATOMIC_ACQUIRE, "agent");
      xb_add(&bar[XB_XGEN(x)], 1u);
      asm volatile("s_waitcnt vmcnt(0)" ::: "memory");
    } else {
      XB_SPIN(xb_ld(&bar[XB_XGEN(x)]) == gen, bar);
      __builtin_amdgcn_fence(__ATOMIC_ACQUIRE, "agent");
      asm volatile("s_waitcnt vmcnt(0)" ::: "memory");
    }
  }
  __syncthreads();
}

constexpr int SMEM_BYTES = 40960;
__device__ __forceinline__ void run_phase(const Params& p, int ph, char* smem) {
  if (ph == 0) { phase_embed(p); return; }
  if (ph == 19) { phase_final(p); return; }
  int l = (ph - 1) / 9, s = (ph - 1) % 9;
  float* fs = (float*)smem;
  switch (s) {
    case 0: phase_convert(p, l, fs); phase_rowstat<true>(p, l, fs); break;
    case 1: phase_gemm<1, true>(p, p.XB, DM, (p.WB + OFF_W1T), 1024, LDP / 128, smem); break;
    case 2: phase_pre(p, l, fs); break;
    case 3: phase_scan(p, l, fs); break;
    case 4: phase_post(p, l, fs); break;
    case 5: phase_gemm<2, false, true>(p, p.PROJ, LDP, (p.WB + OFF_WOT), 1536, 8, smem); break;
    case 6: break;
    case 7: phase_gemm<3, true>(p, p.XB, DM, (p.WB + OFF_WGU), 1024, 44, smem); break;
    case 8: phase_gemm<2, true>(p, p.PROJ, D_FF, (p.WB + OFF_WDT), D_FF, 8, smem); break;
  }
}
constexpr int N_PHASES = 20;

#if MEGA
__global__ void __launch_bounds__(256, 3) k_mega(Params p) {
  __shared__ __attribute__((aligned(16))) char smem[SMEM_BYTES];
  __shared__ uint4 xb_words;
  if (threadIdx.x == 0) { xb_words = make_uint4(0u, 0u, 0u, 0u); }
  __syncthreads();
  cg::grid_group grid = cg::this_grid();
  float* fs = (float*)smem;
  volatile unsigned* xst = (volatile unsigned*)&xb_words;
  xcd_barrier_post(p.bar);
#define GSYNC() do { unsigned* b_ = p.bar; asm volatile("" : "+s"(b_)); xcd_barrier(b_, xst); } while (0)
  {
    const int L0_ = 0;
    int l = opaque_s(L0_);
    phase_convert(p, l, fs);
    phase_rowstat<true, true>(p, l, fs);
    grid.sync();
    l = opaque_s(l);
    phase_gemm<1, true>(p, p.XB, DM, (p.WB + OFF_W1T), 1024, LDP / 128, smem);
    GSYNC();
    l = opaque_s(l);
    phase_pre(p, l, fs);
    GSYNC();
    l = opaque_s(l);
    phase_scan(p, l, fs);
    GSYNC();
    l = opaque_s(l);
    phase_post(p, l, fs);
    GSYNC();
    l = opaque_s(l);
    phase_gemm<2, false, true>(p, p.PROJ, LDP, (p.WB + OFF_WOT), 1536, 8, smem);
    GSYNC();
    l = opaque_s(l);
    phase_gemm<3, true>(p, p.XB, DM, (p.WB + OFF_WGU), 1024, 44, smem);
    GSYNC();
    l = opaque_s(l);
    phase_gemm<2, true>(p, p.PROJ, D_FF, (p.WB + OFF_WDT), D_FF, 8, smem);
    GSYNC();
  }
  {
    const int L0_ = 1;
    int l = opaque_s(L0_);
    phase_convert(p, l, fs);
    phase_rowstat<true>(p, l, fs);
    GSYNC();
    l = opaque_s(l);
    phase_gemm<1, true>(p, p.XB, DM, (p.WB + OFF_W1T), 1024, LDP / 128, smem);
    GSYNC();
    l = opaque_s(l);
    phase_pre(p, l, fs);
    GSYNC();
    l = opaque_s(l);
    phase_scan(p, l, fs);
    GSYNC();
    l = opaque_s(l);
    phase_post(p, l, fs);
    GSYNC();
    l = opaque_s(l);
    phase_gemm<2, false, true>(p, p.PROJ, LDP, (p.WB + OFF_WOT), 1536, 8, smem);
    GSYNC();
    l = opaque_s(l);
    phase_gemm<3, true>(p, p.XB, DM, (p.WB + OFF_WGU), 1024, 44, smem);
    GSYNC();
    l = opaque_s(l);
    phase_gemm<2, true>(p, p.PROJ, D_FF, (p.WB + OFF_WDT), D_FF, 8, smem);
    GSYNC();
  }
  phase_final(p);
}
#else
template <int PH>
__global__ void __launch_bounds__(256, 3) k_phase(Params p) {
  __shared__ __attribute__((aligned(16))) char smem[SMEM_BYTES];
  run_phase(p, PH, smem);
}
template <int PH>
static void launch_all(const Params& p, int grid, hipStream_t stream) {
  hipLaunchKernelGGL(k_phase<PH>, dim3(grid), dim3(256), 0, stream, p);
  if constexpr (PH + 1 < N_PHASES) launch_all<PH + 1>(p, grid, stream);
}
#endif

extern "C" void kernel_launch(void* const* d_in, const int* in_sizes, int n_in, void* d_out, int out_size, void* d_ws,
                              size_t ws_size, hipStream_t stream) {
  Params p{};
  const float** pf = (const float**)&p;
  for (int i = 0; i < 35; ++i) pf[i] = (const float*)d_in[i];
  p.out = (float*)d_out;
  char* ws = (char*)d_ws;
  size_t off = 0;
  auto take = [&](size_t bytes) { char* r = ws + off; off += (bytes + 255) & ~(size_t)255; return r; };
  p.XB = (u16*)take((size_t)M_TOT * DM * 2);
  p.PROJ = (u16*)take((size_t)M_TOT * LDP * 2);
  p.WB = (u16*)take((size_t)WB_TOTAL * 2);
  p.BND = (u16*)take((size_t)NBLK16 * 1792 * 2);
  p.BND2 = (u16*)take((size_t)NBLK16 * 3 * 1024 * 2);
  p.ORW = (u16*)take((size_t)M_TOT * 512 * 2);
  p.FB = (float*)take((size_t)FB_TOTAL * 4);
  p.bar = (unsigned*)take((size_t)XCD_BAR_WORDS * 4);
  p.RWX = (u16*)d_out;
  if (off > ws_size) fprintf(stderr, "workspace too small: need %zu have %zu\n", off, ws_size);
#if MEGA
  static int grid_blocks = 0;
  if (!grid_blocks) {
    int dev = 0, cus = 0, per_cu = 0;
    hipGetDevice(&dev);
    hipDeviceGetAttribute(&cus, hipDeviceAttributeMultiprocessorCount, dev);
    hipOccupancyMaxActiveBlocksPerMultiprocessor(&per_cu, k_mega, 256, 0);
    if (per_cu > 3) per_cu = 3;
    grid_blocks = cus * per_cu;
  }
  hipMemsetAsync(p.bar, 0, (size_t)XCD_BAR_WORDS * 4, stream);
  void* args[] = {&p};
  hipError_t e = hipLaunchCooperativeKernel((void*)k_mega, dim3(grid_blocks), dim3(256), args, 0, stream);
  if (e != hipSuccess) fprintf(stderr, "cooperative launch failed: %s (grid %d)\n", hipGetErrorString(e), grid_blocks);
#else
  launch_all<0>(p, 768, stream);
#endif
}
```
